# Optimizing an MI355X kernel written in HIP

```python
import math
import jax, jax.numpy as jnp
from jax import lax
import numpy as np

D_MODEL = 1024
BATCH = 1
SEQ = 16384
DEPTH = 1

HEAD_DIM = D_MODEL // 8
DN_HEADS = 4
DN_DK = HEAD_DIM
DN_DV = HEAD_DIM
DN_CONV = 4
DN_CHUNK = 64
FOX_HEADS = 4
FOX_HD = HEAD_DIM
FOX_BLOCK = 128
MOE_EXPERTS = 32
MOE_TOPK = 4
MOE_FF = D_MODEL
MOE_BLOCK = 128
SWIGLU_LIMIT = 7.0
SWIGLU_ALPHA = 1.702
N_MOD = 6
RMS_EPS = 1e-6
L2_EPS = 1e-6

DN_QKV = DN_HEADS * (2 * DN_DK + DN_DV)
DN_W = DN_HEADS * DN_DV
FOX_W = FOX_HEADS * FOX_HD
IN_SIZES = (DN_QKV, DN_W, DN_HEADS, DN_HEADS, 3 * FOX_W, FOX_HEADS, D_MODEL, D_MODEL)
N_IN = sum(IN_SIZES)

kernel_name = "hybrid_deltanet_fox_moe_adaln"


def rms_norm(x, g):
    xf = x.astype(jnp.float32)
    y = xf * lax.rsqrt(jnp.mean(xf * xf, axis=-1, keepdims=True) + RMS_EPS)
    return (y * g.astype(jnp.float32)).astype(x.dtype)


def l2_normalize(x):
    return x * lax.rsqrt(jnp.sum(x * x, axis=-1, keepdims=True) + L2_EPS)


def causal_depthwise_conv(x, w):
    K, C = w.shape
    return lax.conv_general_dilated(x, w[:, None, :].astype(x.dtype), window_strides=(1,),
                                    padding=[(K - 1, 0)], dimension_numbers=("NWC", "WIO", "NWC"),
                                    feature_group_count=C)


def gated_delta_rule(q, k, v, g, beta):
    B, S, H, DK = q.shape
    DV = v.shape[-1]
    C = DN_CHUNK
    N = S // C
    f32 = jnp.float32
    q = l2_normalize(q.astype(f32)) * (DK ** -0.5)
    k = l2_normalize(k.astype(f32))
    v = v.astype(f32)

    def chunks(t):
        return jnp.transpose(t.reshape(B, N, C, H, t.shape[-1]), (0, 3, 1, 2, 4))

    q, k, v = chunks(q), chunks(k), chunks(v)
    g = jnp.transpose(g.astype(f32).reshape(B, N, C, H), (0, 3, 1, 2))
    beta = jnp.transpose(beta.astype(f32).reshape(B, N, C, H), (0, 3, 1, 2))
    gc = jnp.cumsum(g, axis=-1)
    incl = jnp.tril(jnp.ones((C, C), dtype=bool))
    strict = jnp.tril(jnp.ones((C, C), dtype=bool), -1)
    decay = jnp.exp(jnp.where(incl, gc[..., :, None] - gc[..., None, :], -jnp.inf))
    kb = k * beta[..., None]
    vb = v * beta[..., None]
    L = jnp.where(strict, jnp.einsum("bhncd,bhnmd->bhncm", kb, k) * decay, 0.0)
    eye = jnp.eye(C, dtype=f32)
    T = lax.linalg.triangular_solve(L + eye, jnp.broadcast_to(eye, L.shape), left_side=True, lower=True)
    u = jnp.einsum("bhncm,bhnmv->bhncv", T, vb)
    w = jnp.einsum("bhncm,bhnmk->bhnck", T, kb * jnp.exp(gc)[..., None])
    attn = jnp.where(incl, jnp.einsum("bhncd,bhnmd->bhncm", q, k) * decay, 0.0)
    q_dec = q * jnp.exp(gc)[..., None]
    g_last = gc[..., -1]
    k_dec = k * jnp.exp(g_last[..., None] - gc)[..., None]
    xs = tuple(jnp.moveaxis(t, 2, 0) for t in (u, w, q_dec, k_dec, attn, g_last))

    def step(state, inp):
        u_n, w_n, qd_n, kd_n, a_n, gl_n = inp
        v_new = u_n - jnp.einsum("bhck,bhkv->bhcv", w_n, state)
        o = jnp.einsum("bhck,bhkv->bhcv", qd_n, state) + jnp.einsum("bhcm,bhmv->bhcv", a_n, v_new)
        state = state * jnp.exp(gl_n)[..., None, None] + jnp.einsum("bhck,bhcv->bhkv", kd_n, v_new)
        return state, o

    state0 = jnp.zeros((B, H, DK, DV), f32)
    _, o = lax.scan(step, state0, xs)
    return jnp.transpose(o, (1, 0, 3, 2, 4)).reshape(B, S, H, DV)


def forgetting_attention(q, k, v, log_f):
    B, S, H, Dh = q.shape
    nb = S // FOX_BLOCK
    scale = Dh ** -0.5
    F = jnp.cumsum(log_f.astype(jnp.float32), axis=1)
    F_k = jnp.transpose(F, (0, 2, 1))
    q_blocks = jnp.moveaxis(q.reshape(B, nb, FOX_BLOCK, H, Dh), 1, 0)
    F_blocks = jnp.moveaxis(F.reshape(B, nb, FOX_BLOCK, H), 1, 0)
    k_pos = jnp.arange(S)

    def block(args):
        q_blk, F_blk, b_idx = args
        s = jnp.einsum("bqhd,bkhd->bhqk", q_blk, k).astype(jnp.float32) * scale
        s = s + jnp.transpose(F_blk, (0, 2, 1))[..., None] - F_k[:, :, None, :]
        q_pos = b_idx * FOX_BLOCK + jnp.arange(FOX_BLOCK)
        s = jnp.where(k_pos[None, :] <= q_pos[:, None], s, -jnp.inf)
        p = jax.nn.softmax(s, axis=-1).astype(v.dtype)
        return jnp.einsum("bhqk,bkhd->bqhd", p, v)

    o = lax.map(block, (q_blocks, F_blocks, jnp.arange(nb)))
    return jnp.moveaxis(o, 0, 1).reshape(B, S, H, Dh)


def moe_ffn(h, w_router, b_router, w_gate_up, b_gate_up, w_down, b_down):
    B, S, D = h.shape
    T = B * S
    A = T * MOE_TOPK
    xt = h.reshape(T, D)
    logits = (xt @ w_router + b_router).astype(jnp.float32)
    top_val, top_idx = lax.top_k(logits, MOE_TOPK)
    gates = jax.nn.softmax(top_val, axis=-1)
    e_flat = top_idx.reshape(A).astype(jnp.int32)
    tok_flat = jnp.arange(A, dtype=jnp.int32) // MOE_TOPK
    g_flat = gates.reshape(A)
    order = jnp.argsort(e_flat)
    e_sorted = e_flat[order]
    counts = jnp.bincount(e_flat, length=MOE_EXPERTS).astype(jnp.int32)
    padded = (counts + MOE_BLOCK - 1) // MOE_BLOCK * MOE_BLOCK
    pad_end = jnp.cumsum(padded)
    pad_start = pad_end - padded
    grp_start = jnp.cumsum(counts) - counts
    dest = pad_start[e_sorted] + (jnp.arange(A, dtype=jnp.int32) - grp_start[e_sorted])
    n_blocks = -(-A // MOE_BLOCK) + MOE_EXPERTS
    P = n_blocks * MOE_BLOCK
    tok_buf = jnp.full((P,), T, jnp.int32).at[dest].set(tok_flat[order])
    gate_buf = jnp.zeros((P,), jnp.float32).at[dest].set(g_flat[order])
    blk_start = jnp.arange(n_blocks, dtype=jnp.int32) * MOE_BLOCK
    blk_e = jnp.minimum(jnp.searchsorted(pad_end, blk_start, side="right"), MOE_EXPERTS - 1)
    x_pad = jnp.concatenate([xt, jnp.zeros((1, D), xt.dtype)], axis=0)
    x_buf = x_pad[tok_buf].reshape(n_blocks, MOE_BLOCK, D)

    def expert_block(args):
        xb, e = args
        gu = xb @ w_gate_up[e] + b_gate_up[e]
        gate, up = gu[:, :MOE_FF], gu[:, MOE_FF:]
        gate = jnp.minimum(gate, SWIGLU_LIMIT)
        up = jnp.clip(up, -SWIGLU_LIMIT, SWIGLU_LIMIT)
        act = (up + 1.0) * (gate * jax.nn.sigmoid(SWIGLU_ALPHA * gate))
        return act @ w_down[e] + b_down[e]

    y_buf = lax.map(expert_block, (x_buf, blk_e)).reshape(P, D)
    y = jnp.zeros((T + 1, D), jnp.float32).at[tok_buf].add(y_buf.astype(jnp.float32) * gate_buf[:, None])
    return y[:T].reshape(B, S, D).astype(h.dtype)


def setup_inputs(seed: int = 0) -> dict:
    key = jax.random.key(seed)
    ks = jax.random.split(key, 24)
    f32 = jnp.float32
    nrm = jax.random.normal
    x = nrm(ks[0], (BATCH, SEQ, D_MODEL), f32)
    c = nrm(ks[1], (BATCH, D_MODEL), f32)
    w_ada = nrm(ks[2], (DEPTH, D_MODEL, N_MOD * D_MODEL), f32) * (0.5 * D_MODEL ** -0.5)
    b_ada = 0.02 * nrm(ks[3], (DEPTH, N_MOD * D_MODEL), f32)
    g_norm1 = 1.0 + 0.02 * nrm(ks[4], (DEPTH, D_MODEL), f32)
    w_in = nrm(ks[5], (DEPTH, D_MODEL, N_IN), f32) * D_MODEL ** -0.5
    conv_w = nrm(ks[6], (DEPTH, DN_CONV, DN_QKV), f32) * DN_CONV ** -0.5
    a_log = jnp.log(jax.random.uniform(ks[7], (DEPTH, DN_HEADS), f32, 1.0, 16.0))
    dt = jnp.exp(jax.random.uniform(ks[8], (DEPTH, DN_HEADS), f32, math.log(1e-3), math.log(1e-1)))
    dt_bias = jnp.log(jnp.expm1(dt))
    g_onorm = 1.0 + 0.02 * nrm(ks[9], (DEPTH, DN_DV), f32)
    b_fgate = jax.random.uniform(ks[10], (DEPTH, FOX_HEADS), f32, 1.0, 4.0)
    w_o_delta = nrm(ks[11], (DEPTH, DN_W, D_MODEL), f32) * DN_W ** -0.5
    w_o_fox = nrm(ks[12], (DEPTH, FOX_W, D_MODEL), f32) * FOX_W ** -0.5
    w_out = nrm(ks[13], (DEPTH, D_MODEL, D_MODEL), f32) * D_MODEL ** -0.5
    g_norm2 = 1.0 + 0.02 * nrm(ks[14], (DEPTH, D_MODEL), f32)
    w_router = nrm(ks[15], (DEPTH, D_MODEL, MOE_EXPERTS), f32) * D_MODEL ** -0.5
    b_router = 0.01 * nrm(ks[16], (DEPTH, MOE_EXPERTS), f32)
    w_gate_up = nrm(ks[17], (DEPTH, MOE_EXPERTS, D_MODEL, 2 * MOE_FF), f32) * D_MODEL ** -0.5
    b_gate_up = 0.01 * nrm(ks[18], (DEPTH, MOE_EXPERTS, 2 * MOE_FF), f32)
    w_down = nrm(ks[19], (DEPTH, MOE_EXPERTS, MOE_FF, D_MODEL), f32) * MOE_FF ** -0.5
    b_down = 0.01 * nrm(ks[20], (DEPTH, MOE_EXPERTS, D_MODEL), f32)
    g_final = 1.0 + 0.02 * nrm(ks[21], (D_MODEL,), f32)
    return {"x": x, "c": c, "w_ada": w_ada, "b_ada": b_ada, "g_norm1": g_norm1, "w_in": w_in,
            "conv_w": conv_w, "a_log": a_log, "dt_bias": dt_bias, "g_onorm": g_onorm, "b_fgate": b_fgate,
            "w_o_delta": w_o_delta, "w_o_fox": w_o_fox, "w_out": w_out, "g_norm2": g_norm2,
            "w_router": w_router, "b_router": b_router, "w_gate_up": w_gate_up, "b_gate_up": b_gate_up,
            "w_down": w_down, "b_down": b_down, "g_final": g_final}


def reference(x, c, w_ada, b_ada, g_norm1, w_in, conv_w, a_log, dt_bias, g_onorm, b_fgate,
              w_o_delta, w_o_fox, w_out, g_norm2, w_router, b_router, w_gate_up, b_gate_up,
              w_down, b_down, g_final):
    B, S, D = x.shape
    split_points = np.cumsum(IN_SIZES)[:-1].tolist()
    for l in range(DEPTH):
        mod = (c @ w_ada[l] + b_ada[l]).reshape(B, N_MOD, D)
        sh1, sc1, gt1, sh2, sc2, gt2 = [mod[:, i, None, :] for i in range(N_MOD)]

        h = rms_norm(x, g_norm1[l]) * (1.0 + sc1) + sh1
        proj = h @ w_in[l]
        dn_qkv, dn_z, dn_b, dn_a, fx_qkv, fx_f, gate_a, gate_b = jnp.split(proj, split_points, axis=-1)

        qkv = jax.nn.silu(causal_depthwise_conv(dn_qkv, conv_w[l]))
        q_a, k_a, v_a = jnp.split(qkv, [DN_HEADS * DN_DK, 2 * DN_HEADS * DN_DK], axis=-1)
        q_a = q_a.reshape(B, S, DN_HEADS, DN_DK)
        k_a = k_a.reshape(B, S, DN_HEADS, DN_DK)
        v_a = v_a.reshape(B, S, DN_HEADS, DN_DV)
        beta = jax.nn.sigmoid(dn_b.astype(jnp.float32))
        g = -jnp.exp(a_log[l]) * jax.nn.softplus(dn_a.astype(jnp.float32) + dt_bias[l])
        o_a = gated_delta_rule(q_a, k_a, v_a, g, beta).astype(x.dtype)
        o_a = rms_norm(o_a, g_onorm[l]) * jax.nn.silu(dn_z.reshape(B, S, DN_HEADS, DN_DV))
        y_a = o_a.reshape(B, S, DN_W) @ w_o_delta[l]

        q_b, k_b, v_b = jnp.split(fx_qkv, [FOX_W, 2 * FOX_W], axis=-1)
        log_f = jax.nn.log_sigmoid(fx_f.astype(jnp.float32) + b_fgate[l])
        o_b = forgetting_attention(q_b.reshape(B, S, FOX_HEADS, FOX_HD), k_b.reshape(B, S, FOX_HEADS, FOX_HD),
                                   v_b.reshape(B, S, FOX_HEADS, FOX_HD), log_f)
        y_b = o_b.reshape(B, S, FOX_W) @ w_o_fox[l]

        merged = jax.nn.sigmoid(gate_a) * y_a + jax.nn.sigmoid(gate_b) * y_b
        x = x + gt1 * (merged @ w_out[l])

        h2 = rms_norm(x, g_norm2[l]) * (1.0 + sc2) + sh2
        x = x + gt2 * moe_ffn(h2, w_router[l], b_router[l], w_gate_up[l], b_gate_up[l], w_down[l], b_down[l])
    return rms_norm(x, g_final)
```

```cpp
#include <hip/hip_runtime.h>
#include <stdint.h>
#include <stdio.h>

#ifndef N_LAUNCHES
#define N_LAUNCHES 0
#endif

#define DI __device__ __forceinline__
#define LAS __attribute__((address_space(3)))
typedef unsigned short bf16_t;
typedef short bf16x8 __attribute__((ext_vector_type(8)));
typedef float f32x4 __attribute__((ext_vector_type(4)));
typedef unsigned u32x4 __attribute__((ext_vector_type(4)));
typedef unsigned u32x2 __attribute__((ext_vector_type(2)));

constexpr int SEQ = 16384, DM = 1024, NIN = 5644, NPJ = 5632, NE = 32, TOPK = 4;
constexpr int NH = 4, HD = 128, CH = 64, NCH = SEQ / CH;
constexpr int PJ_DQ = 0, PJ_DK = 512, PJ_DV = 1024, PJ_DZ = 1536, PJ_FQ = 2048, PJ_FK = 2560, PJ_FV = 3072, PJ_GA = 3584, PJ_GB = 4608;
constexpr int NTHREADS = 512, NWAVES = 8;
constexpr int LDS_BYTES = 152 * 1024;
constexpr int NPHASES = 13;

constexpr size_t MiB = 1u << 20;
constexpr size_t WS_BAR = 0;
constexpr size_t WS_CNT = 32768;
constexpr size_t CTL_ZERO = 65536;
constexpr size_t WS_MOD = 65536;
constexpr size_t WS_F = WS_MOD + 32768;
constexpr size_t WS_EG = WS_F + 262144;
constexpr size_t WS_TOKE = WS_EG + 4096;
constexpr size_t WS_TOKS = WS_TOKE + 262144;
constexpr size_t WS_TOKG = WS_TOKS + 262144;
constexpr size_t WS_SP = WS_TOKG + 262144;
constexpr size_t WS_WINT = WS_SP + MiB;
constexpr size_t WS_WOAT = WS_WINT + (size_t)NPJ * DM * 2;
constexpr size_t WS_WOBT = WS_WOAT + MiB;
constexpr size_t WS_WOUTT = WS_WOBT + MiB;
constexpr size_t WS_WGUT = WS_WOUTT + 2 * MiB;
constexpr size_t WS_WDT = WS_WGUT + 128 * MiB;
constexpr size_t WS_X1 = WS_WDT + 64 * MiB;
constexpr size_t WS_H2 = WS_X1 + 64 * MiB;
constexpr size_t WS_MRG = WS_H2 + 32 * MiB;
constexpr size_t WS_RA = WS_MRG + 32 * MiB;
constexpr size_t WS_RB = WS_RA + 176 * MiB;
constexpr size_t WS_H = WS_RB;
constexpr size_t WS_DNW = WS_H + 32 * MiB;
constexpr size_t WS_DNU = WS_DNW + 16 * MiB;
constexpr size_t WS_DNQD = WS_DNU + 16 * MiB;
constexpr size_t WS_DNKD = WS_DNQD + 16 * MiB;
constexpr size_t WS_DNATT = WS_DNKD + 16 * MiB;
constexpr size_t WS_ORAW = WS_DNATT + 8 * MiB;
constexpr size_t WS_OA = WS_ORAW + 32 * MiB;
constexpr size_t WS_OB = WS_OA + 16 * MiB;
constexpr size_t WS_VT = WS_OB + 16 * MiB;
constexpr size_t WS_END = WS_RB + 184 * MiB;
constexpr size_t WS_XG = WS_RA, WS_YB = WS_RA, WS_ACT = WS_RB, WS_PROJ = WS_RA;
static_assert(WS_VT + 16 * MiB <= WS_END, "region B");

struct Args { const float* in[22]; float* out; unsigned char* ws; int ph_lo, ph_hi; };
enum { I_X = 0, I_C, I_WADA, I_BADA, I_G1, I_WIN, I_CONVW, I_ALOG, I_DTB, I_GON, I_BFG, I_WOD, I_WOF, I_WOUT, I_G2, I_WR, I_BR, I_WGU, I_BGU, I_WD, I_BD, I_GF };

DI float bf2f(bf16_t v) { return __uint_as_float(((unsigned)v) << 16); }
DI bf16_t f2bf(float f) { unsigned u = __float_as_uint(f); u += 0x7fffu + ((u >> 16) & 1u); return (bf16_t)(u >> 16); }
DI unsigned pk2(float lo, float hi) { return (unsigned)f2bf(lo) | ((unsigned)f2bf(hi) << 16); }
DI float sigm(float x) { return 1.f / (1.f + expf(-x)); }
DI float siluf(float x) { return x / (1.f + expf(-x)); }
DI float softplusf(float x) { return fmaxf(x, 0.f) + log1pf(expf(-fabsf(x))); }
DI float logsigf(float x) { return fminf(x, 0.f) - log1pf(expf(-fabsf(x))); }
DI float wave_sum(float v) { for (int o = 32; o >= 1; o >>= 1) v += __shfl_xor(v, o); return v; }
#define MFMA16(a, b, c) __builtin_amdgcn_mfma_f32_16x16x32_bf16((a), (b), (c), 0, 0, 0)

DI int gu_src(int n) { const int g = n >> 6, r = n & 63; return r < 32 ? 32 * g + r : 1024 + 32 * g + (r - 32); }

#define XB_TMO      128
#define XB_XCNT(j)  (256  + 64 * (j))
#define XB_XSUB(j)  (1280 + 64 * (j))
#define XB_XGEN(j)  (2304 + 64 * (j))
#define XB_TOP      3328
#define XB_TOPGEN   3392
#define XCD_BAR_WORDS 3456
#define XB_SPIN_CAP (1u << 22)
DI unsigned xb_ld(unsigned* p)              { return __hip_atomic_load(p, __ATOMIC_RELAXED, __HIP_MEMORY_SCOPE_AGENT); }
DI unsigned xb_add(unsigned* p, unsigned v) { return __hip_atomic_fetch_add(p, v, __ATOMIC_RELAXED, __HIP_MEMORY_SCOPE_AGENT); }
DI unsigned xb_xcc_id() { return (unsigned)__builtin_amdgcn_s_getreg((3 << 11) | 20) & 0xFu; }
#define XB_SPIN(cond, bar) do { unsigned _sp = 0; while (cond) { __builtin_amdgcn_s_sleep(1); \
    if ((++_sp & 255u) == 0u) { if (xb_ld(&(bar)[XB_TMO])) break; if (_sp > XB_SPIN_CAP) { atomicAdd(&(bar)[XB_TMO], 1u); break; } } } } while (0)
struct XcdBarrier { unsigned* bar; unsigned x; volatile LAS unsigned* st; };
DI XcdBarrier xcd_barrier_post(unsigned* bar, volatile LAS unsigned* st) {
    XcdBarrier b; b.bar = bar; b.x = xb_xcc_id(); b.st = st;
    if (threadIdx.x == 0) (void)xb_add(&bar[XB_XCNT(b.x)], 1u);
    return b;
}
DI void xcd_barrier_complete(unsigned* bar, unsigned x, unsigned& nloc, unsigned& nx) {
    const unsigned G = gridDim.x * gridDim.y * gridDim.z;
    unsigned sum, cnt, mine, sp = 0u;
    for (;;) {
        sum = 0u; cnt = 0u; mine = 0u;
#pragma unroll
        for (unsigned j = 0; j < 16; ++j) { const unsigned c = xb_ld(&bar[XB_XCNT(j)]); sum += c; cnt += (c > 0u) ? 1u : 0u; mine = (j == x) ? c : mine; }
        if (sum == G) break;
        __builtin_amdgcn_s_sleep(1);
        if ((++sp & 255u) == 0u) { if (xb_ld(&bar[XB_TMO])) break; if (sp > XB_SPIN_CAP) { atomicAdd(&bar[XB_TMO], 1u); break; } }
    }
    nloc = mine > 0u ? mine : 1u; nx = cnt > 0u ? cnt : 1u;
}
DI void xcd_barrier(const XcdBarrier& b) {
    asm volatile("s_waitcnt vmcnt(0)" ::: "memory");
    __syncthreads();
    if (threadIdx.x == 0) {
        unsigned* bar = b.bar;
        __builtin_amdgcn_s_waitcnt(0);
        unsigned nloc = b.st[0], nx = b.st[1];
        if (nloc == 0u) { xcd_barrier_complete(bar, b.x, nloc, nx); b.st[0] = nloc; b.st[1] = nx; }
        const unsigned old = xb_add(&bar[XB_XSUB(b.x)], 1u);
        const unsigned gen = old / nloc;
        if (old + 1u == (gen + 1u) * nloc) {
            __builtin_amdgcn_fence(__ATOMIC_RELEASE, "agent");
            asm volatile("s_waitcnt vmcnt(0)" ::: "memory");
            const unsigned og = xb_add(&bar[XB_TOP], 1u);
            const unsigned tg = og / nx;
            if (og + 1u == (tg + 1u) * nx) xb_add(&bar[XB_TOPGEN], 1u);
            else XB_SPIN(xb_ld(&bar[XB_TOPGEN]) == tg, bar);
            __builtin_amdgcn_fence(__ATOMIC_ACQUIRE, "agent");
            xb_add(&bar[XB_XGEN(b.x)], 1u);
            asm volatile("s_waitcnt vmcnt(0)" ::: "memory");
        } else {
            XB_SPIN(xb_ld(&bar[XB_XGEN(b.x)]) == gen, bar);
            __builtin_amdgcn_fence(__ATOMIC_ACQUIRE, "agent");
            asm volatile("s_waitcnt vmcnt(0)" ::: "memory");
        }
    }
    __syncthreads();
}

template <int NT>
DI void wave_gemm(const bf16_t* const (&ap)[4], const bf16_t* const (&bp)[NT], int K, f32x4 (&acc)[4][NT]) {
    for (int k0 = 0; k0 < K; k0 += 32) {
        bf16x8 a[4], b[NT];
#pragma unroll
        for (int i = 0; i < 4; ++i) a[i] = *(const bf16x8*)(ap[i] + k0);
#pragma unroll
        for (int j = 0; j < NT; ++j) b[j] = *(const bf16x8*)(bp[j] + k0);
#pragma unroll
        for (int i = 0; i < 4; ++i)
#pragma unroll
            for (int j = 0; j < NT; ++j) acc[i][j] = MFMA16(a[i], b[j], acc[i][j]);
    }
}
template <int NT> DI void zero_acc(f32x4 (&acc)[4][NT]) {
#pragma unroll
    for (int i = 0; i < 4; ++i)
#pragma unroll
        for (int j = 0; j < NT; ++j) acc[i][j] = (f32x4){0.f, 0.f, 0.f, 0.f};
}

DI void transpose_tile(float* tile, const float* src, int ld, int k0, int c0, int c1, bf16_t* dst, int Kd) {
    const int tid = threadIdx.x;
    __syncthreads();
#pragma unroll
    for (int i = 0; i < 8; ++i) { const int kk = (tid >> 6) + 8 * i, nn = tid & 63; const int col = nn < 32 ? c0 + nn : c1 + nn - 32; tile[kk * 65 + nn] = src[(size_t)(k0 + kk) * ld + col]; }
    __syncthreads();
    const int nn = tid >> 3, kc = (tid & 7) * 8;
    u32x4 w;
    w.x = pk2(tile[(kc + 0) * 65 + nn], tile[(kc + 1) * 65 + nn]); w.y = pk2(tile[(kc + 2) * 65 + nn], tile[(kc + 3) * 65 + nn]);
    w.z = pk2(tile[(kc + 4) * 65 + nn], tile[(kc + 5) * 65 + nn]); w.w = pk2(tile[(kc + 6) * 65 + nn], tile[(kc + 7) * 65 + nn]);
    *(u32x4*)(dst + (size_t)nn * Kd + k0 + kc) = w;
}
DI void ph0(const Args& a, float* lds) {
    const int tid = threadIdx.x, G = gridDim.x, bx = blockIdx.x;
    unsigned char* ws = a.ws;
    if (bx < 12) {
        const int j = bx * 512 + tid; const float* c = a.in[I_C]; const float* w = a.in[I_WADA];
        float acc = a.in[I_BADA][j];
        for (int k = 0; k < DM; ++k) acc += c[k] * w[(size_t)k * 6144 + j];
        ((float*)(ws + WS_MOD))[j] = acc;
    }
    constexpr int T_WIN = 88 * 16, T_WOA = 16 * 8, T_WOUT = 16 * 16, T_WGU = 32 * 32 * 16, T_WD = 32 * 16 * 16;
    constexpr int NT = T_WIN + 2 * T_WOA + T_WOUT + T_WGU + T_WD;
    for (int t = bx; t < NT; t += G) {
        int r = t;
        if (r < T_WIN) { const int nt = r / 16, kt = r % 16, n0 = nt * 64; const int c0 = n0 + (n0 >= 3584 ? 12 : (n0 >= 2048 ? 8 : 0));
            transpose_tile(lds, a.in[I_WIN], NIN, kt * 64, c0, c0 + 32, (bf16_t*)(ws + WS_WINT) + (size_t)n0 * DM, DM); continue; }
        r -= T_WIN;
        if (r < T_WOA) { const int nt = r / 8, kt = r % 8, n0 = nt * 64; transpose_tile(lds, a.in[I_WOD], DM, kt * 64, n0, n0 + 32, (bf16_t*)(ws + WS_WOAT) + (size_t)n0 * 512, 512); continue; }
        r -= T_WOA;
        if (r < T_WOA) { const int nt = r / 8, kt = r % 8, n0 = nt * 64; transpose_tile(lds, a.in[I_WOF], DM, kt * 64, n0, n0 + 32, (bf16_t*)(ws + WS_WOBT) + (size_t)n0 * 512, 512); continue; }
        r -= T_WOA;
        if (r < T_WOUT) { const int nt = r / 16, kt = r % 16, n0 = nt * 64; transpose_tile(lds, a.in[I_WOUT], DM, kt * 64, n0, n0 + 32, (bf16_t*)(ws + WS_WOUTT) + (size_t)n0 * DM, DM); continue; }
        r -= T_WOUT;
        if (r < T_WGU) { const int e = r / 512, q = r % 512, nt = q / 16, kt = q % 16, n0 = nt * 64;
            transpose_tile(lds, a.in[I_WGU] + (size_t)e * DM * 2048, 2048, kt * 64, gu_src(n0), gu_src(n0 + 32), (bf16_t*)(ws + WS_WGUT) + ((size_t)e * 2048 + n0) * DM, DM); continue; }
        r -= T_WGU;
        { const int e = r / 256, q = r % 256, nt = q / 16, kt = q % 16, n0 = nt * 64;
            transpose_tile(lds, a.in[I_WD] + (size_t)e * DM * DM, DM, kt * 64, n0, n0 + 32, (bf16_t*)(ws + WS_WDT) + ((size_t)e * DM + n0) * DM, DM); }
    }
}

DI void ph1(const Args& a, float* lds) {
    const int tid = threadIdx.x, lane = tid & 63, wave = tid >> 6, G = gridDim.x;
    float* A1 = lds; float* B1 = lds + 1024; float* wsm = lds + 2048;
    const float* mod = (const float*)(a.ws + WS_MOD);
    for (int k = tid; k < DM; k += NTHREADS) { A1[k] = a.in[I_G1][k] * (1.f + mod[1024 + k]); B1[k] = mod[k]; }
    for (int i = tid; i < 12 * DM; i += NTHREADS) { const int k = i / 12, j = i % 12; wsm[j * DM + k] = a.in[I_WIN][(size_t)k * NIN + (j < 8 ? 2048 + j : 3592 + (j - 8))]; }
    __syncthreads();
    bf16_t* H = (bf16_t*)(a.ws + WS_H); float* SP = (float*)(a.ws + WS_SP);
    for (int t = blockIdx.x * NWAVES + wave; t < SEQ; t += G * NWAVES) {
        const float* xr = a.in[I_X] + (size_t)t * DM;
        f32x4 v[4]; float ss = 0.f;
#pragma unroll
        for (int i = 0; i < 4; ++i) { v[i] = *(const f32x4*)(xr + lane * 4 + 256 * i); ss += v[i][0] * v[i][0] + v[i][1] * v[i][1] + v[i][2] * v[i][2] + v[i][3] * v[i][3]; }
        ss = wave_sum(ss);
        const float rstd = rsqrtf(ss * (1.f / DM) + 1e-6f);
#pragma unroll
        for (int i = 0; i < 4; ++i) { const int k = lane * 4 + 256 * i;
#pragma unroll
            for (int e = 0; e < 4; ++e) v[i][e] = v[i][e] * rstd * A1[k + e] + B1[k + e];
            u32x2 w; w.x = pk2(v[i][0], v[i][1]); w.y = pk2(v[i][2], v[i][3]);
            *(u32x2*)(H + (size_t)t * DM + k) = w; }
#pragma unroll 1
        for (int j = 0; j < 12; ++j) { float pj = 0.f;
#pragma unroll
            for (int i = 0; i < 4; ++i) { const f32x4 wv = *(const f32x4*)(wsm + j * DM + lane * 4 + 256 * i); pj += v[i][0] * wv[0] + v[i][1] * wv[1] + v[i][2] * wv[2] + v[i][3] * wv[3]; }
            const float s = wave_sum(pj); if (lane == j) SP[(size_t)t * 16 + j] = s; }
    }
}

DI void ph2(const Args& a) {
    const int tid = threadIdx.x, lane = tid & 63, wave = tid >> 6, G = gridDim.x, lr = lane & 15, lq = lane >> 4;
    const bf16_t* H = (const bf16_t*)(a.ws + WS_H); const bf16_t* Wt = (const bf16_t*)(a.ws + WS_WINT); bf16_t* P = (bf16_t*)(a.ws + WS_PROJ);
    for (int u = blockIdx.x; u < 128 * 22; u += G) {
        const int rt = u / 22, ct = u % 22, m0 = rt * 128 + (wave >> 2) * 64, n0 = ct * 256 + (wave & 3) * 64;
        const bf16_t* ap[4]; const bf16_t* bp[4];
#pragma unroll
        for (int i = 0; i < 4; ++i) { ap[i] = H + (size_t)(m0 + 16 * i + lr) * DM + lq * 8; bp[i] = Wt + (size_t)(n0 + 16 * i + lr) * DM + lq * 8; }
        f32x4 acc[4][4]; zero_acc<4>(acc);
        wave_gemm<4>(ap, bp, DM, acc);
#pragma unroll
        for (int i = 0; i < 4; ++i)
#pragma unroll
            for (int j = 0; j < 4; ++j)
#pragma unroll
                for (int r = 0; r < 4; ++r) P[(size_t)(m0 + 16 * i + lq * 4 + r) * NPJ + n0 + 16 * j + lr] = f2bf(acc[i][j][r]);
    }
}

DI void ph3_fcum(const Args& a, float* lds) {
    const int tid = threadIdx.x, h = blockIdx.x;
    const float* SP = (const float*)(a.ws + WS_SP); float* F = (float*)(a.ws + WS_F);
    const float bf = a.in[I_BFG][h];
    double* part = (double*)lds;
    double s = 0.0;
    for (int i = 0; i < 32; ++i) s += (double)logsigf(SP[(size_t)(tid * 32 + i) * 16 + 8 + h] + bf);
    part[tid] = s;
    __syncthreads();
    double off = 0.0;
    for (int i = 0; i < tid; ++i) off += part[i];
    for (int i = 0; i < 32; ++i) { off += (double)logsigf(SP[(size_t)(tid * 32 + i) * 16 + 8 + h] + bf); F[(size_t)h * SEQ + tid * 32 + i] = (float)off; }
    __syncthreads();
}
DI void ph3_prep(const Args& a, float* lds, int unit) {
    const int tid = threadIdx.x, lane = tid & 63, wave = tid >> 6;
    const int h = unit & 3, n = unit >> 2, t0 = n * CH;
    float* qs = lds; float* ks = qs + 64 * 129; float* vs = ks + 64 * 129;
    float* Ls = vs + 64 * 129; float* As = Ls + 64 * 65; float* Ts = As + 64 * 65;
    float* gcs = Ts + 64 * 65; float* bes = gcs + 64; float* gs = bes + 64;
    const float* SP = (const float*)(a.ws + WS_SP); const bf16_t* P = (const bf16_t*)(a.ws + WS_PROJ);
    __syncthreads();
    if (tid < 64) { const int t = t0 + tid;
        bes[tid] = sigm(SP[(size_t)t * 16 + h]);
        gs[tid] = -expf(a.in[I_ALOG][h]) * softplusf(SP[(size_t)t * 16 + 4 + h] + a.in[I_DTB][h]); }
    const float* cw = a.in[I_CONVW];
#pragma unroll 1
    for (int sec = 0; sec < 3; ++sec) {
        float* dst = sec == 0 ? qs : (sec == 1 ? ks : vs);
        const int d = tid & 127, col = sec * 512 + h * 128 + d;
        const float w0 = cw[0 * 1536 + col], w1 = cw[1 * 1536 + col], w2 = cw[2 * 1536 + col], w3 = cw[3 * 1536 + col];
        for (int i = 0; i < 16; ++i) { const int c = (tid >> 7) + 4 * i, t = t0 + c;
            float acc = w3 * bf2f(P[(size_t)t * NPJ + col]);
            if (t >= 1) acc += w2 * bf2f(P[(size_t)(t - 1) * NPJ + col]);
            if (t >= 2) acc += w1 * bf2f(P[(size_t)(t - 2) * NPJ + col]);
            if (t >= 3) acc += w0 * bf2f(P[(size_t)(t - 3) * NPJ + col]);
            dst[c * 129 + d] = siluf(acc); }
    }
    __syncthreads();
    if (tid == 0) { float s = 0.f; for (int c = 0; c < 64; ++c) { s += gs[c]; gcs[c] = s; } }
    for (int i = 0; i < 16; ++i) { const int r = wave * 16 + i; float* row = (r < 64 ? qs + r * 129 : ks + (r - 64) * 129);
        const float x0 = row[lane], x1 = row[lane + 64]; const float ss = wave_sum(x0 * x0 + x1 * x1);
        const float sc = rsqrtf(ss + 1e-6f) * (r < 64 ? 0.08838834764831845f : 1.f);
        row[lane] = x0 * sc; row[lane + 64] = x1 * sc; }
    __syncthreads();
    { const int m = tid & 63;
        for (int i = 0; i < 8; ++i) { const int c = (tid >> 6) + 8 * i; float kk = 0.f, qk = 0.f;
            for (int d = 0; d < 128; ++d) { const float km = ks[m * 129 + d]; kk += ks[c * 129 + d] * km; qk += qs[c * 129 + d] * km; }
            const float dec = (m <= c) ? expf(gcs[c] - gcs[m]) : 0.f;
            Ls[c * 65 + m] = (m < c) ? bes[c] * kk * dec : 0.f;
            As[c * 65 + m] = (m <= c) ? qk * dec : 0.f; } }
    __syncthreads();
    if (wave == 0) {
        for (int c = 0; c < 64; ++c) { float acc = (lane == c) ? 1.f : 0.f;
            for (int m = 0; m < c; ++m) acc -= Ls[c * 65 + m] * Ts[m * 65 + lane];
            Ts[c * 65 + lane] = acc;
            asm volatile("s_waitcnt lgkmcnt(0)" ::: "memory"); }
    }
    __syncthreads();
    bf16_t* W = (bf16_t*)(a.ws + WS_DNW) + (size_t)(h * NCH + n) * 64 * 128; bf16_t* U = (bf16_t*)(a.ws + WS_DNU) + (size_t)(h * NCH + n) * 64 * 128;
    bf16_t* QD = (bf16_t*)(a.ws + WS_DNQD) + (size_t)(h * NCH + n) * 64 * 128; bf16_t* KD = (bf16_t*)(a.ws + WS_DNKD) + (size_t)(h * NCH + n) * 64 * 128;
    bf16_t* AT = (bf16_t*)(a.ws + WS_DNATT) + (size_t)(h * NCH + n) * 64 * 64;
    { const int d = tid & 127; const float glast = gcs[63];
        for (int i = 0; i < 16; ++i) { const int c = (tid >> 7) + 4 * i; float uu = 0.f, ww = 0.f;
            for (int m = 0; m <= c; ++m) { const float tb = Ts[c * 65 + m] * bes[m]; uu += tb * vs[m * 129 + d]; ww += tb * expf(gcs[m]) * ks[m * 129 + d]; }
            U[c * 128 + d] = f2bf(uu); W[c * 128 + d] = f2bf(ww);
            QD[c * 128 + d] = f2bf(qs[c * 129 + d] * expf(gcs[c])); KD[c * 128 + d] = f2bf(ks[c * 129 + d] * expf(glast - gcs[c])); } }
    for (int i = tid; i < 64 * 64; i += NTHREADS) AT[i] = f2bf(As[(i >> 6) * 65 + (i & 63)]);
    if (tid == 0) ((float*)(a.ws + WS_EG))[h * NCH + n] = expf(gcs[63]);
}
DI void ph3_vt(const Args& a, float* lds, int unit) {
    const int tid = threadIdx.x; const int h = unit & 3, dh = (unit >> 2) & 1, tt = unit >> 3;
    const bf16_t* P = (const bf16_t*)(a.ws + WS_PROJ); bf16_t* VT = (bf16_t*)(a.ws + WS_VT);
    bf16_t* tile = (bf16_t*)lds;
    __syncthreads();
    for (int i = 0; i < 8; ++i) { const int t = (tid >> 6) + 8 * i, d = tid & 63; tile[t * 66 + d] = P[(size_t)(tt * 64 + t) * NPJ + PJ_FV + h * 128 + dh * 64 + d]; }
    __syncthreads();
    for (int i = 0; i < 8; ++i) { const int d = (tid >> 6) + 8 * i, t = tid & 63; VT[(size_t)(h * 128 + dh * 64 + d) * SEQ + tt * 64 + t] = tile[t * 66 + d]; }
}
DI void ph3(const Args& a, float* lds) {
    const int G = gridDim.x;
    if (blockIdx.x < 4) ph3_fcum(a, lds);
    for (int u = blockIdx.x; u < NH * NCH; u += G) ph3_prep(a, lds, u);
    for (int u = blockIdx.x; u < 4 * 2 * 256; u += G) ph3_vt(a, lds, u);
}

DI void ph4_scan(const Args& a, float* lds) {
    const int tid = threadIdx.x; const int h = blockIdx.x >> 3, vsl = blockIdx.x & 7;
    float* Sst = lds; float* wS = Sst + 128 * 17; float* kdS = wS + 64 * 129; float* qdS = kdS + 64 * 129; float* atS = qdS + 64 * 129; float* uS = atS + 64 * 65; float* vnS = uS + 64 * 17;
    for (int i = tid; i < 128 * 17; i += NTHREADS) Sst[i] = 0.f;
    float* ORAW = (float*)(a.ws + WS_ORAW);
    for (int n = 0; n < NCH; ++n) {
        const size_t cb = (size_t)(h * NCH + n);
        const bf16_t* W = (const bf16_t*)(a.ws + WS_DNW) + cb * 8192; const bf16_t* U = (const bf16_t*)(a.ws + WS_DNU) + cb * 8192;
        const bf16_t* QD = (const bf16_t*)(a.ws + WS_DNQD) + cb * 8192; const bf16_t* KD = (const bf16_t*)(a.ws + WS_DNKD) + cb * 8192;
        const bf16_t* AT = (const bf16_t*)(a.ws + WS_DNATT) + cb * 4096;
        const float eg = ((const float*)(a.ws + WS_EG))[cb];
        __syncthreads();
        for (int i = tid; i < 8192; i += NTHREADS) { const int c = i >> 7, d = i & 127; wS[c * 129 + d] = bf2f(W[i]); kdS[c * 129 + d] = bf2f(KD[i]); qdS[c * 129 + d] = bf2f(QD[i]); }
        for (int i = tid; i < 4096; i += NTHREADS) atS[(i >> 6) * 65 + (i & 63)] = bf2f(AT[i]);
        for (int i = tid; i < 1024; i += NTHREADS) uS[(i >> 4) * 17 + (i & 15)] = bf2f(U[(i >> 4) * 128 + vsl * 16 + (i & 15)]);
        __syncthreads();
        const int j = tid & 15;
        for (int i = 0; i < 2; ++i) { const int c = (tid >> 4) + 32 * i; float acc = uS[c * 17 + j];
            for (int k = 0; k < 128; ++k) acc -= wS[c * 129 + k] * Sst[k * 17 + j];
            vnS[c * 17 + j] = acc; }
        __syncthreads();
        for (int i = 0; i < 2; ++i) { const int c = (tid >> 4) + 32 * i; float acc = 0.f;
            for (int k = 0; k < 128; ++k) acc += qdS[c * 129 + k] * Sst[k * 17 + j];
            for (int m = 0; m <= c; ++m) acc += atS[c * 65 + m] * vnS[m * 17 + j];
            ORAW[(size_t)(n * CH + c) * 512 + h * 128 + vsl * 16 + j] = acc; }
        __syncthreads();
        for (int i = 0; i < 4; ++i) { const int k = (tid >> 4) + 32 * i; float acc = Sst[k * 17 + j] * eg;
            for (int c = 0; c < 64; ++c) acc += kdS[c * 129 + k] * vnS[c * 17 + j];
            Sst[k * 17 + j] = acc; }
    }
    __syncthreads();
}
DI void fox_task(const Args& a, bf16_t* Pw, int id) {
    const int lane = threadIdx.x & 63, lr = lane & 15, lq = lane >> 4;
    const int qt = 1023 - (id >> 2), h = id & 3, t0 = qt * 16;
    const bf16_t* P = (const bf16_t*)(a.ws + WS_PROJ); const bf16_t* VT = (const bf16_t*)(a.ws + WS_VT); const float* F = (const float*)(a.ws + WS_F) + (size_t)h * SEQ;
    bf16_t* OB = (bf16_t*)(a.ws + WS_OB);
    bf16x8 qa[4];
#pragma unroll
    for (int s = 0; s < 4; ++s) qa[s] = *(const bf16x8*)(P + (size_t)(t0 + lr) * NPJ + PJ_FQ + h * 128 + s * 32 + lq * 8);
    float Fq[4], m[4], ls[4]; f32x4 o[8];
#pragma unroll
    for (int r = 0; r < 4; ++r) { Fq[r] = F[t0 + lq * 4 + r]; m[r] = -1e30f; ls[r] = 0.f; }
#pragma unroll
    for (int d = 0; d < 8; ++d) o[d] = (f32x4){0.f, 0.f, 0.f, 0.f};
    const int nkt = (t0 + 15) / 32 + 1;
    for (int kt = 0; kt < nkt; ++kt) {
        const int k0 = kt * 32;
        f32x4 sc[2];
#pragma unroll
        for (int nt = 0; nt < 2; ++nt) { sc[nt] = (f32x4){0.f, 0.f, 0.f, 0.f};
#pragma unroll
            for (int s = 0; s < 4; ++s) { const bf16x8 kb = *(const bf16x8*)(P + (size_t)(k0 + 16 * nt + lr) * NPJ + PJ_FK + h * 128 + s * 32 + lq * 8); sc[nt] = MFMA16(qa[s], kb, sc[nt]); } }
        const float Fk0 = F[k0 + lr], Fk1 = F[k0 + 16 + lr];
        float mx[4];
#pragma unroll
        for (int r = 0; r < 4; ++r) { const int qrow = t0 + lq * 4 + r;
            float s0 = sc[0][r] * 0.08838834764831845f + Fq[r] - Fk0, s1 = sc[1][r] * 0.08838834764831845f + Fq[r] - Fk1;
            if (k0 + lr > qrow) s0 = -__builtin_inff();
            if (k0 + 16 + lr > qrow) s1 = -__builtin_inff();
            sc[0][r] = s0; sc[1][r] = s1; mx[r] = fmaxf(s0, s1); }
#pragma unroll
        for (int r = 0; r < 4; ++r) { for (int o_ = 1; o_ <= 8; o_ <<= 1) mx[r] = fmaxf(mx[r], __shfl_xor(mx[r], o_)); }
        __builtin_amdgcn_wave_barrier();
#pragma unroll
        for (int r = 0; r < 4; ++r) { const float mn = fmaxf(m[r], mx[r]); const float al = expf(m[r] - mn); m[r] = mn;
            const float p0 = expf(sc[0][r] - mn), p1 = expf(sc[1][r] - mn);
            ls[r] = ls[r] * al + p0 + p1;
#pragma unroll
            for (int d = 0; d < 8; ++d) o[d][r] *= al;
            Pw[(lq * 4 + r) * 40 + lr] = f2bf(p0); Pw[(lq * 4 + r) * 40 + 16 + lr] = f2bf(p1); }
        asm volatile("s_waitcnt lgkmcnt(0)" ::: "memory");
        __builtin_amdgcn_wave_barrier();
        const bf16x8 pa = *(const bf16x8*)(Pw + lr * 40 + lq * 8);
        asm volatile("s_waitcnt lgkmcnt(0)" ::: "memory");
        __builtin_amdgcn_wave_barrier();
#pragma unroll
        for (int d = 0; d < 8; ++d) { const bf16x8 vb = *(const bf16x8*)(VT + (size_t)(h * 128 + d * 16 + lr) * SEQ + k0 + lq * 8); o[d] = MFMA16(pa, vb, o[d]); }
    }
#pragma unroll
    for (int r = 0; r < 4; ++r) { for (int o_ = 1; o_ <= 8; o_ <<= 1) ls[r] += __shfl_xor(ls[r], o_); ls[r] = 1.f / ls[r]; }
#pragma unroll
    for (int d = 0; d < 8; ++d)
#pragma unroll
        for (int r = 0; r < 4; ++r) OB[(size_t)(t0 + lq * 4 + r) * 512 + h * 128 + d * 16 + lr] = f2bf(o[d][r] * ls[r]);
}
DI void ph4(const Args& a, float* lds) {
    const int G = gridDim.x, wave = threadIdx.x >> 6;
    if (blockIdx.x < 32) ph4_scan(a, lds);
    bf16_t* Pw = (bf16_t*)lds + wave * 16 * 40;
    const int NT = 4096, NW = G * NWAVES;
    for (int id = blockIdx.x * NWAVES + wave; id < NT / 2; id += NW) { fox_task(a, Pw, id); fox_task(a, Pw, NT - 1 - id); }
}

DI void ph5(const Args& a) {
    const int lane = threadIdx.x & 63, wave = threadIdx.x >> 6, NW = gridDim.x * NWAVES;
    const float* ORAW = (const float*)(a.ws + WS_ORAW); const bf16_t* P = (const bf16_t*)(a.ws + WS_PROJ); bf16_t* OA = (bf16_t*)(a.ws + WS_OA);
    const float g0 = a.in[I_GON][lane], g1 = a.in[I_GON][lane + 64];
    for (int id = blockIdx.x * NWAVES + wave; id < SEQ * 4; id += NW) { const int t = id >> 2, h = id & 3;
        const float o0 = ORAW[(size_t)t * 512 + h * 128 + lane], o1 = ORAW[(size_t)t * 512 + h * 128 + 64 + lane];
        const float rstd = rsqrtf(wave_sum(o0 * o0 + o1 * o1) * (1.f / 128.f) + 1e-6f);
        const float z0 = bf2f(P[(size_t)t * NPJ + PJ_DZ + h * 128 + lane]), z1 = bf2f(P[(size_t)t * NPJ + PJ_DZ + h * 128 + 64 + lane]);
        OA[(size_t)t * 512 + h * 128 + lane] = f2bf(o0 * rstd * g0 * siluf(z0)); OA[(size_t)t * 512 + h * 128 + 64 + lane] = f2bf(o1 * rstd * g1 * siluf(z1)); }
}

DI void ph6(const Args& a) {
    const int tid = threadIdx.x, lane = tid & 63, wave = tid >> 6, G = gridDim.x, lr = lane & 15, lq = lane >> 4;
    const bf16_t* OA = (const bf16_t*)(a.ws + WS_OA); const bf16_t* OB = (const bf16_t*)(a.ws + WS_OB);
    const bf16_t* WA = (const bf16_t*)(a.ws + WS_WOAT); const bf16_t* WB = (const bf16_t*)(a.ws + WS_WOBT);
    const bf16_t* P = (const bf16_t*)(a.ws + WS_PROJ); bf16_t* MR = (bf16_t*)(a.ws + WS_MRG);
    for (int u = blockIdx.x; u < 128 * 4; u += G) {
        const int rt = u >> 2, ct = u & 3, m0 = rt * 128 + (wave >> 2) * 64, n0 = ct * 256 + (wave & 3) * 64;
        const bf16_t* ap[4]; const bf16_t* bp[4];
        f32x4 ya[4][4], yb[4][4]; zero_acc<4>(ya); zero_acc<4>(yb);
#pragma unroll
        for (int i = 0; i < 4; ++i) { ap[i] = OA + (size_t)(m0 + 16 * i + lr) * 512 + lq * 8; bp[i] = WA + (size_t)(n0 + 16 * i + lr) * 512 + lq * 8; }
        wave_gemm<4>(ap, bp, 512, ya);
#pragma unroll
        for (int i = 0; i < 4; ++i) { ap[i] = OB + (size_t)(m0 + 16 * i + lr) * 512 + lq * 8; bp[i] = WB + (size_t)(n0 + 16 * i + lr) * 512 + lq * 8; }
        wave_gemm<4>(ap, bp, 512, yb);
#pragma unroll
        for (int i = 0; i < 4; ++i)
#pragma unroll
            for (int j = 0; j < 4; ++j)
#pragma unroll
                for (int r = 0; r < 4; ++r) { const size_t row = m0 + 16 * i + lq * 4 + r; const int col = n0 + 16 * j + lr;
                    const float ga = bf2f(P[row * NPJ + PJ_GA + col]), gb = bf2f(P[row * NPJ + PJ_GB + col]);
                    MR[row * DM + col] = f2bf(sigm(ga) * ya[i][j][r] + sigm(gb) * yb[i][j][r]); }
    }
}

DI void ph7(const Args& a) {
    const int tid = threadIdx.x, lane = tid & 63, wave = tid >> 6, G = gridDim.x, lr = lane & 15, lq = lane >> 4;
    const bf16_t* MR = (const bf16_t*)(a.ws + WS_MRG); const bf16_t* WO = (const bf16_t*)(a.ws + WS_WOUTT);
    const float* mod = (const float*)(a.ws + WS_MOD); float* X1 = (float*)(a.ws + WS_X1); const float* x = a.in[I_X];
    for (int u = blockIdx.x; u < 128 * 4; u += G) {
        const int rt = u >> 2, ct = u & 3, m0 = rt * 128 + (wave >> 2) * 64, n0 = ct * 256 + (wave & 3) * 64;
        const bf16_t* ap[4]; const bf16_t* bp[4];
#pragma unroll
        for (int i = 0; i < 4; ++i) { ap[i] = MR + (size_t)(m0 + 16 * i + lr) * DM + lq * 8; bp[i] = WO + (size_t)(n0 + 16 * i + lr) * DM + lq * 8; }
        f32x4 acc[4][4]; zero_acc<4>(acc);
        wave_gemm<4>(ap, bp, DM, acc);
#pragma unroll
        for (int j = 0; j < 4; ++j) { const int col = n0 + 16 * j + lr; const float gt = mod[2048 + col];
#pragma unroll
            for (int i = 0; i < 4; ++i)
#pragma unroll
                for (int r = 0; r < 4; ++r) { const size_t row = m0 + 16 * i + lq * 4 + r; X1[row * DM + col] = x[row * DM + col] + gt * acc[i][j][r]; } }
    }
}

DI void ph8(const Args& a, float* lds) {
    const int tid = threadIdx.x, lane = tid & 63, wave = tid >> 6, G = gridDim.x;
    float* A2 = lds; float* B2 = lds + 1024; float* hs = lds + 2048 + wave * 1024;
    const float* mod = (const float*)(a.ws + WS_MOD);
    for (int k = tid; k < DM; k += NTHREADS) { A2[k] = a.in[I_G2][k] * (1.f + mod[4096 + k]); B2[k] = mod[3072 + k]; }
    __syncthreads();
    const float* X1 = (const float*)(a.ws + WS_X1); bf16_t* H2 = (bf16_t*)(a.ws + WS_H2);
    int* TOKE = (int*)(a.ws + WS_TOKE); int* TOKS = (int*)(a.ws + WS_TOKS); float* TOKG = (float*)(a.ws + WS_TOKG); unsigned* CNT = (unsigned*)(a.ws + WS_CNT);
    const float* wr = a.in[I_WR]; const int e = lane & 31, half = lane >> 5; const float br = a.in[I_BR][e];
    for (int t = blockIdx.x * NWAVES + wave; t < SEQ; t += G * NWAVES) {
        const float* xr = X1 + (size_t)t * DM;
        f32x4 v[4]; float ss = 0.f;
#pragma unroll
        for (int i = 0; i < 4; ++i) { v[i] = *(const f32x4*)(xr + lane * 4 + 256 * i); ss += v[i][0] * v[i][0] + v[i][1] * v[i][1] + v[i][2] * v[i][2] + v[i][3] * v[i][3]; }
        ss = wave_sum(ss);
        const float rstd = rsqrtf(ss * (1.f / DM) + 1e-6f);
        __builtin_amdgcn_wave_barrier();
#pragma unroll
        for (int i = 0; i < 4; ++i) { const int k = lane * 4 + 256 * i;
#pragma unroll
            for (int q = 0; q < 4; ++q) { v[i][q] = v[i][q] * rstd * A2[k + q] + B2[k + q]; hs[k + q] = v[i][q]; }
            u32x2 w; w.x = pk2(v[i][0], v[i][1]); w.y = pk2(v[i][2], v[i][3]);
            *(u32x2*)(H2 + (size_t)t * DM + k) = w; }
        asm volatile("s_waitcnt lgkmcnt(0)" ::: "memory");
        __builtin_amdgcn_wave_barrier();
        float lg = 0.f;
        for (int k = half * 512; k < half * 512 + 512; ++k) lg += hs[k] * wr[(size_t)k * NE + e];
        lg += __shfl_xor(lg, 32);
        lg += br;
        asm volatile("s_waitcnt lgkmcnt(0)" ::: "memory");
        __builtin_amdgcn_wave_barrier();
        float cur = lg;
#define TOP1(TV, TI) float TV = cur; int TI = e; for (int o_ = 1; o_ <= 16; o_ <<= 1) { const float ov = __shfl_xor(TV, o_); const int oi = __shfl_xor(TI, o_); if (ov > TV || (ov == TV && oi < TI)) { TV = ov; TI = oi; } } if (e == TI) cur = -__builtin_inff();
        TOP1(tv0, ti0) TOP1(tv1, ti1) TOP1(tv2, ti2) TOP1(tv3, ti3)
#undef TOP1
        const float ex0 = 1.f, ex1 = expf(tv1 - tv0), ex2 = expf(tv2 - tv0), ex3 = expf(tv3 - tv0), den = ex0 + ex1 + ex2 + ex3;
        if (lane < 4) { int ee = ti0; float gg = ex0;
            if (lane == 1) { ee = ti1; gg = ex1; } if (lane == 2) { ee = ti2; gg = ex2; } if (lane == 3) { ee = ti3; gg = ex3; }
            const unsigned slot = atomicAdd(&CNT[ee], 1u);
            TOKE[t * 4 + lane] = ee; TOKS[t * 4 + lane] = (int)slot; TOKG[t * 4 + lane] = gg / den; }
    }
}

DI void pad_starts(const Args& a, int* ps) {
    if (threadIdx.x == 0) { const unsigned* CNT = (const unsigned*)(a.ws + WS_CNT); int s = 0; for (int e = 0; e < NE; ++e) { ps[e] = s; s += (int)((CNT[e] + 255u) / 256u) * 256; } ps[NE] = s; }
    __syncthreads();
}
DI void ph9(const Args& a, float* lds) {
    int* ps = (int*)lds; pad_starts(a, ps);
    const int lane = threadIdx.x & 63, wave = threadIdx.x >> 6, NW = gridDim.x * NWAVES;
    const int* TOKE = (const int*)(a.ws + WS_TOKE); const int* TOKS = (const int*)(a.ws + WS_TOKS);
    const bf16_t* H2 = (const bf16_t*)(a.ws + WS_H2); bf16_t* XG = (bf16_t*)(a.ws + WS_XG);
    for (int id = blockIdx.x * NWAVES + wave; id < SEQ * 4; id += NW) { const int t = id >> 2;
        const size_t row = (size_t)ps[TOKE[id]] + TOKS[id];
        const u32x4 v0 = *(const u32x4*)(H2 + (size_t)t * DM + lane * 8), v1 = *(const u32x4*)(H2 + (size_t)t * DM + 512 + lane * 8);
        *(u32x4*)(XG + row * DM + lane * 8) = v0; *(u32x4*)(XG + row * DM + 512 + lane * 8) = v1; }
}
DI int expert_of(const int* ps, int row0) { int e = 0; for (int i = 1; i < NE; ++i) if (row0 >= ps[i]) e = i; return e; }
DI void ph10(const Args& a, float* lds) {
    int* ps = (int*)lds; pad_starts(a, ps);
    const int tid = threadIdx.x, lane = tid & 63, wave = tid >> 6, G = gridDim.x, lr = lane & 15, lq = lane >> 4;
    const bf16_t* XG = (const bf16_t*)(a.ws + WS_XG); const bf16_t* WG = (const bf16_t*)(a.ws + WS_WGUT); bf16_t* ACT = (bf16_t*)(a.ws + WS_ACT);
    const int nrt = ps[NE] / 128;
    for (int u = blockIdx.x; u < nrt * 8; u += G) {
        const int rt = u >> 3, ct = u & 7, e = expert_of(ps, rt * 128), m0 = rt * 128 + (wave >> 2) * 64, n0 = ct * 256 + (wave & 3) * 64;
        const bf16_t* ap[4]; const bf16_t* bp[4];
#pragma unroll
        for (int i = 0; i < 4; ++i) { ap[i] = XG + (size_t)(m0 + 16 * i + lr) * DM + lq * 8; bp[i] = WG + ((size_t)e * 2048 + n0 + 16 * i + lr) * DM + lq * 8; }
        f32x4 acc[4][4]; zero_acc<4>(acc);
        wave_gemm<4>(ap, bp, DM, acc);
        const float* bgu = a.in[I_BGU] + (size_t)e * 2048;
#pragma unroll
        for (int j = 0; j < 2; ++j) { const int acol = 32 * (n0 >> 6) + 16 * j + lr; const float bg = bgu[acol], bu = bgu[1024 + acol];
#pragma unroll
            for (int i = 0; i < 4; ++i)
#pragma unroll
                for (int r = 0; r < 4; ++r) { float g = acc[i][j][r] + bg, up = acc[i][j + 2][r] + bu;
                    g = fminf(g, 7.f); up = fminf(fmaxf(up, -7.f), 7.f);
                    ACT[(size_t)(m0 + 16 * i + lq * 4 + r) * DM + acol] = f2bf((up + 1.f) * (g * sigm(1.702f * g))); } }
    }
}
DI void ph11(const Args& a, float* lds) {
    int* ps = (int*)lds; pad_starts(a, ps);
    const int tid = threadIdx.x, lane = tid & 63, wave = tid >> 6, G = gridDim.x, lr = lane & 15, lq = lane >> 4;
    const bf16_t* ACT = (const bf16_t*)(a.ws + WS_ACT); const bf16_t* WD = (const bf16_t*)(a.ws + WS_WDT); bf16_t* YB = (bf16_t*)(a.ws + WS_YB);
    const int nrt = ps[NE] / 128;
    for (int u = blockIdx.x; u < nrt * 4; u += G) {
        const int rt = u >> 2, ct = u & 3, e = expert_of(ps, rt * 128), m0 = rt * 128 + (wave >> 2) * 64, n0 = ct * 256 + (wave & 3) * 64;
        const bf16_t* ap[4]; const bf16_t* bp[4];
#pragma unroll
        for (int i = 0; i < 4; ++i) { ap[i] = ACT + (size_t)(m0 + 16 * i + lr) * DM + lq * 8; bp[i] = WD + ((size_t)e * DM + n0 + 16 * i + lr) * DM + lq * 8; }
        f32x4 acc[4][4]; zero_acc<4>(acc);
        wave_gemm<4>(ap, bp, DM, acc);
        const float* bd = a.in[I_BD] + (size_t)e * DM;
#pragma unroll
        for (int j = 0; j < 4; ++j) { const int col = n0 + 16 * j + lr; const float b = bd[col];
#pragma unroll
            for (int i = 0; i < 4; ++i)
#pragma unroll
                for (int r = 0; r < 4; ++r) YB[(size_t)(m0 + 16 * i + lq * 4 + r) * DM + col] = f2bf(acc[i][j][r] + b); }
    }
}
DI void ph12(const Args& a, float* lds) {
    int* ps = (int*)lds; pad_starts(a, ps);
    const int lane = threadIdx.x & 63, wave = threadIdx.x >> 6, G = gridDim.x;
    const float* X1 = (const float*)(a.ws + WS_X1); const bf16_t* YB = (const bf16_t*)(a.ws + WS_YB); const float* mod = (const float*)(a.ws + WS_MOD);
    const int* TOKE = (const int*)(a.ws + WS_TOKE); const int* TOKS = (const int*)(a.ws + WS_TOKS); const float* TOKG = (const float*)(a.ws + WS_TOKG);
    for (int t = blockIdx.x * NWAVES + wave; t < SEQ; t += G * NWAVES) {
        size_t rows[4]; float gk[4];
#pragma unroll
        for (int q = 0; q < 4; ++q) { rows[q] = (size_t)ps[TOKE[t * 4 + q]] + TOKS[t * 4 + q]; gk[q] = TOKG[t * 4 + q]; }
        f32x4 v[4]; float ss = 0.f;
#pragma unroll
        for (int i = 0; i < 4; ++i) { const int k = lane * 4 + 256 * i; v[i] = *(const f32x4*)(X1 + (size_t)t * DM + k);
            f32x4 y = (f32x4){0.f, 0.f, 0.f, 0.f};
#pragma unroll
            for (int q = 0; q < 4; ++q) { const u32x2 w = *(const u32x2*)(YB + rows[q] * DM + k);
                y[0] += gk[q] * __uint_as_float(w.x << 16); y[1] += gk[q] * __uint_as_float(w.x & 0xffff0000u); y[2] += gk[q] * __uint_as_float(w.y << 16); y[3] += gk[q] * __uint_as_float(w.y & 0xffff0000u); }
#pragma unroll
            for (int q = 0; q < 4; ++q) { v[i][q] += mod[5120 + k + q] * y[q]; ss += v[i][q] * v[i][q]; } }
        ss = wave_sum(ss);
        const float rstd = rsqrtf(ss * (1.f / DM) + 1e-6f);
#pragma unroll
        for (int i = 0; i < 4; ++i) { const int k = lane * 4 + 256 * i; f32x4 o;
#pragma unroll
            for (int q = 0; q < 4; ++q) o[q] = v[i][q] * rstd * a.in[I_GF][k + q];
            *(f32x4*)(a.out + (size_t)t * DM + k) = o; }
    }
}

__global__ void __launch_bounds__(NTHREADS, 2) hybrid_fwd(Args a) {
    extern __shared__ __attribute__((aligned(16))) unsigned char lds_raw[];
    float* lds = (float*)(lds_raw + 16);
    LAS unsigned* xbw = (LAS unsigned*)lds_raw;
    if (threadIdx.x == 0) { xbw[0] = 0u; xbw[1] = 0u; xbw[2] = 0u; xbw[3] = 0u; }
    __syncthreads();
    XcdBarrier bar; bar.bar = (unsigned*)(a.ws + WS_BAR); bar.x = 0; bar.st = (volatile LAS unsigned*)xbw;
    const int lo = a.ph_lo, hi = a.ph_hi;
    if (hi - lo > 1) bar = xcd_barrier_post((unsigned*)(a.ws + WS_BAR), (volatile LAS unsigned*)xbw);
#define IN(k) (lo <= (k) && (k) < hi)
#define SEAM(k) do { if (IN(k) && IN((k) + 1)) xcd_barrier(bar); } while (0)
    if (IN(0)) ph0(a, lds);
    SEAM(0);
    if (IN(1)) ph1(a, lds);
    SEAM(1);
    if (IN(2)) ph2(a);
    SEAM(2);
    if (IN(3)) ph3(a, lds);
    SEAM(3);
    if (IN(4)) ph4(a, lds);
    SEAM(4);
    if (IN(5)) ph5(a);
    SEAM(5);
    if (IN(6)) ph6(a);
    SEAM(6);
    if (IN(7)) ph7(a);
    SEAM(7);
    if (IN(8)) ph8(a, lds);
    SEAM(8);
    if (IN(9)) ph9(a, lds);
    SEAM(9);
    if (IN(10)) ph10(a, lds);
    SEAM(10);
    if (IN(11)) ph11(a, lds);
    SEAM(11);
    if (IN(12)) ph12(a, lds);
#undef IN
#undef SEAM
}

extern "C" void kernel_launch(void* const* d_in, const int* in_sizes, int n_in, void* d_out, int out_size, void* d_ws, size_t ws_size, hipStream_t stream) {
    static int grid = 0;
    if (grid == 0) {
        if (n_in != 22 || out_size != SEQ * DM || ws_size < WS_END) { fprintf(stderr, "kernel_launch: unexpected shapes (n_in %d out %d ws %zu, need %zu)\n", n_in, out_size, ws_size, (size_t)WS_END); grid = -1; return; }
        int dev = 0, cus = 0, per_cu = 0;
        if (hipGetDevice(&dev) != hipSuccess || hipDeviceGetAttribute(&cus, hipDeviceAttributeMultiprocessorCount, dev) != hipSuccess) { grid = -1; return; }
        if (hipFuncSetAttribute((const void*)hybrid_fwd, hipFuncAttributeMaxDynamicSharedMemorySize, LDS_BYTES) != hipSuccess) { fprintf(stderr, "kernel_launch: hipFuncSetAttribute failed\n"); grid = -1; return; }
        if (hipOccupancyMaxActiveBlocksPerMultiprocessor(&per_cu, (const void*)hybrid_fwd, NTHREADS, LDS_BYTES) != hipSuccess || per_cu < 1) { fprintf(stderr, "kernel_launch: occupancy query says %d\n", per_cu); }
        (void)hipGetLastError();
        grid = cus;
    }
    if (grid < 0) return;
    (void)hipMemsetAsync(d_ws, 0, CTL_ZERO, stream);
    Args a{};
    for (int i = 0; i < 22; ++i) a.in[i] = (const float*)d_in[i];
    a.out = (float*)d_out; a.ws = (unsigned char*)d_ws;
#if N_LAUNCHES == 1
    a.ph_lo = 0; a.ph_hi = NPHASES;
    hipLaunchKernelGGL(hybrid_fwd, dim3(grid), dim3(NTHREADS), LDS_BYTES, stream, a);
#else
    for (int p = 0; p < NPHASES; ++p) { a.ph_lo = p; a.ph_hi = p + 1; hipLaunchKernelGGL(hybrid_fwd, dim3(grid), dim3(NTHREADS), LDS_BYTES, stream, a); }
#endif
}
```

```cpp
#include <hip/hip_runtime.h>
#include <stdint.h>
#include <stdio.h>

#ifndef N_LAUNCHES
#define N_LAUNCHES 1
#endif

#define DI __device__ __forceinline__
#define LAS __attribute__((address_space(3)))
typedef unsigned short bf16_t;
typedef short bf16x8 __attribute__((ext_vector_type(8)));
typedef float f32x4 __attribute__((ext_vector_type(4)));
typedef unsigned u32x4 __attribute__((ext_vector_type(4)));
typedef unsigned u32x2 __attribute__((ext_vector_type(2)));

constexpr int SEQ = 16384, DM = 1024, NIN = 5644, NPJ = 5632, NE = 32, TOPK = 4;
constexpr int NH = 4, HD = 128, CH = 64, NCH = SEQ / CH;
constexpr int PJ_DQ = 0, PJ_DK = 512, PJ_DV = 1024, PJ_DZ = 1536, PJ_FQ = 2048, PJ_FK = 2560, PJ_FV = 3072, PJ_GA = 3584, PJ_GB = 4608;
constexpr int NTHREADS = 512, NWAVES = 8;
constexpr int LDS_BYTES = 152 * 1024;
constexpr int NPHASES = 13;

constexpr size_t MiB = 1u << 20;
constexpr size_t WS_BAR = 0;
constexpr size_t WS_CNT = 32768;
constexpr size_t CTL_ZERO = 65536;
constexpr size_t WS_MOD = 65536;
constexpr size_t WS_F = WS_MOD + 32768;
constexpr size_t WS_EG = WS_F + 262144;
constexpr size_t WS_TOKE = WS_EG + 4096;
constexpr size_t WS_TOKS = WS_TOKE + 262144;
constexpr size_t WS_TOKG = WS_TOKS + 262144;
constexpr size_t WS_SP = WS_TOKG + 262144;
constexpr size_t WS_WINT = WS_SP + MiB;
constexpr size_t WS_WOAT = WS_WINT + (size_t)NPJ * DM * 2;
constexpr size_t WS_WOBT = WS_WOAT + MiB;
constexpr size_t WS_WOUTT = WS_WOBT + MiB;
constexpr size_t WS_WGUT = WS_WOUTT + 2 * MiB;
constexpr size_t WS_WDT = WS_WGUT + 128 * MiB;
constexpr size_t WS_X1 = WS_WDT + 64 * MiB;
constexpr size_t WS_H2 = WS_X1 + 64 * MiB;
constexpr size_t WS_MRG = WS_H2 + 32 * MiB;
constexpr size_t WS_RA = WS_MRG + 32 * MiB;
constexpr size_t WS_RB = WS_RA + 176 * MiB;
constexpr size_t WS_H = WS_RB;
constexpr size_t WS_DNW = WS_H + 32 * MiB;
constexpr size_t WS_DNU = WS_DNW + 16 * MiB;
constexpr size_t WS_DNQD = WS_DNU + 16 * MiB;
constexpr size_t WS_DNKD = WS_DNQD + 16 * MiB;
constexpr size_t WS_DNATT = WS_DNKD + 16 * MiB;
constexpr size_t WS_ORAW = WS_DNATT + 8 * MiB;
constexpr size_t WS_OA = WS_ORAW + 32 * MiB;
constexpr size_t WS_OB = WS_OA + 16 * MiB;
constexpr size_t WS_VT = WS_OB + 16 * MiB;
constexpr size_t WS_END = WS_RB + 184 * MiB;
constexpr size_t WS_XG = WS_RA, WS_YB = WS_RA, WS_ACT = WS_RB, WS_PROJ = WS_RA;
static_assert(WS_VT + 16 * MiB <= WS_END, "region B");

struct Args { const float* in[22]; float* out; unsigned char* ws; int ph_lo, ph_hi; };
enum { I_X = 0, I_C, I_WADA, I_BADA, I_G1, I_WIN, I_CONVW, I_ALOG, I_DTB, I_GON, I_BFG, I_WOD, I_WOF, I_WOUT, I_G2, I_WR, I_BR, I_WGU, I_BGU, I_WD, I_BD, I_GF };

DI float bf2f(bf16_t v) { return __uint_as_float(((unsigned)v) << 16); }
DI bf16_t f2bf(float f) { unsigned u = __float_as_uint(f); u += 0x7fffu + ((u >> 16) & 1u); return (bf16_t)(u >> 16); }
DI unsigned pk2(float lo, float hi) { return (unsigned)f2bf(lo) | ((unsigned)f2bf(hi) << 16); }
DI float sigm(float x) { return 1.f / (1.f + expf(-x)); }
DI float siluf(float x) { return x / (1.f + expf(-x)); }
DI float softplusf(float x) { return fmaxf(x, 0.f) + log1pf(expf(-fabsf(x))); }
DI float logsigf(float x) { return fminf(x, 0.f) - log1pf(expf(-fabsf(x))); }
DI float wave_sum(float v) { for (int o = 32; o >= 1; o >>= 1) v += __shfl_xor(v, o); return v; }
#define MFMA16(a, b, c) __builtin_amdgcn_mfma_f32_16x16x32_bf16((a), (b), (c), 0, 0, 0)

DI int gu_src(int n) { const int g = n >> 6, r = n & 63; return r < 32 ? 32 * g + r : 1024 + 32 * g + (r - 32); }

#define XB_TMO      128
#define XB_XCNT(j)  (256  + 64 * (j))
#define XB_XSUB(j)  (1280 + 64 * (j))
#define XB_XGEN(j)  (2304 + 64 * (j))
#define XB_TOP      3328
#define XB_TOPGEN   3392
#define XCD_BAR_WORDS 3456
#define XB_SPIN_CAP (1u << 22)
DI unsigned xb_ld(unsigned* p)              { return __hip_atomic_load(p, __ATOMIC_RELAXED, __HIP_MEMORY_SCOPE_AGENT); }
DI unsigned xb_add(unsigned* p, unsigned v) { return __hip_atomic_fetch_add(p, v, __ATOMIC_RELAXED, __HIP_MEMORY_SCOPE_AGENT); }
DI unsigned xb_xcc_id() { return (unsigned)__builtin_amdgcn_s_getreg((3 << 11) | 20) & 0xFu; }
#define XB_SPIN(cond, bar) do { unsigned _sp = 0; while (cond) { __builtin_amdgcn_s_sleep(1); \
    if ((++_sp & 255u) == 0u) { if (xb_ld(&(bar)[XB_TMO])) break; if (_sp > XB_SPIN_CAP) { atomicAdd(&(bar)[XB_TMO], 1u); break; } } } } while (0)
struct XcdBarrier { unsigned* bar; unsigned x; volatile LAS unsigned* st; };
DI XcdBarrier xcd_barrier_post(unsigned* bar, volatile LAS unsigned* st) {
    XcdBarrier b; b.bar = bar; b.x = xb_xcc_id(); b.st = st;
    if (threadIdx.x == 0) (void)xb_add(&bar[XB_XCNT(b.x)], 1u);
    return b;
}
DI void xcd_barrier_complete(unsigned* bar, unsigned x, unsigned& nloc, unsigned& nx) {
    const unsigned G = gridDim.x * gridDim.y * gridDim.z;
    unsigned sum, cnt, mine, sp = 0u;
    for (;;) {
        sum = 0u; cnt = 0u; mine = 0u;
#pragma unroll
        for (unsigned j = 0; j < 16; ++j) { const unsigned c = xb_ld(&bar[XB_XCNT(j)]); sum += c; cnt += (c > 0u) ? 1u : 0u; mine = (j == x) ? c : mine; }
        if (sum == G) break;
        __builtin_amdgcn_s_sleep(1);
        if ((++sp & 255u) == 0u) { if (xb_ld(&bar[XB_TMO])) break; if (sp > XB_SPIN_CAP) { atomicAdd(&bar[XB_TMO], 1u); break; } }
    }
    nloc = mine > 0u ? mine : 1u; nx = cnt > 0u ? cnt : 1u;
}
DI void xcd_barrier(const XcdBarrier& b) {
    asm volatile("s_waitcnt vmcnt(0)" ::: "memory");
    __syncthreads();
    if (threadIdx.x == 0) {
        unsigned* bar = b.bar;
        __builtin_amdgcn_s_waitcnt(0);
        unsigned nloc = b.st[0], nx = b.st[1];
        if (nloc == 0u) { xcd_barrier_complete(bar, b.x, nloc, nx); b.st[0] = nloc; b.st[1] = nx; }
        const unsigned old = xb_add(&bar[XB_XSUB(b.x)], 1u);
        const unsigned gen = old / nloc;
        if (old + 1u == (gen + 1u) * nloc) {
            __builtin_amdgcn_fence(__ATOMIC_RELEASE, "agent");
            asm volatile("s_waitcnt vmcnt(0)" ::: "memory");
            const unsigned og = xb_add(&bar[XB_TOP], 1u);
            const unsigned tg = og / nx;
            if (og + 1u == (tg + 1u) * nx) xb_add(&bar[XB_TOPGEN], 1u);
            else XB_SPIN(xb_ld(&bar[XB_TOPGEN]) == tg, bar);
            __builtin_amdgcn_fence(__ATOMIC_ACQUIRE, "agent");
            xb_add(&bar[XB_XGEN(b.x)], 1u);
            asm volatile("s_waitcnt vmcnt(0)" ::: "memory");
        } else {
            XB_SPIN(xb_ld(&bar[XB_XGEN(b.x)]) == gen, bar);
            __builtin_amdgcn_fence(__ATOMIC_ACQUIRE, "agent");
            asm volatile("s_waitcnt vmcnt(0)" ::: "memory");
        }
    }
    __syncthreads();
}

template <int NT>
DI void wave_gemm(const bf16_t* const (&ap)[4], const bf16_t* const (&bp)[NT], int K, f32x4 (&acc)[4][NT]) {
    for (int k0 = 0; k0 < K; k0 += 32) {
        bf16x8 a[4], b[NT];
#pragma unroll
        for (int i = 0; i < 4; ++i) a[i] = *(const bf16x8*)(ap[i] + k0);
#pragma unroll
        for (int j = 0; j < NT; ++j) b[j] = *(const bf16x8*)(bp[j] + k0);
#pragma unroll
        for (int i = 0; i < 4; ++i)
#pragma unroll
            for (int j = 0; j < NT; ++j) acc[i][j] = MFMA16(a[i], b[j], acc[i][j]);
    }
}
template <int NT> DI void zero_acc(f32x4 (&acc)[4][NT]) {
#pragma unroll
    for (int i = 0; i < 4; ++i)
#pragma unroll
        for (int j = 0; j < NT; ++j) acc[i][j] = (f32x4){0.f, 0.f, 0.f, 0.f};
}

DI void transpose_tile(float* tile, const float* src, int ld, int k0, int c0, int c1, bf16_t* dst, int Kd) {
    const int tid = threadIdx.x;
    __syncthreads();
#pragma unroll
    for (int i = 0; i < 8; ++i) { const int kk = (tid >> 6) + 8 * i, nn = tid & 63; const int col = nn < 32 ? c0 + nn : c1 + nn - 32; tile[kk * 65 + nn] = src[(size_t)(k0 + kk) * ld + col]; }
    __syncthreads();
    const int nn = tid >> 3, kc = (tid & 7) * 8;
    u32x4 w;
    w.x = pk2(tile[(kc + 0) * 65 + nn], tile[(kc + 1) * 65 + nn]); w.y = pk2(tile[(kc + 2) * 65 + nn], tile[(kc + 3) * 65 + nn]);
    w.z = pk2(tile[(kc + 4) * 65 + nn], tile[(kc + 5) * 65 + nn]); w.w = pk2(tile[(kc + 6) * 65 + nn], tile[(kc + 7) * 65 + nn]);
    *(u32x4*)(dst + (size_t)nn * Kd + k0 + kc) = w;
}
DI void ph0(const Args& a, float* lds) {
    const int tid = threadIdx.x, G = gridDim.x, bx = blockIdx.x;
    unsigned char* ws = a.ws;
    if (bx < 12) {
        const int j = bx * 512 + tid; const float* c = a.in[I_C]; const float* w = a.in[I_WADA];
        float acc = a.in[I_BADA][j];
        for (int k = 0; k < DM; ++k) acc += c[k] * w[(size_t)k * 6144 + j];
        ((float*)(ws + WS_MOD))[j] = acc;
    }
    constexpr int T_WIN = 88 * 16, T_WOA = 16 * 8, T_WOUT = 16 * 16, T_WGU = 32 * 32 * 16, T_WD = 32 * 16 * 16;
    constexpr int NT = T_WIN + 2 * T_WOA + T_WOUT + T_WGU + T_WD;
    for (int t = bx; t < NT; t += G) {
        int r = t;
        if (r < T_WIN) { const int nt = r / 16, kt = r % 16, n0 = nt * 64; const int c0 = n0 + (n0 >= 3584 ? 12 : (n0 >= 2048 ? 8 : 0));
            transpose_tile(lds, a.in[I_WIN], NIN, kt * 64, c0, c0 + 32, (bf16_t*)(ws + WS_WINT) + (size_t)n0 * DM, DM); continue; }
        r -= T_WIN;
        if (r < T_WOA) { const int nt = r / 8, kt = r % 8, n0 = nt * 64; transpose_tile(lds, a.in[I_WOD], DM, kt * 64, n0, n0 + 32, (bf16_t*)(ws + WS_WOAT) + (size_t)n0 * 512, 512); continue; }
        r -= T_WOA;
        if (r < T_WOA) { const int nt = r / 8, kt = r % 8, n0 = nt * 64; transpose_tile(lds, a.in[I_WOF], DM, kt * 64, n0, n0 + 32, (bf16_t*)(ws + WS_WOBT) + (size_t)n0 * 512, 512); continue; }
        r -= T_WOA;
        if (r < T_WOUT) { const int nt = r / 16, kt = r % 16, n0 = nt * 64; transpose_tile(lds, a.in[I_WOUT], DM, kt * 64, n0, n0 + 32, (bf16_t*)(ws + WS_WOUTT) + (size_t)n0 * DM, DM); continue; }
        r -= T_WOUT;
        if (r < T_WGU) { const int e = r / 512, q = r % 512, nt = q / 16, kt = q % 16, n0 = nt * 64;
            transpose_tile(lds, a.in[I_WGU] + (size_t)e * DM * 2048, 2048, kt * 64, gu_src(n0), gu_src(n0 + 32), (bf16_t*)(ws + WS_WGUT) + ((size_t)e * 2048 + n0) * DM, DM); continue; }
        r -= T_WGU;
        { const int e = r / 256, q = r % 256, nt = q / 16, kt = q % 16, n0 = nt * 64;
            transpose_tile(lds, a.in[I_WD] + (size_t)e * DM * DM, DM, kt * 64, n0, n0 + 32, (bf16_t*)(ws + WS_WDT) + ((size_t)e * DM + n0) * DM, DM); }
    }
}

DI void ph1(const Args& a, float* lds) {
    const int tid = threadIdx.x, lane = tid & 63, wave = tid >> 6, G = gridDim.x;
    float* A1 = lds; float* B1 = lds + 1024; float* wsm = lds + 2048;
    const float* mod = (const float*)(a.ws + WS_MOD);
    for (int k = tid; k < DM; k += NTHREADS) { A1[k] = a.in[I_G1][k] * (1.f + mod[1024 + k]); B1[k] = mod[k]; }
    for (int i = tid; i < 12 * DM; i += NTHREADS) { const int k = i / 12, j = i % 12; wsm[j * DM + k] = a.in[I_WIN][(size_t)k * NIN + (j < 8 ? 2048 + j : 3592 + (j - 8))]; }
    __syncthreads();
    bf16_t* H = (bf16_t*)(a.ws + WS_H); float* SP = (float*)(a.ws + WS_SP);
    for (int t = blockIdx.x * NWAVES + wave; t < SEQ; t += G * NWAVES) {
        const float* xr = a.in[I_X] + (size_t)t * DM;
        f32x4 v[4]; float ss = 0.f;
#pragma unroll
        for (int i = 0; i < 4; ++i) { v[i] = *(const f32x4*)(xr + lane * 4 + 256 * i); ss += v[i][0] * v[i][0] + v[i][1] * v[i][1] + v[i][2] * v[i][2] + v[i][3] * v[i][3]; }
        ss = wave_sum(ss);
        const float rstd = rsqrtf(ss * (1.f / DM) + 1e-6f);
#pragma unroll
        for (int i = 0; i < 4; ++i) { const int k = lane * 4 + 256 * i;
#pragma unroll
            for (int e = 0; e < 4; ++e) v[i][e] = v[i][e] * rstd * A1[k + e] + B1[k + e];
            u32x2 w; w.x = pk2(v[i][0], v[i][1]); w.y = pk2(v[i][2], v[i][3]);
            *(u32x2*)(H + (size_t)t * DM + k) = w; }
#pragma unroll 1
        for (int j = 0; j < 12; ++j) { float pj = 0.f;
#pragma unroll
            for (int i = 0; i < 4; ++i) { const f32x4 wv = *(const f32x4*)(wsm + j * DM + lane * 4 + 256 * i); pj += v[i][0] * wv[0] + v[i][1] * wv[1] + v[i][2] * wv[2] + v[i][3] * wv[3]; }
            const float s = wave_sum(pj); if (lane == j) SP[(size_t)t * 16 + j] = s; }
    }
}

DI void ph2(const Args& a) {
    const int tid = threadIdx.x, lane = tid & 63, wave = tid >> 6, G = gridDim.x, lr = lane & 15, lq = lane >> 4;
    const bf16_t* H = (const bf16_t*)(a.ws + WS_H); const bf16_t* Wt = (const bf16_t*)(a.ws + WS_WINT); bf16_t* P = (bf16_t*)(a.ws + WS_PROJ);
    for (int u = blockIdx.x; u < 128 * 22; u += G) {
        const int rt = u / 22, ct = u % 22, m0 = rt * 128 + (wave >> 2) * 64, n0 = ct * 256 + (wave & 3) * 64;
        const bf16_t* ap[4]; const bf16_t* bp[4];
#pragma unroll
        for (int i = 0; i < 4; ++i) { ap[i] = H + (size_t)(m0 + 16 * i + lr) * DM + lq * 8; bp[i] = Wt + (size_t)(n0 + 16 * i + lr) * DM + lq * 8; }
        f32x4 acc[4][4]; zero_acc<4>(acc);
        wave_gemm<4>(ap, bp, DM, acc);
#pragma unroll
        for (int i = 0; i < 4; ++i)
#pragma unroll
            for (int j = 0; j < 4; ++j)
#pragma unroll
                for (int r = 0; r < 4; ++r) P[(size_t)(m0 + 16 * i + lq * 4 + r) * NPJ + n0 + 16 * j + lr] = f2bf(acc[i][j][r]);
    }
}

DI void ph3_fcum(const Args& a, float* lds) {
    const int tid = threadIdx.x, h = blockIdx.x;
    const float* SP = (const float*)(a.ws + WS_SP); float* F = (float*)(a.ws + WS_F);
    const float bf = a.in[I_BFG][h];
    double* part = (double*)lds;
    double s = 0.0;
    for (int i = 0; i < 32; ++i) s += (double)logsigf(SP[(size_t)(tid * 32 + i) * 16 + 8 + h] + bf);
    part[tid] = s;
    __syncthreads();
    double off = 0.0;
    for (int i = 0; i < tid; ++i) off += part[i];
    for (int i = 0; i < 32; ++i) { off += (double)logsigf(SP[(size_t)(tid * 32 + i) * 16 + 8 + h] + bf); F[(size_t)h * SEQ + tid * 32 + i] = (float)off; }
    __syncthreads();
}
DI void ph3_prep(const Args& a, float* lds, int unit) {
    const int tid = threadIdx.x, lane = tid & 63, wave = tid >> 6;
    const int h = unit & 3, n = unit >> 2, t0 = n * CH;
    float* qs = lds; float* ks = qs + 64 * 129; float* vs = ks + 64 * 129;
    float* Ls = vs + 64 * 129; float* As = Ls + 64 * 65; float* Ts = As + 64 * 65;
    float* gcs = Ts + 64 * 65; float* bes = gcs + 64; float* gs = bes + 64;
    const float* SP = (const float*)(a.ws + WS_SP); const bf16_t* P = (const bf16_t*)(a.ws + WS_PROJ);
    __syncthreads();
    if (tid < 64) { const int t = t0 + tid;
        bes[tid] = sigm(SP[(size_t)t * 16 + h]);
        gs[tid] = -expf(a.in[I_ALOG][h]) * softplusf(SP[(size_t)t * 16 + 4 + h] + a.in[I_DTB][h]); }
    const float* cw = a.in[I_CONVW];
#pragma unroll 1
    for (int sec = 0; sec < 3; ++sec) {
        float* dst = sec == 0 ? qs : (sec == 1 ? ks : vs);
        const int d = tid & 127, col = sec * 512 + h * 128 + d;
        const float w0 = cw[0 * 1536 + col], w1 = cw[1 * 1536 + col], w2 = cw[2 * 1536 + col], w3 = cw[3 * 1536 + col];
        for (int i = 0; i < 16; ++i) { const int c = (tid >> 7) + 4 * i, t = t0 + c;
            float acc = w3 * bf2f(P[(size_t)t * NPJ + col]);
            if (t >= 1) acc += w2 * bf2f(P[(size_t)(t - 1) * NPJ + col]);
            if (t >= 2) acc += w1 * bf2f(P[(size_t)(t - 2) * NPJ + col]);
            if (t >= 3) acc += w0 * bf2f(P[(size_t)(t - 3) * NPJ + col]);
            dst[c * 129 + d] = siluf(acc); }
    }
    __syncthreads();
    if (tid == 0) { float s = 0.f; for (int c = 0; c < 64; ++c) { s += gs[c]; gcs[c] = s; } }
    for (int i = 0; i < 16; ++i) { const int r = wave * 16 + i; float* row = (r < 64 ? qs + r * 129 : ks + (r - 64) * 129);
        const float x0 = row[lane], x1 = row[lane + 64]; const float ss = wave_sum(x0 * x0 + x1 * x1);
        const float sc = rsqrtf(ss + 1e-6f) * (r < 64 ? 0.08838834764831845f : 1.f);
        row[lane] = x0 * sc; row[lane + 64] = x1 * sc; }
    __syncthreads();
    { const int m = tid & 63;
        for (int i = 0; i < 8; ++i) { const int c = (tid >> 6) + 8 * i; float kk = 0.f, qk = 0.f;
            for (int d = 0; d < 128; ++d) { const float km = ks[m * 129 + d]; kk += ks[c * 129 + d] * km; qk += qs[c * 129 + d] * km; }
            const float dec = (m <= c) ? expf(gcs[c] - gcs[m]) : 0.f;
            Ls[c * 65 + m] = (m < c) ? bes[c] * kk * dec : 0.f;
            As[c * 65 + m] = (m <= c) ? qk * dec : 0.f; } }
    __syncthreads();
    if (wave == 0) {
        for (int c = 0; c < 64; ++c) { float acc = (lane == c) ? 1.f : 0.f;
            for (int m = 0; m < c; ++m) acc -= Ls[c * 65 + m] * Ts[m * 65 + lane];
            Ts[c * 65 + lane] = acc;
            asm volatile("s_waitcnt lgkmcnt(0)" ::: "memory"); }
    }
    __syncthreads();
    bf16_t* W = (bf16_t*)(a.ws + WS_DNW) + (size_t)(h * NCH + n) * 64 * 128; bf16_t* U = (bf16_t*)(a.ws + WS_DNU) + (size_t)(h * NCH + n) * 64 * 128;
    bf16_t* QD = (bf16_t*)(a.ws + WS_DNQD) + (size_t)(h * NCH + n) * 64 * 128; bf16_t* KD = (bf16_t*)(a.ws + WS_DNKD) + (size_t)(h * NCH + n) * 64 * 128;
    bf16_t* AT = (bf16_t*)(a.ws + WS_DNATT) + (size_t)(h * NCH + n) * 64 * 64;
    { const int d = tid & 127; const float glast = gcs[63];
        for (int i = 0; i < 16; ++i) { const int c = (tid >> 7) + 4 * i; float uu = 0.f, ww = 0.f;
            for (int m = 0; m <= c; ++m) { const float tb = Ts[c * 65 + m] * bes[m]; uu += tb * vs[m * 129 + d]; ww += tb * expf(gcs[m]) * ks[m * 129 + d]; }
            U[c * 128 + d] = f2bf(uu); W[c * 128 + d] = f2bf(ww);
            QD[c * 128 + d] = f2bf(qs[c * 129 + d] * expf(gcs[c])); KD[c * 128 + d] = f2bf(ks[c * 129 + d] * expf(glast - gcs[c])); } }
    for (int i = tid; i < 64 * 64; i += NTHREADS) AT[i] = f2bf(As[(i >> 6) * 65 + (i & 63)]);
    if (tid == 0) ((float*)(a.ws + WS_EG))[h * NCH + n] = expf(gcs[63]);
}
DI void ph3_vt(const Args& a, float* lds, int unit) {
    const int tid = threadIdx.x; const int h = unit & 3, dh = (unit >> 2) & 1, tt = unit >> 3;
    const bf16_t* P = (const bf16_t*)(a.ws + WS_PROJ); bf16_t* VT = (bf16_t*)(a.ws + WS_VT);
    bf16_t* tile = (bf16_t*)lds;
    __syncthreads();
    for (int i = 0; i < 8; ++i) { const int t = (tid >> 6) + 8 * i, d = tid & 63; tile[t * 66 + d] = P[(size_t)(tt * 64 + t) * NPJ + PJ_FV + h * 128 + dh * 64 + d]; }
    __syncthreads();
    for (int i = 0; i < 8; ++i) { const int d = (tid >> 6) + 8 * i, t = tid & 63; VT[(size_t)(h * 128 + dh * 64 + d) * SEQ + tt * 64 + t] = tile[t * 66 + d]; }
}
DI void ph3(const Args& a, float* lds) {
    const int G = gridDim.x;
    if (blockIdx.x < 4) ph3_fcum(a, lds);
    for (int u = blockIdx.x; u < NH * NCH; u += G) ph3_prep(a, lds, u);
    for (int u = blockIdx.x; u < 4 * 2 * 256; u += G) ph3_vt(a, lds, u);
}

DI void ph4_scan(const Args& a, float* lds) {
    const int tid = threadIdx.x; const int h = blockIdx.x >> 3, vsl = blockIdx.x & 7;
    float* Sst = lds; float* wS = Sst + 128 * 17; float* kdS = wS + 64 * 129; float* qdS = kdS + 64 * 129; float* atS = qdS + 64 * 129; float* uS = atS + 64 * 65; float* vnS = uS + 64 * 17;
    for (int i = tid; i < 128 * 17; i += NTHREADS) Sst[i] = 0.f;
    float* ORAW = (float*)(a.ws + WS_ORAW);
    for (int n = 0; n < NCH; ++n) {
        const size_t cb = (size_t)(h * NCH + n);
        const bf16_t* W = (const bf16_t*)(a.ws + WS_DNW) + cb * 8192; const bf16_t* U = (const bf16_t*)(a.ws + WS_DNU) + cb * 8192;
        const bf16_t* QD = (const bf16_t*)(a.ws + WS_DNQD) + cb * 8192; const bf16_t* KD = (const bf16_t*)(a.ws + WS_DNKD) + cb * 8192;
        const bf16_t* AT = (const bf16_t*)(a.ws + WS_DNATT) + cb * 4096;
        const float eg = ((const float*)(a.ws + WS_EG))[cb];
        __syncthreads();
        for (int i = tid; i < 8192; i += NTHREADS) { const int c = i >> 7, d = i & 127; wS[c * 129 + d] = bf2f(W[i]); kdS[c * 129 + d] = bf2f(KD[i]); qdS[c * 129 + d] = bf2f(QD[i]); }
        for (int i = tid; i < 4096; i += NTHREADS) atS[(i >> 6) * 65 + (i & 63)] = bf2f(AT[i]);
        for (int i = tid; i < 1024; i += NTHREADS) uS[(i >> 4) * 17 + (i & 15)] = bf2f(U[(i >> 4) * 128 + vsl * 16 + (i & 15)]);
        __syncthreads();
        const int j = tid & 15;
        for (int i = 0; i < 2; ++i) { const int c = (tid >> 4) + 32 * i; float acc = uS[c * 17 + j];
            for (int k = 0; k < 128; ++k) acc -= wS[c * 129 + k] * Sst[k * 17 + j];
            vnS[c * 17 + j] = acc; }
        __syncthreads();
        for (int i = 0; i < 2; ++i) { const int c = (tid >> 4) + 32 * i; float acc = 0.f;
            for (int k = 0; k < 128; ++k) acc += qdS[c * 129 + k] * Sst[k * 17 + j];
            for (int m = 0; m <= c; ++m) acc += atS[c * 65 + m] * vnS[m * 17 + j];
            ORAW[(size_t)(n * CH + c) * 512 + h * 128 + vsl * 16 + j] = acc; }
        __syncthreads();
        for (int i = 0; i < 4; ++i) { const int k = (tid >> 4) + 32 * i; float acc = Sst[k * 17 + j] * eg;
            for (int c = 0; c < 64; ++c) acc += kdS[c * 129 + k] * vnS[c * 17 + j];
            Sst[k * 17 + j] = acc; }
    }
    __syncthreads();
}
DI void fox_task(const Args& a, bf16_t* Pw, int id) {
    const int lane = threadIdx.x & 63, lr = lane & 15, lq = lane >> 4;
    const int qt = 1023 - (id >> 2), h = id & 3, t0 = qt * 16;
    const bf16_t* P = (const bf16_t*)(a.ws + WS_PROJ); const bf16_t* VT = (const bf16_t*)(a.ws + WS_VT); const float* F = (const float*)(a.ws + WS_F) + (size_t)h * SEQ;
    bf16_t* OB = (bf16_t*)(a.ws + WS_OB);
    bf16x8 qa[4];
#pragma unroll
    for (int s = 0; s < 4; ++s) qa[s] = *(const bf16x8*)(P + (size_t)(t0 + lr) * NPJ + PJ_FQ + h * 128 + s * 32 + lq * 8);
    float Fq[4], m[4], ls[4]; f32x4 o[8];
#pragma unroll
    for (int r = 0; r < 4; ++r) { Fq[r] = F[t0 + lq * 4 + r]; m[r] = -1e30f; ls[r] = 0.f; }
#pragma unroll
    for (int d = 0; d < 8; ++d) o[d] = (f32x4){0.f, 0.f, 0.f, 0.f};
    const int nkt = (t0 + 15) / 32 + 1;
    for (int kt = 0; kt < nkt; ++kt) {
        const int k0 = kt * 32;
        f32x4 sc[2];
#pragma unroll
        for (int nt = 0; nt < 2; ++nt) { sc[nt] = (f32x4){0.f, 0.f, 0.f, 0.f};
#pragma unroll
            for (int s = 0; s < 4; ++s) { const bf16x8 kb = *(const bf16x8*)(P + (size_t)(k0 + 16 * nt + lr) * NPJ + PJ_FK + h * 128 + s * 32 + lq * 8); sc[nt] = MFMA16(qa[s], kb, sc[nt]); } }
        const float Fk0 = F[k0 + lr], Fk1 = F[k0 + 16 + lr];
        float mx[4];
#pragma unroll
        for (int r = 0; r < 4; ++r) { const int qrow = t0 + lq * 4 + r;
            float s0 = sc[0][r] * 0.08838834764831845f + Fq[r] - Fk0, s1 = sc[1][r] * 0.08838834764831845f + Fq[r] - Fk1;
            if (k0 + lr > qrow) s0 = -__builtin_inff();
            if (k0 + 16 + lr > qrow) s1 = -__builtin_inff();
            sc[0][r] = s0; sc[1][r] = s1; mx[r] = fmaxf(s0, s1); }
#pragma unroll
        for (int r = 0; r < 4; ++r) { for (int o_ = 1; o_ <= 8; o_ <<= 1) mx[r] = fmaxf(mx[r], __shfl_xor(mx[r], o_)); }
        __builtin_amdgcn_wave_barrier();
#pragma unroll
        for (int r = 0; r < 4; ++r) { const float mn = fmaxf(m[r], mx[r]); const float al = expf(m[r] - mn); m[r] = mn;
            const float p0 = expf(sc[0][r] - mn), p1 = expf(sc[1][r] - mn);
            ls[r] = ls[r] * al + p0 + p1;
#pragma unroll
            for (int d = 0; d < 8; ++d) o[d][r] *= al;
            Pw[(lq * 4 + r) * 40 + lr] = f2bf(p0); Pw[(lq * 4 + r) * 40 + 16 + lr] = f2bf(p1); }
        asm volatile("s_waitcnt lgkmcnt(0)" ::: "memory");
        __builtin_amdgcn_wave_barrier();
        const bf16x8 pa = *(const bf16x8*)(Pw + lr * 40 + lq * 8);
        asm volatile("s_waitcnt lgkmcnt(0)" ::: "memory");
        __builtin_amdgcn_wave_barrier();
#pragma unroll
        for (int d = 0; d < 8; ++d) { const bf16x8 vb = *(const bf16x8*)(VT + (size_t)(h * 128 + d * 16 + lr) * SEQ + k0 + lq * 8); o[d] = MFMA16(pa, vb, o[d]); }
    }
#pragma unroll
    for (int r = 0; r < 4; ++r) { for (int o_ = 1; o_ <= 8; o_ <<= 1) ls[r] += __shfl_xor(ls[r], o_); ls[r] = 1.f / ls[r]; }
#pragma unroll
    for (int d = 0; d < 8; ++d)
#pragma unroll
        for (int r = 0; r < 4; ++r) OB[(size_t)(t0 + lq * 4 + r) * 512 + h * 128 + d * 16 + lr] = f2bf(o[d][r] * ls[r]);
}
DI void ph4(const Args& a, float* lds) {
    const int G = gridDim.x, wave = threadIdx.x >> 6;
    if (blockIdx.x < 32) ph4_scan(a, lds);
    bf16_t* Pw = (bf16_t*)lds + wave * 16 * 40;
    const int NT = 4096, NW = G * NWAVES;
    for (int id = blockIdx.x * NWAVES + wave; id < NT / 2; id += NW) { fox_task(a, Pw, id); fox_task(a, Pw, NT - 1 - id); }
}

DI void ph5(const Args& a) {
    const int lane = threadIdx.x & 63, wave = threadIdx.x >> 6, NW = gridDim.x * NWAVES;
    const float* ORAW = (const float*)(a.ws + WS_ORAW); const bf16_t* P = (const bf16_t*)(a.ws + WS_PROJ); bf16_t* OA = (bf16_t*)(a.ws + WS_OA);
    const float g0 = a.in[I_GON][lane], g1 = a.in[I_GON][lane + 64];
    for (int id = blockIdx.x * NWAVES + wave; id < SEQ * 4; id += NW) { const int t = id >> 2, h = id & 3;
        const float o0 = ORAW[(size_t)t * 512 + h * 128 + lane], o1 = ORAW[(size_t)t * 512 + h * 128 + 64 + lane];
        const float rstd = rsqrtf(wave_sum(o0 * o0 + o1 * o1) * (1.f / 128.f) + 1e-6f);
        const float z0 = bf2f(P[(size_t)t * NPJ + PJ_DZ + h * 128 + lane]), z1 = bf2f(P[(size_t)t * NPJ + PJ_DZ + h * 128 + 64 + lane]);
        OA[(size_t)t * 512 + h * 128 + lane] = f2bf(o0 * rstd * g0 * siluf(z0)); OA[(size_t)t * 512 + h * 128 + 64 + lane] = f2bf(o1 * rstd * g1 * siluf(z1)); }
}

DI void ph6(const Args& a) {
    const int tid = threadIdx.x, lane = tid & 63, wave = tid >> 6, G = gridDim.x, lr = lane & 15, lq = lane >> 4;
    const bf16_t* OA = (const bf16_t*)(a.ws + WS_OA); const bf16_t* OB = (const bf16_t*)(a.ws + WS_OB);
    const bf16_t* WA = (const bf16_t*)(a.ws + WS_WOAT); const bf16_t* WB = (const bf16_t*)(a.ws + WS_WOBT);
    const bf16_t* P = (const bf16_t*)(a.ws + WS_PROJ); bf16_t* MR = (bf16_t*)(a.ws + WS_MRG);
    for (int u = blockIdx.x; u < 128 * 4; u += G) {
        const int rt = u >> 2, ct = u & 3, m0 = rt * 128 + (wave >> 2) * 64, n0 = ct * 256 + (wave & 3) * 64;
        const bf16_t* ap[4]; const bf16_t* bp[4];
        f32x4 ya[4][4], yb[4][4]; zero_acc<4>(ya); zero_acc<4>(yb);
#pragma unroll
        for (int i = 0; i < 4; ++i) { ap[i] = OA + (size_t)(m0 + 16 * i + lr) * 512 + lq * 8; bp[i] = WA + (size_t)(n0 + 16 * i + lr) * 512 + lq * 8; }
        wave_gemm<4>(ap, bp, 512, ya);
#pragma unroll
        for (int i = 0; i < 4; ++i) { ap[i] = OB + (size_t)(m0 + 16 * i + lr) * 512 + lq * 8; bp[i] = WB + (size_t)(n0 + 16 * i + lr) * 512 + lq * 8; }
        wave_gemm<4>(ap, bp, 512, yb);
#pragma unroll
        for (int i = 0; i < 4; ++i)
#pragma unroll
            for (int j = 0; j < 4; ++j)
#pragma unroll
                for (int r = 0; r < 4; ++r) { const size_t row = m0 + 16 * i + lq * 4 + r; const int col = n0 + 16 * j + lr;
                    const float ga = bf2f(P[row * NPJ + PJ_GA + col]), gb = bf2f(P[row * NPJ + PJ_GB + col]);
                    MR[row * DM + col] = f2bf(sigm(ga) * ya[i][j][r] + sigm(gb) * yb[i][j][r]); }
    }
}

DI void ph7(const Args& a) {
    const int tid = threadIdx.x, lane = tid & 63, wave = tid >> 6, G = gridDim.x, lr = lane & 15, lq = lane >> 4;
    const bf16_t* MR = (const bf16_t*)(a.ws + WS_MRG); const bf16_t* WO = (const bf16_t*)(a.ws + WS_WOUTT);
    const float* mod = (const float*)(a.ws + WS_MOD); float* X1 = (float*)(a.ws + WS_X1); const float* x = a.in[I_X];
    for (int u = blockIdx.x; u < 128 * 4; u += G) {
        const int rt = u >> 2, ct = u & 3, m0 = rt * 128 + (wave >> 2) * 64, n0 = ct * 256 + (wave & 3) * 64;
        const bf16_t* ap[4]; const bf16_t* bp[4];
#pragma unroll
        for (int i = 0; i < 4; ++i) { ap[i] = MR + (size_t)(m0 + 16 * i + lr) * DM + lq * 8; bp[i] = WO + (size_t)(n0 + 16 * i + lr) * DM + lq * 8; }
        f32x4 acc[4][4]; zero_acc<4>(acc);
        wave_gemm<4>(ap, bp, DM, acc);
#pragma unroll
        for (int j = 0; j < 4; ++j) { const int col = n0 + 16 * j + lr; const float gt = mod[2048 + col];
#pragma unroll
            for (int i = 0; i < 4; ++i)
#pragma unroll
                for (int r = 0; r < 4; ++r) { const size_t row = m0 + 16 * i + lq * 4 + r; X1[row * DM + col] = x[row * DM + col] + gt * acc[i][j][r]; } }
    }
}

DI void ph8(const Args& a, float* lds) {
    const int tid = threadIdx.x, lane = tid & 63, wave = tid >> 6, G = gridDim.x;
    float* A2 = lds; float* B2 = lds + 1024; float* hs = lds + 2048 + wave * 1024;
    const float* mod = (const float*)(a.ws + WS_MOD);
    for (int k = tid; k < DM; k += NTHREADS) { A2[k] = a.in[I_G2][k] * (1.f + mod[4096 + k]); B2[k] = mod[3072 + k]; }
    __syncthreads();
    const float* X1 = (const float*)(a.ws + WS_X1); bf16_t* H2 = (bf16_t*)(a.ws + WS_H2);
    int* TOKE = (int*)(a.ws + WS_TOKE); int* TOKS = (int*)(a.ws + WS_TOKS); float* TOKG = (float*)(a.ws + WS_TOKG); unsigned* CNT = (unsigned*)(a.ws + WS_CNT);
    const float* wr = a.in[I_WR]; const int e = lane & 31, half = lane >> 5; const float br = a.in[I_BR][e];
    for (int t = blockIdx.x * NWAVES + wave; t < SEQ; t += G * NWAVES) {
        const float* xr = X1 + (size_t)t * DM;
        f32x4 v[4]; float ss = 0.f;
#pragma unroll
        for (int i = 0; i < 4; ++i) { v[i] = *(const f32x4*)(xr + lane * 4 + 256 * i); ss += v[i][0] * v[i][0] + v[i][1] * v[i][1] + v[i][2] * v[i][2] + v[i][3] * v[i][3]; }
        ss = wave_sum(ss);
        const float rstd = rsqrtf(ss * (1.f / DM) + 1e-6f);
        __builtin_amdgcn_wave_barrier();
#pragma unroll
        for (int i = 0; i < 4; ++i) { const int k = lane * 4 + 256 * i;
#pragma unroll
            for (int q = 0; q < 4; ++q) { v[i][q] = v[i][q] * rstd * A2[k + q] + B2[k + q]; hs[k + q] = v[i][q]; }
            u32x2 w; w.x = pk2(v[i][0], v[i][1]); w.y = pk2(v[i][2], v[i][3]);
            *(u32x2*)(H2 + (size_t)t * DM + k) = w; }
        asm volatile("s_waitcnt lgkmcnt(0)" ::: "memory");
        __builtin_amdgcn_wave_barrier();
        float lg = 0.f;
        for (int k = half * 512; k < half * 512 + 512; ++k) lg += hs[k] * wr[(size_t)k * NE + e];
        lg += __shfl_xor(lg, 32);
        lg += br;
        asm volatile("s_waitcnt lgkmcnt(0)" ::: "memory");
        __builtin_amdgcn_wave_barrier();
        float cur = lg;
#define TOP1(TV, TI) float TV = cur; int TI = e; for (int o_ = 1; o_ <= 16; o_ <<= 1) { const float ov = __shfl_xor(TV, o_); const int oi = __shfl_xor(TI, o_); if (ov > TV || (ov == TV && oi < TI)) { TV = ov; TI = oi; } } if (e == TI) cur = -__builtin_inff();
        TOP1(tv0, ti0) TOP1(tv1, ti1) TOP1(tv2, ti2) TOP1(tv3, ti3)
#undef TOP1
        const float ex0 = 1.f, ex1 = expf(tv1 - tv0), ex2 = expf(tv2 - tv0), ex3 = expf(tv3 - tv0), den = ex0 + ex1 + ex2 + ex3;
        if (lane < 4) { int ee = ti0; float gg = ex0;
            if (lane == 1) { ee = ti1; gg = ex1; } if (lane == 2) { ee = ti2; gg = ex2; } if (lane == 3) { ee = ti3; gg = ex3; }
            const unsigned slot = atomicAdd(&CNT[ee], 1u);
            TOKE[t * 4 + lane] = ee; TOKS[t * 4 + lane] = (int)slot; TOKG[t * 4 + lane] = gg / den; }
    }
}

DI void pad_starts(const Args& a, int* ps) {
    if (threadIdx.x == 0) { const unsigned* CNT = (const unsigned*)(a.ws + WS_CNT); int s = 0; for (int e = 0; e < NE; ++e) { ps[e] = s; s += (int)((CNT[e] + 255u) / 256u) * 256; } ps[NE] = s; }
    __syncthreads();
}
DI void ph9(const Args& a, float* lds) {
    int* ps = (int*)lds; pad_starts(a, ps);
    const int lane = threadIdx.x & 63, wave = threadIdx.x >> 6, NW = gridDim.x * NWAVES;
    const int* TOKE = (const int*)(a.ws + WS_TOKE); const int* TOKS = (const int*)(a.ws + WS_TOKS);
    const bf16_t* H2 = (const bf16_t*)(a.ws + WS_H2); bf16_t* XG = (bf16_t*)(a.ws + WS_XG);
    for (int id = blockIdx.x * NWAVES + wave; id < SEQ * 4; id += NW) { const int t = id >> 2;
        const size_t row = (size_t)ps[TOKE[id]] + TOKS[id];
        const u32x4 v0 = *(const u32x4*)(H2 + (size_t)t * DM + lane * 8), v1 = *(const u32x4*)(H2 + (size_t)t * DM + 512 + lane * 8);
        *(u32x4*)(XG + row * DM + lane * 8) = v0; *(u32x4*)(XG + row * DM + 512 + lane * 8) = v1; }
}
DI int expert_of(const int* ps, int row0) { int e = 0; for (int i = 1; i < NE; ++i) if (row0 >= ps[i]) e = i; return e; }
DI void ph10(const Args& a, float* lds) {
    int* ps = (int*)lds; pad_starts(a, ps);
    const int tid = threadIdx.x, lane = tid & 63, wave = tid >> 6, G = gridDim.x, lr = lane & 15, lq = lane >> 4;
    const bf16_t* XG = (const bf16_t*)(a.ws + WS_XG); const bf16_t* WG = (const bf16_t*)(a.ws + WS_WGUT); bf16_t* ACT = (bf16_t*)(a.ws + WS_ACT);
    const int nrt = ps[NE] / 128;
    for (int u = blockIdx.x; u < nrt * 8; u += G) {
        const int rt = u >> 3, ct = u & 7, e = expert_of(ps, rt * 128), m0 = rt * 128 + (wave >> 2) * 64, n0 = ct * 256 + (wave & 3) * 64;
        const bf16_t* ap[4]; const bf16_t* bp[4];
#pragma unroll
        for (int i = 0; i < 4; ++i) { ap[i] = XG + (size_t)(m0 + 16 * i + lr) * DM + lq * 8; bp[i] = WG + ((size_t)e * 2048 + n0 + 16 * i + lr) * DM + lq * 8; }
        f32x4 acc[4][4]; zero_acc<4>(acc);
        wave_gemm<4>(ap, bp, DM, acc);
        const float* bgu = a.in[I_BGU] + (size_t)e * 2048;
#pragma unroll
        for (int j = 0; j < 2; ++j) { const int acol = 32 * (n0 >> 6) + 16 * j + lr; const float bg = bgu[acol], bu = bgu[1024 + acol];
#pragma unroll
            for (int i = 0; i < 4; ++i)
#pragma unroll
                for (int r = 0; r < 4; ++r) { float g = acc[i][j][r] + bg, up = acc[i][j + 2][r] + bu;
                    g = fminf(g, 7.f); up = fminf(fmaxf(up, -7.f), 7.f);
                    ACT[(size_t)(m0 + 16 * i + lq * 4 + r) * DM + acol] = f2bf((up + 1.f) * (g * sigm(1.702f * g))); } }
    }
}
DI void ph11(const Args& a, float* lds) {
    int* ps = (int*)lds; pad_starts(a, ps);
    const int tid = threadIdx.x, lane = tid & 63, wave = tid >> 6, G = gridDim.x, lr = lane & 15, lq = lane >> 4;
    const bf16_t* ACT = (const bf16_t*)(a.ws + WS_ACT); const bf16_t* WD = (const bf16_t*)(a.ws + WS_WDT); bf16_t* YB = (bf16_t*)(a.ws + WS_YB);
    const int nrt = ps[NE] / 128;
    for (int u = blockIdx.x; u < nrt * 4; u += G) {
        const int rt = u >> 2, ct = u & 3, e = expert_of(ps, rt * 128), m0 = rt * 128 + (wave >> 2) * 64, n0 = ct * 256 + (wave & 3) * 64;
        const bf16_t* ap[4]; const bf16_t* bp[4];
#pragma unroll
        for (int i = 0; i < 4; ++i) { ap[i] = ACT + (size_t)(m0 + 16 * i + lr) * DM + lq * 8; bp[i] = WD + ((size_t)e * DM + n0 + 16 * i + lr) * DM + lq * 8; }
        f32x4 acc[4][4]; zero_acc<4>(acc);
        wave_gemm<4>(ap, bp, DM, acc);
        const float* bd = a.in[I_BD] + (size_t)e * DM;
#pragma unroll
        for (int j = 0; j < 4; ++j) { const int col = n0 + 16 * j + lr; const float b = bd[col];
#pragma unroll
            for (int i = 0; i < 4; ++i)
#pragma unroll
                for (int r = 0; r < 4; ++r) YB[(size_t)(m0 + 16 * i + lq * 4 + r) * DM + col] = f2bf(acc[i][j][r] + b); }
    }
}
DI void ph12(const Args& a, float* lds) {
    int* ps = (int*)lds; pad_starts(a, ps);
    const int lane = threadIdx.x & 63, wave = threadIdx.x >> 6, G = gridDim.x;
    const float* X1 = (const float*)(a.ws + WS_X1); const bf16_t* YB = (const bf16_t*)(a.ws + WS_YB); const float* mod = (const float*)(a.ws + WS_MOD);
    const int* TOKE = (const int*)(a.ws + WS_TOKE); const int* TOKS = (const int*)(a.ws + WS_TOKS); const float* TOKG = (const float*)(a.ws + WS_TOKG);
    for (int t = blockIdx.x * NWAVES + wave; t < SEQ; t += G * NWAVES) {
        size_t rows[4]; float gk[4];
#pragma unroll
        for (int q = 0; q < 4; ++q) { rows[q] = (size_t)ps[TOKE[t * 4 + q]] + TOKS[t * 4 + q]; gk[q] = TOKG[t * 4 + q]; }
        f32x4 v[4]; float ss = 0.f;
#pragma unroll
        for (int i = 0; i < 4; ++i) { const int k = lane * 4 + 256 * i; v[i] = *(const f32x4*)(X1 + (size_t)t * DM + k);
            f32x4 y = (f32x4){0.f, 0.f, 0.f, 0.f};
#pragma unroll
            for (int q = 0; q < 4; ++q) { const u32x2 w = *(const u32x2*)(YB + rows[q] * DM + k);
                y[0] += gk[q] * __uint_as_float(w.x << 16); y[1] += gk[q] * __uint_as_float(w.x & 0xffff0000u); y[2] += gk[q] * __uint_as_float(w.y << 16); y[3] += gk[q] * __uint_as_float(w.y & 0xffff0000u); }
#pragma unroll
            for (int q = 0; q < 4; ++q) { v[i][q] += mod[5120 + k + q] * y[q]; ss += v[i][q] * v[i][q]; } }
        ss = wave_sum(ss);
        const float rstd = rsqrtf(ss * (1.f / DM) + 1e-6f);
#pragma unroll
        for (int i = 0; i < 4; ++i) { const int k = lane * 4 + 256 * i; f32x4 o;
#pragma unroll
            for (int q = 0; q < 4; ++q) o[q] = v[i][q] * rstd * a.in[I_GF][k + q];
            *(f32x4*)(a.out + (size_t)t * DM + k) = o; }
    }
}

__global__ void __launch_bounds__(NTHREADS, 2) hybrid_fwd(Args a) {
    extern __shared__ __attribute__((aligned(16))) unsigned char lds_raw[];
    float* lds = (float*)(lds_raw + 16);
    LAS unsigned* xbw = (LAS unsigned*)lds_raw;
    if (threadIdx.x == 0) { xbw[0] = 0u; xbw[1] = 0u; xbw[2] = 0u; xbw[3] = 0u; }
    __syncthreads();
    XcdBarrier bar; bar.bar = (unsigned*)(a.ws + WS_BAR); bar.x = 0; bar.st = (volatile LAS unsigned*)xbw;
    const int lo = a.ph_lo, hi = a.ph_hi;
    if (hi - lo > 1) bar = xcd_barrier_post((unsigned*)(a.ws + WS_BAR), (volatile LAS unsigned*)xbw);
#define IN(k) (lo <= (k) && (k) < hi)
#define SEAM(k) do { if (IN(k) && IN((k) + 1)) xcd_barrier(bar); } while (0)
    if (IN(0)) ph0(a, lds);
    SEAM(0);
    if (IN(1)) ph1(a, lds);
    SEAM(1);
    if (IN(2)) ph2(a);
    SEAM(2);
    if (IN(3)) ph3(a, lds);
    SEAM(3);
    if (IN(4)) ph4(a, lds);
    SEAM(4);
    if (IN(5)) ph5(a);
    SEAM(5);
    if (IN(6)) ph6(a);
    SEAM(6);
    if (IN(7)) ph7(a);
    SEAM(7);
    if (IN(8)) ph8(a, lds);
    SEAM(8);
    if (IN(9)) ph9(a, lds);
    SEAM(9);
    if (IN(10)) ph10(a, lds);
    SEAM(10);
    if (IN(11)) ph11(a, lds);
    SEAM(11);
    if (IN(12)) ph12(a, lds);
#undef IN
#undef SEAM
}

extern "C" void kernel_launch(void* const* d_in, const int* in_sizes, int n_in, void* d_out, int out_size, void* d_ws, size_t ws_size, hipStream_t stream) {
    static int grid = 0;
    if (grid == 0) {
        if (n_in != 22 || out_size != SEQ * DM || ws_size < WS_END) { fprintf(stderr, "kernel_launch: unexpected shapes (n_in %d out %d ws %zu, need %zu)\n", n_in, out_size, ws_size, (size_t)WS_END); grid = -1; return; }
        int dev = 0, cus = 0, per_cu = 0;
        if (hipGetDevice(&dev) != hipSuccess || hipDeviceGetAttribute(&cus, hipDeviceAttributeMultiprocessorCount, dev) != hipSuccess) { grid = -1; return; }
        if (hipFuncSetAttribute((const void*)hybrid_fwd, hipFuncAttributeMaxDynamicSharedMemorySize, LDS_BYTES) != hipSuccess) { fprintf(stderr, "kernel_launch: hipFuncSetAttribute failed\n"); grid = -1; return; }
        if (hipOccupancyMaxActiveBlocksPerMultiprocessor(&per_cu, (const void*)hybrid_fwd, NTHREADS, LDS_BYTES) != hipSuccess || per_cu < 1) { fprintf(stderr, "kernel_launch: occupancy query says %d\n", per_cu); }
        (void)hipGetLastError();
        grid = cus;
    }
    if (grid < 0) return;
    (void)hipMemsetAsync(d_ws, 0, CTL_ZERO, stream);
    Args a{};
    for (int i = 0; i < 22; ++i) a.in[i] = (const float*)d_in[i];
    a.out = (float*)d_out; a.ws = (unsigned char*)d_ws;
#if N_LAUNCHES == 1
    a.ph_lo = 0; a.ph_hi = NPHASES;
    hipLaunchKernelGGL(hybrid_fwd, dim3(grid), dim3(NTHREADS), LDS_BYTES, stream, a);
#else
    for (int p = 0; p < NPHASES; ++p) { a.ph_lo = p; a.ph_hi = p + 1; hipLaunchKernelGGL(hybrid_fwd, dim3(grid), dim3(NTHREADS), LDS_BYTES, stream, a); }
#endif
}
```

```cpp
#include <hip/hip_runtime.h>
#include <stdint.h>
#include <stdio.h>

#ifndef N_LAUNCHES
#define N_LAUNCHES 1
#endif

#define DI __device__ __forceinline__
#define LAS __attribute__((address_space(3)))
typedef unsigned short bf16_t;
typedef short bf16x8 __attribute__((ext_vector_type(8)));
typedef float f32x4 __attribute__((ext_vector_type(4)));
typedef unsigned u32x4 __attribute__((ext_vector_type(4)));
typedef unsigned u32x2 __attribute__((ext_vector_type(2)));

constexpr int SEQ = 16384, DM = 1024, NIN = 5644, NPJ = 5632, NE = 32, TOPK = 4;
constexpr int NH = 4, HD = 128, CH = 64, NCH = SEQ / CH;
constexpr int PJ_DQ = 0, PJ_DK = 512, PJ_DV = 1024, PJ_DZ = 1536, PJ_FQ = 2048, PJ_FK = 2560, PJ_FV = 3072, PJ_GA = 3584, PJ_GB = 4608;
constexpr int NTHREADS = 512, NWAVES = 8;
constexpr int LDS_BYTES = 152 * 1024;
constexpr int NPHASES = 15;

constexpr size_t MiB = 1u << 20;
constexpr size_t WS_BAR = 0;
constexpr size_t WS_CNT = 32768;
constexpr size_t WS_NRM = 32768 + 256;
constexpr size_t WS_QH = 32768 + 512;
constexpr size_t CTL_ZERO = 65536;
constexpr size_t WS_MOD = 65536;
constexpr size_t WS_F = WS_MOD + 32768;
constexpr size_t WS_EG = WS_F + 262144;
constexpr size_t WS_TOKE = WS_EG + 4096;
constexpr size_t WS_TOKS = WS_TOKE + 262144;
constexpr size_t WS_TOKG = WS_TOKS + 262144;
constexpr size_t WS_SP = WS_TOKG + 262144;
constexpr size_t WS_WINT = WS_SP + MiB;
constexpr size_t WS_WOAT = WS_WINT + (size_t)NPJ * DM * 2;
constexpr size_t WS_WOBT = WS_WOAT + MiB;
constexpr size_t WS_WOUTT = WS_WOBT + MiB;
constexpr size_t WS_WGUT = WS_WOUTT + 2 * MiB;
constexpr size_t WS_WDT = WS_WGUT + 128 * MiB;
constexpr size_t WS_X1 = WS_WDT + 64 * MiB;
constexpr size_t WS_H2 = WS_X1 + 64 * MiB;
constexpr size_t WS_MRG = WS_H2 + 32 * MiB;
constexpr size_t WS_RA = WS_MRG + 32 * MiB;
constexpr size_t WS_RB = WS_RA + 176 * MiB;
constexpr size_t WS_H = WS_RB;
constexpr size_t WS_DNW = WS_H + 32 * MiB;
constexpr size_t WS_DNU = WS_DNW + 16 * MiB;
constexpr size_t WS_DNQD = WS_DNU + 16 * MiB;
constexpr size_t WS_DNKD = WS_DNQD + 16 * MiB;
constexpr size_t WS_DNATT = WS_DNKD + 16 * MiB;
constexpr size_t WS_ORAW = WS_DNATT + 8 * MiB;
constexpr size_t WS_OA = WS_ORAW + 32 * MiB;
constexpr size_t WS_OB = WS_OA + 16 * MiB;
constexpr size_t WS_VT = WS_OB + 16 * MiB;
constexpr size_t WS_PG = WS_VT;
constexpr size_t WS_QG = WS_PG + 2 * MiB;
constexpr size_t WS_SG = WS_QG + 4 * MiB;
constexpr size_t WS_END = WS_RB + 184 * MiB;
constexpr size_t WS_XG = WS_RA, WS_YB = WS_RA, WS_ACT = WS_RB, WS_PROJ = WS_RA;
static_assert(WS_VT + 16 * MiB <= WS_END, "region B");

struct Args { const float* in[22]; float* out; unsigned char* ws; int ph_lo, ph_hi; };
enum { I_X = 0, I_C, I_WADA, I_BADA, I_G1, I_WIN, I_CONVW, I_ALOG, I_DTB, I_GON, I_BFG, I_WOD, I_WOF, I_WOUT, I_G2, I_WR, I_BR, I_WGU, I_BGU, I_WD, I_BD, I_GF };

DI float bf2f(bf16_t v) { return __uint_as_float(((unsigned)v) << 16); }
DI bf16_t f2bf(float f) { unsigned u = __float_as_uint(f); u += 0x7fffu + ((u >> 16) & 1u); return (bf16_t)(u >> 16); }
typedef float f32x2_t __attribute__((ext_vector_type(2)));
typedef __bf16 bf16x2_t __attribute__((ext_vector_type(2)));
DI unsigned cvt_pk(float lo, float hi) { const f32x2_t v = {lo, hi}; const bf16x2_t b = __builtin_convertvector(v, bf16x2_t); return __builtin_bit_cast(unsigned, b); }
DI unsigned pk2(float lo, float hi) { return (unsigned)f2bf(lo) | ((unsigned)f2bf(hi) << 16); }
DI float sigm(float x) { return 1.f / (1.f + expf(-x)); }
DI float siluf(float x) { return x / (1.f + expf(-x)); }
DI float softplusf(float x) { return fmaxf(x, 0.f) + log1pf(expf(-fabsf(x))); }
DI float logsigf(float x) { return fminf(x, 0.f) - log1pf(expf(-fabsf(x))); }
DI float wave_sum(float v) { for (int o = 32; o >= 1; o >>= 1) v += __shfl_xor(v, o); return v; }
#define MFMA16(a, b, c) __builtin_amdgcn_mfma_f32_16x16x32_bf16((a), (b), (c), 0, 0, 0)

DI int gu_src(int n) { const int g = n >> 8, r = n & 255; return r < 128 ? 128 * g + r : 1024 + 128 * g + (r - 128); }

#define XB_TMO      128
#define XB_XCNT(j)  (256  + 64 * (j))
#define XB_XSUB(j)  (1280 + 64 * (j))
#define XB_XGEN(j)  (2304 + 64 * (j))
#define XB_TOP      3328
#define XB_TOPGEN   3392
#define XCD_BAR_WORDS 3456
#define XB_SPIN_CAP (1u << 22)
DI unsigned xb_ld(unsigned* p)              { return __hip_atomic_load(p, __ATOMIC_RELAXED, __HIP_MEMORY_SCOPE_AGENT); }
DI unsigned xb_add(unsigned* p, unsigned v) { return __hip_atomic_fetch_add(p, v, __ATOMIC_RELAXED, __HIP_MEMORY_SCOPE_AGENT); }
DI unsigned xb_xcc_id() { return (unsigned)__builtin_amdgcn_s_getreg((3 << 11) | 20) & 0xFu; }
#define XB_SPIN(cond, bar) do { unsigned _sp = 0; while (cond) { __builtin_amdgcn_s_sleep(1); \
    if ((++_sp & 255u) == 0u) { if (xb_ld(&(bar)[XB_TMO])) break; if (_sp > XB_SPIN_CAP) { atomicAdd(&(bar)[XB_TMO], 1u); break; } } } } while (0)
struct XcdBarrier { unsigned* bar; unsigned x; volatile LAS unsigned* st; };
DI XcdBarrier xcd_barrier_post(unsigned* bar, volatile LAS unsigned* st) {
    XcdBarrier b; b.bar = bar; b.x = xb_xcc_id(); b.st = st;
    if (threadIdx.x == 0) (void)xb_add(&bar[XB_XCNT(b.x)], 1u);
    return b;
}
DI void xcd_barrier_complete(unsigned* bar, unsigned x, unsigned& nloc, unsigned& nx) {
    const unsigned G = gridDim.x * gridDim.y * gridDim.z;
    unsigned sum, cnt, mine, sp = 0u;
    for (;;) {
        sum = 0u; cnt = 0u; mine = 0u;
#pragma unroll
        for (unsigned j = 0; j < 16; ++j) { const unsigned c = xb_ld(&bar[XB_XCNT(j)]); sum += c; cnt += (c > 0u) ? 1u : 0u; mine = (j == x) ? c : mine; }
        if (sum == G) break;
        __builtin_amdgcn_s_sleep(1);
        if ((++sp & 255u) == 0u) { if (xb_ld(&bar[XB_TMO])) break; if (sp > XB_SPIN_CAP) { atomicAdd(&bar[XB_TMO], 1u); break; } }
    }
    nloc = mine > 0u ? mine : 1u; nx = cnt > 0u ? cnt : 1u;
}
DI void xcd_barrier(const XcdBarrier& b) {
    asm volatile("s_waitcnt vmcnt(0)" ::: "memory");
    __syncthreads();
    if (threadIdx.x == 0) {
        unsigned* bar = b.bar;
        __builtin_amdgcn_s_waitcnt(0);
        unsigned nloc = b.st[0], nx = b.st[1];
        if (nloc == 0u) { xcd_barrier_complete(bar, b.x, nloc, nx); b.st[0] = nloc; b.st[1] = nx; }
        const unsigned old = xb_add(&bar[XB_XSUB(b.x)], 1u);
        const unsigned gen = old / nloc;
        if (old + 1u == (gen + 1u) * nloc) {
            __builtin_amdgcn_fence(__ATOMIC_RELEASE, "agent");
            asm volatile("s_waitcnt vmcnt(0)" ::: "memory");
            const unsigned og = xb_add(&bar[XB_TOP], 1u);
            const unsigned tg = og / nx;
            if (og + 1u == (tg + 1u) * nx) xb_add(&bar[XB_TOPGEN], 1u);
            else XB_SPIN(xb_ld(&bar[XB_TOPGEN]) == tg, bar);
            __builtin_amdgcn_fence(__ATOMIC_ACQUIRE, "agent");
            xb_add(&bar[XB_XGEN(b.x)], 1u);
            asm volatile("s_waitcnt vmcnt(0)" ::: "memory");
        } else {
            XB_SPIN(xb_ld(&bar[XB_XGEN(b.x)]) == gen, bar);
            __builtin_amdgcn_fence(__ATOMIC_ACQUIRE, "agent");
            asm volatile("s_waitcnt vmcnt(0)" ::: "memory");
        }
    }
    __syncthreads();
}

template <int NT>
DI void wave_gemm(const bf16_t* const (&ap)[4], const bf16_t* const (&bp)[NT], int K, f32x4 (&acc)[4][NT]) {
    for (int k0 = 0; k0 < K; k0 += 32) {
        bf16x8 a[4], b[NT];
#pragma unroll
        for (int i = 0; i < 4; ++i) a[i] = *(const bf16x8*)(ap[i] + k0);
#pragma unroll
        for (int j = 0; j < NT; ++j) b[j] = *(const bf16x8*)(bp[j] + k0);
#pragma unroll
        for (int i = 0; i < 4; ++i)
#pragma unroll
            for (int j = 0; j < NT; ++j) acc[i][j] = MFMA16(a[i], b[j], acc[i][j]);
    }
}
template <int NT> DI void zero_acc(f32x4 (&acc)[4][NT]) {
#pragma unroll
    for (int i = 0; i < 4; ++i)
#pragma unroll
        for (int j = 0; j < NT; ++j) acc[i][j] = (f32x4){0.f, 0.f, 0.f, 0.f};
}


namespace pg8 {
struct Unit { int pm, pn, pb, e; };
struct Gemm { const bf16_t* A; const bf16_t* Bt; int M, N, K; };
constexpr int BM = 256, BK = 64, HALF = 128, HTB = HALF * BK * 2  , STAGE_BYTES = 8 * HTB, NXCD = 8, WGM = 8;

__host__ __device__ __forceinline__ int lds_byte(int r, int c) { const int st = (r >> 4) * 2 + (c >> 5), rr = r & 15, cc = c & 31, ob = rr * 64 + cc * 2; return st * 1024 + (ob ^ (((ob >> 9) & 1) << 5)); }
__host__ __device__ __forceinline__ void stage_rc(int b, int& R, int& C) { const int st = b / 1024, sb = b % 1024, swz = sb ^ (((sb >> 9) & 1) << 5); R = (st >> 1) * 16 + swz / 64; C = (st & 1) * 32 + (swz % 64) / 2; }
__host__ __device__ __forceinline__ int perm32(int rho) { const int n = rho >> 4, i = rho & 15; return 8 * (i >> 2) + 4 * n + (i & 3); }
template <class Epi, class Sched>
__device__ __forceinline__ void gemm_phase(LAS unsigned char* lds, const Gemm g, const Sched& S, const Epi& E) {
    const int tid = threadIdx.x, wid = __builtin_amdgcn_readfirstlane(tid >> 6), lane = tid & 63, wr = wid >> 2, wc = wid & 3, fr = lane & 15, fq = lane >> 4;
    const int K = g.K, nt = K / BK;
    unsigned voffA[2], voffB[2];
#pragma unroll
    for (int i = 0; i < 2; ++i) { int R, C; stage_rc(tid * 16 + i * 8192, R, C); const int Rb = Epi::PERM ? ((R & ~31) + perm32(R & 31)) : R;
        voffA[i] = (unsigned)(R * K + C) * 2u; voffB[i] = (unsigned)(Rb * K + C) * 2u; }
    const size_t kstep = (size_t)(BK * 2);
    const size_t hstep = (size_t)HALF * K * 2;
    const size_t tstep = 2 * hstep;
    const unsigned ldsw = (unsigned)wid * 1024u;
    const int aoff = lds_byte(wr * 64 + fr, fq * 8), boff = lds_byte(wc * 32 + fr, fq * 8);
#define PG8_SA(b, h) (((b) * 2 + (h)) * HTB)
#define PG8_SB(b, h) ((4 + (b) * 2 + (h)) * HTB)
#define PG8_STAGE(bufoff, gbase, voff) do { _Pragma("unroll") for (int _i = 0; _i < 2; ++_i) \
        __builtin_amdgcn_global_load_lds((const unsigned*)((const char*)(gbase) + (voff)[_i]), (LAS unsigned*)(lds + (bufoff) + ldsw + _i * 8192), 16, 0, 0); } while (0)
#define PG8_LDA(dst, b, h) do { _Pragma("unroll") for (int m = 0; m < 4; ++m) _Pragma("unroll") for (int k = 0; k < 2; ++k) dst[m][k] = *(const LAS bf16x8*)(lds + PG8_SA(b, h) + aoff + m * 2048 + k * 1024); } while (0)
#define PG8_LDB(dst, b, h) do { _Pragma("unroll") for (int n = 0; n < 2; ++n) _Pragma("unroll") for (int k = 0; k < 2; ++k) dst[n][k] = *(const LAS bf16x8*)(lds + PG8_SB(b, h) + boff + n * 2048 + k * 1024); } while (0)
#define PG8_MMA(ai, bj, At, Bt) do { __builtin_amdgcn_s_setprio(1); _Pragma("unroll") for (int m = 0; m < 4; ++m) _Pragma("unroll") for (int n = 0; n < 2; ++n) _Pragma("unroll") for (int k = 0; k < 2; ++k) \
        acc[ai][bj][m][n] = __builtin_amdgcn_mfma_f32_16x16x32_bf16(Bt[n][k], At[m][k], acc[ai][bj][m][n], 0, 0, 0); __builtin_amdgcn_s_setprio(0); } while (0)
#define PG8_WAIT_V(n) asm volatile("s_waitcnt vmcnt(" #n ")" ::: "memory")
#define PG8_WAIT_L(n) asm volatile("s_waitcnt lgkmcnt(" #n ")" ::: "memory")
#define PG8_BAR __builtin_amdgcn_s_barrier()
#define PG8_SCHED __builtin_amdgcn_sched_barrier(0)
    Unit cur, nxt; int ui = 0;
    if (!S.next(0, cur)) return;
    f32x4 acc[2][2][4][2];
#pragma unroll
    for (int a = 0; a < 2; ++a)
#pragma unroll
        for (int b = 0; b < 2; ++b)
#pragma unroll
            for (int m = 0; m < 4; ++m)
#pragma unroll
                for (int n = 0; n < 2; ++n) acc[a][b][m][n] = (f32x4){0.f, 0.f, 0.f, 0.f};
    bf16x8 At[4][2], B0[2][2], B1[2][2];
    const char* cA = (const char*)g.A + (size_t)cur.pm * tstep; const char* cB = (const char*)g.Bt + (size_t)cur.pb * tstep;
    S.a_ready(cur);
    PG8_STAGE(PG8_SB(0, 0), cB, voffB); PG8_STAGE(PG8_SA(0, 0), cA, voffA); PG8_STAGE(PG8_SB(0, 1), cB + hstep, voffB); PG8_STAGE(PG8_SA(0, 1), cA + hstep, voffA);
    if (wr == 1) PG8_BAR;
    PG8_WAIT_V(4); PG8_BAR;
    PG8_STAGE(PG8_SB(1, 0), cB + kstep, voffB); PG8_STAGE(PG8_SA(1, 0), cA + kstep, voffA); PG8_STAGE(PG8_SB(1, 1), cB + hstep + kstep, voffB);
    PG8_WAIT_V(6); PG8_BAR;
    for (;;) {
        const bool has_next = S.next(ui + 1, nxt);
        const char* nA = has_next ? (const char*)g.A + (size_t)nxt.pm * tstep : cA; const char* nB = has_next ? (const char*)g.Bt + (size_t)nxt.pb * tstep : cB;
        for (int t = 0; t < nt; t += 2) {
            const bool last = (t == nt - 2);
            const char* a1 = cA + (size_t)(t + 1) * kstep;
            const char* a2 = last ? nA : cA + (size_t)(t + 2) * kstep; const char* b2 = last ? nB : cB + (size_t)(t + 2) * kstep;
            const char* a3 = a2 + kstep; const char* b3 = b2 + kstep;
            if (last && has_next) S.a_ready(nxt);
            PG8_LDB(B0, 0, 0); PG8_SCHED; PG8_LDA(At, 0, 0); PG8_STAGE(PG8_SA(1, 1), a1 + hstep, voffA);
            PG8_WAIT_L(8); PG8_BAR; PG8_WAIT_L(0); PG8_MMA(0, 0, At, B0); PG8_BAR; PG8_SCHED;
            PG8_LDB(B1, 0, 1); PG8_STAGE(PG8_SB(0, 0), b2, voffB);
            PG8_BAR; PG8_WAIT_L(0); PG8_MMA(0, 1, At, B1); PG8_BAR;
            PG8_LDA(At, 0, 1); PG8_STAGE(PG8_SA(0, 0), a2, voffA);
            PG8_BAR; PG8_WAIT_L(0); PG8_MMA(1, 0, At, B0); PG8_BAR; PG8_SCHED;
            PG8_STAGE(PG8_SB(0, 1), b2 + hstep, voffB);
            PG8_WAIT_V(6); PG8_BAR; PG8_MMA(1, 1, At, B1); PG8_BAR;
            PG8_LDB(B0, 1, 0); PG8_SCHED; PG8_LDA(At, 1, 0); PG8_STAGE(PG8_SA(0, 1), a2 + hstep, voffA);
            PG8_WAIT_L(8); PG8_BAR; PG8_WAIT_L(0); PG8_MMA(0, 0, At, B0); PG8_BAR; PG8_SCHED;
            PG8_LDB(B1, 1, 1); PG8_STAGE(PG8_SB(1, 0), b3, voffB);
            PG8_BAR; PG8_WAIT_L(0); PG8_MMA(0, 1, At, B1); PG8_BAR;
            PG8_LDA(At, 1, 1); PG8_STAGE(PG8_SA(1, 0), a3, voffA);
            PG8_BAR; PG8_WAIT_L(0); PG8_MMA(1, 0, At, B0); PG8_BAR; PG8_SCHED;
            PG8_STAGE(PG8_SB(1, 1), b3 + hstep, voffB);
            PG8_WAIT_V(6); PG8_BAR; PG8_MMA(1, 1, At, B1); PG8_BAR;
        }
        if constexpr (!Epi::AFTER_DRAIN) { E(acc, cur, wr, wc, fr, fq); S.done(cur); }
        if (!has_next) break;
#pragma unroll
        for (int a = 0; a < 2; ++a)
#pragma unroll
            for (int b = 0; b < 2; ++b)
#pragma unroll
                for (int m = 0; m < 4; ++m)
#pragma unroll
                    for (int n = 0; n < 2; ++n) acc[a][b][m][n] = (f32x4){0.f, 0.f, 0.f, 0.f};
        cur = nxt; cA = nA; cB = nB; ++ui;
    }
    PG8_WAIT_V(0);
    if (wr == 0) PG8_BAR;
    PG8_BAR;
    if constexpr (Epi::AFTER_DRAIN) { E.fused(acc, cur, wr, wc, fr, fq, lds, wid, lane); S.done(cur); }
#undef PG8_SA
#undef PG8_SB
#undef PG8_STAGE
#undef PG8_LDA
#undef PG8_LDB
#undef PG8_MMA
#undef PG8_WAIT_V
#undef PG8_WAIT_L
#undef PG8_BAR
#undef PG8_SCHED
}

DI unsigned cvt_pk_bf16(float lo, float hi) { return cvt_pk(lo, hi); }
DI float fsig(float x) { return __builtin_amdgcn_rcpf(1.f + __builtin_amdgcn_exp2f(-1.4426950408889634f * x)); }
DI int expert_of_l(const LAS int* ps, int row0) { int e = 0;
#pragma unroll 1
    for (int i = 1; i < NE; ++i) if (row0 >= ps[i]) e = i; return e; }
struct OrderDense {
    int nM, nN, nwg, G, c;
    DI void init(int nM_, int nN_, int G_, int c_) { nM = nM_; nN = nN_; nwg = nM * nN; G = G_; c = c_; }
    DI bool tile(int i, Unit& u) const {
        const long L = (long)i * G + c; if (L >= nwg) return false;
        int wgid = (int)L; { const int q = nwg / NXCD, r = nwg % NXCD, xcd = wgid % NXCD, off = wgid / NXCD; wgid = (xcd < r ? xcd * (q + 1) : r * (q + 1) + (xcd - r) * q) + off; }
        const int nig = WGM * nN, gid = wgid / nig, fm = gid * WGM, gsz = (nM - fm) < WGM ? (nM - fm) : WGM;
        u.pm = fm + ((wgid % nig) % gsz); u.pn = (wgid % nig) / gsz; return true;
    }
    DI bool next(int i, Unit& u) const { if (!tile(i, u)) return false; u.pb = u.pn; u.e = 0; return true; }
    DI void a_ready(const Unit&) const {}
    DI void done(const Unit&) const {}
};
struct OrderGrouped : OrderDense {
    const LAS int* ps;
    DI bool next(int i, Unit& u) const { if (!tile(i, u)) return false; u.e = expert_of_l(ps, u.pm * BM); u.pb = u.e * nN + u.pn; return true; }
};
struct EpiStoreBf16 {
    static constexpr bool PERM = true, AFTER_DRAIN = false;
    bf16_t* O; int ldc; const float* bias; int bstride;
    DI void operator()(const f32x4 (&acc)[2][2][4][2], const Unit& u, int wr, int wc, int fr, int fq) const {
        const int row0 = u.pm * BM + wr * 64 + fr, col0 = u.pn * BM + wc * 32 + 8 * fq;
        f32x4 bv[2][2];
#pragma unroll
        for (int bj = 0; bj < 2; ++bj)
#pragma unroll
            for (int n = 0; n < 2; ++n) bv[bj][n] = bias ? *(const f32x4*)(bias + (size_t)u.e * bstride + col0 + bj * HALF + 4 * n) : (f32x4){0.f, 0.f, 0.f, 0.f};
#pragma unroll
        for (int ai = 0; ai < 2; ++ai)
#pragma unroll
            for (int m = 0; m < 4; ++m) { bf16_t* rowp = O + (size_t)(row0 + ai * HALF + m * 16) * ldc + col0;
#pragma unroll
                for (int bj = 0; bj < 2; ++bj) { const f32x4 v0 = acc[ai][bj][m][0] + bv[bj][0], v1 = acc[ai][bj][m][1] + bv[bj][1];
                    u32x4 w; w.x = cvt_pk_bf16(v0[0], v0[1]); w.y = cvt_pk_bf16(v0[2], v0[3]); w.z = cvt_pk_bf16(v1[0], v1[1]); w.w = cvt_pk_bf16(v1[2], v1[3]);
                    *(u32x4*)(rowp + bj * HALF) = w; } }
    }
};
template <int SECOND> struct EpiMerge {
    static constexpr bool PERM = true, AFTER_DRAIN = false;
    const bf16_t* gate; float* T; bf16_t* O;
    DI void operator()(const f32x4 (&acc)[2][2][4][2], const Unit& u, int wr, int wc, int fr, int fq) const {
        const int row0 = u.pm * BM + wr * 64 + fr, col0 = u.pn * BM + wc * 32 + 8 * fq;
#pragma unroll
        for (int ai = 0; ai < 2; ++ai)
#pragma unroll
            for (int mp = 0; mp < 2; ++mp) {
                u32x4 g[2][2]; f32x4 t0[2][2], t1[2][2];
#pragma unroll
                for (int mm = 0; mm < 2; ++mm)
#pragma unroll
                    for (int bj = 0; bj < 2; ++bj) { const size_t row = (size_t)(row0 + ai * HALF + (2 * mp + mm) * 16); const int col = col0 + bj * HALF;
                        g[mm][bj] = *(const u32x4*)(gate + row * NPJ + col);
                        if (SECOND) { t0[mm][bj] = *(const f32x4*)(T + row * DM + col); t1[mm][bj] = *(const f32x4*)(T + row * DM + col + 4); } }
#pragma unroll
                for (int mm = 0; mm < 2; ++mm)
#pragma unroll
                    for (int bj = 0; bj < 2; ++bj) { const int m = 2 * mp + mm; const size_t row = (size_t)(row0 + ai * HALF + m * 16); const int col = col0 + bj * HALF;
                        const u32x4 gg = g[mm][bj]; f32x4 v0 = acc[ai][bj][m][0], v1 = acc[ai][bj][m][1];
                        v0[0] *= fsig(__uint_as_float(gg.x << 16)); v0[1] *= fsig(__uint_as_float(gg.x & 0xffff0000u)); v0[2] *= fsig(__uint_as_float(gg.y << 16)); v0[3] *= fsig(__uint_as_float(gg.y & 0xffff0000u));
                        v1[0] *= fsig(__uint_as_float(gg.z << 16)); v1[1] *= fsig(__uint_as_float(gg.z & 0xffff0000u)); v1[2] *= fsig(__uint_as_float(gg.w << 16)); v1[3] *= fsig(__uint_as_float(gg.w & 0xffff0000u));
                        if (SECOND == 0) { float* tp = T + row * DM + col; *(f32x4*)tp = v0; *(f32x4*)(tp + 4) = v1; }
                        else { v0 += t0[mm][bj]; v1 += t1[mm][bj];
                            u32x4 w; w.x = cvt_pk_bf16(v0[0], v0[1]); w.y = cvt_pk_bf16(v0[2], v0[3]); w.z = cvt_pk_bf16(v1[0], v1[1]); w.w = cvt_pk_bf16(v1[2], v1[3]);
                            *(u32x4*)(O + row * DM + col) = w; } }
            }
    }
};
struct EpiResid {
    static constexpr bool PERM = false, AFTER_DRAIN = false;
    const float* x; const float* gt; float* X1;
    DI void operator()(const f32x4 (&acc)[2][2][4][2], const Unit& u, int wr, int wc, int fr, int fq) const {
        const int row0 = u.pm * BM + wr * 64 + fr, col0 = u.pn * BM + wc * 32 + 4 * fq;
        f32x4 gv[2][2];
#pragma unroll
        for (int bj = 0; bj < 2; ++bj)
#pragma unroll
            for (int n = 0; n < 2; ++n) gv[bj][n] = *(const f32x4*)(gt + col0 + bj * HALF + n * 16);
#pragma unroll
        for (int ai = 0; ai < 2; ++ai)
#pragma unroll
            for (int mp = 0; mp < 2; ++mp) {
                f32x4 xv[2][2][2];
#pragma unroll
                for (int mm = 0; mm < 2; ++mm)
#pragma unroll
                    for (int bj = 0; bj < 2; ++bj)
#pragma unroll
                        for (int n = 0; n < 2; ++n) xv[mm][bj][n] = *(const f32x4*)(x + (size_t)(row0 + ai * HALF + (2 * mp + mm) * 16) * DM + col0 + bj * HALF + n * 16);
#pragma unroll
                for (int mm = 0; mm < 2; ++mm)
#pragma unroll
                    for (int bj = 0; bj < 2; ++bj)
#pragma unroll
                        for (int n = 0; n < 2; ++n) *(f32x4*)(X1 + (size_t)(row0 + ai * HALF + (2 * mp + mm) * 16) * DM + col0 + bj * HALF + n * 16) = xv[mm][bj][n] + gv[bj][n] * acc[ai][bj][2 * mp + mm][n];
            }
    }
};
struct EpiSwiglu {
    static constexpr bool PERM = true, AFTER_DRAIN = false;
    bf16_t* ACT; const float* bgu;
    DI void operator()(const f32x4 (&acc)[2][2][4][2], const Unit& u, int wr, int wc, int fr, int fq) const {
        const int row0 = u.pm * BM + wr * 64 + fr, gcol = u.pn * HALF + wc * 32 + 8 * fq;
        const float* bb = bgu + (size_t)u.e * 2048 + gcol;
        f32x4 bg[2], bu[2];
#pragma unroll
        for (int n = 0; n < 2; ++n) { bg[n] = *(const f32x4*)(bb + 4 * n); bu[n] = *(const f32x4*)(bb + 1024 + 4 * n); }
#pragma unroll
        for (int ai = 0; ai < 2; ++ai)
#pragma unroll
            for (int m = 0; m < 4; ++m) { float r[8];
#pragma unroll
                for (int n = 0; n < 2; ++n)
#pragma unroll
                    for (int j = 0; j < 4; ++j) { float g = acc[ai][0][m][n][j] + bg[n][j], up = acc[ai][1][m][n][j] + bu[n][j];
                        g = fminf(g, 7.f); up = fminf(fmaxf(up, -7.f), 7.f);
                        r[4 * n + j] = (up + 1.f) * (g * fsig(1.702f * g)); }
                u32x4 w; w.x = cvt_pk_bf16(r[0], r[1]); w.y = cvt_pk_bf16(r[2], r[3]); w.z = cvt_pk_bf16(r[4], r[5]); w.w = cvt_pk_bf16(r[6], r[7]);
                *(u32x4*)(ACT + (size_t)(row0 + ai * HALF + m * 16) * DM + gcol) = w; }
    }
};
}


namespace fox {
typedef float f32x16 __attribute__((ext_vector_type(16)));
typedef short s16x4 __attribute__((ext_vector_type(4)));
constexpr float SCALE = 0.08838834764831845f;
constexpr int KVBLK = 64, SHM_K = 16384, SHM_V = 16384;
constexpr int OFF_V = 0, OFF_K = 2 * SHM_V, OFF_G = OFF_K + 2 * SHM_K, OFF_WS = OFF_G + 512, OFF_MISC = OFF_WS + 8 * 256;
constexpr float THR = 8.f;
#define KSWZ(row, colB) ((row) * 256 + ((colB) ^ (((row) & 7) << 4)))
#define SBAR() __builtin_amdgcn_sched_barrier(0)
DI int v_st(int k, int c) { const int kk = (k & ~0xC) | ((k & 4) << 1) | ((k & 8) >> 1); return ((kk >> 3) * 4 + (c >> 5)) * 512 + ((kk & 7) * 32 + (c & 31)) * 2; }
DI int v_rd_base(int lane) { return ((lane & 3) << 3) | (((lane >> 2) & 3) << 6) | (((lane >> 4) & 1) << 5) | (((lane >> 5) & 1) << 8); }
constexpr int v_rd_off(int d0, int ks, int half) { return d0 * 512 + ks * 4096 + half * 2048; }
DI int crow(int r, int hi) { return (r & 3) + 8 * (r >> 2) + 4 * hi; }
DI unsigned cvtpk(float lo, float hi) { return cvt_pk(lo, hi); }
DI void mask_tile(f32x16& p0, f32x16& p1, int dq) {
    const float NEG = -__builtin_inff();
#pragma unroll
    for (int r = 0; r < 16; ++r) { const int c = (r & 3) + 8 * (r >> 2); if (dq - c < 0) p0[r] = NEG; if (dq - c - 32 < 0) p1[r] = NEG; }
}
DI void partialSM(f32x16& p0, f32x16& p1, float& m_reg, float& mn, float& alpha) {
    float pmax = p0[0];
#pragma unroll
    for (int r = 1; r < 16; ++r) pmax = fmaxf(pmax, p0[r]);
#pragma unroll
    for (int r = 0; r < 16; ++r) pmax = fmaxf(pmax, p1[r]);
    { auto rr = __builtin_amdgcn_permlane32_swap(__float_as_uint(pmax), __float_as_uint(pmax), false, false); pmax = fmaxf(__uint_as_float(rr[0]), __uint_as_float(rr[1])); }
    constexpr float C2 = 1.4426950408889634f * SCALE;
    if (__builtin_expect(__all((pmax - m_reg) * SCALE <= THR), 1)) { mn = m_reg; alpha = 1.f; }
    else { mn = fmaxf(m_reg, pmax); alpha = __builtin_amdgcn_exp2f((m_reg - mn) * C2); m_reg = mn; }
    const float mnL = -mn * C2;
#pragma unroll
    for (int r = 0; r < 16; ++r) p0[r] = fmaf(p0[r], C2, mnL);
#pragma unroll
    for (int r = 0; r < 16; ++r) p1[r] = fmaf(p1[r], C2, mnL);
#pragma unroll
    for (int r = 0; r < 16; ++r) p0[r] = __builtin_amdgcn_exp2f(p0[r]);
}
DI void finishSM(f32x16& p0, f32x16& p1, float alpha, float& l_reg, bf16x8& pa0, bf16x8& pa1, bf16x8& pa2, bf16x8& pa3) {
#pragma unroll
    for (int r = 0; r < 16; ++r) p1[r] = __builtin_amdgcn_exp2f(p1[r]);
    float ps = 0;
#pragma unroll
    for (int r = 0; r < 16; ++r) ps += p0[r];
#pragma unroll
    for (int r = 0; r < 16; ++r) ps += p1[r];
    { auto rr = __builtin_amdgcn_permlane32_swap(__float_as_uint(ps), __float_as_uint(ps), false, false); ps = __uint_as_float(rr[0]) + __uint_as_float(rr[1]); }
    l_reg = l_reg * alpha + ps;
#define PK4(P, B_, OUT) do { unsigned a0 = cvtpk(P[B_+0], P[B_+1]), a1 = cvtpk(P[B_+2], P[B_+3]);                          \
        unsigned b0 = cvtpk(P[B_+4], P[B_+5]), b1 = cvtpk(P[B_+6], P[B_+7]);                                             \
        auto r0 = __builtin_amdgcn_permlane32_swap(a0, b0, false, false); auto r1 = __builtin_amdgcn_permlane32_swap(a1, b1, false, false); \
        u32x4 w = {r0[0], r1[0], r0[1], r1[1]}; OUT = *reinterpret_cast<bf16x8*>(&w); } while (0)
    PK4(p0, 0, pa0); PK4(p0, 8, pa1); PK4(p1, 0, pa2); PK4(p1, 8, pa3);
#undef PK4
}
DI void qkt(f32x16& p0, f32x16& p1, const char* Kb, int r32, int hi, const bf16x8* qr) {
    p0 = f32x16{}; p1 = f32x16{};
    const char* kb[4];
#pragma unroll
    for (int dd = 0; dd < 4; ++dd) kb[dd] = Kb + KSWZ(r32, (dd * 16 + hi * 8) * 2);
#pragma unroll
    for (int d0 = 0; d0 < 8; ++d0) { const char* a = kb[d0 & 3] + (d0 >> 2) * 128;
        bf16x8 b0 = *reinterpret_cast<const bf16x8*>(a);
        bf16x8 b1 = *reinterpret_cast<const bf16x8*>(a + 32 * 256);
        p0 = __builtin_amdgcn_mfma_f32_32x32x16_bf16(b0, qr[d0], p0, 0, 0, 0);
        p1 = __builtin_amdgcn_mfma_f32_32x32x16_bf16(b1, qr[d0], p1, 0, 0, 0); }
}
DI void pv_tile(f32x16* o, int vb0, bf16x8 pa0, bf16x8 pa1, bf16x8 pa2, bf16x8 pa3) {
#define TRRD(dst, off) asm volatile("ds_read_b64_tr_b16 %0, %1 offset:%2" : "=&v"(dst) : "v"(vb0), "i"(off) : "memory")
#define PV_D0(d0) do { s16x4 l0, l1, l2, l3, h0, h1, h2, h3; constexpr int b_ = v_rd_off(d0, 0, 0); \
        TRRD(l0, b_); TRRD(h0, b_ + 2048); TRRD(l1, b_ + 4096); TRRD(h1, b_ + 6144); TRRD(l2, b_ + 8192); TRRD(h2, b_ + 10240); TRRD(l3, b_ + 12288); TRRD(h3, b_ + 14336); \
        asm volatile("s_waitcnt lgkmcnt(0)" ::: "memory"); SBAR();   \
        o[d0] = __builtin_amdgcn_mfma_f32_32x32x16_bf16(pa0, (bf16x8){l0[0], l0[1], l0[2], l0[3], h0[0], h0[1], h0[2], h0[3]}, o[d0], 0, 0, 0);   \
        o[d0] = __builtin_amdgcn_mfma_f32_32x32x16_bf16(pa1, (bf16x8){l1[0], l1[1], l1[2], l1[3], h1[0], h1[1], h1[2], h1[3]}, o[d0], 0, 0, 0);   \
        o[d0] = __builtin_amdgcn_mfma_f32_32x32x16_bf16(pa2, (bf16x8){l2[0], l2[1], l2[2], l2[3], h2[0], h2[1], h2[2], h2[3]}, o[d0], 0, 0, 0);   \
        o[d0] = __builtin_amdgcn_mfma_f32_32x32x16_bf16(pa3, (bf16x8){l3[0], l3[1], l3[2], l3[3], h3[0], h3[1], h3[2], h3[3]}, o[d0], 0, 0, 0); } while (0)
    PV_D0(0); PV_D0(1); PV_D0(2); PV_D0(3);
#undef PV_D0
#undef TRRD
}
DI void fox_block(const Args& a, char* lds, int h, int P0, int j_lo) {
    const int tid = threadIdx.x, wid = __builtin_amdgcn_readfirstlane(tid >> 6), lane = tid & 63, r32 = lane & 31, hi = lane >> 5;
    const bf16_t* P = (const bf16_t*)(a.ws + WS_PROJ); const float* F = (const float*)(a.ws + WS_F) + (size_t)h * SEQ; bf16_t* OB = (bf16_t*)(a.ws + WS_OB);
    const bf16_t* Qp = P + PJ_FQ + h * 128; const bf16_t* Kp = P + PJ_FK + h * 128; const bf16_t* Vp = P + PJ_FV + h * 128;
    const int j_hi = (P0 + 255) / KVBLK + 1, NT = j_hi - j_lo;
    const int qlo = P0 + wid * 32, qm = qlo + r32 - 4 * hi;
    char* V_lds = lds + OFF_V; char* K_lds = lds + OFF_K; float* G_lds = (float*)(lds + OFF_G);
    float* wsp = (float*)(lds + OFF_WS) + wid * 64; float* li_l = wsp; float* al_l = wsp + 32;
    const int sr = tid >> 4, sc = (tid & 15) * 8, vst0 = v_st(sr, sc), vst1 = v_st(32 + sr, sc), kws = KSWZ(sr, sc * 2);
    const int vb0 = (int)(unsigned)(uintptr_t)(LAS char*)V_lds + v_rd_base(lane);
    const float Fref = F[P0];
    bf16x8 qr[8];
#pragma unroll
    for (int d0 = 0; d0 < 8; ++d0) qr[d0] = *(const bf16x8*)(Qp + (size_t)(qlo + r32) * NPJ + d0 * 16 + hi * 8);
    float m_reg = -1e30f, l_reg = 0.f; f32x16 o[4] = {};
    bf16x8 st_k0, st_k1, st_v0, st_v1; float st_g = 0.f;
#define FOX_LOAD(t) do { const size_t k0_ = (size_t)(j_lo + (t)) * KVBLK; \
        st_k0 = *(const bf16x8*)(Kp + (k0_ + sr) * NPJ + sc); st_k1 = *(const bf16x8*)(Kp + (k0_ + 32 + sr) * NPJ + sc); \
        st_v0 = *(const bf16x8*)(Vp + (k0_ + sr) * NPJ + sc); st_v1 = *(const bf16x8*)(Vp + (k0_ + 32 + sr) * NPJ + sc); \
        if (tid < 64) st_g = F[k0_ + tid]; } while (0)
#define FOX_WRITE(bf) do { *(bf16x8*)(K_lds + (bf) * SHM_K + kws) = st_k0; *(bf16x8*)(K_lds + (bf) * SHM_K + kws + 32 * 256) = st_k1; \
        *(bf16x8*)(V_lds + (bf) * SHM_V + vst0) = st_v0; *(bf16x8*)(V_lds + (bf) * SHM_V + vst1) = st_v1; \
        if (tid < 64) G_lds[(bf) * 64 + tid] = (st_g - Fref) * (1.f / SCALE); } while (0)
    FOX_LOAD(0); asm volatile("s_waitcnt vmcnt(0)" ::: "memory"); FOX_WRITE(0);
    __syncthreads();
    for (int t = 0; t < NT; ++t) {
        const int bf = t & 1, kb_ = (j_lo + t) * KVBLK;
        if (t + 1 < NT) FOX_LOAD(t + 1);
        if (kb_ <= qlo + 31) {
            f32x16 p0, p1; float mn, al; bf16x8 pa0, pa1, pa2, pa3;
            qkt(p0, p1, K_lds + bf * SHM_K, r32, hi, qr);
            const float* gt = G_lds + bf * 64 + 4 * hi;
#pragma unroll
            for (int g4 = 0; g4 < 4; ++g4) { const f32x4 g0 = *(const f32x4*)(gt + 8 * g4), g1 = *(const f32x4*)(gt + 32 + 8 * g4);
#pragma unroll
                for (int i = 0; i < 4; ++i) { p0[4 * g4 + i] -= g0[i]; p1[4 * g4 + i] -= g1[i]; } }
            if (kb_ + KVBLK - 1 > qlo) mask_tile(p0, p1, qm - kb_);
            partialSM(p0, p1, m_reg, mn, al);
            finishSM(p0, p1, al, l_reg, pa0, pa1, pa2, pa3);
            if (__any(al < 1.f)) { if (hi == 0) al_l[r32] = al; asm volatile("s_waitcnt lgkmcnt(0)" ::: "memory");
#pragma unroll
                for (int d_ = 0; d_ < 4; ++d_)
#pragma unroll
                    for (int r = 0; r < 16; ++r) o[d_][r] *= al_l[crow(r, hi)]; }
            SBAR();
            pv_tile(o, vb0 + bf * SHM_V, pa0, pa1, pa2, pa3);
        }
        if (t + 1 < NT) { asm volatile("s_waitcnt vmcnt(0)" ::: "memory"); FOX_WRITE(bf ^ 1); }
        __syncthreads();
    }
#undef FOX_LOAD
#undef FOX_WRITE
    if (hi == 0) li_l[r32] = l_reg;
    asm volatile("s_waitcnt lgkmcnt(0)" ::: "memory");
    bf16_t* Ow = OB + (size_t)qlo * 512 + h * 128;
#pragma unroll
    for (int r = 0; r < 16; ++r) { const int orow = crow(r, hi); const float rl = __builtin_amdgcn_rcpf(li_l[orow]);
#pragma unroll
        for (int d0 = 0; d0 < 4; ++d0) { const float v = o[d0][r] * rl; const float vn = __shfl_xor(v, 1);
            if ((r32 & 1) == 0) *(unsigned*)(Ow + (size_t)orow * 512 + d0 * 32 + r32) = cvtpk(v, vn); } }
    __syncthreads();
}
#undef KSWZ
}

DI void transpose_tile(float* tile, const float* src, int ld, int k0, int c0, int c1, bf16_t* dst, int Kd) {
    const int tid = threadIdx.x;
    __syncthreads();
#pragma unroll
    for (int i = 0; i < 8; ++i) { const int kk = (tid >> 6) + 8 * i, nn = tid & 63; const int col = nn < 32 ? c0 + nn : c1 + nn - 32; tile[kk * 65 + nn] = src[(size_t)(k0 + kk) * ld + col]; }
    __syncthreads();
    const int nn = tid >> 3, kc = (tid & 7) * 8;
    u32x4 w;
    w.x = pk2(tile[(kc + 0) * 65 + nn], tile[(kc + 1) * 65 + nn]); w.y = pk2(tile[(kc + 2) * 65 + nn], tile[(kc + 3) * 65 + nn]);
    w.z = pk2(tile[(kc + 4) * 65 + nn], tile[(kc + 5) * 65 + nn]); w.w = pk2(tile[(kc + 6) * 65 + nn], tile[(kc + 7) * 65 + nn]);
    *(u32x4*)(dst + (size_t)nn * Kd + k0 + kc) = w;
}
DI void ph0(const Args& a, float* lds) {
    const int tid = threadIdx.x, G = gridDim.x, bx = blockIdx.x;
    unsigned char* ws = a.ws;
    if (bx < 12) {
        const int j = bx * 512 + tid; const float* c = a.in[I_C]; const float* w = a.in[I_WADA];
        float acc = a.in[I_BADA][j];
        for (int k = 0; k < DM; ++k) acc += c[k] * w[(size_t)k * 6144 + j];
        ((float*)(ws + WS_MOD))[j] = acc;
    }
    constexpr int T_WIN = 88 * 16, T_WOA = 16 * 8, T_WOUT = 16 * 16, T_WGU = 32 * 32 * 16, T_WD = 32 * 16 * 16;
    constexpr int NT = T_WIN + 2 * T_WOA + T_WOUT + T_WGU + T_WD;
    for (int t = bx; t < NT; t += G) {
        int r = t;
        if (r < T_WIN) { const int nt = r / 16, kt = r % 16, n0 = nt * 64; const int c0 = n0 + (n0 >= 3584 ? 12 : (n0 >= 2048 ? 8 : 0));
            transpose_tile(lds, a.in[I_WIN], NIN, kt * 64, c0, c0 + 32, (bf16_t*)(ws + WS_WINT) + (size_t)n0 * DM, DM); continue; }
        r -= T_WIN;
        if (r < T_WOA) { const int nt = r / 8, kt = r % 8, n0 = nt * 64; transpose_tile(lds, a.in[I_WOD], DM, kt * 64, n0, n0 + 32, (bf16_t*)(ws + WS_WOAT) + (size_t)n0 * 512, 512); continue; }
        r -= T_WOA;
        if (r < T_WOA) { const int nt = r / 8, kt = r % 8, n0 = nt * 64; transpose_tile(lds, a.in[I_WOF], DM, kt * 64, n0, n0 + 32, (bf16_t*)(ws + WS_WOBT) + (size_t)n0 * 512, 512); continue; }
        r -= T_WOA;
        if (r < T_WOUT) { const int nt = r / 16, kt = r % 16, n0 = nt * 64; transpose_tile(lds, a.in[I_WOUT], DM, kt * 64, n0, n0 + 32, (bf16_t*)(ws + WS_WOUTT) + (size_t)n0 * DM, DM); continue; }
        r -= T_WOUT;
        if (r < T_WGU) { const int e = r / 512, q = r % 512, nt = q / 16, kt = q % 16, n0 = nt * 64;
            transpose_tile(lds, a.in[I_WGU] + (size_t)e * DM * 2048, 2048, kt * 64, gu_src(n0), gu_src(n0 + 32), (bf16_t*)(ws + WS_WGUT) + ((size_t)e * 2048 + n0) * DM, DM); continue; }
        r -= T_WGU;
        { const int e = r / 256, q = r % 256, nt = q / 16, kt = q % 16, n0 = nt * 64;
            transpose_tile(lds, a.in[I_WD] + (size_t)e * DM * DM, DM, kt * 64, n0, n0 + 32, (bf16_t*)(ws + WS_WDT) + ((size_t)e * DM + n0) * DM, DM); }
    }
}

DI void ph1(const Args& a, float* lds) {
    const int tid = threadIdx.x, lane = tid & 63, wave = tid >> 6, G = gridDim.x;
    float* A1 = lds; float* B1 = lds + 1024; float* wsm = lds + 2048;
    const float* mod = (const float*)(a.ws + WS_MOD);
    for (int k = tid; k < DM; k += NTHREADS) { A1[k] = a.in[I_G1][k] * (1.f + mod[1024 + k]); B1[k] = mod[k]; }
    for (int i = tid; i < 12 * DM; i += NTHREADS) { const int k = i / 12, j = i % 12; wsm[j * DM + k] = a.in[I_WIN][(size_t)k * NIN + (j < 8 ? 2048 + j : 3592 + (j - 8))]; }
    __syncthreads();
    bf16_t* H = (bf16_t*)(a.ws + WS_H); float* SP = (float*)(a.ws + WS_SP);
    for (int t = blockIdx.x * NWAVES + wave; t < SEQ; t += G * NWAVES) {
        const float* xr = a.in[I_X] + (size_t)t * DM;
        f32x4 v[4]; float ss = 0.f;
#pragma unroll
        for (int i = 0; i < 4; ++i) { v[i] = *(const f32x4*)(xr + lane * 4 + 256 * i); ss += v[i][0] * v[i][0] + v[i][1] * v[i][1] + v[i][2] * v[i][2] + v[i][3] * v[i][3]; }
        ss = wave_sum(ss);
        const float rstd = rsqrtf(ss * (1.f / DM) + 1e-6f);
#pragma unroll
        for (int i = 0; i < 4; ++i) { const int k = lane * 4 + 256 * i;
#pragma unroll
            for (int e = 0; e < 4; ++e) v[i][e] = v[i][e] * rstd * A1[k + e] + B1[k + e];
            u32x2 w; w.x = pk2(v[i][0], v[i][1]); w.y = pk2(v[i][2], v[i][3]);
            *(u32x2*)(H + (size_t)t * DM + k) = w; }
#pragma unroll 1
        for (int j = 0; j < 12; ++j) { float pj = 0.f;
#pragma unroll
            for (int i = 0; i < 4; ++i) { const f32x4 wv = *(const f32x4*)(wsm + j * DM + lane * 4 + 256 * i); pj += v[i][0] * wv[0] + v[i][1] * wv[1] + v[i][2] * wv[2] + v[i][3] * wv[3]; }
            const float s = wave_sum(pj); if (lane == j) SP[(size_t)t * 16 + j] = s; }
    }
}

DI void ph2(const Args& a, unsigned char* ldsb) {
    pg8::Gemm g{(const bf16_t*)(a.ws + WS_H), (const bf16_t*)(a.ws + WS_WINT), SEQ, NPJ, DM};
    pg8::OrderDense S; S.init(SEQ / 256, NPJ / 256, (int)gridDim.x, (int)blockIdx.x);
    pg8::EpiStoreBf16 E{(bf16_t*)(a.ws + WS_PROJ), NPJ, nullptr, 0};
    pg8::gemm_phase<pg8::EpiStoreBf16, pg8::OrderDense>((LAS unsigned char*)ldsb, g, S, E);
}

DI void ph3_fcum(const Args& a, float* lds) {
    const int tid = threadIdx.x, h = blockIdx.x;
    const float* SP = (const float*)(a.ws + WS_SP); float* F = (float*)(a.ws + WS_F);
    const float bf = a.in[I_BFG][h];
    double* part = (double*)lds;
    double s = 0.0;
    for (int i = 0; i < 32; ++i) s += (double)logsigf(SP[(size_t)(tid * 32 + i) * 16 + 8 + h] + bf);
    part[tid] = s;
    __syncthreads();
    double off = 0.0;
    for (int i = 0; i < tid; ++i) off += part[i];
    for (int i = 0; i < 32; ++i) { off += (double)logsigf(SP[(size_t)(tid * 32 + i) * 16 + 8 + h] + bf); F[(size_t)h * SEQ + tid * 32 + i] = (float)off; }
    __syncthreads();
}
DI void ph3_prep(const Args& a, float* lds, int unit) {
    const int tid = threadIdx.x, lane = tid & 63, wave = tid >> 6;
    const int h = unit & 3, n = unit >> 2, t0 = n * CH;
    float* qs = lds; float* ks = qs + 64 * 129; float* vs = ks + 64 * 129;
    float* Ls = vs + 64 * 129; float* As = Ls + 64 * 65; float* Ts = As + 64 * 65;
    float* gcs = Ts + 64 * 65; float* bes = gcs + 64; float* gs = bes + 64;
    const float* SP = (const float*)(a.ws + WS_SP); const bf16_t* P = (const bf16_t*)(a.ws + WS_PROJ);
    __syncthreads();
    if (tid < 64) { const int t = t0 + tid;
        bes[tid] = sigm(SP[(size_t)t * 16 + h]);
        gs[tid] = -expf(a.in[I_ALOG][h]) * softplusf(SP[(size_t)t * 16 + 4 + h] + a.in[I_DTB][h]); }
    const float* cw = a.in[I_CONVW];
#pragma unroll 1
    for (int sec = 0; sec < 3; ++sec) {
        float* dst = sec == 0 ? qs : (sec == 1 ? ks : vs);
        const int d = tid & 127, col = sec * 512 + h * 128 + d;
        const float w0 = cw[0 * 1536 + col], w1 = cw[1 * 1536 + col], w2 = cw[2 * 1536 + col], w3 = cw[3 * 1536 + col];
        for (int i = 0; i < 16; ++i) { const int c = (tid >> 7) + 4 * i, t = t0 + c;
            float acc = w3 * bf2f(P[(size_t)t * NPJ + col]);
            if (t >= 1) acc += w2 * bf2f(P[(size_t)(t - 1) * NPJ + col]);
            if (t >= 2) acc += w1 * bf2f(P[(size_t)(t - 2) * NPJ + col]);
            if (t >= 3) acc += w0 * bf2f(P[(size_t)(t - 3) * NPJ + col]);
            dst[c * 129 + d] = siluf(acc); }
    }
    __syncthreads();
    if (tid == 0) { float s = 0.f; for (int c = 0; c < 64; ++c) { s += gs[c]; gcs[c] = s; } }
    for (int i = 0; i < 16; ++i) { const int r = wave * 16 + i; float* row = (r < 64 ? qs + r * 129 : ks + (r - 64) * 129);
        const float x0 = row[lane], x1 = row[lane + 64]; const float ss = wave_sum(x0 * x0 + x1 * x1);
        const float sc = rsqrtf(ss + 1e-6f) * (r < 64 ? 0.08838834764831845f : 1.f);
        row[lane] = x0 * sc; row[lane + 64] = x1 * sc; }
    __syncthreads();
    { const int m = tid & 63;
        for (int i = 0; i < 8; ++i) { const int c = (tid >> 6) + 8 * i; float kk = 0.f, qk = 0.f;
            for (int d = 0; d < 128; ++d) { const float km = ks[m * 129 + d]; kk += ks[c * 129 + d] * km; qk += qs[c * 129 + d] * km; }
            const float dec = (m <= c) ? expf(gcs[c] - gcs[m]) : 0.f;
            Ls[c * 65 + m] = (m < c) ? bes[c] * kk * dec : 0.f;
            As[c * 65 + m] = (m <= c) ? qk * dec : 0.f; } }
    __syncthreads();
    if (wave == 0) {
        for (int c = 0; c < 64; ++c) { float acc = (lane == c) ? 1.f : 0.f;
            for (int m = 0; m < c; ++m) acc -= Ls[c * 65 + m] * Ts[m * 65 + lane];
            Ts[c * 65 + lane] = acc;
            asm volatile("s_waitcnt lgkmcnt(0)" ::: "memory"); }
    }
    __syncthreads();
    bf16_t* WF = (bf16_t*)(a.ws + WS_DNW) + (size_t)(h * NCH + n) * 8192; bf16_t* UF = (bf16_t*)(a.ws + WS_DNU) + (size_t)(h * NCH + n) * 8192;
    bf16_t* QF = (bf16_t*)(a.ws + WS_DNQD) + (size_t)(h * NCH + n) * 8192; bf16_t* KF = (bf16_t*)(a.ws + WS_DNKD) + (size_t)(h * NCH + n) * 8192;
    bf16_t* AF = (bf16_t*)(a.ws + WS_DNATT) + (size_t)(h * NCH + n) * 4096;
    { const int d = tid & 127; const float glast = gcs[63];
        for (int i = 0; i < 16; ++i) { const int c = (tid >> 7) + 4 * i; float uu = 0.f, ww = 0.f;
            for (int m = 0; m <= c; ++m) { const float tb = Ts[c * 65 + m] * bes[m]; uu += tb * vs[m * 129 + d]; ww += tb * expf(gcs[m]) * ks[m * 129 + d]; }
            const int d32 = d & 31, c32 = c & 31;
            const int iw = (((c >> 4) * 4 + (d >> 5)) * 64 + ((d32 >> 2) & 3) * 16 + (c & 15)) * 8 + 4 * (d32 >> 4) + (d32 & 3);
            const int ik = (((d >> 4) * 2 + (c >> 5)) * 64 + ((c32 >> 2) & 3) * 16 + (d & 15)) * 8 + 4 * (c32 >> 4) + (c32 & 3);
            const int iu = (((d >> 4) * 4 + (c >> 4)) * 64 + ((c & 15) >> 2) * 16 + (d & 15)) * 4 + (c & 3);
            UF[iu] = f2bf(uu); WF[iw] = f2bf(-ww);
            QF[iw] = f2bf(qs[c * 129 + d] * expf(gcs[c])); KF[ik] = f2bf(ks[c * 129 + d] * expf(glast - gcs[c])); } }
    for (int i = tid; i < 64 * 64; i += NTHREADS) { const int c = i >> 6, c2 = i & 63, c32 = c2 & 31;
        AF[(((c >> 4) * 2 + (c2 >> 5)) * 64 + ((c32 >> 2) & 3) * 16 + (c & 15)) * 8 + 4 * (c32 >> 4) + (c32 & 3)] = f2bf(As[c * 65 + c2]); }
    if (tid == 0) ((float*)(a.ws + WS_EG))[h * NCH + n] = expf(gcs[63]);
}
DI void ph3_norms(const Args& a) {
    const int lane = threadIdx.x & 63, wave = threadIdx.x >> 6, NW = gridDim.x * NWAVES;
    const bf16_t* P = (const bf16_t*)(a.ws + WS_PROJ); unsigned* NRM = (unsigned*)(a.ws + WS_NRM);
    float mq = 0.f, mk = 0.f; const int gw = blockIdx.x * NWAVES + wave, h = gw & 3;
    for (int id = gw; id < SEQ * 4; id += NW) { const int t = id >> 2; const bf16_t* row = P + (size_t)t * NPJ + h * 128;
        const float q0 = bf2f(row[PJ_FQ + lane]), q1 = bf2f(row[PJ_FQ + 64 + lane]), k0 = bf2f(row[PJ_FK + lane]), k1 = bf2f(row[PJ_FK + 64 + lane]);
        mq = fmaxf(mq, wave_sum(q0 * q0 + q1 * q1)); mk = fmaxf(mk, wave_sum(k0 * k0 + k1 * k1)); }
    if ((NW & 3) == 0 && lane == 0) { atomicMax(&NRM[h], __float_as_uint(mq)); atomicMax(&NRM[4 + h], __float_as_uint(mk)); }
}
DI void ph3(const Args& a, float* lds) {
    const int G = gridDim.x;
    if (blockIdx.x < 4) ph3_fcum(a, lds);
    for (int u = blockIdx.x; u < NH * NCH; u += G) ph3_prep(a, lds, u);
    ph3_norms(a);
}

namespace dn {
DI unsigned cvtpk(float lo, float hi) { return cvt_pk(lo, hi); }
DI bf16x8 packB(const f32x4& t0, const f32x4& t1) { u32x4 w = {cvtpk(t0[0], t0[1]), cvtpk(t0[2], t0[3]), cvtpk(t1[0], t1[1]), cvtpk(t1[2], t1[3])}; return *reinterpret_cast<bf16x8*>(&w); }
DI bf16x8 frag(const bf16_t* base, int f, int lane) { return *(const bf16x8*)(base + ((size_t)f * 64 + lane) * 8); }
template <bool WITH_U, bool WITH_O>
DI void step(const bf16_t* WFn, const bf16_t* KFn, const bf16_t* QFn, const bf16_t* AFn, const bf16_t* UFs, float eg, f32x4 (&S)[8], f32x4 (&o)[4], int lane) {
    bf16x8 sb[4];
#pragma unroll
    for (int s = 0; s < 4; ++s) sb[s] = packB(S[2 * s], S[2 * s + 1]);
    f32x4 vn[4];
#pragma unroll
    for (int mt = 0; mt < 4; ++mt) {
        if (WITH_U) { const u32x2 w = *(const u32x2*)(UFs + ((size_t)mt * 64 + lane) * 4); vn[mt] = (f32x4){__uint_as_float(w.x << 16), __uint_as_float(w.x & 0xffff0000u), __uint_as_float(w.y << 16), __uint_as_float(w.y & 0xffff0000u)}; }
        else vn[mt] = (f32x4){0.f, 0.f, 0.f, 0.f};
#pragma unroll
        for (int s = 0; s < 4; ++s) vn[mt] = MFMA16(frag(WFn, mt * 4 + s, lane), sb[s], vn[mt]); }
    if (WITH_O) {
#pragma unroll
        for (int mt = 0; mt < 4; ++mt) { o[mt] = (f32x4){0.f, 0.f, 0.f, 0.f};
#pragma unroll
            for (int s = 0; s < 4; ++s) o[mt] = MFMA16(frag(QFn, mt * 4 + s, lane), sb[s], o[mt]); } }
    bf16x8 vb[2];
#pragma unroll
    for (int s = 0; s < 2; ++s) vb[s] = packB(vn[2 * s], vn[2 * s + 1]);
    if (WITH_O) {
#pragma unroll
        for (int mt = 0; mt < 4; ++mt)
#pragma unroll
            for (int s = 0; s < 2; ++s) o[mt] = MFMA16(frag(AFn, mt * 2 + s, lane), vb[s], o[mt]); }
#pragma unroll
    for (int mt = 0; mt < 8; ++mt) { S[mt] = S[mt] * eg;
#pragma unroll
        for (int s = 0; s < 2; ++s) S[mt] = MFMA16(frag(KFn, mt * 2 + s, lane), vb[s], S[mt]); }
}
}
constexpr int NGRP = 16, GRP = 16;
DI void scanA(const Args& a) {
    const int lane = threadIdx.x & 63, wave = threadIdx.x >> 6, lr = lane & 15, lq = lane >> 4;
    if (wave >= 4) return;
    for (int task = blockIdx.x * 4 + wave; task < NH * NGRP * 16; task += gridDim.x * 4) {
        const int chain = task >> 4, sl = task & 15, h = chain >> 4, g = chain & 15; const bool isP = sl >= 8; const int vs = sl & 7;
        f32x4 S[8], o[4];
#pragma unroll
        for (int mt = 0; mt < 8; ++mt)
#pragma unroll
            for (int r = 0; r < 4; ++r) S[mt][r] = (isP && (16 * mt + 4 * lq + r == 16 * vs + lr)) ? 1.f : 0.f;
        for (int n = g * GRP; n < (g + 1) * GRP; ++n) { const size_t cb = (size_t)(h * NCH + n);
            const bf16_t* WFn = (const bf16_t*)(a.ws + WS_DNW) + cb * 8192; const bf16_t* KFn = (const bf16_t*)(a.ws + WS_DNKD) + cb * 8192;
            const bf16_t* UFs = (const bf16_t*)(a.ws + WS_DNU) + cb * 8192 + (size_t)vs * 1024; const float eg = ((const float*)(a.ws + WS_EG))[cb];
            if (isP) dn::step<false, false>(WFn, KFn, nullptr, nullptr, nullptr, eg, S, o, lane);
            else dn::step<true, false>(WFn, KFn, nullptr, nullptr, UFs, eg, S, o, lane); }
        if (isP) { bf16_t* PG = (bf16_t*)(a.ws + WS_PG) + (size_t)chain * 16384;
#pragma unroll
            for (int mt = 0; mt < 8; ++mt)
#pragma unroll
                for (int r = 0; r < 4; ++r) PG[((mt * 4 + (vs >> 1)) * 64 + (lr >> 2) * 16 + 4 * lq + r) * 8 + 4 * (vs & 1) + (lr & 3)] = f2bf(S[mt][r]); }
        else { float* QG = (float*)(a.ws + WS_QG) + ((size_t)chain * 8 + vs) * 2048;
#pragma unroll
            for (int mt = 0; mt < 8; ++mt) *(f32x4*)(QG + ((size_t)mt * 64 + lane) * 4) = S[mt]; }
    }
}
DI void scanB(const Args& a) {
    const int lane = threadIdx.x & 63, wave = threadIdx.x >> 6;
    if (wave != 0 || blockIdx.x >= NH * 8) return;
    const int h = blockIdx.x >> 3, vs = blockIdx.x & 7;
    f32x4 S[8];
#pragma unroll
    for (int mt = 0; mt < 8; ++mt) S[mt] = (f32x4){0.f, 0.f, 0.f, 0.f};
    for (int g = 0; g < NGRP; ++g) { const size_t chain = (size_t)(h * NGRP + g);
        float* SG = (float*)(a.ws + WS_SG) + (chain * 8 + vs) * 2048; const float* QG = (const float*)(a.ws + WS_QG) + (chain * 8 + vs) * 2048;
        const bf16_t* PG = (const bf16_t*)(a.ws + WS_PG) + chain * 16384;
        bf16x8 sb[4];
#pragma unroll
        for (int s = 0; s < 4; ++s) sb[s] = dn::packB(S[2 * s], S[2 * s + 1]);
#pragma unroll
        for (int mt = 0; mt < 8; ++mt) { *(f32x4*)(SG + ((size_t)mt * 64 + lane) * 4) = S[mt];
            f32x4 acc = *(const f32x4*)(QG + ((size_t)mt * 64 + lane) * 4);
#pragma unroll
            for (int s = 0; s < 4; ++s) acc = MFMA16(dn::frag(PG, mt * 4 + s, lane), sb[s], acc);
            S[mt] = acc; }
    }
}
DI void scanC(const Args& a) {
    const int lane = threadIdx.x & 63, wave = threadIdx.x >> 6, lr = lane & 15, lq = lane >> 4;
    if (wave >= 2) return;
    float* ORAW = (float*)(a.ws + WS_ORAW);
    for (int task = blockIdx.x * 2 + wave; task < NH * NGRP * 8; task += gridDim.x * 2) {
        const int chain = task >> 3, vs = task & 7, h = chain >> 4, g = chain & 15;
        const float* SG = (const float*)(a.ws + WS_SG) + ((size_t)chain * 8 + vs) * 2048;
        f32x4 S[8], o[4];
#pragma unroll
        for (int mt = 0; mt < 8; ++mt) S[mt] = *(const f32x4*)(SG + ((size_t)mt * 64 + lane) * 4);
        for (int n = g * GRP; n < (g + 1) * GRP; ++n) { const size_t cb = (size_t)(h * NCH + n);
            const bf16_t* WFn = (const bf16_t*)(a.ws + WS_DNW) + cb * 8192; const bf16_t* KFn = (const bf16_t*)(a.ws + WS_DNKD) + cb * 8192;
            const bf16_t* QFn = (const bf16_t*)(a.ws + WS_DNQD) + cb * 8192; const bf16_t* AFn = (const bf16_t*)(a.ws + WS_DNATT) + cb * 4096;
            const bf16_t* UFs = (const bf16_t*)(a.ws + WS_DNU) + cb * 8192 + (size_t)vs * 1024; const float eg = ((const float*)(a.ws + WS_EG))[cb];
            dn::step<true, true>(WFn, KFn, QFn, AFn, UFs, eg, S, o, lane);
#pragma unroll
            for (int mt = 0; mt < 4; ++mt)
#pragma unroll
                for (int r = 0; r < 4; ++r) ORAW[(size_t)(n * CH + 16 * mt + 4 * lq + r) * 512 + h * 128 + 16 * vs + lr] = o[mt][r]; }
    }
}
DI void ph4_fox(const Args& a, char* lds) {
    const int tid = threadIdx.x, lane = tid & 63, wave = tid >> 6;
    const float* F = (const float*)(a.ws + WS_F); const unsigned* NRM = (const unsigned*)(a.ws + WS_NRM); unsigned* QH = (unsigned*)(a.ws + WS_QH);
    int* misc = (int*)(lds + fox::OFF_MISC);
    int ord0 = 0, ord1 = 1, ord2 = 2, ord3 = 3;
    { float r0 = -F[0 * SEQ + SEQ - 1], r1 = -F[1 * SEQ + SEQ - 1], r2 = -F[2 * SEQ + SEQ - 1], r3 = -F[3 * SEQ + SEQ - 1];
#define CSWAP(ra, rb, oa, ob) if (rb < ra) { const float tf = ra; ra = rb; rb = tf; const int ti = oa; oa = ob; ob = ti; }
      CSWAP(r0, r1, ord0, ord1) CSWAP(r2, r3, ord2, ord3) CSWAP(r0, r2, ord0, ord2) CSWAP(r1, r3, ord1, ord3) CSWAP(r1, r2, ord1, ord2)
#undef CSWAP
    }
    for (;;) {
        __syncthreads();
        if (tid == 0) misc[0] = (int)atomicAdd(QH, 1u);
        __syncthreads();
        const int it = misc[0];
        if (it >= 256) break;
        const int hsel = it >> 6, h = hsel == 0 ? ord0 : (hsel == 1 ? ord1 : (hsel == 2 ? ord2 : ord3)), qb = 63 - (it & 63), P0 = qb * 256;
        if (wave == 0) {
            const float* Fh = F + (size_t)h * SEQ;
            const float qkb = sqrtf(__uint_as_float(NRM[h]) * __uint_as_float(NRM[4 + h])) * fox::SCALE, lim = Fh[P0] + 2.f * qkb + 32.f;
            const int jd = P0 / 64, stride = jd / 64 + 1;
            int j = lane * stride; bool ok = (j > jd) ? true : (Fh[64 * j + 63] <= lim);
            unsigned long long mk = __ballot(ok); const int first = mk ? __builtin_ctzll(mk) : 64;
            const int lo_ex = first == 0 ? -1 : (first - 1) * stride; int hi_in = (first < 64 && first * stride <= jd) ? first * stride : jd;
            j = lo_ex + 1 + lane; ok = (j < hi_in) ? (Fh[64 * j + 63] <= lim) : false;
            mk = __ballot(ok); const int jlo = mk ? lo_ex + 1 + __builtin_ctzll(mk) : hi_in;
            if (lane == 0) misc[1] = jlo;
        }
        __syncthreads();
        fox::fox_block(a, lds, h, P0, misc[1]);
    }
}
DI void ph4(const Args& a, float* lds) {
    scanA(a);
    ph4_fox(a, (char*)lds);
}

DI void ph5(const Args& a) {
    const int lane = threadIdx.x & 63, wave = threadIdx.x >> 6, NW = gridDim.x * NWAVES;
    const float* ORAW = (const float*)(a.ws + WS_ORAW); const bf16_t* P = (const bf16_t*)(a.ws + WS_PROJ); bf16_t* OA = (bf16_t*)(a.ws + WS_OA);
    const float g0 = a.in[I_GON][lane], g1 = a.in[I_GON][lane + 64];
    for (int id = blockIdx.x * NWAVES + wave; id < SEQ * 4; id += NW) { const int t = id >> 2, h = id & 3;
        const float o0 = ORAW[(size_t)t * 512 + h * 128 + lane], o1 = ORAW[(size_t)t * 512 + h * 128 + 64 + lane];
        const float rstd = rsqrtf(wave_sum(o0 * o0 + o1 * o1) * (1.f / 128.f) + 1e-6f);
        const float z0 = bf2f(P[(size_t)t * NPJ + PJ_DZ + h * 128 + lane]), z1 = bf2f(P[(size_t)t * NPJ + PJ_DZ + h * 128 + 64 + lane]);
        OA[(size_t)t * 512 + h * 128 + lane] = f2bf(o0 * rstd * g0 * siluf(z0)); OA[(size_t)t * 512 + h * 128 + 64 + lane] = f2bf(o1 * rstd * g1 * siluf(z1)); }
}

DI void ph6(const Args& a, unsigned char* ldsb) {
    const bf16_t* P = (const bf16_t*)(a.ws + WS_PROJ);
    pg8::OrderDense S; S.init(SEQ / 256, DM / 256, (int)gridDim.x, (int)blockIdx.x);
    { pg8::Gemm g{(const bf16_t*)(a.ws + WS_OA), (const bf16_t*)(a.ws + WS_WOAT), SEQ, DM, 512};
      pg8::EpiMerge<0> E{P + PJ_GA, (float*)(a.ws + WS_X1), (bf16_t*)(a.ws + WS_MRG)};
      pg8::gemm_phase<pg8::EpiMerge<0>, pg8::OrderDense>((LAS unsigned char*)ldsb, g, S, E); }
    __syncthreads();
    { pg8::Gemm g{(const bf16_t*)(a.ws + WS_OB), (const bf16_t*)(a.ws + WS_WOBT), SEQ, DM, 512};
      pg8::EpiMerge<1> E{P + PJ_GB, (float*)(a.ws + WS_X1), (bf16_t*)(a.ws + WS_MRG)};
      pg8::gemm_phase<pg8::EpiMerge<1>, pg8::OrderDense>((LAS unsigned char*)ldsb, g, S, E); }
}

DI void ph7(const Args& a, unsigned char* ldsb) {
    pg8::Gemm g{(const bf16_t*)(a.ws + WS_MRG), (const bf16_t*)(a.ws + WS_WOUTT), SEQ, DM, DM};
    pg8::OrderDense S; S.init(SEQ / 256, DM / 256, (int)gridDim.x, (int)blockIdx.x);
    pg8::EpiResid E{a.in[I_X], (const float*)(a.ws + WS_MOD) + 2048, (float*)(a.ws + WS_X1)};
    pg8::gemm_phase<pg8::EpiResid, pg8::OrderDense>((LAS unsigned char*)ldsb, g, S, E);
}

DI void ph8(const Args& a, float* lds) {
    const int tid = threadIdx.x, lane = tid & 63, wave = tid >> 6, G = gridDim.x;
    float* A2 = lds; float* B2 = lds + 1024; float* hs = lds + 2048 + wave * 1024;
    const float* mod = (const float*)(a.ws + WS_MOD);
    for (int k = tid; k < DM; k += NTHREADS) { A2[k] = a.in[I_G2][k] * (1.f + mod[4096 + k]); B2[k] = mod[3072 + k]; }
    __syncthreads();
    const float* X1 = (const float*)(a.ws + WS_X1); bf16_t* H2 = (bf16_t*)(a.ws + WS_H2);
    int* TOKE = (int*)(a.ws + WS_TOKE); int* TOKS = (int*)(a.ws + WS_TOKS); float* TOKG = (float*)(a.ws + WS_TOKG); unsigned* CNT = (unsigned*)(a.ws + WS_CNT);
    const float* wr = a.in[I_WR]; const int e = lane & 31, half = lane >> 5; const float br = a.in[I_BR][e];
    for (int t = blockIdx.x * NWAVES + wave; t < SEQ; t += G * NWAVES) {
        const float* xr = X1 + (size_t)t * DM;
        f32x4 v[4]; float ss = 0.f;
#pragma unroll
        for (int i = 0; i < 4; ++i) { v[i] = *(const f32x4*)(xr + lane * 4 + 256 * i); ss += v[i][0] * v[i][0] + v[i][1] * v[i][1] + v[i][2] * v[i][2] + v[i][3] * v[i][3]; }
        ss = wave_sum(ss);
        const float rstd = rsqrtf(ss * (1.f / DM) + 1e-6f);
        __builtin_amdgcn_wave_barrier();
#pragma unroll
        for (int i = 0; i < 4; ++i) { const int k = lane * 4 + 256 * i;
#pragma unroll
            for (int q = 0; q < 4; ++q) { v[i][q] = v[i][q] * rstd * A2[k + q] + B2[k + q]; hs[k + q] = v[i][q]; }
            u32x2 w; w.x = pk2(v[i][0], v[i][1]); w.y = pk2(v[i][2], v[i][3]);
            *(u32x2*)(H2 + (size_t)t * DM + k) = w; }
        asm volatile("s_waitcnt lgkmcnt(0)" ::: "memory");
        __builtin_amdgcn_wave_barrier();
        float lg = 0.f;
        for (int k = half * 512; k < half * 512 + 512; ++k) lg += hs[k] * wr[(size_t)k * NE + e];
        lg += __shfl_xor(lg, 32);
        lg += br;
        asm volatile("s_waitcnt lgkmcnt(0)" ::: "memory");
        __builtin_amdgcn_wave_barrier();
        float cur = lg;
#define TOP1(TV, TI) float TV = cur; int TI = e; for (int o_ = 1; o_ <= 16; o_ <<= 1) { const float ov = __shfl_xor(TV, o_); const int oi = __shfl_xor(TI, o_); if (ov > TV || (ov == TV && oi < TI)) { TV = ov; TI = oi; } } if (e == TI) cur = -__builtin_inff();
        TOP1(tv0, ti0) TOP1(tv1, ti1) TOP1(tv2, ti2) TOP1(tv3, ti3)
#undef TOP1
        const float ex0 = 1.f, ex1 = expf(tv1 - tv0), ex2 = expf(tv2 - tv0), ex3 = expf(tv3 - tv0), den = ex0 + ex1 + ex2 + ex3;
        if (lane < 4) { int ee = ti0; float gg = ex0;
            if (lane == 1) { ee = ti1; gg = ex1; } if (lane == 2) { ee = ti2; gg = ex2; } if (lane == 3) { ee = ti3; gg = ex3; }
            const unsigned slot = atomicAdd(&CNT[ee], 1u);
            TOKE[t * 4 + lane] = ee; TOKS[t * 4 + lane] = (int)slot; TOKG[t * 4 + lane] = gg / den; }
    }
}

DI void pad_starts(const Args& a, int* ps) {
    if (threadIdx.x == 0) { const unsigned* CNT = (const unsigned*)(a.ws + WS_CNT); int s = 0; for (int e = 0; e < NE; ++e) { ps[e] = s; s += (int)((CNT[e] + 255u) / 256u) * 256; } ps[NE] = s; }
    __syncthreads();
}
DI void ph9(const Args& a, float* lds) {
    int* ps = (int*)lds; pad_starts(a, ps);
    const int lane = threadIdx.x & 63, wave = threadIdx.x >> 6, NW = gridDim.x * NWAVES;
    const int* TOKE = (const int*)(a.ws + WS_TOKE); const int* TOKS = (const int*)(a.ws + WS_TOKS);
    const bf16_t* H2 = (const bf16_t*)(a.ws + WS_H2); bf16_t* XG = (bf16_t*)(a.ws + WS_XG);
    for (int id = blockIdx.x * NWAVES + wave; id < SEQ * 4; id += NW) { const int t = id >> 2;
        const size_t row = (size_t)ps[TOKE[id]] + TOKS[id];
        const u32x4 v0 = *(const u32x4*)(H2 + (size_t)t * DM + lane * 8), v1 = *(const u32x4*)(H2 + (size_t)t * DM + 512 + lane * 8);
        *(u32x4*)(XG + row * DM + lane * 8) = v0; *(u32x4*)(XG + row * DM + 512 + lane * 8) = v1; }
}
DI int expert_of(const int* ps, int row0) { int e = 0; for (int i = 1; i < NE; ++i) if (row0 >= ps[i]) e = i; return e; }
DI void ph10(const Args& a, unsigned char* ldsb) {
    int* ps = (int*)(ldsb + 131072); pad_starts(a, ps);
    pg8::Gemm g{(const bf16_t*)(a.ws + WS_XG), (const bf16_t*)(a.ws + WS_WGUT), 0, 2048, DM};
    pg8::OrderGrouped S; S.init(ps[NE] / 256, 8, (int)gridDim.x, (int)blockIdx.x); S.ps = (const LAS int*)ps;
    pg8::EpiSwiglu E{(bf16_t*)(a.ws + WS_ACT), a.in[I_BGU]};
    pg8::gemm_phase<pg8::EpiSwiglu, pg8::OrderGrouped>((LAS unsigned char*)ldsb, g, S, E);
}
DI void ph11(const Args& a, unsigned char* ldsb) {
    int* ps = (int*)(ldsb + 131072); pad_starts(a, ps);
    pg8::Gemm g{(const bf16_t*)(a.ws + WS_ACT), (const bf16_t*)(a.ws + WS_WDT), 0, DM, DM};
    pg8::OrderGrouped S; S.init(ps[NE] / 256, 4, (int)gridDim.x, (int)blockIdx.x); S.ps = (const LAS int*)ps;
    pg8::EpiStoreBf16 E{(bf16_t*)(a.ws + WS_YB), DM, a.in[I_BD], DM};
    pg8::gemm_phase<pg8::EpiStoreBf16, pg8::OrderGrouped>((LAS unsigned char*)ldsb, g, S, E);
}
DI void ph12(const Args& a, float* lds) {
    int* ps = (int*)lds; pad_starts(a, ps);
    const int lane = threadIdx.x & 63, wave = threadIdx.x >> 6, G = gridDim.x;
    const float* X1 = (const float*)(a.ws + WS_X1); const bf16_t* YB = (const bf16_t*)(a.ws + WS_YB); const float* mod = (const float*)(a.ws + WS_MOD);
    const int* TOKE = (const int*)(a.ws + WS_TOKE); const int* TOKS = (const int*)(a.ws + WS_TOKS); const float* TOKG = (const float*)(a.ws + WS_TOKG);
    for (int t = blockIdx.x * NWAVES + wave; t < SEQ; t += G * NWAVES) {
        size_t rows[4]; float gk[4];
#pragma unroll
        for (int q = 0; q < 4; ++q) { rows[q] = (size_t)ps[TOKE[t * 4 + q]] + TOKS[t * 4 + q]; gk[q] = TOKG[t * 4 + q]; }
        f32x4 v[4]; float ss = 0.f;
#pragma unroll
        for (int i = 0; i < 4; ++i) { const int k = lane * 4 + 256 * i; v[i] = *(const f32x4*)(X1 + (size_t)t * DM + k);
            f32x4 y = (f32x4){0.f, 0.f, 0.f, 0.f};
#pragma unroll
            for (int q = 0; q < 4; ++q) { const u32x2 w = *(const u32x2*)(YB + rows[q] * DM + k);
                y[0] += gk[q] * __uint_as_float(w.x << 16); y[1] += gk[q] * __uint_as_float(w.x & 0xffff0000u); y[2] += gk[q] * __uint_as_float(w.y << 16); y[3] += gk[q] * __uint_as_float(w.y & 0xffff0000u); }
#pragma unroll
            for (int q = 0; q < 4; ++q) { v[i][q] += mod[5120 + k + q] * y[q]; ss += v[i][q] * v[i][q]; } }
        ss = wave_sum(ss);
        const float rstd = rsqrtf(ss * (1.f / DM) + 1e-6f);
#pragma unroll
        for (int i = 0; i < 4; ++i) { const int k = lane * 4 + 256 * i; f32x4 o;
#pragma unroll
            for (int q = 0; q < 4; ++q) o[q] = v[i][q] * rstd * a.in[I_GF][k + q];
            *(f32x4*)(a.out + (size_t)t * DM + k) = o; }
    }
}

__global__ void __launch_bounds__(NTHREADS, 2) hybrid_fwd(Args a) {
    extern __shared__ __attribute__((aligned(16))) unsigned char lds_raw[];
    float* lds = (float*)(lds_raw + 16);
    LAS unsigned* xbw = (LAS unsigned*)lds_raw;
    if (threadIdx.x == 0) { xbw[0] = 0u; xbw[1] = 0u; xbw[2] = 0u; xbw[3] = 0u; }
    __syncthreads();
    XcdBarrier bar; bar.bar = (unsigned*)(a.ws + WS_BAR); bar.x = 0; bar.st = (volatile LAS unsigned*)xbw;
    const int lo = a.ph_lo, hi = a.ph_hi;
    if (hi - lo > 1) bar = xcd_barrier_post((unsigned*)(a.ws + WS_BAR), (volatile LAS unsigned*)xbw);
#define IN(k) (lo <= (k) && (k) < hi)
#define SEAM(k) do { if (IN(k) && IN((k) + 1)) xcd_barrier(bar); } while (0)
    if (IN(0)) ph0(a, lds);
    SEAM(0);
    if (IN(1)) ph1(a, lds);
    SEAM(1);
    if (IN(2)) ph2(a, lds_raw + 16);
    SEAM(2);
    if (IN(3)) ph3(a, lds);
    SEAM(3);
    if (IN(4)) ph4(a, lds);
    SEAM(4);
    if (IN(5)) scanB(a);
    SEAM(5);
    if (IN(6)) scanC(a);
    SEAM(6);
    if (IN(7)) ph5(a);
    SEAM(7);
    if (IN(8)) ph6(a, lds_raw + 16);
    SEAM(8);
    if (IN(9)) ph7(a, lds_raw + 16);
    SEAM(9);
    if (IN(10)) ph8(a, lds);
    SEAM(10);
    if (IN(11)) ph9(a, lds);
    SEAM(11);
    if (IN(12)) ph10(a, lds_raw + 16);
    SEAM(12);
    if (IN(13)) ph11(a, lds_raw + 16);
    SEAM(13);
    if (IN(14)) ph12(a, lds);
#undef IN
#undef SEAM
}

extern "C" void kernel_launch(void* const* d_in, const int* in_sizes, int n_in, void* d_out, int out_size, void* d_ws, size_t ws_size, hipStream_t stream) {
    static int grid = 0;
    if (grid == 0) {
        if (n_in != 22 || out_size != SEQ * DM || ws_size < WS_END) { fprintf(stderr, "kernel_launch: unexpected shapes (n_in %d out %d ws %zu, need %zu)\n", n_in, out_size, ws_size, (size_t)WS_END); grid = -1; return; }
        int dev = 0, cus = 0, per_cu = 0;
        if (hipGetDevice(&dev) != hipSuccess || hipDeviceGetAttribute(&cus, hipDeviceAttributeMultiprocessorCount, dev) != hipSuccess) { grid = -1; return; }
        if (hipFuncSetAttribute((const void*)hybrid_fwd, hipFuncAttributeMaxDynamicSharedMemorySize, LDS_BYTES) != hipSuccess) { fprintf(stderr, "kernel_launch: hipFuncSetAttribute failed\n"); grid = -1; return; }
        if (hipOccupancyMaxActiveBlocksPerMultiprocessor(&per_cu, (const void*)hybrid_fwd, NTHREADS, LDS_BYTES) != hipSuccess || per_cu < 1) { fprintf(stderr, "kernel_launch: occupancy query says %d\n", per_cu); }
        (void)hipGetLastError();
        grid = cus;
    }
    if (grid < 0) return;
    (void)hipMemsetAsync(d_ws, 0, CTL_ZERO, stream);
    Args a{};
    for (int i = 0; i < 22; ++i) a.in[i] = (const float*)d_in[i];
    a.out = (float*)d_out; a.ws = (unsigned char*)d_ws;
#if N_LAUNCHES == 1
    a.ph_lo = 0; a.ph_hi = NPHASES;
    hipLaunchKernelGGL(hybrid_fwd, dim3(grid), dim3(NTHREADS), LDS_BYTES, stream, a);
#else
    for (int p = 0; p < NPHASES; ++p) { a.ph_lo = p; a.ph_hi = p + 1; hipLaunchKernelGGL(hybrid_fwd, dim3(grid), dim3(NTHREADS), LDS_BYTES, stream, a); }
#endif
}
```

```cpp
#include <hip/hip_runtime.h>
#include <stdint.h>
#include <stdio.h>

#ifndef N_LAUNCHES
#define N_LAUNCHES 1
#endif

#define DI __device__ __forceinline__
#define LAS __attribute__((address_space(3)))
typedef unsigned short bf16_t;
typedef short bf16x8 __attribute__((ext_vector_type(8)));
typedef float f32x4 __attribute__((ext_vector_type(4)));
typedef unsigned u32x4 __attribute__((ext_vector_type(4)));
typedef unsigned u32x2 __attribute__((ext_vector_type(2)));

constexpr int SEQ = 16384, DM = 1024, NIN = 5644, NPJ = 5632, NE = 32, TOPK = 4;
constexpr int NH = 4, HD = 128, CH = 64, NCH = SEQ / CH;
constexpr int PJ_DQ = 0, PJ_DK = 512, PJ_DV = 1024, PJ_DZ = 1536, PJ_FQ = 2048, PJ_FK = 2560, PJ_FV = 3072, PJ_GA = 3584, PJ_GB = 4608;
constexpr int NTHREADS = 512, NWAVES = 8;
constexpr int LDS_BYTES = 152 * 1024;
constexpr int NPHASES = 15;

constexpr size_t MiB = 1u << 20;
constexpr size_t WS_BAR = 0;
constexpr size_t WS_CNT = 32768;
constexpr size_t WS_NRM = 32768 + 256;
constexpr size_t WS_QH = 32768 + 512;
constexpr size_t CTL_ZERO = 65536;
constexpr size_t WS_MOD = 65536;
constexpr size_t WS_F = WS_MOD + 32768;
constexpr size_t WS_EG = WS_F + 262144;
constexpr size_t WS_TOKE = WS_EG + 4096;
constexpr size_t WS_TOKS = WS_TOKE + 262144;
constexpr size_t WS_TOKG = WS_TOKS + 262144;
constexpr size_t WS_SP = WS_TOKG + 262144;
constexpr size_t WS_WINT = WS_SP + MiB;
constexpr size_t WS_WOAT = WS_WINT + (size_t)NPJ * DM * 2;
constexpr size_t WS_WOBT = WS_WOAT + MiB;
constexpr size_t WS_WOUTT = WS_WOBT + MiB;
constexpr size_t WS_WGUT = WS_WOUTT + 2 * MiB;
constexpr size_t WS_WDT = WS_WGUT + 128 * MiB;
constexpr size_t WS_X1 = WS_WDT + 64 * MiB;
constexpr size_t WS_H2 = WS_X1 + 64 * MiB;
constexpr size_t WS_MRG = WS_H2 + 32 * MiB;
constexpr size_t WS_RA = WS_MRG + 32 * MiB;
constexpr size_t WS_RB = WS_RA + 176 * MiB;
constexpr size_t WS_H = WS_RB;
constexpr size_t WS_DNW = WS_H + 32 * MiB;
constexpr size_t WS_DNU = WS_DNW + 16 * MiB;
constexpr size_t WS_DNQD = WS_DNU + 16 * MiB;
constexpr size_t WS_DNKD = WS_DNQD + 16 * MiB;
constexpr size_t WS_DNATT = WS_DNKD + 16 * MiB;
constexpr size_t WS_ORAW = WS_DNATT + 8 * MiB;
constexpr size_t WS_OA = WS_ORAW + 32 * MiB;
constexpr size_t WS_OB = WS_OA + 16 * MiB;
constexpr size_t WS_VT = WS_OB + 16 * MiB;
constexpr size_t WS_PG = WS_VT;
constexpr size_t WS_QG = WS_PG + 2 * MiB;
constexpr size_t WS_SG = WS_QG + 4 * MiB;
constexpr size_t WS_END = WS_RB + 184 * MiB;
constexpr size_t WS_XG = WS_RA, WS_YB = WS_RA, WS_ACT = WS_RB, WS_PROJ = WS_RA;
static_assert(WS_VT + 16 * MiB <= WS_END, "region B");

struct Args { const float* in[22]; float* out; unsigned char* ws; int ph_lo, ph_hi; };
enum { I_X = 0, I_C, I_WADA, I_BADA, I_G1, I_WIN, I_CONVW, I_ALOG, I_DTB, I_GON, I_BFG, I_WOD, I_WOF, I_WOUT, I_G2, I_WR, I_BR, I_WGU, I_BGU, I_WD, I_BD, I_GF };

DI float bf2f(bf16_t v) { return __uint_as_float(((unsigned)v) << 16); }
DI bf16_t f2bf(float f) { unsigned u = __float_as_uint(f); u += 0x7fffu + ((u >> 16) & 1u); return (bf16_t)(u >> 16); }
typedef float f32x2_t __attribute__((ext_vector_type(2)));
typedef __bf16 bf16x2_t __attribute__((ext_vector_type(2)));
DI unsigned cvt_pk(float lo, float hi) { const f32x2_t v = {lo, hi}; const bf16x2_t b = __builtin_convertvector(v, bf16x2_t); return __builtin_bit_cast(unsigned, b); }
DI unsigned pk2(float lo, float hi) { return (unsigned)f2bf(lo) | ((unsigned)f2bf(hi) << 16); }
DI float sigm(float x) { return 1.f / (1.f + expf(-x)); }
DI float siluf(float x) { return x / (1.f + expf(-x)); }
DI float softplusf(float x) { return fmaxf(x, 0.f) + log1pf(expf(-fabsf(x))); }
DI float logsigf(float x) { return fminf(x, 0.f) - log1pf(expf(-fabsf(x))); }
DI float wave_sum(float v) { for (int o = 32; o >= 1; o >>= 1) v += __shfl_xor(v, o); return v; }
#define MFMA16(a, b, c) __builtin_amdgcn_mfma_f32_16x16x32_bf16((a), (b), (c), 0, 0, 0)

DI int gu_src(int n) { const int g = n >> 8, r = n & 255; return r < 128 ? 128 * g + r : 1024 + 128 * g + (r - 128); }

#define XB_TMO      128
#define XB_XCNT(j)  (256  + 64 * (j))
#define XB_XSUB(j)  (1280 + 64 * (j))
#define XB_XGEN(j)  (2304 + 64 * (j))
#define XB_TOP      3328
#define XB_TOPGEN   3392
#define XCD_BAR_WORDS 3456
#define XB_SPIN_CAP (1u << 22)
DI unsigned xb_ld(unsigned* p)              { return __hip_atomic_load(p, __ATOMIC_RELAXED, __HIP_MEMORY_SCOPE_AGENT); }
DI unsigned xb_add(unsigned* p, unsigned v) { return __hip_atomic_fetch_add(p, v, __ATOMIC_RELAXED, __HIP_MEMORY_SCOPE_AGENT); }
DI unsigned xb_xcc_id() { return (unsigned)__builtin_amdgcn_s_getreg((3 << 11) | 20) & 0xFu; }
#define XB_SPIN(cond, bar) do { unsigned _sp = 0; while (cond) { __builtin_amdgcn_s_sleep(1); \
    if ((++_sp & 255u) == 0u) { if (xb_ld(&(bar)[XB_TMO])) break; if (_sp > XB_SPIN_CAP) { atomicAdd(&(bar)[XB_TMO], 1u); break; } } } } while (0)
struct XcdBarrier { unsigned* bar; unsigned x; volatile LAS unsigned* st; };
DI XcdBarrier xcd_barrier_post(unsigned* bar, volatile LAS unsigned* st) {
    XcdBarrier b; b.bar = bar; b.x = xb_xcc_id(); b.st = st;
    if (threadIdx.x == 0) (void)xb_add(&bar[XB_XCNT(b.x)], 1u);
    return b;
}
DI void xcd_barrier_complete(unsigned* bar, unsigned x, unsigned& nloc, unsigned& nx) {
    const unsigned G = gridDim.x * gridDim.y * gridDim.z;
    unsigned sum, cnt, mine, sp = 0u;
    for (;;) {
        sum = 0u; cnt = 0u; mine = 0u;
#pragma unroll
        for (unsigned j = 0; j < 16; ++j) { const unsigned c = xb_ld(&bar[XB_XCNT(j)]); sum += c; cnt += (c > 0u) ? 1u : 0u; mine = (j == x) ? c : mine; }
        if (sum == G) break;
        __builtin_amdgcn_s_sleep(1);
        if ((++sp & 255u) == 0u) { if (xb_ld(&bar[XB_TMO])) break; if (sp > XB_SPIN_CAP) { atomicAdd(&bar[XB_TMO], 1u); break; } }
    }
    nloc = mine > 0u ? mine : 1u; nx = cnt > 0u ? cnt : 1u;
}
DI void xcd_barrier(const XcdBarrier& b) {
    asm volatile("s_waitcnt vmcnt(0)" ::: "memory");
    __syncthreads();
    if (threadIdx.x == 0) {
        unsigned* bar = b.bar;
        __builtin_amdgcn_s_waitcnt(0);
        unsigned nloc = b.st[0], nx = b.st[1];
        if (nloc == 0u) { xcd_barrier_complete(bar, b.x, nloc, nx); b.st[0] = nloc; b.st[1] = nx; }
        const unsigned old = xb_add(&bar[XB_XSUB(b.x)], 1u);
        const unsigned gen = old / nloc;
        if (old + 1u == (gen + 1u) * nloc) {
            __builtin_amdgcn_fence(__ATOMIC_RELEASE, "agent");
            asm volatile("s_waitcnt vmcnt(0)" ::: "memory");
            const unsigned og = xb_add(&bar[XB_TOP], 1u);
            const unsigned tg = og / nx;
            if (og + 1u == (tg + 1u) * nx) xb_add(&bar[XB_TOPGEN], 1u);
            else XB_SPIN(xb_ld(&bar[XB_TOPGEN]) == tg, bar);
            __builtin_amdgcn_fence(__ATOMIC_ACQUIRE, "agent");
            xb_add(&bar[XB_XGEN(b.x)], 1u);
            asm volatile("s_waitcnt vmcnt(0)" ::: "memory");
        } else {
            XB_SPIN(xb_ld(&bar[XB_XGEN(b.x)]) == gen, bar);
            __builtin_amdgcn_fence(__ATOMIC_ACQUIRE, "agent");
            asm volatile("s_waitcnt vmcnt(0)" ::: "memory");
        }
    }
    __syncthreads();
}

template <int NT>
DI void wave_gemm(const bf16_t* const (&ap)[4], const bf16_t* const (&bp)[NT], int K, f32x4 (&acc)[4][NT]) {
    for (int k0 = 0; k0 < K; k0 += 32) {
        bf16x8 a[4], b[NT];
#pragma unroll
        for (int i = 0; i < 4; ++i) a[i] = *(const bf16x8*)(ap[i] + k0);
#pragma unroll
        for (int j = 0; j < NT; ++j) b[j] = *(const bf16x8*)(bp[j] + k0);
#pragma unroll
        for (int i = 0; i < 4; ++i)
#pragma unroll
            for (int j = 0; j < NT; ++j) acc[i][j] = MFMA16(a[i], b[j], acc[i][j]);
    }
}
template <int NT> DI void zero_acc(f32x4 (&acc)[4][NT]) {
#pragma unroll
    for (int i = 0; i < 4; ++i)
#pragma unroll
        for (int j = 0; j < NT; ++j) acc[i][j] = (f32x4){0.f, 0.f, 0.f, 0.f};
}


namespace pg8 {
struct Unit { int pm, pn, pb, e; };
struct Gemm { const bf16_t* A; const bf16_t* Bt; int M, N, K; };
constexpr int BM = 256, BK = 64, HALF = 128, HTB = HALF * BK * 2  , STAGE_BYTES = 8 * HTB, NXCD = 8, WGM = 8;

__host__ __device__ __forceinline__ int lds_byte(int r, int c) { const int st = (r >> 4) * 2 + (c >> 5), rr = r & 15, cc = c & 31, ob = rr * 64 + cc * 2; return st * 1024 + (ob ^ (((ob >> 9) & 1) << 5)); }
__host__ __device__ __forceinline__ void stage_rc(int b, int& R, int& C) { const int st = b / 1024, sb = b % 1024, swz = sb ^ (((sb >> 9) & 1) << 5); R = (st >> 1) * 16 + swz / 64; C = (st & 1) * 32 + (swz % 64) / 2; }
__host__ __device__ __forceinline__ int perm32(int rho) { const int n = rho >> 4, i = rho & 15; return 8 * (i >> 2) + 4 * n + (i & 3); }
template <class Epi, class Sched>
__device__ __forceinline__ void gemm_phase(LAS unsigned char* lds, const Gemm g, const Sched& S, const Epi& E) {
    const int tid = threadIdx.x, wid = __builtin_amdgcn_readfirstlane(tid >> 6), lane = tid & 63, wr = wid >> 2, wc = wid & 3, fr = lane & 15, fq = lane >> 4;
    const int K = g.K, nt = K / BK;
    unsigned voffA[2], voffB[2];
#pragma unroll
    for (int i = 0; i < 2; ++i) { int R, C; stage_rc(tid * 16 + i * 8192, R, C); const int Rb = Epi::PERM ? ((R & ~31) + perm32(R & 31)) : R;
        voffA[i] = (unsigned)(R * K + C) * 2u; voffB[i] = (unsigned)(Rb * K + C) * 2u; }
    const size_t kstep = (size_t)(BK * 2);
    const size_t hstep = (size_t)HALF * K * 2;
    const size_t tstep = 2 * hstep;
    const unsigned ldsw = (unsigned)wid * 1024u;
    const int aoff = lds_byte(wr * 64 + fr, fq * 8), boff = lds_byte(wc * 32 + fr, fq * 8);
#define PG8_SA(b, h) (((b) * 2 + (h)) * HTB)
#define PG8_SB(b, h) ((4 + (b) * 2 + (h)) * HTB)
#define PG8_STAGE(bufoff, gbase, voff) do { _Pragma("unroll") for (int _i = 0; _i < 2; ++_i) \
        __builtin_amdgcn_global_load_lds((const unsigned*)((const char*)(gbase) + (voff)[_i]), (LAS unsigned*)(lds + (bufoff) + ldsw + _i * 8192), 16, 0, 0); } while (0)
#define PG8_LDA(dst, b, h) do { _Pragma("unroll") for (int m = 0; m < 4; ++m) _Pragma("unroll") for (int k = 0; k < 2; ++k) dst[m][k] = *(const LAS bf16x8*)(lds + PG8_SA(b, h) + aoff + m * 2048 + k * 1024); } while (0)
#define PG8_LDB(dst, b, h) do { _Pragma("unroll") for (int n = 0; n < 2; ++n) _Pragma("unroll") for (int k = 0; k < 2; ++k) dst[n][k] = *(const LAS bf16x8*)(lds + PG8_SB(b, h) + boff + n * 2048 + k * 1024); } while (0)
#define PG8_MMA(ai, bj, At, Bt) do { __builtin_amdgcn_s_setprio(1); _Pragma("unroll") for (int m = 0; m < 4; ++m) _Pragma("unroll") for (int n = 0; n < 2; ++n) _Pragma("unroll") for (int k = 0; k < 2; ++k) \
        acc[ai][bj][m][n] = __builtin_amdgcn_mfma_f32_16x16x32_bf16(Bt[n][k], At[m][k], acc[ai][bj][m][n], 0, 0, 0); __builtin_amdgcn_s_setprio(0); } while (0)
#define PG8_WAIT_V(n) asm volatile("s_waitcnt vmcnt(" #n ")" ::: "memory")
#define PG8_WAIT_L(n) asm volatile("s_waitcnt lgkmcnt(" #n ")" ::: "memory")
#define PG8_BAR __builtin_amdgcn_s_barrier()
#define PG8_SCHED __builtin_amdgcn_sched_barrier(0)
    Unit cur, nxt; int ui = 0;
    if (!S.next(0, cur)) return;
    f32x4 acc[2][2][4][2];
#pragma unroll
    for (int a = 0; a < 2; ++a)
#pragma unroll
        for (int b = 0; b < 2; ++b)
#pragma unroll
            for (int m = 0; m < 4; ++m)
#pragma unroll
                for (int n = 0; n < 2; ++n) acc[a][b][m][n] = (f32x4){0.f, 0.f, 0.f, 0.f};
    bf16x8 At[4][2], B0[2][2], B1[2][2];
    const char* cA = (const char*)g.A + (size_t)cur.pm * tstep; const char* cB = (const char*)g.Bt + (size_t)cur.pb * tstep;
    S.a_ready(cur);
    PG8_STAGE(PG8_SB(0, 0), cB, voffB); PG8_STAGE(PG8_SA(0, 0), cA, voffA); PG8_STAGE(PG8_SB(0, 1), cB + hstep, voffB); PG8_STAGE(PG8_SA(0, 1), cA + hstep, voffA);
    if (wr == 1) PG8_BAR;
    PG8_WAIT_V(4); PG8_BAR;
    PG8_STAGE(PG8_SB(1, 0), cB + kstep, voffB); PG8_STAGE(PG8_SA(1, 0), cA + kstep, voffA); PG8_STAGE(PG8_SB(1, 1), cB + hstep + kstep, voffB);
    PG8_WAIT_V(6); PG8_BAR;
    for (;;) {
        const bool has_next = S.next(ui + 1, nxt);
        const char* nA = has_next ? (const char*)g.A + (size_t)nxt.pm * tstep : cA; const char* nB = has_next ? (const char*)g.Bt + (size_t)nxt.pb * tstep : cB;
        for (int t = 0; t < nt; t += 2) {
            const bool last = (t == nt - 2);
            const char* a1 = cA + (size_t)(t + 1) * kstep;
            const char* a2 = last ? nA : cA + (size_t)(t + 2) * kstep; const char* b2 = last ? nB : cB + (size_t)(t + 2) * kstep;
            const char* a3 = a2 + kstep; const char* b3 = b2 + kstep;
            if (last && has_next) S.a_ready(nxt);
            PG8_LDB(B0, 0, 0); PG8_SCHED; PG8_LDA(At, 0, 0); PG8_STAGE(PG8_SA(1, 1), a1 + hstep, voffA);
            PG8_WAIT_L(8); PG8_BAR; PG8_WAIT_L(0); PG8_MMA(0, 0, At, B0); PG8_BAR; PG8_SCHED;
            PG8_LDB(B1, 0, 1); PG8_STAGE(PG8_SB(0, 0), b2, voffB);
            PG8_BAR; PG8_WAIT_L(0); PG8_MMA(0, 1, At, B1); PG8_BAR;
            PG8_LDA(At, 0, 1); PG8_STAGE(PG8_SA(0, 0), a2, voffA);
            PG8_BAR; PG8_WAIT_L(0); PG8_MMA(1, 0, At, B0); PG8_BAR; PG8_SCHED;
            PG8_STAGE(PG8_SB(0, 1), b2 + hstep, voffB);
            PG8_WAIT_V(6); PG8_BAR; PG8_MMA(1, 1, At, B1); PG8_BAR;
            PG8_LDB(B0, 1, 0); PG8_SCHED; PG8_LDA(At, 1, 0); PG8_STAGE(PG8_SA(0, 1), a2 + hstep, voffA);
            PG8_WAIT_L(8); PG8_BAR; PG8_WAIT_L(0); PG8_MMA(0, 0, At, B0); PG8_BAR; PG8_SCHED;
            PG8_LDB(B1, 1, 1); PG8_STAGE(PG8_SB(1, 0), b3, voffB);
            PG8_BAR; PG8_WAIT_L(0); PG8_MMA(0, 1, At, B1); PG8_BAR;
            PG8_LDA(At, 1, 1); PG8_STAGE(PG8_SA(1, 0), a3, voffA);
            PG8_BAR; PG8_WAIT_L(0); PG8_MMA(1, 0, At, B0); PG8_BAR; PG8_SCHED;
            PG8_STAGE(PG8_SB(1, 1), b3 + hstep, voffB);
            PG8_WAIT_V(6); PG8_BAR; PG8_MMA(1, 1, At, B1); PG8_BAR;
        }
        if constexpr (!Epi::AFTER_DRAIN) { E(acc, cur, wr, wc, fr, fq); S.done(cur); }
        if (!has_next) break;
#pragma unroll
        for (int a = 0; a < 2; ++a)
#pragma unroll
            for (int b = 0; b < 2; ++b)
#pragma unroll
                for (int m = 0; m < 4; ++m)
#pragma unroll
                    for (int n = 0; n < 2; ++n) acc[a][b][m][n] = (f32x4){0.f, 0.f, 0.f, 0.f};
        cur = nxt; cA = nA; cB = nB; ++ui;
    }
    PG8_WAIT_V(0);
    if (wr == 0) PG8_BAR;
    PG8_BAR;
    if constexpr (Epi::AFTER_DRAIN) { E.fused(acc, cur, wr, wc, fr, fq, lds, wid, lane); S.done(cur); }
#undef PG8_SA
#undef PG8_SB
#undef PG8_STAGE
#undef PG8_LDA
#undef PG8_LDB
#undef PG8_MMA
#undef PG8_WAIT_V
#undef PG8_WAIT_L
#undef PG8_BAR
#undef PG8_SCHED
}

DI unsigned cvt_pk_bf16(float lo, float hi) { return cvt_pk(lo, hi); }
DI float fsig(float x) { return __builtin_amdgcn_rcpf(1.f + __builtin_amdgcn_exp2f(-1.4426950408889634f * x)); }
DI int expert_of_l(const LAS int* ps, int row0) { int e = 0;
#pragma unroll 1
    for (int i = 1; i < NE; ++i) if (row0 >= ps[i]) e = i; return e; }
struct OrderDense {
    int nM, nN, nwg, G, c;
    DI void init(int nM_, int nN_, int G_, int c_) { nM = nM_; nN = nN_; nwg = nM * nN; G = G_; c = c_; }
    DI bool tile(int i, Unit& u) const {
        const long L = (long)i * G + c; if (L >= nwg) return false;
        int wgid = (int)L; { const int q = nwg / NXCD, r = nwg % NXCD, xcd = wgid % NXCD, off = wgid / NXCD; wgid = (xcd < r ? xcd * (q + 1) : r * (q + 1) + (xcd - r) * q) + off; }
        const int nig = WGM * nN, gid = wgid / nig, fm = gid * WGM, gsz = (nM - fm) < WGM ? (nM - fm) : WGM;
        u.pm = fm + ((wgid % nig) % gsz); u.pn = (wgid % nig) / gsz; return true;
    }
    DI bool next(int i, Unit& u) const { if (!tile(i, u)) return false; u.pb = u.pn; u.e = 0; return true; }
    DI void a_ready(const Unit&) const {}
    DI void done(const Unit&) const {}
};
struct OrderGrouped : OrderDense {
    const LAS int* ps;
    DI bool next(int i, Unit& u) const { if (!tile(i, u)) return false; u.e = expert_of_l(ps, u.pm * BM); u.pb = u.e * nN + u.pn; return true; }
};
struct EpiStoreBf16 {
    static constexpr bool PERM = true, AFTER_DRAIN = false;
    bf16_t* O; int ldc; const float* bias; int bstride;
    DI void operator()(const f32x4 (&acc)[2][2][4][2], const Unit& u, int wr, int wc, int fr, int fq) const {
        const int row0 = u.pm * BM + wr * 64 + fr, col0 = u.pn * BM + wc * 32 + 8 * fq;
        f32x4 bv[2][2];
#pragma unroll
        for (int bj = 0; bj < 2; ++bj)
#pragma unroll
            for (int n = 0; n < 2; ++n) bv[bj][n] = bias ? *(const f32x4*)(bias + (size_t)u.e * bstride + col0 + bj * HALF + 4 * n) : (f32x4){0.f, 0.f, 0.f, 0.f};
#pragma unroll
        for (int ai = 0; ai < 2; ++ai)
#pragma unroll
            for (int m = 0; m < 4; ++m) { bf16_t* rowp = O + (size_t)(row0 + ai * HALF + m * 16) * ldc + col0;
#pragma unroll
                for (int bj = 0; bj < 2; ++bj) { const f32x4 v0 = acc[ai][bj][m][0] + bv[bj][0], v1 = acc[ai][bj][m][1] + bv[bj][1];
                    u32x4 w; w.x = cvt_pk_bf16(v0[0], v0[1]); w.y = cvt_pk_bf16(v0[2], v0[3]); w.z = cvt_pk_bf16(v1[0], v1[1]); w.w = cvt_pk_bf16(v1[2], v1[3]);
                    *(u32x4*)(rowp + bj * HALF) = w; } }
    }
};
template <int SECOND> struct EpiMerge {
    static constexpr bool PERM = true, AFTER_DRAIN = false;
    const bf16_t* gate; float* T; bf16_t* O;
    DI void operator()(const f32x4 (&acc)[2][2][4][2], const Unit& u, int wr, int wc, int fr, int fq) const {
        const int row0 = u.pm * BM + wr * 64 + fr, col0 = u.pn * BM + wc * 32 + 8 * fq;
#pragma unroll
        for (int ai = 0; ai < 2; ++ai)
#pragma unroll
            for (int mp = 0; mp < 2; ++mp) {
                u32x4 g[2][2]; f32x4 t0[2][2], t1[2][2];
#pragma unroll
                for (int mm = 0; mm < 2; ++mm)
#pragma unroll
                    for (int bj = 0; bj < 2; ++bj) { const size_t row = (size_t)(row0 + ai * HALF + (2 * mp + mm) * 16); const int col = col0 + bj * HALF;
                        g[mm][bj] = *(const u32x4*)(gate + row * NPJ + col);
                        if (SECOND) { t0[mm][bj] = *(const f32x4*)(T + row * DM + col); t1[mm][bj] = *(const f32x4*)(T + row * DM + col + 4); } }
#pragma unroll
                for (int mm = 0; mm < 2; ++mm)
#pragma unroll
                    for (int bj = 0; bj < 2; ++bj) { const int m = 2 * mp + mm; const size_t row = (size_t)(row0 + ai * HALF + m * 16); const int col = col0 + bj * HALF;
                        const u32x4 gg = g[mm][bj]; f32x4 v0 = acc[ai][bj][m][0], v1 = acc[ai][bj][m][1];
                        v0[0] *= fsig(__uint_as_float(gg.x << 16)); v0[1] *= fsig(__uint_as_float(gg.x & 0xffff0000u)); v0[2] *= fsig(__uint_as_float(gg.y << 16)); v0[3] *= fsig(__uint_as_float(gg.y & 0xffff0000u));
                        v1[0] *= fsig(__uint_as_float(gg.z << 16)); v1[1] *= fsig(__uint_as_float(gg.z & 0xffff0000u)); v1[2] *= fsig(__uint_as_float(gg.w << 16)); v1[3] *= fsig(__uint_as_float(gg.w & 0xffff0000u));
                        if (SECOND == 0) { float* tp = T + row * DM + col; *(f32x4*)tp = v0; *(f32x4*)(tp + 4) = v1; }
                        else { v0 += t0[mm][bj]; v1 += t1[mm][bj];
                            u32x4 w; w.x = cvt_pk_bf16(v0[0], v0[1]); w.y = cvt_pk_bf16(v0[2], v0[3]); w.z = cvt_pk_bf16(v1[0], v1[1]); w.w = cvt_pk_bf16(v1[2], v1[3]);
                            *(u32x4*)(O + row * DM + col) = w; } }
            }
    }
};
struct EpiResid {
    static constexpr bool PERM = false, AFTER_DRAIN = false;
    const float* x; const float* gt; float* X1;
    DI void operator()(const f32x4 (&acc)[2][2][4][2], const Unit& u, int wr, int wc, int fr, int fq) const {
        const int row0 = u.pm * BM + wr * 64 + fr, col0 = u.pn * BM + wc * 32 + 4 * fq;
        f32x4 gv[2][2];
#pragma unroll
        for (int bj = 0; bj < 2; ++bj)
#pragma unroll
            for (int n = 0; n < 2; ++n) gv[bj][n] = *(const f32x4*)(gt + col0 + bj * HALF + n * 16);
#pragma unroll
        for (int ai = 0; ai < 2; ++ai)
#pragma unroll
            for (int mp = 0; mp < 2; ++mp) {
                f32x4 xv[2][2][2];
#pragma unroll
                for (int mm = 0; mm < 2; ++mm)
#pragma unroll
                    for (int bj = 0; bj < 2; ++bj)
#pragma unroll
                        for (int n = 0; n < 2; ++n) xv[mm][bj][n] = *(const f32x4*)(x + (size_t)(row0 + ai * HALF + (2 * mp + mm) * 16) * DM + col0 + bj * HALF + n * 16);
#pragma unroll
                for (int mm = 0; mm < 2; ++mm)
#pragma unroll
                    for (int bj = 0; bj < 2; ++bj)
#pragma unroll
                        for (int n = 0; n < 2; ++n) *(f32x4*)(X1 + (size_t)(row0 + ai * HALF + (2 * mp + mm) * 16) * DM + col0 + bj * HALF + n * 16) = xv[mm][bj][n] + gv[bj][n] * acc[ai][bj][2 * mp + mm][n];
            }
    }
};
struct EpiSwiglu {
    static constexpr bool PERM = true, AFTER_DRAIN = false;
    bf16_t* ACT; const float* bgu;
    DI void operator()(const f32x4 (&acc)[2][2][4][2], const Unit& u, int wr, int wc, int fr, int fq) const {
        const int row0 = u.pm * BM + wr * 64 + fr, gcol = u.pn * HALF + wc * 32 + 8 * fq;
        const float* bb = bgu + (size_t)u.e * 2048 + gcol;
        f32x4 bg[2], bu[2];
#pragma unroll
        for (int n = 0; n < 2; ++n) { bg[n] = *(const f32x4*)(bb + 4 * n); bu[n] = *(const f32x4*)(bb + 1024 + 4 * n); }
#pragma unroll
        for (int ai = 0; ai < 2; ++ai)
#pragma unroll
            for (int m = 0; m < 4; ++m) { float r[8];
#pragma unroll
                for (int n = 0; n < 2; ++n)
#pragma unroll
                    for (int j = 0; j < 4; ++j) { float g = acc[ai][0][m][n][j] + bg[n][j], up = acc[ai][1][m][n][j] + bu[n][j];
                        g = fminf(g, 7.f); up = fminf(fmaxf(up, -7.f), 7.f);
                        r[4 * n + j] = (up + 1.f) * (g * fsig(1.702f * g)); }
                u32x4 w; w.x = cvt_pk_bf16(r[0], r[1]); w.y = cvt_pk_bf16(r[2], r[3]); w.z = cvt_pk_bf16(r[4], r[5]); w.w = cvt_pk_bf16(r[6], r[7]);
                *(u32x4*)(ACT + (size_t)(row0 + ai * HALF + m * 16) * DM + gcol) = w; }
    }
};
}


namespace fox {
typedef float f32x16 __attribute__((ext_vector_type(16)));
typedef short s16x4 __attribute__((ext_vector_type(4)));
constexpr float SCALE = 0.08838834764831845f;
constexpr int KVBLK = 64, SHM_K = 16384, SHM_V = 16384;
constexpr int OFF_V = 0, OFF_K = 2 * SHM_V, OFF_G = OFF_K + 2 * SHM_K, OFF_WS = OFF_G + 512, OFF_MISC = OFF_WS + 8 * 256;
constexpr float THR = 8.f;
#define KSWZ(row, colB) ((row) * 256 + ((colB) ^ (((row) & 7) << 4)))
#define SBAR() __builtin_amdgcn_sched_barrier(0)
DI int v_st(int k, int c) { const int kk = (k & ~0xC) | ((k & 4) << 1) | ((k & 8) >> 1); return ((kk >> 3) * 4 + (c >> 5)) * 512 + ((kk & 7) * 32 + (c & 31)) * 2; }
DI int v_rd_base(int lane) { return ((lane & 3) << 3) | (((lane >> 2) & 3) << 6) | (((lane >> 4) & 1) << 5) | (((lane >> 5) & 1) << 8); }
constexpr int v_rd_off(int d0, int ks, int half) { return d0 * 512 + ks * 4096 + half * 2048; }
DI int crow(int r, int hi) { return (r & 3) + 8 * (r >> 2) + 4 * hi; }
DI unsigned cvtpk(float lo, float hi) { return cvt_pk(lo, hi); }
DI void mask_tile(f32x16& p0, f32x16& p1, int dq) {
    const float NEG = -__builtin_inff();
#pragma unroll
    for (int r = 0; r < 16; ++r) { const int c = (r & 3) + 8 * (r >> 2); if (dq - c < 0) p0[r] = NEG; if (dq - c - 32 < 0) p1[r] = NEG; }
}
DI void partialSM(f32x16& p0, f32x16& p1, float& m_reg, float& mn, float& alpha) {
    float pmax = p0[0];
#pragma unroll
    for (int r = 1; r < 16; ++r) pmax = fmaxf(pmax, p0[r]);
#pragma unroll
    for (int r = 0; r < 16; ++r) pmax = fmaxf(pmax, p1[r]);
    { auto rr = __builtin_amdgcn_permlane32_swap(__float_as_uint(pmax), __float_as_uint(pmax), false, false); pmax = fmaxf(__uint_as_float(rr[0]), __uint_as_float(rr[1])); }
    constexpr float C2 = 1.4426950408889634f * SCALE;
    if (__builtin_expect(__all((pmax - m_reg) * SCALE <= THR), 1)) { mn = m_reg; alpha = 1.f; }
    else { mn = fmaxf(m_reg, pmax); alpha = __builtin_amdgcn_exp2f((m_reg - mn) * C2); m_reg = mn; }
    const float mnL = -mn * C2;
#pragma unroll
    for (int r = 0; r < 16; ++r) p0[r] = fmaf(p0[r], C2, mnL);
#pragma unroll
    for (int r = 0; r < 16; ++r) p1[r] = fmaf(p1[r], C2, mnL);
#pragma unroll
    for (int r = 0; r < 16; ++r) p0[r] = __builtin_amdgcn_exp2f(p0[r]);
}
DI void finishSM(f32x16& p0, f32x16& p1, float alpha, float& l_reg, bf16x8& pa0, bf16x8& pa1, bf16x8& pa2, bf16x8& pa3) {
#pragma unroll
    for (int r = 0; r < 16; ++r) p1[r] = __builtin_amdgcn_exp2f(p1[r]);
    float ps = 0;
#pragma unroll
    for (int r = 0; r < 16; ++r) ps += p0[r];
#pragma unroll
    for (int r = 0; r < 16; ++r) ps += p1[r];
    { auto rr = __builtin_amdgcn_permlane32_swap(__float_as_uint(ps), __float_as_uint(ps), false, false); ps = __uint_as_float(rr[0]) + __uint_as_float(rr[1]); }
    l_reg = l_reg * alpha + ps;
#define PK4(P, B_, OUT) do { unsigned a0 = cvtpk(P[B_+0], P[B_+1]), a1 = cvtpk(P[B_+2], P[B_+3]);                          \
        unsigned b0 = cvtpk(P[B_+4], P[B_+5]), b1 = cvtpk(P[B_+6], P[B_+7]);                                             \
        auto r0 = __builtin_amdgcn_permlane32_swap(a0, b0, false, false); auto r1 = __builtin_amdgcn_permlane32_swap(a1, b1, false, false); \
        u32x4 w = {r0[0], r1[0], r0[1], r1[1]}; OUT = *reinterpret_cast<bf16x8*>(&w); } while (0)
    PK4(p0, 0, pa0); PK4(p0, 8, pa1); PK4(p1, 0, pa2); PK4(p1, 8, pa3);
#undef PK4
}
DI void qkt(f32x16& p0, f32x16& p1, const char* Kb, int r32, int hi, const bf16x8* qr) {
    p0 = f32x16{}; p1 = f32x16{};
    const char* kb[4];
#pragma unroll
    for (int dd = 0; dd < 4; ++dd) kb[dd] = Kb + KSWZ(r32, (dd * 16 + hi * 8) * 2);
#pragma unroll
    for (int d0 = 0; d0 < 8; ++d0) { const char* a = kb[d0 & 3] + (d0 >> 2) * 128;
        bf16x8 b0 = *reinterpret_cast<const bf16x8*>(a);
        bf16x8 b1 = *reinterpret_cast<const bf16x8*>(a + 32 * 256);
        p0 = __builtin_amdgcn_mfma_f32_32x32x16_bf16(b0, qr[d0], p0, 0, 0, 0);
        p1 = __builtin_amdgcn_mfma_f32_32x32x16_bf16(b1, qr[d0], p1, 0, 0, 0); }
}
DI void pv_tile(f32x16* o, int vb0, bf16x8 pa0, bf16x8 pa1, bf16x8 pa2, bf16x8 pa3) {
#define TRRD(dst, off) asm volatile("ds_read_b64_tr_b16 %0, %1 offset:%2" : "=&v"(dst) : "v"(vb0), "i"(off) : "memory")
#define PV_D0(d0) do { s16x4 l0, l1, l2, l3, h0, h1, h2, h3; constexpr int b_ = v_rd_off(d0, 0, 0); \
        TRRD(l0, b_); TRRD(h0, b_ + 2048); TRRD(l1, b_ + 4096); TRRD(h1, b_ + 6144); TRRD(l2, b_ + 8192); TRRD(h2, b_ + 10240); TRRD(l3, b_ + 12288); TRRD(h3, b_ + 14336); \
        asm volatile("s_waitcnt lgkmcnt(0)" ::: "memory"); SBAR();   \
        o[d0] = __builtin_amdgcn_mfma_f32_32x32x16_bf16(pa0, (bf16x8){l0[0], l0[1], l0[2], l0[3], h0[0], h0[1], h0[2], h0[3]}, o[d0], 0, 0, 0);   \
        o[d0] = __builtin_amdgcn_mfma_f32_32x32x16_bf16(pa1, (bf16x8){l1[0], l1[1], l1[2], l1[3], h1[0], h1[1], h1[2], h1[3]}, o[d0], 0, 0, 0);   \
        o[d0] = __builtin_amdgcn_mfma_f32_32x32x16_bf16(pa2, (bf16x8){l2[0], l2[1], l2[2], l2[3], h2[0], h2[1], h2[2], h2[3]}, o[d0], 0, 0, 0);   \
        o[d0] = __builtin_amdgcn_mfma_f32_32x32x16_bf16(pa3, (bf16x8){l3[0], l3[1], l3[2], l3[3], h3[0], h3[1], h3[2], h3[3]}, o[d0], 0, 0, 0); } while (0)
    PV_D0(0); PV_D0(1); PV_D0(2); PV_D0(3);
#undef PV_D0
#undef TRRD
}
DI void fox_block(const Args& a, char* lds, int h, int P0, int j_lo) {
    const int tid = threadIdx.x, wid = __builtin_amdgcn_readfirstlane(tid >> 6), lane = tid & 63, r32 = lane & 31, hi = lane >> 5;
    const bf16_t* P = (const bf16_t*)(a.ws + WS_PROJ); const float* F = (const float*)(a.ws + WS_F) + (size_t)h * SEQ; bf16_t* OB = (bf16_t*)(a.ws + WS_OB);
    const bf16_t* Qp = P + PJ_FQ + h * 128; const bf16_t* Kp = P + PJ_FK + h * 128; const bf16_t* Vp = P + PJ_FV + h * 128;
    const int j_hi = (P0 + 255) / KVBLK + 1, NT = j_hi - j_lo;
    const int qlo = P0 + wid * 32, qm = qlo + r32 - 4 * hi;
    char* V_lds = lds + OFF_V; char* K_lds = lds + OFF_K; float* G_lds = (float*)(lds + OFF_G);
    float* wsp = (float*)(lds + OFF_WS) + wid * 64; float* li_l = wsp; float* al_l = wsp + 32;
    const int sr = tid >> 4, sc = (tid & 15) * 8, vst0 = v_st(sr, sc), vst1 = v_st(32 + sr, sc), kws = KSWZ(sr, sc * 2);
    const int vb0 = (int)(unsigned)(uintptr_t)(LAS char*)V_lds + v_rd_base(lane);
    const float Fref = F[P0];
    bf16x8 qr[8];
#pragma unroll
    for (int d0 = 0; d0 < 8; ++d0) qr[d0] = *(const bf16x8*)(Qp + (size_t)(qlo + r32) * NPJ + d0 * 16 + hi * 8);
    float m_reg = -1e30f, l_reg = 0.f; f32x16 o[4] = {};
    bf16x8 st_k0, st_k1, st_v0, st_v1; float st_g = 0.f;
#define FOX_LOAD(t) do { const size_t k0_ = (size_t)(j_lo + (t)) * KVBLK; \
        st_k0 = *(const bf16x8*)(Kp + (k0_ + sr) * NPJ + sc); st_k1 = *(const bf16x8*)(Kp + (k0_ + 32 + sr) * NPJ + sc); \
        st_v0 = *(const bf16x8*)(Vp + (k0_ + sr) * NPJ + sc); st_v1 = *(const bf16x8*)(Vp + (k0_ + 32 + sr) * NPJ + sc); \
        if (tid < 64) st_g = F[k0_ + tid]; } while (0)
#define FOX_WRITE(bf) do { *(bf16x8*)(K_lds + (bf) * SHM_K + kws) = st_k0; *(bf16x8*)(K_lds + (bf) * SHM_K + kws + 32 * 256) = st_k1; \
        *(bf16x8*)(V_lds + (bf) * SHM_V + vst0) = st_v0; *(bf16x8*)(V_lds + (bf) * SHM_V + vst1) = st_v1; \
        if (tid < 64) G_lds[(bf) * 64 + tid] = (st_g - Fref) * (1.f / SCALE); } while (0)
    FOX_LOAD(0); asm volatile("s_waitcnt vmcnt(0)" ::: "memory"); FOX_WRITE(0);
    __syncthreads();
    for (int t = 0; t < NT; ++t) {
        const int bf = t & 1, kb_ = (j_lo + t) * KVBLK;
        if (t + 1 < NT) FOX_LOAD(t + 1);
        if (kb_ <= qlo + 31) {
            f32x16 p0, p1; float mn, al; bf16x8 pa0, pa1, pa2, pa3;
            qkt(p0, p1, K_lds + bf * SHM_K, r32, hi, qr);
            const float* gt = G_lds + bf * 64 + 4 * hi;
#pragma unroll
            for (int g4 = 0; g4 < 4; ++g4) { const f32x4 g0 = *(const f32x4*)(gt + 8 * g4), g1 = *(const f32x4*)(gt + 32 + 8 * g4);
#pragma unroll
                for (int i = 0; i < 4; ++i) { p0[4 * g4 + i] -= g0[i]; p1[4 * g4 + i] -= g1[i]; } }
            if (kb_ + KVBLK - 1 > qlo) mask_tile(p0, p1, qm - kb_);
            partialSM(p0, p1, m_reg, mn, al);
            finishSM(p0, p1, al, l_reg, pa0, pa1, pa2, pa3);
            if (__any(al < 1.f)) { if (hi == 0) al_l[r32] = al; asm volatile("s_waitcnt lgkmcnt(0)" ::: "memory");
#pragma unroll
                for (int d_ = 0; d_ < 4; ++d_)
#pragma unroll
                    for (int r = 0; r < 16; ++r) o[d_][r] *= al_l[crow(r, hi)]; }
            SBAR();
            pv_tile(o, vb0 + bf * SHM_V, pa0, pa1, pa2, pa3);
        }
        if (t + 1 < NT) { asm volatile("s_waitcnt vmcnt(0)" ::: "memory"); FOX_WRITE(bf ^ 1); }
        __syncthreads();
    }
#undef FOX_LOAD
#undef FOX_WRITE
    if (hi == 0) li_l[r32] = l_reg;
    asm volatile("s_waitcnt lgkmcnt(0)" ::: "memory");
    bf16_t* Ow = OB + (size_t)qlo * 512 + h * 128;
#pragma unroll
    for (int r = 0; r < 16; ++r) { const int orow = crow(r, hi); const float rl = __builtin_amdgcn_rcpf(li_l[orow]);
#pragma unroll
        for (int d0 = 0; d0 < 4; ++d0) { const float v = o[d0][r] * rl; const float vn = __shfl_xor(v, 1);
            if ((r32 & 1) == 0) *(unsigned*)(Ow + (size_t)orow * 512 + d0 * 32 + r32) = cvtpk(v, vn); } }
    __syncthreads();
}
#undef KSWZ
}

DI void transpose_tile(float* tile, const float* src, int ld, int k0, int c0, int c1, bf16_t* dst, int Kd) {
    const int tid = threadIdx.x, nn = tid & 63, k8 = tid >> 6; const int col = nn < 32 ? c0 + nn : c1 + nn - 32;
    const float* s = src + (size_t)(k0 + k8 * 8) * ld + col;
    float v[8];
#pragma unroll
    for (int i = 0; i < 8; ++i) v[i] = s[(size_t)i * ld];
    u32x4 w; w.x = cvt_pk(v[0], v[1]); w.y = cvt_pk(v[2], v[3]); w.z = cvt_pk(v[4], v[5]); w.w = cvt_pk(v[6], v[7]);
    *(u32x4*)(dst + (size_t)nn * Kd + k0 + k8 * 8) = w;
}
DI void ph0(const Args& a, float* lds) {
    const int tid = threadIdx.x, G = gridDim.x, bx = blockIdx.x;
    unsigned char* ws = a.ws;
    for (int grp = bx; grp < 256; grp += G) {
        const int col = tid % 24, ks = tid / 24, j = grp * 24 + col; const float* c = a.in[I_C]; const float* w = a.in[I_WADA];
        float acc = 0.f;
        if (ks < 21) { const int k1 = (ks * 49 + 49) < DM ? (ks * 49 + 49) : DM; for (int k = ks * 49; k < k1; ++k) acc += c[k] * w[(size_t)k * 6144 + j]; }
        __syncthreads();
        if (ks < 21) lds[ks * 24 + col] = acc;
        __syncthreads();
        if (tid < 24) { float s = a.in[I_BADA][grp * 24 + tid]; for (int q = 0; q < 21; ++q) s += lds[q * 24 + tid]; ((float*)(ws + WS_MOD))[grp * 24 + tid] = s; }
    }
    constexpr int T_WIN = 88 * 16, T_WOA = 16 * 8, T_WOUT = 16 * 16, T_WGU = 32 * 32 * 16, T_WD = 32 * 16 * 16;
    constexpr int NT = T_WIN + 2 * T_WOA + T_WOUT + T_WGU + T_WD;
    for (int t = bx; t < NT; t += G) {
        int r = t;
        if (r < T_WIN) { const int nt = r / 16, kt = r % 16, n0 = nt * 64; const int c0 = n0 + (n0 >= 3584 ? 12 : (n0 >= 2048 ? 8 : 0));
            transpose_tile(lds, a.in[I_WIN], NIN, kt * 64, c0, c0 + 32, (bf16_t*)(ws + WS_WINT) + (size_t)n0 * DM, DM); continue; }
        r -= T_WIN;
        if (r < T_WOA) { const int nt = r / 8, kt = r % 8, n0 = nt * 64; transpose_tile(lds, a.in[I_WOD], DM, kt * 64, n0, n0 + 32, (bf16_t*)(ws + WS_WOAT) + (size_t)n0 * 512, 512); continue; }
        r -= T_WOA;
        if (r < T_WOA) { const int nt = r / 8, kt = r % 8, n0 = nt * 64; transpose_tile(lds, a.in[I_WOF], DM, kt * 64, n0, n0 + 32, (bf16_t*)(ws + WS_WOBT) + (size_t)n0 * 512, 512); continue; }
        r -= T_WOA;
        if (r < T_WOUT) { const int nt = r / 16, kt = r % 16, n0 = nt * 64; transpose_tile(lds, a.in[I_WOUT], DM, kt * 64, n0, n0 + 32, (bf16_t*)(ws + WS_WOUTT) + (size_t)n0 * DM, DM); continue; }
        r -= T_WOUT;
        if (r < T_WGU) { const int e = r / 512, q = r % 512, nt = q / 16, kt = q % 16, n0 = nt * 64;
            transpose_tile(lds, a.in[I_WGU] + (size_t)e * DM * 2048, 2048, kt * 64, gu_src(n0), gu_src(n0 + 32), (bf16_t*)(ws + WS_WGUT) + ((size_t)e * 2048 + n0) * DM, DM); continue; }
        r -= T_WGU;
        { const int e = r / 256, q = r % 256, nt = q / 16, kt = q % 16, n0 = nt * 64;
            transpose_tile(lds, a.in[I_WD] + (size_t)e * DM * DM, DM, kt * 64, n0, n0 + 32, (bf16_t*)(ws + WS_WDT) + ((size_t)e * DM + n0) * DM, DM); }
    }
}

DI void ph1(const Args& a, float* lds) {
    const int tid = threadIdx.x, lane = tid & 63, wave = tid >> 6, G = gridDim.x;
    float* A1 = lds; float* B1 = lds + 1024; float* wsm = lds + 2048;
    const float* mod = (const float*)(a.ws + WS_MOD);
    for (int k = tid; k < DM; k += NTHREADS) { A1[k] = a.in[I_G1][k] * (1.f + mod[1024 + k]); B1[k] = mod[k]; }
    for (int i = tid; i < 12 * DM; i += NTHREADS) { const int k = i / 12, j = i % 12; wsm[j * DM + k] = a.in[I_WIN][(size_t)k * NIN + (j < 8 ? 2048 + j : 3592 + (j - 8))]; }
    __syncthreads();
    bf16_t* H = (bf16_t*)(a.ws + WS_H); float* SP = (float*)(a.ws + WS_SP);
    for (int t = blockIdx.x * NWAVES + wave; t < SEQ; t += G * NWAVES) {
        const float* xr = a.in[I_X] + (size_t)t * DM;
        f32x4 v[4]; float ss = 0.f;
#pragma unroll
        for (int i = 0; i < 4; ++i) { v[i] = *(const f32x4*)(xr + lane * 4 + 256 * i); ss += v[i][0] * v[i][0] + v[i][1] * v[i][1] + v[i][2] * v[i][2] + v[i][3] * v[i][3]; }
        ss = wave_sum(ss);
        const float rstd = rsqrtf(ss * (1.f / DM) + 1e-6f);
#pragma unroll
        for (int i = 0; i < 4; ++i) { const int k = lane * 4 + 256 * i;
#pragma unroll
            for (int e = 0; e < 4; ++e) v[i][e] = v[i][e] * rstd * A1[k + e] + B1[k + e];
            u32x2 w; w.x = pk2(v[i][0], v[i][1]); w.y = pk2(v[i][2], v[i][3]);
            *(u32x2*)(H + (size_t)t * DM + k) = w; }
#pragma unroll 1
        for (int j = 0; j < 12; ++j) { float pj = 0.f;
#pragma unroll
            for (int i = 0; i < 4; ++i) { const f32x4 wv = *(const f32x4*)(wsm + j * DM + lane * 4 + 256 * i); pj += v[i][0] * wv[0] + v[i][1] * wv[1] + v[i][2] * wv[2] + v[i][3] * wv[3]; }
            const float s = wave_sum(pj); if (lane == j) SP[(size_t)t * 16 + j] = s; }
    }
}

DI void ph2(const Args& a, unsigned char* ldsb) {
    pg8::Gemm g{(const bf16_t*)(a.ws + WS_H), (const bf16_t*)(a.ws + WS_WINT), SEQ, NPJ, DM};
    pg8::OrderDense S; S.init(SEQ / 256, NPJ / 256, (int)gridDim.x, (int)blockIdx.x);
    pg8::EpiStoreBf16 E{(bf16_t*)(a.ws + WS_PROJ), NPJ, nullptr, 0};
    pg8::gemm_phase<pg8::EpiStoreBf16, pg8::OrderDense>((LAS unsigned char*)ldsb, g, S, E);
}

DI void ph3_fcum(const Args& a, float* lds) {
    const int tid = threadIdx.x, h = blockIdx.x;
    const float* SP = (const float*)(a.ws + WS_SP); float* F = (float*)(a.ws + WS_F);
    const float bf = a.in[I_BFG][h];
    double* part = (double*)lds;
    double s = 0.0;
    for (int i = 0; i < 32; ++i) s += (double)logsigf(SP[(size_t)(tid * 32 + i) * 16 + 8 + h] + bf);
    part[tid] = s;
    __syncthreads();
    double off = 0.0;
    for (int i = 0; i < tid; ++i) off += part[i];
    for (int i = 0; i < 32; ++i) { off += (double)logsigf(SP[(size_t)(tid * 32 + i) * 16 + 8 + h] + bf); F[(size_t)h * SEQ + tid * 32 + i] = (float)off; }
    __syncthreads();
}
namespace prep {
constexpr int QS = 0, KS = 17408, KT = 34816, VT = 53248, UNIT = 71680, SM = 2 * UNIT;
DI bf16x8 ld8(const char* p) { return *(const bf16x8*)p; }
template <int C, int M4> struct TRow { static DI void run(const float (&T)[64], const float* Ls, float& a0, float& a1) {
    if constexpr (4 * M4 < C) { const f32x4 Lv = *(const f32x4*)(Ls + C * 68 + 4 * M4);
        a0 -= Lv[0] * T[4 * M4]; if constexpr (4 * M4 + 1 < C) a1 -= Lv[1] * T[4 * M4 + 1]; if constexpr (4 * M4 + 2 < C) a0 -= Lv[2] * T[4 * M4 + 2]; if constexpr (4 * M4 + 3 < C) a1 -= Lv[3] * T[4 * M4 + 3];
        TRow<C, M4 + 1>::run(T, Ls, a0, a1); } } };
template <int C> struct TRow<C, 16> { static DI void run(const float (&)[64], const float*, float&, float&) {} };
template <int C> DI void tsolve(float (&T)[64], const float* Ls, int lane) {
    if constexpr (C < 64) { float a0 = (lane == C) ? 1.f : 0.f, a1 = 0.f; TRow<C, 0>::run(T, Ls, a0, a1); T[C] = a0 + a1; asm volatile("" ::: "memory"); __builtin_amdgcn_sched_barrier(0); tsolve<C + 1>(T, Ls, lane); } }
}
DI void ph3_prep2(const Args& a, char* lds, int pair) {
    using namespace prep;
    const int tid = threadIdx.x, lane = tid & 63, wave = tid >> 6, grp = wave >> 2, wq = wave & 3, tg = tid & 255, lr = lane & 15, lq = lane >> 4;
    int unit = pair * 2 + grp; if (unit >= NH * NCH) unit = NH * NCH - 1;
    const int h = unit & 3, n = unit >> 2, t0 = n * CH;
    char* U = lds + grp * UNIT;
    float* gcs = (float*)(lds + SM) + grp * 192; float* bes = gcs + 64; float* egs = gcs + 128;
    const float* SP = (const float*)(a.ws + WS_SP); const bf16_t* P = (const bf16_t*)(a.ws + WS_PROJ);
    const size_t cb = (size_t)(h * NCH + n);
    bf16_t* WF = (bf16_t*)(a.ws + WS_DNW) + cb * 8192; bf16_t* UF = (bf16_t*)(a.ws + WS_DNU) + cb * 8192;
    bf16_t* QF = (bf16_t*)(a.ws + WS_DNQD) + cb * 8192; bf16_t* KF = (bf16_t*)(a.ws + WS_DNKD) + cb * 8192; bf16_t* AF = (bf16_t*)(a.ws + WS_DNATT) + cb * 4096;
    __syncthreads();
    if (wq == 0) { const int t = t0 + lane;
        const float be = sigm(SP[(size_t)t * 16 + h]);
        float g = -expf(a.in[I_ALOG][h]) * softplusf(SP[(size_t)t * 16 + 4 + h] + a.in[I_DTB][h]);
#pragma unroll
        for (int o_ = 1; o_ < 64; o_ <<= 1) { const float y = __shfl_up(g, o_); if (lane >= o_) g += y; }
        gcs[lane] = g; bes[lane] = be; egs[lane] = expf(g); }
    __syncthreads();
    { const int d8 = tg & 15, ci = tg >> 4; const float* cw = a.in[I_CONVW];
#pragma unroll 1
        for (int sec = 0; sec < 3; ++sec) {
            const int col = sec * 512 + h * 128 + d8 * 8;
            f32x4 w[4][2];
#pragma unroll
            for (int j = 0; j < 4; ++j) { w[j][0] = *(const f32x4*)(cw + j * 1536 + col); w[j][1] = *(const f32x4*)(cw + j * 1536 + col + 4); }
#pragma unroll 1
            for (int i = 0; i < 4; ++i) { const int c = ci + 16 * i, t = t0 + c;
                float v[8];
#pragma unroll
                for (int e = 0; e < 8; ++e) v[e] = 0.f;
#pragma unroll
                for (int j = 0; j < 4; ++j) { const int tt = t - 3 + j;
                    if (tt >= 0) { const u32x4 x = *(const u32x4*)(P + (size_t)tt * NPJ + col);
                        v[0] += w[j][0][0] * __uint_as_float(x.x << 16); v[1] += w[j][0][1] * __uint_as_float(x.x & 0xffff0000u); v[2] += w[j][0][2] * __uint_as_float(x.y << 16); v[3] += w[j][0][3] * __uint_as_float(x.y & 0xffff0000u);
                        v[4] += w[j][1][0] * __uint_as_float(x.z << 16); v[5] += w[j][1][1] * __uint_as_float(x.z & 0xffff0000u); v[6] += w[j][1][2] * __uint_as_float(x.w << 16); v[7] += w[j][1][3] * __uint_as_float(x.w & 0xffff0000u); } }
                float ss = 0.f;
#pragma unroll
                for (int e = 0; e < 8; ++e) { v[e] = siluf(v[e]); ss += v[e] * v[e]; }
                if (sec < 2) { ss += __shfl_xor(ss, 1); ss += __shfl_xor(ss, 2); ss += __shfl_xor(ss, 4); ss += __shfl_xor(ss, 8);
                    const float sc = rsqrtf(ss + 1e-6f) * (sec == 0 ? 0.08838834764831845f : 1.f);
#pragma unroll
                    for (int e = 0; e < 8; ++e) v[e] *= sc; }
                u32x4 pk; pk.x = cvt_pk(v[0], v[1]); pk.y = cvt_pk(v[2], v[3]); pk.z = cvt_pk(v[4], v[5]); pk.w = cvt_pk(v[6], v[7]);
                if (sec == 0) { *(u32x4*)(U + QS + c * 272 + d8 * 16) = pk;
                    const float eg = egs[c];
                    const int base = (((c >> 4) * 4 + (d8 >> 2)) * 64 + (c & 15)) * 8 + 4 * ((d8 & 3) >> 1), l0 = (2 * (d8 & 3)) & 3;
                    u32x2 q0, q1; q0.x = cvt_pk(v[0] * eg, v[1] * eg); q0.y = cvt_pk(v[2] * eg, v[3] * eg); q1.x = cvt_pk(v[4] * eg, v[5] * eg); q1.y = cvt_pk(v[6] * eg, v[7] * eg);
                    *(u32x2*)(QF + base + l0 * 128) = q0; *(u32x2*)(QF + base + (l0 + 1) * 128) = q1; }
                else { if (sec == 1) *(u32x4*)(U + KS + c * 272 + d8 * 16) = pk;
                    bf16_t* T_ = (bf16_t*)(U + (sec == 1 ? KT : VT)) + (d8 * 8) * 72 + c;
                    T_[0 * 72] = (bf16_t)(pk.x & 0xffffu); T_[1 * 72] = (bf16_t)(pk.x >> 16); T_[2 * 72] = (bf16_t)(pk.y & 0xffffu); T_[3 * 72] = (bf16_t)(pk.y >> 16);
                    T_[4 * 72] = (bf16_t)(pk.z & 0xffffu); T_[5 * 72] = (bf16_t)(pk.z >> 16); T_[6 * 72] = (bf16_t)(pk.w & 0xffffu); T_[7 * 72] = (bf16_t)(pk.w >> 16); }
            }
        }
    }
    __syncthreads();
    f32x4 Lr[4];
    { const int mt = wq;
#pragma unroll
        for (int nt = 0; nt < 4; ++nt) { Lr[nt] = (f32x4){0.f, 0.f, 0.f, 0.f};
            if (nt <= mt) {
#pragma unroll
                for (int s = 0; s < 4; ++s) Lr[nt] = MFMA16(ld8(U + KS + (16 * mt + lr) * 272 + (32 * s + 8 * lq) * 2), ld8(U + KS + (16 * nt + lr) * 272 + (32 * s + 8 * lq) * 2), Lr[nt]); } }
        const int ntq = 3 - wq; const float gcc = gcs[16 * ntq + lr];
#pragma unroll
        for (int mtk = 0; mtk < 4; ++mtk) { f32x4 acc = (f32x4){0.f, 0.f, 0.f, 0.f};
            if (mtk <= ntq) {
#pragma unroll
                for (int s = 0; s < 4; ++s) acc = MFMA16(ld8(U + KS + (16 * mtk + lr) * 272 + (32 * s + 8 * lq) * 2), ld8(U + QS + (16 * ntq + lr) * 272 + (32 * s + 8 * lq) * 2), acc);
#pragma unroll
                for (int r = 0; r < 4; ++r) { const int m = 16 * mtk + 4 * lq + r, c = 16 * ntq + lr; acc[r] = (m <= c) ? acc[r] * expf(gcc - gcs[m]) : 0.f; } }
            u32x2 o_; o_.x = cvt_pk(acc[0], acc[1]); o_.y = cvt_pk(acc[2], acc[3]);
            *(u32x2*)(AF + ((ntq * 2 + (mtk >> 1)) * 64 + lane) * 8 + 4 * (mtk & 1)) = o_; }
    }
    __syncthreads();
    { const int mt = wq; float* LT = (float*)(U + QS);
#pragma unroll
        for (int nt = 0; nt < 4; ++nt) if (nt <= mt) { const int m = 16 * nt + lr; f32x4 o_;
#pragma unroll
            for (int r = 0; r < 4; ++r) { const int c = 16 * mt + 4 * lq + r; o_[r] = (m < c) ? bes[c] * Lr[nt][r] * expf(gcs[c] - gcs[m]) : 0.f; }
            *(f32x4*)(LT + m * 68 + 16 * mt + 4 * lq) = o_; } }
    __syncthreads();
    if (wq == 0) { const float* LT = (const float*)(U + QS); float* Tl = (float*)(U + KS);
#pragma unroll
        for (int ib = 0; ib < 4; ++ib) { float acc[16];
#pragma unroll
            for (int r = 0; r < 16; ++r) acc[r] = (lane == 16 * ib + r) ? 1.f : 0.f;
#pragma unroll 2
            for (int m = 0; m < 16 * ib; ++m) { const float t = Tl[m * 68 + lane];
#pragma unroll
                for (int q = 0; q < 4; ++q) { const f32x4 Lv = *(const f32x4*)(LT + m * 68 + 16 * ib + 4 * q);
#pragma unroll
                    for (int e = 0; e < 4; ++e) acc[4 * q + e] -= Lv[e] * t; } }
#pragma unroll
            for (int p = 0; p < 16; ++p) { const float t = acc[p]; Tl[(16 * ib + p) * 68 + lane] = t;
                if (p < 15) {
#pragma unroll
                    for (int q = 0; q < 4; ++q) if (4 * q + 3 > p) { const f32x4 Lv = *(const f32x4*)(LT + (16 * ib + p) * 68 + 16 * ib + 4 * q);
#pragma unroll
                        for (int e = 0; e < 4; ++e) if (4 * q + e > p) acc[4 * q + e] -= Lv[e] * t; } } }
            asm volatile("s_waitcnt lgkmcnt(0)" ::: "memory"); }
        if (lane == 0) ((float*)(a.ws + WS_EG))[cb] = egs[63];
    } else { const float gl = gcs[63];
        for (int i = tg - 64; i < 2048; i += 192) { const int dk = i >> 4, cq = i & 15;
            const u32x2 x = *(const u32x2*)(U + KT + dk * 144 + cq * 8);
            const float e0 = expf(gl - gcs[4 * cq]), e1 = expf(gl - gcs[4 * cq + 1]), e2 = expf(gl - gcs[4 * cq + 2]), e3 = expf(gl - gcs[4 * cq + 3]);
            u32x2 o_; o_.x = cvt_pk(__uint_as_float(x.x << 16) * e0, __uint_as_float(x.x & 0xffff0000u) * e1); o_.y = cvt_pk(__uint_as_float(x.y << 16) * e2, __uint_as_float(x.y & 0xffff0000u) * e3);
            *(u32x2*)(KF + (((dk >> 4) * 2 + (cq >> 3)) * 64 + (cq & 3) * 16 + (dk & 15)) * 8 + 4 * ((cq >> 2) & 1)) = o_; } }
    __syncthreads();
    { const float* Tl = (const float*)(U + KS); const int c = tg >> 2, m0 = (tg & 3) * 16;
        f32x4 tv[4];
#pragma unroll
        for (int q = 0; q < 4; ++q) tv[q] = *(const f32x4*)(Tl + c * 68 + m0 + 4 * q);
        __syncthreads();
        bf16_t* Tb = (bf16_t*)(U + QS); bf16_t* Tg = (bf16_t*)(U + KS);
#pragma unroll
        for (int q = 0; q < 4; ++q) { u32x2 b_, g_; float be[4], bg[4];
#pragma unroll
            for (int e = 0; e < 4; ++e) { const int m = m0 + 4 * q + e; be[e] = tv[q][e] * bes[m]; bg[e] = be[e] * egs[m]; }
            b_.x = cvt_pk(be[0], be[1]); b_.y = cvt_pk(be[2], be[3]); g_.x = cvt_pk(bg[0], bg[1]); g_.y = cvt_pk(bg[2], bg[3]);
            *(u32x2*)(Tb + c * 72 + m0 + 4 * q) = b_; *(u32x2*)(Tg + c * 72 + m0 + 4 * q) = g_; } }
    __syncthreads();
    {
#pragma unroll
        for (int q = 0; q < 2; ++q) { const int nt = 2 * wq + q;
#pragma unroll
            for (int mt = 0; mt < 4; ++mt) { f32x4 acc = (f32x4){0.f, 0.f, 0.f, 0.f};
#pragma unroll
                for (int s = 0; s < 2; ++s) acc = MFMA16(ld8(U + QS + (16 * mt + lr) * 144 + (32 * s + 8 * lq) * 2), ld8(U + VT + (16 * nt + lr) * 144 + (32 * s + 8 * lq) * 2), acc);
                u32x2 o_; o_.x = cvt_pk(acc[0], acc[1]); o_.y = cvt_pk(acc[2], acc[3]);
                *(u32x2*)(UF + ((nt * 4 + mt) * 64 + lane) * 4) = o_; } }
#pragma unroll
        for (int q = 0; q < 2; ++q) { const int mtk = 2 * wq + q;
#pragma unroll
            for (int ntc = 0; ntc < 4; ++ntc) { f32x4 acc = (f32x4){0.f, 0.f, 0.f, 0.f};
#pragma unroll
                for (int s = 0; s < 2; ++s) acc = MFMA16(ld8(U + KT + (16 * mtk + lr) * 144 + (32 * s + 8 * lq) * 2), ld8(U + KS + (16 * ntc + lr) * 144 + (32 * s + 8 * lq) * 2), acc);
                u32x2 o_; o_.x = cvt_pk(-acc[0], -acc[1]); o_.y = cvt_pk(-acc[2], -acc[3]);
                *(u32x2*)(WF + ((ntc * 4 + (mtk >> 1)) * 64 + lane) * 8 + 4 * (mtk & 1)) = o_; } }
    }
}
DI void ph3_norms(const Args& a) {
    const int lane = threadIdx.x & 63, wave = threadIdx.x >> 6, NW = gridDim.x * NWAVES;
    const bf16_t* P = (const bf16_t*)(a.ws + WS_PROJ); unsigned* NRM = (unsigned*)(a.ws + WS_NRM);
    float mq = 0.f, mk = 0.f; const int gw = blockIdx.x * NWAVES + wave, h = gw & 3;
    for (int id = gw; id < SEQ * 4; id += NW) { const int t = id >> 2; const bf16_t* row = P + (size_t)t * NPJ + h * 128;
        const float q0 = bf2f(row[PJ_FQ + lane]), q1 = bf2f(row[PJ_FQ + 64 + lane]), k0 = bf2f(row[PJ_FK + lane]), k1 = bf2f(row[PJ_FK + 64 + lane]);
        mq = fmaxf(mq, wave_sum(q0 * q0 + q1 * q1)); mk = fmaxf(mk, wave_sum(k0 * k0 + k1 * k1)); }
    if ((NW & 3) == 0 && lane == 0) { atomicMax(&NRM[h], __float_as_uint(mq)); atomicMax(&NRM[4 + h], __float_as_uint(mk)); }
}
DI void ph3(const Args& a, float* lds) {
    const int G = gridDim.x;
    if (blockIdx.x < 4) ph3_fcum(a, lds);
    for (int p = blockIdx.x; p < NH * NCH / 2; p += G) ph3_prep2(a, (char*)lds, p);
    ph3_norms(a);
}

namespace dn {
DI unsigned cvtpk(float lo, float hi) { return cvt_pk(lo, hi); }
DI bf16x8 packB(const f32x4& t0, const f32x4& t1) { u32x4 w = {cvtpk(t0[0], t0[1]), cvtpk(t0[2], t0[3]), cvtpk(t1[0], t1[1]), cvtpk(t1[2], t1[3])}; return *reinterpret_cast<bf16x8*>(&w); }
DI bf16x8 frag(const bf16_t* base, int f, int lane) { return *(const bf16x8*)(base + ((size_t)f * 64 + lane) * 8); }
template <bool WITH_U, bool WITH_O>
DI void step(const bf16_t* WFn, const bf16_t* KFn, const bf16_t* QFn, const bf16_t* AFn, const bf16_t* UFs, float eg, f32x4 (&S)[8], f32x4 (&o)[4], int lane) {
    bf16x8 sb[4];
#pragma unroll
    for (int s = 0; s < 4; ++s) sb[s] = packB(S[2 * s], S[2 * s + 1]);
    f32x4 vn[4];
#pragma unroll
    for (int mt = 0; mt < 4; ++mt) {
        if (WITH_U) { const u32x2 w = *(const u32x2*)(UFs + ((size_t)mt * 64 + lane) * 4); vn[mt] = (f32x4){__uint_as_float(w.x << 16), __uint_as_float(w.x & 0xffff0000u), __uint_as_float(w.y << 16), __uint_as_float(w.y & 0xffff0000u)}; }
        else vn[mt] = (f32x4){0.f, 0.f, 0.f, 0.f};
#pragma unroll
        for (int s = 0; s < 4; ++s) vn[mt] = MFMA16(frag(WFn, mt * 4 + s, lane), sb[s], vn[mt]); }
    if (WITH_O) {
#pragma unroll
        for (int mt = 0; mt < 4; ++mt) { o[mt] = (f32x4){0.f, 0.f, 0.f, 0.f};
#pragma unroll
            for (int s = 0; s < 4; ++s) o[mt] = MFMA16(frag(QFn, mt * 4 + s, lane), sb[s], o[mt]); } }
    bf16x8 vb[2];
#pragma unroll
    for (int s = 0; s < 2; ++s) vb[s] = packB(vn[2 * s], vn[2 * s + 1]);
    if (WITH_O) {
#pragma unroll
        for (int mt = 0; mt < 4; ++mt)
#pragma unroll
            for (int s = 0; s < 2; ++s) o[mt] = MFMA16(frag(AFn, mt * 2 + s, lane), vb[s], o[mt]); }
#pragma unroll
    for (int mt = 0; mt < 8; ++mt) { S[mt] = S[mt] * eg;
#pragma unroll
        for (int s = 0; s < 2; ++s) S[mt] = MFMA16(frag(KFn, mt * 2 + s, lane), vb[s], S[mt]); }
}
}
constexpr int NGRP = 16, GRP = 16;
DI void scanA(const Args& a) {
    const int lane = threadIdx.x & 63, wave = threadIdx.x >> 6, lr = lane & 15, lq = lane >> 4;
    if (wave >= 4) return;
    for (int task = blockIdx.x * 4 + wave; task < NH * NGRP * 16; task += gridDim.x * 4) {
        const int chain = task >> 4, sl = task & 15, h = chain >> 4, g = chain & 15; const bool isP = sl >= 8; const int vs = sl & 7;
        f32x4 S[8], o[4];
#pragma unroll
        for (int mt = 0; mt < 8; ++mt)
#pragma unroll
            for (int r = 0; r < 4; ++r) S[mt][r] = (isP && (16 * mt + 4 * lq + r == 16 * vs + lr)) ? 1.f : 0.f;
        for (int n = g * GRP; n < (g + 1) * GRP; ++n) { const size_t cb = (size_t)(h * NCH + n);
            const bf16_t* WFn = (const bf16_t*)(a.ws + WS_DNW) + cb * 8192; const bf16_t* KFn = (const bf16_t*)(a.ws + WS_DNKD) + cb * 8192;
            const bf16_t* UFs = (const bf16_t*)(a.ws + WS_DNU) + cb * 8192 + (size_t)vs * 1024; const float eg = ((const float*)(a.ws + WS_EG))[cb];
            if (isP) dn::step<false, false>(WFn, KFn, nullptr, nullptr, nullptr, eg, S, o, lane);
            else dn::step<true, false>(WFn, KFn, nullptr, nullptr, UFs, eg, S, o, lane); }
        if (isP) { bf16_t* PG = (bf16_t*)(a.ws + WS_PG) + (size_t)chain * 16384;
#pragma unroll
            for (int mt = 0; mt < 8; ++mt)
#pragma unroll
                for (int r = 0; r < 4; ++r) PG[((mt * 4 + (vs >> 1)) * 64 + (lr >> 2) * 16 + 4 * lq + r) * 8 + 4 * (vs & 1) + (lr & 3)] = f2bf(S[mt][r]); }
        else { float* QG = (float*)(a.ws + WS_QG) + ((size_t)chain * 8 + vs) * 2048;
#pragma unroll
            for (int mt = 0; mt < 8; ++mt) *(f32x4*)(QG + ((size_t)mt * 64 + lane) * 4) = S[mt]; }
    }
}
DI void scanB(const Args& a) {
    const int lane = threadIdx.x & 63, wave = threadIdx.x >> 6;
    if (wave != 0 || blockIdx.x >= NH * 8) return;
    const int h = blockIdx.x >> 3, vs = blockIdx.x & 7;
    f32x4 S[8];
#pragma unroll
    for (int mt = 0; mt < 8; ++mt) S[mt] = (f32x4){0.f, 0.f, 0.f, 0.f};
    for (int g = 0; g < NGRP; ++g) { const size_t chain = (size_t)(h * NGRP + g);
        float* SG = (float*)(a.ws + WS_SG) + (chain * 8 + vs) * 2048; const float* QG = (const float*)(a.ws + WS_QG) + (chain * 8 + vs) * 2048;
        const bf16_t* PG = (const bf16_t*)(a.ws + WS_PG) + chain * 16384;
        bf16x8 sb[4];
#pragma unroll
        for (int s = 0; s < 4; ++s) sb[s] = dn::packB(S[2 * s], S[2 * s + 1]);
#pragma unroll
        for (int mt = 0; mt < 8; ++mt) { *(f32x4*)(SG + ((size_t)mt * 64 + lane) * 4) = S[mt];
            f32x4 acc = *(const f32x4*)(QG + ((size_t)mt * 64 + lane) * 4);
#pragma unroll
            for (int s = 0; s < 4; ++s) acc = MFMA16(dn::frag(PG, mt * 4 + s, lane), sb[s], acc);
            S[mt] = acc; }
    }
}
DI void scanC(const Args& a) {
    const int lane = threadIdx.x & 63, wave = threadIdx.x >> 6, lr = lane & 15, lq = lane >> 4;
    if (wave >= 2) return;
    float* ORAW = (float*)(a.ws + WS_ORAW);
    for (int task = blockIdx.x * 2 + wave; task < NH * NGRP * 8; task += gridDim.x * 2) {
        const int chain = task >> 3, vs = task & 7, h = chain >> 4, g = chain & 15;
        const float* SG = (const float*)(a.ws + WS_SG) + ((size_t)chain * 8 + vs) * 2048;
        f32x4 S[8], o[4];
#pragma unroll
        for (int mt = 0; mt < 8; ++mt) S[mt] = *(const f32x4*)(SG + ((size_t)mt * 64 + lane) * 4);
        for (int n = g * GRP; n < (g + 1) * GRP; ++n) { const size_t cb = (size_t)(h * NCH + n);
            const bf16_t* WFn = (const bf16_t*)(a.ws + WS_DNW) + cb * 8192; const bf16_t* KFn = (const bf16_t*)(a.ws + WS_DNKD) + cb * 8192;
            const bf16_t* QFn = (const bf16_t*)(a.ws + WS_DNQD) + cb * 8192; const bf16_t* AFn = (const bf16_t*)(a.ws + WS_DNATT) + cb * 4096;
            const bf16_t* UFs = (const bf16_t*)(a.ws + WS_DNU) + cb * 8192 + (size_t)vs * 1024; const float eg = ((const float*)(a.ws + WS_EG))[cb];
            dn::step<true, true>(WFn, KFn, QFn, AFn, UFs, eg, S, o, lane);
#pragma unroll
            for (int mt = 0; mt < 4; ++mt)
#pragma unroll
                for (int r = 0; r < 4; ++r) ORAW[(size_t)(n * CH + 16 * mt + 4 * lq + r) * 512 + h * 128 + 16 * vs + lr] = o[mt][r]; }
    }
}
DI void ph4_fox(const Args& a, char* lds) {
    const int tid = threadIdx.x, lane = tid & 63, wave = tid >> 6;
    const float* F = (const float*)(a.ws + WS_F); const unsigned* NRM = (const unsigned*)(a.ws + WS_NRM); unsigned* QH = (unsigned*)(a.ws + WS_QH);
    int* misc = (int*)(lds + fox::OFF_MISC);
    int ord0 = 0, ord1 = 1, ord2 = 2, ord3 = 3;
    { float r0 = -F[0 * SEQ + SEQ - 1], r1 = -F[1 * SEQ + SEQ - 1], r2 = -F[2 * SEQ + SEQ - 1], r3 = -F[3 * SEQ + SEQ - 1];
#define CSWAP(ra, rb, oa, ob) if (rb < ra) { const float tf = ra; ra = rb; rb = tf; const int ti = oa; oa = ob; ob = ti; }
      CSWAP(r0, r1, ord0, ord1) CSWAP(r2, r3, ord2, ord3) CSWAP(r0, r2, ord0, ord2) CSWAP(r1, r3, ord1, ord3) CSWAP(r1, r2, ord1, ord2)
#undef CSWAP
    }
    for (;;) {
        __syncthreads();
        if (tid == 0) misc[0] = (int)atomicAdd(QH, 1u);
        __syncthreads();
        const int it = misc[0];
        if (it >= 256) break;
        const int hsel = it >> 6, h = hsel == 0 ? ord0 : (hsel == 1 ? ord1 : (hsel == 2 ? ord2 : ord3)), qb = 63 - (it & 63), P0 = qb * 256;
        if (wave == 0) {
            const float* Fh = F + (size_t)h * SEQ;
            const float qkb = sqrtf(__uint_as_float(NRM[h]) * __uint_as_float(NRM[4 + h])) * fox::SCALE, lim = Fh[P0] + 2.f * qkb + 32.f;
            const int jd = P0 / 64, stride = jd / 64 + 1;
            int j = lane * stride; bool ok = (j > jd) ? true : (Fh[64 * j + 63] <= lim);
            unsigned long long mk = __ballot(ok); const int first = mk ? __builtin_ctzll(mk) : 64;
            const int lo_ex = first == 0 ? -1 : (first - 1) * stride; int hi_in = (first < 64 && first * stride <= jd) ? first * stride : jd;
            j = lo_ex + 1 + lane; ok = (j < hi_in) ? (Fh[64 * j + 63] <= lim) : false;
            mk = __ballot(ok); const int jlo = mk ? lo_ex + 1 + __builtin_ctzll(mk) : hi_in;
            if (lane == 0) misc[1] = jlo;
        }
        __syncthreads();
        fox::fox_block(a, lds, h, P0, misc[1]);
    }
}
DI void ph4(const Args& a, float* lds) {
    scanA(a);
    ph4_fox(a, (char*)lds);
}

DI void ph5(const Args& a) {
    const int lane = threadIdx.x & 63, wave = threadIdx.x >> 6, NW = gridDim.x * NWAVES;
    const float* ORAW = (const float*)(a.ws + WS_ORAW); const bf16_t* P = (const bf16_t*)(a.ws + WS_PROJ); bf16_t* OA = (bf16_t*)(a.ws + WS_OA);
    const float g0 = a.in[I_GON][lane], g1 = a.in[I_GON][lane + 64];
    for (int id = blockIdx.x * NWAVES + wave; id < SEQ * 4; id += NW) { const int t = id >> 2, h = id & 3;
        const float o0 = ORAW[(size_t)t * 512 + h * 128 + lane], o1 = ORAW[(size_t)t * 512 + h * 128 + 64 + lane];
        const float rstd = rsqrtf(wave_sum(o0 * o0 + o1 * o1) * (1.f / 128.f) + 1e-6f);
        const float z0 = bf2f(P[(size_t)t * NPJ + PJ_DZ + h * 128 + lane]), z1 = bf2f(P[(size_t)t * NPJ + PJ_DZ + h * 128 + 64 + lane]);
        OA[(size_t)t * 512 + h * 128 + lane] = f2bf(o0 * rstd * g0 * siluf(z0)); OA[(size_t)t * 512 + h * 128 + 64 + lane] = f2bf(o1 * rstd * g1 * siluf(z1)); }
}

DI void ph6(const Args& a, unsigned char* ldsb) {
    const bf16_t* P = (const bf16_t*)(a.ws + WS_PROJ);
    pg8::OrderDense S; S.init(SEQ / 256, DM / 256, (int)gridDim.x, (int)blockIdx.x);
    { pg8::Gemm g{(const bf16_t*)(a.ws + WS_OA), (const bf16_t*)(a.ws + WS_WOAT), SEQ, DM, 512};
      pg8::EpiMerge<0> E{P + PJ_GA, (float*)(a.ws + WS_X1), (bf16_t*)(a.ws + WS_MRG)};
      pg8::gemm_phase<pg8::EpiMerge<0>, pg8::OrderDense>((LAS unsigned char*)ldsb, g, S, E); }
    __syncthreads();
    { pg8::Gemm g{(const bf16_t*)(a.ws + WS_OB), (const bf16_t*)(a.ws + WS_WOBT), SEQ, DM, 512};
      pg8::EpiMerge<1> E{P + PJ_GB, (float*)(a.ws + WS_X1), (bf16_t*)(a.ws + WS_MRG)};
      pg8::gemm_phase<pg8::EpiMerge<1>, pg8::OrderDense>((LAS unsigned char*)ldsb, g, S, E); }
}

DI void ph7(const Args& a, unsigned char* ldsb) {
    pg8::Gemm g{(const bf16_t*)(a.ws + WS_MRG), (const bf16_t*)(a.ws + WS_WOUTT), SEQ, DM, DM};
    pg8::OrderDense S; S.init(SEQ / 256, DM / 256, (int)gridDim.x, (int)blockIdx.x);
    pg8::EpiResid E{a.in[I_X], (const float*)(a.ws + WS_MOD) + 2048, (float*)(a.ws + WS_X1)};
    pg8::gemm_phase<pg8::EpiResid, pg8::OrderDense>((LAS unsigned char*)ldsb, g, S, E);
}

DI void ph8(const Args& a, float* lds) {
    const int tid = threadIdx.x, lane = tid & 63, wave = tid >> 6, G = gridDim.x;
    constexpr int HP = 1028;
    float* A2 = lds; float* B2 = lds + 1024; float* hs = lds + 2048; float* lgs = hs + 16 * HP;
    const float* mod = (const float*)(a.ws + WS_MOD);
    for (int k = tid; k < DM; k += NTHREADS) { A2[k] = a.in[I_G2][k] * (1.f + mod[4096 + k]); B2[k] = mod[3072 + k]; }
    const float* X1 = (const float*)(a.ws + WS_X1); bf16_t* H2 = (bf16_t*)(a.ws + WS_H2);
    int* TOKE = (int*)(a.ws + WS_TOKE); int* TOKS = (int*)(a.ws + WS_TOKS); float* TOKG = (float*)(a.ws + WS_TOKG); unsigned* CNT = (unsigned*)(a.ws + WS_CNT);
    const float* wr = a.in[I_WR];
    for (int tile = blockIdx.x; tile < SEQ / 16; tile += G) {
        __syncthreads();
#pragma unroll 1
        for (int q = 0; q < 2; ++q) { const int tt = wave * 2 + q, t = tile * 16 + tt; const float* xr = X1 + (size_t)t * DM;
            f32x4 v[4]; float ss = 0.f;
#pragma unroll
            for (int i = 0; i < 4; ++i) { v[i] = *(const f32x4*)(xr + lane * 4 + 256 * i); ss += v[i][0] * v[i][0] + v[i][1] * v[i][1] + v[i][2] * v[i][2] + v[i][3] * v[i][3]; }
            ss = wave_sum(ss);
            const float rstd = rsqrtf(ss * (1.f / DM) + 1e-6f);
#pragma unroll
            for (int i = 0; i < 4; ++i) { const int k = lane * 4 + 256 * i;
#pragma unroll
                for (int e = 0; e < 4; ++e) v[i][e] = v[i][e] * rstd * A2[k + e] + B2[k + e];
                *(f32x4*)(hs + tt * HP + k) = v[i];
                u32x2 w; w.x = cvt_pk(v[i][0], v[i][1]); w.y = cvt_pk(v[i][2], v[i][3]);
                *(u32x2*)(H2 + (size_t)t * DM + k) = w; } }
        __syncthreads();
        { const int tt = tid >> 5, e = tid & 31; const float* hrow = hs + tt * HP; float acc = 0.f;
#pragma unroll 8
            for (int k = 0; k < DM; ++k) acc += hrow[k] * wr[(size_t)k * NE + e];
            lgs[tt * 32 + e] = acc + a.in[I_BR][e]; }
        __syncthreads();
        { const int e = lane & 31, tt = wave * 2 + (lane >> 5), t = tile * 16 + tt;
            float cur = lgs[tt * 32 + e];
#define TOP1(TV, TI) float TV = cur; int TI = e; for (int o_ = 1; o_ <= 16; o_ <<= 1) { const float ov = __shfl_xor(TV, o_); const int oi = __shfl_xor(TI, o_); if (ov > TV || (ov == TV && oi < TI)) { TV = ov; TI = oi; } } if (e == TI) cur = -__builtin_inff();
            TOP1(tv0, ti0) TOP1(tv1, ti1) TOP1(tv2, ti2) TOP1(tv3, ti3)
#undef TOP1
            const float ex0 = 1.f, ex1 = expf(tv1 - tv0), ex2 = expf(tv2 - tv0), ex3 = expf(tv3 - tv0), den = ex0 + ex1 + ex2 + ex3;
            if (e < 4) { int ee = ti0; float gg = ex0;
                if (e == 1) { ee = ti1; gg = ex1; } if (e == 2) { ee = ti2; gg = ex2; } if (e == 3) { ee = ti3; gg = ex3; }
                const unsigned slot = atomicAdd(&CNT[ee], 1u);
                TOKE[t * 4 + e] = ee; TOKS[t * 4 + e] = (int)slot; TOKG[t * 4 + e] = gg / den; } }
    }
}

DI void pad_starts(const Args& a, int* ps) {
    if (threadIdx.x == 0) { const unsigned* CNT = (const unsigned*)(a.ws + WS_CNT); int s = 0; for (int e = 0; e < NE; ++e) { ps[e] = s; s += (int)((CNT[e] + 255u) / 256u) * 256; } ps[NE] = s; }
    __syncthreads();
}
DI void ph9(const Args& a, float* lds) {
    int* ps = (int*)lds; pad_starts(a, ps);
    const int lane = threadIdx.x & 63, wave = threadIdx.x >> 6, NW = gridDim.x * NWAVES;
    const int* TOKE = (const int*)(a.ws + WS_TOKE); const int* TOKS = (const int*)(a.ws + WS_TOKS);
    const bf16_t* H2 = (const bf16_t*)(a.ws + WS_H2); bf16_t* XG = (bf16_t*)(a.ws + WS_XG);
    for (int id = blockIdx.x * NWAVES + wave; id < SEQ * 4; id += NW) { const int t = id >> 2;
        const size_t row = (size_t)ps[TOKE[id]] + TOKS[id];
        const u32x4 v0 = *(const u32x4*)(H2 + (size_t)t * DM + lane * 8), v1 = *(const u32x4*)(H2 + (size_t)t * DM + 512 + lane * 8);
        *(u32x4*)(XG + row * DM + lane * 8) = v0; *(u32x4*)(XG + row * DM + 512 + lane * 8) = v1; }
}
DI int expert_of(const int* ps, int row0) { int e = 0; for (int i = 1; i < NE; ++i) if (row0 >= ps[i]) e = i; return e; }
DI void ph10(const Args& a, unsigned char* ldsb) {
    int* ps = (int*)(ldsb + 131072); pad_starts(a, ps);
    pg8::Gemm g{(const bf16_t*)(a.ws + WS_XG), (const bf16_t*)(a.ws + WS_WGUT), 0, 2048, DM};
    pg8::OrderGrouped S; S.init(ps[NE] / 256, 8, (int)gridDim.x, (int)blockIdx.x); S.ps = (const LAS int*)ps;
    pg8::EpiSwiglu E{(bf16_t*)(a.ws + WS_ACT), a.in[I_BGU]};
    pg8::gemm_phase<pg8::EpiSwiglu, pg8::OrderGrouped>((LAS unsigned char*)ldsb, g, S, E);
}
DI void ph11(const Args& a, unsigned char* ldsb) {
    int* ps = (int*)(ldsb + 131072); pad_starts(a, ps);
    pg8::Gemm g{(const bf16_t*)(a.ws + WS_ACT), (const bf16_t*)(a.ws + WS_WDT), 0, DM, DM};
    pg8::OrderGrouped S; S.init(ps[NE] / 256, 4, (int)gridDim.x, (int)blockIdx.x); S.ps = (const LAS int*)ps;
    pg8::EpiStoreBf16 E{(bf16_t*)(a.ws + WS_YB), DM, a.in[I_BD], DM};
    pg8::gemm_phase<pg8::EpiStoreBf16, pg8::OrderGrouped>((LAS unsigned char*)ldsb, g, S, E);
}
DI void ph12(const Args& a, float* lds) {
    int* ps = (int*)lds; pad_starts(a, ps);
    const int lane = threadIdx.x & 63, wave = threadIdx.x >> 6, G = gridDim.x;
    const float* X1 = (const float*)(a.ws + WS_X1); const bf16_t* YB = (const bf16_t*)(a.ws + WS_YB); const float* mod = (const float*)(a.ws + WS_MOD);
    const int* TOKE = (const int*)(a.ws + WS_TOKE); const int* TOKS = (const int*)(a.ws + WS_TOKS); const float* TOKG = (const float*)(a.ws + WS_TOKG);
    for (int t = blockIdx.x * NWAVES + wave; t < SEQ; t += G * NWAVES) {
        size_t rows[4]; float gk[4];
#pragma unroll
        for (int q = 0; q < 4; ++q) { rows[q] = (size_t)ps[TOKE[t * 4 + q]] + TOKS[t * 4 + q]; gk[q] = TOKG[t * 4 + q]; }
        f32x4 v[4]; float ss = 0.f;
#pragma unroll
        for (int i = 0; i < 4; ++i) { const int k = lane * 4 + 256 * i; v[i] = *(const f32x4*)(X1 + (size_t)t * DM + k);
            f32x4 y = (f32x4){0.f, 0.f, 0.f, 0.f};
#pragma unroll
            for (int q = 0; q < 4; ++q) { const u32x2 w = *(const u32x2*)(YB + rows[q] * DM + k);
                y[0] += gk[q] * __uint_as_float(w.x << 16); y[1] += gk[q] * __uint_as_float(w.x & 0xffff0000u); y[2] += gk[q] * __uint_as_float(w.y << 16); y[3] += gk[q] * __uint_as_float(w.y & 0xffff0000u); }
#pragma unroll
            for (int q = 0; q < 4; ++q) { v[i][q] += mod[5120 + k + q] * y[q]; ss += v[i][q] * v[i][q]; } }
        ss = wave_sum(ss);
        const float rstd = rsqrtf(ss * (1.f / DM) + 1e-6f);
#pragma unroll
        for (int i = 0; i < 4; ++i) { const int k = lane * 4 + 256 * i; f32x4 o;
#pragma unroll
            for (int q = 0; q < 4; ++q) o[q] = v[i][q] * rstd * a.in[I_GF][k + q];
            *(f32x4*)(a.out + (size_t)t * DM + k) = o; }
    }
}

__global__ void __launch_bounds__(NTHREADS, 2) hybrid_fwd(Args a) {
    extern __shared__ __attribute__((aligned(16))) unsigned char lds_raw[];
    float* lds = (float*)(lds_raw + 16);
    LAS unsigned* xbw = (LAS unsigned*)lds_raw;
    if (threadIdx.x == 0) { xbw[0] = 0u; xbw[1] = 0u; xbw[2] = 0u; xbw[3] = 0u; }
    __syncthreads();
    XcdBarrier bar; bar.bar = (unsigned*)(a.ws + WS_BAR); bar.x = 0; bar.st = (volatile LAS unsigned*)xbw;
    const int lo = a.ph_lo, hi = a.ph_hi;
    if (hi - lo > 1) bar = xcd_barrier_post((unsigned*)(a.ws + WS_BAR), (volatile LAS unsigned*)xbw);
#define IN(k) (lo <= (k) && (k) < hi)
#define SEAM(k) do { if (IN(k) && IN((k) + 1)) xcd_barrier(bar); } while (0)
    if (IN(0)) ph0(a, lds);
    SEAM(0);
    if (IN(1)) ph1(a, lds);
    SEAM(1);
    if (IN(2)) ph2(a, lds_raw + 16);
    SEAM(2);
    if (IN(3)) ph3(a, lds);
    SEAM(3);
    if (IN(4)) ph4(a, lds);
    SEAM(4);
    if (IN(5)) scanB(a);
    SEAM(5);
    if (IN(6)) scanC(a);
    SEAM(6);
    if (IN(7)) ph5(a);
    SEAM(7);
    if (IN(8)) ph6(a, lds_raw + 16);
    SEAM(8);
    if (IN(9)) ph7(a, lds_raw + 16);
    SEAM(9);
    if (IN(10)) ph8(a, lds);
    SEAM(10);
    if (IN(11)) ph9(a, lds);
    SEAM(11);
    if (IN(12)) ph10(a, lds_raw + 16);
    SEAM(12);
    if (IN(13)) ph11(a, lds_raw + 16);
    SEAM(13);
    if (IN(14)) ph12(a, lds);
#undef IN
#undef SEAM
}

extern "C" void kernel_launch(void* const* d_in, const int* in_sizes, int n_in, void* d_out, int out_size, void* d_ws, size_t ws_size, hipStream_t stream) {
    static int grid = 0;
    if (grid == 0) {
        if (n_in != 22 || out_size != SEQ * DM || ws_size < WS_END) { fprintf(stderr, "kernel_launch: unexpected shapes (n_in %d out %d ws %zu, need %zu)\n", n_in, out_size, ws_size, (size_t)WS_END); grid = -1; return; }
        int dev = 0, cus = 0, per_cu = 0;
        if (hipGetDevice(&dev) != hipSuccess || hipDeviceGetAttribute(&cus, hipDeviceAttributeMultiprocessorCount, dev) != hipSuccess) { grid = -1; return; }
        if (hipFuncSetAttribute((const void*)hybrid_fwd, hipFuncAttributeMaxDynamicSharedMemorySize, LDS_BYTES) != hipSuccess) { fprintf(stderr, "kernel_launch: hipFuncSetAttribute failed\n"); grid = -1; return; }
        if (hipOccupancyMaxActiveBlocksPerMultiprocessor(&per_cu, (const void*)hybrid_fwd, NTHREADS, LDS_BYTES) != hipSuccess || per_cu < 1) { fprintf(stderr, "kernel_launch: occupancy query says %d\n", per_cu); }
        (void)hipGetLastError();
        grid = cus;
    }
    if (grid < 0) return;
    (void)hipMemsetAsync(d_ws, 0, CTL_ZERO, stream);
    Args a{};
    for (int i = 0; i < 22; ++i) a.in[i] = (const float*)d_in[i];
    a.out = (float*)d_out; a.ws = (unsigned char*)d_ws;
#if N_LAUNCHES == 1
    a.ph_lo = 0; a.ph_hi = NPHASES;
    hipLaunchKernelGGL(hybrid_fwd, dim3(grid), dim3(NTHREADS), LDS_BYTES, stream, a);
#else
    for (int p = 0; p < NPHASES; ++p) { a.ph_lo = p; a.ph_hi = p + 1; hipLaunchKernelGGL(hybrid_fwd, dim3(grid), dim3(NTHREADS), LDS_BYTES, stream, a); }
#endif
}
```

```cpp
#include <hip/hip_runtime.h>
#include <stdint.h>
#include <stdio.h>

#ifndef N_LAUNCHES
#define N_LAUNCHES 1
#endif

#define DI __device__ __forceinline__
#define LAS __attribute__((address_space(3)))
typedef unsigned short bf16_t;
typedef short bf16x8 __attribute__((ext_vector_type(8)));
typedef float f32x4 __attribute__((ext_vector_type(4)));
typedef unsigned u32x4 __attribute__((ext_vector_type(4)));
typedef unsigned u32x2 __attribute__((ext_vector_type(2)));

constexpr int SEQ = 16384, DM = 1024, NIN = 5644, NPJ = 5632, NE = 32, TOPK = 4;
constexpr int NH = 4, HD = 128, CH = 64, NCH = SEQ / CH;
constexpr int PJ_DQ = 0, PJ_DK = 512, PJ_DV = 1024, PJ_DZ = 1536, PJ_FQ = 2048, PJ_FK = 2560, PJ_FV = 3072, PJ_GA = 3584, PJ_GB = 4608;
constexpr int NTHREADS = 512, NWAVES = 8;
constexpr int LDS_BYTES = 152 * 1024;
constexpr int NPHASES = 15;

constexpr size_t MiB = 1u << 20;
constexpr size_t WS_BAR = 0;
constexpr size_t WS_CNT = 32768;
constexpr size_t WS_NRM = 32768 + 256;
constexpr size_t WS_QH = 32768 + 512;
constexpr size_t CTL_ZERO = 65536;
constexpr size_t WS_MOD = 65536;
constexpr size_t WS_F = WS_MOD + 32768;
constexpr size_t WS_EG = WS_F + 262144;
constexpr size_t WS_TOKE = WS_EG + 4096;
constexpr size_t WS_TOKS = WS_TOKE + 262144;
constexpr size_t WS_TOKG = WS_TOKS + 262144;
constexpr size_t WS_SP = WS_TOKG + 262144;
constexpr size_t WS_WINT = WS_SP + MiB;
constexpr size_t WS_WOAT = WS_WINT + (size_t)NPJ * DM * 2;
constexpr size_t WS_WOBT = WS_WOAT + MiB;
constexpr size_t WS_WOUTT = WS_WOBT + MiB;
constexpr size_t WS_WGUT = WS_WOUTT + 2 * MiB;
constexpr size_t WS_WDT = WS_WGUT + 128 * MiB;
constexpr size_t WS_X1 = WS_WDT + 64 * MiB;
constexpr size_t WS_H2 = WS_X1 + 64 * MiB;
constexpr size_t WS_MRG = WS_H2 + 32 * MiB;
constexpr size_t WS_RA = WS_MRG + 32 * MiB;
constexpr size_t WS_RB = WS_RA + 176 * MiB;
constexpr size_t WS_H = WS_RB;
constexpr size_t WS_DNW = WS_H + 32 * MiB;
constexpr size_t WS_DNU = WS_DNW + 16 * MiB;
constexpr size_t WS_DNQD = WS_DNU + 16 * MiB;
constexpr size_t WS_DNKD = WS_DNQD + 16 * MiB;
constexpr size_t WS_DNATT = WS_DNKD + 16 * MiB;
constexpr size_t WS_ORAW = WS_DNATT + 8 * MiB;
constexpr size_t WS_OA = WS_ORAW + 32 * MiB;
constexpr size_t WS_OB = WS_OA + 16 * MiB;
constexpr size_t WS_VT = WS_OB + 16 * MiB;
constexpr size_t WS_PG = WS_VT;
constexpr size_t WS_QG = WS_PG + 2 * MiB;
constexpr size_t WS_SG = WS_QG + 4 * MiB;
constexpr size_t WS_NRMB = 32768 + 1024;
constexpr size_t WS_TCNT = WS_SG + 4 * MiB;
constexpr size_t WS_END = WS_RB + 184 * MiB;
constexpr size_t WS_XG = WS_RA, WS_YB = WS_RA, WS_ACT = WS_RB, WS_PROJ = WS_RA;
static_assert(WS_VT + 16 * MiB <= WS_END, "region B");

struct Args { const float* in[22]; float* out; unsigned char* ws; int ph_lo, ph_hi; };
enum { I_X = 0, I_C, I_WADA, I_BADA, I_G1, I_WIN, I_CONVW, I_ALOG, I_DTB, I_GON, I_BFG, I_WOD, I_WOF, I_WOUT, I_G2, I_WR, I_BR, I_WGU, I_BGU, I_WD, I_BD, I_GF };

DI float bf2f(bf16_t v) { return __uint_as_float(((unsigned)v) << 16); }
DI bf16_t f2bf(float f) { unsigned u = __float_as_uint(f); u += 0x7fffu + ((u >> 16) & 1u); return (bf16_t)(u >> 16); }
typedef float f32x2_t __attribute__((ext_vector_type(2)));
typedef __bf16 bf16x2_t __attribute__((ext_vector_type(2)));
DI unsigned cvt_pk(float lo, float hi) { const f32x2_t v = {lo, hi}; const bf16x2_t b = __builtin_convertvector(v, bf16x2_t); return __builtin_bit_cast(unsigned, b); }
DI unsigned pk2(float lo, float hi) { return (unsigned)f2bf(lo) | ((unsigned)f2bf(hi) << 16); }
DI float sigm(float x) { return 1.f / (1.f + expf(-x)); }
DI float siluf(float x) { return x / (1.f + expf(-x)); }
DI float softplusf(float x) { return fmaxf(x, 0.f) + log1pf(expf(-fabsf(x))); }
DI float logsigf(float x) { return fminf(x, 0.f) - log1pf(expf(-fabsf(x))); }
DI float wave_sum(float v) { for (int o = 32; o >= 1; o >>= 1) v += __shfl_xor(v, o); return v; }
#define MFMA16(a, b, c) __builtin_amdgcn_mfma_f32_16x16x32_bf16((a), (b), (c), 0, 0, 0)

DI int gu_src(int n) { const int g = n >> 8, r = n & 255; return r < 128 ? 128 * g + r : 1024 + 128 * g + (r - 128); }

#define XB_TMO      128
#define XB_XCNT(j)  (256  + 64 * (j))
#define XB_XSUB(j)  (1280 + 64 * (j))
#define XB_XGEN(j)  (2304 + 64 * (j))
#define XB_TOP      3328
#define XB_TOPGEN   3392
#define XCD_BAR_WORDS 3456
#define XB_SPIN_CAP (1u << 22)
DI unsigned xb_ld(unsigned* p)              { return __hip_atomic_load(p, __ATOMIC_RELAXED, __HIP_MEMORY_SCOPE_AGENT); }
DI unsigned xb_add(unsigned* p, unsigned v) { return __hip_atomic_fetch_add(p, v, __ATOMIC_RELAXED, __HIP_MEMORY_SCOPE_AGENT); }
DI unsigned xb_xcc_id() { return (unsigned)__builtin_amdgcn_s_getreg((3 << 11) | 20) & 0xFu; }
#define XB_SPIN(cond, bar) do { unsigned _sp = 0; while (cond) { __builtin_amdgcn_s_sleep(1); \
    if ((++_sp & 255u) == 0u) { if (xb_ld(&(bar)[XB_TMO])) break; if (_sp > XB_SPIN_CAP) { atomicAdd(&(bar)[XB_TMO], 1u); break; } } } } while (0)
struct XcdBarrier { unsigned* bar; unsigned x; volatile LAS unsigned* st; };
DI XcdBarrier xcd_barrier_post(unsigned* bar, volatile LAS unsigned* st) {
    XcdBarrier b; b.bar = bar; b.x = xb_xcc_id(); b.st = st;
    if (threadIdx.x == 0) (void)xb_add(&bar[XB_XCNT(b.x)], 1u);
    return b;
}
DI void xcd_barrier_complete(unsigned* bar, unsigned x, unsigned& nloc, unsigned& nx) {
    const unsigned G = gridDim.x * gridDim.y * gridDim.z;
    unsigned sum, cnt, mine, sp = 0u;
    for (;;) {
        sum = 0u; cnt = 0u; mine = 0u;
#pragma unroll
        for (unsigned j = 0; j < 16; ++j) { const unsigned c = xb_ld(&bar[XB_XCNT(j)]); sum += c; cnt += (c > 0u) ? 1u : 0u; mine = (j == x) ? c : mine; }
        if (sum == G) break;
        __builtin_amdgcn_s_sleep(1);
        if ((++sp & 255u) == 0u) { if (xb_ld(&bar[XB_TMO])) break; if (sp > XB_SPIN_CAP) { atomicAdd(&bar[XB_TMO], 1u); break; } }
    }
    nloc = mine > 0u ? mine : 1u; nx = cnt > 0u ? cnt : 1u;
}
DI void xcd_barrier(const XcdBarrier& b) {
    asm volatile("s_waitcnt vmcnt(0)" ::: "memory");
    __syncthreads();
    if (threadIdx.x == 0) {
        unsigned* bar = b.bar;
        __builtin_amdgcn_s_waitcnt(0);
        unsigned nloc = b.st[0], nx = b.st[1];
        if (nloc == 0u) { xcd_barrier_complete(bar, b.x, nloc, nx); b.st[0] = nloc; b.st[1] = nx; }
        const unsigned old = xb_add(&bar[XB_XSUB(b.x)], 1u);
        const unsigned gen = old / nloc;
        if (old + 1u == (gen + 1u) * nloc) {
            __builtin_amdgcn_fence(__ATOMIC_RELEASE, "agent");
            asm volatile("s_waitcnt vmcnt(0)" ::: "memory");
            const unsigned og = xb_add(&bar[XB_TOP], 1u);
            const unsigned tg = og / nx;
            if (og + 1u == (tg + 1u) * nx) xb_add(&bar[XB_TOPGEN], 1u);
            else XB_SPIN(xb_ld(&bar[XB_TOPGEN]) == tg, bar);
            __builtin_amdgcn_fence(__ATOMIC_ACQUIRE, "agent");
            xb_add(&bar[XB_XGEN(b.x)], 1u);
            asm volatile("s_waitcnt vmcnt(0)" ::: "memory");
        } else {
            XB_SPIN(xb_ld(&bar[XB_XGEN(b.x)]) == gen, bar);
            __builtin_amdgcn_fence(__ATOMIC_ACQUIRE, "agent");
            asm volatile("s_waitcnt vmcnt(0)" ::: "memory");
        }
    }
    __syncthreads();
}

template <int NT>
DI void wave_gemm(const bf16_t* const (&ap)[4], const bf16_t* const (&bp)[NT], int K, f32x4 (&acc)[4][NT]) {
    for (int k0 = 0; k0 < K; k0 += 32) {
        bf16x8 a[4], b[NT];
#pragma unroll
        for (int i = 0; i < 4; ++i) a[i] = *(const bf16x8*)(ap[i] + k0);
#pragma unroll
        for (int j = 0; j < NT; ++j) b[j] = *(const bf16x8*)(bp[j] + k0);
#pragma unroll
        for (int i = 0; i < 4; ++i)
#pragma unroll
            for (int j = 0; j < NT; ++j) acc[i][j] = MFMA16(a[i], b[j], acc[i][j]);
    }
}
template <int NT> DI void zero_acc(f32x4 (&acc)[4][NT]) {
#pragma unroll
    for (int i = 0; i < 4; ++i)
#pragma unroll
        for (int j = 0; j < NT; ++j) acc[i][j] = (f32x4){0.f, 0.f, 0.f, 0.f};
}


namespace pg8 {
struct Unit { int pm, pn, pb, e; };
struct Gemm { const bf16_t* A; const bf16_t* Bt; int M, N, K; };
constexpr int BM = 256, BK = 64, HALF = 128, HTB = HALF * BK * 2  , STAGE_BYTES = 8 * HTB, NXCD = 8, WGM = 8;

__host__ __device__ __forceinline__ int lds_byte(int r, int c) { const int st = (r >> 4) * 2 + (c >> 5), rr = r & 15, cc = c & 31, ob = rr * 64 + cc * 2; return st * 1024 + (ob ^ (((ob >> 9) & 1) << 5)); }
__host__ __device__ __forceinline__ void stage_rc(int b, int& R, int& C) { const int st = b / 1024, sb = b % 1024, swz = sb ^ (((sb >> 9) & 1) << 5); R = (st >> 1) * 16 + swz / 64; C = (st & 1) * 32 + (swz % 64) / 2; }
__host__ __device__ __forceinline__ int perm32(int rho) { const int n = rho >> 4, i = rho & 15; return 8 * (i >> 2) + 4 * n + (i & 3); }
template <class Epi, class Sched>
__device__ __forceinline__ void gemm_phase(LAS unsigned char* lds, const Gemm g, const Sched& S, const Epi& E) {
    const int tid = threadIdx.x, wid = __builtin_amdgcn_readfirstlane(tid >> 6), lane = tid & 63, wr = wid >> 2, wc = wid & 3, fr = lane & 15, fq = lane >> 4;
    const int K = g.K, nt = K / BK;
    unsigned voffA[2], voffB[2];
#pragma unroll
    for (int i = 0; i < 2; ++i) { int R, C; stage_rc(tid * 16 + i * 8192, R, C); const int Rb = Epi::PERM ? ((R & ~31) + perm32(R & 31)) : R;
        voffA[i] = (unsigned)(R * K + C) * 2u; voffB[i] = (unsigned)(Rb * K + C) * 2u; }
    const size_t kstep = (size_t)(BK * 2);
    const size_t hstep = (size_t)HALF * K * 2;
    const size_t tstep = 2 * hstep;
    const unsigned ldsw = (unsigned)wid * 1024u;
    const int aoff = lds_byte(wr * 64 + fr, fq * 8), boff = lds_byte(wc * 32 + fr, fq * 8);
#define PG8_SA(b, h) (((b) * 2 + (h)) * HTB)
#define PG8_SB(b, h) ((4 + (b) * 2 + (h)) * HTB)
#define PG8_STAGE(bufoff, gbase, voff) do { _Pragma("unroll") for (int _i = 0; _i < 2; ++_i) \
        __builtin_amdgcn_global_load_lds((const unsigned*)((const char*)(gbase) + (voff)[_i]), (LAS unsigned*)(lds + (bufoff) + ldsw + _i * 8192), 16, 0, 0); } while (0)
#define PG8_LDA(dst, b, h) do { _Pragma("unroll") for (int m = 0; m < 4; ++m) _Pragma("unroll") for (int k = 0; k < 2; ++k) dst[m][k] = *(const LAS bf16x8*)(lds + PG8_SA(b, h) + aoff + m * 2048 + k * 1024); } while (0)
#define PG8_LDB(dst, b, h) do { _Pragma("unroll") for (int n = 0; n < 2; ++n) _Pragma("unroll") for (int k = 0; k < 2; ++k) dst[n][k] = *(const LAS bf16x8*)(lds + PG8_SB(b, h) + boff + n * 2048 + k * 1024); } while (0)
#define PG8_MMA(ai, bj, At, Bt) do { __builtin_amdgcn_s_setprio(1); _Pragma("unroll") for (int m = 0; m < 4; ++m) _Pragma("unroll") for (int n = 0; n < 2; ++n) _Pragma("unroll") for (int k = 0; k < 2; ++k) \
        acc[ai][bj][m][n] = __builtin_amdgcn_mfma_f32_16x16x32_bf16(Bt[n][k], At[m][k], acc[ai][bj][m][n], 0, 0, 0); __builtin_amdgcn_s_setprio(0); } while (0)
#define PG8_WAIT_V(n) asm volatile("s_waitcnt vmcnt(" #n ")" ::: "memory")
#define PG8_WAIT_L(n) asm volatile("s_waitcnt lgkmcnt(" #n ")" ::: "memory")
#define PG8_BAR __builtin_amdgcn_s_barrier()
#define PG8_SCHED __builtin_amdgcn_sched_barrier(0)
    Unit cur, nxt; int ui = 0;
    if (!S.next(0, cur)) return;
    f32x4 acc[2][2][4][2];
#pragma unroll
    for (int a = 0; a < 2; ++a)
#pragma unroll
        for (int b = 0; b < 2; ++b)
#pragma unroll
            for (int m = 0; m < 4; ++m)
#pragma unroll
                for (int n = 0; n < 2; ++n) acc[a][b][m][n] = (f32x4){0.f, 0.f, 0.f, 0.f};
    bf16x8 At[4][2], B0[2][2], B1[2][2];
    const char* cA = (const char*)g.A + (size_t)cur.pm * tstep; const char* cB = (const char*)g.Bt + (size_t)cur.pb * tstep;
    S.a_ready(cur);
    PG8_STAGE(PG8_SB(0, 0), cB, voffB); PG8_STAGE(PG8_SA(0, 0), cA, voffA); PG8_STAGE(PG8_SB(0, 1), cB + hstep, voffB); PG8_STAGE(PG8_SA(0, 1), cA + hstep, voffA);
    if (wr == 1) PG8_BAR;
    PG8_WAIT_V(4); PG8_BAR;
    PG8_STAGE(PG8_SB(1, 0), cB + kstep, voffB); PG8_STAGE(PG8_SA(1, 0), cA + kstep, voffA); PG8_STAGE(PG8_SB(1, 1), cB + hstep + kstep, voffB);
    PG8_WAIT_V(6); PG8_BAR;
    for (;;) {
        const bool has_next = S.next(ui + 1, nxt);
        const char* nA = has_next ? (const char*)g.A + (size_t)nxt.pm * tstep : cA; const char* nB = has_next ? (const char*)g.Bt + (size_t)nxt.pb * tstep : cB;
        for (int t = 0; t < nt; t += 2) {
            const bool last = (t == nt - 2);
            const char* a1 = cA + (size_t)(t + 1) * kstep;
            const char* a2 = last ? nA : cA + (size_t)(t + 2) * kstep; const char* b2 = last ? nB : cB + (size_t)(t + 2) * kstep;
            const char* a3 = a2 + kstep; const char* b3 = b2 + kstep;
            if (last && has_next) S.a_ready(nxt);
            PG8_LDB(B0, 0, 0); PG8_SCHED; PG8_LDA(At, 0, 0); PG8_STAGE(PG8_SA(1, 1), a1 + hstep, voffA);
            PG8_WAIT_L(8); PG8_BAR; PG8_WAIT_L(0); PG8_MMA(0, 0, At, B0); PG8_BAR; PG8_SCHED;
            PG8_LDB(B1, 0, 1); PG8_STAGE(PG8_SB(0, 0), b2, voffB);
            PG8_BAR; PG8_WAIT_L(0); PG8_MMA(0, 1, At, B1); PG8_BAR;
            PG8_LDA(At, 0, 1); PG8_STAGE(PG8_SA(0, 0), a2, voffA);
            PG8_BAR; PG8_WAIT_L(0); PG8_MMA(1, 0, At, B0); PG8_BAR; PG8_SCHED;
            PG8_STAGE(PG8_SB(0, 1), b2 + hstep, voffB);
            PG8_WAIT_V(6); PG8_BAR; PG8_MMA(1, 1, At, B1); PG8_BAR;
            PG8_LDB(B0, 1, 0); PG8_SCHED; PG8_LDA(At, 1, 0); PG8_STAGE(PG8_SA(0, 1), a2 + hstep, voffA);
            PG8_WAIT_L(8); PG8_BAR; PG8_WAIT_L(0); PG8_MMA(0, 0, At, B0); PG8_BAR; PG8_SCHED;
            PG8_LDB(B1, 1, 1); PG8_STAGE(PG8_SB(1, 0), b3, voffB);
            PG8_BAR; PG8_WAIT_L(0); PG8_MMA(0, 1, At, B1); PG8_BAR;
            PG8_LDA(At, 1, 1); PG8_STAGE(PG8_SA(1, 0), a3, voffA);
            PG8_BAR; PG8_WAIT_L(0); PG8_MMA(1, 0, At, B0); PG8_BAR; PG8_SCHED;
            PG8_STAGE(PG8_SB(1, 1), b3 + hstep, voffB);
            PG8_WAIT_V(6); PG8_BAR; PG8_MMA(1, 1, At, B1); PG8_BAR;
        }
        if constexpr (!Epi::AFTER_DRAIN) { E(acc, cur, wr, wc, fr, fq); S.done(cur); }
        if (!has_next) break;
#pragma unroll
        for (int a = 0; a < 2; ++a)
#pragma unroll
            for (int b = 0; b < 2; ++b)
#pragma unroll
                for (int m = 0; m < 4; ++m)
#pragma unroll
                    for (int n = 0; n < 2; ++n) acc[a][b][m][n] = (f32x4){0.f, 0.f, 0.f, 0.f};
        cur = nxt; cA = nA; cB = nB; ++ui;
    }
    PG8_WAIT_V(0);
    if (wr == 0) PG8_BAR;
    PG8_BAR;
    if constexpr (Epi::AFTER_DRAIN) { E.fused(acc, cur, wr, wc, fr, fq, lds, wid, lane); S.done(cur); }
#undef PG8_SA
#undef PG8_SB
#undef PG8_STAGE
#undef PG8_LDA
#undef PG8_LDB
#undef PG8_MMA
#undef PG8_WAIT_V
#undef PG8_WAIT_L
#undef PG8_BAR
#undef PG8_SCHED
}

DI unsigned cvt_pk_bf16(float lo, float hi) { return cvt_pk(lo, hi); }
DI float fsig(float x) { return __builtin_amdgcn_rcpf(1.f + __builtin_amdgcn_exp2f(-1.4426950408889634f * x)); }
DI int expert_of_l(const LAS int* ps, int row0) { int e = 0;
#pragma unroll 1
    for (int i = 1; i < NE; ++i) if (row0 >= ps[i]) e = i; return e; }
struct OrderDense {
    int nM, nN, nwg, G, c;
    DI void init(int nM_, int nN_, int G_, int c_) { nM = nM_; nN = nN_; nwg = nM * nN; G = G_; c = c_; }
    DI bool tile(int i, Unit& u) const {
        const long L = (long)i * G + c; if (L >= nwg) return false;
        int wgid = (int)L; { const int q = nwg / NXCD, r = nwg % NXCD, xcd = wgid % NXCD, off = wgid / NXCD; wgid = (xcd < r ? xcd * (q + 1) : r * (q + 1) + (xcd - r) * q) + off; }
        const int nig = WGM * nN, gid = wgid / nig, fm = gid * WGM, gsz = (nM - fm) < WGM ? (nM - fm) : WGM;
        u.pm = fm + ((wgid % nig) % gsz); u.pn = (wgid % nig) / gsz; return true;
    }
    DI bool next(int i, Unit& u) const { if (!tile(i, u)) return false; u.pb = u.pn; u.e = 0; return true; }
    DI void a_ready(const Unit&) const {}
    DI void done(const Unit&) const {}
};
struct OrderGrouped : OrderDense {
    const LAS int* ps;
    DI bool next(int i, Unit& u) const { if (!tile(i, u)) return false; u.e = expert_of_l(ps, u.pm * BM); u.pb = u.e * nN + u.pn; return true; }
};
struct EpiStoreBf16 {
    static constexpr bool PERM = true, AFTER_DRAIN = false;
    bf16_t* O; int ldc; const float* bias; int bstride;
    DI void operator()(const f32x4 (&acc)[2][2][4][2], const Unit& u, int wr, int wc, int fr, int fq) const {
        const int row0 = u.pm * BM + wr * 64 + fr, col0 = u.pn * BM + wc * 32 + 8 * fq;
        f32x4 bv[2][2];
#pragma unroll
        for (int bj = 0; bj < 2; ++bj)
#pragma unroll
            for (int n = 0; n < 2; ++n) bv[bj][n] = bias ? *(const f32x4*)(bias + (size_t)u.e * bstride + col0 + bj * HALF + 4 * n) : (f32x4){0.f, 0.f, 0.f, 0.f};
#pragma unroll
        for (int ai = 0; ai < 2; ++ai)
#pragma unroll
            for (int m = 0; m < 4; ++m) { bf16_t* rowp = O + (size_t)(row0 + ai * HALF + m * 16) * ldc + col0;
#pragma unroll
                for (int bj = 0; bj < 2; ++bj) { const f32x4 v0 = acc[ai][bj][m][0] + bv[bj][0], v1 = acc[ai][bj][m][1] + bv[bj][1];
                    u32x4 w; w.x = cvt_pk_bf16(v0[0], v0[1]); w.y = cvt_pk_bf16(v0[2], v0[3]); w.z = cvt_pk_bf16(v1[0], v1[1]); w.w = cvt_pk_bf16(v1[2], v1[3]);
                    *(u32x4*)(rowp + bj * HALF) = w; } }
    }
};
template <int SECOND> struct EpiMerge {
    static constexpr bool PERM = true, AFTER_DRAIN = false;
    const bf16_t* gate; float* T; bf16_t* O;
    DI void operator()(const f32x4 (&acc)[2][2][4][2], const Unit& u, int wr, int wc, int fr, int fq) const {
        const int row0 = u.pm * BM + wr * 64 + fr, col0 = u.pn * BM + wc * 32 + 8 * fq;
#pragma unroll
        for (int ai = 0; ai < 2; ++ai)
#pragma unroll
            for (int mp = 0; mp < 2; ++mp) {
                u32x4 g[2][2]; f32x4 t0[2][2], t1[2][2];
#pragma unroll
                for (int mm = 0; mm < 2; ++mm)
#pragma unroll
                    for (int bj = 0; bj < 2; ++bj) { const size_t row = (size_t)(row0 + ai * HALF + (2 * mp + mm) * 16); const int col = col0 + bj * HALF;
                        g[mm][bj] = *(const u32x4*)(gate + row * NPJ + col);
                        if (SECOND) { t0[mm][bj] = *(const f32x4*)(T + row * DM + col); t1[mm][bj] = *(const f32x4*)(T + row * DM + col + 4); } }
#pragma unroll
                for (int mm = 0; mm < 2; ++mm)
#pragma unroll
                    for (int bj = 0; bj < 2; ++bj) { const int m = 2 * mp + mm; const size_t row = (size_t)(row0 + ai * HALF + m * 16); const int col = col0 + bj * HALF;
                        const u32x4 gg = g[mm][bj]; f32x4 v0 = acc[ai][bj][m][0], v1 = acc[ai][bj][m][1];
                        v0[0] *= fsig(__uint_as_float(gg.x << 16)); v0[1] *= fsig(__uint_as_float(gg.x & 0xffff0000u)); v0[2] *= fsig(__uint_as_float(gg.y << 16)); v0[3] *= fsig(__uint_as_float(gg.y & 0xffff0000u));
                        v1[0] *= fsig(__uint_as_float(gg.z << 16)); v1[1] *= fsig(__uint_as_float(gg.z & 0xffff0000u)); v1[2] *= fsig(__uint_as_float(gg.w << 16)); v1[3] *= fsig(__uint_as_float(gg.w & 0xffff0000u));
                        if (SECOND == 0) { float* tp = T + row * DM + col; *(f32x4*)tp = v0; *(f32x4*)(tp + 4) = v1; }
                        else { v0 += t0[mm][bj]; v1 += t1[mm][bj];
                            u32x4 w; w.x = cvt_pk_bf16(v0[0], v0[1]); w.y = cvt_pk_bf16(v0[2], v0[3]); w.z = cvt_pk_bf16(v1[0], v1[1]); w.w = cvt_pk_bf16(v1[2], v1[3]);
                            *(u32x4*)(O + row * DM + col) = w; } }
            }
    }
};
struct EpiResid {
    static constexpr bool PERM = false, AFTER_DRAIN = false;
    const float* x; const float* gt; float* X1;
    DI void operator()(const f32x4 (&acc)[2][2][4][2], const Unit& u, int wr, int wc, int fr, int fq) const {
        const int row0 = u.pm * BM + wr * 64 + fr, col0 = u.pn * BM + wc * 32 + 4 * fq;
        f32x4 gv[2][2];
#pragma unroll
        for (int bj = 0; bj < 2; ++bj)
#pragma unroll
            for (int n = 0; n < 2; ++n) gv[bj][n] = *(const f32x4*)(gt + col0 + bj * HALF + n * 16);
#pragma unroll
        for (int ai = 0; ai < 2; ++ai)
#pragma unroll
            for (int mp = 0; mp < 2; ++mp) {
                f32x4 xv[2][2][2];
#pragma unroll
                for (int mm = 0; mm < 2; ++mm)
#pragma unroll
                    for (int bj = 0; bj < 2; ++bj)
#pragma unroll
                        for (int n = 0; n < 2; ++n) xv[mm][bj][n] = *(const f32x4*)(x + (size_t)(row0 + ai * HALF + (2 * mp + mm) * 16) * DM + col0 + bj * HALF + n * 16);
#pragma unroll
                for (int mm = 0; mm < 2; ++mm)
#pragma unroll
                    for (int bj = 0; bj < 2; ++bj)
#pragma unroll
                        for (int n = 0; n < 2; ++n) *(f32x4*)(X1 + (size_t)(row0 + ai * HALF + (2 * mp + mm) * 16) * DM + col0 + bj * HALF + n * 16) = xv[mm][bj][n] + gv[bj][n] * acc[ai][bj][2 * mp + mm][n];
            }
    }
};
struct EpiSwiglu {
    static constexpr bool PERM = true, AFTER_DRAIN = false;
    bf16_t* ACT; const float* bgu;
    DI void operator()(const f32x4 (&acc)[2][2][4][2], const Unit& u, int wr, int wc, int fr, int fq) const {
        const int row0 = u.pm * BM + wr * 64 + fr, gcol = u.pn * HALF + wc * 32 + 8 * fq;
        const float* bb = bgu + (size_t)u.e * 2048 + gcol;
        f32x4 bg[2], bu[2];
#pragma unroll
        for (int n = 0; n < 2; ++n) { bg[n] = *(const f32x4*)(bb + 4 * n); bu[n] = *(const f32x4*)(bb + 1024 + 4 * n); }
#pragma unroll
        for (int ai = 0; ai < 2; ++ai)
#pragma unroll
            for (int m = 0; m < 4; ++m) { float r[8];
#pragma unroll
                for (int n = 0; n < 2; ++n)
#pragma unroll
                    for (int j = 0; j < 4; ++j) { float g = acc[ai][0][m][n][j] + bg[n][j], up = acc[ai][1][m][n][j] + bu[n][j];
                        g = fminf(g, 7.f); up = fminf(fmaxf(up, -7.f), 7.f);
                        r[4 * n + j] = (up + 1.f) * (g * fsig(1.702f * g)); }
                u32x4 w; w.x = cvt_pk_bf16(r[0], r[1]); w.y = cvt_pk_bf16(r[2], r[3]); w.z = cvt_pk_bf16(r[4], r[5]); w.w = cvt_pk_bf16(r[6], r[7]);
                *(u32x4*)(ACT + (size_t)(row0 + ai * HALF + m * 16) * DM + gcol) = w; }
    }
};
}


namespace fox {
typedef float f32x16 __attribute__((ext_vector_type(16)));
typedef short s16x4 __attribute__((ext_vector_type(4)));
constexpr float SCALE = 0.08838834764831845f;
constexpr int KVBLK = 64, SHM_K = 16384, SHM_V = 16384;
constexpr int OFF_V = 0, OFF_K = 2 * SHM_V, OFF_G = OFF_K + 2 * SHM_K, OFF_WS = OFF_G + 512, OFF_MISC = OFF_WS + 8 * 256;
constexpr float THR = 8.f;
#define KSWZ(row, colB) ((row) * 256 + ((colB) ^ (((row) & 7) << 4)))
#define SBAR() __builtin_amdgcn_sched_barrier(0)
DI int v_st(int k, int c) { const int kk = (k & ~0xC) | ((k & 4) << 1) | ((k & 8) >> 1); return ((kk >> 3) * 4 + (c >> 5)) * 512 + ((kk & 7) * 32 + (c & 31)) * 2; }
DI int v_rd_base(int lane) { return ((lane & 3) << 3) | (((lane >> 2) & 3) << 6) | (((lane >> 4) & 1) << 5) | (((lane >> 5) & 1) << 8); }
constexpr int v_rd_off(int d0, int ks, int half) { return d0 * 512 + ks * 4096 + half * 2048; }
DI int crow(int r, int hi) { return (r & 3) + 8 * (r >> 2) + 4 * hi; }
DI unsigned cvtpk(float lo, float hi) { return cvt_pk(lo, hi); }
DI void mask_tile(f32x16& p0, f32x16& p1, int dq) {
    const float NEG = -__builtin_inff();
#pragma unroll
    for (int r = 0; r < 16; ++r) { const int c = (r & 3) + 8 * (r >> 2); if (dq - c < 0) p0[r] = NEG; if (dq - c - 32 < 0) p1[r] = NEG; }
}
DI void partialSM(f32x16& p0, f32x16& p1, float& m_reg, float& mn, float& alpha) {
    float pmax = p0[0];
#pragma unroll
    for (int r = 1; r < 16; ++r) pmax = fmaxf(pmax, p0[r]);
#pragma unroll
    for (int r = 0; r < 16; ++r) pmax = fmaxf(pmax, p1[r]);
    { auto rr = __builtin_amdgcn_permlane32_swap(__float_as_uint(pmax), __float_as_uint(pmax), false, false); pmax = fmaxf(__uint_as_float(rr[0]), __uint_as_float(rr[1])); }
    constexpr float C2 = 1.4426950408889634f * SCALE;
    if (__builtin_expect(__all((pmax - m_reg) * SCALE <= THR), 1)) { mn = m_reg; alpha = 1.f; }
    else { mn = fmaxf(m_reg, pmax); alpha = __builtin_amdgcn_exp2f((m_reg - mn) * C2); m_reg = mn; }
    const float mnL = -mn * C2;
#pragma unroll
    for (int r = 0; r < 16; ++r) p0[r] = fmaf(p0[r], C2, mnL);
#pragma unroll
    for (int r = 0; r < 16; ++r) p1[r] = fmaf(p1[r], C2, mnL);
#pragma unroll
    for (int r = 0; r < 16; ++r) p0[r] = __builtin_amdgcn_exp2f(p0[r]);
}
DI void finishSM(f32x16& p0, f32x16& p1, float alpha, float& l_reg, bf16x8& pa0, bf16x8& pa1, bf16x8& pa2, bf16x8& pa3) {
#pragma unroll
    for (int r = 0; r < 16; ++r) p1[r] = __builtin_amdgcn_exp2f(p1[r]);
    float ps = 0;
#pragma unroll
    for (int r = 0; r < 16; ++r) ps += p0[r];
#pragma unroll
    for (int r = 0; r < 16; ++r) ps += p1[r];
    { auto rr = __builtin_amdgcn_permlane32_swap(__float_as_uint(ps), __float_as_uint(ps), false, false); ps = __uint_as_float(rr[0]) + __uint_as_float(rr[1]); }
    l_reg = l_reg * alpha + ps;
#define PK4(P, B_, OUT) do { unsigned a0 = cvtpk(P[B_+0], P[B_+1]), a1 = cvtpk(P[B_+2], P[B_+3]);                          \
        unsigned b0 = cvtpk(P[B_+4], P[B_+5]), b1 = cvtpk(P[B_+6], P[B_+7]);                                             \
        auto r0 = __builtin_amdgcn_permlane32_swap(a0, b0, false, false); auto r1 = __builtin_amdgcn_permlane32_swap(a1, b1, false, false); \
        u32x4 w = {r0[0], r1[0], r0[1], r1[1]}; OUT = *reinterpret_cast<bf16x8*>(&w); } while (0)
    PK4(p0, 0, pa0); PK4(p0, 8, pa1); PK4(p1, 0, pa2); PK4(p1, 8, pa3);
#undef PK4
}
DI void qkt(f32x16& p0, f32x16& p1, const char* Kb, int r32, int hi, const bf16x8* qr) {
    p0 = f32x16{}; p1 = f32x16{};
    const char* kb[4];
#pragma unroll
    for (int dd = 0; dd < 4; ++dd) kb[dd] = Kb + KSWZ(r32, (dd * 16 + hi * 8) * 2);
#pragma unroll
    for (int d0 = 0; d0 < 8; ++d0) { const char* a = kb[d0 & 3] + (d0 >> 2) * 128;
        bf16x8 b0 = *reinterpret_cast<const bf16x8*>(a);
        bf16x8 b1 = *reinterpret_cast<const bf16x8*>(a + 32 * 256);
        p0 = __builtin_amdgcn_mfma_f32_32x32x16_bf16(b0, qr[d0], p0, 0, 0, 0);
        p1 = __builtin_amdgcn_mfma_f32_32x32x16_bf16(b1, qr[d0], p1, 0, 0, 0); }
}
DI void pv_tile(f32x16* o, int vb0, bf16x8 pa0, bf16x8 pa1, bf16x8 pa2, bf16x8 pa3) {
#define TRRD(dst, off) asm volatile("ds_read_b64_tr_b16 %0, %1 offset:%2" : "=&v"(dst) : "v"(vb0), "i"(off) : "memory")
#define PV_D0(d0) do { s16x4 l0, l1, l2, l3, h0, h1, h2, h3; constexpr int b_ = v_rd_off(d0, 0, 0); \
        TRRD(l0, b_); TRRD(h0, b_ + 2048); TRRD(l1, b_ + 4096); TRRD(h1, b_ + 6144); TRRD(l2, b_ + 8192); TRRD(h2, b_ + 10240); TRRD(l3, b_ + 12288); TRRD(h3, b_ + 14336); \
        asm volatile("s_waitcnt lgkmcnt(0)" ::: "memory"); SBAR();   \
        o[d0] = __builtin_amdgcn_mfma_f32_32x32x16_bf16(pa0, (bf16x8){l0[0], l0[1], l0[2], l0[3], h0[0], h0[1], h0[2], h0[3]}, o[d0], 0, 0, 0);   \
        o[d0] = __builtin_amdgcn_mfma_f32_32x32x16_bf16(pa1, (bf16x8){l1[0], l1[1], l1[2], l1[3], h1[0], h1[1], h1[2], h1[3]}, o[d0], 0, 0, 0);   \
        o[d0] = __builtin_amdgcn_mfma_f32_32x32x16_bf16(pa2, (bf16x8){l2[0], l2[1], l2[2], l2[3], h2[0], h2[1], h2[2], h2[3]}, o[d0], 0, 0, 0);   \
        o[d0] = __builtin_amdgcn_mfma_f32_32x32x16_bf16(pa3, (bf16x8){l3[0], l3[1], l3[2], l3[3], h3[0], h3[1], h3[2], h3[3]}, o[d0], 0, 0, 0); } while (0)
    PV_D0(0); PV_D0(1); PV_D0(2); PV_D0(3);
#undef PV_D0
#undef TRRD
}
DI void fox_block(const Args& a, char* lds, int h, int P0, int j_lo) {
    const int tid = threadIdx.x, wid = __builtin_amdgcn_readfirstlane(tid >> 6), lane = tid & 63, r32 = lane & 31, hi = lane >> 5;
    const bf16_t* P = (const bf16_t*)(a.ws + WS_PROJ); const float* F = (const float*)(a.ws + WS_F) + (size_t)h * SEQ; bf16_t* OB = (bf16_t*)(a.ws + WS_OB);
    const bf16_t* Qp = P + PJ_FQ + h * 128; const bf16_t* Kp = P + PJ_FK + h * 128; const bf16_t* Vp = P + PJ_FV + h * 128;
    const int j_hi = (P0 + 255) / KVBLK + 1, NT = j_hi - j_lo;
    const int qlo = P0 + wid * 32, qm = qlo + r32 - 4 * hi;
    char* V_lds = lds + OFF_V; char* K_lds = lds + OFF_K; float* G_lds = (float*)(lds + OFF_G);
    float* wsp = (float*)(lds + OFF_WS) + wid * 64; float* li_l = wsp; float* al_l = wsp + 32;
    const int sr = tid >> 4, sc = (tid & 15) * 8, vst0 = v_st(sr, sc), vst1 = v_st(32 + sr, sc), kws = KSWZ(sr, sc * 2);
    const int vb0 = (int)(unsigned)(uintptr_t)(LAS char*)V_lds + v_rd_base(lane);
    const float Fref = F[P0];
    bf16x8 qr[8];
#pragma unroll
    for (int d0 = 0; d0 < 8; ++d0) qr[d0] = *(const bf16x8*)(Qp + (size_t)(qlo + r32) * NPJ + d0 * 16 + hi * 8);
    float m_reg = -1e30f, l_reg = 0.f; f32x16 o[4] = {};
    bf16x8 st_k0, st_k1, st_v0, st_v1; float st_g = 0.f;
#define FOX_LOAD(t) do { const size_t k0_ = (size_t)(j_lo + (t)) * KVBLK; \
        st_k0 = *(const bf16x8*)(Kp + (k0_ + sr) * NPJ + sc); st_k1 = *(const bf16x8*)(Kp + (k0_ + 32 + sr) * NPJ + sc); \
        st_v0 = *(const bf16x8*)(Vp + (k0_ + sr) * NPJ + sc); st_v1 = *(const bf16x8*)(Vp + (k0_ + 32 + sr) * NPJ + sc); \
        if (tid < 64) st_g = F[k0_ + tid]; } while (0)
#define FOX_WRITE(bf) do { *(bf16x8*)(K_lds + (bf) * SHM_K + kws) = st_k0; *(bf16x8*)(K_lds + (bf) * SHM_K + kws + 32 * 256) = st_k1; \
        *(bf16x8*)(V_lds + (bf) * SHM_V + vst0) = st_v0; *(bf16x8*)(V_lds + (bf) * SHM_V + vst1) = st_v1; \
        if (tid < 64) G_lds[(bf) * 64 + tid] = (st_g - Fref) * (1.f / SCALE); } while (0)
    FOX_LOAD(0); asm volatile("s_waitcnt vmcnt(0)" ::: "memory"); FOX_WRITE(0);
    __syncthreads();
    for (int t = 0; t < NT; ++t) {
        const int bf = t & 1, kb_ = (j_lo + t) * KVBLK;
        if (t + 1 < NT) FOX_LOAD(t + 1);
        if (kb_ <= qlo + 31) {
            f32x16 p0, p1; float mn, al; bf16x8 pa0, pa1, pa2, pa3;
            qkt(p0, p1, K_lds + bf * SHM_K, r32, hi, qr);
            const float* gt = G_lds + bf * 64 + 4 * hi;
#pragma unroll
            for (int g4 = 0; g4 < 4; ++g4) { const f32x4 g0 = *(const f32x4*)(gt + 8 * g4), g1 = *(const f32x4*)(gt + 32 + 8 * g4);
#pragma unroll
                for (int i = 0; i < 4; ++i) { p0[4 * g4 + i] -= g0[i]; p1[4 * g4 + i] -= g1[i]; } }
            if (kb_ + KVBLK - 1 > qlo) mask_tile(p0, p1, qm - kb_);
            partialSM(p0, p1, m_reg, mn, al);
            finishSM(p0, p1, al, l_reg, pa0, pa1, pa2, pa3);
            if (__any(al < 1.f)) { if (hi == 0) al_l[r32] = al; asm volatile("s_waitcnt lgkmcnt(0)" ::: "memory");
#pragma unroll
                for (int d_ = 0; d_ < 4; ++d_)
#pragma unroll
                    for (int r = 0; r < 16; ++r) o[d_][r] *= al_l[crow(r, hi)]; }
            SBAR();
            pv_tile(o, vb0 + bf * SHM_V, pa0, pa1, pa2, pa3);
        }
        if (t + 1 < NT) { asm volatile("s_waitcnt vmcnt(0)" ::: "memory"); FOX_WRITE(bf ^ 1); }
        __syncthreads();
    }
#undef FOX_LOAD
#undef FOX_WRITE
    if (hi == 0) li_l[r32] = l_reg;
    asm volatile("s_waitcnt lgkmcnt(0)" ::: "memory");
    bf16_t* Ow = OB + (size_t)qlo * 512 + h * 128;
#pragma unroll
    for (int r = 0; r < 16; ++r) { const int orow = crow(r, hi); const float rl = __builtin_amdgcn_rcpf(li_l[orow]);
#pragma unroll
        for (int d0 = 0; d0 < 4; ++d0) { const float v = o[d0][r] * rl; const float vn = __shfl_xor(v, 1);
            if ((r32 & 1) == 0) *(unsigned*)(Ow + (size_t)orow * 512 + d0 * 32 + r32) = cvtpk(v, vn); } }
    __syncthreads();
}
#undef KSWZ
}

DI void transpose_tile(float* tile, const float* src, int ld, int k0, int c0, int c1, bf16_t* dst, int Kd) {
    const int tid = threadIdx.x, nn = tid & 63, k8 = tid >> 6; const int col = nn < 32 ? c0 + nn : c1 + nn - 32;
    const float* s = src + (size_t)(k0 + k8 * 8) * ld + col;
    float v[8];
#pragma unroll
    for (int i = 0; i < 8; ++i) v[i] = s[(size_t)i * ld];
    u32x4 w; w.x = cvt_pk(v[0], v[1]); w.y = cvt_pk(v[2], v[3]); w.z = cvt_pk(v[4], v[5]); w.w = cvt_pk(v[6], v[7]);
    *(u32x4*)(dst + (size_t)nn * Kd + k0 + k8 * 8) = w;
}
DI void ph0(const Args& a, float* lds) {
    const int tid = threadIdx.x, G = gridDim.x, bx = blockIdx.x;
    unsigned char* ws = a.ws;
    for (int grp = bx; grp < 256; grp += G) {
        const int col = tid % 24, ks = tid / 24, j = grp * 24 + col; const float* c = a.in[I_C]; const float* w = a.in[I_WADA];
        float acc = 0.f;
        if (ks < 21) { const int k1 = (ks * 49 + 49) < DM ? (ks * 49 + 49) : DM; for (int k = ks * 49; k < k1; ++k) acc += c[k] * w[(size_t)k * 6144 + j]; }
        __syncthreads();
        if (ks < 21) lds[ks * 24 + col] = acc;
        __syncthreads();
        if (tid < 24) { float s = a.in[I_BADA][grp * 24 + tid]; for (int q = 0; q < 21; ++q) s += lds[q * 24 + tid]; ((float*)(ws + WS_MOD))[grp * 24 + tid] = s; }
    }
    constexpr int T_WIN = 88 * 16, T_WOA = 16 * 8, T_WOUT = 16 * 16, T_WGU = 32 * 32 * 16, T_WD = 32 * 16 * 16;
    constexpr int NT = T_WIN + 2 * T_WOA + T_WOUT + T_WGU + T_WD;
    for (int t = bx; t < NT; t += G) {
        int r = t;
        if (r < T_WIN) { const int nt = r / 16, kt = r % 16, n0 = nt * 64; const int c0 = n0 + (n0 >= 3584 ? 12 : (n0 >= 2048 ? 8 : 0));
            transpose_tile(lds, a.in[I_WIN], NIN, kt * 64, c0, c0 + 32, (bf16_t*)(ws + WS_WINT) + (size_t)n0 * DM, DM); continue; }
        r -= T_WIN;
        if (r < T_WOA) { const int nt = r / 8, kt = r % 8, n0 = nt * 64; transpose_tile(lds, a.in[I_WOD], DM, kt * 64, n0, n0 + 32, (bf16_t*)(ws + WS_WOAT) + (size_t)n0 * 512, 512); continue; }
        r -= T_WOA;
        if (r < T_WOA) { const int nt = r / 8, kt = r % 8, n0 = nt * 64; transpose_tile(lds, a.in[I_WOF], DM, kt * 64, n0, n0 + 32, (bf16_t*)(ws + WS_WOBT) + (size_t)n0 * 512, 512); continue; }
        r -= T_WOA;
        if (r < T_WOUT) { const int nt = r / 16, kt = r % 16, n0 = nt * 64; transpose_tile(lds, a.in[I_WOUT], DM, kt * 64, n0, n0 + 32, (bf16_t*)(ws + WS_WOUTT) + (size_t)n0 * DM, DM); continue; }
        r -= T_WOUT;
        if (r < T_WGU) { const int e = r / 512, q = r % 512, nt = q / 16, kt = q % 16, n0 = nt * 64;
            transpose_tile(lds, a.in[I_WGU] + (size_t)e * DM * 2048, 2048, kt * 64, gu_src(n0), gu_src(n0 + 32), (bf16_t*)(ws + WS_WGUT) + ((size_t)e * 2048 + n0) * DM, DM); continue; }
        r -= T_WGU;
        { const int e = r / 256, q = r % 256, nt = q / 16, kt = q % 16, n0 = nt * 64;
            transpose_tile(lds, a.in[I_WD] + (size_t)e * DM * DM, DM, kt * 64, n0, n0 + 32, (bf16_t*)(ws + WS_WDT) + ((size_t)e * DM + n0) * DM, DM); }
    }
}

DI void ph1(const Args& a, float* lds) {
    const int tid = threadIdx.x, lane = tid & 63, wave = tid >> 6, G = gridDim.x;
    float* A1 = lds; float* B1 = lds + 1024; float* wsm = lds + 2048;
    const float* mod = (const float*)(a.ws + WS_MOD);
    for (int k = tid; k < DM; k += NTHREADS) { A1[k] = a.in[I_G1][k] * (1.f + mod[1024 + k]); B1[k] = mod[k]; }
    for (int i = tid; i < 12 * DM; i += NTHREADS) { const int k = i / 12, j = i % 12; wsm[j * DM + k] = a.in[I_WIN][(size_t)k * NIN + (j < 8 ? 2048 + j : 3592 + (j - 8))]; }
    __syncthreads();
    bf16_t* H = (bf16_t*)(a.ws + WS_H); float* SP = (float*)(a.ws + WS_SP);
    for (int t = blockIdx.x * NWAVES + wave; t < SEQ; t += G * NWAVES) {
        const float* xr = a.in[I_X] + (size_t)t * DM;
        f32x4 v[4]; float ss = 0.f;
#pragma unroll
        for (int i = 0; i < 4; ++i) { v[i] = *(const f32x4*)(xr + lane * 4 + 256 * i); ss += v[i][0] * v[i][0] + v[i][1] * v[i][1] + v[i][2] * v[i][2] + v[i][3] * v[i][3]; }
        ss = wave_sum(ss);
        const float rstd = rsqrtf(ss * (1.f / DM) + 1e-6f);
#pragma unroll
        for (int i = 0; i < 4; ++i) { const int k = lane * 4 + 256 * i;
#pragma unroll
            for (int e = 0; e < 4; ++e) v[i][e] = v[i][e] * rstd * A1[k + e] + B1[k + e];
            u32x2 w; w.x = pk2(v[i][0], v[i][1]); w.y = pk2(v[i][2], v[i][3]);
            *(u32x2*)(H + (size_t)t * DM + k) = w; }
#pragma unroll 1
        for (int j = 0; j < 12; ++j) { float pj = 0.f;
#pragma unroll
            for (int i = 0; i < 4; ++i) { const f32x4 wv = *(const f32x4*)(wsm + j * DM + lane * 4 + 256 * i); pj += v[i][0] * wv[0] + v[i][1] * wv[1] + v[i][2] * wv[2] + v[i][3] * wv[3]; }
            const float s = wave_sum(pj); if (lane == j) SP[(size_t)t * 16 + j] = s; }
    }
}

DI void ph2(const Args& a, unsigned char* ldsb) {
    pg8::Gemm g{(const bf16_t*)(a.ws + WS_H), (const bf16_t*)(a.ws + WS_WINT), SEQ, NPJ, DM};
    pg8::OrderDense S; S.init(SEQ / 256, NPJ / 256, (int)gridDim.x, (int)blockIdx.x);
    pg8::EpiStoreBf16 E{(bf16_t*)(a.ws + WS_PROJ), NPJ, nullptr, 0};
    pg8::gemm_phase<pg8::EpiStoreBf16, pg8::OrderDense>((LAS unsigned char*)ldsb, g, S, E);
}

DI void ph3_fcum(const Args& a, float* lds) {
    const int tid = threadIdx.x, lane = tid & 63, wave = tid >> 6, h = blockIdx.x;
    const float* SP = (const float*)(a.ws + WS_SP); float* F = (float*)(a.ws + WS_F);
    const float bf = a.in[I_BFG][h];
    double* wtot = (double*)lds;
    float lf[32];
#pragma unroll
    for (int i = 0; i < 32; ++i) lf[i] = SP[(size_t)(tid * 32 + i) * 16 + 8 + h];
    double s = 0.0;
#pragma unroll
    for (int i = 0; i < 32; ++i) { lf[i] = logsigf(lf[i] + bf); s += (double)lf[i]; }
    double inc = s;
#pragma unroll
    for (int o_ = 1; o_ < 64; o_ <<= 1) { const double y = __shfl_up(inc, o_); if (lane >= o_) inc += y; }
    __syncthreads();
    if (lane == 63) wtot[wave] = inc;
    __syncthreads();
    double off = inc - s;
    for (int w = 0; w < wave; ++w) off += wtot[w];
#pragma unroll
    for (int i = 0; i < 32; ++i) { off += (double)lf[i]; F[(size_t)h * SEQ + tid * 32 + i] = (float)off; }
    __syncthreads();
}
namespace prep {
constexpr int QS = 0, KS = 17408, KT = 34816, VT = 53248, UNIT = 71680, SM = 2 * UNIT;
DI bf16x8 ld8(const char* p) { return *(const bf16x8*)p; }
template <int C, int M4> struct TRow { static DI void run(const float (&T)[64], const float* Ls, float& a0, float& a1) {
    if constexpr (4 * M4 < C) { const f32x4 Lv = *(const f32x4*)(Ls + C * 68 + 4 * M4);
        a0 -= Lv[0] * T[4 * M4]; if constexpr (4 * M4 + 1 < C) a1 -= Lv[1] * T[4 * M4 + 1]; if constexpr (4 * M4 + 2 < C) a0 -= Lv[2] * T[4 * M4 + 2]; if constexpr (4 * M4 + 3 < C) a1 -= Lv[3] * T[4 * M4 + 3];
        TRow<C, M4 + 1>::run(T, Ls, a0, a1); } } };
template <int C> struct TRow<C, 16> { static DI void run(const float (&)[64], const float*, float&, float&) {} };
template <int C> DI void tsolve(float (&T)[64], const float* Ls, int lane) {
    if constexpr (C < 64) { float a0 = (lane == C) ? 1.f : 0.f, a1 = 0.f; TRow<C, 0>::run(T, Ls, a0, a1); T[C] = a0 + a1; asm volatile("" ::: "memory"); __builtin_amdgcn_sched_barrier(0); tsolve<C + 1>(T, Ls, lane); } }
}
DI void ph3_prep2(const Args& a, char* lds, int pair) {
    using namespace prep;
    const int tid = threadIdx.x, lane = tid & 63, wave = tid >> 6, grp = wave >> 2, wq = wave & 3, tg = tid & 255, lr = lane & 15, lq = lane >> 4;
    int unit = pair * 2 + grp; if (unit >= NH * NCH) unit = NH * NCH - 1;
    const int h = unit & 3, n = unit >> 2, t0 = n * CH;
    char* U = lds + grp * UNIT;
    float* gcs = (float*)(lds + SM) + grp * 192; float* bes = gcs + 64; float* egs = gcs + 128;
    const float* SP = (const float*)(a.ws + WS_SP); const bf16_t* P = (const bf16_t*)(a.ws + WS_PROJ);
    const size_t cb = (size_t)(h * NCH + n);
    bf16_t* WF = (bf16_t*)(a.ws + WS_DNW) + cb * 8192; bf16_t* UF = (bf16_t*)(a.ws + WS_DNU) + cb * 8192;
    bf16_t* QF = (bf16_t*)(a.ws + WS_DNQD) + cb * 8192; bf16_t* KF = (bf16_t*)(a.ws + WS_DNKD) + cb * 8192; bf16_t* AF = (bf16_t*)(a.ws + WS_DNATT) + cb * 4096;
    __syncthreads();
    if (wq == 0) { const int t = t0 + lane;
        const float be = sigm(SP[(size_t)t * 16 + h]);
        float g = -expf(a.in[I_ALOG][h]) * softplusf(SP[(size_t)t * 16 + 4 + h] + a.in[I_DTB][h]);
#pragma unroll
        for (int o_ = 1; o_ < 64; o_ <<= 1) { const float y = __shfl_up(g, o_); if (lane >= o_) g += y; }
        gcs[lane] = g; bes[lane] = be; egs[lane] = expf(g); }
    __syncthreads();
    { const int d8 = tg & 15, ci = tg >> 4; const float* cw = a.in[I_CONVW];
#pragma unroll 1
        for (int sec = 0; sec < 3; ++sec) {
            const int col = sec * 512 + h * 128 + d8 * 8;
            f32x4 w[4][2];
#pragma unroll
            for (int j = 0; j < 4; ++j) { w[j][0] = *(const f32x4*)(cw + j * 1536 + col); w[j][1] = *(const f32x4*)(cw + j * 1536 + col + 4); }
#pragma unroll 1
          for (int ih = 0; ih < 2; ++ih) {
            u32x4 xin[2][4];
#pragma unroll
            for (int i = 0; i < 2; ++i)
#pragma unroll
                for (int j = 0; j < 4; ++j) { int tt = t0 + ci + 16 * (2 * ih + i) - 3 + j; tt = tt < 0 ? 0 : tt; xin[i][j] = *(const u32x4*)(P + (size_t)tt * NPJ + col); }
#pragma unroll
            for (int i = 0; i < 2; ++i) { const int c = ci + 16 * (2 * ih + i), t = t0 + c;
                float v[8];
#pragma unroll
                for (int e = 0; e < 8; ++e) v[e] = 0.f;
#pragma unroll
                for (int j = 0; j < 4; ++j) { const float ok = (t - 3 + j >= 0) ? 1.f : 0.f; const u32x4 x = xin[i][j];
                    v[0] += ok * w[j][0][0] * __uint_as_float(x.x << 16); v[1] += ok * w[j][0][1] * __uint_as_float(x.x & 0xffff0000u); v[2] += ok * w[j][0][2] * __uint_as_float(x.y << 16); v[3] += ok * w[j][0][3] * __uint_as_float(x.y & 0xffff0000u);
                    v[4] += ok * w[j][1][0] * __uint_as_float(x.z << 16); v[5] += ok * w[j][1][1] * __uint_as_float(x.z & 0xffff0000u); v[6] += ok * w[j][1][2] * __uint_as_float(x.w << 16); v[7] += ok * w[j][1][3] * __uint_as_float(x.w & 0xffff0000u); }
                float ss = 0.f;
#pragma unroll
                for (int e = 0; e < 8; ++e) { v[e] = siluf(v[e]); ss += v[e] * v[e]; }
                if (sec < 2) { ss += __shfl_xor(ss, 1); ss += __shfl_xor(ss, 2); ss += __shfl_xor(ss, 4); ss += __shfl_xor(ss, 8);
                    const float sc = rsqrtf(ss + 1e-6f) * (sec == 0 ? 0.08838834764831845f : 1.f);
#pragma unroll
                    for (int e = 0; e < 8; ++e) v[e] *= sc; }
                u32x4 pk; pk.x = cvt_pk(v[0], v[1]); pk.y = cvt_pk(v[2], v[3]); pk.z = cvt_pk(v[4], v[5]); pk.w = cvt_pk(v[6], v[7]);
                if (sec == 0) { *(u32x4*)(U + QS + c * 272 + d8 * 16) = pk;
                    const float eg = egs[c];
                    const int base = (((c >> 4) * 4 + (d8 >> 2)) * 64 + (c & 15)) * 8 + 4 * ((d8 & 3) >> 1), l0 = (2 * (d8 & 3)) & 3;
                    u32x2 q0, q1; q0.x = cvt_pk(v[0] * eg, v[1] * eg); q0.y = cvt_pk(v[2] * eg, v[3] * eg); q1.x = cvt_pk(v[4] * eg, v[5] * eg); q1.y = cvt_pk(v[6] * eg, v[7] * eg);
                    *(u32x2*)(QF + base + l0 * 128) = q0; *(u32x2*)(QF + base + (l0 + 1) * 128) = q1; }
                else { if (sec == 1) *(u32x4*)(U + KS + c * 272 + d8 * 16) = pk;
                    bf16_t* T_ = (bf16_t*)(U + (sec == 1 ? KT : VT)) + (d8 * 8) * 72 + c;
                    T_[0 * 72] = (bf16_t)(pk.x & 0xffffu); T_[1 * 72] = (bf16_t)(pk.x >> 16); T_[2 * 72] = (bf16_t)(pk.y & 0xffffu); T_[3 * 72] = (bf16_t)(pk.y >> 16);
                    T_[4 * 72] = (bf16_t)(pk.z & 0xffffu); T_[5 * 72] = (bf16_t)(pk.z >> 16); T_[6 * 72] = (bf16_t)(pk.w & 0xffffu); T_[7 * 72] = (bf16_t)(pk.w >> 16); }
            }
          }
        }
    }
    __syncthreads();
    f32x4 Lr[4];
    { const int mt = wq;
#pragma unroll
        for (int nt = 0; nt < 4; ++nt) { Lr[nt] = (f32x4){0.f, 0.f, 0.f, 0.f};
            if (nt <= mt) {
#pragma unroll
                for (int s = 0; s < 4; ++s) Lr[nt] = MFMA16(ld8(U + KS + (16 * mt + lr) * 272 + (32 * s + 8 * lq) * 2), ld8(U + KS + (16 * nt + lr) * 272 + (32 * s + 8 * lq) * 2), Lr[nt]); } }
        const int ntq = 3 - wq; const float gcc = gcs[16 * ntq + lr];
#pragma unroll
        for (int mtk = 0; mtk < 4; ++mtk) { f32x4 acc = (f32x4){0.f, 0.f, 0.f, 0.f};
            if (mtk <= ntq) {
#pragma unroll
                for (int s = 0; s < 4; ++s) acc = MFMA16(ld8(U + KS + (16 * mtk + lr) * 272 + (32 * s + 8 * lq) * 2), ld8(U + QS + (16 * ntq + lr) * 272 + (32 * s + 8 * lq) * 2), acc);
#pragma unroll
                for (int r = 0; r < 4; ++r) { const int m = 16 * mtk + 4 * lq + r, c = 16 * ntq + lr; acc[r] = (m <= c) ? acc[r] * expf(gcc - gcs[m]) : 0.f; } }
            u32x2 o_; o_.x = cvt_pk(acc[0], acc[1]); o_.y = cvt_pk(acc[2], acc[3]);
            *(u32x2*)(AF + ((ntq * 2 + (mtk >> 1)) * 64 + lane) * 8 + 4 * (mtk & 1)) = o_; }
    }
    __syncthreads();
    { const int mt = wq; float* LT = (float*)(U + QS);
#pragma unroll
        for (int nt = 0; nt < 4; ++nt) if (nt <= mt) { const int m = 16 * nt + lr; f32x4 o_;
#pragma unroll
            for (int r = 0; r < 4; ++r) { const int c = 16 * mt + 4 * lq + r; o_[r] = (m < c) ? bes[c] * Lr[nt][r] * expf(gcs[c] - gcs[m]) : 0.f; }
            *(f32x4*)(LT + m * 68 + 16 * mt + 4 * lq) = o_; } }
    __syncthreads();
    if (wq == 0) { const float* LT = (const float*)(U + QS); float* Tl = (float*)(U + KS);
#pragma unroll
        for (int ib = 0; ib < 4; ++ib) { float acc[16];
#pragma unroll
            for (int r = 0; r < 16; ++r) acc[r] = (lane == 16 * ib + r) ? 1.f : 0.f;
#pragma unroll 2
            for (int m = 0; m < 16 * ib; ++m) { const float t = Tl[m * 68 + lane];
#pragma unroll
                for (int q = 0; q < 4; ++q) { const f32x4 Lv = *(const f32x4*)(LT + m * 68 + 16 * ib + 4 * q);
#pragma unroll
                    for (int e = 0; e < 4; ++e) acc[4 * q + e] -= Lv[e] * t; } }
#pragma unroll
            for (int p = 0; p < 16; ++p) { const float t = acc[p]; Tl[(16 * ib + p) * 68 + lane] = t;
                if (p < 15) {
#pragma unroll
                    for (int q = 0; q < 4; ++q) if (4 * q + 3 > p) { const f32x4 Lv = *(const f32x4*)(LT + (16 * ib + p) * 68 + 16 * ib + 4 * q);
#pragma unroll
                        for (int e = 0; e < 4; ++e) if (4 * q + e > p) acc[4 * q + e] -= Lv[e] * t; } } }
            asm volatile("s_waitcnt lgkmcnt(0)" ::: "memory"); }
        if (lane == 0) ((float*)(a.ws + WS_EG))[cb] = egs[63];
    } else { const float gl = gcs[63];
        for (int i = tg - 64; i < 2048; i += 192) { const int dk = i >> 4, cq = i & 15;
            const u32x2 x = *(const u32x2*)(U + KT + dk * 144 + cq * 8);
            const float e0 = expf(gl - gcs[4 * cq]), e1 = expf(gl - gcs[4 * cq + 1]), e2 = expf(gl - gcs[4 * cq + 2]), e3 = expf(gl - gcs[4 * cq + 3]);
            u32x2 o_; o_.x = cvt_pk(__uint_as_float(x.x << 16) * e0, __uint_as_float(x.x & 0xffff0000u) * e1); o_.y = cvt_pk(__uint_as_float(x.y << 16) * e2, __uint_as_float(x.y & 0xffff0000u) * e3);
            *(u32x2*)(KF + (((dk >> 4) * 2 + (cq >> 3)) * 64 + (cq & 3) * 16 + (dk & 15)) * 8 + 4 * ((cq >> 2) & 1)) = o_; } }
    __syncthreads();
    { const float* Tl = (const float*)(U + KS); const int c = tg >> 2, m0 = (tg & 3) * 16;
        f32x4 tv[4];
#pragma unroll
        for (int q = 0; q < 4; ++q) tv[q] = *(const f32x4*)(Tl + c * 68 + m0 + 4 * q);
        __syncthreads();
        bf16_t* Tb = (bf16_t*)(U + QS); bf16_t* Tg = (bf16_t*)(U + KS);
#pragma unroll
        for (int q = 0; q < 4; ++q) { u32x2 b_, g_; float be[4], bg[4];
#pragma unroll
            for (int e = 0; e < 4; ++e) { const int m = m0 + 4 * q + e; be[e] = tv[q][e] * bes[m]; bg[e] = be[e] * egs[m]; }
            b_.x = cvt_pk(be[0], be[1]); b_.y = cvt_pk(be[2], be[3]); g_.x = cvt_pk(bg[0], bg[1]); g_.y = cvt_pk(bg[2], bg[3]);
            *(u32x2*)(Tb + c * 72 + m0 + 4 * q) = b_; *(u32x2*)(Tg + c * 72 + m0 + 4 * q) = g_; } }
    __syncthreads();
    {
#pragma unroll
        for (int q = 0; q < 2; ++q) { const int nt = 2 * wq + q;
#pragma unroll
            for (int mt = 0; mt < 4; ++mt) { f32x4 acc = (f32x4){0.f, 0.f, 0.f, 0.f};
#pragma unroll
                for (int s = 0; s < 2; ++s) acc = MFMA16(ld8(U + QS + (16 * mt + lr) * 144 + (32 * s + 8 * lq) * 2), ld8(U + VT + (16 * nt + lr) * 144 + (32 * s + 8 * lq) * 2), acc);
                u32x2 o_; o_.x = cvt_pk(acc[0], acc[1]); o_.y = cvt_pk(acc[2], acc[3]);
                *(u32x2*)(UF + ((nt * 4 + mt) * 64 + lane) * 4) = o_; } }
#pragma unroll
        for (int q = 0; q < 2; ++q) { const int mtk = 2 * wq + q;
#pragma unroll
            for (int ntc = 0; ntc < 4; ++ntc) { f32x4 acc = (f32x4){0.f, 0.f, 0.f, 0.f};
#pragma unroll
                for (int s = 0; s < 2; ++s) acc = MFMA16(ld8(U + KT + (16 * mtk + lr) * 144 + (32 * s + 8 * lq) * 2), ld8(U + KS + (16 * ntc + lr) * 144 + (32 * s + 8 * lq) * 2), acc);
                u32x2 o_; o_.x = cvt_pk(-acc[0], -acc[1]); o_.y = cvt_pk(-acc[2], -acc[3]);
                *(u32x2*)(WF + ((ntc * 4 + (mtk >> 1)) * 64 + lane) * 8 + 4 * (mtk & 1)) = o_; } }
    }
}
DI void ph3_norms(const Args& a, float* lds) {
    const int lane = threadIdx.x & 63, wave = threadIdx.x >> 6, NW = gridDim.x * NWAVES, sub = lane >> 4, l16 = lane & 15;
    const bf16_t* P = (const bf16_t*)(a.ws + WS_PROJ);
    float mq[4] = {0.f, 0.f, 0.f, 0.f}, mk[4] = {0.f, 0.f, 0.f, 0.f};
    for (int base = (blockIdx.x * NWAVES + wave) * 4; base < SEQ; base += NW * 4) { const bf16_t* row = P + (size_t)(base + sub) * NPJ + l16 * 8;
        u32x4 xq[4], xk[4];
#pragma unroll
        for (int h = 0; h < 4; ++h) { xq[h] = *(const u32x4*)(row + PJ_FQ + h * 128); xk[h] = *(const u32x4*)(row + PJ_FK + h * 128); }
#pragma unroll
        for (int h = 0; h < 4; ++h) { float sq = 0.f, sk = 0.f;
#pragma unroll
            for (int e = 0; e < 4; ++e) { const float a0 = __uint_as_float(xq[h][e] << 16), a1 = __uint_as_float(xq[h][e] & 0xffff0000u), b0 = __uint_as_float(xk[h][e] << 16), b1 = __uint_as_float(xk[h][e] & 0xffff0000u);
                sq += a0 * a0 + a1 * a1; sk += b0 * b0 + b1 * b1; }
#pragma unroll
            for (int o_ = 1; o_ <= 8; o_ <<= 1) { sq += __shfl_xor(sq, o_); sk += __shfl_xor(sk, o_); }
            mq[h] = fmaxf(mq[h], sq); mk[h] = fmaxf(mk[h], sk); } }
    __syncthreads();
    float* red = lds;
#pragma unroll
    for (int h = 0; h < 4; ++h) { mq[h] = fmaxf(mq[h], __shfl_xor(mq[h], 16)); mq[h] = fmaxf(mq[h], __shfl_xor(mq[h], 32)); mk[h] = fmaxf(mk[h], __shfl_xor(mk[h], 16)); mk[h] = fmaxf(mk[h], __shfl_xor(mk[h], 32));
        if (lane == 0) { red[wave * 8 + h] = mq[h]; red[wave * 8 + 4 + h] = mk[h]; } }
    __syncthreads();
    if (threadIdx.x < 8) { float m = red[threadIdx.x];
        for (int w = 1; w < NWAVES; ++w) m = fmaxf(m, red[w * 8 + threadIdx.x]);
        ((float*)(a.ws + WS_NRMB))[blockIdx.x * 8 + threadIdx.x] = m; }
}
DI void ph3(const Args& a, float* lds) {
    const int G = gridDim.x;
    if (blockIdx.x < 4) ph3_fcum(a, lds);
    for (int p = blockIdx.x; p < NH * NCH / 2; p += G) ph3_prep2(a, (char*)lds, p);
    ph3_norms(a, lds);
}

namespace dn {
DI unsigned cvtpk(float lo, float hi) { return cvt_pk(lo, hi); }
DI bf16x8 packB(const f32x4& t0, const f32x4& t1) { u32x4 w = {cvtpk(t0[0], t0[1]), cvtpk(t0[2], t0[3]), cvtpk(t1[0], t1[1]), cvtpk(t1[2], t1[3])}; return *reinterpret_cast<bf16x8*>(&w); }
DI bf16x8 frag(const bf16_t* base, int f, int lane) { return *(const bf16x8*)(base + ((size_t)f * 64 + lane) * 8); }
template <bool WITH_U, bool WITH_O>
DI void step(const bf16_t* WFn, const bf16_t* KFn, const bf16_t* QFn, const bf16_t* AFn, const bf16_t* UFs, float eg, f32x4 (&S)[8], f32x4 (&o)[4], int lane) {
    bf16x8 sb[4];
#pragma unroll
    for (int s = 0; s < 4; ++s) sb[s] = packB(S[2 * s], S[2 * s + 1]);
    f32x4 vn[4];
#pragma unroll
    for (int mt = 0; mt < 4; ++mt) {
        if (WITH_U) { const u32x2 w = *(const u32x2*)(UFs + ((size_t)mt * 64 + lane) * 4); vn[mt] = (f32x4){__uint_as_float(w.x << 16), __uint_as_float(w.x & 0xffff0000u), __uint_as_float(w.y << 16), __uint_as_float(w.y & 0xffff0000u)}; }
        else vn[mt] = (f32x4){0.f, 0.f, 0.f, 0.f};
#pragma unroll
        for (int s = 0; s < 4; ++s) vn[mt] = MFMA16(frag(WFn, mt * 4 + s, lane), sb[s], vn[mt]); }
    if (WITH_O) {
#pragma unroll
        for (int mt = 0; mt < 4; ++mt) { o[mt] = (f32x4){0.f, 0.f, 0.f, 0.f};
#pragma unroll
            for (int s = 0; s < 4; ++s) o[mt] = MFMA16(frag(QFn, mt * 4 + s, lane), sb[s], o[mt]); } }
    bf16x8 vb[2];
#pragma unroll
    for (int s = 0; s < 2; ++s) vb[s] = packB(vn[2 * s], vn[2 * s + 1]);
    if (WITH_O) {
#pragma unroll
        for (int mt = 0; mt < 4; ++mt)
#pragma unroll
            for (int s = 0; s < 2; ++s) o[mt] = MFMA16(frag(AFn, mt * 2 + s, lane), vb[s], o[mt]); }
#pragma unroll
    for (int mt = 0; mt < 8; ++mt) { S[mt] = S[mt] * eg;
#pragma unroll
        for (int s = 0; s < 2; ++s) S[mt] = MFMA16(frag(KFn, mt * 2 + s, lane), vb[s], S[mt]); }
}
}
constexpr int NGRP = 16, GRP = 16;
DI void scanA(const Args& a) {
    const int lane = threadIdx.x & 63, wave = threadIdx.x >> 6, lr = lane & 15, lq = lane >> 4;
    if (wave >= 4) return;
    for (int task = blockIdx.x * 4 + wave; task < NH * NGRP * 16; task += gridDim.x * 4) {
        const int chain = task >> 4, sl = task & 15, h = chain >> 4, g = chain & 15; const bool isP = sl >= 8; const int vs = sl & 7;
        f32x4 S[8], o[4];
#pragma unroll
        for (int mt = 0; mt < 8; ++mt)
#pragma unroll
            for (int r = 0; r < 4; ++r) S[mt][r] = (isP && (16 * mt + 4 * lq + r == 16 * vs + lr)) ? 1.f : 0.f;
        for (int n = g * GRP; n < (g + 1) * GRP; ++n) { const size_t cb = (size_t)(h * NCH + n);
            const bf16_t* WFn = (const bf16_t*)(a.ws + WS_DNW) + cb * 8192; const bf16_t* KFn = (const bf16_t*)(a.ws + WS_DNKD) + cb * 8192;
            const bf16_t* UFs = (const bf16_t*)(a.ws + WS_DNU) + cb * 8192 + (size_t)vs * 1024; const float eg = ((const float*)(a.ws + WS_EG))[cb];
            if (isP) dn::step<false, false>(WFn, KFn, nullptr, nullptr, nullptr, eg, S, o, lane);
            else dn::step<true, false>(WFn, KFn, nullptr, nullptr, UFs, eg, S, o, lane); }
        if (isP) { bf16_t* PG = (bf16_t*)(a.ws + WS_PG) + (size_t)chain * 16384;
#pragma unroll
            for (int mt = 0; mt < 8; ++mt)
#pragma unroll
                for (int r = 0; r < 4; ++r) PG[((mt * 4 + (vs >> 1)) * 64 + (lr >> 2) * 16 + 4 * lq + r) * 8 + 4 * (vs & 1) + (lr & 3)] = f2bf(S[mt][r]); }
        else { float* QG = (float*)(a.ws + WS_QG) + ((size_t)chain * 8 + vs) * 2048;
#pragma unroll
            for (int mt = 0; mt < 8; ++mt) *(f32x4*)(QG + ((size_t)mt * 64 + lane) * 4) = S[mt]; }
    }
}
DI void scanB(const Args& a) {
    const int lane = threadIdx.x & 63, wave = threadIdx.x >> 6;
    if (wave != 0 || blockIdx.x >= NH * 8) return;
    const int h = blockIdx.x >> 3, vs = blockIdx.x & 7;
    f32x4 S[8];
#pragma unroll
    for (int mt = 0; mt < 8; ++mt) S[mt] = (f32x4){0.f, 0.f, 0.f, 0.f};
    for (int g = 0; g < NGRP; ++g) { const size_t chain = (size_t)(h * NGRP + g);
        float* SG = (float*)(a.ws + WS_SG) + (chain * 8 + vs) * 2048; const float* QG = (const float*)(a.ws + WS_QG) + (chain * 8 + vs) * 2048;
        const bf16_t* PG = (const bf16_t*)(a.ws + WS_PG) + chain * 16384;
        bf16x8 sb[4];
#pragma unroll
        for (int s = 0; s < 4; ++s) sb[s] = dn::packB(S[2 * s], S[2 * s + 1]);
#pragma unroll
        for (int mt = 0; mt < 8; ++mt) { *(f32x4*)(SG + ((size_t)mt * 64 + lane) * 4) = S[mt];
            f32x4 acc = *(const f32x4*)(QG + ((size_t)mt * 64 + lane) * 4);
#pragma unroll
            for (int s = 0; s < 4; ++s) acc = MFMA16(dn::frag(PG, mt * 4 + s, lane), sb[s], acc);
            S[mt] = acc; }
    }
}
DI void scanC(const Args& a) {
    const int lane = threadIdx.x & 63, wave = threadIdx.x >> 6, lr = lane & 15, lq = lane >> 4;
    if (wave >= 2) return;
    float* ORAW = (float*)(a.ws + WS_ORAW);
    for (int task = blockIdx.x * 2 + wave; task < NH * NGRP * 8; task += gridDim.x * 2) {
        const int chain = task >> 3, vs = task & 7, h = chain >> 4, g = chain & 15;
        const float* SG = (const float*)(a.ws + WS_SG) + ((size_t)chain * 8 + vs) * 2048;
        f32x4 S[8], o[4];
#pragma unroll
        for (int mt = 0; mt < 8; ++mt) S[mt] = *(const f32x4*)(SG + ((size_t)mt * 64 + lane) * 4);
        for (int n = g * GRP; n < (g + 1) * GRP; ++n) { const size_t cb = (size_t)(h * NCH + n);
            const bf16_t* WFn = (const bf16_t*)(a.ws + WS_DNW) + cb * 8192; const bf16_t* KFn = (const bf16_t*)(a.ws + WS_DNKD) + cb * 8192;
            const bf16_t* QFn = (const bf16_t*)(a.ws + WS_DNQD) + cb * 8192; const bf16_t* AFn = (const bf16_t*)(a.ws + WS_DNATT) + cb * 4096;
            const bf16_t* UFs = (const bf16_t*)(a.ws + WS_DNU) + cb * 8192 + (size_t)vs * 1024; const float eg = ((const float*)(a.ws + WS_EG))[cb];
            dn::step<true, true>(WFn, KFn, QFn, AFn, UFs, eg, S, o, lane);
#pragma unroll
            for (int mt = 0; mt < 4; ++mt)
#pragma unroll
                for (int r = 0; r < 4; ++r) ORAW[(size_t)(n * CH + 16 * mt + 4 * lq + r) * 512 + h * 128 + 16 * vs + lr] = o[mt][r]; }
    }
}
DI void ph4_fox(const Args& a, char* lds) {
    const int tid = threadIdx.x, lane = tid & 63, wave = tid >> 6;
    const float* F = (const float*)(a.ws + WS_F); unsigned* QH = (unsigned*)(a.ws + WS_QH);
    int* misc = (int*)(lds + fox::OFF_MISC);
    int ord0 = 0, ord1 = 1, ord2 = 2, ord3 = 3;
    { float r0 = -F[0 * SEQ + SEQ - 1], r1 = -F[1 * SEQ + SEQ - 1], r2 = -F[2 * SEQ + SEQ - 1], r3 = -F[3 * SEQ + SEQ - 1];
#define CSWAP(ra, rb, oa, ob) if (rb < ra) { const float tf = ra; ra = rb; rb = tf; const int ti = oa; oa = ob; ob = ti; }
      CSWAP(r0, r1, ord0, ord1) CSWAP(r2, r3, ord2, ord3) CSWAP(r0, r2, ord0, ord2) CSWAP(r1, r3, ord1, ord3) CSWAP(r1, r2, ord1, ord2)
#undef CSWAP
    }
    float* qkbs = (float*)(lds + fox::OFF_MISC) + 8;
    __syncthreads();
    if (tid < 8) { const float* NB = (const float*)(a.ws + WS_NRMB); float m = 0.f; for (int b = 0; b < (int)gridDim.x; ++b) m = fmaxf(m, NB[b * 8 + tid]); qkbs[8 + tid] = m; }
    __syncthreads();
    if (tid < 4) qkbs[tid] = sqrtf(qkbs[8 + tid] * qkbs[12 + tid]) * fox::SCALE;
    __syncthreads();
    for (int round = 0;; ++round) {
        __syncthreads();
        if (tid == 0) misc[0] = (round == 0) ? (int)blockIdx.x : (int)(gridDim.x + atomicAdd(QH, 1u));
        __syncthreads();
        const int it = misc[0];
        if (it >= 256) break;
        const int hsel = it >> 6, h = hsel == 0 ? ord0 : (hsel == 1 ? ord1 : (hsel == 2 ? ord2 : ord3)), qb = 63 - (it & 63), P0 = qb * 256;
        if (wave == 0) {
            const float* Fh = F + (size_t)h * SEQ;
            const float qkb = qkbs[h], lim = Fh[P0] + 2.f * qkb + 32.f;
            const int jd = P0 / 64, stride = jd / 64 + 1;
            int j = lane * stride; bool ok = (j > jd) ? true : (Fh[64 * j + 63] <= lim);
            unsigned long long mk = __ballot(ok); const int first = mk ? __builtin_ctzll(mk) : 64;
            const int lo_ex = first == 0 ? -1 : (first - 1) * stride; int hi_in = (first < 64 && first * stride <= jd) ? first * stride : jd;
            j = lo_ex + 1 + lane; ok = (j < hi_in) ? (Fh[64 * j + 63] <= lim) : false;
            mk = __ballot(ok); const int jlo = mk ? lo_ex + 1 + __builtin_ctzll(mk) : hi_in;
            if (lane == 0) misc[1] = jlo;
        }
        __syncthreads();
        fox::fox_block(a, lds, h, P0, misc[1]);
    }
}
DI void ph4(const Args& a, float* lds) {
    scanA(a);
    ph4_fox(a, (char*)lds);
}

DI void ph5(const Args& a) {
    const int lane = threadIdx.x & 63, wave = threadIdx.x >> 6, NW = gridDim.x * NWAVES;
    const float* ORAW = (const float*)(a.ws + WS_ORAW); const bf16_t* P = (const bf16_t*)(a.ws + WS_PROJ); bf16_t* OA = (bf16_t*)(a.ws + WS_OA);
    const float g0 = a.in[I_GON][lane], g1 = a.in[I_GON][lane + 64];
    for (int id = blockIdx.x * NWAVES + wave; id < SEQ * 4; id += NW) { const int t = id >> 2, h = id & 3;
        const float o0 = ORAW[(size_t)t * 512 + h * 128 + lane], o1 = ORAW[(size_t)t * 512 + h * 128 + 64 + lane];
        const float rstd = rsqrtf(wave_sum(o0 * o0 + o1 * o1) * (1.f / 128.f) + 1e-6f);
        const float z0 = bf2f(P[(size_t)t * NPJ + PJ_DZ + h * 128 + lane]), z1 = bf2f(P[(size_t)t * NPJ + PJ_DZ + h * 128 + 64 + lane]);
        OA[(size_t)t * 512 + h * 128 + lane] = f2bf(o0 * rstd * g0 * siluf(z0)); OA[(size_t)t * 512 + h * 128 + 64 + lane] = f2bf(o1 * rstd * g1 * siluf(z1)); }
}

DI void ph6(const Args& a, unsigned char* ldsb) {
    const bf16_t* P = (const bf16_t*)(a.ws + WS_PROJ);
    pg8::OrderDense S; S.init(SEQ / 256, DM / 256, (int)gridDim.x, (int)blockIdx.x);
    { pg8::Gemm g{(const bf16_t*)(a.ws + WS_OA), (const bf16_t*)(a.ws + WS_WOAT), SEQ, DM, 512};
      pg8::EpiMerge<0> E{P + PJ_GA, (float*)(a.ws + WS_X1), (bf16_t*)(a.ws + WS_MRG)};
      pg8::gemm_phase<pg8::EpiMerge<0>, pg8::OrderDense>((LAS unsigned char*)ldsb, g, S, E); }
    __syncthreads();
    { pg8::Gemm g{(const bf16_t*)(a.ws + WS_OB), (const bf16_t*)(a.ws + WS_WOBT), SEQ, DM, 512};
      pg8::EpiMerge<1> E{P + PJ_GB, (float*)(a.ws + WS_X1), (bf16_t*)(a.ws + WS_MRG)};
      pg8::gemm_phase<pg8::EpiMerge<1>, pg8::OrderDense>((LAS unsigned char*)ldsb, g, S, E); }
}

DI void ph7(const Args& a, unsigned char* ldsb) {
    pg8::Gemm g{(const bf16_t*)(a.ws + WS_MRG), (const bf16_t*)(a.ws + WS_WOUTT), SEQ, DM, DM};
    pg8::OrderDense S; S.init(SEQ / 256, DM / 256, (int)gridDim.x, (int)blockIdx.x);
    pg8::EpiResid E{a.in[I_X], (const float*)(a.ws + WS_MOD) + 2048, (float*)(a.ws + WS_X1)};
    pg8::gemm_phase<pg8::EpiResid, pg8::OrderDense>((LAS unsigned char*)ldsb, g, S, E);
}

DI void ph8(const Args& a, float* lds) {
    const int tid = threadIdx.x, lane = tid & 63, wave = tid >> 6, G = gridDim.x;
    constexpr int HP = 1028;
    float* A2 = lds; float* B2 = lds + 1024; float* hs = lds + 2048; float* lgs = hs + 16 * HP;
    const float* mod = (const float*)(a.ws + WS_MOD);
    for (int k = tid; k < DM; k += NTHREADS) { A2[k] = a.in[I_G2][k] * (1.f + mod[4096 + k]); B2[k] = mod[3072 + k]; }
    const float* X1 = (const float*)(a.ws + WS_X1); bf16_t* H2 = (bf16_t*)(a.ws + WS_H2);
    int* TOKE = (int*)(a.ws + WS_TOKE); int* TOKS = (int*)(a.ws + WS_TOKS); float* TOKG = (float*)(a.ws + WS_TOKG); unsigned* CNT = (unsigned*)(a.ws + WS_CNT);
    const float* wr = a.in[I_WR];
    float* part = lgs + 512; int* lcnt = (int*)(part + 8 * 16 * 32);
    float wb0[32], wb1[32];
#pragma unroll
    for (int s = 0; s < 32; ++s) { const size_t k = (size_t)(128 * wave + 4 * s + (lane >> 4)); wb0[s] = wr[k * NE + (lane & 15)]; wb1[s] = wr[k * NE + 16 + (lane & 15)]; }
    for (int tile = blockIdx.x; tile < SEQ / 16; tile += G) {
        __syncthreads();
#pragma unroll 1
        for (int q = 0; q < 2; ++q) { const int tt = wave * 2 + q, t = tile * 16 + tt; const float* xr = X1 + (size_t)t * DM;
            f32x4 v[4]; float ss = 0.f;
#pragma unroll
            for (int i = 0; i < 4; ++i) { v[i] = *(const f32x4*)(xr + lane * 4 + 256 * i); ss += v[i][0] * v[i][0] + v[i][1] * v[i][1] + v[i][2] * v[i][2] + v[i][3] * v[i][3]; }
            ss = wave_sum(ss);
            const float rstd = rsqrtf(ss * (1.f / DM) + 1e-6f);
#pragma unroll
            for (int i = 0; i < 4; ++i) { const int k = lane * 4 + 256 * i;
#pragma unroll
                for (int e = 0; e < 4; ++e) v[i][e] = v[i][e] * rstd * A2[k + e] + B2[k + e];
                *(f32x4*)(hs + tt * HP + k) = v[i];
                u32x2 w; w.x = cvt_pk(v[i][0], v[i][1]); w.y = cvt_pk(v[i][2], v[i][3]);
                *(u32x2*)(H2 + (size_t)t * DM + k) = w; } }
        __syncthreads();
        {
            if (tid < 32) lcnt[tid] = 0;
            f32x4 c0 = (f32x4){0.f, 0.f, 0.f, 0.f}, c1 = c0; const float* ha = hs + (lane & 15) * HP + 128 * wave + (lane >> 4);
#pragma unroll
            for (int s = 0; s < 32; ++s) { const float av = ha[4 * s];
                c0 = __builtin_amdgcn_mfma_f32_16x16x4f32(av, wb0[s], c0, 0, 0, 0); c1 = __builtin_amdgcn_mfma_f32_16x16x4f32(av, wb1[s], c1, 0, 0, 0); }
#pragma unroll
            for (int r = 0; r < 4; ++r) { part[(wave * 16 + 4 * (lane >> 4) + r) * 32 + (lane & 15)] = c0[r]; part[(wave * 16 + 4 * (lane >> 4) + r) * 32 + 16 + (lane & 15)] = c1[r]; }
            __syncthreads();
            const int tt = tid >> 5, e = tid & 31; float acc = a.in[I_BR][e];
#pragma unroll
            for (int w = 0; w < 8; ++w) acc += part[(w * 16 + tt) * 32 + e];
            lgs[tt * 32 + e] = acc; }
        __syncthreads();
        { const int e = lane & 31, tt = wave * 2 + (lane >> 5), t = tile * 16 + tt;
            float cur = lgs[tt * 32 + e];
#define TOP1(TV, TI) float TV = cur; int TI = e; for (int o_ = 1; o_ <= 16; o_ <<= 1) { const float ov = __shfl_xor(TV, o_); const int oi = __shfl_xor(TI, o_); if (ov > TV || (ov == TV && oi < TI)) { TV = ov; TI = oi; } } if (e == TI) cur = -__builtin_inff();
            TOP1(tv0, ti0) TOP1(tv1, ti1) TOP1(tv2, ti2) TOP1(tv3, ti3)
#undef TOP1
            const float ex0 = 1.f, ex1 = expf(tv1 - tv0), ex2 = expf(tv2 - tv0), ex3 = expf(tv3 - tv0), den = ex0 + ex1 + ex2 + ex3;
            if (e < 4) { int ee = ti0; float gg = ex0;
                if (e == 1) { ee = ti1; gg = ex1; } if (e == 2) { ee = ti2; gg = ex2; } if (e == 3) { ee = ti3; gg = ex3; }
                const int rank = atomicAdd(lcnt + ee, 1);
                TOKE[t * 4 + e] = ee; TOKS[t * 4 + e] = rank; TOKG[t * 4 + e] = gg / den; } }
        __syncthreads();
        if (tid < 32) ((int*)(a.ws + WS_TCNT))[tile * 32 + tid] = lcnt[tid];
    }
}

DI void pad_starts(const Args& a, int* ps) {
    if (threadIdx.x == 0) { const unsigned* CNT = (const unsigned*)(a.ws + WS_CNT); int s = 0; for (int e = 0; e < NE; ++e) { ps[e] = s; s += (int)((CNT[e] + 255u) / 256u) * 256; } ps[NE] = s; }
    __syncthreads();
}
DI void ph9(const Args& a, float* lds) {
    const int tid = threadIdx.x, lane = tid & 63, wave = tid >> 6, G = gridDim.x;
    int* tab = (int*)lds; int* segs = tab + 32768; int* segoff = segs + 512; int* ps = segoff + 512; int* basel = ps + 64;
    const int* TCNT = (const int*)(a.ws + WS_TCNT);
    for (int i = tid; i < 8192; i += NTHREADS) ((u32x4*)tab)[i] = ((const u32x4*)TCNT)[i];
    __syncthreads();
    { const int e = tid & 31, sg = tid >> 5; int s = 0;
#pragma unroll 8
        for (int q = 0; q < 64; ++q) s += tab[(sg * 64 + q) * 32 + e];
        segs[sg * 32 + e] = s; }
    __syncthreads();
    if (tid < 32) { int run = 0; for (int sg = 0; sg < 16; ++sg) { segoff[sg * 32 + tid] = run; run += segs[sg * 32 + tid]; }
        segs[tid] = run;
        if (blockIdx.x == 0) ((unsigned*)(a.ws + WS_CNT))[tid] = (unsigned)run; }
    __syncthreads();
    if (tid == 0) { int s = 0; for (int e = 0; e < NE; ++e) { ps[e] = s; s += ((segs[e] + 255) / 256) * 256; } ps[NE] = s; }
    __syncthreads();
    const int* TOKE = (const int*)(a.ws + WS_TOKE); int* TOKS = (int*)(a.ws + WS_TOKS);
    const bf16_t* H2 = (const bf16_t*)(a.ws + WS_H2); bf16_t* XG = (bf16_t*)(a.ws + WS_XG);
    for (int tile = blockIdx.x; tile < SEQ / 16; tile += G) {
        __syncthreads();
        if (tid < 32) { int b = segoff[(tile >> 6) * 32 + tid]; for (int q = (tile >> 6) * 64; q < tile; ++q) b += tab[q * 32 + tid]; basel[tid] = ps[tid] + b; }
        __syncthreads();
#pragma unroll 1
        for (int q = 0; q < 8; ++q) { const int id = tile * 64 + wave * 8 + q, t = id >> 2;
            const size_t row = (size_t)(basel[TOKE[id]] + TOKS[id]);
            const u32x4 v0 = *(const u32x4*)(H2 + (size_t)t * DM + lane * 8), v1 = *(const u32x4*)(H2 + (size_t)t * DM + 512 + lane * 8);
            *(u32x4*)(XG + row * DM + lane * 8) = v0; *(u32x4*)(XG + row * DM + 512 + lane * 8) = v1;
            if (lane == 0) TOKS[id] = (int)row; }
    }
}
DI int expert_of(const int* ps, int row0) { int e = 0; for (int i = 1; i < NE; ++i) if (row0 >= ps[i]) e = i; return e; }
DI void ph10(const Args& a, unsigned char* ldsb) {
    int* ps = (int*)(ldsb + 131072); pad_starts(a, ps);
    pg8::Gemm g{(const bf16_t*)(a.ws + WS_XG), (const bf16_t*)(a.ws + WS_WGUT), 0, 2048, DM};
    pg8::OrderGrouped S; S.init(ps[NE] / 256, 8, (int)gridDim.x, (int)blockIdx.x); S.ps = (const LAS int*)ps;
    pg8::EpiSwiglu E{(bf16_t*)(a.ws + WS_ACT), a.in[I_BGU]};
    pg8::gemm_phase<pg8::EpiSwiglu, pg8::OrderGrouped>((LAS unsigned char*)ldsb, g, S, E);
}
DI void ph11(const Args& a, unsigned char* ldsb) {
    int* ps = (int*)(ldsb + 131072); pad_starts(a, ps);
    pg8::Gemm g{(const bf16_t*)(a.ws + WS_ACT), (const bf16_t*)(a.ws + WS_WDT), 0, DM, DM};
    pg8::OrderGrouped S; S.init(ps[NE] / 256, 4, (int)gridDim.x, (int)blockIdx.x); S.ps = (const LAS int*)ps;
    pg8::EpiStoreBf16 E{(bf16_t*)(a.ws + WS_YB), DM, a.in[I_BD], DM};
    pg8::gemm_phase<pg8::EpiStoreBf16, pg8::OrderGrouped>((LAS unsigned char*)ldsb, g, S, E);
}
DI void ph12(const Args& a, float* lds) {
    int* ps = (int*)lds; pad_starts(a, ps);
    const int lane = threadIdx.x & 63, wave = threadIdx.x >> 6, G = gridDim.x;
    const float* X1 = (const float*)(a.ws + WS_X1); const bf16_t* YB = (const bf16_t*)(a.ws + WS_YB); const float* mod = (const float*)(a.ws + WS_MOD);
    const int* TOKE = (const int*)(a.ws + WS_TOKE); const int* TOKS = (const int*)(a.ws + WS_TOKS); const float* TOKG = (const float*)(a.ws + WS_TOKG);
    for (int t = blockIdx.x * NWAVES + wave; t < SEQ; t += G * NWAVES) {
        size_t rows[4]; float gk[4];
#pragma unroll
        for (int q = 0; q < 4; ++q) { rows[q] = (size_t)TOKS[t * 4 + q]; gk[q] = TOKG[t * 4 + q]; }
        f32x4 v[4]; float ss = 0.f;
#pragma unroll
        for (int i = 0; i < 4; ++i) { const int k = lane * 4 + 256 * i; v[i] = *(const f32x4*)(X1 + (size_t)t * DM + k);
            f32x4 y = (f32x4){0.f, 0.f, 0.f, 0.f};
#pragma unroll
            for (int q = 0; q < 4; ++q) { const u32x2 w = *(const u32x2*)(YB + rows[q] * DM + k);
                y[0] += gk[q] * __uint_as_float(w.x << 16); y[1] += gk[q] * __uint_as_float(w.x & 0xffff0000u); y[2] += gk[q] * __uint_as_float(w.y << 16); y[3] += gk[q] * __uint_as_float(w.y & 0xffff0000u); }
#pragma unroll
            for (int q = 0; q < 4; ++q) { v[i][q] += mod[5120 + k + q] * y[q]; ss += v[i][q] * v[i][q]; } }
        ss = wave_sum(ss);
        const float rstd = rsqrtf(ss * (1.f / DM) + 1e-6f);
#pragma unroll
        for (int i = 0; i < 4; ++i) { const int k = lane * 4 + 256 * i; f32x4 o;
#pragma unroll
            for (int q = 0; q < 4; ++q) o[q] = v[i][q] * rstd * a.in[I_GF][k + q];
            *(f32x4*)(a.out + (size_t)t * DM + k) = o; }
    }
}

__global__ void __launch_bounds__(NTHREADS, 2) hybrid_fwd(Args a) {
    extern __shared__ __attribute__((aligned(16))) unsigned char lds_raw[];
    float* lds = (float*)(lds_raw + 16);
    LAS unsigned* xbw = (LAS unsigned*)lds_raw;
    if (threadIdx.x == 0) { xbw[0] = 0u; xbw[1] = 0u; xbw[2] = 0u; xbw[3] = 0u; }
    __syncthreads();
    XcdBarrier bar; bar.bar = (unsigned*)(a.ws + WS_BAR); bar.x = 0; bar.st = (volatile LAS unsigned*)xbw;
    const int lo = a.ph_lo, hi = a.ph_hi;
    if (hi - lo > 1) bar = xcd_barrier_post((unsigned*)(a.ws + WS_BAR), (volatile LAS unsigned*)xbw);
#define IN(k) (lo <= (k) && (k) < hi)
#define SEAM(k) do { if (IN(k) && IN((k) + 1)) xcd_barrier(bar); } while (0)
    if (IN(0)) ph0(a, lds);
    SEAM(0);
    if (IN(1)) ph1(a, lds);
    SEAM(1);
    if (IN(2)) ph2(a, lds_raw + 16);
    SEAM(2);
    if (IN(3)) ph3(a, lds);
    SEAM(3);
    if (IN(4)) ph4(a, lds);
    SEAM(4);
    if (IN(5)) scanB(a);
    SEAM(5);
    if (IN(6)) scanC(a);
    SEAM(6);
    if (IN(7)) ph5(a);
    SEAM(7);
    if (IN(8)) ph6(a, lds_raw + 16);
    SEAM(8);
    if (IN(9)) ph7(a, lds_raw + 16);
    SEAM(9);
    if (IN(10)) ph8(a, lds);
    SEAM(10);
    if (IN(11)) ph9(a, lds);
    SEAM(11);
    if (IN(12)) ph10(a, lds_raw + 16);
    SEAM(12);
    if (IN(13)) ph11(a, lds_raw + 16);
    SEAM(13);
    if (IN(14)) ph12(a, lds);
#undef IN
#undef SEAM
}

extern "C" void kernel_launch(void* const* d_in, const int* in_sizes, int n_in, void* d_out, int out_size, void* d_ws, size_t ws_size, hipStream_t stream) {
    static int grid = 0;
    if (grid == 0) {
        if (n_in != 22 || out_size != SEQ * DM || ws_size < WS_END) { fprintf(stderr, "kernel_launch: unexpected shapes (n_in %d out %d ws %zu, need %zu)\n", n_in, out_size, ws_size, (size_t)WS_END); grid = -1; return; }
        int dev = 0, cus = 0, per_cu = 0;
        if (hipGetDevice(&dev) != hipSuccess || hipDeviceGetAttribute(&cus, hipDeviceAttributeMultiprocessorCount, dev) != hipSuccess) { grid = -1; return; }
        if (hipFuncSetAttribute((const void*)hybrid_fwd, hipFuncAttributeMaxDynamicSharedMemorySize, LDS_BYTES) != hipSuccess) { fprintf(stderr, "kernel_launch: hipFuncSetAttribute failed\n"); grid = -1; return; }
        if (hipOccupancyMaxActiveBlocksPerMultiprocessor(&per_cu, (const void*)hybrid_fwd, NTHREADS, LDS_BYTES) != hipSuccess || per_cu < 1) { fprintf(stderr, "kernel_launch: occupancy query says %d\n", per_cu); }
        (void)hipGetLastError();
        grid = cus;
    }
    if (grid < 0) return;
    (void)hipMemsetAsync(d_ws, 0, CTL_ZERO, stream);
    Args a{};
    for (int i = 0; i < 22; ++i) a.in[i] = (const float*)d_in[i];
    a.out = (float*)d_out; a.ws = (unsigned char*)d_ws;
#if N_LAUNCHES == 1
    a.ph_lo = 0; a.ph_hi = NPHASES;
    hipLaunchKernelGGL(hybrid_fwd, dim3(grid), dim3(NTHREADS), LDS_BYTES, stream, a);
#else
    for (int p = 0; p < NPHASES; ++p) { a.ph_lo = p; a.ph_hi = p + 1; hipLaunchKernelGGL(hybrid_fwd, dim3(grid), dim3(NTHREADS), LDS_BYTES, stream, a); }
#endif
}
```

```cpp
#include <hip/hip_runtime.h>
#include <stdint.h>
#include <stdio.h>

#ifndef N_LAUNCHES
#define N_LAUNCHES 1
#endif

#define DI __device__ __forceinline__
#define LAS __attribute__((address_space(3)))
typedef unsigned short bf16_t;
typedef short bf16x8 __attribute__((ext_vector_type(8)));
typedef float f32x4 __attribute__((ext_vector_type(4)));
typedef unsigned u32x4 __attribute__((ext_vector_type(4)));
typedef unsigned u32x2 __attribute__((ext_vector_type(2)));

constexpr int SEQ = 16384, DM = 1024, NIN = 5644, NPJ = 5632, NE = 32, TOPK = 4;
constexpr int NH = 4, HD = 128, CH = 64, NCH = SEQ / CH;
constexpr int PJ_DQ = 0, PJ_DK = 512, PJ_DV = 1024, PJ_DZ = 1536, PJ_FQ = 2048, PJ_FK = 2560, PJ_FV = 3072, PJ_GA = 3584, PJ_GB = 4608;
constexpr int NTHREADS = 512, NWAVES = 8;
constexpr int LDS_BYTES = 152 * 1024;
constexpr int NPHASES = 14;

constexpr size_t MiB = 1u << 20;
constexpr size_t WS_BAR = 0;
constexpr size_t WS_CNT = 32768;
constexpr size_t WS_NRM = 32768 + 256;
constexpr size_t WS_QH = 32768 + 512;
constexpr size_t CTL_ZERO = 65536;
constexpr size_t WS_MOD = 65536;
constexpr size_t WS_F = WS_MOD + 32768;
constexpr size_t WS_EG = WS_F + 262144;
constexpr size_t WS_TOKE = WS_EG + 4096;
constexpr size_t WS_TOKS = WS_TOKE + 262144;
constexpr size_t WS_TOKG = WS_TOKS + 262144;
constexpr size_t WS_SP = WS_TOKG + 262144;
constexpr size_t WS_WINT = WS_SP + MiB;
constexpr size_t WS_WOAT = WS_WINT + (size_t)NPJ * DM * 2;
constexpr size_t WS_WOBT = WS_WOAT + MiB;
constexpr size_t WS_WOUTT = WS_WOBT + MiB;
constexpr size_t WS_WGUT = WS_WOUTT + 2 * MiB;
constexpr size_t WS_WDT = WS_WGUT + 128 * MiB;
constexpr size_t WS_X1 = WS_WDT + 64 * MiB;
constexpr size_t WS_H2 = WS_X1 + 64 * MiB;
constexpr size_t WS_MRG = WS_H2 + 32 * MiB;
constexpr size_t WS_RA = WS_MRG + 32 * MiB;
constexpr size_t WS_RB = WS_RA + 176 * MiB;
constexpr size_t WS_H = WS_RB;
constexpr size_t WS_DNW = WS_H + 32 * MiB;
constexpr size_t WS_DNU = WS_DNW + 16 * MiB;
constexpr size_t WS_DNQD = WS_DNU + 16 * MiB;
constexpr size_t WS_DNKD = WS_DNQD + 16 * MiB;
constexpr size_t WS_DNATT = WS_DNKD + 16 * MiB;
constexpr size_t WS_ORAW = WS_DNATT + 8 * MiB;
constexpr size_t WS_OA = WS_ORAW + 32 * MiB;
constexpr size_t WS_OB = WS_OA + 16 * MiB;
constexpr size_t WS_VT = WS_OB + 16 * MiB;
constexpr size_t WS_PG = WS_VT;
constexpr size_t WS_QG = WS_PG + 2 * MiB;
constexpr size_t WS_SG = WS_QG + 4 * MiB;
constexpr size_t WS_TCNT = WS_SG + 4 * MiB;
constexpr size_t WS_NRMT = WS_TCNT + 131072;
constexpr size_t WS_END = WS_RB + 184 * MiB;
constexpr size_t WS_XG = WS_RA, WS_YB = WS_RA, WS_ACT = WS_RB, WS_PROJ = WS_RA;
static_assert(WS_VT + 16 * MiB <= WS_END, "region B");

struct Args { const float* in[22]; float* out; unsigned char* ws; int ph_lo, ph_hi; };
enum { I_X = 0, I_C, I_WADA, I_BADA, I_G1, I_WIN, I_CONVW, I_ALOG, I_DTB, I_GON, I_BFG, I_WOD, I_WOF, I_WOUT, I_G2, I_WR, I_BR, I_WGU, I_BGU, I_WD, I_BD, I_GF };

DI float bf2f(bf16_t v) { return __uint_as_float(((unsigned)v) << 16); }
DI bf16_t f2bf(float f) { unsigned u = __float_as_uint(f); u += 0x7fffu + ((u >> 16) & 1u); return (bf16_t)(u >> 16); }
typedef float f32x2_t __attribute__((ext_vector_type(2)));
typedef __bf16 bf16x2_t __attribute__((ext_vector_type(2)));
DI unsigned cvt_pk(float lo, float hi) { const f32x2_t v = {lo, hi}; const bf16x2_t b = __builtin_convertvector(v, bf16x2_t); return __builtin_bit_cast(unsigned, b); }
DI unsigned pk2(float lo, float hi) { return (unsigned)f2bf(lo) | ((unsigned)f2bf(hi) << 16); }
DI float sigm(float x) { return 1.f / (1.f + expf(-x)); }
DI float siluf(float x) { return x / (1.f + expf(-x)); }
DI float softplusf(float x) { return fmaxf(x, 0.f) + log1pf(expf(-fabsf(x))); }
DI float logsigf(float x) { return fminf(x, 0.f) - log1pf(expf(-fabsf(x))); }
DI float wave_sum(float v) { for (int o = 32; o >= 1; o >>= 1) v += __shfl_xor(v, o); return v; }
#define MFMA16(a, b, c) __builtin_amdgcn_mfma_f32_16x16x32_bf16((a), (b), (c), 0, 0, 0)

DI int gu_src(int n) { const int g = n >> 8, r = n & 255; return r < 128 ? 128 * g + r : 1024 + 128 * g + (r - 128); }

#define XB_TMO      128
#define XB_XCNT(j)  (256  + 64 * (j))
#define XB_XSUB(j)  (1280 + 64 * (j))
#define XB_XGEN(j)  (2304 + 64 * (j))
#define XB_TOP      3328
#define XB_TOPGEN   3392
#define XCD_BAR_WORDS 3456
#define XB_SPIN_CAP (1u << 22)
DI unsigned xb_ld(unsigned* p)              { return __hip_atomic_load(p, __ATOMIC_RELAXED, __HIP_MEMORY_SCOPE_AGENT); }
DI unsigned xb_add(unsigned* p, unsigned v) { return __hip_atomic_fetch_add(p, v, __ATOMIC_RELAXED, __HIP_MEMORY_SCOPE_AGENT); }
DI unsigned xb_xcc_id() { return (unsigned)__builtin_amdgcn_s_getreg((3 << 11) | 20) & 0xFu; }
#define XB_SPIN(cond, bar) do { unsigned _sp = 0; while (cond) { __builtin_amdgcn_s_sleep(1); \
    if ((++_sp & 255u) == 0u) { if (xb_ld(&(bar)[XB_TMO])) break; if (_sp > XB_SPIN_CAP) { atomicAdd(&(bar)[XB_TMO], 1u); break; } } } } while (0)
struct XcdBarrier { unsigned* bar; unsigned x; volatile LAS unsigned* st; };
DI XcdBarrier xcd_barrier_post(unsigned* bar, volatile LAS unsigned* st) {
    XcdBarrier b; b.bar = bar; b.x = xb_xcc_id(); b.st = st;
    if (threadIdx.x == 0) (void)xb_add(&bar[XB_XCNT(b.x)], 1u);
    return b;
}
DI void xcd_barrier_complete(unsigned* bar, unsigned x, unsigned& nloc, unsigned& nx) {
    const unsigned G = gridDim.x * gridDim.y * gridDim.z;
    unsigned sum, cnt, mine, sp = 0u;
    for (;;) {
        sum = 0u; cnt = 0u; mine = 0u;
#pragma unroll
        for (unsigned j = 0; j < 16; ++j) { const unsigned c = xb_ld(&bar[XB_XCNT(j)]); sum += c; cnt += (c > 0u) ? 1u : 0u; mine = (j == x) ? c : mine; }
        if (sum == G) break;
        __builtin_amdgcn_s_sleep(1);
        if ((++sp & 255u) == 0u) { if (xb_ld(&bar[XB_TMO])) break; if (sp > XB_SPIN_CAP) { atomicAdd(&bar[XB_TMO], 1u); break; } }
    }
    nloc = mine > 0u ? mine : 1u; nx = cnt > 0u ? cnt : 1u;
}
DI void xcd_barrier(const XcdBarrier& b) {
    asm volatile("s_waitcnt vmcnt(0)" ::: "memory");
    __syncthreads();
    if (threadIdx.x == 0) {
        unsigned* bar = b.bar;
        __builtin_amdgcn_s_waitcnt(0);
        unsigned nloc = b.st[0], nx = b.st[1];
        if (nloc == 0u) { xcd_barrier_complete(bar, b.x, nloc, nx); b.st[0] = nloc; b.st[1] = nx; }
        const unsigned old = xb_add(&bar[XB_XSUB(b.x)], 1u);
        const unsigned gen = old / nloc;
        if (old + 1u == (gen + 1u) * nloc) {
            __builtin_amdgcn_fence(__ATOMIC_RELEASE, "agent");
            asm volatile("s_waitcnt vmcnt(0)" ::: "memory");
            const unsigned og = xb_add(&bar[XB_TOP], 1u);
            const unsigned tg = og / nx;
            if (og + 1u == (tg + 1u) * nx) xb_add(&bar[XB_TOPGEN], 1u);
            else XB_SPIN(xb_ld(&bar[XB_TOPGEN]) == tg, bar);
            __builtin_amdgcn_fence(__ATOMIC_ACQUIRE, "agent");
            xb_add(&bar[XB_XGEN(b.x)], 1u);
            asm volatile("s_waitcnt vmcnt(0)" ::: "memory");
        } else {
            XB_SPIN(xb_ld(&bar[XB_XGEN(b.x)]) == gen, bar);
            __builtin_amdgcn_fence(__ATOMIC_ACQUIRE, "agent");
            asm volatile("s_waitcnt vmcnt(0)" ::: "memory");
        }
    }
    __syncthreads();
}

template <int NT>
DI void wave_gemm(const bf16_t* const (&ap)[4], const bf16_t* const (&bp)[NT], int K, f32x4 (&acc)[4][NT]) {
    for (int k0 = 0; k0 < K; k0 += 32) {
        bf16x8 a[4], b[NT];
#pragma unroll
        for (int i = 0; i < 4; ++i) a[i] = *(const bf16x8*)(ap[i] + k0);
#pragma unroll
        for (int j = 0; j < NT; ++j) b[j] = *(const bf16x8*)(bp[j] + k0);
#pragma unroll
        for (int i = 0; i < 4; ++i)
#pragma unroll
            for (int j = 0; j < NT; ++j) acc[i][j] = MFMA16(a[i], b[j], acc[i][j]);
    }
}
template <int NT> DI void zero_acc(f32x4 (&acc)[4][NT]) {
#pragma unroll
    for (int i = 0; i < 4; ++i)
#pragma unroll
        for (int j = 0; j < NT; ++j) acc[i][j] = (f32x4){0.f, 0.f, 0.f, 0.f};
}


namespace pg8 {
struct Unit { int pm, pn, pb, e; };
struct Gemm { const bf16_t* A; const bf16_t* Bt; int M, N, K; };
constexpr int BM = 256, BK = 64, HALF = 128, HTB = HALF * BK * 2  , STAGE_BYTES = 8 * HTB, NXCD = 8, WGM = 8;

__host__ __device__ __forceinline__ int lds_byte(int r, int c) { const int st = (r >> 4) * 2 + (c >> 5), rr = r & 15, cc = c & 31, ob = rr * 64 + cc * 2; return st * 1024 + (ob ^ (((ob >> 9) & 1) << 5)); }
__host__ __device__ __forceinline__ void stage_rc(int b, int& R, int& C) { const int st = b / 1024, sb = b % 1024, swz = sb ^ (((sb >> 9) & 1) << 5); R = (st >> 1) * 16 + swz / 64; C = (st & 1) * 32 + (swz % 64) / 2; }
__host__ __device__ __forceinline__ int perm32(int rho) { const int n = rho >> 4, i = rho & 15; return 8 * (i >> 2) + 4 * n + (i & 3); }
template <class Epi, class Sched>
__device__ __forceinline__ void gemm_phase(LAS unsigned char* lds, const Gemm g, const Sched& S, const Epi& E) {
    const int tid = threadIdx.x, wid = __builtin_amdgcn_readfirstlane(tid >> 6), lane = tid & 63, wr = wid >> 2, wc = wid & 3, fr = lane & 15, fq = lane >> 4;
    const int K = g.K, nt = K / BK;
    unsigned voffA[2], voffB[2];
#pragma unroll
    for (int i = 0; i < 2; ++i) { int R, C; stage_rc(tid * 16 + i * 8192, R, C); const int Rb = Epi::PERM ? ((R & ~31) + perm32(R & 31)) : R;
        voffA[i] = (unsigned)(R * K + C) * 2u; voffB[i] = (unsigned)(Rb * K + C) * 2u; }
    const size_t kstep = (size_t)(BK * 2);
    const size_t hstep = (size_t)HALF * K * 2;
    const size_t tstep = 2 * hstep;
    const unsigned ldsw = (unsigned)wid * 1024u;
    const int aoff = lds_byte(wr * 64 + fr, fq * 8), boff = lds_byte(wc * 32 + fr, fq * 8);
#define PG8_SA(b, h) (((b) * 2 + (h)) * HTB)
#define PG8_SB(b, h) ((4 + (b) * 2 + (h)) * HTB)
#define PG8_STAGE(bufoff, gbase, voff) do { _Pragma("unroll") for (int _i = 0; _i < 2; ++_i) \
        __builtin_amdgcn_global_load_lds((const unsigned*)((const char*)(gbase) + (voff)[_i]), (LAS unsigned*)(lds + (bufoff) + ldsw + _i * 8192), 16, 0, 0); } while (0)
#define PG8_LDA(dst, b, h) do { _Pragma("unroll") for (int m = 0; m < 4; ++m) _Pragma("unroll") for (int k = 0; k < 2; ++k) dst[m][k] = *(const LAS bf16x8*)(lds + PG8_SA(b, h) + aoff + m * 2048 + k * 1024); } while (0)
#define PG8_LDB(dst, b, h) do { _Pragma("unroll") for (int n = 0; n < 2; ++n) _Pragma("unroll") for (int k = 0; k < 2; ++k) dst[n][k] = *(const LAS bf16x8*)(lds + PG8_SB(b, h) + boff + n * 2048 + k * 1024); } while (0)
#define PG8_MMA(ai, bj, At, Bt) do { __builtin_amdgcn_s_setprio(1); _Pragma("unroll") for (int m = 0; m < 4; ++m) _Pragma("unroll") for (int n = 0; n < 2; ++n) _Pragma("unroll") for (int k = 0; k < 2; ++k) \
        acc[ai][bj][m][n] = __builtin_amdgcn_mfma_f32_16x16x32_bf16(Bt[n][k], At[m][k], acc[ai][bj][m][n], 0, 0, 0); __builtin_amdgcn_s_setprio(0); } while (0)
#define PG8_WAIT_V(n) asm volatile("s_waitcnt vmcnt(" #n ")" ::: "memory")
#define PG8_WAIT_L(n) asm volatile("s_waitcnt lgkmcnt(" #n ")" ::: "memory")
#define PG8_BAR __builtin_amdgcn_s_barrier()
#define PG8_SCHED __builtin_amdgcn_sched_barrier(0)
    Unit cur, nxt; int ui = 0;
    if (!S.next(0, cur)) return;
    f32x4 acc[2][2][4][2];
#pragma unroll
    for (int a = 0; a < 2; ++a)
#pragma unroll
        for (int b = 0; b < 2; ++b)
#pragma unroll
            for (int m = 0; m < 4; ++m)
#pragma unroll
                for (int n = 0; n < 2; ++n) acc[a][b][m][n] = (f32x4){0.f, 0.f, 0.f, 0.f};
    bf16x8 At[4][2], B0[2][2], B1[2][2];
    const char* cA = (const char*)g.A + (size_t)cur.pm * tstep; const char* cB = (const char*)g.Bt + (size_t)cur.pb * tstep;
    S.a_ready(cur);
    PG8_STAGE(PG8_SB(0, 0), cB, voffB); PG8_STAGE(PG8_SA(0, 0), cA, voffA); PG8_STAGE(PG8_SB(0, 1), cB + hstep, voffB); PG8_STAGE(PG8_SA(0, 1), cA + hstep, voffA);
    if (wr == 1) PG8_BAR;
    PG8_WAIT_V(4); PG8_BAR;
    PG8_STAGE(PG8_SB(1, 0), cB + kstep, voffB); PG8_STAGE(PG8_SA(1, 0), cA + kstep, voffA); PG8_STAGE(PG8_SB(1, 1), cB + hstep + kstep, voffB);
    PG8_WAIT_V(6); PG8_BAR;
    for (;;) {
        const bool has_next = S.next(ui + 1, nxt);
        const char* nA = has_next ? (const char*)g.A + (size_t)nxt.pm * tstep : cA; const char* nB = has_next ? (const char*)g.Bt + (size_t)nxt.pb * tstep : cB;
        for (int t = 0; t < nt; t += 2) {
            const bool last = (t == nt - 2);
            const char* a1 = cA + (size_t)(t + 1) * kstep;
            const char* a2 = last ? nA : cA + (size_t)(t + 2) * kstep; const char* b2 = last ? nB : cB + (size_t)(t + 2) * kstep;
            const char* a3 = a2 + kstep; const char* b3 = b2 + kstep;
            if (last && has_next) S.a_ready(nxt);
            PG8_LDB(B0, 0, 0); PG8_SCHED; PG8_LDA(At, 0, 0); PG8_STAGE(PG8_SA(1, 1), a1 + hstep, voffA);
            PG8_WAIT_L(8); PG8_BAR; PG8_WAIT_L(0); PG8_MMA(0, 0, At, B0); PG8_BAR; PG8_SCHED;
            PG8_LDB(B1, 0, 1); PG8_STAGE(PG8_SB(0, 0), b2, voffB);
            PG8_BAR; PG8_WAIT_L(0); PG8_MMA(0, 1, At, B1); PG8_BAR;
            PG8_LDA(At, 0, 1); PG8_STAGE(PG8_SA(0, 0), a2, voffA);
            PG8_BAR; PG8_WAIT_L(0); PG8_MMA(1, 0, At, B0); PG8_BAR; PG8_SCHED;
            PG8_STAGE(PG8_SB(0, 1), b2 + hstep, voffB);
            PG8_WAIT_V(6); PG8_BAR; PG8_MMA(1, 1, At, B1); PG8_BAR;
            PG8_LDB(B0, 1, 0); PG8_SCHED; PG8_LDA(At, 1, 0); PG8_STAGE(PG8_SA(0, 1), a2 + hstep, voffA);
            PG8_WAIT_L(8); PG8_BAR; PG8_WAIT_L(0); PG8_MMA(0, 0, At, B0); PG8_BAR; PG8_SCHED;
            PG8_LDB(B1, 1, 1); PG8_STAGE(PG8_SB(1, 0), b3, voffB);
            PG8_BAR; PG8_WAIT_L(0); PG8_MMA(0, 1, At, B1); PG8_BAR;
            PG8_LDA(At, 1, 1); PG8_STAGE(PG8_SA(1, 0), a3, voffA);
            PG8_BAR; PG8_WAIT_L(0); PG8_MMA(1, 0, At, B0); PG8_BAR; PG8_SCHED;
            PG8_STAGE(PG8_SB(1, 1), b3 + hstep, voffB);
            PG8_WAIT_V(6); PG8_BAR; PG8_MMA(1, 1, At, B1); PG8_BAR;
        }
        if constexpr (!Epi::AFTER_DRAIN) { E(acc, cur, wr, wc, fr, fq); S.done(cur); }
        if (!has_next) break;
#pragma unroll
        for (int a = 0; a < 2; ++a)
#pragma unroll
            for (int b = 0; b < 2; ++b)
#pragma unroll
                for (int m = 0; m < 4; ++m)
#pragma unroll
                    for (int n = 0; n < 2; ++n) acc[a][b][m][n] = (f32x4){0.f, 0.f, 0.f, 0.f};
        cur = nxt; cA = nA; cB = nB; ++ui;
    }
    PG8_WAIT_V(0);
    if (wr == 0) PG8_BAR;
    PG8_BAR;
    if constexpr (Epi::AFTER_DRAIN) { E.fused(acc, cur, wr, wc, fr, fq, lds, wid, lane); S.done(cur); }
#undef PG8_SA
#undef PG8_SB
#undef PG8_STAGE
#undef PG8_LDA
#undef PG8_LDB
#undef PG8_MMA
#undef PG8_WAIT_V
#undef PG8_WAIT_L
#undef PG8_BAR
#undef PG8_SCHED
}

DI unsigned cvt_pk_bf16(float lo, float hi) { return cvt_pk(lo, hi); }
DI float fsig(float x) { return __builtin_amdgcn_rcpf(1.f + __builtin_amdgcn_exp2f(-1.4426950408889634f * x)); }
DI int expert_of_l(const LAS int* ps, int row0) { int e = 0;
#pragma unroll 1
    for (int i = 1; i < NE; ++i) if (row0 >= ps[i]) e = i; return e; }
struct OrderDense {
    int nM, nN, nwg, G, c;
    DI void init(int nM_, int nN_, int G_, int c_) { nM = nM_; nN = nN_; nwg = nM * nN; G = G_; c = c_; }
    DI bool tile(int i, Unit& u) const {
        const long L = (long)i * G + c; if (L >= nwg) return false;
        int wgid = (int)L; { const int q = nwg / NXCD, r = nwg % NXCD, xcd = wgid % NXCD, off = wgid / NXCD; wgid = (xcd < r ? xcd * (q + 1) : r * (q + 1) + (xcd - r) * q) + off; }
        const int nig = WGM * nN, gid = wgid / nig, fm = gid * WGM, gsz = (nM - fm) < WGM ? (nM - fm) : WGM;
        u.pm = fm + ((wgid % nig) % gsz); u.pn = (wgid % nig) / gsz; return true;
    }
    DI bool next(int i, Unit& u) const { if (!tile(i, u)) return false; u.pb = u.pn; u.e = 0; return true; }
    DI void a_ready(const Unit&) const {}
    DI void done(const Unit&) const {}
};
struct OrderGrouped : OrderDense {
    const LAS int* ps;
    DI bool next(int i, Unit& u) const { if (!tile(i, u)) return false; u.e = expert_of_l(ps, u.pm * BM); u.pb = u.e * nN + u.pn; return true; }
};
struct EpiStoreBf16 {
    static constexpr bool PERM = true, AFTER_DRAIN = false;
    bf16_t* O; int ldc; const float* bias; int bstride;
    DI void operator()(const f32x4 (&acc)[2][2][4][2], const Unit& u, int wr, int wc, int fr, int fq) const {
        const int row0 = u.pm * BM + wr * 64 + fr, col0 = u.pn * BM + wc * 32 + 8 * fq;
        f32x4 bv[2][2];
#pragma unroll
        for (int bj = 0; bj < 2; ++bj)
#pragma unroll
            for (int n = 0; n < 2; ++n) bv[bj][n] = bias ? *(const f32x4*)(bias + (size_t)u.e * bstride + col0 + bj * HALF + 4 * n) : (f32x4){0.f, 0.f, 0.f, 0.f};
#pragma unroll
        for (int ai = 0; ai < 2; ++ai)
#pragma unroll
            for (int m = 0; m < 4; ++m) { bf16_t* rowp = O + (size_t)(row0 + ai * HALF + m * 16) * ldc + col0;
#pragma unroll
                for (int bj = 0; bj < 2; ++bj) { const f32x4 v0 = acc[ai][bj][m][0] + bv[bj][0], v1 = acc[ai][bj][m][1] + bv[bj][1];
                    u32x4 w; w.x = cvt_pk_bf16(v0[0], v0[1]); w.y = cvt_pk_bf16(v0[2], v0[3]); w.z = cvt_pk_bf16(v1[0], v1[1]); w.w = cvt_pk_bf16(v1[2], v1[3]);
                    *(u32x4*)(rowp + bj * HALF) = w; } }
    }
};
template <int SECOND> struct EpiMerge {
    static constexpr bool PERM = true, AFTER_DRAIN = false;
    const bf16_t* gate; float* T; bf16_t* O;
    DI void operator()(const f32x4 (&acc)[2][2][4][2], const Unit& u, int wr, int wc, int fr, int fq) const {
        const int row0 = u.pm * BM + wr * 64 + fr, col0 = u.pn * BM + wc * 32 + 8 * fq;
#pragma unroll
        for (int ai = 0; ai < 2; ++ai)
#pragma unroll
            for (int mp = 0; mp < 2; ++mp) {
                u32x4 g[2][2]; f32x4 t0[2][2], t1[2][2];
#pragma unroll
                for (int mm = 0; mm < 2; ++mm)
#pragma unroll
                    for (int bj = 0; bj < 2; ++bj) { const size_t row = (size_t)(row0 + ai * HALF + (2 * mp + mm) * 16); const int col = col0 + bj * HALF;
                        g[mm][bj] = *(const u32x4*)(gate + row * NPJ + col);
                        if (SECOND) { t0[mm][bj] = *(const f32x4*)(T + row * DM + col); t1[mm][bj] = *(const f32x4*)(T + row * DM + col + 4); } }
#pragma unroll
                for (int mm = 0; mm < 2; ++mm)
#pragma unroll
                    for (int bj = 0; bj < 2; ++bj) { const int m = 2 * mp + mm; const size_t row = (size_t)(row0 + ai * HALF + m * 16); const int col = col0 + bj * HALF;
                        const u32x4 gg = g[mm][bj]; f32x4 v0 = acc[ai][bj][m][0], v1 = acc[ai][bj][m][1];
                        v0[0] *= fsig(__uint_as_float(gg.x << 16)); v0[1] *= fsig(__uint_as_float(gg.x & 0xffff0000u)); v0[2] *= fsig(__uint_as_float(gg.y << 16)); v0[3] *= fsig(__uint_as_float(gg.y & 0xffff0000u));
                        v1[0] *= fsig(__uint_as_float(gg.z << 16)); v1[1] *= fsig(__uint_as_float(gg.z & 0xffff0000u)); v1[2] *= fsig(__uint_as_float(gg.w << 16)); v1[3] *= fsig(__uint_as_float(gg.w & 0xffff0000u));
                        if (SECOND == 0) { float* tp = T + row * DM + col; *(f32x4*)tp = v0; *(f32x4*)(tp + 4) = v1; }
                        else { v0 += t0[mm][bj]; v1 += t1[mm][bj];
                            u32x4 w; w.x = cvt_pk_bf16(v0[0], v0[1]); w.y = cvt_pk_bf16(v0[2], v0[3]); w.z = cvt_pk_bf16(v1[0], v1[1]); w.w = cvt_pk_bf16(v1[2], v1[3]);
                            *(u32x4*)(O + row * DM + col) = w; } }
            }
    }
};
struct EpiResid {
    static constexpr bool PERM = false, AFTER_DRAIN = false;
    const float* x; const float* gt; float* X1;
    DI void operator()(const f32x4 (&acc)[2][2][4][2], const Unit& u, int wr, int wc, int fr, int fq) const {
        const int row0 = u.pm * BM + wr * 64 + fr, col0 = u.pn * BM + wc * 32 + 4 * fq;
        f32x4 gv[2][2];
#pragma unroll
        for (int bj = 0; bj < 2; ++bj)
#pragma unroll
            for (int n = 0; n < 2; ++n) gv[bj][n] = *(const f32x4*)(gt + col0 + bj * HALF + n * 16);
#pragma unroll
        for (int ai = 0; ai < 2; ++ai)
#pragma unroll
            for (int mp = 0; mp < 2; ++mp) {
                f32x4 xv[2][2][2];
#pragma unroll
                for (int mm = 0; mm < 2; ++mm)
#pragma unroll
                    for (int bj = 0; bj < 2; ++bj)
#pragma unroll
                        for (int n = 0; n < 2; ++n) xv[mm][bj][n] = *(const f32x4*)(x + (size_t)(row0 + ai * HALF + (2 * mp + mm) * 16) * DM + col0 + bj * HALF + n * 16);
#pragma unroll
                for (int mm = 0; mm < 2; ++mm)
#pragma unroll
                    for (int bj = 0; bj < 2; ++bj)
#pragma unroll
                        for (int n = 0; n < 2; ++n) *(f32x4*)(X1 + (size_t)(row0 + ai * HALF + (2 * mp + mm) * 16) * DM + col0 + bj * HALF + n * 16) = xv[mm][bj][n] + gv[bj][n] * acc[ai][bj][2 * mp + mm][n];
            }
    }
};
struct EpiSwiglu {
    static constexpr bool PERM = true, AFTER_DRAIN = false;
    bf16_t* ACT; const float* bgu;
    DI void operator()(const f32x4 (&acc)[2][2][4][2], const Unit& u, int wr, int wc, int fr, int fq) const {
        const int row0 = u.pm * BM + wr * 64 + fr, gcol = u.pn * HALF + wc * 32 + 8 * fq;
        const float* bb = bgu + (size_t)u.e * 2048 + gcol;
        f32x4 bg[2], bu[2];
#pragma unroll
        for (int n = 0; n < 2; ++n) { bg[n] = *(const f32x4*)(bb + 4 * n); bu[n] = *(const f32x4*)(bb + 1024 + 4 * n); }
#pragma unroll
        for (int ai = 0; ai < 2; ++ai)
#pragma unroll
            for (int m = 0; m < 4; ++m) { float r[8];
#pragma unroll
                for (int n = 0; n < 2; ++n)
#pragma unroll
                    for (int j = 0; j < 4; ++j) { float g = acc[ai][0][m][n][j] + bg[n][j], up = acc[ai][1][m][n][j] + bu[n][j];
                        g = fminf(g, 7.f); up = fminf(fmaxf(up, -7.f), 7.f);
                        r[4 * n + j] = (up + 1.f) * (g * fsig(1.702f * g)); }
                u32x4 w; w.x = cvt_pk_bf16(r[0], r[1]); w.y = cvt_pk_bf16(r[2], r[3]); w.z = cvt_pk_bf16(r[4], r[5]); w.w = cvt_pk_bf16(r[6], r[7]);
                *(u32x4*)(ACT + (size_t)(row0 + ai * HALF + m * 16) * DM + gcol) = w; }
    }
};
}


namespace fox {
typedef float f32x16 __attribute__((ext_vector_type(16)));
typedef short s16x4 __attribute__((ext_vector_type(4)));
constexpr float SCALE = 0.08838834764831845f;
constexpr int KVBLK = 64, SHM_K = 16384, SHM_V = 16384;
constexpr int OFF_V = 0, OFF_K = 2 * SHM_V, OFF_G = OFF_K + 2 * SHM_K, OFF_WS = OFF_G + 512, OFF_MISC = OFF_WS + 8 * 256;
constexpr float THR = 8.f;
#define KSWZ(row, colB) ((row) * 256 + ((colB) ^ (((row) & 7) << 4)))
#define SBAR() __builtin_amdgcn_sched_barrier(0)
DI int v_st(int k, int c) { const int kk = (k & ~0xC) | ((k & 4) << 1) | ((k & 8) >> 1); return ((kk >> 3) * 4 + (c >> 5)) * 512 + ((kk & 7) * 32 + (c & 31)) * 2; }
DI int v_rd_base(int lane) { return ((lane & 3) << 3) | (((lane >> 2) & 3) << 6) | (((lane >> 4) & 1) << 5) | (((lane >> 5) & 1) << 8); }
constexpr int v_rd_off(int d0, int ks, int half) { return d0 * 512 + ks * 4096 + half * 2048; }
DI int crow(int r, int hi) { return (r & 3) + 8 * (r >> 2) + 4 * hi; }
DI unsigned cvtpk(float lo, float hi) { return cvt_pk(lo, hi); }
DI void mask_tile(f32x16& p0, f32x16& p1, int dq) {
    const float NEG = -__builtin_inff();
#pragma unroll
    for (int r = 0; r < 16; ++r) { const int c = (r & 3) + 8 * (r >> 2); if (dq - c < 0) p0[r] = NEG; if (dq - c - 32 < 0) p1[r] = NEG; }
}
DI void partialSM(f32x16& p0, f32x16& p1, float& m_reg, float& mn, float& alpha) {
    float pmax = p0[0];
#pragma unroll
    for (int r = 1; r < 16; ++r) pmax = fmaxf(pmax, p0[r]);
#pragma unroll
    for (int r = 0; r < 16; ++r) pmax = fmaxf(pmax, p1[r]);
    { auto rr = __builtin_amdgcn_permlane32_swap(__float_as_uint(pmax), __float_as_uint(pmax), false, false); pmax = fmaxf(__uint_as_float(rr[0]), __uint_as_float(rr[1])); }
    constexpr float C2 = 1.4426950408889634f * SCALE;
    if (__builtin_expect(__all((pmax - m_reg) * SCALE <= THR), 1)) { mn = m_reg; alpha = 1.f; }
    else { mn = fmaxf(m_reg, pmax); alpha = __builtin_amdgcn_exp2f((m_reg - mn) * C2); m_reg = mn; }
    const float mnL = -mn * C2;
#pragma unroll
    for (int r = 0; r < 16; ++r) p0[r] = fmaf(p0[r], C2, mnL);
#pragma unroll
    for (int r = 0; r < 16; ++r) p1[r] = fmaf(p1[r], C2, mnL);
#pragma unroll
    for (int r = 0; r < 16; ++r) p0[r] = __builtin_amdgcn_exp2f(p0[r]);
}
DI void finishSM(f32x16& p0, f32x16& p1, float alpha, float& l_reg, bf16x8& pa0, bf16x8& pa1, bf16x8& pa2, bf16x8& pa3) {
#pragma unroll
    for (int r = 0; r < 16; ++r) p1[r] = __builtin_amdgcn_exp2f(p1[r]);
    float ps = 0;
#pragma unroll
    for (int r = 0; r < 16; ++r) ps += p0[r];
#pragma unroll
    for (int r = 0; r < 16; ++r) ps += p1[r];
    { auto rr = __builtin_amdgcn_permlane32_swap(__float_as_uint(ps), __float_as_uint(ps), false, false); ps = __uint_as_float(rr[0]) + __uint_as_float(rr[1]); }
    l_reg = l_reg * alpha + ps;
#define PK4(P, B_, OUT) do { unsigned a0 = cvtpk(P[B_+0], P[B_+1]), a1 = cvtpk(P[B_+2], P[B_+3]);                          \
        unsigned b0 = cvtpk(P[B_+4], P[B_+5]), b1 = cvtpk(P[B_+6], P[B_+7]);                                             \
        auto r0 = __builtin_amdgcn_permlane32_swap(a0, b0, false, false); auto r1 = __builtin_amdgcn_permlane32_swap(a1, b1, false, false); \
        u32x4 w = {r0[0], r1[0], r0[1], r1[1]}; OUT = *reinterpret_cast<bf16x8*>(&w); } while (0)
    PK4(p0, 0, pa0); PK4(p0, 8, pa1); PK4(p1, 0, pa2); PK4(p1, 8, pa3);
#undef PK4
}
DI void qkt(f32x16& p0, f32x16& p1, const char* Kb, int r32, int hi, const bf16x8* qr) {
    p0 = f32x16{}; p1 = f32x16{};
    const char* kb[4];
#pragma unroll
    for (int dd = 0; dd < 4; ++dd) kb[dd] = Kb + KSWZ(r32, (dd * 16 + hi * 8) * 2);
#pragma unroll
    for (int d0 = 0; d0 < 8; ++d0) { const char* a = kb[d0 & 3] + (d0 >> 2) * 128;
        bf16x8 b0 = *reinterpret_cast<const bf16x8*>(a);
        bf16x8 b1 = *reinterpret_cast<const bf16x8*>(a + 32 * 256);
        p0 = __builtin_amdgcn_mfma_f32_32x32x16_bf16(b0, qr[d0], p0, 0, 0, 0);
        p1 = __builtin_amdgcn_mfma_f32_32x32x16_bf16(b1, qr[d0], p1, 0, 0, 0); }
}
DI void pv_tile(f32x16* o, int vb0, bf16x8 pa0, bf16x8 pa1, bf16x8 pa2, bf16x8 pa3) {
#define TRRD(dst, off) asm volatile("ds_read_b64_tr_b16 %0, %1 offset:%2" : "=&v"(dst) : "v"(vb0), "i"(off) : "memory")
#define PV_D0(d0) do { s16x4 l0, l1, l2, l3, h0, h1, h2, h3; constexpr int b_ = v_rd_off(d0, 0, 0); \
        TRRD(l0, b_); TRRD(h0, b_ + 2048); TRRD(l1, b_ + 4096); TRRD(h1, b_ + 6144); TRRD(l2, b_ + 8192); TRRD(h2, b_ + 10240); TRRD(l3, b_ + 12288); TRRD(h3, b_ + 14336); \
        asm volatile("s_waitcnt lgkmcnt(0)" ::: "memory"); SBAR();   \
        o[d0] = __builtin_amdgcn_mfma_f32_32x32x16_bf16(pa0, (bf16x8){l0[0], l0[1], l0[2], l0[3], h0[0], h0[1], h0[2], h0[3]}, o[d0], 0, 0, 0);   \
        o[d0] = __builtin_amdgcn_mfma_f32_32x32x16_bf16(pa1, (bf16x8){l1[0], l1[1], l1[2], l1[3], h1[0], h1[1], h1[2], h1[3]}, o[d0], 0, 0, 0);   \
        o[d0] = __builtin_amdgcn_mfma_f32_32x32x16_bf16(pa2, (bf16x8){l2[0], l2[1], l2[2], l2[3], h2[0], h2[1], h2[2], h2[3]}, o[d0], 0, 0, 0);   \
        o[d0] = __builtin_amdgcn_mfma_f32_32x32x16_bf16(pa3, (bf16x8){l3[0], l3[1], l3[2], l3[3], h3[0], h3[1], h3[2], h3[3]}, o[d0], 0, 0, 0); } while (0)
    PV_D0(0); PV_D0(1); PV_D0(2); PV_D0(3);
#undef PV_D0
#undef TRRD
}
DI void fox_block(const Args& a, char* lds, int h, int P0, int j_lo) {
    const int tid = threadIdx.x, wid = __builtin_amdgcn_readfirstlane(tid >> 6), lane = tid & 63, r32 = lane & 31, hi = lane >> 5;
    const bf16_t* P = (const bf16_t*)(a.ws + WS_PROJ); const float* F = (const float*)(a.ws + WS_F) + (size_t)h * SEQ; bf16_t* OB = (bf16_t*)(a.ws + WS_OB);
    const bf16_t* Qp = P + PJ_FQ + h * 128; const bf16_t* Kp = P + PJ_FK + h * 128; const bf16_t* Vp = P + PJ_FV + h * 128;
    const int j_hi = (P0 + 255) / KVBLK + 1, NT = j_hi - j_lo;
    const int qlo = P0 + wid * 32, qm = qlo + r32 - 4 * hi;
    char* V_lds = lds + OFF_V; char* K_lds = lds + OFF_K; float* G_lds = (float*)(lds + OFF_G);
    float* wsp = (float*)(lds + OFF_WS) + wid * 64; float* li_l = wsp; float* al_l = wsp + 32;
    const int sr = tid >> 4;
    const int vb0 = (int)(unsigned)(uintptr_t)(LAS char*)V_lds + v_rd_base(lane);
    const float Fref = F[P0];
    bf16x8 qr[8];
#pragma unroll
    for (int d0 = 0; d0 < 8; ++d0) qr[d0] = *(const bf16x8*)(Qp + (size_t)(qlo + r32) * NPJ + d0 * 16 + hi * 8);
    float m_reg = -1e30f, l_reg = 0.f; f32x16 o[4] = {};
    float st_g = 0.f;
    const int ksrc = (((tid & 15) * 16) ^ ((sr & 7) << 4)) >> 1;
    const int vkk = (tid >> 7) * 8 + ((tid & 31) >> 2), vkey = (vkk & ~0xC) | ((vkk & 4) << 1) | ((vkk & 8) >> 1), vcol = ((tid >> 5) & 3) * 32 + (tid & 3) * 8;
    LAS unsigned char* ldsl = (LAS unsigned char*)lds;
#define FOX_LOAD(t, bf) do { const size_t k0_ = (size_t)(j_lo + (t)) * KVBLK; \
        __builtin_amdgcn_global_load_lds((const unsigned*)(Kp + (k0_ + sr) * NPJ + ksrc), (LAS unsigned*)(ldsl + OFF_K + (bf) * SHM_K + wid * 1024), 16, 0, 0); \
        __builtin_amdgcn_global_load_lds((const unsigned*)(Kp + (k0_ + 32 + sr) * NPJ + ksrc), (LAS unsigned*)(ldsl + OFF_K + (bf) * SHM_K + 8192 + wid * 1024), 16, 0, 0); \
        __builtin_amdgcn_global_load_lds((const unsigned*)(Vp + (k0_ + vkey) * NPJ + vcol), (LAS unsigned*)(ldsl + OFF_V + (bf) * SHM_V + wid * 1024), 16, 0, 0); \
        __builtin_amdgcn_global_load_lds((const unsigned*)(Vp + (k0_ + 32 + vkey) * NPJ + vcol), (LAS unsigned*)(ldsl + OFF_V + (bf) * SHM_V + 8192 + wid * 1024), 16, 0, 0); \
        if (tid < 64) st_g = F[k0_ + tid]; } while (0)
#define FOX_WRITE(bf) do { if (tid < 64) G_lds[(bf) * 64 + tid] = (st_g - Fref) * (1.f / SCALE); } while (0)
    FOX_LOAD(0, 0); asm volatile("s_waitcnt vmcnt(0)" ::: "memory"); FOX_WRITE(0);
    __syncthreads();
    for (int t = 0; t < NT; ++t) {
        const int bf = t & 1, kb_ = (j_lo + t) * KVBLK;
        if (t + 1 < NT) FOX_LOAD(t + 1, bf ^ 1);
        if (kb_ <= qlo + 31) {
            f32x16 p0, p1; float mn, al; bf16x8 pa0, pa1, pa2, pa3;
            qkt(p0, p1, K_lds + bf * SHM_K, r32, hi, qr);
            const float* gt = G_lds + bf * 64 + 4 * hi;
#pragma unroll
            for (int g4 = 0; g4 < 4; ++g4) { const f32x4 g0 = *(const f32x4*)(gt + 8 * g4), g1 = *(const f32x4*)(gt + 32 + 8 * g4);
#pragma unroll
                for (int i = 0; i < 4; ++i) { p0[4 * g4 + i] -= g0[i]; p1[4 * g4 + i] -= g1[i]; } }
            if (kb_ + KVBLK - 1 > qlo) mask_tile(p0, p1, qm - kb_);
            partialSM(p0, p1, m_reg, mn, al);
            finishSM(p0, p1, al, l_reg, pa0, pa1, pa2, pa3);
            if (__any(al < 1.f)) { if (hi == 0) al_l[r32] = al; asm volatile("s_waitcnt lgkmcnt(0)" ::: "memory");
#pragma unroll
                for (int d_ = 0; d_ < 4; ++d_)
#pragma unroll
                    for (int r = 0; r < 16; ++r) o[d_][r] *= al_l[crow(r, hi)]; }
            SBAR();
            pv_tile(o, vb0 + bf * SHM_V, pa0, pa1, pa2, pa3);
        }
        if (t + 1 < NT) { asm volatile("s_waitcnt vmcnt(0)" ::: "memory"); FOX_WRITE(bf ^ 1); }
        __syncthreads();
    }
#undef FOX_LOAD
#undef FOX_WRITE
    if (hi == 0) li_l[r32] = l_reg;
    asm volatile("s_waitcnt lgkmcnt(0)" ::: "memory");
    bf16_t* Ow = OB + (size_t)qlo * 512 + h * 128;
#pragma unroll
    for (int r = 0; r < 16; ++r) { const int orow = crow(r, hi); const float rl = __builtin_amdgcn_rcpf(li_l[orow]);
#pragma unroll
        for (int d0 = 0; d0 < 4; ++d0) { const float v = o[d0][r] * rl; const float vn = __shfl_xor(v, 1);
            if ((r32 & 1) == 0) *(unsigned*)(Ow + (size_t)orow * 512 + d0 * 32 + r32) = cvtpk(v, vn); } }
    __syncthreads();
}
#undef KSWZ
}

DI void transpose_tile(float* tile, const float* src, int ld, int k0, int c0, int c1, bf16_t* dst, int Kd) {
    const int tid = threadIdx.x, nn = tid & 63, k8 = tid >> 6; const int col = nn < 32 ? c0 + nn : c1 + nn - 32;
    const float* s = src + (size_t)(k0 + k8 * 8) * ld + col;
    float v[8];
#pragma unroll
    for (int i = 0; i < 8; ++i) v[i] = s[(size_t)i * ld];
    u32x4 w; w.x = cvt_pk(v[0], v[1]); w.y = cvt_pk(v[2], v[3]); w.z = cvt_pk(v[4], v[5]); w.w = cvt_pk(v[6], v[7]);
    *(u32x4*)(dst + (size_t)nn * Kd + k0 + k8 * 8) = w;
}
DI void ph0(const Args& a, float* lds) {
    const int tid = threadIdx.x, G = gridDim.x, bx = blockIdx.x;
    unsigned char* ws = a.ws;
    for (int grp = bx; grp < 256; grp += G) {
        const int col = tid % 24, ks = tid / 24, j = grp * 24 + col; const float* c = a.in[I_C]; const float* w = a.in[I_WADA];
        float acc = 0.f;
        if (ks < 21) { const int k1 = (ks * 49 + 49) < DM ? (ks * 49 + 49) : DM; for (int k = ks * 49; k < k1; ++k) acc += c[k] * w[(size_t)k * 6144 + j]; }
        __syncthreads();
        if (ks < 21) lds[ks * 24 + col] = acc;
        __syncthreads();
        if (tid < 24) { float s = a.in[I_BADA][grp * 24 + tid]; for (int q = 0; q < 21; ++q) s += lds[q * 24 + tid]; ((float*)(ws + WS_MOD))[grp * 24 + tid] = s; }
    }
    constexpr int T_WIN = 88 * 16, T_WOA = 16 * 8, T_WOUT = 16 * 16, T_WGU = 32 * 32 * 16, T_WD = 32 * 16 * 16;
    constexpr int NT = T_WIN + 2 * T_WOA + T_WOUT + T_WGU + T_WD;
    for (int t = bx; t < NT; t += G) {
        int r = t;
        if (r < T_WIN) { const int nt = r / 16, kt = r % 16, n0 = nt * 64; const int c0 = n0 + (n0 >= 3584 ? 12 : (n0 >= 2048 ? 8 : 0));
            transpose_tile(lds, a.in[I_WIN], NIN, kt * 64, c0, c0 + 32, (bf16_t*)(ws + WS_WINT) + (size_t)n0 * DM, DM); continue; }
        r -= T_WIN;
        if (r < T_WOA) { const int nt = r / 8, kt = r % 8, n0 = nt * 64; transpose_tile(lds, a.in[I_WOD], DM, kt * 64, n0, n0 + 32, (bf16_t*)(ws + WS_WOAT) + (size_t)n0 * 512, 512); continue; }
        r -= T_WOA;
        if (r < T_WOA) { const int nt = r / 8, kt = r % 8, n0 = nt * 64; transpose_tile(lds, a.in[I_WOF], DM, kt * 64, n0, n0 + 32, (bf16_t*)(ws + WS_WOBT) + (size_t)n0 * 512, 512); continue; }
        r -= T_WOA;
        if (r < T_WOUT) { const int nt = r / 16, kt = r % 16, n0 = nt * 64; transpose_tile(lds, a.in[I_WOUT], DM, kt * 64, n0, n0 + 32, (bf16_t*)(ws + WS_WOUTT) + (size_t)n0 * DM, DM); continue; }
        r -= T_WOUT;
        if (r < T_WGU) { const int e = r / 512, q = r % 512, nt = q / 16, kt = q % 16, n0 = nt * 64;
            transpose_tile(lds, a.in[I_WGU] + (size_t)e * DM * 2048, 2048, kt * 64, gu_src(n0), gu_src(n0 + 32), (bf16_t*)(ws + WS_WGUT) + ((size_t)e * 2048 + n0) * DM, DM); continue; }
        r -= T_WGU;
        { const int e = r / 256, q = r % 256, nt = q / 16, kt = q % 16, n0 = nt * 64;
            transpose_tile(lds, a.in[I_WD] + (size_t)e * DM * DM, DM, kt * 64, n0, n0 + 32, (bf16_t*)(ws + WS_WDT) + ((size_t)e * DM + n0) * DM, DM); }
    }
}

DI void ph1(const Args& a, float* lds) {
    const int tid = threadIdx.x, lane = tid & 63, wave = tid >> 6, G = gridDim.x;
    float* A1 = lds; float* B1 = lds + 1024; float* wsm = lds + 2048;
    const float* mod = (const float*)(a.ws + WS_MOD);
    for (int k = tid; k < DM; k += NTHREADS) { A1[k] = a.in[I_G1][k] * (1.f + mod[1024 + k]); B1[k] = mod[k]; }
    for (int i = tid; i < 12 * DM; i += NTHREADS) { const int k = i / 12, j = i % 12; wsm[j * DM + k] = a.in[I_WIN][(size_t)k * NIN + (j < 8 ? 2048 + j : 3592 + (j - 8))]; }
    __syncthreads();
    bf16_t* H = (bf16_t*)(a.ws + WS_H); float* SP = (float*)(a.ws + WS_SP);
    for (int t = blockIdx.x * NWAVES + wave; t < SEQ; t += G * NWAVES) {
        const float* xr = a.in[I_X] + (size_t)t * DM;
        f32x4 v[4]; float ss = 0.f;
#pragma unroll
        for (int i = 0; i < 4; ++i) { v[i] = *(const f32x4*)(xr + lane * 4 + 256 * i); ss += v[i][0] * v[i][0] + v[i][1] * v[i][1] + v[i][2] * v[i][2] + v[i][3] * v[i][3]; }
        ss = wave_sum(ss);
        const float rstd = rsqrtf(ss * (1.f / DM) + 1e-6f);
#pragma unroll
        for (int i = 0; i < 4; ++i) { const int k = lane * 4 + 256 * i;
#pragma unroll
            for (int e = 0; e < 4; ++e) v[i][e] = v[i][e] * rstd * A1[k + e] + B1[k + e];
            u32x2 w; w.x = pk2(v[i][0], v[i][1]); w.y = pk2(v[i][2], v[i][3]);
            *(u32x2*)(H + (size_t)t * DM + k) = w; }
#pragma unroll 1
        for (int j = 0; j < 12; ++j) { float pj = 0.f;
#pragma unroll
            for (int i = 0; i < 4; ++i) { const f32x4 wv = *(const f32x4*)(wsm + j * DM + lane * 4 + 256 * i); pj += v[i][0] * wv[0] + v[i][1] * wv[1] + v[i][2] * wv[2] + v[i][3] * wv[3]; }
            const float s = wave_sum(pj); if (lane == j) SP[(size_t)t * 16 + j] = s; }
    }
}

DI void ph2(const Args& a, unsigned char* ldsb) {
    pg8::Gemm g{(const bf16_t*)(a.ws + WS_H), (const bf16_t*)(a.ws + WS_WINT), SEQ, NPJ, DM};
    pg8::OrderDense S; S.init(SEQ / 256, NPJ / 256, (int)gridDim.x, (int)blockIdx.x);
    pg8::EpiStoreBf16 E{(bf16_t*)(a.ws + WS_PROJ), NPJ, nullptr, 0};
    pg8::gemm_phase<pg8::EpiStoreBf16, pg8::OrderDense>((LAS unsigned char*)ldsb, g, S, E);
}

DI void ph3_fcum(const Args& a, float* lds) {
    const int tid = threadIdx.x, lane = tid & 63, wave = tid >> 6, h = blockIdx.x;
    const float* SP = (const float*)(a.ws + WS_SP); float* F = (float*)(a.ws + WS_F);
    const float bf = a.in[I_BFG][h];
    double* wtot = (double*)lds;
    float lf[32];
#pragma unroll
    for (int i = 0; i < 32; ++i) lf[i] = SP[(size_t)(tid * 32 + i) * 16 + 8 + h];
    double s = 0.0;
#pragma unroll
    for (int i = 0; i < 32; ++i) { lf[i] = logsigf(lf[i] + bf); s += (double)lf[i]; }
    double inc = s;
#pragma unroll
    for (int o_ = 1; o_ < 64; o_ <<= 1) { const double y = __shfl_up(inc, o_); if (lane >= o_) inc += y; }
    __syncthreads();
    if (lane == 63) wtot[wave] = inc;
    __syncthreads();
    double off = inc - s;
    for (int w = 0; w < wave; ++w) off += wtot[w];
#pragma unroll
    for (int i = 0; i < 32; ++i) { off += (double)lf[i]; F[(size_t)h * SEQ + tid * 32 + i] = (float)off; }
    __syncthreads();
}
namespace prep {
constexpr int QS = 0, KS = 17408, KT = 34816, VT = 53248, UNIT = 71680, SM = 2 * UNIT;
DI bf16x8 ld8(const char* p) { return *(const bf16x8*)p; }
template <int C, int M4> struct TRow { static DI void run(const float (&T)[64], const float* Ls, float& a0, float& a1) {
    if constexpr (4 * M4 < C) { const f32x4 Lv = *(const f32x4*)(Ls + C * 68 + 4 * M4);
        a0 -= Lv[0] * T[4 * M4]; if constexpr (4 * M4 + 1 < C) a1 -= Lv[1] * T[4 * M4 + 1]; if constexpr (4 * M4 + 2 < C) a0 -= Lv[2] * T[4 * M4 + 2]; if constexpr (4 * M4 + 3 < C) a1 -= Lv[3] * T[4 * M4 + 3];
        TRow<C, M4 + 1>::run(T, Ls, a0, a1); } } };
template <int C> struct TRow<C, 16> { static DI void run(const float (&)[64], const float*, float&, float&) {} };
template <int C> DI void tsolve(float (&T)[64], const float* Ls, int lane) {
    if constexpr (C < 64) { float a0 = (lane == C) ? 1.f : 0.f, a1 = 0.f; TRow<C, 0>::run(T, Ls, a0, a1); T[C] = a0 + a1; asm volatile("" ::: "memory"); __builtin_amdgcn_sched_barrier(0); tsolve<C + 1>(T, Ls, lane); } }
}
DI void ph3_prep2(const Args& a, char* lds, int pair) {
    using namespace prep;
    const int tid = threadIdx.x, lane = tid & 63, wave = tid >> 6, grp = wave >> 2, wq = wave & 3, tg = tid & 255, lr = lane & 15, lq = lane >> 4;
    int unit = pair * 2 + grp; if (unit >= NH * NCH) unit = NH * NCH - 1;
    const int h = unit & 3, n = unit >> 2, t0 = n * CH;
    char* U = lds + grp * UNIT;
    float* gcs = (float*)(lds + SM) + grp * 192; float* bes = gcs + 64; float* egs = gcs + 128;
    const float* SP = (const float*)(a.ws + WS_SP); const bf16_t* P = (const bf16_t*)(a.ws + WS_PROJ);
    const size_t cb = (size_t)(h * NCH + n);
    bf16_t* WF = (bf16_t*)(a.ws + WS_DNW) + cb * 8192; bf16_t* UF = (bf16_t*)(a.ws + WS_DNU) + cb * 8192;
    bf16_t* QF = (bf16_t*)(a.ws + WS_DNQD) + cb * 8192; bf16_t* KF = (bf16_t*)(a.ws + WS_DNKD) + cb * 8192; bf16_t* AF = (bf16_t*)(a.ws + WS_DNATT) + cb * 4096;
    __syncthreads();
    if (wq == 0) { const int t = t0 + lane;
        const float be = sigm(SP[(size_t)t * 16 + h]);
        float g = -expf(a.in[I_ALOG][h]) * softplusf(SP[(size_t)t * 16 + 4 + h] + a.in[I_DTB][h]);
#pragma unroll
        for (int o_ = 1; o_ < 64; o_ <<= 1) { const float y = __shfl_up(g, o_); if (lane >= o_) g += y; }
        gcs[lane] = g; bes[lane] = be; egs[lane] = expf(g); }
    __syncthreads();
    { const int d8 = tg & 15, ci = tg >> 4; const float* cw = a.in[I_CONVW];
#pragma unroll 1
        for (int sec = 0; sec < 3; ++sec) {
            const int col = sec * 512 + h * 128 + d8 * 8;
            f32x4 w[4][2];
#pragma unroll
            for (int j = 0; j < 4; ++j) { w[j][0] = *(const f32x4*)(cw + j * 1536 + col); w[j][1] = *(const f32x4*)(cw + j * 1536 + col + 4); }
#pragma unroll 1
          for (int ih = 0; ih < 2; ++ih) {
            u32x4 xin[2][4];
#pragma unroll
            for (int i = 0; i < 2; ++i)
#pragma unroll
                for (int j = 0; j < 4; ++j) { int tt = t0 + ci + 16 * (2 * ih + i) - 3 + j; tt = tt < 0 ? 0 : tt; xin[i][j] = *(const u32x4*)(P + (size_t)tt * NPJ + col); }
#pragma unroll
            for (int i = 0; i < 2; ++i) { const int c = ci + 16 * (2 * ih + i), t = t0 + c;
                float v[8];
#pragma unroll
                for (int e = 0; e < 8; ++e) v[e] = 0.f;
#pragma unroll
                for (int j = 0; j < 4; ++j) { const float ok = (t - 3 + j >= 0) ? 1.f : 0.f; const u32x4 x = xin[i][j];
                    v[0] += ok * w[j][0][0] * __uint_as_float(x.x << 16); v[1] += ok * w[j][0][1] * __uint_as_float(x.x & 0xffff0000u); v[2] += ok * w[j][0][2] * __uint_as_float(x.y << 16); v[3] += ok * w[j][0][3] * __uint_as_float(x.y & 0xffff0000u);
                    v[4] += ok * w[j][1][0] * __uint_as_float(x.z << 16); v[5] += ok * w[j][1][1] * __uint_as_float(x.z & 0xffff0000u); v[6] += ok * w[j][1][2] * __uint_as_float(x.w << 16); v[7] += ok * w[j][1][3] * __uint_as_float(x.w & 0xffff0000u); }
                float ss = 0.f;
#pragma unroll
                for (int e = 0; e < 8; ++e) { v[e] = siluf(v[e]); ss += v[e] * v[e]; }
                if (sec < 2) { ss += __shfl_xor(ss, 1); ss += __shfl_xor(ss, 2); ss += __shfl_xor(ss, 4); ss += __shfl_xor(ss, 8);
                    const float sc = rsqrtf(ss + 1e-6f) * (sec == 0 ? 0.08838834764831845f : 1.f);
#pragma unroll
                    for (int e = 0; e < 8; ++e) v[e] *= sc; }
                u32x4 pk; pk.x = cvt_pk(v[0], v[1]); pk.y = cvt_pk(v[2], v[3]); pk.z = cvt_pk(v[4], v[5]); pk.w = cvt_pk(v[6], v[7]);
                if (sec == 0) { *(u32x4*)(U + QS + c * 272 + d8 * 16) = pk;
                    const float eg = egs[c];
                    const int base = (((c >> 4) * 4 + (d8 >> 2)) * 64 + (c & 15)) * 8 + 4 * ((d8 & 3) >> 1), l0 = (2 * (d8 & 3)) & 3;
                    u32x2 q0, q1; q0.x = cvt_pk(v[0] * eg, v[1] * eg); q0.y = cvt_pk(v[2] * eg, v[3] * eg); q1.x = cvt_pk(v[4] * eg, v[5] * eg); q1.y = cvt_pk(v[6] * eg, v[7] * eg);
                    *(u32x2*)(QF + base + l0 * 128) = q0; *(u32x2*)(QF + base + (l0 + 1) * 128) = q1; }
                else { if (sec == 1) *(u32x4*)(U + KS + c * 272 + d8 * 16) = pk;
                    bf16_t* T_ = (bf16_t*)(U + (sec == 1 ? KT : VT)) + (d8 * 8) * 72 + c;
                    T_[0 * 72] = (bf16_t)(pk.x & 0xffffu); T_[1 * 72] = (bf16_t)(pk.x >> 16); T_[2 * 72] = (bf16_t)(pk.y & 0xffffu); T_[3 * 72] = (bf16_t)(pk.y >> 16);
                    T_[4 * 72] = (bf16_t)(pk.z & 0xffffu); T_[5 * 72] = (bf16_t)(pk.z >> 16); T_[6 * 72] = (bf16_t)(pk.w & 0xffffu); T_[7 * 72] = (bf16_t)(pk.w >> 16); }
            }
          }
        }
    }
    __syncthreads();
    f32x4 Lr[4];
    { const int mt = wq;
#pragma unroll
        for (int nt = 0; nt < 4; ++nt) { Lr[nt] = (f32x4){0.f, 0.f, 0.f, 0.f};
            if (nt <= mt) {
#pragma unroll
                for (int s = 0; s < 4; ++s) Lr[nt] = MFMA16(ld8(U + KS + (16 * mt + lr) * 272 + (32 * s + 8 * lq) * 2), ld8(U + KS + (16 * nt + lr) * 272 + (32 * s + 8 * lq) * 2), Lr[nt]); } }
        const int ntq = 3 - wq; const float gcc = gcs[16 * ntq + lr];
#pragma unroll
        for (int mtk = 0; mtk < 4; ++mtk) { f32x4 acc = (f32x4){0.f, 0.f, 0.f, 0.f};
            if (mtk <= ntq) {
#pragma unroll
                for (int s = 0; s < 4; ++s) acc = MFMA16(ld8(U + KS + (16 * mtk + lr) * 272 + (32 * s + 8 * lq) * 2), ld8(U + QS + (16 * ntq + lr) * 272 + (32 * s + 8 * lq) * 2), acc);
#pragma unroll
                for (int r = 0; r < 4; ++r) { const int m = 16 * mtk + 4 * lq + r, c = 16 * ntq + lr; acc[r] = (m <= c) ? acc[r] * expf(gcc - gcs[m]) : 0.f; } }
            u32x2 o_; o_.x = cvt_pk(acc[0], acc[1]); o_.y = cvt_pk(acc[2], acc[3]);
            *(u32x2*)(AF + ((ntq * 2 + (mtk >> 1)) * 64 + lane) * 8 + 4 * (mtk & 1)) = o_; }
    }
    __syncthreads();
    { const int mt = wq; float* LT = (float*)(U + QS);
#pragma unroll
        for (int nt = 0; nt < 4; ++nt) if (nt <= mt) { const int m = 16 * nt + lr; f32x4 o_;
#pragma unroll
            for (int r = 0; r < 4; ++r) { const int c = 16 * mt + 4 * lq + r; o_[r] = (m < c) ? bes[c] * Lr[nt][r] * expf(gcs[c] - gcs[m]) : 0.f; }
            *(f32x4*)(LT + m * 68 + 16 * mt + 4 * lq) = o_; } }
    __syncthreads();
    if (wq == 0) { const float* LT = (const float*)(U + QS); float* Tl = (float*)(U + KS);
#pragma unroll
        for (int ib = 0; ib < 4; ++ib) { float acc[16];
#pragma unroll
            for (int r = 0; r < 16; ++r) acc[r] = (lane == 16 * ib + r) ? 1.f : 0.f;
#pragma unroll 2
            for (int m = 0; m < 16 * ib; ++m) { const float t = Tl[m * 68 + lane];
#pragma unroll
                for (int q = 0; q < 4; ++q) { const f32x4 Lv = *(const f32x4*)(LT + m * 68 + 16 * ib + 4 * q);
#pragma unroll
                    for (int e = 0; e < 4; ++e) acc[4 * q + e] -= Lv[e] * t; } }
#pragma unroll
            for (int p = 0; p < 16; ++p) { const float t = acc[p]; Tl[(16 * ib + p) * 68 + lane] = t;
                if (p < 15) {
#pragma unroll
                    for (int q = 0; q < 4; ++q) if (4 * q + 3 > p) { const f32x4 Lv = *(const f32x4*)(LT + (16 * ib + p) * 68 + 16 * ib + 4 * q);
#pragma unroll
                        for (int e = 0; e < 4; ++e) if (4 * q + e > p) acc[4 * q + e] -= Lv[e] * t; } } }
            asm volatile("s_waitcnt lgkmcnt(0)" ::: "memory"); }
        if (lane == 0) ((float*)(a.ws + WS_EG))[cb] = egs[63];
    } else { const float gl = gcs[63];
        for (int i = tg - 64; i < 2048; i += 192) { const int dk = i >> 4, cq = i & 15;
            const u32x2 x = *(const u32x2*)(U + KT + dk * 144 + cq * 8);
            const float e0 = expf(gl - gcs[4 * cq]), e1 = expf(gl - gcs[4 * cq + 1]), e2 = expf(gl - gcs[4 * cq + 2]), e3 = expf(gl - gcs[4 * cq + 3]);
            u32x2 o_; o_.x = cvt_pk(__uint_as_float(x.x << 16) * e0, __uint_as_float(x.x & 0xffff0000u) * e1); o_.y = cvt_pk(__uint_as_float(x.y << 16) * e2, __uint_as_float(x.y & 0xffff0000u) * e3);
            *(u32x2*)(KF + (((dk >> 4) * 2 + (cq >> 3)) * 64 + (cq & 3) * 16 + (dk & 15)) * 8 + 4 * ((cq >> 2) & 1)) = o_; } }
    __syncthreads();
    { const float* Tl = (const float*)(U + KS); const int c = tg >> 2, m0 = (tg & 3) * 16;
        f32x4 tv[4];
#pragma unroll
        for (int q = 0; q < 4; ++q) tv[q] = *(const f32x4*)(Tl + c * 68 + m0 + 4 * q);
        __syncthreads();
        bf16_t* Tb = (bf16_t*)(U + QS); bf16_t* Tg = (bf16_t*)(U + KS);
#pragma unroll
        for (int q = 0; q < 4; ++q) { u32x2 b_, g_; float be[4], bg[4];
#pragma unroll
            for (int e = 0; e < 4; ++e) { const int m = m0 + 4 * q + e; be[e] = tv[q][e] * bes[m]; bg[e] = be[e] * egs[m]; }
            b_.x = cvt_pk(be[0], be[1]); b_.y = cvt_pk(be[2], be[3]); g_.x = cvt_pk(bg[0], bg[1]); g_.y = cvt_pk(bg[2], bg[3]);
            *(u32x2*)(Tb + c * 72 + m0 + 4 * q) = b_; *(u32x2*)(Tg + c * 72 + m0 + 4 * q) = g_; } }
    __syncthreads();
    {
#pragma unroll
        for (int q = 0; q < 2; ++q) { const int nt = 2 * wq + q;
#pragma unroll
            for (int mt = 0; mt < 4; ++mt) { f32x4 acc = (f32x4){0.f, 0.f, 0.f, 0.f};
#pragma unroll
                for (int s = 0; s < 2; ++s) acc = MFMA16(ld8(U + QS + (16 * mt + lr) * 144 + (32 * s + 8 * lq) * 2), ld8(U + VT + (16 * nt + lr) * 144 + (32 * s + 8 * lq) * 2), acc);
                u32x2 o_; o_.x = cvt_pk(acc[0], acc[1]); o_.y = cvt_pk(acc[2], acc[3]);
                *(u32x2*)(UF + ((nt * 4 + mt) * 64 + lane) * 4) = o_; } }
#pragma unroll
        for (int q = 0; q < 2; ++q) { const int mtk = 2 * wq + q;
#pragma unroll
            for (int ntc = 0; ntc < 4; ++ntc) { f32x4 acc = (f32x4){0.f, 0.f, 0.f, 0.f};
#pragma unroll
                for (int s = 0; s < 2; ++s) acc = MFMA16(ld8(U + KT + (16 * mtk + lr) * 144 + (32 * s + 8 * lq) * 2), ld8(U + KS + (16 * ntc + lr) * 144 + (32 * s + 8 * lq) * 2), acc);
                u32x2 o_; o_.x = cvt_pk(-acc[0], -acc[1]); o_.y = cvt_pk(-acc[2], -acc[3]);
                *(u32x2*)(WF + ((ntc * 4 + (mtk >> 1)) * 64 + lane) * 8 + 4 * (mtk & 1)) = o_; } }
    }
}
DI void ph3_norms(const Args& a, float* lds) {
    const int lane = threadIdx.x & 63, wave = threadIdx.x >> 6, NW = gridDim.x * NWAVES, sub = lane >> 4, l16 = lane & 15;
    const bf16_t* P = (const bf16_t*)(a.ws + WS_PROJ); float* TB = (float*)(a.ws + WS_NRMT);
    for (int grp = blockIdx.x * NWAVES + wave; grp < SEQ / 8; grp += NW) {
        float mq[4] = {0.f, 0.f, 0.f, 0.f}, mk[4] = {0.f, 0.f, 0.f, 0.f}, md[4] = {3.0e38f, 3.0e38f, 3.0e38f, 3.0e38f};
#pragma unroll
        for (int it = 0; it < 2; ++it) { const bf16_t* row = P + (size_t)(grp * 8 + it * 4 + sub) * NPJ + l16 * 8;
            u32x4 xq[4], xk[4];
#pragma unroll
            for (int h = 0; h < 4; ++h) { xq[h] = *(const u32x4*)(row + PJ_FQ + h * 128); xk[h] = *(const u32x4*)(row + PJ_FK + h * 128); }
#pragma unroll
            for (int h = 0; h < 4; ++h) { float sq = 0.f, sk = 0.f, sd = 0.f;
#pragma unroll
                for (int e = 0; e < 4; ++e) { const float a0 = __uint_as_float(xq[h][e] << 16), a1 = __uint_as_float(xq[h][e] & 0xffff0000u), b0 = __uint_as_float(xk[h][e] << 16), b1 = __uint_as_float(xk[h][e] & 0xffff0000u);
                    sq += a0 * a0 + a1 * a1; sk += b0 * b0 + b1 * b1; sd += a0 * b0 + a1 * b1; }
#pragma unroll
                for (int o_ = 1; o_ <= 8; o_ <<= 1) { sq += __shfl_xor(sq, o_); sk += __shfl_xor(sk, o_); sd += __shfl_xor(sd, o_); }
                mq[h] = fmaxf(mq[h], sq); mk[h] = fmaxf(mk[h], sk); md[h] = fminf(md[h], sd); } }
#pragma unroll
        for (int h = 0; h < 4; ++h) { mq[h] = fmaxf(mq[h], __shfl_xor(mq[h], 16)); mq[h] = fmaxf(mq[h], __shfl_xor(mq[h], 32)); mk[h] = fmaxf(mk[h], __shfl_xor(mk[h], 16)); mk[h] = fmaxf(mk[h], __shfl_xor(mk[h], 32));
            md[h] = fminf(md[h], __shfl_xor(md[h], 16)); md[h] = fminf(md[h], __shfl_xor(md[h], 32));
            if (lane == 0) { TB[grp * 12 + h] = mq[h]; TB[grp * 12 + 4 + h] = mk[h]; TB[grp * 12 + 8 + h] = md[h]; } }
    }
}
DI void ph3(const Args& a, float* lds) {
    const int G = gridDim.x;
    if (blockIdx.x < 4) ph3_fcum(a, lds);
    for (int p = blockIdx.x; p < NH * NCH / 2; p += G) ph3_prep2(a, (char*)lds, p);
    ph3_norms(a, lds);
}

namespace dn {
DI unsigned cvtpk(float lo, float hi) { return cvt_pk(lo, hi); }
DI bf16x8 packB(const f32x4& t0, const f32x4& t1) { u32x4 w = {cvtpk(t0[0], t0[1]), cvtpk(t0[2], t0[3]), cvtpk(t1[0], t1[1]), cvtpk(t1[2], t1[3])}; return *reinterpret_cast<bf16x8*>(&w); }
DI bf16x8 frag(const bf16_t* base, int f, int lane) { return *(const bf16x8*)(base + ((size_t)f * 64 + lane) * 8); }
template <bool WITH_U, bool WITH_O>
DI void step(const bf16_t* WFn, const bf16_t* KFn, const bf16_t* QFn, const bf16_t* AFn, const bf16_t* UFs, float eg, f32x4 (&S)[8], f32x4 (&o)[4], int lane) {
    bf16x8 sb[4];
#pragma unroll
    for (int s = 0; s < 4; ++s) sb[s] = packB(S[2 * s], S[2 * s + 1]);
    f32x4 vn[4];
#pragma unroll
    for (int mt = 0; mt < 4; ++mt) {
        if (WITH_U) { const u32x2 w = *(const u32x2*)(UFs + ((size_t)mt * 64 + lane) * 4); vn[mt] = (f32x4){__uint_as_float(w.x << 16), __uint_as_float(w.x & 0xffff0000u), __uint_as_float(w.y << 16), __uint_as_float(w.y & 0xffff0000u)}; }
        else vn[mt] = (f32x4){0.f, 0.f, 0.f, 0.f};
#pragma unroll
        for (int s = 0; s < 4; ++s) vn[mt] = MFMA16(frag(WFn, mt * 4 + s, lane), sb[s], vn[mt]); }
    if (WITH_O) {
#pragma unroll
        for (int mt = 0; mt < 4; ++mt) { o[mt] = (f32x4){0.f, 0.f, 0.f, 0.f};
#pragma unroll
            for (int s = 0; s < 4; ++s) o[mt] = MFMA16(frag(QFn, mt * 4 + s, lane), sb[s], o[mt]); } }
    bf16x8 vb[2];
#pragma unroll
    for (int s = 0; s < 2; ++s) vb[s] = packB(vn[2 * s], vn[2 * s + 1]);
    if (WITH_O) {
#pragma unroll
        for (int mt = 0; mt < 4; ++mt)
#pragma unroll
            for (int s = 0; s < 2; ++s) o[mt] = MFMA16(frag(AFn, mt * 2 + s, lane), vb[s], o[mt]); }
#pragma unroll
    for (int mt = 0; mt < 8; ++mt) { S[mt] = S[mt] * eg;
#pragma unroll
        for (int s = 0; s < 2; ++s) S[mt] = MFMA16(frag(KFn, mt * 2 + s, lane), vb[s], S[mt]); }
}
}
constexpr int NGRP = 16, GRP = 16;
constexpr int NSCAN = NH * NGRP;
constexpr int SBUF = 57344;
template <int N> struct Stage { u32x4 r[N]; };
DI void stage_load2(Stage<4>& st, const bf16_t* s0, const bf16_t* s1) {
    const int tid = threadIdx.x;
    st.r[0] = *(const u32x4*)(s0 + (size_t)tid * 8); st.r[1] = *(const u32x4*)(s0 + (size_t)(tid + 512) * 8);
    st.r[2] = *(const u32x4*)(s1 + (size_t)tid * 8); st.r[3] = *(const u32x4*)(s1 + (size_t)(tid + 512) * 8);
}
DI void stage_write2(const Stage<4>& st, char* buf) {
    const int tid = threadIdx.x;
    *(u32x4*)(buf + tid * 16) = st.r[0]; *(u32x4*)(buf + (tid + 512) * 16) = st.r[1];
    *(u32x4*)(buf + 16384 + tid * 16) = st.r[2]; *(u32x4*)(buf + 16384 + (tid + 512) * 16) = st.r[3];
}
DI void stage_load4(Stage<7>& st, const bf16_t* s0, const bf16_t* s1, const bf16_t* s2, const bf16_t* s3) {
    const int tid = threadIdx.x;
    st.r[0] = *(const u32x4*)(s0 + (size_t)tid * 8); st.r[1] = *(const u32x4*)(s0 + (size_t)(tid + 512) * 8);
    st.r[2] = *(const u32x4*)(s1 + (size_t)tid * 8); st.r[3] = *(const u32x4*)(s1 + (size_t)(tid + 512) * 8);
    st.r[4] = *(const u32x4*)(s2 + (size_t)tid * 8); st.r[5] = *(const u32x4*)(s2 + (size_t)(tid + 512) * 8);
    st.r[6] = *(const u32x4*)(s3 + (size_t)tid * 8);
}
DI void stage_write4(const Stage<7>& st, char* buf) {
    const int tid = threadIdx.x;
    *(u32x4*)(buf + tid * 16) = st.r[0]; *(u32x4*)(buf + (tid + 512) * 16) = st.r[1];
    *(u32x4*)(buf + 16384 + tid * 16) = st.r[2]; *(u32x4*)(buf + 16384 + (tid + 512) * 16) = st.r[3];
    *(u32x4*)(buf + 32768 + tid * 16) = st.r[4]; *(u32x4*)(buf + 32768 + (tid + 512) * 16) = st.r[5];
    *(u32x4*)(buf + 49152 + tid * 16) = st.r[6];
}
DI f32x4 u_unpack(const u32x2 w) { return (f32x4){__uint_as_float(w.x << 16), __uint_as_float(w.x & 0xffff0000u), __uint_as_float(w.y << 16), __uint_as_float(w.y & 0xffff0000u)}; }
DI void scanA_chain(const Args& a, char* lds, int chain) {
    const int tid = threadIdx.x, lane = tid & 63, vs = tid >> 6, lr = lane & 15, lq = lane >> 4;
    const int h = chain >> 4, g = chain & 15;
    f32x4 SQ[8], SP[8];
#pragma unroll
    for (int mt = 0; mt < 8; ++mt) { SQ[mt] = (f32x4){0.f, 0.f, 0.f, 0.f};
#pragma unroll
        for (int r = 0; r < 4; ++r) SP[mt][r] = (16 * mt + 4 * lq + r == 16 * vs + lr) ? 1.f : 0.f; }
    const size_t cb0 = (size_t)(h * NCH + g * GRP);
    const bf16_t* WF = (const bf16_t*)(a.ws + WS_DNW) + cb0 * 8192; const bf16_t* KF = (const bf16_t*)(a.ws + WS_DNKD) + cb0 * 8192;
    const bf16_t* UF = (const bf16_t*)(a.ws + WS_DNU) + cb0 * 8192 + (size_t)vs * 1024; const float* EG = (const float*)(a.ws + WS_EG) + cb0;
    Stage<4> st; u32x2 ucur[4], unxt[4];
    __syncthreads();
    stage_load2(st, WF, KF);
#pragma unroll
    for (int mt = 0; mt < 4; ++mt) ucur[mt] = *(const u32x2*)(UF + ((size_t)mt * 64 + lane) * 4);
    asm volatile("s_waitcnt vmcnt(0)" ::: "memory");
    stage_write2(st, lds);
    __syncthreads();
    for (int i = 0; i < GRP; ++i) {
        const char* buf = lds + (i & 1) * SBUF;
        if (i + 1 < GRP) { stage_load2(st, WF + (size_t)(i + 1) * 8192, KF + (size_t)(i + 1) * 8192);
#pragma unroll
            for (int mt = 0; mt < 4; ++mt) unxt[mt] = *(const u32x2*)(UF + (size_t)(i + 1) * 8192 + ((size_t)mt * 64 + lane) * 4); }
        const float eg = EG[i];
        const bf16_t* Wl = (const bf16_t*)buf; const bf16_t* Kl = (const bf16_t*)(buf + 16384);
        bf16x8 sbq[4], sbp[4];
#pragma unroll
        for (int s = 0; s < 4; ++s) { sbq[s] = dn::packB(SQ[2 * s], SQ[2 * s + 1]); sbp[s] = dn::packB(SP[2 * s], SP[2 * s + 1]); }
        f32x4 vq[4], vp[4];
#pragma unroll
        for (int mt = 0; mt < 4; ++mt) { vq[mt] = u_unpack(ucur[mt]); vp[mt] = (f32x4){0.f, 0.f, 0.f, 0.f};
#pragma unroll
            for (int s = 0; s < 4; ++s) { const bf16x8 f = dn::frag(Wl, mt * 4 + s, lane); vq[mt] = MFMA16(f, sbq[s], vq[mt]); vp[mt] = MFMA16(f, sbp[s], vp[mt]); } }
        bf16x8 vbq[2], vbp[2];
#pragma unroll
        for (int s = 0; s < 2; ++s) { vbq[s] = dn::packB(vq[2 * s], vq[2 * s + 1]); vbp[s] = dn::packB(vp[2 * s], vp[2 * s + 1]); }
#pragma unroll
        for (int mt = 0; mt < 8; ++mt) { SQ[mt] = SQ[mt] * eg; SP[mt] = SP[mt] * eg;
#pragma unroll
            for (int s = 0; s < 2; ++s) { const bf16x8 f = dn::frag(Kl, mt * 2 + s, lane); SQ[mt] = MFMA16(f, vbq[s], SQ[mt]); SP[mt] = MFMA16(f, vbp[s], SP[mt]); } }
        if (i + 1 < GRP) { asm volatile("s_waitcnt vmcnt(0)" ::: "memory"); stage_write2(st, lds + ((i + 1) & 1) * SBUF);
#pragma unroll
            for (int mt = 0; mt < 4; ++mt) ucur[mt] = unxt[mt]; }
        __syncthreads();
    }
    bf16_t* PG = (bf16_t*)(a.ws + WS_PG) + (size_t)chain * 16384;
#pragma unroll
    for (int mt = 0; mt < 8; ++mt)
#pragma unroll
        for (int r = 0; r < 4; ++r) PG[((mt * 4 + (vs >> 1)) * 64 + (lr >> 2) * 16 + 4 * lq + r) * 8 + 4 * (vs & 1) + (lr & 3)] = f2bf(SP[mt][r]);
    float* QG = (float*)(a.ws + WS_QG) + ((size_t)chain * 8 + vs) * 2048;
#pragma unroll
    for (int mt = 0; mt < 8; ++mt) *(f32x4*)(QG + ((size_t)mt * 64 + lane) * 4) = SQ[mt];
}
DI void scanPC_chain(const Args& a, char* lds, int chain) {
    const int tid = threadIdx.x, lane = tid & 63, vs = tid >> 6, lr = lane & 15, lq = lane >> 4;
    const int h = chain >> 4, g = chain & 15;
    f32x4 S[8];
#pragma unroll
    for (int mt = 0; mt < 8; ++mt) S[mt] = (f32x4){0.f, 0.f, 0.f, 0.f};
    __syncthreads();
    if (g > 0) {
        const bf16_t* PG = (const bf16_t*)(a.ws + WS_PG) + (size_t)(h * NGRP) * 16384; const float* QG = (const float*)(a.ws + WS_QG) + ((size_t)(h * NGRP) * 8 + vs) * 2048;
        Stage<4> st; f32x4 qc[8], qn[8];
        stage_load2(st, PG, PG + 8192);
#pragma unroll
        for (int mt = 0; mt < 8; ++mt) qc[mt] = *(const f32x4*)(QG + ((size_t)mt * 64 + lane) * 4);
        asm volatile("s_waitcnt vmcnt(0)" ::: "memory");
        stage_write2(st, lds);
        __syncthreads();
        for (int j = 0; j < g; ++j) {
            const bf16_t* Pl = (const bf16_t*)(lds + (j & 1) * SBUF);
            if (j + 1 < g) { stage_load2(st, PG + (size_t)(j + 1) * 16384, PG + (size_t)(j + 1) * 16384 + 8192);
#pragma unroll
                for (int mt = 0; mt < 8; ++mt) qn[mt] = *(const f32x4*)(QG + (size_t)(j + 1) * 16384 + ((size_t)mt * 64 + lane) * 4); }
            bf16x8 sb[4];
#pragma unroll
            for (int s = 0; s < 4; ++s) sb[s] = dn::packB(S[2 * s], S[2 * s + 1]);
#pragma unroll
            for (int mt = 0; mt < 8; ++mt) { f32x4 acc = qc[mt];
#pragma unroll
                for (int s = 0; s < 4; ++s) acc = MFMA16(dn::frag(Pl, mt * 4 + s, lane), sb[s], acc);
                S[mt] = acc; }
            if (j + 1 < g) { asm volatile("s_waitcnt vmcnt(0)" ::: "memory"); stage_write2(st, lds + ((j + 1) & 1) * SBUF);
#pragma unroll
                for (int mt = 0; mt < 8; ++mt) qc[mt] = qn[mt]; }
            __syncthreads();
        }
    }
    const size_t cb0 = (size_t)(h * NCH + g * GRP);
    const bf16_t* WF = (const bf16_t*)(a.ws + WS_DNW) + cb0 * 8192; const bf16_t* KF = (const bf16_t*)(a.ws + WS_DNKD) + cb0 * 8192;
    const bf16_t* QF = (const bf16_t*)(a.ws + WS_DNQD) + cb0 * 8192; const bf16_t* AF = (const bf16_t*)(a.ws + WS_DNATT) + cb0 * 4096;
    const bf16_t* UF = (const bf16_t*)(a.ws + WS_DNU) + cb0 * 8192 + (size_t)vs * 1024; const float* EG = (const float*)(a.ws + WS_EG) + cb0;
    float* ORAW = (float*)(a.ws + WS_ORAW);
    Stage<7> st; u32x2 ucur[4], unxt[4];
    stage_load4(st, WF, KF, QF, AF);
#pragma unroll
    for (int mt = 0; mt < 4; ++mt) ucur[mt] = *(const u32x2*)(UF + ((size_t)mt * 64 + lane) * 4);
    asm volatile("s_waitcnt vmcnt(0)" ::: "memory");
    stage_write4(st, lds);
    __syncthreads();
    for (int i = 0; i < GRP; ++i) {
        const char* buf = lds + (i & 1) * SBUF; const int n = g * GRP + i;
        if (i + 1 < GRP) { stage_load4(st, WF + (size_t)(i + 1) * 8192, KF + (size_t)(i + 1) * 8192, QF + (size_t)(i + 1) * 8192, AF + (size_t)(i + 1) * 4096);
#pragma unroll
            for (int mt = 0; mt < 4; ++mt) unxt[mt] = *(const u32x2*)(UF + (size_t)(i + 1) * 8192 + ((size_t)mt * 64 + lane) * 4); }
        const float eg = EG[i];
        const bf16_t* Wl = (const bf16_t*)buf; const bf16_t* Kl = (const bf16_t*)(buf + 16384); const bf16_t* Ql = (const bf16_t*)(buf + 32768); const bf16_t* Al = (const bf16_t*)(buf + 49152);
        bf16x8 sb[4];
#pragma unroll
        for (int s = 0; s < 4; ++s) sb[s] = dn::packB(S[2 * s], S[2 * s + 1]);
        f32x4 vn[4], o[4];
#pragma unroll
        for (int mt = 0; mt < 4; ++mt) { vn[mt] = u_unpack(ucur[mt]); o[mt] = (f32x4){0.f, 0.f, 0.f, 0.f};
#pragma unroll
            for (int s = 0; s < 4; ++s) { vn[mt] = MFMA16(dn::frag(Wl, mt * 4 + s, lane), sb[s], vn[mt]); o[mt] = MFMA16(dn::frag(Ql, mt * 4 + s, lane), sb[s], o[mt]); } }
        bf16x8 vb[2];
#pragma unroll
        for (int s = 0; s < 2; ++s) vb[s] = dn::packB(vn[2 * s], vn[2 * s + 1]);
#pragma unroll
        for (int mt = 0; mt < 4; ++mt)
#pragma unroll
            for (int s = 0; s < 2; ++s) o[mt] = MFMA16(dn::frag(Al, mt * 2 + s, lane), vb[s], o[mt]);
#pragma unroll
        for (int mt = 0; mt < 8; ++mt) { S[mt] = S[mt] * eg;
#pragma unroll
            for (int s = 0; s < 2; ++s) S[mt] = MFMA16(dn::frag(Kl, mt * 2 + s, lane), vb[s], S[mt]); }
#pragma unroll
        for (int mt = 0; mt < 4; ++mt)
#pragma unroll
            for (int r = 0; r < 4; ++r) ORAW[(size_t)(n * CH + 16 * mt + 4 * lq + r) * 512 + h * 128 + 16 * vs + lr] = o[mt][r];
        if (i + 1 < GRP) { asm volatile("s_waitcnt vmcnt(0)" ::: "memory"); stage_write4(st, lds + ((i + 1) & 1) * SBUF);
#pragma unroll
            for (int mt = 0; mt < 4; ++mt) ucur[mt] = unxt[mt]; }
        __syncthreads();
    }
}
DI void ph4_fox(const Args& a, char* lds, int nscan) {
    const int tid = threadIdx.x, lane = tid & 63, wave = tid >> 6;
    const float* F = (const float*)(a.ws + WS_F); unsigned* QH = (unsigned*)(a.ws + WS_QH);
    int* misc = (int*)(lds + fox::OFF_MISC);
    if (tid == 0) { int ord0 = 0, ord1 = 1, ord2 = 2, ord3 = 3;
      float r0 = -F[0 * SEQ + SEQ - 1], r1 = -F[1 * SEQ + SEQ - 1], r2 = -F[2 * SEQ + SEQ - 1], r3 = -F[3 * SEQ + SEQ - 1];
#define CSWAP(ra, rb, oa, ob) if (rb < ra) { const float tf = ra; ra = rb; rb = tf; const int ti = oa; oa = ob; ob = ti; }
      CSWAP(r0, r1, ord0, ord1) CSWAP(r2, r3, ord2, ord3) CSWAP(r0, r2, ord0, ord2) CSWAP(r1, r3, ord1, ord3) CSWAP(r1, r2, ord1, ord2)
#undef CSWAP
      misc[4] = ord0; misc[5] = ord1; misc[6] = ord2; misc[7] = ord3; }
    float* qkbs = (float*)(lds + fox::OFF_MISC) + 8;
    const float* TB = (const float*)(a.ws + WS_NRMT);
    __syncthreads();
    { float m = 0.f; const int h = tid & 3;
        for (int g_ = tid >> 2; g_ < SEQ / 8; g_ += NTHREADS / 4) m = fmaxf(m, TB[g_ * 12 + 4 + h]);
        for (int o_ = 4; o_ < 64; o_ <<= 1) m = fmaxf(m, __shfl_xor(m, o_));
        if (lane < 4) qkbs[16 + wave * 4 + lane] = m; }
    __syncthreads();
    if (tid < 4) { float m = 0.f; for (int w = 0; w < NWAVES; ++w) m = fmaxf(m, qkbs[16 + w * 4 + tid]); qkbs[tid] = m; }
    __syncthreads();
    for (int round = 0;; ++round) {
        __syncthreads();
        if (tid == 0) misc[0] = (round == 0 && (int)blockIdx.x >= nscan) ? (int)blockIdx.x - nscan : (int)((int)gridDim.x - nscan + (int)atomicAdd(QH, 1u));
        __syncthreads();
        const int it = misc[0];
        if (it >= 256) break;
        const int h = misc[4 + (it >> 6)], qb = 63 - (it & 63), P0 = qb * 256;
        if (wave == 0) {
            const float* Fh = F + (size_t)h * SEQ;
            float mq = 0.f, md = 3.0e38f;
            if (lane < 32) { mq = TB[(qb * 32 + lane) * 12 + h]; md = TB[(qb * 32 + lane) * 12 + 8 + h]; }
            for (int o_ = 1; o_ < 64; o_ <<= 1) { mq = fmaxf(mq, __shfl_xor(mq, o_)); md = fminf(md, __shfl_xor(md, o_)); }
            const float qkb = sqrtf(mq * qkbs[h]) * fox::SCALE, lim = Fh[P0] + qkb - md * fox::SCALE + 32.f;
            const int jd = P0 / 64, stride = jd / 64 + 1;
            int j = lane * stride; bool ok = (j > jd) ? true : (Fh[64 * j + 63] <= lim);
            unsigned long long mk = __ballot(ok); const int first = mk ? __builtin_ctzll(mk) : 64;
            const int lo_ex = first == 0 ? -1 : (first - 1) * stride; int hi_in = (first < 64 && first * stride <= jd) ? first * stride : jd;
            j = lo_ex + 1 + lane; ok = (j < hi_in) ? (Fh[64 * j + 63] <= lim) : false;
            mk = __ballot(ok); const int jlo = mk ? lo_ex + 1 + __builtin_ctzll(mk) : hi_in;
            if (lane == 0) misc[1] = jlo;
        }
        __syncthreads();
        fox::fox_block(a, lds, h, P0, misc[1]);
    }
}
DI void ph4(const Args& a, float* lds) {
    const int nscan = (int)gridDim.x >= 2 * NSCAN ? NSCAN : 0;
    for (int chain = blockIdx.x; chain < NSCAN; chain += gridDim.x) scanA_chain(a, (char*)lds, chain);
    ph4_fox(a, (char*)lds, nscan);
}
DI void ph5_scan(const Args& a, float* lds) {
    for (int chain = blockIdx.x; chain < NSCAN; chain += gridDim.x) scanPC_chain(a, (char*)lds, chain);
}

DI void ph5(const Args& a) {
    const int lane = threadIdx.x & 63, wave = threadIdx.x >> 6, NW = gridDim.x * NWAVES;
    const float* ORAW = (const float*)(a.ws + WS_ORAW); const bf16_t* P = (const bf16_t*)(a.ws + WS_PROJ); bf16_t* OA = (bf16_t*)(a.ws + WS_OA);
    const float g0 = a.in[I_GON][lane], g1 = a.in[I_GON][lane + 64];
    for (int id = blockIdx.x * NWAVES + wave; id < SEQ * 4; id += NW) { const int t = id >> 2, h = id & 3;
        const float o0 = ORAW[(size_t)t * 512 + h * 128 + lane], o1 = ORAW[(size_t)t * 512 + h * 128 + 64 + lane];
        const float rstd = rsqrtf(wave_sum(o0 * o0 + o1 * o1) * (1.f / 128.f) + 1e-6f);
        const float z0 = bf2f(P[(size_t)t * NPJ + PJ_DZ + h * 128 + lane]), z1 = bf2f(P[(size_t)t * NPJ + PJ_DZ + h * 128 + 64 + lane]);
        OA[(size_t)t * 512 + h * 128 + lane] = f2bf(o0 * rstd * g0 * siluf(z0)); OA[(size_t)t * 512 + h * 128 + 64 + lane] = f2bf(o1 * rstd * g1 * siluf(z1)); }
}

DI void ph6(const Args& a, unsigned char* ldsb) {
    const bf16_t* P = (const bf16_t*)(a.ws + WS_PROJ);
    pg8::OrderDense S; S.init(SEQ / 256, DM / 256, (int)gridDim.x, (int)blockIdx.x);
    { pg8::Gemm g{(const bf16_t*)(a.ws + WS_OA), (const bf16_t*)(a.ws + WS_WOAT), SEQ, DM, 512};
      pg8::EpiMerge<0> E{P + PJ_GA, (float*)(a.ws + WS_X1), (bf16_t*)(a.ws + WS_MRG)};
      pg8::gemm_phase<pg8::EpiMerge<0>, pg8::OrderDense>((LAS unsigned char*)ldsb, g, S, E); }
    __syncthreads();
    { pg8::Gemm g{(const bf16_t*)(a.ws + WS_OB), (const bf16_t*)(a.ws + WS_WOBT), SEQ, DM, 512};
      pg8::EpiMerge<1> E{P + PJ_GB, (float*)(a.ws + WS_X1), (bf16_t*)(a.ws + WS_MRG)};
      pg8::gemm_phase<pg8::EpiMerge<1>, pg8::OrderDense>((LAS unsigned char*)ldsb, g, S, E); }
}

DI void ph7(const Args& a, unsigned char* ldsb) {
    pg8::Gemm g{(const bf16_t*)(a.ws + WS_MRG), (const bf16_t*)(a.ws + WS_WOUTT), SEQ, DM, DM};
    pg8::OrderDense S; S.init(SEQ / 256, DM / 256, (int)gridDim.x, (int)blockIdx.x);
    pg8::EpiResid E{a.in[I_X], (const float*)(a.ws + WS_MOD) + 2048, (float*)(a.ws + WS_X1)};
    pg8::gemm_phase<pg8::EpiResid, pg8::OrderDense>((LAS unsigned char*)ldsb, g, S, E);
}

DI void ph8(const Args& a, float* lds) {
    const int tid = threadIdx.x, lane = tid & 63, wave = tid >> 6, G = gridDim.x;
    constexpr int HP = 1028;
    float* A2 = lds; float* B2 = lds + 1024; float* hs = lds + 2048; float* lgs = hs + 16 * HP;
    const float* mod = (const float*)(a.ws + WS_MOD);
    for (int k = tid; k < DM; k += NTHREADS) { A2[k] = a.in[I_G2][k] * (1.f + mod[4096 + k]); B2[k] = mod[3072 + k]; }
    const float* X1 = (const float*)(a.ws + WS_X1); bf16_t* H2 = (bf16_t*)(a.ws + WS_H2);
    int* TOKE = (int*)(a.ws + WS_TOKE); int* TOKS = (int*)(a.ws + WS_TOKS); float* TOKG = (float*)(a.ws + WS_TOKG); unsigned* CNT = (unsigned*)(a.ws + WS_CNT);
    const float* wr = a.in[I_WR];
    float* part = lgs + 512; int* lcnt = (int*)(part + 8 * 16 * 32);
    float wb0[32], wb1[32];
#pragma unroll
    for (int s = 0; s < 32; ++s) { const size_t k = (size_t)(128 * wave + 4 * s + (lane >> 4)); wb0[s] = wr[k * NE + (lane & 15)]; wb1[s] = wr[k * NE + 16 + (lane & 15)]; }
    for (int tile = blockIdx.x; tile < SEQ / 16; tile += G) {
        __syncthreads();
#pragma unroll 1
        for (int q = 0; q < 2; ++q) { const int tt = wave * 2 + q, t = tile * 16 + tt; const float* xr = X1 + (size_t)t * DM;
            f32x4 v[4]; float ss = 0.f;
#pragma unroll
            for (int i = 0; i < 4; ++i) { v[i] = *(const f32x4*)(xr + lane * 4 + 256 * i); ss += v[i][0] * v[i][0] + v[i][1] * v[i][1] + v[i][2] * v[i][2] + v[i][3] * v[i][3]; }
            ss = wave_sum(ss);
            const float rstd = rsqrtf(ss * (1.f / DM) + 1e-6f);
#pragma unroll
            for (int i = 0; i < 4; ++i) { const int k = lane * 4 + 256 * i;
#pragma unroll
                for (int e = 0; e < 4; ++e) v[i][e] = v[i][e] * rstd * A2[k + e] + B2[k + e];
                *(f32x4*)(hs + tt * HP + k) = v[i];
                u32x2 w; w.x = cvt_pk(v[i][0], v[i][1]); w.y = cvt_pk(v[i][2], v[i][3]);
                *(u32x2*)(H2 + (size_t)t * DM + k) = w; } }
        __syncthreads();
        {
            if (tid < 32) lcnt[tid] = 0;
            f32x4 c0 = (f32x4){0.f, 0.f, 0.f, 0.f}, c1 = c0; const float* ha = hs + (lane & 15) * HP + 128 * wave + (lane >> 4);
#pragma unroll
            for (int s = 0; s < 32; ++s) { const float av = ha[4 * s];
                c0 = __builtin_amdgcn_mfma_f32_16x16x4f32(av, wb0[s], c0, 0, 0, 0); c1 = __builtin_amdgcn_mfma_f32_16x16x4f32(av, wb1[s], c1, 0, 0, 0); }
#pragma unroll
            for (int r = 0; r < 4; ++r) { part[(wave * 16 + 4 * (lane >> 4) + r) * 32 + (lane & 15)] = c0[r]; part[(wave * 16 + 4 * (lane >> 4) + r) * 32 + 16 + (lane & 15)] = c1[r]; }
            __syncthreads();
            const int tt = tid >> 5, e = tid & 31; float acc = a.in[I_BR][e];
#pragma unroll
            for (int w = 0; w < 8; ++w) acc += part[(w * 16 + tt) * 32 + e];
            lgs[tt * 32 + e] = acc; }
        __syncthreads();
        { const int e = lane & 31, tt = wave * 2 + (lane >> 5), t = tile * 16 + tt;
            float cur = lgs[tt * 32 + e];
#define TOP1(TV, TI) float TV = cur; int TI = e; for (int o_ = 1; o_ <= 16; o_ <<= 1) { const float ov = __shfl_xor(TV, o_); const int oi = __shfl_xor(TI, o_); if (ov > TV || (ov == TV && oi < TI)) { TV = ov; TI = oi; } } if (e == TI) cur = -__builtin_inff();
            TOP1(tv0, ti0) TOP1(tv1, ti1) TOP1(tv2, ti2) TOP1(tv3, ti3)
#undef TOP1
            const float ex0 = 1.f, ex1 = expf(tv1 - tv0), ex2 = expf(tv2 - tv0), ex3 = expf(tv3 - tv0), den = ex0 + ex1 + ex2 + ex3;
            if (e < 4) { int ee = ti0; float gg = ex0;
                if (e == 1) { ee = ti1; gg = ex1; } if (e == 2) { ee = ti2; gg = ex2; } if (e == 3) { ee = ti3; gg = ex3; }
                const int rank = atomicAdd(lcnt + ee, 1);
                TOKE[t * 4 + e] = ee; TOKS[t * 4 + e] = rank; TOKG[t * 4 + e] = gg / den; } }
        __syncthreads();
        if (tid < 32) ((int*)(a.ws + WS_TCNT))[tile * 32 + tid] = lcnt[tid];
    }
}

DI void pad_starts(const Args& a, int* ps) {
    if (threadIdx.x == 0) { const unsigned* CNT = (const unsigned*)(a.ws + WS_CNT); int s = 0; for (int e = 0; e < NE; ++e) { ps[e] = s; s += (int)((CNT[e] + 255u) / 256u) * 256; } ps[NE] = s; }
    __syncthreads();
}
DI void ph9(const Args& a, float* lds) {
    const int tid = threadIdx.x, lane = tid & 63, wave = tid >> 6, G = gridDim.x;
    int* tab = (int*)lds; int* segs = tab + 32768; int* segoff = segs + 512; int* ps = segoff + 512; int* basel = ps + 64;
    const int* TCNT = (const int*)(a.ws + WS_TCNT);
    for (int i = tid; i < 8192; i += NTHREADS) ((u32x4*)tab)[i] = ((const u32x4*)TCNT)[i];
    __syncthreads();
    { const int e = tid & 31, sg = tid >> 5; int s = 0;
#pragma unroll 8
        for (int q = 0; q < 64; ++q) s += tab[(sg * 64 + q) * 32 + e];
        segs[sg * 32 + e] = s; }
    __syncthreads();
    if (tid < 32) { int run = 0; for (int sg = 0; sg < 16; ++sg) { segoff[sg * 32 + tid] = run; run += segs[sg * 32 + tid]; }
        segs[tid] = run;
        if (blockIdx.x == 0) ((unsigned*)(a.ws + WS_CNT))[tid] = (unsigned)run; }
    __syncthreads();
    if (tid == 0) { int s = 0; for (int e = 0; e < NE; ++e) { ps[e] = s; s += ((segs[e] + 255) / 256) * 256; } ps[NE] = s; }
    __syncthreads();
    const int* TOKE = (const int*)(a.ws + WS_TOKE); int* TOKS = (int*)(a.ws + WS_TOKS);
    const bf16_t* H2 = (const bf16_t*)(a.ws + WS_H2); bf16_t* XG = (bf16_t*)(a.ws + WS_XG);
    for (int tile = blockIdx.x; tile < SEQ / 16; tile += G) {
        __syncthreads();
        if (tid < 32) { int b = segoff[(tile >> 6) * 32 + tid]; for (int q = (tile >> 6) * 64; q < tile; ++q) b += tab[q * 32 + tid]; basel[tid] = ps[tid] + b; }
        __syncthreads();
#pragma unroll 1
        for (int q = 0; q < 8; ++q) { const int id = tile * 64 + wave * 8 + q, t = id >> 2;
            const size_t row = (size_t)(basel[TOKE[id]] + TOKS[id]);
            const u32x4 v0 = *(const u32x4*)(H2 + (size_t)t * DM + lane * 8), v1 = *(const u32x4*)(H2 + (size_t)t * DM + 512 + lane * 8);
            *(u32x4*)(XG + row * DM + lane * 8) = v0; *(u32x4*)(XG + row * DM + 512 + lane * 8) = v1;
            if (lane == 0) TOKS[id] = (int)row; }
    }
}
DI int expert_of(const int* ps, int row0) { int e = 0; for (int i = 1; i < NE; ++i) if (row0 >= ps[i]) e = i; return e; }
DI void ph10(const Args& a, unsigned char* ldsb) {
    int* ps = (int*)(ldsb + 131072); pad_starts(a, ps);
    pg8::Gemm g{(const bf16_t*)(a.ws + WS_XG), (const bf16_t*)(a.ws + WS_WGUT), 0, 2048, DM};
    pg8::OrderGrouped S; S.init(ps[NE] / 256, 8, (int)gridDim.x, (int)blockIdx.x); S.ps = (const LAS int*)ps;
    pg8::EpiSwiglu E{(bf16_t*)(a.ws + WS_ACT), a.in[I_BGU]};
    pg8::gemm_phase<pg8::EpiSwiglu, pg8::OrderGrouped>((LAS unsigned char*)ldsb, g, S, E);
}
DI void ph11(const Args& a, unsigned char* ldsb) {
    int* ps = (int*)(ldsb + 131072); pad_starts(a, ps);
    pg8::Gemm g{(const bf16_t*)(a.ws + WS_ACT), (const bf16_t*)(a.ws + WS_WDT), 0, DM, DM};
    pg8::OrderGrouped S; S.init(ps[NE] / 256, 4, (int)gridDim.x, (int)blockIdx.x); S.ps = (const LAS int*)ps;
    pg8::EpiStoreBf16 E{(bf16_t*)(a.ws + WS_YB), DM, a.in[I_BD], DM};
    pg8::gemm_phase<pg8::EpiStoreBf16, pg8::OrderGrouped>((LAS unsigned char*)ldsb, g, S, E);
}
DI void ph12(const Args& a, float* lds) {
    int* ps = (int*)lds; pad_starts(a, ps);
    const int lane = threadIdx.x & 63, wave = threadIdx.x >> 6, G = gridDim.x;
    const float* X1 = (const float*)(a.ws + WS_X1); const bf16_t* YB = (const bf16_t*)(a.ws + WS_YB); const float* mod = (const float*)(a.ws + WS_MOD);
    const int* TOKE = (const int*)(a.ws + WS_TOKE); const int* TOKS = (const int*)(a.ws + WS_TOKS); const float* TOKG = (const float*)(a.ws + WS_TOKG);
    for (int t = blockIdx.x * NWAVES + wave; t < SEQ; t += G * NWAVES) {
        size_t rows[4]; float gk[4];
#pragma unroll
        for (int q = 0; q < 4; ++q) { rows[q] = (size_t)TOKS[t * 4 + q]; gk[q] = TOKG[t * 4 + q]; }
        f32x4 v[4]; float ss = 0.f;
#pragma unroll
        for (int i = 0; i < 4; ++i) { const int k = lane * 4 + 256 * i; v[i] = *(const f32x4*)(X1 + (size_t)t * DM + k);
            f32x4 y = (f32x4){0.f, 0.f, 0.f, 0.f};
#pragma unroll
            for (int q = 0; q < 4; ++q) { const u32x2 w = *(const u32x2*)(YB + rows[q] * DM + k);
                y[0] += gk[q] * __uint_as_float(w.x << 16); y[1] += gk[q] * __uint_as_float(w.x & 0xffff0000u); y[2] += gk[q] * __uint_as_float(w.y << 16); y[3] += gk[q] * __uint_as_float(w.y & 0xffff0000u); }
#pragma unroll
            for (int q = 0; q < 4; ++q) { v[i][q] += mod[5120 + k + q] * y[q]; ss += v[i][q] * v[i][q]; } }
        ss = wave_sum(ss);
        const float rstd = rsqrtf(ss * (1.f / DM) + 1e-6f);
#pragma unroll
        for (int i = 0; i < 4; ++i) { const int k = lane * 4 + 256 * i; f32x4 o;
#pragma unroll
            for (int q = 0; q < 4; ++q) o[q] = v[i][q] * rstd * a.in[I_GF][k + q];
            *(f32x4*)(a.out + (size_t)t * DM + k) = o; }
    }
}

__global__ void __launch_bounds__(NTHREADS, 2) hybrid_fwd(Args a) {
    extern __shared__ __attribute__((aligned(16))) unsigned char lds_raw[];
    float* lds = (float*)(lds_raw + 16);
    LAS unsigned* xbw = (LAS unsigned*)lds_raw;
    if (threadIdx.x == 0) { xbw[0] = 0u; xbw[1] = 0u; xbw[2] = 0u; xbw[3] = 0u; }
    __syncthreads();
    XcdBarrier bar; bar.bar = (unsigned*)(a.ws + WS_BAR); bar.x = 0; bar.st = (volatile LAS unsigned*)xbw;
    const int lo = a.ph_lo, hi = a.ph_hi;
    if (hi - lo > 1) bar = xcd_barrier_post((unsigned*)(a.ws + WS_BAR), (volatile LAS unsigned*)xbw);
#define IN(k) (lo <= (k) && (k) < hi)
#define SEAM(k) do { if (IN(k) && IN((k) + 1)) xcd_barrier(bar); } while (0)
    if (IN(0)) ph0(a, lds);
    SEAM(0);
    if (IN(1)) ph1(a, lds);
    SEAM(1);
    if (IN(2)) ph2(a, lds_raw + 16);
    SEAM(2);
    if (IN(3)) ph3(a, lds);
    SEAM(3);
    if (IN(4)) ph4(a, lds);
    SEAM(4);
    if (IN(5)) ph5_scan(a, lds);
    SEAM(5);
    if (IN(6)) ph5(a);
    SEAM(6);
    if (IN(7)) ph6(a, lds_raw + 16);
    SEAM(7);
    if (IN(8)) ph7(a, lds_raw + 16);
    SEAM(8);
    if (IN(9)) ph8(a, lds);
    SEAM(9);
    if (IN(10)) ph9(a, lds);
    SEAM(10);
    if (IN(11)) ph10(a, lds_raw + 16);
    SEAM(11);
    if (IN(12)) ph11(a, lds_raw + 16);
    SEAM(12);
    if (IN(13)) ph12(a, lds);
#undef IN
#undef SEAM
}

extern "C" void kernel_launch(void* const* d_in, const int* in_sizes, int n_in, void* d_out, int out_size, void* d_ws, size_t ws_size, hipStream_t stream) {
    static int grid = 0;
    if (grid == 0) {
        if (n_in != 22 || out_size != SEQ * DM || ws_size < WS_END) { fprintf(stderr, "kernel_launch: unexpected shapes (n_in %d out %d ws %zu, need %zu)\n", n_in, out_size, ws_size, (size_t)WS_END); grid = -1; return; }
        int dev = 0, cus = 0, per_cu = 0;
        if (hipGetDevice(&dev) != hipSuccess || hipDeviceGetAttribute(&cus, hipDeviceAttributeMultiprocessorCount, dev) != hipSuccess) { grid = -1; return; }
        if (hipFuncSetAttribute((const void*)hybrid_fwd, hipFuncAttributeMaxDynamicSharedMemorySize, LDS_BYTES) != hipSuccess) { fprintf(stderr, "kernel_launch: hipFuncSetAttribute failed\n"); grid = -1; return; }
        if (hipOccupancyMaxActiveBlocksPerMultiprocessor(&per_cu, (const void*)hybrid_fwd, NTHREADS, LDS_BYTES) != hipSuccess || per_cu < 1) { fprintf(stderr, "kernel_launch: occupancy query says %d\n", per_cu); }
        (void)hipGetLastError();
        grid = cus;
    }
    if (grid < 0) return;
    (void)hipMemsetAsync(d_ws, 0, CTL_ZERO, stream);
    Args a{};
    for (int i = 0; i < 22; ++i) a.in[i] = (const float*)d_in[i];
    a.out = (float*)d_out; a.ws = (unsigned char*)d_ws;
#if N_LAUNCHES == 1
    a.ph_lo = 0; a.ph_hi = NPHASES;
    hipLaunchKernelGGL(hybrid_fwd, dim3(grid), dim3(NTHREADS), LDS_BYTES, stream, a);
#else
    for (int p = 0; p < NPHASES; ++p) { a.ph_lo = p; a.ph_hi = p + 1; hipLaunchKernelGGL(hybrid_fwd, dim3(grid), dim3(NTHREADS), LDS_BYTES, stream, a); }
#endif
}
```

```cpp
#include <hip/hip_runtime.h>
#include <stdint.h>
#include <stdio.h>

#ifndef N_LAUNCHES
#define N_LAUNCHES 1
#endif

#define DI __device__ __forceinline__
#define LAS __attribute__((address_space(3)))
typedef unsigned short bf16_t;
typedef short bf16x8 __attribute__((ext_vector_type(8)));
typedef float f32x4 __attribute__((ext_vector_type(4)));
typedef unsigned u32x4 __attribute__((ext_vector_type(4)));
typedef unsigned u32x2 __attribute__((ext_vector_type(2)));

constexpr int SEQ = 16384, DM = 1024, NIN = 5644, NPJ = 5632, NE = 32, TOPK = 4;
constexpr int NH = 4, HD = 128, CH = 64, NCH = SEQ / CH;
constexpr int PJ_DQ = 0, PJ_DK = 512, PJ_DV = 1024, PJ_DZ = 1536, PJ_FQ = 2048, PJ_FK = 2560, PJ_FV = 3072, PJ_GA = 3584, PJ_GB = 4608;
constexpr int NTHREADS = 512, NWAVES = 8;
constexpr int LDS_BYTES = 152 * 1024;
constexpr int NPHASES = 14;

constexpr size_t MiB = 1u << 20;
constexpr size_t WS_BAR = 0;
constexpr size_t WS_CNT = 32768;
constexpr size_t WS_NRM = 32768 + 256;
constexpr size_t WS_QH = 32768 + 512;
constexpr size_t CTL_ZERO = 65536;
constexpr size_t WS_MOD = 65536;
constexpr size_t WS_F = WS_MOD + 32768;
constexpr size_t WS_EG = WS_F + 262144;
constexpr size_t WS_TOKE = WS_EG + 4096;
constexpr size_t WS_TOKS = WS_TOKE + 262144;
constexpr size_t WS_TOKG = WS_TOKS + 262144;
constexpr size_t WS_SP = WS_TOKG + 262144;
constexpr size_t WS_WINT = WS_SP + MiB;
constexpr size_t WS_WOAT = WS_WINT + (size_t)NPJ * DM * 2;
constexpr size_t WS_WOBT = WS_WOAT + MiB;
constexpr size_t WS_WOUTT = WS_WOBT + MiB;
constexpr size_t WS_WGUT = WS_WOUTT + 2 * MiB;
constexpr size_t WS_WDT = WS_WGUT + 128 * MiB;
constexpr size_t WS_X1 = WS_WDT + 64 * MiB;
constexpr size_t WS_H2 = WS_X1 + 64 * MiB;
constexpr size_t WS_MRG = WS_H2 + 32 * MiB;
constexpr size_t WS_RA = WS_MRG + 32 * MiB;
constexpr size_t WS_RB = WS_RA + 176 * MiB;
constexpr size_t WS_H = WS_RB;
constexpr size_t WS_DNW = WS_H + 32 * MiB;
constexpr size_t WS_DNU = WS_DNW + 16 * MiB;
constexpr size_t WS_DNQD = WS_DNU + 16 * MiB;
constexpr size_t WS_DNKD = WS_DNQD + 16 * MiB;
constexpr size_t WS_DNATT = WS_DNKD + 16 * MiB;
constexpr size_t WS_ORAW = WS_DNATT + 8 * MiB;
constexpr size_t WS_OA = WS_ORAW + 32 * MiB;
constexpr size_t WS_OB = WS_OA + 16 * MiB;
constexpr size_t WS_VT = WS_OB + 16 * MiB;
constexpr size_t WS_PG = WS_VT;
constexpr size_t WS_QG = WS_PG + 2 * MiB;
constexpr size_t WS_SG = WS_QG + 4 * MiB;
constexpr size_t WS_TCNT = WS_SG + 4 * MiB;
constexpr size_t WS_NRMT = WS_TCNT + 131072;
constexpr size_t WS_END = WS_RB + 184 * MiB;
constexpr size_t WS_XG = WS_RA, WS_YB = WS_RA, WS_ACT = WS_RB, WS_PROJ = WS_RA;
static_assert(WS_VT + 16 * MiB <= WS_END, "region B");

struct Args { const float* in[22]; float* out; unsigned char* ws; int ph_lo, ph_hi; };
enum { I_X = 0, I_C, I_WADA, I_BADA, I_G1, I_WIN, I_CONVW, I_ALOG, I_DTB, I_GON, I_BFG, I_WOD, I_WOF, I_WOUT, I_G2, I_WR, I_BR, I_WGU, I_BGU, I_WD, I_BD, I_GF };

DI float bf2f(bf16_t v) { return __uint_as_float(((unsigned)v) << 16); }
DI bf16_t f2bf(float f) { unsigned u = __float_as_uint(f); u += 0x7fffu + ((u >> 16) & 1u); return (bf16_t)(u >> 16); }
typedef float f32x2_t __attribute__((ext_vector_type(2)));
typedef __bf16 bf16x2_t __attribute__((ext_vector_type(2)));
DI unsigned cvt_pk(float lo, float hi) { const f32x2_t v = {lo, hi}; const bf16x2_t b = __builtin_convertvector(v, bf16x2_t); return __builtin_bit_cast(unsigned, b); }
DI unsigned pk2(float lo, float hi) { return (unsigned)f2bf(lo) | ((unsigned)f2bf(hi) << 16); }
DI float sigm(float x) { return 1.f / (1.f + expf(-x)); }
DI float siluf(float x) { return x / (1.f + expf(-x)); }
DI float softplusf(float x) { return fmaxf(x, 0.f) + log1pf(expf(-fabsf(x))); }
DI float logsigf(float x) { return fminf(x, 0.f) - log1pf(expf(-fabsf(x))); }
DI float wave_sum(float v) { for (int o = 32; o >= 1; o >>= 1) v += __shfl_xor(v, o); return v; }
#define MFMA16(a, b, c) __builtin_amdgcn_mfma_f32_16x16x32_bf16((a), (b), (c), 0, 0, 0)

DI int gu_src(int n) { const int g = n >> 8, r = n & 255; return r < 128 ? 128 * g + r : 1024 + 128 * g + (r - 128); }

#define XB_TMO      128
#define XB_XCNT(j)  (256  + 64 * (j))
#define XB_XSUB(j)  (1280 + 64 * (j))
#define XB_XGEN(j)  (2304 + 64 * (j))
#define XB_TOP      3328
#define XB_TOPGEN   3392
#define XCD_BAR_WORDS 3456
#define XB_SPIN_CAP (1u << 22)
DI unsigned xb_ld(unsigned* p)              { return __hip_atomic_load(p, __ATOMIC_RELAXED, __HIP_MEMORY_SCOPE_AGENT); }
DI unsigned xb_add(unsigned* p, unsigned v) { return __hip_atomic_fetch_add(p, v, __ATOMIC_RELAXED, __HIP_MEMORY_SCOPE_AGENT); }
DI unsigned xb_xcc_id() { return (unsigned)__builtin_amdgcn_s_getreg((3 << 11) | 20) & 0xFu; }
#define XB_SPIN(cond, bar) do { unsigned _sp = 0; while (cond) { __builtin_amdgcn_s_sleep(1); \
    if ((++_sp & 255u) == 0u) { if (xb_ld(&(bar)[XB_TMO])) break; if (_sp > XB_SPIN_CAP) { atomicAdd(&(bar)[XB_TMO], 1u); break; } } } } while (0)
struct XcdBarrier { unsigned* bar; unsigned x; volatile LAS unsigned* st; };
DI XcdBarrier xcd_barrier_post(unsigned* bar, volatile LAS unsigned* st) {
    XcdBarrier b; b.bar = bar; b.x = xb_xcc_id(); b.st = st;
    if (threadIdx.x == 0) (void)xb_add(&bar[XB_XCNT(b.x)], 1u);
    return b;
}
DI void xcd_barrier_complete(unsigned* bar, unsigned x, unsigned& nloc, unsigned& nx) {
    const unsigned G = gridDim.x * gridDim.y * gridDim.z;
    unsigned sum, cnt, mine, sp = 0u;
    for (;;) {
        sum = 0u; cnt = 0u; mine = 0u;
#pragma unroll
        for (unsigned j = 0; j < 16; ++j) { const unsigned c = xb_ld(&bar[XB_XCNT(j)]); sum += c; cnt += (c > 0u) ? 1u : 0u; mine = (j == x) ? c : mine; }
        if (sum == G) break;
        __builtin_amdgcn_s_sleep(1);
        if ((++sp & 255u) == 0u) { if (xb_ld(&bar[XB_TMO])) break; if (sp > XB_SPIN_CAP) { atomicAdd(&bar[XB_TMO], 1u); break; } }
    }
    nloc = mine > 0u ? mine : 1u; nx = cnt > 0u ? cnt : 1u;
}
DI void xcd_barrier(const XcdBarrier& b) {
    asm volatile("s_waitcnt vmcnt(0)" ::: "memory");
    __syncthreads();
    if (threadIdx.x == 0) {
        unsigned* bar = b.bar;
        __builtin_amdgcn_s_waitcnt(0);
        unsigned nloc = b.st[0], nx = b.st[1];
        if (nloc == 0u) { xcd_barrier_complete(bar, b.x, nloc, nx); b.st[0] = nloc; b.st[1] = nx; }
        const unsigned old = xb_add(&bar[XB_XSUB(b.x)], 1u);
        const unsigned gen = old / nloc;
        if (old + 1u == (gen + 1u) * nloc) {
            __builtin_amdgcn_fence(__ATOMIC_RELEASE, "agent");
            asm volatile("s_waitcnt vmcnt(0)" ::: "memory");
            const unsigned og = xb_add(&bar[XB_TOP], 1u);
            const unsigned tg = og / nx;
            if (og + 1u == (tg + 1u) * nx) xb_add(&bar[XB_TOPGEN], 1u);
            else XB_SPIN(xb_ld(&bar[XB_TOPGEN]) == tg, bar);
            __builtin_amdgcn_fence(__ATOMIC_ACQUIRE, "agent");
            xb_add(&bar[XB_XGEN(b.x)], 1u);
            asm volatile("s_waitcnt vmcnt(0)" ::: "memory");
        } else {
            XB_SPIN(xb_ld(&bar[XB_XGEN(b.x)]) == gen, bar);
            __builtin_amdgcn_fence(__ATOMIC_ACQUIRE, "agent");
            asm volatile("s_waitcnt vmcnt(0)" ::: "memory");
        }
    }
    __syncthreads();
}

template <int NT>
DI void wave_gemm(const bf16_t* const (&ap)[4], const bf16_t* const (&bp)[NT], int K, f32x4 (&acc)[4][NT]) {
    for (int k0 = 0; k0 < K; k0 += 32) {
        bf16x8 a[4], b[NT];
#pragma unroll
        for (int i = 0; i < 4; ++i) a[i] = *(const bf16x8*)(ap[i] + k0);
#pragma unroll
        for (int j = 0; j < NT; ++j) b[j] = *(const bf16x8*)(bp[j] + k0);
#pragma unroll
        for (int i = 0; i < 4; ++i)
#pragma unroll
            for (int j = 0; j < NT; ++j) acc[i][j] = MFMA16(a[i], b[j], acc[i][j]);
    }
}
template <int NT> DI void zero_acc(f32x4 (&acc)[4][NT]) {
#pragma unroll
    for (int i = 0; i < 4; ++i)
#pragma unroll
        for (int j = 0; j < NT; ++j) acc[i][j] = (f32x4){0.f, 0.f, 0.f, 0.f};
}


namespace pg8 {
struct Unit { int pm, pn, pb, e; };
struct Gemm { const bf16_t* A; const bf16_t* Bt; int M, N, K; };
constexpr int BM = 256, BK = 64, HALF = 128, HTB = HALF * BK * 2  , STAGE_BYTES = 8 * HTB, NXCD = 8, WGM = 8;

__host__ __device__ __forceinline__ int lds_byte(int r, int c) { const int st = (r >> 4) * 2 + (c >> 5), rr = r & 15, cc = c & 31, ob = rr * 64 + cc * 2; return st * 1024 + (ob ^ (((ob >> 9) & 1) << 5)); }
__host__ __device__ __forceinline__ void stage_rc(int b, int& R, int& C) { const int st = b / 1024, sb = b % 1024, swz = sb ^ (((sb >> 9) & 1) << 5); R = (st >> 1) * 16 + swz / 64; C = (st & 1) * 32 + (swz % 64) / 2; }
__host__ __device__ __forceinline__ int perm32(int rho) { const int n = rho >> 4, i = rho & 15; return 8 * (i >> 2) + 4 * n + (i & 3); }
template <class Epi, class Sched>
__device__ __forceinline__ void gemm_phase(LAS unsigned char* lds, const Gemm g, const Sched& S, const Epi& E) {
    const int tid = threadIdx.x, wid = __builtin_amdgcn_readfirstlane(tid >> 6), lane = tid & 63, wr = wid >> 2, wc = wid & 3, fr = lane & 15, fq = lane >> 4;
    const int K = g.K, nt = K / BK;
    unsigned voffA[2], voffB[2];
#pragma unroll
    for (int i = 0; i < 2; ++i) { int R, C; stage_rc(tid * 16 + i * 8192, R, C); const int Rb = Epi::PERM ? ((R & ~31) + perm32(R & 31)) : R;
        voffA[i] = (unsigned)(R * K + C) * 2u; voffB[i] = (unsigned)(Rb * K + C) * 2u; }
    const size_t kstep = (size_t)(BK * 2);
    const size_t hstep = (size_t)HALF * K * 2;
    const size_t tstep = 2 * hstep;
    const unsigned ldsw = (unsigned)wid * 1024u;
    const int aoff = lds_byte(wr * 64 + fr, fq * 8), boff = lds_byte(wc * 32 + fr, fq * 8);
#define PG8_SA(b, h) (((b) * 2 + (h)) * HTB)
#define PG8_SB(b, h) ((4 + (b) * 2 + (h)) * HTB)
#define PG8_STAGE(bufoff, gbase, voff) do { _Pragma("unroll") for (int _i = 0; _i < 2; ++_i) \
        __builtin_amdgcn_global_load_lds((const unsigned*)((const char*)(gbase) + (voff)[_i]), (LAS unsigned*)(lds + (bufoff) + ldsw + _i * 8192), 16, 0, 0); } while (0)
#define PG8_LDA(dst, b, h) do { _Pragma("unroll") for (int m = 0; m < 4; ++m) _Pragma("unroll") for (int k = 0; k < 2; ++k) dst[m][k] = *(const LAS bf16x8*)(lds + PG8_SA(b, h) + aoff + m * 2048 + k * 1024); } while (0)
#define PG8_LDB(dst, b, h) do { _Pragma("unroll") for (int n = 0; n < 2; ++n) _Pragma("unroll") for (int k = 0; k < 2; ++k) dst[n][k] = *(const LAS bf16x8*)(lds + PG8_SB(b, h) + boff + n * 2048 + k * 1024); } while (0)
#define PG8_MMA(ai, bj, At, Bt) do { __builtin_amdgcn_s_setprio(1); _Pragma("unroll") for (int m = 0; m < 4; ++m) _Pragma("unroll") for (int n = 0; n < 2; ++n) _Pragma("unroll") for (int k = 0; k < 2; ++k) \
        acc[ai][bj][m][n] = __builtin_amdgcn_mfma_f32_16x16x32_bf16(Bt[n][k], At[m][k], acc[ai][bj][m][n], 0, 0, 0); __builtin_amdgcn_s_setprio(0); } while (0)
#define PG8_WAIT_V(n) asm volatile("s_waitcnt vmcnt(" #n ")" ::: "memory")
#define PG8_WAIT_L(n) asm volatile("s_waitcnt lgkmcnt(" #n ")" ::: "memory")
#define PG8_BAR __builtin_amdgcn_s_barrier()
#define PG8_SCHED __builtin_amdgcn_sched_barrier(0)
    Unit cur, nxt; int ui = 0;
    if (!S.next(0, cur)) return;
    f32x4 acc[2][2][4][2];
#pragma unroll
    for (int a = 0; a < 2; ++a)
#pragma unroll
        for (int b = 0; b < 2; ++b)
#pragma unroll
            for (int m = 0; m < 4; ++m)
#pragma unroll
                for (int n = 0; n < 2; ++n) acc[a][b][m][n] = (f32x4){0.f, 0.f, 0.f, 0.f};
    bf16x8 At[4][2], B0[2][2], B1[2][2];
    const char* cA = (const char*)g.A + (size_t)cur.pm * tstep; const char* cB = (const char*)g.Bt + (size_t)cur.pb * tstep;
    S.a_ready(cur);
    PG8_STAGE(PG8_SB(0, 0), cB, voffB); PG8_STAGE(PG8_SA(0, 0), cA, voffA); PG8_STAGE(PG8_SB(0, 1), cB + hstep, voffB); PG8_STAGE(PG8_SA(0, 1), cA + hstep, voffA);
    if (wr == 1) PG8_BAR;
    PG8_WAIT_V(4); PG8_BAR;
    PG8_STAGE(PG8_SB(1, 0), cB + kstep, voffB); PG8_STAGE(PG8_SA(1, 0), cA + kstep, voffA); PG8_STAGE(PG8_SB(1, 1), cB + hstep + kstep, voffB);
    PG8_WAIT_V(6); PG8_BAR;
    for (;;) {
        const bool has_next = S.next(ui + 1, nxt);
        const char* nA = has_next ? (const char*)g.A + (size_t)nxt.pm * tstep : cA; const char* nB = has_next ? (const char*)g.Bt + (size_t)nxt.pb * tstep : cB;
        for (int t = 0; t < nt; t += 2) {
            const bool last = (t == nt - 2);
            const char* a1 = cA + (size_t)(t + 1) * kstep;
            const char* a2 = last ? nA : cA + (size_t)(t + 2) * kstep; const char* b2 = last ? nB : cB + (size_t)(t + 2) * kstep;
            const char* a3 = a2 + kstep; const char* b3 = b2 + kstep;
            if (last && has_next) S.a_ready(nxt);
            PG8_LDB(B0, 0, 0); PG8_SCHED; PG8_LDA(At, 0, 0); PG8_STAGE(PG8_SA(1, 1), a1 + hstep, voffA);
            PG8_WAIT_L(8); PG8_BAR; PG8_WAIT_L(0); PG8_MMA(0, 0, At, B0); PG8_BAR; PG8_SCHED;
            PG8_LDB(B1, 0, 1); PG8_STAGE(PG8_SB(0, 0), b2, voffB);
            PG8_BAR; PG8_WAIT_L(0); PG8_MMA(0, 1, At, B1); PG8_BAR;
            PG8_LDA(At, 0, 1); PG8_STAGE(PG8_SA(0, 0), a2, voffA);
            PG8_BAR; PG8_WAIT_L(0); PG8_MMA(1, 0, At, B0); PG8_BAR; PG8_SCHED;
            PG8_STAGE(PG8_SB(0, 1), b2 + hstep, voffB);
            PG8_WAIT_V(6); PG8_BAR; PG8_MMA(1, 1, At, B1); PG8_BAR;
            PG8_LDB(B0, 1, 0); PG8_SCHED; PG8_LDA(At, 1, 0); PG8_STAGE(PG8_SA(0, 1), a2 + hstep, voffA);
            PG8_WAIT_L(8); PG8_BAR; PG8_WAIT_L(0); PG8_MMA(0, 0, At, B0); PG8_BAR; PG8_SCHED;
            PG8_LDB(B1, 1, 1); PG8_STAGE(PG8_SB(1, 0), b3, voffB);
            PG8_BAR; PG8_WAIT_L(0); PG8_MMA(0, 1, At, B1); PG8_BAR;
            PG8_LDA(At, 1, 1); PG8_STAGE(PG8_SA(1, 0), a3, voffA);
            PG8_BAR; PG8_WAIT_L(0); PG8_MMA(1, 0, At, B0); PG8_BAR; PG8_SCHED;
            PG8_STAGE(PG8_SB(1, 1), b3 + hstep, voffB);
            PG8_WAIT_V(6); PG8_BAR; PG8_MMA(1, 1, At, B1); PG8_BAR;
        }
        if constexpr (!Epi::AFTER_DRAIN) { E(acc, cur, wr, wc, fr, fq); S.done(cur); }
        if (!has_next) break;
#pragma unroll
        for (int a = 0; a < 2; ++a)
#pragma unroll
            for (int b = 0; b < 2; ++b)
#pragma unroll
                for (int m = 0; m < 4; ++m)
#pragma unroll
                    for (int n = 0; n < 2; ++n) acc[a][b][m][n] = (f32x4){0.f, 0.f, 0.f, 0.f};
        cur = nxt; cA = nA; cB = nB; ++ui;
    }
    PG8_WAIT_V(0);
    if (wr == 0) PG8_BAR;
    PG8_BAR;
    if constexpr (Epi::AFTER_DRAIN) { E.fused(acc, cur, wr, wc, fr, fq, lds, wid, lane); S.done(cur); }
#undef PG8_SA
#undef PG8_SB
#undef PG8_STAGE
#undef PG8_LDA
#undef PG8_LDB
#undef PG8_MMA
#undef PG8_WAIT_V
#undef PG8_WAIT_L
#undef PG8_BAR
#undef PG8_SCHED
}

DI unsigned cvt_pk_bf16(float lo, float hi) { return cvt_pk(lo, hi); }
DI float fsig(float x) { return __builtin_amdgcn_rcpf(1.f + __builtin_amdgcn_exp2f(-1.4426950408889634f * x)); }
DI int expert_of_l(const LAS int* ps, int row0) { int e = 0;
#pragma unroll 1
    for (int i = 1; i < NE; ++i) if (row0 >= ps[i]) e = i; return e; }
struct OrderDense {
    int nM, nN, nwg, G, c;
    DI void init(int nM_, int nN_, int G_, int c_) { nM = nM_; nN = nN_; nwg = nM * nN; G = G_; c = c_; }
    DI bool tile(int i, Unit& u) const {
        const long L = (long)i * G + c; if (L >= nwg) return false;
        int wgid = (int)L; { const int q = nwg / NXCD, r = nwg % NXCD, xcd = wgid % NXCD, off = wgid / NXCD; wgid = (xcd < r ? xcd * (q + 1) : r * (q + 1) + (xcd - r) * q) + off; }
        const int nig = WGM * nN, gid = wgid / nig, fm = gid * WGM, gsz = (nM - fm) < WGM ? (nM - fm) : WGM;
        u.pm = fm + ((wgid % nig) % gsz); u.pn = (wgid % nig) / gsz; return true;
    }
    DI bool next(int i, Unit& u) const { if (!tile(i, u)) return false; u.pb = u.pn; u.e = 0; return true; }
    DI void a_ready(const Unit&) const {}
    DI void done(const Unit&) const {}
};
struct OrderGrouped : OrderDense {
    const LAS int* ps;
    DI bool next(int i, Unit& u) const { if (!tile(i, u)) return false; u.e = expert_of_l(ps, u.pm * BM); u.pb = u.e * nN + u.pn; return true; }
};
struct EpiStoreBf16 {
    static constexpr bool PERM = true, AFTER_DRAIN = false;
    bf16_t* O; int ldc; const float* bias; int bstride;
    DI void operator()(const f32x4 (&acc)[2][2][4][2], const Unit& u, int wr, int wc, int fr, int fq) const {
        const int row0 = u.pm * BM + wr * 64 + fr, col0 = u.pn * BM + wc * 32 + 8 * fq;
        f32x4 bv[2][2];
#pragma unroll
        for (int bj = 0; bj < 2; ++bj)
#pragma unroll
            for (int n = 0; n < 2; ++n) bv[bj][n] = bias ? *(const f32x4*)(bias + (size_t)u.e * bstride + col0 + bj * HALF + 4 * n) : (f32x4){0.f, 0.f, 0.f, 0.f};
#pragma unroll
        for (int ai = 0; ai < 2; ++ai)
#pragma unroll
            for (int m = 0; m < 4; ++m) { bf16_t* rowp = O + (size_t)(row0 + ai * HALF + m * 16) * ldc + col0;
#pragma unroll
                for (int bj = 0; bj < 2; ++bj) { const f32x4 v0 = acc[ai][bj][m][0] + bv[bj][0], v1 = acc[ai][bj][m][1] + bv[bj][1];
                    u32x4 w; w.x = cvt_pk_bf16(v0[0], v0[1]); w.y = cvt_pk_bf16(v0[2], v0[3]); w.z = cvt_pk_bf16(v1[0], v1[1]); w.w = cvt_pk_bf16(v1[2], v1[3]);
                    *(u32x4*)(rowp + bj * HALF) = w; } }
    }
};
template <int SECOND> struct EpiMerge {
    static constexpr bool PERM = true, AFTER_DRAIN = false;
    const bf16_t* gate; float* T; bf16_t* O;
    DI void operator()(const f32x4 (&acc)[2][2][4][2], const Unit& u, int wr, int wc, int fr, int fq) const {
        const int row0 = u.pm * BM + wr * 64 + fr, col0 = u.pn * BM + wc * 32 + 8 * fq;
#pragma unroll
        for (int ai = 0; ai < 2; ++ai)
#pragma unroll
            for (int mp = 0; mp < 2; ++mp) {
                u32x4 g[2][2]; f32x4 t0[2][2], t1[2][2];
#pragma unroll
                for (int mm = 0; mm < 2; ++mm)
#pragma unroll
                    for (int bj = 0; bj < 2; ++bj) { const size_t row = (size_t)(row0 + ai * HALF + (2 * mp + mm) * 16); const int col = col0 + bj * HALF;
                        g[mm][bj] = *(const u32x4*)(gate + row * NPJ + col);
                        if (SECOND) { t0[mm][bj] = *(const f32x4*)(T + row * DM + col); t1[mm][bj] = *(const f32x4*)(T + row * DM + col + 4); } }
#pragma unroll
                for (int mm = 0; mm < 2; ++mm)
#pragma unroll
                    for (int bj = 0; bj < 2; ++bj) { const int m = 2 * mp + mm; const size_t row = (size_t)(row0 + ai * HALF + m * 16); const int col = col0 + bj * HALF;
                        const u32x4 gg = g[mm][bj]; f32x4 v0 = acc[ai][bj][m][0], v1 = acc[ai][bj][m][1];
                        v0[0] *= fsig(__uint_as_float(gg.x << 16)); v0[1] *= fsig(__uint_as_float(gg.x & 0xffff0000u)); v0[2] *= fsig(__uint_as_float(gg.y << 16)); v0[3] *= fsig(__uint_as_float(gg.y & 0xffff0000u));
                        v1[0] *= fsig(__uint_as_float(gg.z << 16)); v1[1] *= fsig(__uint_as_float(gg.z & 0xffff0000u)); v1[2] *= fsig(__uint_as_float(gg.w << 16)); v1[3] *= fsig(__uint_as_float(gg.w & 0xffff0000u));
                        if (SECOND == 0) { float* tp = T + row * DM + col; *(f32x4*)tp = v0; *(f32x4*)(tp + 4) = v1; }
                        else { v0 += t0[mm][bj]; v1 += t1[mm][bj];
                            u32x4 w; w.x = cvt_pk_bf16(v0[0], v0[1]); w.y = cvt_pk_bf16(v0[2], v0[3]); w.z = cvt_pk_bf16(v1[0], v1[1]); w.w = cvt_pk_bf16(v1[2], v1[3]);
                            *(u32x4*)(O + row * DM + col) = w; } }
            }
    }
};
struct EpiResid {
    static constexpr bool PERM = false, AFTER_DRAIN = false;
    const float* x; const float* gt; float* X1;
    DI void operator()(const f32x4 (&acc)[2][2][4][2], const Unit& u, int wr, int wc, int fr, int fq) const {
        const int row0 = u.pm * BM + wr * 64 + fr, col0 = u.pn * BM + wc * 32 + 4 * fq;
        f32x4 gv[2][2];
#pragma unroll
        for (int bj = 0; bj < 2; ++bj)
#pragma unroll
            for (int n = 0; n < 2; ++n) gv[bj][n] = *(const f32x4*)(gt + col0 + bj * HALF + n * 16);
#pragma unroll
        for (int ai = 0; ai < 2; ++ai)
#pragma unroll
            for (int mp = 0; mp < 2; ++mp) {
                f32x4 xv[2][2][2];
#pragma unroll
                for (int mm = 0; mm < 2; ++mm)
#pragma unroll
                    for (int bj = 0; bj < 2; ++bj)
#pragma unroll
                        for (int n = 0; n < 2; ++n) xv[mm][bj][n] = *(const f32x4*)(x + (size_t)(row0 + ai * HALF + (2 * mp + mm) * 16) * DM + col0 + bj * HALF + n * 16);
#pragma unroll
                for (int mm = 0; mm < 2; ++mm)
#pragma unroll
                    for (int bj = 0; bj < 2; ++bj)
#pragma unroll
                        for (int n = 0; n < 2; ++n) *(f32x4*)(X1 + (size_t)(row0 + ai * HALF + (2 * mp + mm) * 16) * DM + col0 + bj * HALF + n * 16) = xv[mm][bj][n] + gv[bj][n] * acc[ai][bj][2 * mp + mm][n];
            }
    }
};
struct EpiSwiglu {
    static constexpr bool PERM = true, AFTER_DRAIN = false;
    bf16_t* ACT; const float* bgu;
    DI void operator()(const f32x4 (&acc)[2][2][4][2], const Unit& u, int wr, int wc, int fr, int fq) const {
        const int row0 = u.pm * BM + wr * 64 + fr, gcol = u.pn * HALF + wc * 32 + 8 * fq;
        const float* bb = bgu + (size_t)u.e * 2048 + gcol;
        f32x4 bg[2], bu[2];
#pragma unroll
        for (int n = 0; n < 2; ++n) { bg[n] = *(const f32x4*)(bb + 4 * n); bu[n] = *(const f32x4*)(bb + 1024 + 4 * n); }
#pragma unroll
        for (int ai = 0; ai < 2; ++ai)
#pragma unroll
            for (int m = 0; m < 4; ++m) { float r[8];
#pragma unroll
                for (int n = 0; n < 2; ++n)
#pragma unroll
                    for (int j = 0; j < 4; ++j) { float g = acc[ai][0][m][n][j] + bg[n][j], up = acc[ai][1][m][n][j] + bu[n][j];
                        g = fminf(g, 7.f); up = fminf(fmaxf(up, -7.f), 7.f);
                        r[4 * n + j] = (up + 1.f) * (g * fsig(1.702f * g)); }
                u32x4 w; w.x = cvt_pk_bf16(r[0], r[1]); w.y = cvt_pk_bf16(r[2], r[3]); w.z = cvt_pk_bf16(r[4], r[5]); w.w = cvt_pk_bf16(r[6], r[7]);
                *(u32x4*)(ACT + (size_t)(row0 + ai * HALF + m * 16) * DM + gcol) = w; }
    }
};
}


namespace fox {
typedef float f32x16 __attribute__((ext_vector_type(16)));
typedef short s16x4 __attribute__((ext_vector_type(4)));
constexpr float SCALE = 0.08838834764831845f;
constexpr int KVBLK = 64, SHM_K = 16384, SHM_V = 16384;
constexpr int OFF_V = 0, OFF_K = 2 * SHM_V, OFF_G = OFF_K + 2 * SHM_K, OFF_WS = OFF_G + 512, OFF_MISC = OFF_WS + 8 * 256;
constexpr float THR = 8.f;
#define KSWZ(row, colB) ((row) * 256 + ((colB) ^ (((row) & 7) << 4)))
#define SBAR() __builtin_amdgcn_sched_barrier(0)
DI int v_st(int k, int c) { const int kk = (k & ~0xC) | ((k & 4) << 1) | ((k & 8) >> 1); return ((kk >> 3) * 4 + (c >> 5)) * 512 + ((kk & 7) * 32 + (c & 31)) * 2; }
DI int v_rd_base(int lane) { return ((lane & 3) << 3) | (((lane >> 2) & 3) << 6) | (((lane >> 4) & 1) << 5) | (((lane >> 5) & 1) << 8); }
constexpr int v_rd_off(int d0, int ks, int half) { return d0 * 512 + ks * 4096 + half * 2048; }
DI int crow(int r, int hi) { return (r & 3) + 8 * (r >> 2) + 4 * hi; }
DI unsigned cvtpk(float lo, float hi) { return cvt_pk(lo, hi); }
DI void mask_tile(f32x16& p0, f32x16& p1, int dq) {
    const float NEG = -__builtin_inff();
#pragma unroll
    for (int r = 0; r < 16; ++r) { const int c = (r & 3) + 8 * (r >> 2); if (dq - c < 0) p0[r] = NEG; if (dq - c - 32 < 0) p1[r] = NEG; }
}
DI void partialSM(f32x16& p0, f32x16& p1, float& m_reg, float& mn, float& alpha) {
    float pmax = p0[0];
#pragma unroll
    for (int r = 1; r < 16; ++r) pmax = fmaxf(pmax, p0[r]);
#pragma unroll
    for (int r = 0; r < 16; ++r) pmax = fmaxf(pmax, p1[r]);
    { auto rr = __builtin_amdgcn_permlane32_swap(__float_as_uint(pmax), __float_as_uint(pmax), false, false); pmax = fmaxf(__uint_as_float(rr[0]), __uint_as_float(rr[1])); }
    constexpr float C2 = 1.4426950408889634f * SCALE;
    if (__builtin_expect(__all((pmax - m_reg) * SCALE <= THR), 1)) { mn = m_reg; alpha = 1.f; }
    else { mn = fmaxf(m_reg, pmax); alpha = __builtin_amdgcn_exp2f((m_reg - mn) * C2); m_reg = mn; }
    const float mnL = -mn * C2;
#pragma unroll
    for (int r = 0; r < 16; ++r) p0[r] = fmaf(p0[r], C2, mnL);
#pragma unroll
    for (int r = 0; r < 16; ++r) p1[r] = fmaf(p1[r], C2, mnL);
#pragma unroll
    for (int r = 0; r < 16; ++r) p0[r] = __builtin_amdgcn_exp2f(p0[r]);
}
DI void finishSM(f32x16& p0, f32x16& p1, float alpha, float& l_reg, bf16x8& pa0, bf16x8& pa1, bf16x8& pa2, bf16x8& pa3) {
#pragma unroll
    for (int r = 0; r < 16; ++r) p1[r] = __builtin_amdgcn_exp2f(p1[r]);
    float ps = 0;
#pragma unroll
    for (int r = 0; r < 16; ++r) ps += p0[r];
#pragma unroll
    for (int r = 0; r < 16; ++r) ps += p1[r];
    { auto rr = __builtin_amdgcn_permlane32_swap(__float_as_uint(ps), __float_as_uint(ps), false, false); ps = __uint_as_float(rr[0]) + __uint_as_float(rr[1]); }
    l_reg = l_reg * alpha + ps;
#define PK4(P, B_, OUT) do { unsigned a0 = cvtpk(P[B_+0], P[B_+1]), a1 = cvtpk(P[B_+2], P[B_+3]);                          \
        unsigned b0 = cvtpk(P[B_+4], P[B_+5]), b1 = cvtpk(P[B_+6], P[B_+7]);                                             \
        auto r0 = __builtin_amdgcn_permlane32_swap(a0, b0, false, false); auto r1 = __builtin_amdgcn_permlane32_swap(a1, b1, false, false); \
        u32x4 w = {r0[0], r1[0], r0[1], r1[1]}; OUT = *reinterpret_cast<bf16x8*>(&w); } while (0)
    PK4(p0, 0, pa0); PK4(p0, 8, pa1); PK4(p1, 0, pa2); PK4(p1, 8, pa3);
#undef PK4
}
DI void qkt(f32x16& p0, f32x16& p1, const char* Kb, int r32, int hi, const bf16x8* qr) {
    p0 = f32x16{}; p1 = f32x16{};
    const char* kb[4];
#pragma unroll
    for (int dd = 0; dd < 4; ++dd) kb[dd] = Kb + KSWZ(r32, (dd * 16 + hi * 8) * 2);
#pragma unroll
    for (int d0 = 0; d0 < 8; ++d0) { const char* a = kb[d0 & 3] + (d0 >> 2) * 128;
        bf16x8 b0 = *reinterpret_cast<const bf16x8*>(a);
        bf16x8 b1 = *reinterpret_cast<const bf16x8*>(a + 32 * 256);
        p0 = __builtin_amdgcn_mfma_f32_32x32x16_bf16(b0, qr[d0], p0, 0, 0, 0);
        p1 = __builtin_amdgcn_mfma_f32_32x32x16_bf16(b1, qr[d0], p1, 0, 0, 0); }
}
DI void pv_tile(f32x16* o, int vb0, bf16x8 pa0, bf16x8 pa1, bf16x8 pa2, bf16x8 pa3) {
#define TRRD(dst, off) asm volatile("ds_read_b64_tr_b16 %0, %1 offset:%2" : "=&v"(dst) : "v"(vb0), "i"(off) : "memory")
#define PV_D0(d0) do { s16x4 l0, l1, l2, l3, h0, h1, h2, h3; constexpr int b_ = v_rd_off(d0, 0, 0); \
        TRRD(l0, b_); TRRD(h0, b_ + 2048); TRRD(l1, b_ + 4096); TRRD(h1, b_ + 6144); TRRD(l2, b_ + 8192); TRRD(h2, b_ + 10240); TRRD(l3, b_ + 12288); TRRD(h3, b_ + 14336); \
        asm volatile("s_waitcnt lgkmcnt(0)" ::: "memory"); SBAR();   \
        o[d0] = __builtin_amdgcn_mfma_f32_32x32x16_bf16(pa0, (bf16x8){l0[0], l0[1], l0[2], l0[3], h0[0], h0[1], h0[2], h0[3]}, o[d0], 0, 0, 0);   \
        o[d0] = __builtin_amdgcn_mfma_f32_32x32x16_bf16(pa1, (bf16x8){l1[0], l1[1], l1[2], l1[3], h1[0], h1[1], h1[2], h1[3]}, o[d0], 0, 0, 0);   \
        o[d0] = __builtin_amdgcn_mfma_f32_32x32x16_bf16(pa2, (bf16x8){l2[0], l2[1], l2[2], l2[3], h2[0], h2[1], h2[2], h2[3]}, o[d0], 0, 0, 0);   \
        o[d0] = __builtin_amdgcn_mfma_f32_32x32x16_bf16(pa3, (bf16x8){l3[0], l3[1], l3[2], l3[3], h3[0], h3[1], h3[2], h3[3]}, o[d0], 0, 0, 0); } while (0)
    PV_D0(0); PV_D0(1); PV_D0(2); PV_D0(3);
#undef PV_D0
#undef TRRD
}
DI void fox_block(const Args& a, char* lds, int h, int P0, int j_lo) {
    const int tid = threadIdx.x, wid = __builtin_amdgcn_readfirstlane(tid >> 6), lane = tid & 63, r32 = lane & 31, hi = lane >> 5;
    const bf16_t* P = (const bf16_t*)(a.ws + WS_PROJ); const float* F = (const float*)(a.ws + WS_F) + (size_t)h * SEQ; bf16_t* OB = (bf16_t*)(a.ws + WS_OB);
    const bf16_t* Qp = P + PJ_FQ + h * 128; const bf16_t* Kp = P + PJ_FK + h * 128; const bf16_t* Vp = P + PJ_FV + h * 128;
    const int j_hi = (P0 + 255) / KVBLK + 1, NT = j_hi - j_lo;
    const int qlo = P0 + wid * 32, qm = qlo + r32 - 4 * hi;
    char* V_lds = lds + OFF_V; char* K_lds = lds + OFF_K; float* G_lds = (float*)(lds + OFF_G);
    float* wsp = (float*)(lds + OFF_WS) + wid * 64; float* li_l = wsp; float* al_l = wsp + 32;
    const int sr = tid >> 4;
    const int vb0 = (int)(unsigned)(uintptr_t)(LAS char*)V_lds + v_rd_base(lane);
    const float Fref = F[P0];
    bf16x8 qr[8];
#pragma unroll
    for (int d0 = 0; d0 < 8; ++d0) qr[d0] = *(const bf16x8*)(Qp + (size_t)(qlo + r32) * NPJ + d0 * 16 + hi * 8);
    float m_reg = -1e30f, l_reg = 0.f; f32x16 o[4] = {};
    float st_g = 0.f;
    const int ksrc = (((tid & 15) * 16) ^ ((sr & 7) << 4)) >> 1;
    const int vkk = (tid >> 7) * 8 + ((tid & 31) >> 2), vkey = (vkk & ~0xC) | ((vkk & 4) << 1) | ((vkk & 8) >> 1), vcol = ((tid >> 5) & 3) * 32 + (tid & 3) * 8;
    LAS unsigned char* ldsl = (LAS unsigned char*)lds;
#define FOX_LOAD(t, bf) do { const size_t k0_ = (size_t)(j_lo + (t)) * KVBLK; \
        __builtin_amdgcn_global_load_lds((const unsigned*)(Kp + (k0_ + sr) * NPJ + ksrc), (LAS unsigned*)(ldsl + OFF_K + (bf) * SHM_K + wid * 1024), 16, 0, 0); \
        __builtin_amdgcn_global_load_lds((const unsigned*)(Kp + (k0_ + 32 + sr) * NPJ + ksrc), (LAS unsigned*)(ldsl + OFF_K + (bf) * SHM_K + 8192 + wid * 1024), 16, 0, 0); \
        __builtin_amdgcn_global_load_lds((const unsigned*)(Vp + (k0_ + vkey) * NPJ + vcol), (LAS unsigned*)(ldsl + OFF_V + (bf) * SHM_V + wid * 1024), 16, 0, 0); \
        __builtin_amdgcn_global_load_lds((const unsigned*)(Vp + (k0_ + 32 + vkey) * NPJ + vcol), (LAS unsigned*)(ldsl + OFF_V + (bf) * SHM_V + 8192 + wid * 1024), 16, 0, 0); \
        if (tid < 64) st_g = F[k0_ + tid]; } while (0)
#define FOX_WRITE(bf) do { if (tid < 64) G_lds[(bf) * 64 + tid] = (st_g - Fref) * (1.f / SCALE); } while (0)
    FOX_LOAD(0, 0); asm volatile("s_waitcnt vmcnt(0)" ::: "memory"); FOX_WRITE(0);
    __syncthreads();
    for (int t = 0; t < NT; ++t) {
        const int bf = t & 1, kb_ = (j_lo + t) * KVBLK;
        if (t + 1 < NT) FOX_LOAD(t + 1, bf ^ 1);
        if (kb_ <= qlo + 31) {
            f32x16 p0, p1; float mn, al; bf16x8 pa0, pa1, pa2, pa3;
            qkt(p0, p1, K_lds + bf * SHM_K, r32, hi, qr);
            const float* gt = G_lds + bf * 64 + 4 * hi;
#pragma unroll
            for (int g4 = 0; g4 < 4; ++g4) { const f32x4 g0 = *(const f32x4*)(gt + 8 * g4), g1 = *(const f32x4*)(gt + 32 + 8 * g4);
#pragma unroll
                for (int i = 0; i < 4; ++i) { p0[4 * g4 + i] -= g0[i]; p1[4 * g4 + i] -= g1[i]; } }
            if (kb_ + KVBLK - 1 > qlo) mask_tile(p0, p1, qm - kb_);
            partialSM(p0, p1, m_reg, mn, al);
            finishSM(p0, p1, al, l_reg, pa0, pa1, pa2, pa3);
            if (__any(al < 1.f)) { if (hi == 0) al_l[r32] = al; asm volatile("s_waitcnt lgkmcnt(0)" ::: "memory");
#pragma unroll
                for (int d_ = 0; d_ < 4; ++d_)
#pragma unroll
                    for (int r = 0; r < 16; ++r) o[d_][r] *= al_l[crow(r, hi)]; }
            SBAR();
            pv_tile(o, vb0 + bf * SHM_V, pa0, pa1, pa2, pa3);
        }
        if (t + 1 < NT) { asm volatile("s_waitcnt vmcnt(0)" ::: "memory"); FOX_WRITE(bf ^ 1); }
        __syncthreads();
    }
#undef FOX_LOAD
#undef FOX_WRITE
    if (hi == 0) li_l[r32] = l_reg;
    asm volatile("s_waitcnt lgkmcnt(0)" ::: "memory");
    bf16_t* Ow = OB + (size_t)qlo * 512 + h * 128;
#pragma unroll
    for (int r = 0; r < 16; ++r) { const int orow = crow(r, hi); const float rl = __builtin_amdgcn_rcpf(li_l[orow]);
#pragma unroll
        for (int d0 = 0; d0 < 4; ++d0) { const float v = o[d0][r] * rl; const float vn = __shfl_xor(v, 1);
            if ((r32 & 1) == 0) *(unsigned*)(Ow + (size_t)orow * 512 + d0 * 32 + r32) = cvtpk(v, vn); } }
    __syncthreads();
}
#undef KSWZ
}

DI void transpose_tile(float* tile, const float* src, int ld, int k0, int c0, int c1, bf16_t* dst, int Kd) {
    const int tid = threadIdx.x, nn = tid & 63, k8 = tid >> 6; const int col = nn < 32 ? c0 + nn : c1 + nn - 32;
    const float* s = src + (size_t)(k0 + k8 * 8) * ld + col;
    float v[8];
#pragma unroll
    for (int i = 0; i < 8; ++i) v[i] = s[(size_t)i * ld];
    u32x4 w; w.x = cvt_pk(v[0], v[1]); w.y = cvt_pk(v[2], v[3]); w.z = cvt_pk(v[4], v[5]); w.w = cvt_pk(v[6], v[7]);
    *(u32x4*)(dst + (size_t)nn * Kd + k0 + k8 * 8) = w;
}
constexpr int T_WIN = 88 * 16, T_WOA = 16 * 8, T_WOUT = 16 * 16, T_WGU = 32 * 32 * 16, T_WD = 32 * 16 * 16;
constexpr int T_SMALL = T_WIN + 2 * T_WOA + T_WOUT;
DI void conv_tile(const Args& a, float* lds, int t) {
    unsigned char* ws = a.ws; int r = t;
    if (r < T_WIN) { const int nt = r / 16, kt = r % 16, n0 = nt * 64; const int c0 = n0 + (n0 >= 3584 ? 12 : (n0 >= 2048 ? 8 : 0));
        transpose_tile(lds, a.in[I_WIN], NIN, kt * 64, c0, c0 + 32, (bf16_t*)(ws + WS_WINT) + (size_t)n0 * DM, DM); return; }
    r -= T_WIN;
    if (r < T_WOA) { const int nt = r / 8, kt = r % 8, n0 = nt * 64; transpose_tile(lds, a.in[I_WOD], DM, kt * 64, n0, n0 + 32, (bf16_t*)(ws + WS_WOAT) + (size_t)n0 * 512, 512); return; }
    r -= T_WOA;
    if (r < T_WOA) { const int nt = r / 8, kt = r % 8, n0 = nt * 64; transpose_tile(lds, a.in[I_WOF], DM, kt * 64, n0, n0 + 32, (bf16_t*)(ws + WS_WOBT) + (size_t)n0 * 512, 512); return; }
    r -= T_WOA;
    if (r < T_WOUT) { const int nt = r / 16, kt = r % 16, n0 = nt * 64; transpose_tile(lds, a.in[I_WOUT], DM, kt * 64, n0, n0 + 32, (bf16_t*)(ws + WS_WOUTT) + (size_t)n0 * DM, DM); return; }
    r -= T_WOUT;
    if (r < T_WGU) { const int e = r / 512, q = r % 512, nt = q / 16, kt = q % 16, n0 = nt * 64;
        transpose_tile(lds, a.in[I_WGU] + (size_t)e * DM * 2048, 2048, kt * 64, gu_src(n0), gu_src(n0 + 32), (bf16_t*)(ws + WS_WGUT) + ((size_t)e * 2048 + n0) * DM, DM); return; }
    r -= T_WGU;
    { const int e = r / 256, q = r % 256, nt = q / 16, kt = q % 16, n0 = nt * 64;
        transpose_tile(lds, a.in[I_WD] + (size_t)e * DM * DM, DM, kt * 64, n0, n0 + 32, (bf16_t*)(ws + WS_WDT) + ((size_t)e * DM + n0) * DM, DM); }
}
DI void ph0(const Args& a, float* lds) {
    const int tid = threadIdx.x, G = gridDim.x, bx = blockIdx.x;
    unsigned char* ws = a.ws;
    for (int grp = bx; grp < 256; grp += G) {
        const int col = tid % 24, ks = tid / 24, j = grp * 24 + col; const float* c = a.in[I_C]; const float* w = a.in[I_WADA];
        float acc = 0.f;
        if (ks < 21) { const int k1 = (ks * 49 + 49) < DM ? (ks * 49 + 49) : DM; for (int k = ks * 49; k < k1; ++k) acc += c[k] * w[(size_t)k * 6144 + j]; }
        __syncthreads();
        if (ks < 21) lds[ks * 24 + col] = acc;
        __syncthreads();
        if (tid < 24) { float s = a.in[I_BADA][grp * 24 + tid]; for (int q = 0; q < 21; ++q) s += lds[q * 24 + tid]; ((float*)(ws + WS_MOD))[grp * 24 + tid] = s; }
    }
    for (int t = bx; t < T_SMALL; t += G) conv_tile(a, lds, t);
}

DI void ph1(const Args& a, float* lds) {
    const int tid = threadIdx.x, lane = tid & 63, wave = tid >> 6, G = gridDim.x;
    float* A1 = lds; float* B1 = lds + 1024; float* wsm = lds + 2048;
    const float* mod = (const float*)(a.ws + WS_MOD);
    for (int k = tid; k < DM; k += NTHREADS) { A1[k] = a.in[I_G1][k] * (1.f + mod[1024 + k]); B1[k] = mod[k]; }
    for (int i = tid; i < 12 * DM; i += NTHREADS) { const int k = i / 12, j = i % 12; wsm[j * DM + k] = a.in[I_WIN][(size_t)k * NIN + (j < 8 ? 2048 + j : 3592 + (j - 8))]; }
    __syncthreads();
    bf16_t* H = (bf16_t*)(a.ws + WS_H); float* SP = (float*)(a.ws + WS_SP);
    for (int t0 = (blockIdx.x * NWAVES + wave) * 2; t0 < SEQ; t0 += G * NWAVES * 2) {
        f32x4 v[2][4]; float ss[2] = {0.f, 0.f};
#pragma unroll
        for (int q = 0; q < 2; ++q)
#pragma unroll
            for (int i = 0; i < 4; ++i) v[q][i] = *(const f32x4*)(a.in[I_X] + (size_t)(t0 + q) * DM + lane * 4 + 256 * i);
#pragma unroll
        for (int q = 0; q < 2; ++q)
#pragma unroll
            for (int i = 0; i < 4; ++i) ss[q] += v[q][i][0] * v[q][i][0] + v[q][i][1] * v[q][i][1] + v[q][i][2] * v[q][i][2] + v[q][i][3] * v[q][i][3];
        ss[0] = wave_sum(ss[0]); ss[1] = wave_sum(ss[1]);
#pragma unroll
        for (int q = 0; q < 2; ++q) { const float rstd = rsqrtf(ss[q] * (1.f / DM) + 1e-6f);
#pragma unroll
            for (int i = 0; i < 4; ++i) { const int k = lane * 4 + 256 * i;
#pragma unroll
                for (int e = 0; e < 4; ++e) v[q][i][e] = v[q][i][e] * rstd * A1[k + e] + B1[k + e];
                u32x2 w; w.x = cvt_pk(v[q][i][0], v[q][i][1]); w.y = cvt_pk(v[q][i][2], v[q][i][3]);
                *(u32x2*)(H + (size_t)(t0 + q) * DM + k) = w; } }
#pragma unroll 1
        for (int j = 0; j < 12; ++j) { float p0 = 0.f, p1 = 0.f;
#pragma unroll
            for (int i = 0; i < 4; ++i) { const f32x4 wv = *(const f32x4*)(wsm + j * DM + lane * 4 + 256 * i);
                p0 += v[0][i][0] * wv[0] + v[0][i][1] * wv[1] + v[0][i][2] * wv[2] + v[0][i][3] * wv[3];
                p1 += v[1][i][0] * wv[0] + v[1][i][1] * wv[1] + v[1][i][2] * wv[2] + v[1][i][3] * wv[3]; }
            p0 = wave_sum(p0); p1 = wave_sum(p1); if (lane == j) { SP[(size_t)t0 * 16 + j] = p0; SP[(size_t)(t0 + 1) * 16 + j] = p1; } }
    }
}

DI void ph2(const Args& a, unsigned char* ldsb) {
    pg8::Gemm g{(const bf16_t*)(a.ws + WS_H), (const bf16_t*)(a.ws + WS_WINT), SEQ, NPJ, DM};
    pg8::OrderDense S; S.init(SEQ / 256, NPJ / 256, (int)gridDim.x, (int)blockIdx.x);
    pg8::EpiStoreBf16 E{(bf16_t*)(a.ws + WS_PROJ), NPJ, nullptr, 0};
    pg8::gemm_phase<pg8::EpiStoreBf16, pg8::OrderDense>((LAS unsigned char*)ldsb, g, S, E);
}

DI void ph3_fcum(const Args& a, float* lds) {
    const int tid = threadIdx.x, lane = tid & 63, wave = tid >> 6, h = blockIdx.x;
    const float* SP = (const float*)(a.ws + WS_SP); float* F = (float*)(a.ws + WS_F);
    const float bf = a.in[I_BFG][h];
    double* wtot = (double*)lds;
    float lf[32];
#pragma unroll
    for (int i = 0; i < 32; ++i) lf[i] = SP[(size_t)(tid * 32 + i) * 16 + 8 + h];
    double s = 0.0;
#pragma unroll
    for (int i = 0; i < 32; ++i) { lf[i] = logsigf(lf[i] + bf); s += (double)lf[i]; }
    double inc = s;
#pragma unroll
    for (int o_ = 1; o_ < 64; o_ <<= 1) { const double y = __shfl_up(inc, o_); if (lane >= o_) inc += y; }
    __syncthreads();
    if (lane == 63) wtot[wave] = inc;
    __syncthreads();
    double off = inc - s;
    for (int w = 0; w < wave; ++w) off += wtot[w];
#pragma unroll
    for (int i = 0; i < 32; ++i) { off += (double)lf[i]; F[(size_t)h * SEQ + tid * 32 + i] = (float)off; }
    __syncthreads();
}
namespace prep {
constexpr int QS = 0, KS = 17408, KT = 34816, VT = 53248, UNIT = 71680, SM = 2 * UNIT;
DI bf16x8 ld8(const char* p) { return *(const bf16x8*)p; }
template <int C, int M4> struct TRow { static DI void run(const float (&T)[64], const float* Ls, float& a0, float& a1) {
    if constexpr (4 * M4 < C) { const f32x4 Lv = *(const f32x4*)(Ls + C * 68 + 4 * M4);
        a0 -= Lv[0] * T[4 * M4]; if constexpr (4 * M4 + 1 < C) a1 -= Lv[1] * T[4 * M4 + 1]; if constexpr (4 * M4 + 2 < C) a0 -= Lv[2] * T[4 * M4 + 2]; if constexpr (4 * M4 + 3 < C) a1 -= Lv[3] * T[4 * M4 + 3];
        TRow<C, M4 + 1>::run(T, Ls, a0, a1); } } };
template <int C> struct TRow<C, 16> { static DI void run(const float (&)[64], const float*, float&, float&) {} };
template <int C> DI void tsolve(float (&T)[64], const float* Ls, int lane) {
    if constexpr (C < 64) { float a0 = (lane == C) ? 1.f : 0.f, a1 = 0.f; TRow<C, 0>::run(T, Ls, a0, a1); T[C] = a0 + a1; asm volatile("" ::: "memory"); __builtin_amdgcn_sched_barrier(0); tsolve<C + 1>(T, Ls, lane); } }
}
DI void ph3_prep2(const Args& a, char* lds, int pair) {
    using namespace prep;
    const int tid = threadIdx.x, lane = tid & 63, wave = tid >> 6, grp = wave >> 2, wq = wave & 3, tg = tid & 255, lr = lane & 15, lq = lane >> 4;
    int unit = pair * 2 + grp; if (unit >= NH * NCH) unit = NH * NCH - 1;
    const int h = unit & 3, n = unit >> 2, t0 = n * CH;
    char* U = lds + grp * UNIT;
    float* gcs = (float*)(lds + SM) + grp * 192; float* bes = gcs + 64; float* egs = gcs + 128;
    const float* SP = (const float*)(a.ws + WS_SP); const bf16_t* P = (const bf16_t*)(a.ws + WS_PROJ);
    const size_t cb = (size_t)(h * NCH + n);
    bf16_t* WF = (bf16_t*)(a.ws + WS_DNW) + cb * 8192; bf16_t* UF = (bf16_t*)(a.ws + WS_DNU) + cb * 8192;
    bf16_t* QF = (bf16_t*)(a.ws + WS_DNQD) + cb * 8192; bf16_t* KF = (bf16_t*)(a.ws + WS_DNKD) + cb * 8192; bf16_t* AF = (bf16_t*)(a.ws + WS_DNATT) + cb * 4096;
    __syncthreads();
    if (wq == 0) { const int t = t0 + lane;
        const float be = sigm(SP[(size_t)t * 16 + h]);
        float g = -expf(a.in[I_ALOG][h]) * softplusf(SP[(size_t)t * 16 + 4 + h] + a.in[I_DTB][h]);
#pragma unroll
        for (int o_ = 1; o_ < 64; o_ <<= 1) { const float y = __shfl_up(g, o_); if (lane >= o_) g += y; }
        gcs[lane] = g; bes[lane] = be; egs[lane] = expf(g); }
    __syncthreads();
    { const int d8 = tg & 15, ci = tg >> 4; const float* cw = a.in[I_CONVW];
#pragma unroll 1
        for (int sec = 0; sec < 3; ++sec) {
            const int col = sec * 512 + h * 128 + d8 * 8;
            f32x4 w[4][2];
#pragma unroll
            for (int j = 0; j < 4; ++j) { w[j][0] = *(const f32x4*)(cw + j * 1536 + col); w[j][1] = *(const f32x4*)(cw + j * 1536 + col + 4); }
#pragma unroll 1
          for (int ih = 0; ih < 2; ++ih) {
            u32x4 xin[2][4];
#pragma unroll
            for (int i = 0; i < 2; ++i)
#pragma unroll
                for (int j = 0; j < 4; ++j) { int tt = t0 + ci + 16 * (2 * ih + i) - 3 + j; tt = tt < 0 ? 0 : tt; xin[i][j] = *(const u32x4*)(P + (size_t)tt * NPJ + col); }
#pragma unroll
            for (int i = 0; i < 2; ++i) { const int c = ci + 16 * (2 * ih + i), t = t0 + c;
                float v[8];
#pragma unroll
                for (int e = 0; e < 8; ++e) v[e] = 0.f;
#pragma unroll
                for (int j = 0; j < 4; ++j) { const float ok = (t - 3 + j >= 0) ? 1.f : 0.f; const u32x4 x = xin[i][j];
                    v[0] += ok * w[j][0][0] * __uint_as_float(x.x << 16); v[1] += ok * w[j][0][1] * __uint_as_float(x.x & 0xffff0000u); v[2] += ok * w[j][0][2] * __uint_as_float(x.y << 16); v[3] += ok * w[j][0][3] * __uint_as_float(x.y & 0xffff0000u);
                    v[4] += ok * w[j][1][0] * __uint_as_float(x.z << 16); v[5] += ok * w[j][1][1] * __uint_as_float(x.z & 0xffff0000u); v[6] += ok * w[j][1][2] * __uint_as_float(x.w << 16); v[7] += ok * w[j][1][3] * __uint_as_float(x.w & 0xffff0000u); }
                float ss = 0.f;
#pragma unroll
                for (int e = 0; e < 8; ++e) { v[e] = siluf(v[e]); ss += v[e] * v[e]; }
                if (sec < 2) { ss += __shfl_xor(ss, 1); ss += __shfl_xor(ss, 2); ss += __shfl_xor(ss, 4); ss += __shfl_xor(ss, 8);
                    const float sc = rsqrtf(ss + 1e-6f) * (sec == 0 ? 0.08838834764831845f : 1.f);
#pragma unroll
                    for (int e = 0; e < 8; ++e) v[e] *= sc; }
                u32x4 pk; pk.x = cvt_pk(v[0], v[1]); pk.y = cvt_pk(v[2], v[3]); pk.z = cvt_pk(v[4], v[5]); pk.w = cvt_pk(v[6], v[7]);
                if (sec == 0) { *(u32x4*)(U + QS + c * 272 + d8 * 16) = pk;
                    const float eg = egs[c];
                    const int base = (((c >> 4) * 4 + (d8 >> 2)) * 64 + (c & 15)) * 8 + 4 * ((d8 & 3) >> 1), l0 = (2 * (d8 & 3)) & 3;
                    u32x2 q0, q1; q0.x = cvt_pk(v[0] * eg, v[1] * eg); q0.y = cvt_pk(v[2] * eg, v[3] * eg); q1.x = cvt_pk(v[4] * eg, v[5] * eg); q1.y = cvt_pk(v[6] * eg, v[7] * eg);
                    *(u32x2*)(QF + base + l0 * 128) = q0; *(u32x2*)(QF + base + (l0 + 1) * 128) = q1; }
                else { if (sec == 1) *(u32x4*)(U + KS + c * 272 + d8 * 16) = pk;
                    bf16_t* T_ = (bf16_t*)(U + (sec == 1 ? KT : VT)) + (d8 * 8) * 72 + c;
                    T_[0 * 72] = (bf16_t)(pk.x & 0xffffu); T_[1 * 72] = (bf16_t)(pk.x >> 16); T_[2 * 72] = (bf16_t)(pk.y & 0xffffu); T_[3 * 72] = (bf16_t)(pk.y >> 16);
                    T_[4 * 72] = (bf16_t)(pk.z & 0xffffu); T_[5 * 72] = (bf16_t)(pk.z >> 16); T_[6 * 72] = (bf16_t)(pk.w & 0xffffu); T_[7 * 72] = (bf16_t)(pk.w >> 16); }
            }
          }
        }
    }
    __syncthreads();
    f32x4 Lr[4];
    { const int mt = wq;
#pragma unroll
        for (int nt = 0; nt < 4; ++nt) { Lr[nt] = (f32x4){0.f, 0.f, 0.f, 0.f};
            if (nt <= mt) {
#pragma unroll
                for (int s = 0; s < 4; ++s) Lr[nt] = MFMA16(ld8(U + KS + (16 * mt + lr) * 272 + (32 * s + 8 * lq) * 2), ld8(U + KS + (16 * nt + lr) * 272 + (32 * s + 8 * lq) * 2), Lr[nt]); } }
        const int ntq = 3 - wq; const float gcc = gcs[16 * ntq + lr];
#pragma unroll
        for (int mtk = 0; mtk < 4; ++mtk) { f32x4 acc = (f32x4){0.f, 0.f, 0.f, 0.f};
            if (mtk <= ntq) {
#pragma unroll
                for (int s = 0; s < 4; ++s) acc = MFMA16(ld8(U + KS + (16 * mtk + lr) * 272 + (32 * s + 8 * lq) * 2), ld8(U + QS + (16 * ntq + lr) * 272 + (32 * s + 8 * lq) * 2), acc);
#pragma unroll
                for (int r = 0; r < 4; ++r) { const int m = 16 * mtk + 4 * lq + r, c = 16 * ntq + lr; acc[r] = (m <= c) ? acc[r] * expf(gcc - gcs[m]) : 0.f; } }
            u32x2 o_; o_.x = cvt_pk(acc[0], acc[1]); o_.y = cvt_pk(acc[2], acc[3]);
            *(u32x2*)(AF + ((ntq * 2 + (mtk >> 1)) * 64 + lane) * 8 + 4 * (mtk & 1)) = o_; }
    }
    __syncthreads();
    { const int mt = wq; float* LT = (float*)(U + QS);
#pragma unroll
        for (int nt = 0; nt < 4; ++nt) if (nt <= mt) { const int m = 16 * nt + lr; f32x4 o_;
#pragma unroll
            for (int r = 0; r < 4; ++r) { const int c = 16 * mt + 4 * lq + r; o_[r] = (m < c) ? bes[c] * Lr[nt][r] * expf(gcs[c] - gcs[m]) : 0.f; }
            *(f32x4*)(LT + m * 68 + 16 * mt + 4 * lq) = o_; } }
    __syncthreads();
    if (wq == 0) { const float* LT = (const float*)(U + QS); float* Tl = (float*)(U + KS);
#pragma unroll
        for (int ib = 0; ib < 4; ++ib) { float acc[16];
#pragma unroll
            for (int r = 0; r < 16; ++r) acc[r] = (lane == 16 * ib + r) ? 1.f : 0.f;
#pragma unroll 2
            for (int m = 0; m < 16 * ib; ++m) { const float t = Tl[m * 68 + lane];
#pragma unroll
                for (int q = 0; q < 4; ++q) { const f32x4 Lv = *(const f32x4*)(LT + m * 68 + 16 * ib + 4 * q);
#pragma unroll
                    for (int e = 0; e < 4; ++e) acc[4 * q + e] -= Lv[e] * t; } }
#pragma unroll
            for (int p = 0; p < 16; ++p) { const float t = acc[p]; Tl[(16 * ib + p) * 68 + lane] = t;
                if (p < 15) {
#pragma unroll
                    for (int q = 0; q < 4; ++q) if (4 * q + 3 > p) { const f32x4 Lv = *(const f32x4*)(LT + (16 * ib + p) * 68 + 16 * ib + 4 * q);
#pragma unroll
                        for (int e = 0; e < 4; ++e) if (4 * q + e > p) acc[4 * q + e] -= Lv[e] * t; } } }
            asm volatile("s_waitcnt lgkmcnt(0)" ::: "memory"); }
        if (lane == 0) ((float*)(a.ws + WS_EG))[cb] = egs[63];
    } else { const float gl = gcs[63];
        for (int i = tg - 64; i < 2048; i += 192) { const int dk = i >> 4, cq = i & 15;
            const u32x2 x = *(const u32x2*)(U + KT + dk * 144 + cq * 8);
            const float e0 = expf(gl - gcs[4 * cq]), e1 = expf(gl - gcs[4 * cq + 1]), e2 = expf(gl - gcs[4 * cq + 2]), e3 = expf(gl - gcs[4 * cq + 3]);
            u32x2 o_; o_.x = cvt_pk(__uint_as_float(x.x << 16) * e0, __uint_as_float(x.x & 0xffff0000u) * e1); o_.y = cvt_pk(__uint_as_float(x.y << 16) * e2, __uint_as_float(x.y & 0xffff0000u) * e3);
            *(u32x2*)(KF + (((dk >> 4) * 2 + (cq >> 3)) * 64 + (cq & 3) * 16 + (dk & 15)) * 8 + 4 * ((cq >> 2) & 1)) = o_; } }
    __syncthreads();
    { const float* Tl = (const float*)(U + KS); const int c = tg >> 2, m0 = (tg & 3) * 16;
        f32x4 tv[4];
#pragma unroll
        for (int q = 0; q < 4; ++q) tv[q] = *(const f32x4*)(Tl + c * 68 + m0 + 4 * q);
        __syncthreads();
        bf16_t* Tb = (bf16_t*)(U + QS); bf16_t* Tg = (bf16_t*)(U + KS);
#pragma unroll
        for (int q = 0; q < 4; ++q) { u32x2 b_, g_; float be[4], bg[4];
#pragma unroll
            for (int e = 0; e < 4; ++e) { const int m = m0 + 4 * q + e; be[e] = tv[q][e] * bes[m]; bg[e] = be[e] * egs[m]; }
            b_.x = cvt_pk(be[0], be[1]); b_.y = cvt_pk(be[2], be[3]); g_.x = cvt_pk(bg[0], bg[1]); g_.y = cvt_pk(bg[2], bg[3]);
            *(u32x2*)(Tb + c * 72 + m0 + 4 * q) = b_; *(u32x2*)(Tg + c * 72 + m0 + 4 * q) = g_; } }
    __syncthreads();
    {
#pragma unroll
        for (int q = 0; q < 2; ++q) { const int nt = 2 * wq + q;
#pragma unroll
            for (int mt = 0; mt < 4; ++mt) { f32x4 acc = (f32x4){0.f, 0.f, 0.f, 0.f};
#pragma unroll
                for (int s = 0; s < 2; ++s) acc = MFMA16(ld8(U + QS + (16 * mt + lr) * 144 + (32 * s + 8 * lq) * 2), ld8(U + VT + (16 * nt + lr) * 144 + (32 * s + 8 * lq) * 2), acc);
                u32x2 o_; o_.x = cvt_pk(acc[0], acc[1]); o_.y = cvt_pk(acc[2], acc[3]);
                *(u32x2*)(UF + ((nt * 4 + mt) * 64 + lane) * 4) = o_; } }
#pragma unroll
        for (int q = 0; q < 2; ++q) { const int mtk = 2 * wq + q;
#pragma unroll
            for (int ntc = 0; ntc < 4; ++ntc) { f32x4 acc = (f32x4){0.f, 0.f, 0.f, 0.f};
#pragma unroll
                for (int s = 0; s < 2; ++s) acc = MFMA16(ld8(U + KT + (16 * mtk + lr) * 144 + (32 * s + 8 * lq) * 2), ld8(U + KS + (16 * ntc + lr) * 144 + (32 * s + 8 * lq) * 2), acc);
                u32x2 o_; o_.x = cvt_pk(-acc[0], -acc[1]); o_.y = cvt_pk(-acc[2], -acc[3]);
                *(u32x2*)(WF + ((ntc * 4 + (mtk >> 1)) * 64 + lane) * 8 + 4 * (mtk & 1)) = o_; } }
    }
}
DI void ph3_norms(const Args& a, float* lds) {
    const int lane = threadIdx.x & 63, wave = threadIdx.x >> 6, NW = gridDim.x * NWAVES, sub = lane >> 4, l16 = lane & 15;
    const bf16_t* P = (const bf16_t*)(a.ws + WS_PROJ); float* TB = (float*)(a.ws + WS_NRMT);
    for (int grp = blockIdx.x * NWAVES + wave; grp < SEQ / 8; grp += NW) {
        float mq[4] = {0.f, 0.f, 0.f, 0.f}, mk[4] = {0.f, 0.f, 0.f, 0.f}, md[4] = {3.0e38f, 3.0e38f, 3.0e38f, 3.0e38f};
#pragma unroll
        for (int it = 0; it < 2; ++it) { const bf16_t* row = P + (size_t)(grp * 8 + it * 4 + sub) * NPJ + l16 * 8;
            u32x4 xq[4], xk[4];
#pragma unroll
            for (int h = 0; h < 4; ++h) { xq[h] = *(const u32x4*)(row + PJ_FQ + h * 128); xk[h] = *(const u32x4*)(row + PJ_FK + h * 128); }
#pragma unroll
            for (int h = 0; h < 4; ++h) { float sq = 0.f, sk = 0.f, sd = 0.f;
#pragma unroll
                for (int e = 0; e < 4; ++e) { const float a0 = __uint_as_float(xq[h][e] << 16), a1 = __uint_as_float(xq[h][e] & 0xffff0000u), b0 = __uint_as_float(xk[h][e] << 16), b1 = __uint_as_float(xk[h][e] & 0xffff0000u);
                    sq += a0 * a0 + a1 * a1; sk += b0 * b0 + b1 * b1; sd += a0 * b0 + a1 * b1; }
#pragma unroll
                for (int o_ = 1; o_ <= 8; o_ <<= 1) { sq += __shfl_xor(sq, o_); sk += __shfl_xor(sk, o_); sd += __shfl_xor(sd, o_); }
                mq[h] = fmaxf(mq[h], sq); mk[h] = fmaxf(mk[h], sk); md[h] = fminf(md[h], sd); } }
#pragma unroll
        for (int h = 0; h < 4; ++h) { mq[h] = fmaxf(mq[h], __shfl_xor(mq[h], 16)); mq[h] = fmaxf(mq[h], __shfl_xor(mq[h], 32)); mk[h] = fmaxf(mk[h], __shfl_xor(mk[h], 16)); mk[h] = fmaxf(mk[h], __shfl_xor(mk[h], 32));
            md[h] = fminf(md[h], __shfl_xor(md[h], 16)); md[h] = fminf(md[h], __shfl_xor(md[h], 32));
            if (lane == 0) { TB[grp * 12 + h] = mq[h]; TB[grp * 12 + 4 + h] = mk[h]; TB[grp * 12 + 8 + h] = md[h]; } }
    }
}
DI void ph3(const Args& a, float* lds) {
    const int G = gridDim.x;
    if (blockIdx.x < 4) ph3_fcum(a, lds);
    for (int p = blockIdx.x; p < NH * NCH / 2; p += G) ph3_prep2(a, (char*)lds, p);
    ph3_norms(a, lds);
}

namespace dn {
DI unsigned cvtpk(float lo, float hi) { return cvt_pk(lo, hi); }
DI bf16x8 packB(const f32x4& t0, const f32x4& t1) { u32x4 w = {cvtpk(t0[0], t0[1]), cvtpk(t0[2], t0[3]), cvtpk(t1[0], t1[1]), cvtpk(t1[2], t1[3])}; return *reinterpret_cast<bf16x8*>(&w); }
DI bf16x8 frag(const bf16_t* base, int f, int lane) { return *(const bf16x8*)(base + ((size_t)f * 64 + lane) * 8); }
template <bool WITH_U, bool WITH_O>
DI void step(const bf16_t* WFn, const bf16_t* KFn, const bf16_t* QFn, const bf16_t* AFn, const bf16_t* UFs, float eg, f32x4 (&S)[8], f32x4 (&o)[4], int lane) {
    bf16x8 sb[4];
#pragma unroll
    for (int s = 0; s < 4; ++s) sb[s] = packB(S[2 * s], S[2 * s + 1]);
    f32x4 vn[4];
#pragma unroll
    for (int mt = 0; mt < 4; ++mt) {
        if (WITH_U) { const u32x2 w = *(const u32x2*)(UFs + ((size_t)mt * 64 + lane) * 4); vn[mt] = (f32x4){__uint_as_float(w.x << 16), __uint_as_float(w.x & 0xffff0000u), __uint_as_float(w.y << 16), __uint_as_float(w.y & 0xffff0000u)}; }
        else vn[mt] = (f32x4){0.f, 0.f, 0.f, 0.f};
#pragma unroll
        for (int s = 0; s < 4; ++s) vn[mt] = MFMA16(frag(WFn, mt * 4 + s, lane), sb[s], vn[mt]); }
    if (WITH_O) {
#pragma unroll
        for (int mt = 0; mt < 4; ++mt) { o[mt] = (f32x4){0.f, 0.f, 0.f, 0.f};
#pragma unroll
            for (int s = 0; s < 4; ++s) o[mt] = MFMA16(frag(QFn, mt * 4 + s, lane), sb[s], o[mt]); } }
    bf16x8 vb[2];
#pragma unroll
    for (int s = 0; s < 2; ++s) vb[s] = packB(vn[2 * s], vn[2 * s + 1]);
    if (WITH_O) {
#pragma unroll
        for (int mt = 0; mt < 4; ++mt)
#pragma unroll
            for (int s = 0; s < 2; ++s) o[mt] = MFMA16(frag(AFn, mt * 2 + s, lane), vb[s], o[mt]); }
#pragma unroll
    for (int mt = 0; mt < 8; ++mt) { S[mt] = S[mt] * eg;
#pragma unroll
        for (int s = 0; s < 2; ++s) S[mt] = MFMA16(frag(KFn, mt * 2 + s, lane), vb[s], S[mt]); }
}
}
constexpr int NGRP = 16, GRP = 16;
constexpr int NSCAN = NH * NGRP;
constexpr int SBUF = 57344;
template <int N> struct Stage { u32x4 r[N]; };
DI void stage_load2(Stage<4>& st, const bf16_t* s0, const bf16_t* s1) {
    const int tid = threadIdx.x;
    st.r[0] = *(const u32x4*)(s0 + (size_t)tid * 8); st.r[1] = *(const u32x4*)(s0 + (size_t)(tid + 512) * 8);
    st.r[2] = *(const u32x4*)(s1 + (size_t)tid * 8); st.r[3] = *(const u32x4*)(s1 + (size_t)(tid + 512) * 8);
}
DI void stage_write2(const Stage<4>& st, char* buf) {
    const int tid = threadIdx.x;
    *(u32x4*)(buf + tid * 16) = st.r[0]; *(u32x4*)(buf + (tid + 512) * 16) = st.r[1];
    *(u32x4*)(buf + 16384 + tid * 16) = st.r[2]; *(u32x4*)(buf + 16384 + (tid + 512) * 16) = st.r[3];
}
DI void stage_load4(Stage<7>& st, const bf16_t* s0, const bf16_t* s1, const bf16_t* s2, const bf16_t* s3) {
    const int tid = threadIdx.x;
    st.r[0] = *(const u32x4*)(s0 + (size_t)tid * 8); st.r[1] = *(const u32x4*)(s0 + (size_t)(tid + 512) * 8);
    st.r[2] = *(const u32x4*)(s1 + (size_t)tid * 8); st.r[3] = *(const u32x4*)(s1 + (size_t)(tid + 512) * 8);
    st.r[4] = *(const u32x4*)(s2 + (size_t)tid * 8); st.r[5] = *(const u32x4*)(s2 + (size_t)(tid + 512) * 8);
    st.r[6] = *(const u32x4*)(s3 + (size_t)tid * 8);
}
DI void stage_write4(const Stage<7>& st, char* buf) {
    const int tid = threadIdx.x;
    *(u32x4*)(buf + tid * 16) = st.r[0]; *(u32x4*)(buf + (tid + 512) * 16) = st.r[1];
    *(u32x4*)(buf + 16384 + tid * 16) = st.r[2]; *(u32x4*)(buf + 16384 + (tid + 512) * 16) = st.r[3];
    *(u32x4*)(buf + 32768 + tid * 16) = st.r[4]; *(u32x4*)(buf + 32768 + (tid + 512) * 16) = st.r[5];
    *(u32x4*)(buf + 49152 + tid * 16) = st.r[6];
}
DI f32x4 u_unpack(const u32x2 w) { return (f32x4){__uint_as_float(w.x << 16), __uint_as_float(w.x & 0xffff0000u), __uint_as_float(w.y << 16), __uint_as_float(w.y & 0xffff0000u)}; }
DI void scanA_chain(const Args& a, char* lds, int chain) {
    const int tid = threadIdx.x, lane = tid & 63, vs = tid >> 6, lr = lane & 15, lq = lane >> 4;
    const int h = chain >> 4, g = chain & 15;
    f32x4 SQ[8], SP[8];
#pragma unroll
    for (int mt = 0; mt < 8; ++mt) { SQ[mt] = (f32x4){0.f, 0.f, 0.f, 0.f};
#pragma unroll
        for (int r = 0; r < 4; ++r) SP[mt][r] = (16 * mt + 4 * lq + r == 16 * vs + lr) ? 1.f : 0.f; }
    const size_t cb0 = (size_t)(h * NCH + g * GRP);
    const bf16_t* WF = (const bf16_t*)(a.ws + WS_DNW) + cb0 * 8192; const bf16_t* KF = (const bf16_t*)(a.ws + WS_DNKD) + cb0 * 8192;
    const bf16_t* UF = (const bf16_t*)(a.ws + WS_DNU) + cb0 * 8192 + (size_t)vs * 1024; const float* EG = (const float*)(a.ws + WS_EG) + cb0;
    Stage<4> st; u32x2 ucur[4], unxt[4];
    __syncthreads();
    stage_load2(st, WF, KF);
#pragma unroll
    for (int mt = 0; mt < 4; ++mt) ucur[mt] = *(const u32x2*)(UF + ((size_t)mt * 64 + lane) * 4);
    asm volatile("s_waitcnt vmcnt(0)" ::: "memory");
    stage_write2(st, lds);
    __syncthreads();
    for (int i = 0; i < GRP; ++i) {
        const char* buf = lds + (i & 1) * SBUF;
        if (i + 1 < GRP) { stage_load2(st, WF + (size_t)(i + 1) * 8192, KF + (size_t)(i + 1) * 8192);
#pragma unroll
            for (int mt = 0; mt < 4; ++mt) unxt[mt] = *(const u32x2*)(UF + (size_t)(i + 1) * 8192 + ((size_t)mt * 64 + lane) * 4); }
        const float eg = EG[i];
        const bf16_t* Wl = (const bf16_t*)buf; const bf16_t* Kl = (const bf16_t*)(buf + 16384);
        bf16x8 sbq[4], sbp[4];
#pragma unroll
        for (int s = 0; s < 4; ++s) { sbq[s] = dn::packB(SQ[2 * s], SQ[2 * s + 1]); sbp[s] = dn::packB(SP[2 * s], SP[2 * s + 1]); }
        f32x4 vq[4], vp[4];
#pragma unroll
        for (int mt = 0; mt < 4; ++mt) { vq[mt] = u_unpack(ucur[mt]); vp[mt] = (f32x4){0.f, 0.f, 0.f, 0.f};
#pragma unroll
            for (int s = 0; s < 4; ++s) { const bf16x8 f = dn::frag(Wl, mt * 4 + s, lane); vq[mt] = MFMA16(f, sbq[s], vq[mt]); vp[mt] = MFMA16(f, sbp[s], vp[mt]); } }
        bf16x8 vbq[2], vbp[2];
#pragma unroll
        for (int s = 0; s < 2; ++s) { vbq[s] = dn::packB(vq[2 * s], vq[2 * s + 1]); vbp[s] = dn::packB(vp[2 * s], vp[2 * s + 1]); }
#pragma unroll
        for (int mt = 0; mt < 8; ++mt) { SQ[mt] = SQ[mt] * eg; SP[mt] = SP[mt] * eg;
#pragma unroll
            for (int s = 0; s < 2; ++s) { const bf16x8 f = dn::frag(Kl, mt * 2 + s, lane); SQ[mt] = MFMA16(f, vbq[s], SQ[mt]); SP[mt] = MFMA16(f, vbp[s], SP[mt]); } }
        if (i + 1 < GRP) { asm volatile("s_waitcnt vmcnt(0)" ::: "memory"); stage_write2(st, lds + ((i + 1) & 1) * SBUF);
#pragma unroll
            for (int mt = 0; mt < 4; ++mt) ucur[mt] = unxt[mt]; }
        __syncthreads();
    }
    bf16_t* PG = (bf16_t*)(a.ws + WS_PG) + (size_t)chain * 16384;
#pragma unroll
    for (int mt = 0; mt < 8; ++mt)
#pragma unroll
        for (int r = 0; r < 4; ++r) PG[((mt * 4 + (vs >> 1)) * 64 + (lr >> 2) * 16 + 4 * lq + r) * 8 + 4 * (vs & 1) + (lr & 3)] = f2bf(SP[mt][r]);
    float* QG = (float*)(a.ws + WS_QG) + ((size_t)chain * 8 + vs) * 2048;
#pragma unroll
    for (int mt = 0; mt < 8; ++mt) *(f32x4*)(QG + ((size_t)mt * 64 + lane) * 4) = SQ[mt];
}
DI void scanPC_chain(const Args& a, char* lds, int chain) {
    const int tid = threadIdx.x, lane = tid & 63, vs = tid >> 6, lr = lane & 15, lq = lane >> 4;
    const int h = chain >> 4, g = chain & 15;
    f32x4 S[8];
#pragma unroll
    for (int mt = 0; mt < 8; ++mt) S[mt] = (f32x4){0.f, 0.f, 0.f, 0.f};
    __syncthreads();
    if (g > 0) {
        const bf16_t* PG = (const bf16_t*)(a.ws + WS_PG) + (size_t)(h * NGRP) * 16384; const float* QG = (const float*)(a.ws + WS_QG) + ((size_t)(h * NGRP) * 8 + vs) * 2048;
        Stage<4> st; f32x4 qc[8], qn[8];
        stage_load2(st, PG, PG + 8192);
#pragma unroll
        for (int mt = 0; mt < 8; ++mt) qc[mt] = *(const f32x4*)(QG + ((size_t)mt * 64 + lane) * 4);
        asm volatile("s_waitcnt vmcnt(0)" ::: "memory");
        stage_write2(st, lds);
        __syncthreads();
        for (int j = 0; j < g; ++j) {
            const bf16_t* Pl = (const bf16_t*)(lds + (j & 1) * SBUF);
            if (j + 1 < g) { stage_load2(st, PG + (size_t)(j + 1) * 16384, PG + (size_t)(j + 1) * 16384 + 8192);
#pragma unroll
                for (int mt = 0; mt < 8; ++mt) qn[mt] = *(const f32x4*)(QG + (size_t)(j + 1) * 16384 + ((size_t)mt * 64 + lane) * 4); }
            bf16x8 sb[4];
#pragma unroll
            for (int s = 0; s < 4; ++s) sb[s] = dn::packB(S[2 * s], S[2 * s + 1]);
#pragma unroll
            for (int mt = 0; mt < 8; ++mt) { f32x4 acc = qc[mt];
#pragma unroll
                for (int s = 0; s < 4; ++s) acc = MFMA16(dn::frag(Pl, mt * 4 + s, lane), sb[s], acc);
                S[mt] = acc; }
            if (j + 1 < g) { asm volatile("s_waitcnt vmcnt(0)" ::: "memory"); stage_write2(st, lds + ((j + 1) & 1) * SBUF);
#pragma unroll
                for (int mt = 0; mt < 8; ++mt) qc[mt] = qn[mt]; }
            __syncthreads();
        }
    }
    const size_t cb0 = (size_t)(h * NCH + g * GRP);
    const bf16_t* WF = (const bf16_t*)(a.ws + WS_DNW) + cb0 * 8192; const bf16_t* KF = (const bf16_t*)(a.ws + WS_DNKD) + cb0 * 8192;
    const bf16_t* QF = (const bf16_t*)(a.ws + WS_DNQD) + cb0 * 8192; const bf16_t* AF = (const bf16_t*)(a.ws + WS_DNATT) + cb0 * 4096;
    const bf16_t* UF = (const bf16_t*)(a.ws + WS_DNU) + cb0 * 8192 + (size_t)vs * 1024; const float* EG = (const float*)(a.ws + WS_EG) + cb0;
    float* ORAW = (float*)(a.ws + WS_ORAW);
    Stage<7> st; u32x2 ucur[4], unxt[4];
    stage_load4(st, WF, KF, QF, AF);
#pragma unroll
    for (int mt = 0; mt < 4; ++mt) ucur[mt] = *(const u32x2*)(UF + ((size_t)mt * 64 + lane) * 4);
    asm volatile("s_waitcnt vmcnt(0)" ::: "memory");
    stage_write4(st, lds);
    __syncthreads();
    for (int i = 0; i < GRP; ++i) {
        const char* buf = lds + (i & 1) * SBUF; const int n = g * GRP + i;
        if (i + 1 < GRP) { stage_load4(st, WF + (size_t)(i + 1) * 8192, KF + (size_t)(i + 1) * 8192, QF + (size_t)(i + 1) * 8192, AF + (size_t)(i + 1) * 4096);
#pragma unroll
            for (int mt = 0; mt < 4; ++mt) unxt[mt] = *(const u32x2*)(UF + (size_t)(i + 1) * 8192 + ((size_t)mt * 64 + lane) * 4); }
        const float eg = EG[i];
        const bf16_t* Wl = (const bf16_t*)buf; const bf16_t* Kl = (const bf16_t*)(buf + 16384); const bf16_t* Ql = (const bf16_t*)(buf + 32768); const bf16_t* Al = (const bf16_t*)(buf + 49152);
        bf16x8 sb[4];
#pragma unroll
        for (int s = 0; s < 4; ++s) sb[s] = dn::packB(S[2 * s], S[2 * s + 1]);
        f32x4 vn[4], o[4];
#pragma unroll
        for (int mt = 0; mt < 4; ++mt) { vn[mt] = u_unpack(ucur[mt]); o[mt] = (f32x4){0.f, 0.f, 0.f, 0.f};
#pragma unroll
            for (int s = 0; s < 4; ++s) { vn[mt] = MFMA16(dn::frag(Wl, mt * 4 + s, lane), sb[s], vn[mt]); o[mt] = MFMA16(dn::frag(Ql, mt * 4 + s, lane), sb[s], o[mt]); } }
        bf16x8 vb[2];
#pragma unroll
        for (int s = 0; s < 2; ++s) vb[s] = dn::packB(vn[2 * s], vn[2 * s + 1]);
#pragma unroll
        for (int mt = 0; mt < 4; ++mt)
#pragma unroll
            for (int s = 0; s < 2; ++s) o[mt] = MFMA16(dn::frag(Al, mt * 2 + s, lane), vb[s], o[mt]);
#pragma unroll
        for (int mt = 0; mt < 8; ++mt) { S[mt] = S[mt] * eg;
#pragma unroll
            for (int s = 0; s < 2; ++s) S[mt] = MFMA16(dn::frag(Kl, mt * 2 + s, lane), vb[s], S[mt]); }
#pragma unroll
        for (int mt = 0; mt < 4; ++mt)
#pragma unroll
            for (int r = 0; r < 4; ++r) ORAW[(size_t)(n * CH + 16 * mt + 4 * lq + r) * 512 + h * 128 + 16 * vs + lr] = o[mt][r];
        if (i + 1 < GRP) { asm volatile("s_waitcnt vmcnt(0)" ::: "memory"); stage_write4(st, lds + ((i + 1) & 1) * SBUF);
#pragma unroll
            for (int mt = 0; mt < 4; ++mt) ucur[mt] = unxt[mt]; }
        __syncthreads();
    }
}
DI int fox_jlo(const Args& a, int h, int qb, const float* qkbs, int lane) {
    const float* Fh = (const float*)(a.ws + WS_F) + (size_t)h * SEQ; const float* TB = (const float*)(a.ws + WS_NRMT); const int P0 = qb * 256;
    float mq = 0.f, md = 3.0e38f;
    if (lane < 32) { mq = TB[(qb * 32 + lane) * 12 + h]; md = TB[(qb * 32 + lane) * 12 + 8 + h]; }
    for (int o_ = 1; o_ < 64; o_ <<= 1) { mq = fmaxf(mq, __shfl_xor(mq, o_)); md = fminf(md, __shfl_xor(md, o_)); }
    const float qkb = sqrtf(mq * qkbs[h]) * fox::SCALE, lim = Fh[P0] + qkb - md * fox::SCALE + 32.f;
    const int jd = P0 / 64, stride = jd / 64 + 1;
    int j = lane * stride; bool ok = (j > jd) ? true : (Fh[64 * j + 63] <= lim);
    unsigned long long mk = __ballot(ok); const int first = mk ? __builtin_ctzll(mk) : 64;
    const int lo_ex = first == 0 ? -1 : (first - 1) * stride; const int hi_in = (first < 64 && first * stride <= jd) ? first * stride : jd;
    j = lo_ex + 1 + lane; ok = (j < hi_in) ? (Fh[64 * j + 63] <= lim) : false;
    mk = __ballot(ok); return mk ? lo_ex + 1 + __builtin_ctzll(mk) : hi_in;
}
DI void ph4_fox(const Args& a, char* lds, int nscan) {
    const int tid = threadIdx.x, lane = tid & 63, wave = tid >> 6;
    const float* F = (const float*)(a.ws + WS_F); unsigned* QH = (unsigned*)(a.ws + WS_QH);
    int* misc = (int*)(lds + fox::OFF_MISC);
    if (tid == 0) { int ord0 = 0, ord1 = 1, ord2 = 2, ord3 = 3;
      float r0 = -F[0 * SEQ + SEQ - 1], r1 = -F[1 * SEQ + SEQ - 1], r2 = -F[2 * SEQ + SEQ - 1], r3 = -F[3 * SEQ + SEQ - 1];
#define CSWAP(ra, rb, oa, ob) if (rb < ra) { const float tf = ra; ra = rb; rb = tf; const int ti = oa; oa = ob; ob = ti; }
      CSWAP(r0, r1, ord0, ord1) CSWAP(r2, r3, ord2, ord3) CSWAP(r0, r2, ord0, ord2) CSWAP(r1, r3, ord1, ord3) CSWAP(r1, r2, ord1, ord2)
#undef CSWAP
      misc[4] = ord0; misc[5] = ord1; misc[6] = ord2; misc[7] = ord3; }
    float* qkbs = (float*)(lds + fox::OFF_MISC) + 8;
    const float* TB = (const float*)(a.ws + WS_NRMT);
    __syncthreads();
    { float m = 0.f; const int h = tid & 3;
        for (int g_ = tid >> 2; g_ < SEQ / 8; g_ += NTHREADS / 4) m = fmaxf(m, TB[g_ * 12 + 4 + h]);
        for (int o_ = 4; o_ < 64; o_ <<= 1) m = fmaxf(m, __shfl_xor(m, o_));
        if (lane < 4) qkbs[16 + wave * 4 + lane] = m; }
    __syncthreads();
    if (tid < 4) { float m = 0.f; for (int w = 0; w < NWAVES; ++w) m = fmaxf(m, qkbs[16 + w * 4 + tid]); qkbs[tid] = m; }
    __syncthreads();
    for (int round = 0;; ++round) {
        __syncthreads();
        if (tid == 0) misc[0] = (round == 0 && (int)blockIdx.x >= nscan) ? (int)blockIdx.x - nscan : (int)((int)gridDim.x - nscan + (int)atomicAdd(QH, 1u));
        __syncthreads();
        const int it = misc[0];
        if (it >= 256) break;
        const int h = misc[4 + (it >> 6)], qb = 63 - (it & 63), P0 = qb * 256;
        if (wave == 0) { const int jlo = fox_jlo(a, h, qb, qkbs, lane); if (lane == 0) misc[1] = jlo; }
        __syncthreads();
        fox::fox_block(a, lds, h, P0, misc[1]);
    }
    __syncthreads();
    if (wave < 4) { const int jl = fox_jlo(a, wave, 63, qkbs, lane); if (lane == 0) misc[60 + wave] = 256 - jl; }
    __syncthreads();
    if ((int)gridDim.x == 256 && nscan == NSCAN) {
        const int eA = 5 * misc[60 + misc[4]] + 10, eB = 5 * misc[60 + misc[5]] + 10, eC = 5 * misc[60 + misc[6]] + 10, eD = 5 * misc[60 + misc[7]] + 10;
        const int ld0 = 40 + eD, ld1 = eA, ld2 = eB, ld3 = eC;
        const int L = (T_WGU * 4 + 64 * (ld0 + ld1 + ld2 + ld3)) / 256;
        int J0 = (L - ld0) / 4, J1 = (L - ld1) / 4, J2 = (L - ld2) / 4, J3 = (L - ld3) / 4;
        J0 = J0 < 0 ? 0 : J0; J1 = J1 < 0 ? 0 : J1; J2 = J2 < 0 ? 0 : J2; J3 = J3 < 0 ? 0 : J3;
        const int tot = 64 * (J0 + J1 + J2 + J3), extra = tot < T_WGU ? (T_WGU - tot + 255) / 256 : 0;
        J0 += extra; J1 += extra; J2 += extra; J3 += extra;
        const int cls = (int)blockIdx.x >> 6, idx = (int)blockIdx.x & 63;
        const int Jc = cls == 0 ? J0 : (cls == 1 ? J1 : (cls == 2 ? J2 : J3));
        const int start = (cls > 0 ? 64 * J0 : 0) + (cls > 1 ? 64 * J1 : 0) + (cls > 2 ? 64 * J2 : 0) + idx * Jc;
        int end = start + Jc; end = end > T_WGU ? T_WGU : end;
        for (int t = start; t < end; ++t) conv_tile(a, (float*)lds, T_SMALL + t);
    } else {
        for (int t = blockIdx.x; t < T_WGU; t += gridDim.x) conv_tile(a, (float*)lds, T_SMALL + t);
    }
}
DI void ph4(const Args& a, float* lds) {
    const int nscan = (int)gridDim.x >= 2 * NSCAN ? NSCAN : 0;
    for (int chain = blockIdx.x; chain < NSCAN; chain += gridDim.x) scanA_chain(a, (char*)lds, chain);
    ph4_fox(a, (char*)lds, nscan);
}
DI void ph5_scan(const Args& a, float* lds) {
    const int G = gridDim.x;
    if (G >= 2 * NSCAN) {
        if ((int)blockIdx.x < NSCAN) scanPC_chain(a, (char*)lds, blockIdx.x);
        else for (int t = blockIdx.x - NSCAN; t < T_WD; t += G - NSCAN) conv_tile(a, lds, T_SMALL + T_WGU + t);
    } else {
        for (int chain = blockIdx.x; chain < NSCAN; chain += G) scanPC_chain(a, (char*)lds, chain);
        for (int t = blockIdx.x; t < T_WD; t += G) conv_tile(a, lds, T_SMALL + T_WGU + t);
    }
}

DI void ph5(const Args& a) {
    const int lane = threadIdx.x & 63, wave = threadIdx.x >> 6, NW = gridDim.x * NWAVES;
    const float* ORAW = (const float*)(a.ws + WS_ORAW); const bf16_t* P = (const bf16_t*)(a.ws + WS_PROJ); bf16_t* OA = (bf16_t*)(a.ws + WS_OA);
    const float g0 = a.in[I_GON][lane], g1 = a.in[I_GON][lane + 64];
    for (int id = blockIdx.x * NWAVES + wave; id < SEQ * 4; id += NW) { const int t = id >> 2, h = id & 3;
        const float o0 = ORAW[(size_t)t * 512 + h * 128 + lane], o1 = ORAW[(size_t)t * 512 + h * 128 + 64 + lane];
        const float rstd = rsqrtf(wave_sum(o0 * o0 + o1 * o1) * (1.f / 128.f) + 1e-6f);
        const float z0 = bf2f(P[(size_t)t * NPJ + PJ_DZ + h * 128 + lane]), z1 = bf2f(P[(size_t)t * NPJ + PJ_DZ + h * 128 + 64 + lane]);
        OA[(size_t)t * 512 + h * 128 + lane] = f2bf(o0 * rstd * g0 * siluf(z0)); OA[(size_t)t * 512 + h * 128 + 64 + lane] = f2bf(o1 * rstd * g1 * siluf(z1)); }
}

DI void ph6(const Args& a, unsigned char* ldsb) {
    const bf16_t* P = (const bf16_t*)(a.ws + WS_PROJ);
    pg8::OrderDense S; S.init(SEQ / 256, DM / 256, (int)gridDim.x, (int)blockIdx.x);
    { pg8::Gemm g{(const bf16_t*)(a.ws + WS_OA), (const bf16_t*)(a.ws + WS_WOAT), SEQ, DM, 512};
      pg8::EpiMerge<0> E{P + PJ_GA, (float*)(a.ws + WS_X1), (bf16_t*)(a.ws + WS_MRG)};
      pg8::gemm_phase<pg8::EpiMerge<0>, pg8::OrderDense>((LAS unsigned char*)ldsb, g, S, E); }
    __syncthreads();
    { pg8::Gemm g{(const bf16_t*)(a.ws + WS_OB), (const bf16_t*)(a.ws + WS_WOBT), SEQ, DM, 512};
      pg8::EpiMerge<1> E{P + PJ_GB, (float*)(a.ws + WS_X1), (bf16_t*)(a.ws + WS_MRG)};
      pg8::gemm_phase<pg8::EpiMerge<1>, pg8::OrderDense>((LAS unsigned char*)ldsb, g, S, E); }
}

DI void ph7(const Args& a, unsigned char* ldsb) {
    pg8::Gemm g{(const bf16_t*)(a.ws + WS_MRG), (const bf16_t*)(a.ws + WS_WOUTT), SEQ, DM, DM};
    pg8::OrderDense S; S.init(SEQ / 256, DM / 256, (int)gridDim.x, (int)blockIdx.x);
    pg8::EpiResid E{a.in[I_X], (const float*)(a.ws + WS_MOD) + 2048, (float*)(a.ws + WS_X1)};
    pg8::gemm_phase<pg8::EpiResid, pg8::OrderDense>((LAS unsigned char*)ldsb, g, S, E);
}

DI void ph8(const Args& a, float* lds) {
    const int tid = threadIdx.x, lane = tid & 63, wave = tid >> 6, G = gridDim.x;
    constexpr int HP = 1028;
    float* A2 = lds; float* B2 = lds + 1024; float* hs = lds + 2048; float* lgs = hs + 16 * HP;
    const float* mod = (const float*)(a.ws + WS_MOD);
    for (int k = tid; k < DM; k += NTHREADS) { A2[k] = a.in[I_G2][k] * (1.f + mod[4096 + k]); B2[k] = mod[3072 + k]; }
    const float* X1 = (const float*)(a.ws + WS_X1); bf16_t* H2 = (bf16_t*)(a.ws + WS_H2);
    int* TOKE = (int*)(a.ws + WS_TOKE); int* TOKS = (int*)(a.ws + WS_TOKS); float* TOKG = (float*)(a.ws + WS_TOKG); unsigned* CNT = (unsigned*)(a.ws + WS_CNT);
    const float* wr = a.in[I_WR];
    float* part = lgs + 512; int* lcnt = (int*)(part + 8 * 16 * 32);
    float wb0[32], wb1[32];
#pragma unroll
    for (int s = 0; s < 32; ++s) { const size_t k = (size_t)(128 * wave + 4 * s + (lane >> 4)); wb0[s] = wr[k * NE + (lane & 15)]; wb1[s] = wr[k * NE + 16 + (lane & 15)]; }
    for (int tile = blockIdx.x; tile < SEQ / 16; tile += G) {
        __syncthreads();
#pragma unroll 1
        for (int q = 0; q < 2; ++q) { const int tt = wave * 2 + q, t = tile * 16 + tt; const float* xr = X1 + (size_t)t * DM;
            f32x4 v[4]; float ss = 0.f;
#pragma unroll
            for (int i = 0; i < 4; ++i) { v[i] = *(const f32x4*)(xr + lane * 4 + 256 * i); ss += v[i][0] * v[i][0] + v[i][1] * v[i][1] + v[i][2] * v[i][2] + v[i][3] * v[i][3]; }
            ss = wave_sum(ss);
            const float rstd = rsqrtf(ss * (1.f / DM) + 1e-6f);
#pragma unroll
            for (int i = 0; i < 4; ++i) { const int k = lane * 4 + 256 * i;
#pragma unroll
                for (int e = 0; e < 4; ++e) v[i][e] = v[i][e] * rstd * A2[k + e] + B2[k + e];
                *(f32x4*)(hs + tt * HP + k) = v[i];
                u32x2 w; w.x = cvt_pk(v[i][0], v[i][1]); w.y = cvt_pk(v[i][2], v[i][3]);
                *(u32x2*)(H2 + (size_t)t * DM + k) = w; } }
        __syncthreads();
        {
            if (tid < 32) lcnt[tid] = 0;
            f32x4 c0 = (f32x4){0.f, 0.f, 0.f, 0.f}, c1 = c0; const float* ha = hs + (lane & 15) * HP + 128 * wave + (lane >> 4);
#pragma unroll
            for (int s = 0; s < 32; ++s) { const float av = ha[4 * s];
                c0 = __builtin_amdgcn_mfma_f32_16x16x4f32(av, wb0[s], c0, 0, 0, 0); c1 = __builtin_amdgcn_mfma_f32_16x16x4f32(av, wb1[s], c1, 0, 0, 0); }
#pragma unroll
            for (int r = 0; r < 4; ++r) { part[(wave * 16 + 4 * (lane >> 4) + r) * 32 + (lane & 15)] = c0[r]; part[(wave * 16 + 4 * (lane >> 4) + r) * 32 + 16 + (lane & 15)] = c1[r]; }
            __syncthreads();
            const int tt = tid >> 5, e = tid & 31; float acc = a.in[I_BR][e];
#pragma unroll
            for (int w = 0; w < 8; ++w) acc += part[(w * 16 + tt) * 32 + e];
            lgs[tt * 32 + e] = acc; }
        __syncthreads();
        { const int e = lane & 31, tt = wave * 2 + (lane >> 5), t = tile * 16 + tt;
            float cur = lgs[tt * 32 + e];
#define TOP1(TV, TI) float TV = cur; int TI = e; for (int o_ = 1; o_ <= 16; o_ <<= 1) { const float ov = __shfl_xor(TV, o_); const int oi = __shfl_xor(TI, o_); if (ov > TV || (ov == TV && oi < TI)) { TV = ov; TI = oi; } } if (e == TI) cur = -__builtin_inff();
            TOP1(tv0, ti0) TOP1(tv1, ti1) TOP1(tv2, ti2) TOP1(tv3, ti3)
#undef TOP1
            const float ex0 = 1.f, ex1 = expf(tv1 - tv0), ex2 = expf(tv2 - tv0), ex3 = expf(tv3 - tv0), den = ex0 + ex1 + ex2 + ex3;
            if (e < 4) { int ee = ti0; float gg = ex0;
                if (e == 1) { ee = ti1; gg = ex1; } if (e == 2) { ee = ti2; gg = ex2; } if (e == 3) { ee = ti3; gg = ex3; }
                const int rank = atomicAdd(lcnt + ee, 1);
                TOKE[t * 4 + e] = ee; TOKS[t * 4 + e] = rank; TOKG[t * 4 + e] = gg / den; } }
        __syncthreads();
        if (tid < 32) ((int*)(a.ws + WS_TCNT))[tile * 32 + tid] = lcnt[tid];
    }
}

DI void pad_starts(const Args& a, int* ps) {
    if (threadIdx.x == 0) { const unsigned* CNT = (const unsigned*)(a.ws + WS_CNT); int s = 0; for (int e = 0; e < NE; ++e) { ps[e] = s; s += (int)((CNT[e] + 255u) / 256u) * 256; } ps[NE] = s; }
    __syncthreads();
}
DI void ph9(const Args& a, float* lds) {
    const int tid = threadIdx.x, lane = tid & 63, wave = tid >> 6, G = gridDim.x;
    int* tab = (int*)lds; int* segs = tab + 32768; int* segoff = segs + 512; int* ps = segoff + 512; int* basel = ps + 64;
    const int* TCNT = (const int*)(a.ws + WS_TCNT);
    for (int i = tid; i < 8192; i += NTHREADS) ((u32x4*)tab)[i] = ((const u32x4*)TCNT)[i];
    __syncthreads();
    { const int e = tid & 31, sg = tid >> 5; int s = 0;
#pragma unroll 8
        for (int q = 0; q < 64; ++q) s += tab[(sg * 64 + q) * 32 + e];
        segs[sg * 32 + e] = s; }
    __syncthreads();
    if (tid < 32) { int run = 0; for (int sg = 0; sg < 16; ++sg) { segoff[sg * 32 + tid] = run; run += segs[sg * 32 + tid]; }
        segs[tid] = run;
        if (blockIdx.x == 0) ((unsigned*)(a.ws + WS_CNT))[tid] = (unsigned)run; }
    __syncthreads();
    if (tid == 0) { int s = 0; for (int e = 0; e < NE; ++e) { ps[e] = s; s += ((segs[e] + 255) / 256) * 256; } ps[NE] = s; }
    __syncthreads();
    const int* TOKE = (const int*)(a.ws + WS_TOKE); int* TOKS = (int*)(a.ws + WS_TOKS);
    const bf16_t* H2 = (const bf16_t*)(a.ws + WS_H2); bf16_t* XG = (bf16_t*)(a.ws + WS_XG);
    for (int tile = blockIdx.x; tile < SEQ / 16; tile += G) {
        __syncthreads();
        if (tid < 32) { int b = segoff[(tile >> 6) * 32 + tid]; for (int q = (tile >> 6) * 64; q < tile; ++q) b += tab[q * 32 + tid]; basel[tid] = ps[tid] + b; }
        __syncthreads();
#pragma unroll 1
        for (int q = 0; q < 8; ++q) { const int id = tile * 64 + wave * 8 + q, t = id >> 2;
            const size_t row = (size_t)(basel[TOKE[id]] + TOKS[id]);
            const u32x4 v0 = *(const u32x4*)(H2 + (size_t)t * DM + lane * 8), v1 = *(const u32x4*)(H2 + (size_t)t * DM + 512 + lane * 8);
            *(u32x4*)(XG + row * DM + lane * 8) = v0; *(u32x4*)(XG + row * DM + 512 + lane * 8) = v1;
            if (lane == 0) TOKS[id] = (int)row; }
    }
}
DI int expert_of(const int* ps, int row0) { int e = 0; for (int i = 1; i < NE; ++i) if (row0 >= ps[i]) e = i; return e; }
DI void ph10(const Args& a, unsigned char* ldsb) {
    int* ps = (int*)(ldsb + 131072); pad_starts(a, ps);
    pg8::Gemm g{(const bf16_t*)(a.ws + WS_XG), (const bf16_t*)(a.ws + WS_WGUT), 0, 2048, DM};
    pg8::OrderGrouped S; S.init(ps[NE] / 256, 8, (int)gridDim.x, (int)blockIdx.x); S.ps = (const LAS int*)ps;
    pg8::EpiSwiglu E{(bf16_t*)(a.ws + WS_ACT), a.in[I_BGU]};
    pg8::gemm_phase<pg8::EpiSwiglu, pg8::OrderGrouped>((LAS unsigned char*)ldsb, g, S, E);
}
DI void ph11(const Args& a, unsigned char* ldsb) {
    int* ps = (int*)(ldsb + 131072); pad_starts(a, ps);
    pg8::Gemm g{(const bf16_t*)(a.ws + WS_ACT), (const bf16_t*)(a.ws + WS_WDT), 0, DM, DM};
    pg8::OrderGrouped S; S.init(ps[NE] / 256, 4, (int)gridDim.x, (int)blockIdx.x); S.ps = (const LAS int*)ps;
    pg8::EpiStoreBf16 E{(bf16_t*)(a.ws + WS_YB), DM, a.in[I_BD], DM};
    pg8::gemm_phase<pg8::EpiStoreBf16, pg8::OrderGrouped>((LAS unsigned char*)ldsb, g, S, E);
}
DI void ph12(const Args& a, float* lds) {
    const int lane = threadIdx.x & 63, wave = threadIdx.x >> 6, G = gridDim.x;
    const float* X1 = (const float*)(a.ws + WS_X1); const bf16_t* YB = (const bf16_t*)(a.ws + WS_YB); const float* mod = (const float*)(a.ws + WS_MOD);
    const int* TOKS = (const int*)(a.ws + WS_TOKS); const float* TOKG = (const float*)(a.ws + WS_TOKG);
    f32x4 gt[4], gf[4];
#pragma unroll
    for (int i = 0; i < 4; ++i) { gt[i] = *(const f32x4*)(mod + 5120 + lane * 4 + 256 * i); gf[i] = *(const f32x4*)(a.in[I_GF] + lane * 4 + 256 * i); }
    for (int t0 = (blockIdx.x * NWAVES + wave) * 2; t0 < SEQ; t0 += G * NWAVES * 2) {
        int rows[2][4]; float gk[2][4];
#pragma unroll
        for (int p = 0; p < 2; ++p)
#pragma unroll
            for (int q = 0; q < 4; ++q) { rows[p][q] = TOKS[(t0 + p) * 4 + q]; gk[p][q] = TOKG[(t0 + p) * 4 + q]; }
        f32x4 v[2][4]; u32x2 yv[2][4][4];
#pragma unroll
        for (int p = 0; p < 2; ++p)
#pragma unroll
            for (int i = 0; i < 4; ++i) { const int k = lane * 4 + 256 * i; v[p][i] = *(const f32x4*)(X1 + (size_t)(t0 + p) * DM + k);
#pragma unroll
                for (int q = 0; q < 4; ++q) yv[p][i][q] = *(const u32x2*)(YB + (size_t)rows[p][q] * DM + k); }
#pragma unroll
        for (int p = 0; p < 2; ++p) { float ss = 0.f;
#pragma unroll
            for (int i = 0; i < 4; ++i) { f32x4 y = (f32x4){0.f, 0.f, 0.f, 0.f};
#pragma unroll
                for (int q = 0; q < 4; ++q) { const u32x2 w = yv[p][i][q];
                    y[0] += gk[p][q] * __uint_as_float(w.x << 16); y[1] += gk[p][q] * __uint_as_float(w.x & 0xffff0000u); y[2] += gk[p][q] * __uint_as_float(w.y << 16); y[3] += gk[p][q] * __uint_as_float(w.y & 0xffff0000u); }
                v[p][i] += gt[i] * y; ss += v[p][i][0] * v[p][i][0] + v[p][i][1] * v[p][i][1] + v[p][i][2] * v[p][i][2] + v[p][i][3] * v[p][i][3]; }
            ss = wave_sum(ss);
            const float rstd = rsqrtf(ss * (1.f / DM) + 1e-6f);
#pragma unroll
            for (int i = 0; i < 4; ++i) *(f32x4*)(a.out + (size_t)(t0 + p) * DM + lane * 4 + 256 * i) = v[p][i] * rstd * gf[i]; }
    }
}

__global__ void __launch_bounds__(NTHREADS, 2) hybrid_fwd(Args a) {
    extern __shared__ __attribute__((aligned(16))) unsigned char lds_raw[];
    float* lds = (float*)(lds_raw + 16);
    LAS unsigned* xbw = (LAS unsigned*)lds_raw;
    if (threadIdx.x == 0) { xbw[0] = 0u; xbw[1] = 0u; xbw[2] = 0u; xbw[3] = 0u; }
    __syncthreads();
    XcdBarrier bar; bar.bar = (unsigned*)(a.ws + WS_BAR); bar.x = 0; bar.st = (volatile LAS unsigned*)xbw;
    const int lo = a.ph_lo, hi = a.ph_hi;
    if (hi - lo > 1) bar = xcd_barrier_post((unsigned*)(a.ws + WS_BAR), (volatile LAS unsigned*)xbw);
#define IN(k) (lo <= (k) && (k) < hi)
#define SEAM(k) do { if (IN(k) && IN((k) + 1)) xcd_barrier(bar); } while (0)
    if (IN(0)) ph0(a, lds);
    SEAM(0);
    if (IN(1)) ph1(a, lds);
    SEAM(1);
    if (IN(2)) ph2(a, lds_raw + 16);
    SEAM(2);
    if (IN(3)) ph3(a, lds);
    SEAM(3);
    if (IN(4)) ph4(a, lds);
    SEAM(4);
    if (IN(5)) ph5_scan(a, lds);
    SEAM(5);
    if (IN(6)) ph5(a);
    SEAM(6);
    if (IN(7)) ph6(a, lds_raw + 16);
    SEAM(7);
    if (IN(8)) ph7(a, lds_raw + 16);
    SEAM(8);
    if (IN(9)) ph8(a, lds);
    SEAM(9);
    if (IN(10)) ph9(a, lds);
    SEAM(10);
    if (IN(11)) ph10(a, lds_raw + 16);
    SEAM(11);
    if (IN(12)) ph11(a, lds_raw + 16);
    SEAM(12);
    if (IN(13)) ph12(a, lds);
#undef IN
#undef SEAM
}

extern "C" void kernel_launch(void* const* d_in, const int* in_sizes, int n_in, void* d_out, int out_size, void* d_ws, size_t ws_size, hipStream_t stream) {
    static int grid = 0;
    if (grid == 0) {
        if (n_in != 22 || out_size != SEQ * DM || ws_size < WS_END) { fprintf(stderr, "kernel_launch: unexpected shapes (n_in %d out %d ws %zu, need %zu)\n", n_in, out_size, ws_size, (size_t)WS_END); grid = -1; return; }
        int dev = 0, cus = 0, per_cu = 0;
        if (hipGetDevice(&dev) != hipSuccess || hipDeviceGetAttribute(&cus, hipDeviceAttributeMultiprocessorCount, dev) != hipSuccess) { grid = -1; return; }
        if (hipFuncSetAttribute((const void*)hybrid_fwd, hipFuncAttributeMaxDynamicSharedMemorySize, LDS_BYTES) != hipSuccess) { fprintf(stderr, "kernel_launch: hipFuncSetAttribute failed\n"); grid = -1; return; }
        if (hipOccupancyMaxActiveBlocksPerMultiprocessor(&per_cu, (const void*)hybrid_fwd, NTHREADS, LDS_BYTES) != hipSuccess || per_cu < 1) { fprintf(stderr, "kernel_launch: occupancy query says %d\n", per_cu); }
        (void)hipGetLastError();
        grid = cus;
    }
    if (grid < 0) return;
    (void)hipMemsetAsync(d_ws, 0, CTL_ZERO, stream);
    Args a{};
    for (int i = 0; i < 22; ++i) a.in[i] = (const float*)d_in[i];
    a.out = (float*)d_out; a.ws = (unsigned char*)d_ws;
#if N_LAUNCHES == 1
    a.ph_lo = 0; a.ph_hi = NPHASES;
    hipLaunchKernelGGL(hybrid_fwd, dim3(grid), dim3(NTHREADS), LDS_BYTES, stream, a);
#else
    for (int p = 0; p < NPHASES; ++p) { a.ph_lo = p; a.ph_hi = p + 1; hipLaunchKernelGGL(hybrid_fwd, dim3(grid), dim3(NTHREADS), LDS_BYTES, stream, a); }
#endif
}
```

```cpp
#include <hip/hip_runtime.h>
#include <stdint.h>
#include <stdio.h>

#ifndef N_LAUNCHES
#define N_LAUNCHES 1
#endif

#define DI __device__ __forceinline__
#define LAS __attribute__((address_space(3)))
typedef unsigned short bf16_t;
typedef short bf16x8 __attribute__((ext_vector_type(8)));
typedef float f32x4 __attribute__((ext_vector_type(4)));
typedef unsigned u32x4 __attribute__((ext_vector_type(4)));
typedef unsigned u32x2 __attribute__((ext_vector_type(2)));

constexpr int SEQ = 16384, DM = 1024, NIN = 5644, NPJ = 5632, NE = 32, TOPK = 4;
constexpr int NH = 4, HD = 128, CH = 64, NCH = SEQ / CH;
constexpr int PJ_DQ = 0, PJ_DK = 512, PJ_DV = 1024, PJ_DZ = 1536, PJ_FQ = 2048, PJ_FK = 2560, PJ_FV = 3072, PJ_GA = 3584, PJ_GB = 4608;
constexpr int NTHREADS = 512, NWAVES = 8;
constexpr int LDS_BYTES = 152 * 1024;
constexpr int NPHASES = 14;

constexpr size_t MiB = 1u << 20;
constexpr size_t WS_BAR = 0;
constexpr size_t WS_CNT = 32768;
constexpr size_t WS_NRM = 32768 + 256;
constexpr size_t WS_QH = 32768 + 512;
constexpr size_t CTL_ZERO = 65536;
constexpr size_t WS_MOD = 65536;
constexpr size_t WS_F = WS_MOD + 32768;
constexpr size_t WS_EG = WS_F + 262144;
constexpr size_t WS_TOKE = WS_EG + 4096;
constexpr size_t WS_TOKS = WS_TOKE + 262144;
constexpr size_t WS_TOKG = WS_TOKS + 262144;
constexpr size_t WS_SP = WS_TOKG + 262144;
constexpr size_t WS_WINT = WS_SP + MiB;
constexpr size_t WS_WOAT = WS_WINT + (size_t)NPJ * DM * 2;
constexpr size_t WS_WOBT = WS_WOAT + MiB;
constexpr size_t WS_WOUTT = WS_WOBT + MiB;
constexpr size_t WS_WGUT = WS_WOUTT + 2 * MiB;
constexpr size_t WS_WDT = WS_WGUT + 128 * MiB;
constexpr size_t WS_X1 = WS_WDT + 64 * MiB;
constexpr size_t WS_H2 = WS_X1 + 64 * MiB;
constexpr size_t WS_MRG = WS_H2 + 32 * MiB;
constexpr size_t WS_RA = WS_MRG + 32 * MiB;
constexpr size_t WS_RB = WS_RA + 176 * MiB;
constexpr size_t WS_H = WS_RB;
constexpr size_t WS_DNW = WS_H + 32 * MiB;
constexpr size_t WS_DNU = WS_DNW + 16 * MiB;
constexpr size_t WS_DNQD = WS_DNU + 16 * MiB;
constexpr size_t WS_DNKD = WS_DNQD + 16 * MiB;
constexpr size_t WS_DNATT = WS_DNKD + 16 * MiB;
constexpr size_t WS_ORAW = WS_DNATT + 8 * MiB;
constexpr size_t WS_OA = WS_ORAW + 32 * MiB;
constexpr size_t WS_OB = WS_OA + 16 * MiB;
constexpr size_t WS_VT = WS_OB + 16 * MiB;
constexpr size_t WS_PG = WS_VT;
constexpr size_t WS_QG = WS_PG + 2 * MiB;
constexpr size_t WS_SG = WS_QG + 4 * MiB;
constexpr size_t WS_TCNT = WS_SG + 4 * MiB;
constexpr size_t WS_NRMT = WS_TCNT + 131072;
constexpr size_t WS_END = WS_RB + 184 * MiB;
constexpr size_t WS_XG = WS_RA, WS_YB = WS_RA, WS_ACT = WS_RB, WS_PROJ = WS_RA;
static_assert(WS_VT + 16 * MiB <= WS_END, "region B");

struct Args { const float* in[22]; float* out; unsigned char* ws; int ph_lo, ph_hi; };
enum { I_X = 0, I_C, I_WADA, I_BADA, I_G1, I_WIN, I_CONVW, I_ALOG, I_DTB, I_GON, I_BFG, I_WOD, I_WOF, I_WOUT, I_G2, I_WR, I_BR, I_WGU, I_BGU, I_WD, I_BD, I_GF };

DI float bf2f(bf16_t v) { return __uint_as_float(((unsigned)v) << 16); }
DI bf16_t f2bf(float f) { unsigned u = __float_as_uint(f); u += 0x7fffu + ((u >> 16) & 1u); return (bf16_t)(u >> 16); }
typedef float f32x2_t __attribute__((ext_vector_type(2)));
typedef __bf16 bf16x2_t __attribute__((ext_vector_type(2)));
DI unsigned cvt_pk(float lo, float hi) { const f32x2_t v = {lo, hi}; const bf16x2_t b = __builtin_convertvector(v, bf16x2_t); return __builtin_bit_cast(unsigned, b); }
DI unsigned pk2(float lo, float hi) { return (unsigned)f2bf(lo) | ((unsigned)f2bf(hi) << 16); }
DI float sigm(float x) { return 1.f / (1.f + expf(-x)); }
DI float siluf(float x) { return x / (1.f + expf(-x)); }
DI float softplusf(float x) { return fmaxf(x, 0.f) + log1pf(expf(-fabsf(x))); }
DI float logsigf(float x) { return fminf(x, 0.f) - log1pf(expf(-fabsf(x))); }
DI float wave_sum(float v) { for (int o = 32; o >= 1; o >>= 1) v += __shfl_xor(v, o); return v; }
#define MFMA16(a, b, c) __builtin_amdgcn_mfma_f32_16x16x32_bf16((a), (b), (c), 0, 0, 0)

DI int gu_src(int n) { const int g = n >> 8, r = n & 255; return r < 128 ? 128 * g + r : 1024 + 128 * g + (r - 128); }

#define XB_TMO      128
#define XB_XCNT(j)  (256  + 64 * (j))
#define XB_XSUB(j)  (1280 + 64 * (j))
#define XB_XGEN(j)  (2304 + 64 * (j))
#define XB_TOP      3328
#define XB_TOPGEN   3392
#define XCD_BAR_WORDS 3456
#define XB_SPIN_CAP (1u << 22)
DI unsigned xb_ld(unsigned* p)              { return __hip_atomic_load(p, __ATOMIC_RELAXED, __HIP_MEMORY_SCOPE_AGENT); }
DI unsigned xb_add(unsigned* p, unsigned v) { return __hip_atomic_fetch_add(p, v, __ATOMIC_RELAXED, __HIP_MEMORY_SCOPE_AGENT); }
DI unsigned xb_xcc_id() { return (unsigned)__builtin_amdgcn_s_getreg((3 << 11) | 20) & 0xFu; }
#define XB_SPIN(cond, bar) do { unsigned _sp = 0; while (cond) { __builtin_amdgcn_s_sleep(1); \
    if ((++_sp & 255u) == 0u) { if (xb_ld(&(bar)[XB_TMO])) break; if (_sp > XB_SPIN_CAP) { atomicAdd(&(bar)[XB_TMO], 1u); break; } } } } while (0)
struct XcdBarrier { unsigned* bar; unsigned x; volatile LAS unsigned* st; };
DI XcdBarrier xcd_barrier_post(unsigned* bar, volatile LAS unsigned* st) {
    XcdBarrier b; b.bar = bar; b.x = xb_xcc_id(); b.st = st;
    if (threadIdx.x == 0) (void)xb_add(&bar[XB_XCNT(b.x)], 1u);
    return b;
}
DI void xcd_barrier_complete(unsigned* bar, unsigned x, unsigned& nloc, unsigned& nx) {
    const unsigned G = gridDim.x * gridDim.y * gridDim.z;
    unsigned sum, cnt, mine, sp = 0u;
    for (;;) {
        sum = 0u; cnt = 0u; mine = 0u;
#pragma unroll
        for (unsigned j = 0; j < 16; ++j) { const unsigned c = xb_ld(&bar[XB_XCNT(j)]); sum += c; cnt += (c > 0u) ? 1u : 0u; mine = (j == x) ? c : mine; }
        if (sum == G) break;
        __builtin_amdgcn_s_sleep(1);
        if ((++sp & 255u) == 0u) { if (xb_ld(&bar[XB_TMO])) break; if (sp > XB_SPIN_CAP) { atomicAdd(&bar[XB_TMO], 1u); break; } }
    }
    nloc = mine > 0u ? mine : 1u; nx = cnt > 0u ? cnt : 1u;
}
DI void xcd_barrier(const XcdBarrier& b) {
    asm volatile("s_waitcnt vmcnt(0)" ::: "memory");
    __syncthreads();
    if (threadIdx.x == 0) {
        unsigned* bar = b.bar;
        __builtin_amdgcn_s_waitcnt(0);
        unsigned nloc = b.st[0], nx = b.st[1];
        if (nloc == 0u) { xcd_barrier_complete(bar, b.x, nloc, nx); b.st[0] = nloc; b.st[1] = nx; }
        const unsigned old = xb_add(&bar[XB_XSUB(b.x)], 1u);
        const unsigned gen = old / nloc;
        if (old + 1u == (gen + 1u) * nloc) {
            __builtin_amdgcn_fence(__ATOMIC_RELEASE, "agent");
            asm volatile("s_waitcnt vmcnt(0)" ::: "memory");
            const unsigned og = xb_add(&bar[XB_TOP], 1u);
            const unsigned tg = og / nx;
            if (og + 1u == (tg + 1u) * nx) xb_add(&bar[XB_TOPGEN], 1u);
            else XB_SPIN(xb_ld(&bar[XB_TOPGEN]) == tg, bar);
            __builtin_amdgcn_fence(__ATOMIC_ACQUIRE, "agent");
            xb_add(&bar[XB_XGEN(b.x)], 1u);
            asm volatile("s_waitcnt vmcnt(0)" ::: "memory");
        } else {
            XB_SPIN(xb_ld(&bar[XB_XGEN(b.x)]) == gen, bar);
            __builtin_amdgcn_fence(__ATOMIC_ACQUIRE, "agent");
            asm volatile("s_waitcnt vmcnt(0)" ::: "memory");
        }
    }
    __syncthreads();
}

template <int NT>
DI void wave_gemm(const bf16_t* const (&ap)[4], const bf16_t* const (&bp)[NT], int K, f32x4 (&acc)[4][NT]) {
    for (int k0 = 0; k0 < K; k0 += 32) {
        bf16x8 a[4], b[NT];
#pragma unroll
        for (int i = 0; i < 4; ++i) a[i] = *(const bf16x8*)(ap[i] + k0);
#pragma unroll
        for (int j = 0; j < NT; ++j) b[j] = *(const bf16x8*)(bp[j] + k0);
#pragma unroll
        for (int i = 0; i < 4; ++i)
#pragma unroll
            for (int j = 0; j < NT; ++j) acc[i][j] = MFMA16(a[i], b[j], acc[i][j]);
    }
}
template <int NT> DI void zero_acc(f32x4 (&acc)[4][NT]) {
#pragma unroll
    for (int i = 0; i < 4; ++i)
#pragma unroll
        for (int j = 0; j < NT; ++j) acc[i][j] = (f32x4){0.f, 0.f, 0.f, 0.f};
}


namespace pg8 {
struct Unit { int pm, pn, pb, e; };
struct Gemm { const bf16_t* A; const bf16_t* Bt; int M, N, K; };
constexpr int BM = 256, BK = 64, HALF = 128, HTB = HALF * BK * 2  , STAGE_BYTES = 8 * HTB, NXCD = 8, WGM = 8;

__host__ __device__ __forceinline__ int lds_byte(int r, int c) { const int st = (r >> 4) * 2 + (c >> 5), rr = r & 15, cc = c & 31, ob = rr * 64 + cc * 2; return st * 1024 + (ob ^ (((ob >> 9) & 1) << 5)); }
__host__ __device__ __forceinline__ void stage_rc(int b, int& R, int& C) { const int st = b / 1024, sb = b % 1024, swz = sb ^ (((sb >> 9) & 1) << 5); R = (st >> 1) * 16 + swz / 64; C = (st & 1) * 32 + (swz % 64) / 2; }
__host__ __device__ __forceinline__ int perm32(int rho) { const int n = rho >> 4, i = rho & 15; return 8 * (i >> 2) + 4 * n + (i & 3); }
template <class Epi, class Sched>
__device__ __forceinline__ void gemm_phase(LAS unsigned char* lds, const Gemm g, const Sched& S, const Epi& E) {
    const int tid = threadIdx.x, wid = __builtin_amdgcn_readfirstlane(tid >> 6), lane = tid & 63, wr = wid >> 2, wc = wid & 3, fr = lane & 15, fq = lane >> 4;
    const int K = g.K, nt = K / BK;
    unsigned voffA[2], voffB[2];
#pragma unroll
    for (int i = 0; i < 2; ++i) { int R, C; stage_rc(tid * 16 + i * 8192, R, C); const int Rb = Epi::PERM ? ((R & ~31) + perm32(R & 31)) : R;
        voffA[i] = (unsigned)(R * K + C) * 2u; voffB[i] = (unsigned)(Rb * K + C) * 2u; }
    const size_t kstep = (size_t)(BK * 2);
    const size_t hstep = (size_t)HALF * K * 2;
    const size_t tstep = 2 * hstep;
    const unsigned ldsw = (unsigned)wid * 1024u;
    const int aoff = lds_byte(wr * 64 + fr, fq * 8), boff = lds_byte(wc * 32 + fr, fq * 8);
#define PG8_SA(b, h) (((b) * 2 + (h)) * HTB)
#define PG8_SB(b, h) ((4 + (b) * 2 + (h)) * HTB)
#define PG8_STAGE(bufoff, gbase, voff) do { _Pragma("unroll") for (int _i = 0; _i < 2; ++_i) \
        __builtin_amdgcn_global_load_lds((const unsigned*)((const char*)(gbase) + (voff)[_i]), (LAS unsigned*)(lds + (bufoff) + ldsw + _i * 8192), 16, 0, 0); } while (0)
#define PG8_LDA(dst, b, h) do { _Pragma("unroll") for (int m = 0; m < 4; ++m) _Pragma("unroll") for (int k = 0; k < 2; ++k) dst[m][k] = *(const LAS bf16x8*)(lds + PG8_SA(b, h) + aoff + m * 2048 + k * 1024); } while (0)
#define PG8_LDB(dst, b, h) do { _Pragma("unroll") for (int n = 0; n < 2; ++n) _Pragma("unroll") for (int k = 0; k < 2; ++k) dst[n][k] = *(const LAS bf16x8*)(lds + PG8_SB(b, h) + boff + n * 2048 + k * 1024); } while (0)
#define PG8_MMA(ai, bj, At, Bt) do { __builtin_amdgcn_s_setprio(1); _Pragma("unroll") for (int m = 0; m < 4; ++m) _Pragma("unroll") for (int n = 0; n < 2; ++n) _Pragma("unroll") for (int k = 0; k < 2; ++k) \
        acc[ai][bj][m][n] = __builtin_amdgcn_mfma_f32_16x16x32_bf16(Bt[n][k], At[m][k], acc[ai][bj][m][n], 0, 0, 0); __builtin_amdgcn_s_setprio(0); } while (0)
#define PG8_WAIT_V(n) asm volatile("s_waitcnt vmcnt(" #n ")" ::: "memory")
#define PG8_WAIT_L(n) asm volatile("s_waitcnt lgkmcnt(" #n ")" ::: "memory")
#define PG8_BAR __builtin_amdgcn_s_barrier()
#define PG8_SCHED __builtin_amdgcn_sched_barrier(0)
    Unit cur, nxt; int ui = 0;
    if (!S.next(0, cur)) return;
    f32x4 acc[2][2][4][2];
#pragma unroll
    for (int a = 0; a < 2; ++a)
#pragma unroll
        for (int b = 0; b < 2; ++b)
#pragma unroll
            for (int m = 0; m < 4; ++m)
#pragma unroll
                for (int n = 0; n < 2; ++n) acc[a][b][m][n] = (f32x4){0.f, 0.f, 0.f, 0.f};
    bf16x8 At[4][2], B0[2][2], B1[2][2];
    const char* cA = (const char*)g.A + (size_t)cur.pm * tstep; const char* cB = (const char*)g.Bt + (size_t)cur.pb * tstep;
    S.a_ready(cur);
    PG8_STAGE(PG8_SB(0, 0), cB, voffB); PG8_STAGE(PG8_SA(0, 0), cA, voffA); PG8_STAGE(PG8_SB(0, 1), cB + hstep, voffB); PG8_STAGE(PG8_SA(0, 1), cA + hstep, voffA);
    if (wr == 1) PG8_BAR;
    PG8_WAIT_V(4); PG8_BAR;
    PG8_STAGE(PG8_SB(1, 0), cB + kstep, voffB); PG8_STAGE(PG8_SA(1, 0), cA + kstep, voffA); PG8_STAGE(PG8_SB(1, 1), cB + hstep + kstep, voffB);
    PG8_WAIT_V(6); PG8_BAR;
    for (;;) {
        const bool has_next = S.next(ui + 1, nxt);
        const char* nA = has_next ? (const char*)g.A + (size_t)nxt.pm * tstep : cA; const char* nB = has_next ? (const char*)g.Bt + (size_t)nxt.pb * tstep : cB;
        for (int t = 0; t < nt; t += 2) {
            const bool last = (t == nt - 2);
            const char* a1 = cA + (size_t)(t + 1) * kstep;
            const char* a2 = last ? nA : cA + (size_t)(t + 2) * kstep; const char* b2 = last ? nB : cB + (size_t)(t + 2) * kstep;
            const char* a3 = a2 + kstep; const char* b3 = b2 + kstep;
            if (last && has_next) S.a_ready(nxt);
            PG8_LDB(B0, 0, 0); PG8_SCHED; PG8_LDA(At, 0, 0); PG8_STAGE(PG8_SA(1, 1), a1 + hstep, voffA);
            PG8_WAIT_L(8); PG8_BAR; PG8_WAIT_L(0); PG8_MMA(0, 0, At, B0); PG8_BAR; PG8_SCHED;
            PG8_LDB(B1, 0, 1); PG8_STAGE(PG8_SB(0, 0), b2, voffB);
            PG8_BAR; PG8_WAIT_L(0); PG8_MMA(0, 1, At, B1); PG8_BAR;
            PG8_LDA(At, 0, 1); PG8_STAGE(PG8_SA(0, 0), a2, voffA);
            PG8_BAR; PG8_WAIT_L(0); PG8_MMA(1, 0, At, B0); PG8_BAR; PG8_SCHED;
            PG8_STAGE(PG8_SB(0, 1), b2 + hstep, voffB);
            PG8_WAIT_V(6); PG8_BAR; PG8_MMA(1, 1, At, B1); PG8_BAR;
            PG8_LDB(B0, 1, 0); PG8_SCHED; PG8_LDA(At, 1, 0); PG8_STAGE(PG8_SA(0, 1), a2 + hstep, voffA);
            PG8_WAIT_L(8); PG8_BAR; PG8_WAIT_L(0); PG8_MMA(0, 0, At, B0); PG8_BAR; PG8_SCHED;
            PG8_LDB(B1, 1, 1); PG8_STAGE(PG8_SB(1, 0), b3, voffB);
            PG8_BAR; PG8_WAIT_L(0); PG8_MMA(0, 1, At, B1); PG8_BAR;
            PG8_LDA(At, 1, 1); PG8_STAGE(PG8_SA(1, 0), a3, voffA);
            PG8_BAR; PG8_WAIT_L(0); PG8_MMA(1, 0, At, B0); PG8_BAR; PG8_SCHED;
            PG8_STAGE(PG8_SB(1, 1), b3 + hstep, voffB);
            PG8_WAIT_V(6); PG8_BAR; PG8_MMA(1, 1, At, B1); PG8_BAR;
        }
        if constexpr (!Epi::AFTER_DRAIN) { E(acc, cur, wr, wc, fr, fq); S.done(cur); }
        if (!has_next) break;
#pragma unroll
        for (int a = 0; a < 2; ++a)
#pragma unroll
            for (int b = 0; b < 2; ++b)
#pragma unroll
                for (int m = 0; m < 4; ++m)
#pragma unroll
                    for (int n = 0; n < 2; ++n) acc[a][b][m][n] = (f32x4){0.f, 0.f, 0.f, 0.f};
        cur = nxt; cA = nA; cB = nB; ++ui;
    }
    PG8_WAIT_V(0);
    if (wr == 0) PG8_BAR;
    PG8_BAR;
    if constexpr (Epi::AFTER_DRAIN) { E.fused(acc, cur, wr, wc, fr, fq, lds, wid, lane); S.done(cur); }
#undef PG8_SA
#undef PG8_SB
#undef PG8_STAGE
#undef PG8_LDA
#undef PG8_LDB
#undef PG8_MMA
#undef PG8_WAIT_V
#undef PG8_WAIT_L
#undef PG8_BAR
#undef PG8_SCHED
}

DI unsigned cvt_pk_bf16(float lo, float hi) { return cvt_pk(lo, hi); }
DI float fsig(float x) { return __builtin_amdgcn_rcpf(1.f + __builtin_amdgcn_exp2f(-1.4426950408889634f * x)); }
DI int expert_of_l(const LAS int* ps, int row0) { int e = 0;
#pragma unroll 1
    for (int i = 1; i < NE; ++i) if (row0 >= ps[i]) e = i; return e; }
struct OrderDense {
    int nM, nN, nwg, G, c;
    DI void init(int nM_, int nN_, int G_, int c_) { nM = nM_; nN = nN_; nwg = nM * nN; G = G_; c = c_; }
    DI bool tile(int i, Unit& u) const {
        const long L = (long)i * G + c; if (L >= nwg) return false;
        int wgid = (int)L; { const int q = nwg / NXCD, r = nwg % NXCD, xcd = wgid % NXCD, off = wgid / NXCD; wgid = (xcd < r ? xcd * (q + 1) : r * (q + 1) + (xcd - r) * q) + off; }
        const int nig = WGM * nN, gid = wgid / nig, fm = gid * WGM, gsz = (nM - fm) < WGM ? (nM - fm) : WGM;
        u.pm = fm + ((wgid % nig) % gsz); u.pn = (wgid % nig) / gsz; return true;
    }
    DI bool next(int i, Unit& u) const { if (!tile(i, u)) return false; u.pb = u.pn; u.e = 0; return true; }
    DI void a_ready(const Unit&) const {}
    DI void done(const Unit&) const {}
};
struct OrderGrouped : OrderDense {
    const LAS int* ps;
    DI bool next(int i, Unit& u) const { if (!tile(i, u)) return false; u.e = expert_of_l(ps, u.pm * BM); u.pb = u.e * nN + u.pn; return true; }
};
struct EpiStoreBf16 {
    static constexpr bool PERM = true, AFTER_DRAIN = false;
    bf16_t* O; int ldc; const float* bias; int bstride;
    DI void operator()(const f32x4 (&acc)[2][2][4][2], const Unit& u, int wr, int wc, int fr, int fq) const {
        const int row0 = u.pm * BM + wr * 64 + fr, col0 = u.pn * BM + wc * 32 + 8 * fq;
        f32x4 bv[2][2];
#pragma unroll
        for (int bj = 0; bj < 2; ++bj)
#pragma unroll
            for (int n = 0; n < 2; ++n) bv[bj][n] = bias ? *(const f32x4*)(bias + (size_t)u.e * bstride + col0 + bj * HALF + 4 * n) : (f32x4){0.f, 0.f, 0.f, 0.f};
#pragma unroll
        for (int ai = 0; ai < 2; ++ai)
#pragma unroll
            for (int m = 0; m < 4; ++m) { bf16_t* rowp = O + (size_t)(row0 + ai * HALF + m * 16) * ldc + col0;
#pragma unroll
                for (int bj = 0; bj < 2; ++bj) { const f32x4 v0 = acc[ai][bj][m][0] + bv[bj][0], v1 = acc[ai][bj][m][1] + bv[bj][1];
                    u32x4 w; w.x = cvt_pk_bf16(v0[0], v0[1]); w.y = cvt_pk_bf16(v0[2], v0[3]); w.z = cvt_pk_bf16(v1[0], v1[1]); w.w = cvt_pk_bf16(v1[2], v1[3]);
                    *(u32x4*)(rowp + bj * HALF) = w; } }
    }
};
template <int SECOND> struct EpiMerge {
    static constexpr bool PERM = true, AFTER_DRAIN = false;
    const bf16_t* gate; float* T; bf16_t* O;
    DI void operator()(const f32x4 (&acc)[2][2][4][2], const Unit& u, int wr, int wc, int fr, int fq) const {
        const int row0 = u.pm * BM + wr * 64 + fr, col0 = u.pn * BM + wc * 32 + 8 * fq;
#pragma unroll
        for (int ai = 0; ai < 2; ++ai)
#pragma unroll
            for (int mp = 0; mp < 2; ++mp) {
                u32x4 g[2][2]; f32x4 t0[2][2], t1[2][2];
#pragma unroll
                for (int mm = 0; mm < 2; ++mm)
#pragma unroll
                    for (int bj = 0; bj < 2; ++bj) { const size_t row = (size_t)(row0 + ai * HALF + (2 * mp + mm) * 16); const int col = col0 + bj * HALF;
                        g[mm][bj] = *(const u32x4*)(gate + row * NPJ + col);
                        if (SECOND) { t0[mm][bj] = *(const f32x4*)(T + row * DM + col); t1[mm][bj] = *(const f32x4*)(T + row * DM + col + 4); } }
#pragma unroll
                for (int mm = 0; mm < 2; ++mm)
#pragma unroll
                    for (int bj = 0; bj < 2; ++bj) { const int m = 2 * mp + mm; const size_t row = (size_t)(row0 + ai * HALF + m * 16); const int col = col0 + bj * HALF;
                        const u32x4 gg = g[mm][bj]; f32x4 v0 = acc[ai][bj][m][0], v1 = acc[ai][bj][m][1];
                        v0[0] *= fsig(__uint_as_float(gg.x << 16)); v0[1] *= fsig(__uint_as_float(gg.x & 0xffff0000u)); v0[2] *= fsig(__uint_as_float(gg.y << 16)); v0[3] *= fsig(__uint_as_float(gg.y & 0xffff0000u));
                        v1[0] *= fsig(__uint_as_float(gg.z << 16)); v1[1] *= fsig(__uint_as_float(gg.z & 0xffff0000u)); v1[2] *= fsig(__uint_as_float(gg.w << 16)); v1[3] *= fsig(__uint_as_float(gg.w & 0xffff0000u));
                        if (SECOND == 0) { float* tp = T + row * DM + col; *(f32x4*)tp = v0; *(f32x4*)(tp + 4) = v1; }
                        else { v0 += t0[mm][bj]; v1 += t1[mm][bj];
                            u32x4 w; w.x = cvt_pk_bf16(v0[0], v0[1]); w.y = cvt_pk_bf16(v0[2], v0[3]); w.z = cvt_pk_bf16(v1[0], v1[1]); w.w = cvt_pk_bf16(v1[2], v1[3]);
                            *(u32x4*)(O + row * DM + col) = w; } }
            }
    }
};
struct EpiResid {
    static constexpr bool PERM = false, AFTER_DRAIN = false;
    const float* x; const float* gt; float* X1;
    DI void operator()(const f32x4 (&acc)[2][2][4][2], const Unit& u, int wr, int wc, int fr, int fq) const {
        const int row0 = u.pm * BM + wr * 64 + fr, col0 = u.pn * BM + wc * 32 + 4 * fq;
        f32x4 gv[2][2];
#pragma unroll
        for (int bj = 0; bj < 2; ++bj)
#pragma unroll
            for (int n = 0; n < 2; ++n) gv[bj][n] = *(const f32x4*)(gt + col0 + bj * HALF + n * 16);
#pragma unroll
        for (int ai = 0; ai < 2; ++ai)
#pragma unroll
            for (int mp = 0; mp < 2; ++mp) {
                f32x4 xv[2][2][2];
#pragma unroll
                for (int mm = 0; mm < 2; ++mm)
#pragma unroll
                    for (int bj = 0; bj < 2; ++bj)
#pragma unroll
                        for (int n = 0; n < 2; ++n) xv[mm][bj][n] = *(const f32x4*)(x + (size_t)(row0 + ai * HALF + (2 * mp + mm) * 16) * DM + col0 + bj * HALF + n * 16);
#pragma unroll
                for (int mm = 0; mm < 2; ++mm)
#pragma unroll
                    for (int bj = 0; bj < 2; ++bj)
#pragma unroll
                        for (int n = 0; n < 2; ++n) *(f32x4*)(X1 + (size_t)(row0 + ai * HALF + (2 * mp + mm) * 16) * DM + col0 + bj * HALF + n * 16) = xv[mm][bj][n] + gv[bj][n] * acc[ai][bj][2 * mp + mm][n];
            }
    }
};
struct EpiSwiglu {
    static constexpr bool PERM = true, AFTER_DRAIN = false;
    bf16_t* ACT; const float* bgu;
    DI void operator()(const f32x4 (&acc)[2][2][4][2], const Unit& u, int wr, int wc, int fr, int fq) const {
        const int row0 = u.pm * BM + wr * 64 + fr, gcol = u.pn * HALF + wc * 32 + 8 * fq;
        const float* bb = bgu + (size_t)u.e * 2048 + gcol;
        f32x4 bg[2], bu[2];
#pragma unroll
        for (int n = 0; n < 2; ++n) { bg[n] = *(const f32x4*)(bb + 4 * n); bu[n] = *(const f32x4*)(bb + 1024 + 4 * n); }
#pragma unroll
        for (int ai = 0; ai < 2; ++ai)
#pragma unroll
            for (int m = 0; m < 4; ++m) { float r[8];
#pragma unroll
                for (int n = 0; n < 2; ++n)
#pragma unroll
                    for (int j = 0; j < 4; ++j) { float g = acc[ai][0][m][n][j] + bg[n][j], up = acc[ai][1][m][n][j] + bu[n][j];
                        g = fminf(g, 7.f); up = fminf(fmaxf(up, -7.f), 7.f);
                        r[4 * n + j] = (up + 1.f) * (g * fsig(1.702f * g)); }
                u32x4 w; w.x = cvt_pk_bf16(r[0], r[1]); w.y = cvt_pk_bf16(r[2], r[3]); w.z = cvt_pk_bf16(r[4], r[5]); w.w = cvt_pk_bf16(r[6], r[7]);
                *(u32x4*)(ACT + (size_t)(row0 + ai * HALF + m * 16) * DM + gcol) = w; }
    }
};
}


namespace fox {
typedef float f32x16 __attribute__((ext_vector_type(16)));
typedef short s16x4 __attribute__((ext_vector_type(4)));
constexpr float SCALE = 0.08838834764831845f;
constexpr int KVBLK = 64, SHM_K = 16384, SHM_V = 16384;
constexpr int OFF_V = 0, OFF_K = 2 * SHM_V, OFF_G = OFF_K + 2 * SHM_K, OFF_WS = OFF_G + 512, OFF_MISC = OFF_WS + 8 * 256;
constexpr float THR = 8.f;
#define KSWZ(row, colB) ((row) * 256 + ((colB) ^ (((row) & 7) << 4)))
#define SBAR() __builtin_amdgcn_sched_barrier(0)
DI int v_st(int k, int c) { const int kk = (k & ~0xC) | ((k & 4) << 1) | ((k & 8) >> 1); return ((kk >> 3) * 4 + (c >> 5)) * 512 + ((kk & 7) * 32 + (c & 31)) * 2; }
DI int v_rd_base(int lane) { return ((lane & 3) << 3) | (((lane >> 2) & 3) << 6) | (((lane >> 4) & 1) << 5) | (((lane >> 5) & 1) << 8); }
constexpr int v_rd_off(int d0, int ks, int half) { return d0 * 512 + ks * 4096 + half * 2048; }
DI int crow(int r, int hi) { return (r & 3) + 8 * (r >> 2) + 4 * hi; }
DI unsigned cvtpk(float lo, float hi) { return cvt_pk(lo, hi); }
DI void mask_tile(f32x16& p0, f32x16& p1, int dq) {
    const float NEG = -__builtin_inff();
#pragma unroll
    for (int r = 0; r < 16; ++r) { const int c = (r & 3) + 8 * (r >> 2); if (dq - c < 0) p0[r] = NEG; if (dq - c - 32 < 0) p1[r] = NEG; }
}
DI void partialSM(f32x16& p0, f32x16& p1, float& m_reg, float& mn, float& alpha) {
    float pmax = p0[0];
#pragma unroll
    for (int r = 1; r < 16; ++r) pmax = fmaxf(pmax, p0[r]);
#pragma unroll
    for (int r = 0; r < 16; ++r) pmax = fmaxf(pmax, p1[r]);
    { auto rr = __builtin_amdgcn_permlane32_swap(__float_as_uint(pmax), __float_as_uint(pmax), false, false); pmax = fmaxf(__uint_as_float(rr[0]), __uint_as_float(rr[1])); }
    constexpr float C2 = 1.4426950408889634f * SCALE;
    if (__builtin_expect(__all((pmax - m_reg) * SCALE <= THR), 1)) { mn = m_reg; alpha = 1.f; }
    else { mn = fmaxf(m_reg, pmax); alpha = __builtin_amdgcn_exp2f((m_reg - mn) * C2); m_reg = mn; }
    const float mnL = -mn * C2;
#pragma unroll
    for (int r = 0; r < 16; ++r) p0[r] = fmaf(p0[r], C2, mnL);
#pragma unroll
    for (int r = 0; r < 16; ++r) p1[r] = fmaf(p1[r], C2, mnL);
#pragma unroll
    for (int r = 0; r < 16; ++r) p0[r] = __builtin_amdgcn_exp2f(p0[r]);
}
DI void finishSM(f32x16& p0, f32x16& p1, float alpha, float& l_reg, bf16x8& pa0, bf16x8& pa1, bf16x8& pa2, bf16x8& pa3) {
#pragma unroll
    for (int r = 0; r < 16; ++r) p1[r] = __builtin_amdgcn_exp2f(p1[r]);
    float ps = 0;
#pragma unroll
    for (int r = 0; r < 16; ++r) ps += p0[r];
#pragma unroll
    for (int r = 0; r < 16; ++r) ps += p1[r];
    { auto rr = __builtin_amdgcn_permlane32_swap(__float_as_uint(ps), __float_as_uint(ps), false, false); ps = __uint_as_float(rr[0]) + __uint_as_float(rr[1]); }
    l_reg = l_reg * alpha + ps;
#define PK4(P, B_, OUT) do { unsigned a0 = cvtpk(P[B_+0], P[B_+1]), a1 = cvtpk(P[B_+2], P[B_+3]);                          \
        unsigned b0 = cvtpk(P[B_+4], P[B_+5]), b1 = cvtpk(P[B_+6], P[B_+7]);                                             \
        auto r0 = __builtin_amdgcn_permlane32_swap(a0, b0, false, false); auto r1 = __builtin_amdgcn_permlane32_swap(a1, b1, false, false); \
        u32x4 w = {r0[0], r1[0], r0[1], r1[1]}; OUT = *reinterpret_cast<bf16x8*>(&w); } while (0)
    PK4(p0, 0, pa0); PK4(p0, 8, pa1); PK4(p1, 0, pa2); PK4(p1, 8, pa3);
#undef PK4
}
DI void qkt(f32x16& p0, f32x16& p1, const char* Kb, int r32, int hi, const bf16x8* qr) {
    p0 = f32x16{}; p1 = f32x16{};
    const char* kb[4];
#pragma unroll
    for (int dd = 0; dd < 4; ++dd) kb[dd] = Kb + KSWZ(r32, (dd * 16 + hi * 8) * 2);
#pragma unroll
    for (int d0 = 0; d0 < 8; ++d0) { const char* a = kb[d0 & 3] + (d0 >> 2) * 128;
        bf16x8 b0 = *reinterpret_cast<const bf16x8*>(a);
        bf16x8 b1 = *reinterpret_cast<const bf16x8*>(a + 32 * 256);
        p0 = __builtin_amdgcn_mfma_f32_32x32x16_bf16(b0, qr[d0], p0, 0, 0, 0);
        p1 = __builtin_amdgcn_mfma_f32_32x32x16_bf16(b1, qr[d0], p1, 0, 0, 0); }
}
DI void pv_tile(f32x16* o, int vb0, bf16x8 pa0, bf16x8 pa1, bf16x8 pa2, bf16x8 pa3) {
#define TRRD(dst, off) asm volatile("ds_read_b64_tr_b16 %0, %1 offset:%2" : "=&v"(dst) : "v"(vb0), "i"(off) : "memory")
#define PV_D0(d0) do { s16x4 l0, l1, l2, l3, h0, h1, h2, h3; constexpr int b_ = v_rd_off(d0, 0, 0); \
        TRRD(l0, b_); TRRD(h0, b_ + 2048); TRRD(l1, b_ + 4096); TRRD(h1, b_ + 6144); TRRD(l2, b_ + 8192); TRRD(h2, b_ + 10240); TRRD(l3, b_ + 12288); TRRD(h3, b_ + 14336); \
        asm volatile("s_waitcnt lgkmcnt(0)" ::: "memory"); SBAR();   \
        o[d0] = __builtin_amdgcn_mfma_f32_32x32x16_bf16(pa0, (bf16x8){l0[0], l0[1], l0[2], l0[3], h0[0], h0[1], h0[2], h0[3]}, o[d0], 0, 0, 0);   \
        o[d0] = __builtin_amdgcn_mfma_f32_32x32x16_bf16(pa1, (bf16x8){l1[0], l1[1], l1[2], l1[3], h1[0], h1[1], h1[2], h1[3]}, o[d0], 0, 0, 0);   \
        o[d0] = __builtin_amdgcn_mfma_f32_32x32x16_bf16(pa2, (bf16x8){l2[0], l2[1], l2[2], l2[3], h2[0], h2[1], h2[2], h2[3]}, o[d0], 0, 0, 0);   \
        o[d0] = __builtin_amdgcn_mfma_f32_32x32x16_bf16(pa3, (bf16x8){l3[0], l3[1], l3[2], l3[3], h3[0], h3[1], h3[2], h3[3]}, o[d0], 0, 0, 0); } while (0)
    PV_D0(0); PV_D0(1); PV_D0(2); PV_D0(3);
#undef PV_D0
#undef TRRD
}
DI void fox_block(const Args& a, char* lds, int h, int P0, int j_lo) {
    const int tid = threadIdx.x, wid = __builtin_amdgcn_readfirstlane(tid >> 6), lane = tid & 63, r32 = lane & 31, hi = lane >> 5;
    const bf16_t* P = (const bf16_t*)(a.ws + WS_PROJ); const float* F = (const float*)(a.ws + WS_F) + (size_t)h * SEQ; bf16_t* OB = (bf16_t*)(a.ws + WS_OB);
    const bf16_t* Qp = P + PJ_FQ + h * 128; const bf16_t* Kp = P + PJ_FK + h * 128; const bf16_t* Vp = P + PJ_FV + h * 128;
    const int j_hi = (P0 + 255) / KVBLK + 1, NT = j_hi - j_lo;
    const int qlo = P0 + wid * 32, qm = qlo + r32 - 4 * hi;
    char* V_lds = lds + OFF_V; char* K_lds = lds + OFF_K; float* G_lds = (float*)(lds + OFF_G);
    float* wsp = (float*)(lds + OFF_WS) + wid * 64; float* li_l = wsp; float* al_l = wsp + 32;
    const int sr = tid >> 4;
    const int vb0 = (int)(unsigned)(uintptr_t)(LAS char*)V_lds + v_rd_base(lane);
    const float Fref = F[P0];
    bf16x8 qr[8];
#pragma unroll
    for (int d0 = 0; d0 < 8; ++d0) qr[d0] = *(const bf16x8*)(Qp + (size_t)(qlo + r32) * NPJ + d0 * 16 + hi * 8);
    float m_reg = -1e30f, l_reg = 0.f; f32x16 o[4] = {};
    float st_g = 0.f;
    const int ksrc = (((tid & 15) * 16) ^ ((sr & 7) << 4)) >> 1;
    const int vkk = (tid >> 7) * 8 + ((tid & 31) >> 2), vkey = (vkk & ~0xC) | ((vkk & 4) << 1) | ((vkk & 8) >> 1), vcol = ((tid >> 5) & 3) * 32 + (tid & 3) * 8;
    LAS unsigned char* ldsl = (LAS unsigned char*)lds;
#define FOX_LOAD(t, bf) do { const size_t k0_ = (size_t)(j_lo + (t)) * KVBLK; \
        __builtin_amdgcn_global_load_lds((const unsigned*)(Kp + (k0_ + sr) * NPJ + ksrc), (LAS unsigned*)(ldsl + OFF_K + (bf) * SHM_K + wid * 1024), 16, 0, 0); \
        __builtin_amdgcn_global_load_lds((const unsigned*)(Kp + (k0_ + 32 + sr) * NPJ + ksrc), (LAS unsigned*)(ldsl + OFF_K + (bf) * SHM_K + 8192 + wid * 1024), 16, 0, 0); \
        __builtin_amdgcn_global_load_lds((const unsigned*)(Vp + (k0_ + vkey) * NPJ + vcol), (LAS unsigned*)(ldsl + OFF_V + (bf) * SHM_V + wid * 1024), 16, 0, 0); \
        __builtin_amdgcn_global_load_lds((const unsigned*)(Vp + (k0_ + 32 + vkey) * NPJ + vcol), (LAS unsigned*)(ldsl + OFF_V + (bf) * SHM_V + 8192 + wid * 1024), 16, 0, 0); \
        if (tid < 64) st_g = F[k0_ + tid]; } while (0)
#define FOX_WRITE(bf) do { if (tid < 64) G_lds[(bf) * 64 + tid] = (st_g - Fref) * (1.f / SCALE); } while (0)
    FOX_LOAD(0, 0); asm volatile("s_waitcnt vmcnt(0)" ::: "memory"); FOX_WRITE(0);
    __syncthreads();
    for (int t = 0; t < NT; ++t) {
        const int bf = t & 1, kb_ = (j_lo + t) * KVBLK;
        if (t + 1 < NT) FOX_LOAD(t + 1, bf ^ 1);
        if (kb_ <= qlo + 31) {
            f32x16 p0, p1; float mn, al; bf16x8 pa0, pa1, pa2, pa3;
            qkt(p0, p1, K_lds + bf * SHM_K, r32, hi, qr);
            const float* gt = G_lds + bf * 64 + 4 * hi;
#pragma unroll
            for (int g4 = 0; g4 < 4; ++g4) { const f32x4 g0 = *(const f32x4*)(gt + 8 * g4), g1 = *(const f32x4*)(gt + 32 + 8 * g4);
#pragma unroll
                for (int i = 0; i < 4; ++i) { p0[4 * g4 + i] -= g0[i]; p1[4 * g4 + i] -= g1[i]; } }
            if (kb_ + KVBLK - 1 > qlo) mask_tile(p0, p1, qm - kb_);
            partialSM(p0, p1, m_reg, mn, al);
            finishSM(p0, p1, al, l_reg, pa0, pa1, pa2, pa3);
            if (__any(al < 1.f)) { if (hi == 0) al_l[r32] = al; asm volatile("s_waitcnt lgkmcnt(0)" ::: "memory");
#pragma unroll
                for (int d_ = 0; d_ < 4; ++d_)
#pragma unroll
                    for (int r = 0; r < 16; ++r) o[d_][r] *= al_l[crow(r, hi)]; }
            SBAR();
            pv_tile(o, vb0 + bf * SHM_V, pa0, pa1, pa2, pa3);
        }
        if (t + 1 < NT) { asm volatile("s_waitcnt vmcnt(0)" ::: "memory"); FOX_WRITE(bf ^ 1); }
        __syncthreads();
    }
#undef FOX_LOAD
#undef FOX_WRITE
    if (hi == 0) li_l[r32] = l_reg;
    asm volatile("s_waitcnt lgkmcnt(0)" ::: "memory");
    bf16_t* Ow = OB + (size_t)qlo * 512 + h * 128;
#pragma unroll
    for (int r = 0; r < 16; ++r) { const int orow = crow(r, hi); const float rl = __builtin_amdgcn_rcpf(li_l[orow]);
#pragma unroll
        for (int d0 = 0; d0 < 4; ++d0) { const float v = o[d0][r] * rl; const float vn = __shfl_xor(v, 1);
            if ((r32 & 1) == 0) *(unsigned*)(Ow + (size_t)orow * 512 + d0 * 32 + r32) = cvtpk(v, vn); } }
    __syncthreads();
}
#undef KSWZ
}

DI void transpose_tile(float* tile, const float* src, int ld, int k0, int c0, int c1, bf16_t* dst, int Kd) {
    const int tid = threadIdx.x, nn = tid & 63, k8 = tid >> 6; const int col = nn < 32 ? c0 + nn : c1 + nn - 32;
    const float* s = src + (size_t)(k0 + k8 * 8) * ld + col;
    float v[8];
#pragma unroll
    for (int i = 0; i < 8; ++i) v[i] = s[(size_t)i * ld];
    u32x4 w; w.x = cvt_pk(v[0], v[1]); w.y = cvt_pk(v[2], v[3]); w.z = cvt_pk(v[4], v[5]); w.w = cvt_pk(v[6], v[7]);
    *(u32x4*)(dst + (size_t)nn * Kd + k0 + k8 * 8) = w;
}
DI void transpose_quad(char* lds, int& par, const float* src, int ld, int k0, int c0, int c1, bf16_t* dst, int Kd) {
    const int tid = threadIdx.x, nn = tid & 63, k8 = tid >> 6; const int col = nn < 32 ? c0 + nn : c1 + nn - 32;
    const float* s = src + (size_t)(k0 + k8 * 8) * ld + col;
    float v[4][8];
#pragma unroll
    for (int kk = 0; kk < 4; ++kk)
#pragma unroll
        for (int i = 0; i < 8; ++i) v[kk][i] = s[(size_t)(kk * 64 + i) * ld];
    char* tile = lds + par * 33792; par ^= 1;
#pragma unroll
    for (int kk = 0; kk < 4; ++kk) { u32x4 w; w.x = cvt_pk(v[kk][0], v[kk][1]); w.y = cvt_pk(v[kk][2], v[kk][3]); w.z = cvt_pk(v[kk][4], v[kk][5]); w.w = cvt_pk(v[kk][6], v[kk][7]);
        *(u32x4*)(tile + nn * 528 + (kk * 64 + k8 * 8) * 2) = w; }
    __syncthreads();
    const int rn = tid >> 3, ch = tid & 7;
#pragma unroll
    for (int q = 0; q < 4; ++q) *(u32x4*)(dst + (size_t)rn * Kd + k0 + (ch + 8 * q) * 8) = *(const u32x4*)(tile + rn * 528 + (ch + 8 * q) * 16);
}
constexpr int Q_WGU = 32 * 32 * 4, Q_WD = 32 * 16 * 4;
DI void conv_quad_gu(const Args& a, char* lds, int& par, int r) { const int e = r / 128, q = r % 128, nt = q / 4, kt = q % 4, n0 = nt * 64;
    transpose_quad(lds, par, a.in[I_WGU] + (size_t)e * DM * 2048, 2048, kt * 256, gu_src(n0), gu_src(n0 + 32), (bf16_t*)(a.ws + WS_WGUT) + ((size_t)e * 2048 + n0) * DM, DM); }
DI void conv_quad_d(const Args& a, char* lds, int& par, int r) { const int e = r / 64, q = r % 64, nt = q / 4, kt = q % 4, n0 = nt * 64;
    transpose_quad(lds, par, a.in[I_WD] + (size_t)e * DM * DM, DM, kt * 256, n0, n0 + 32, (bf16_t*)(a.ws + WS_WDT) + ((size_t)e * DM + n0) * DM, DM); }
constexpr int T_WIN = 88 * 16, T_WOA = 16 * 8, T_WOUT = 16 * 16, T_WGU = 32 * 32 * 16, T_WD = 32 * 16 * 16;
constexpr int T_SMALL = T_WIN + 2 * T_WOA + T_WOUT;
DI void conv_tile(const Args& a, float* lds, int t) {
    unsigned char* ws = a.ws; int r = t;
    if (r < T_WIN) { const int nt = r / 16, kt = r % 16, n0 = nt * 64; const int c0 = n0 + (n0 >= 3584 ? 12 : (n0 >= 2048 ? 8 : 0));
        transpose_tile(lds, a.in[I_WIN], NIN, kt * 64, c0, c0 + 32, (bf16_t*)(ws + WS_WINT) + (size_t)n0 * DM, DM); return; }
    r -= T_WIN;
    if (r < T_WOA) { const int nt = r / 8, kt = r % 8, n0 = nt * 64; transpose_tile(lds, a.in[I_WOD], DM, kt * 64, n0, n0 + 32, (bf16_t*)(ws + WS_WOAT) + (size_t)n0 * 512, 512); return; }
    r -= T_WOA;
    if (r < T_WOA) { const int nt = r / 8, kt = r % 8, n0 = nt * 64; transpose_tile(lds, a.in[I_WOF], DM, kt * 64, n0, n0 + 32, (bf16_t*)(ws + WS_WOBT) + (size_t)n0 * 512, 512); return; }
    r -= T_WOA;
    if (r < T_WOUT) { const int nt = r / 16, kt = r % 16, n0 = nt * 64; transpose_tile(lds, a.in[I_WOUT], DM, kt * 64, n0, n0 + 32, (bf16_t*)(ws + WS_WOUTT) + (size_t)n0 * DM, DM); return; }
    r -= T_WOUT;
    if (r < T_WGU) { const int e = r / 512, q = r % 512, nt = q / 16, kt = q % 16, n0 = nt * 64;
        transpose_tile(lds, a.in[I_WGU] + (size_t)e * DM * 2048, 2048, kt * 64, gu_src(n0), gu_src(n0 + 32), (bf16_t*)(ws + WS_WGUT) + ((size_t)e * 2048 + n0) * DM, DM); return; }
    r -= T_WGU;
    { const int e = r / 256, q = r % 256, nt = q / 16, kt = q % 16, n0 = nt * 64;
        transpose_tile(lds, a.in[I_WD] + (size_t)e * DM * DM, DM, kt * 64, n0, n0 + 32, (bf16_t*)(ws + WS_WDT) + ((size_t)e * DM + n0) * DM, DM); }
}
DI void ph0(const Args& a, float* lds) {
    const int tid = threadIdx.x, G = gridDim.x, bx = blockIdx.x;
    unsigned char* ws = a.ws;
    for (int grp = bx; grp < 256; grp += G) {
        const int col = tid % 24, ks = tid / 24, j = grp * 24 + col; const float* c = a.in[I_C]; const float* w = a.in[I_WADA];
        float acc = 0.f;
        if (ks < 21) { const int k1 = (ks * 49 + 49) < DM ? (ks * 49 + 49) : DM; for (int k = ks * 49; k < k1; ++k) acc += c[k] * w[(size_t)k * 6144 + j]; }
        __syncthreads();
        if (ks < 21) lds[ks * 24 + col] = acc;
        __syncthreads();
        if (tid < 24) { float s = a.in[I_BADA][grp * 24 + tid]; for (int q = 0; q < 21; ++q) s += lds[q * 24 + tid]; ((float*)(ws + WS_MOD))[grp * 24 + tid] = s; }
    }
    for (int t = bx; t < T_SMALL; t += G) conv_tile(a, lds, t);
}

DI void ph1(const Args& a, float* lds) {
    const int tid = threadIdx.x, lane = tid & 63, wave = tid >> 6, G = gridDim.x;
    float* A1 = lds; float* B1 = lds + 1024; float* wsm = lds + 2048;
    const float* mod = (const float*)(a.ws + WS_MOD);
    for (int k = tid; k < DM; k += NTHREADS) { A1[k] = a.in[I_G1][k] * (1.f + mod[1024 + k]); B1[k] = mod[k]; }
    for (int i = tid; i < 12 * DM; i += NTHREADS) { const int k = i / 12, j = i % 12; wsm[j * DM + k] = a.in[I_WIN][(size_t)k * NIN + (j < 8 ? 2048 + j : 3592 + (j - 8))]; }
    __syncthreads();
    bf16_t* H = (bf16_t*)(a.ws + WS_H); float* SP = (float*)(a.ws + WS_SP);
    for (int t0 = (blockIdx.x * NWAVES + wave) * 2; t0 < SEQ; t0 += G * NWAVES * 2) {
        f32x4 v[2][4]; float ss[2] = {0.f, 0.f};
#pragma unroll
        for (int q = 0; q < 2; ++q)
#pragma unroll
            for (int i = 0; i < 4; ++i) v[q][i] = *(const f32x4*)(a.in[I_X] + (size_t)(t0 + q) * DM + lane * 4 + 256 * i);
#pragma unroll
        for (int q = 0; q < 2; ++q)
#pragma unroll
            for (int i = 0; i < 4; ++i) ss[q] += v[q][i][0] * v[q][i][0] + v[q][i][1] * v[q][i][1] + v[q][i][2] * v[q][i][2] + v[q][i][3] * v[q][i][3];
        ss[0] = wave_sum(ss[0]); ss[1] = wave_sum(ss[1]);
#pragma unroll
        for (int q = 0; q < 2; ++q) { const float rstd = rsqrtf(ss[q] * (1.f / DM) + 1e-6f);
#pragma unroll
            for (int i = 0; i < 4; ++i) { const int k = lane * 4 + 256 * i;
#pragma unroll
                for (int e = 0; e < 4; ++e) v[q][i][e] = v[q][i][e] * rstd * A1[k + e] + B1[k + e];
                u32x2 w; w.x = cvt_pk(v[q][i][0], v[q][i][1]); w.y = cvt_pk(v[q][i][2], v[q][i][3]);
                *(u32x2*)(H + (size_t)(t0 + q) * DM + k) = w; } }
#pragma unroll 1
        for (int j = 0; j < 12; ++j) { float p0 = 0.f, p1 = 0.f;
#pragma unroll
            for (int i = 0; i < 4; ++i) { const f32x4 wv = *(const f32x4*)(wsm + j * DM + lane * 4 + 256 * i);
                p0 += v[0][i][0] * wv[0] + v[0][i][1] * wv[1] + v[0][i][2] * wv[2] + v[0][i][3] * wv[3];
                p1 += v[1][i][0] * wv[0] + v[1][i][1] * wv[1] + v[1][i][2] * wv[2] + v[1][i][3] * wv[3]; }
            p0 = wave_sum(p0); p1 = wave_sum(p1); if (lane == j) { SP[(size_t)t0 * 16 + j] = p0; SP[(size_t)(t0 + 1) * 16 + j] = p1; } }
    }
}

DI void ph2(const Args& a, unsigned char* ldsb) {
    pg8::Gemm g{(const bf16_t*)(a.ws + WS_H), (const bf16_t*)(a.ws + WS_WINT), SEQ, NPJ, DM};
    pg8::OrderDense S; S.init(SEQ / 256, NPJ / 256, (int)gridDim.x, (int)blockIdx.x);
    pg8::EpiStoreBf16 E{(bf16_t*)(a.ws + WS_PROJ), NPJ, nullptr, 0};
    pg8::gemm_phase<pg8::EpiStoreBf16, pg8::OrderDense>((LAS unsigned char*)ldsb, g, S, E);
}

DI void ph3_fcum(const Args& a, float* lds) {
    const int tid = threadIdx.x, lane = tid & 63, wave = tid >> 6, h = blockIdx.x;
    const float* SP = (const float*)(a.ws + WS_SP); float* F = (float*)(a.ws + WS_F);
    const float bf = a.in[I_BFG][h];
    double* wtot = (double*)lds;
    float lf[32];
#pragma unroll
    for (int i = 0; i < 32; ++i) lf[i] = SP[(size_t)(tid * 32 + i) * 16 + 8 + h];
    double s = 0.0;
#pragma unroll
    for (int i = 0; i < 32; ++i) { lf[i] = logsigf(lf[i] + bf); s += (double)lf[i]; }
    double inc = s;
#pragma unroll
    for (int o_ = 1; o_ < 64; o_ <<= 1) { const double y = __shfl_up(inc, o_); if (lane >= o_) inc += y; }
    __syncthreads();
    if (lane == 63) wtot[wave] = inc;
    __syncthreads();
    double off = inc - s;
    for (int w = 0; w < wave; ++w) off += wtot[w];
#pragma unroll
    for (int i = 0; i < 32; ++i) { off += (double)lf[i]; F[(size_t)h * SEQ + tid * 32 + i] = (float)off; }
    __syncthreads();
}
namespace prep {
constexpr int QS = 0, KS = 17408, KT = 34816, VT = 53248, UNIT = 71680, SM = 2 * UNIT;
DI bf16x8 ld8(const char* p) { return *(const bf16x8*)p; }
template <int C, int M4> struct TRow { static DI void run(const float (&T)[64], const float* Ls, float& a0, float& a1) {
    if constexpr (4 * M4 < C) { const f32x4 Lv = *(const f32x4*)(Ls + C * 68 + 4 * M4);
        a0 -= Lv[0] * T[4 * M4]; if constexpr (4 * M4 + 1 < C) a1 -= Lv[1] * T[4 * M4 + 1]; if constexpr (4 * M4 + 2 < C) a0 -= Lv[2] * T[4 * M4 + 2]; if constexpr (4 * M4 + 3 < C) a1 -= Lv[3] * T[4 * M4 + 3];
        TRow<C, M4 + 1>::run(T, Ls, a0, a1); } } };
template <int C> struct TRow<C, 16> { static DI void run(const float (&)[64], const float*, float&, float&) {} };
template <int C> DI void tsolve(float (&T)[64], const float* Ls, int lane) {
    if constexpr (C < 64) { float a0 = (lane == C) ? 1.f : 0.f, a1 = 0.f; TRow<C, 0>::run(T, Ls, a0, a1); T[C] = a0 + a1; asm volatile("" ::: "memory"); __builtin_amdgcn_sched_barrier(0); tsolve<C + 1>(T, Ls, lane); } }
}
DI void ph3_prep2(const Args& a, char* lds, int pair) {
    using namespace prep;
    const int tid = threadIdx.x, lane = tid & 63, wave = tid >> 6, grp = wave >> 2, wq = wave & 3, tg = tid & 255, lr = lane & 15, lq = lane >> 4;
    int unit = pair * 2 + grp; if (unit >= NH * NCH) unit = NH * NCH - 1;
    const int h = unit & 3, n = unit >> 2, t0 = n * CH;
    char* U = lds + grp * UNIT;
    float* gcs = (float*)(lds + SM) + grp * 192; float* bes = gcs + 64; float* egs = gcs + 128;
    const float* SP = (const float*)(a.ws + WS_SP); const bf16_t* P = (const bf16_t*)(a.ws + WS_PROJ);
    const size_t cb = (size_t)(h * NCH + n);
    bf16_t* WF = (bf16_t*)(a.ws + WS_DNW) + cb * 8192; bf16_t* UF = (bf16_t*)(a.ws + WS_DNU) + cb * 8192;
    bf16_t* QF = (bf16_t*)(a.ws + WS_DNQD) + cb * 8192; bf16_t* KF = (bf16_t*)(a.ws + WS_DNKD) + cb * 8192; bf16_t* AF = (bf16_t*)(a.ws + WS_DNATT) + cb * 4096;
    __syncthreads();
    if (wq == 0) { const int t = t0 + lane;
        const float be = sigm(SP[(size_t)t * 16 + h]);
        float g = -expf(a.in[I_ALOG][h]) * softplusf(SP[(size_t)t * 16 + 4 + h] + a.in[I_DTB][h]);
#pragma unroll
        for (int o_ = 1; o_ < 64; o_ <<= 1) { const float y = __shfl_up(g, o_); if (lane >= o_) g += y; }
        gcs[lane] = g; bes[lane] = be; egs[lane] = expf(g); }
    __syncthreads();
    { const int d8 = tg & 15, ci = tg >> 4; const float* cw = a.in[I_CONVW];
#pragma unroll 1
        for (int sec = 0; sec < 3; ++sec) {
            const int col = sec * 512 + h * 128 + d8 * 8;
            f32x4 w[4][2];
#pragma unroll
            for (int j = 0; j < 4; ++j) { w[j][0] = *(const f32x4*)(cw + j * 1536 + col); w[j][1] = *(const f32x4*)(cw + j * 1536 + col + 4); }
#pragma unroll 1
          for (int ih = 0; ih < 2; ++ih) {
            u32x4 xin[2][4];
#pragma unroll
            for (int i = 0; i < 2; ++i)
#pragma unroll
                for (int j = 0; j < 4; ++j) { int tt = t0 + ci + 16 * (2 * ih + i) - 3 + j; tt = tt < 0 ? 0 : tt; xin[i][j] = *(const u32x4*)(P + (size_t)tt * NPJ + col); }
#pragma unroll
            for (int i = 0; i < 2; ++i) { const int c = ci + 16 * (2 * ih + i), t = t0 + c;
                float v[8];
#pragma unroll
                for (int e = 0; e < 8; ++e) v[e] = 0.f;
#pragma unroll
                for (int j = 0; j < 4; ++j) { const float ok = (t - 3 + j >= 0) ? 1.f : 0.f; const u32x4 x = xin[i][j];
                    v[0] += ok * w[j][0][0] * __uint_as_float(x.x << 16); v[1] += ok * w[j][0][1] * __uint_as_float(x.x & 0xffff0000u); v[2] += ok * w[j][0][2] * __uint_as_float(x.y << 16); v[3] += ok * w[j][0][3] * __uint_as_float(x.y & 0xffff0000u);
                    v[4] += ok * w[j][1][0] * __uint_as_float(x.z << 16); v[5] += ok * w[j][1][1] * __uint_as_float(x.z & 0xffff0000u); v[6] += ok * w[j][1][2] * __uint_as_float(x.w << 16); v[7] += ok * w[j][1][3] * __uint_as_float(x.w & 0xffff0000u); }
                float ss = 0.f;
#pragma unroll
                for (int e = 0; e < 8; ++e) { v[e] = siluf(v[e]); ss += v[e] * v[e]; }
                if (sec < 2) { ss += __shfl_xor(ss, 1); ss += __shfl_xor(ss, 2); ss += __shfl_xor(ss, 4); ss += __shfl_xor(ss, 8);
                    const float sc = rsqrtf(ss + 1e-6f) * (sec == 0 ? 0.08838834764831845f : 1.f);
#pragma unroll
                    for (int e = 0; e < 8; ++e) v[e] *= sc; }
                u32x4 pk; pk.x = cvt_pk(v[0], v[1]); pk.y = cvt_pk(v[2], v[3]); pk.z = cvt_pk(v[4], v[5]); pk.w = cvt_pk(v[6], v[7]);
                if (sec == 0) { *(u32x4*)(U + QS + c * 272 + d8 * 16) = pk;
                    const float eg = egs[c];
                    const int base = (((c >> 4) * 4 + (d8 >> 2)) * 64 + (c & 15)) * 8 + 4 * ((d8 & 3) >> 1), l0 = (2 * (d8 & 3)) & 3;
                    u32x2 q0, q1; q0.x = cvt_pk(v[0] * eg, v[1] * eg); q0.y = cvt_pk(v[2] * eg, v[3] * eg); q1.x = cvt_pk(v[4] * eg, v[5] * eg); q1.y = cvt_pk(v[6] * eg, v[7] * eg);
                    *(u32x2*)(QF + base + l0 * 128) = q0; *(u32x2*)(QF + base + (l0 + 1) * 128) = q1; }
                else { if (sec == 1) *(u32x4*)(U + KS + c * 272 + d8 * 16) = pk;
                    bf16_t* T_ = (bf16_t*)(U + (sec == 1 ? KT : VT)) + (d8 * 8) * 72 + c;
                    T_[0 * 72] = (bf16_t)(pk.x & 0xffffu); T_[1 * 72] = (bf16_t)(pk.x >> 16); T_[2 * 72] = (bf16_t)(pk.y & 0xffffu); T_[3 * 72] = (bf16_t)(pk.y >> 16);
                    T_[4 * 72] = (bf16_t)(pk.z & 0xffffu); T_[5 * 72] = (bf16_t)(pk.z >> 16); T_[6 * 72] = (bf16_t)(pk.w & 0xffffu); T_[7 * 72] = (bf16_t)(pk.w >> 16); }
            }
          }
        }
    }
    __syncthreads();
    f32x4 Lr[4];
    { const int mt = wq;
#pragma unroll
        for (int nt = 0; nt < 4; ++nt) { Lr[nt] = (f32x4){0.f, 0.f, 0.f, 0.f};
            if (nt <= mt) {
#pragma unroll
                for (int s = 0; s < 4; ++s) Lr[nt] = MFMA16(ld8(U + KS + (16 * mt + lr) * 272 + (32 * s + 8 * lq) * 2), ld8(U + KS + (16 * nt + lr) * 272 + (32 * s + 8 * lq) * 2), Lr[nt]); } }
        const int ntq = 3 - wq; const float gcc = gcs[16 * ntq + lr];
#pragma unroll
        for (int mtk = 0; mtk < 4; ++mtk) { f32x4 acc = (f32x4){0.f, 0.f, 0.f, 0.f};
            if (mtk <= ntq) {
#pragma unroll
                for (int s = 0; s < 4; ++s) acc = MFMA16(ld8(U + KS + (16 * mtk + lr) * 272 + (32 * s + 8 * lq) * 2), ld8(U + QS + (16 * ntq + lr) * 272 + (32 * s + 8 * lq) * 2), acc);
#pragma unroll
                for (int r = 0; r < 4; ++r) { const int m = 16 * mtk + 4 * lq + r, c = 16 * ntq + lr; acc[r] = (m <= c) ? acc[r] * expf(gcc - gcs[m]) : 0.f; } }
            u32x2 o_; o_.x = cvt_pk(acc[0], acc[1]); o_.y = cvt_pk(acc[2], acc[3]);
            *(u32x2*)(AF + ((ntq * 2 + (mtk >> 1)) * 64 + lane) * 8 + 4 * (mtk & 1)) = o_; }
    }
    __syncthreads();
    { const int mt = wq; float* LT = (float*)(U + QS);
#pragma unroll
        for (int nt = 0; nt < 4; ++nt) if (nt <= mt) { const int m = 16 * nt + lr; f32x4 o_;
#pragma unroll
            for (int r = 0; r < 4; ++r) { const int c = 16 * mt + 4 * lq + r; o_[r] = (m < c) ? bes[c] * Lr[nt][r] * expf(gcs[c] - gcs[m]) : 0.f; }
            *(f32x4*)(LT + m * 68 + 16 * mt + 4 * lq) = o_; } }
    __syncthreads();
    if (wq == 0) { const float* LT = (const float*)(U + QS); float* Tl = (float*)(U + KS);
#pragma unroll
        for (int ib = 0; ib < 4; ++ib) { float acc[16];
#pragma unroll
            for (int r = 0; r < 16; ++r) acc[r] = (lane == 16 * ib + r) ? 1.f : 0.f;
#pragma unroll 2
            for (int m = 0; m < 16 * ib; ++m) { const float t = Tl[m * 68 + lane];
#pragma unroll
                for (int q = 0; q < 4; ++q) { const f32x4 Lv = *(const f32x4*)(LT + m * 68 + 16 * ib + 4 * q);
#pragma unroll
                    for (int e = 0; e < 4; ++e) acc[4 * q + e] -= Lv[e] * t; } }
#pragma unroll
            for (int p = 0; p < 16; ++p) { const float t = acc[p]; Tl[(16 * ib + p) * 68 + lane] = t;
                if (p < 15) {
#pragma unroll
                    for (int q = 0; q < 4; ++q) if (4 * q + 3 > p) { const f32x4 Lv = *(const f32x4*)(LT + (16 * ib + p) * 68 + 16 * ib + 4 * q);
#pragma unroll
                        for (int e = 0; e < 4; ++e) if (4 * q + e > p) acc[4 * q + e] -= Lv[e] * t; } } }
            asm volatile("s_waitcnt lgkmcnt(0)" ::: "memory"); }
        if (lane == 0) ((float*)(a.ws + WS_EG))[cb] = egs[63];
    } else { const float gl = gcs[63];
        for (int i = tg - 64; i < 2048; i += 192) { const int dk = i >> 4, cq = i & 15;
            const u32x2 x = *(const u32x2*)(U + KT + dk * 144 + cq * 8);
            const float e0 = expf(gl - gcs[4 * cq]), e1 = expf(gl - gcs[4 * cq + 1]), e2 = expf(gl - gcs[4 * cq + 2]), e3 = expf(gl - gcs[4 * cq + 3]);
            u32x2 o_; o_.x = cvt_pk(__uint_as_float(x.x << 16) * e0, __uint_as_float(x.x & 0xffff0000u) * e1); o_.y = cvt_pk(__uint_as_float(x.y << 16) * e2, __uint_as_float(x.y & 0xffff0000u) * e3);
            *(u32x2*)(KF + (((dk >> 4) * 2 + (cq >> 3)) * 64 + (cq & 3) * 16 + (dk & 15)) * 8 + 4 * ((cq >> 2) & 1)) = o_; } }
    __syncthreads();
    { const float* Tl = (const float*)(U + KS); const int c = tg >> 2, m0 = (tg & 3) * 16;
        f32x4 tv[4];
#pragma unroll
        for (int q = 0; q < 4; ++q) tv[q] = *(const f32x4*)(Tl + c * 68 + m0 + 4 * q);
        __syncthreads();
        bf16_t* Tb = (bf16_t*)(U + QS); bf16_t* Tg = (bf16_t*)(U + KS);
#pragma unroll
        for (int q = 0; q < 4; ++q) { u32x2 b_, g_; float be[4], bg[4];
#pragma unroll
            for (int e = 0; e < 4; ++e) { const int m = m0 + 4 * q + e; be[e] = tv[q][e] * bes[m]; bg[e] = be[e] * egs[m]; }
            b_.x = cvt_pk(be[0], be[1]); b_.y = cvt_pk(be[2], be[3]); g_.x = cvt_pk(bg[0], bg[1]); g_.y = cvt_pk(bg[2], bg[3]);
            *(u32x2*)(Tb + c * 72 + m0 + 4 * q) = b_; *(u32x2*)(Tg + c * 72 + m0 + 4 * q) = g_; } }
    __syncthreads();
    {
#pragma unroll
        for (int q = 0; q < 2; ++q) { const int nt = 2 * wq + q;
#pragma unroll
            for (int mt = 0; mt < 4; ++mt) { f32x4 acc = (f32x4){0.f, 0.f, 0.f, 0.f};
#pragma unroll
                for (int s = 0; s < 2; ++s) acc = MFMA16(ld8(U + QS + (16 * mt + lr) * 144 + (32 * s + 8 * lq) * 2), ld8(U + VT + (16 * nt + lr) * 144 + (32 * s + 8 * lq) * 2), acc);
                u32x2 o_; o_.x = cvt_pk(acc[0], acc[1]); o_.y = cvt_pk(acc[2], acc[3]);
                *(u32x2*)(UF + ((nt * 4 + mt) * 64 + lane) * 4) = o_; } }
#pragma unroll
        for (int q = 0; q < 2; ++q) { const int mtk = 2 * wq + q;
#pragma unroll
            for (int ntc = 0; ntc < 4; ++ntc) { f32x4 acc = (f32x4){0.f, 0.f, 0.f, 0.f};
#pragma unroll
                for (int s = 0; s < 2; ++s) acc = MFMA16(ld8(U + KT + (16 * mtk + lr) * 144 + (32 * s + 8 * lq) * 2), ld8(U + KS + (16 * ntc + lr) * 144 + (32 * s + 8 * lq) * 2), acc);
                u32x2 o_; o_.x = cvt_pk(-acc[0], -acc[1]); o_.y = cvt_pk(-acc[2], -acc[3]);
                *(u32x2*)(WF + ((ntc * 4 + (mtk >> 1)) * 64 + lane) * 8 + 4 * (mtk & 1)) = o_; } }
    }
}
DI void ph3_norms(const Args& a, float* lds) {
    const int lane = threadIdx.x & 63, wave = threadIdx.x >> 6, NW = gridDim.x * NWAVES, sub = lane >> 4, l16 = lane & 15;
    const bf16_t* P = (const bf16_t*)(a.ws + WS_PROJ); float* TB = (float*)(a.ws + WS_NRMT);
    for (int grp = blockIdx.x * NWAVES + wave; grp < SEQ / 8; grp += NW) {
        float mq[4] = {0.f, 0.f, 0.f, 0.f}, mk[4] = {0.f, 0.f, 0.f, 0.f}, md[4] = {3.0e38f, 3.0e38f, 3.0e38f, 3.0e38f};
#pragma unroll
        for (int it = 0; it < 2; ++it) { const bf16_t* row = P + (size_t)(grp * 8 + it * 4 + sub) * NPJ + l16 * 8;
            u32x4 xq[4], xk[4];
#pragma unroll
            for (int h = 0; h < 4; ++h) { xq[h] = *(const u32x4*)(row + PJ_FQ + h * 128); xk[h] = *(const u32x4*)(row + PJ_FK + h * 128); }
#pragma unroll
            for (int h = 0; h < 4; ++h) { float sq = 0.f, sk = 0.f, sd = 0.f;
#pragma unroll
                for (int e = 0; e < 4; ++e) { const float a0 = __uint_as_float(xq[h][e] << 16), a1 = __uint_as_float(xq[h][e] & 0xffff0000u), b0 = __uint_as_float(xk[h][e] << 16), b1 = __uint_as_float(xk[h][e] & 0xffff0000u);
                    sq += a0 * a0 + a1 * a1; sk += b0 * b0 + b1 * b1; sd += a0 * b0 + a1 * b1; }
#pragma unroll
                for (int o_ = 1; o_ <= 8; o_ <<= 1) { sq += __shfl_xor(sq, o_); sk += __shfl_xor(sk, o_); sd += __shfl_xor(sd, o_); }
                mq[h] = fmaxf(mq[h], sq); mk[h] = fmaxf(mk[h], sk); md[h] = fminf(md[h], sd); } }
#pragma unroll
        for (int h = 0; h < 4; ++h) { mq[h] = fmaxf(mq[h], __shfl_xor(mq[h], 16)); mq[h] = fmaxf(mq[h], __shfl_xor(mq[h], 32)); mk[h] = fmaxf(mk[h], __shfl_xor(mk[h], 16)); mk[h] = fmaxf(mk[h], __shfl_xor(mk[h], 32));
            md[h] = fminf(md[h], __shfl_xor(md[h], 16)); md[h] = fminf(md[h], __shfl_xor(md[h], 32));
            if (lane == 0) { TB[grp * 12 + h] = mq[h]; TB[grp * 12 + 4 + h] = mk[h]; TB[grp * 12 + 8 + h] = md[h]; } }
    }
}
DI void ph3(const Args& a, float* lds) {
    const int G = gridDim.x;
    if (blockIdx.x < 4) ph3_fcum(a, lds);
    for (int p = blockIdx.x; p < NH * NCH / 2; p += G) ph3_prep2(a, (char*)lds, p);
    ph3_norms(a, lds);
}

namespace dn {
DI unsigned cvtpk(float lo, float hi) { return cvt_pk(lo, hi); }
DI bf16x8 packB(const f32x4& t0, const f32x4& t1) { u32x4 w = {cvtpk(t0[0], t0[1]), cvtpk(t0[2], t0[3]), cvtpk(t1[0], t1[1]), cvtpk(t1[2], t1[3])}; return *reinterpret_cast<bf16x8*>(&w); }
DI bf16x8 frag(const bf16_t* base, int f, int lane) { return *(const bf16x8*)(base + ((size_t)f * 64 + lane) * 8); }
template <bool WITH_U, bool WITH_O>
DI void step(const bf16_t* WFn, const bf16_t* KFn, const bf16_t* QFn, const bf16_t* AFn, const bf16_t* UFs, float eg, f32x4 (&S)[8], f32x4 (&o)[4], int lane) {
    bf16x8 sb[4];
#pragma unroll
    for (int s = 0; s < 4; ++s) sb[s] = packB(S[2 * s], S[2 * s + 1]);
    f32x4 vn[4];
#pragma unroll
    for (int mt = 0; mt < 4; ++mt) {
        if (WITH_U) { const u32x2 w = *(const u32x2*)(UFs + ((size_t)mt * 64 + lane) * 4); vn[mt] = (f32x4){__uint_as_float(w.x << 16), __uint_as_float(w.x & 0xffff0000u), __uint_as_float(w.y << 16), __uint_as_float(w.y & 0xffff0000u)}; }
        else vn[mt] = (f32x4){0.f, 0.f, 0.f, 0.f};
#pragma unroll
        for (int s = 0; s < 4; ++s) vn[mt] = MFMA16(frag(WFn, mt * 4 + s, lane), sb[s], vn[mt]); }
    if (WITH_O) {
#pragma unroll
        for (int mt = 0; mt < 4; ++mt) { o[mt] = (f32x4){0.f, 0.f, 0.f, 0.f};
#pragma unroll
            for (int s = 0; s < 4; ++s) o[mt] = MFMA16(frag(QFn, mt * 4 + s, lane), sb[s], o[mt]); } }
    bf16x8 vb[2];
#pragma unroll
    for (int s = 0; s < 2; ++s) vb[s] = packB(vn[2 * s], vn[2 * s + 1]);
    if (WITH_O) {
#pragma unroll
        for (int mt = 0; mt < 4; ++mt)
#pragma unroll
            for (int s = 0; s < 2; ++s) o[mt] = MFMA16(frag(AFn, mt * 2 + s, lane), vb[s], o[mt]); }
#pragma unroll
    for (int mt = 0; mt < 8; ++mt) { S[mt] = S[mt] * eg;
#pragma unroll
        for (int s = 0; s < 2; ++s) S[mt] = MFMA16(frag(KFn, mt * 2 + s, lane), vb[s], S[mt]); }
}
}
constexpr int NGRP = 16, GRP = 16;
constexpr int NSCAN = NH * NGRP;
constexpr int SBUF = 57344;
template <int N> struct Stage { u32x4 r[N]; };
DI void stage_load2(Stage<4>& st, const bf16_t* s0, const bf16_t* s1) {
    const int tid = threadIdx.x;
    st.r[0] = *(const u32x4*)(s0 + (size_t)tid * 8); st.r[1] = *(const u32x4*)(s0 + (size_t)(tid + 512) * 8);
    st.r[2] = *(const u32x4*)(s1 + (size_t)tid * 8); st.r[3] = *(const u32x4*)(s1 + (size_t)(tid + 512) * 8);
}
DI void stage_write2(const Stage<4>& st, char* buf) {
    const int tid = threadIdx.x;
    *(u32x4*)(buf + tid * 16) = st.r[0]; *(u32x4*)(buf + (tid + 512) * 16) = st.r[1];
    *(u32x4*)(buf + 16384 + tid * 16) = st.r[2]; *(u32x4*)(buf + 16384 + (tid + 512) * 16) = st.r[3];
}
DI void stage_load4(Stage<7>& st, const bf16_t* s0, const bf16_t* s1, const bf16_t* s2, const bf16_t* s3) {
    const int tid = threadIdx.x;
    st.r[0] = *(const u32x4*)(s0 + (size_t)tid * 8); st.r[1] = *(const u32x4*)(s0 + (size_t)(tid + 512) * 8);
    st.r[2] = *(const u32x4*)(s1 + (size_t)tid * 8); st.r[3] = *(const u32x4*)(s1 + (size_t)(tid + 512) * 8);
    st.r[4] = *(const u32x4*)(s2 + (size_t)tid * 8); st.r[5] = *(const u32x4*)(s2 + (size_t)(tid + 512) * 8);
    st.r[6] = *(const u32x4*)(s3 + (size_t)tid * 8);
}
DI void stage_write4(const Stage<7>& st, char* buf) {
    const int tid = threadIdx.x;
    *(u32x4*)(buf + tid * 16) = st.r[0]; *(u32x4*)(buf + (tid + 512) * 16) = st.r[1];
    *(u32x4*)(buf + 16384 + tid * 16) = st.r[2]; *(u32x4*)(buf + 16384 + (tid + 512) * 16) = st.r[3];
    *(u32x4*)(buf + 32768 + tid * 16) = st.r[4]; *(u32x4*)(buf + 32768 + (tid + 512) * 16) = st.r[5];
    *(u32x4*)(buf + 49152 + tid * 16) = st.r[6];
}
DI f32x4 u_unpack(const u32x2 w) { return (f32x4){__uint_as_float(w.x << 16), __uint_as_float(w.x & 0xffff0000u), __uint_as_float(w.y << 16), __uint_as_float(w.y & 0xffff0000u)}; }
DI void scanA_chain(const Args& a, char* lds, int chain) {
    const int tid = threadIdx.x, lane = tid & 63, vs = tid >> 6, lr = lane & 15, lq = lane >> 4;
    const int h = chain >> 4, g = chain & 15;
    f32x4 SQ[8], SP[8];
#pragma unroll
    for (int mt = 0; mt < 8; ++mt) { SQ[mt] = (f32x4){0.f, 0.f, 0.f, 0.f};
#pragma unroll
        for (int r = 0; r < 4; ++r) SP[mt][r] = (16 * mt + 4 * lq + r == 16 * vs + lr) ? 1.f : 0.f; }
    const size_t cb0 = (size_t)(h * NCH + g * GRP);
    const bf16_t* WF = (const bf16_t*)(a.ws + WS_DNW) + cb0 * 8192; const bf16_t* KF = (const bf16_t*)(a.ws + WS_DNKD) + cb0 * 8192;
    const bf16_t* UF = (const bf16_t*)(a.ws + WS_DNU) + cb0 * 8192 + (size_t)vs * 1024; const float* EG = (const float*)(a.ws + WS_EG) + cb0;
    Stage<4> st; u32x2 ucur[4], unxt[4];
    __syncthreads();
    stage_load2(st, WF, KF);
#pragma unroll
    for (int mt = 0; mt < 4; ++mt) ucur[mt] = *(const u32x2*)(UF + ((size_t)mt * 64 + lane) * 4);
    asm volatile("s_waitcnt vmcnt(0)" ::: "memory");
    stage_write2(st, lds);
    __syncthreads();
    for (int i = 0; i < GRP; ++i) {
        const char* buf = lds + (i & 1) * SBUF;
        if (i + 1 < GRP) { stage_load2(st, WF + (size_t)(i + 1) * 8192, KF + (size_t)(i + 1) * 8192);
#pragma unroll
            for (int mt = 0; mt < 4; ++mt) unxt[mt] = *(const u32x2*)(UF + (size_t)(i + 1) * 8192 + ((size_t)mt * 64 + lane) * 4); }
        const float eg = EG[i];
        const bf16_t* Wl = (const bf16_t*)buf; const bf16_t* Kl = (const bf16_t*)(buf + 16384);
        bf16x8 sbq[4], sbp[4];
#pragma unroll
        for (int s = 0; s < 4; ++s) { sbq[s] = dn::packB(SQ[2 * s], SQ[2 * s + 1]); sbp[s] = dn::packB(SP[2 * s], SP[2 * s + 1]); }
        f32x4 vq[4], vp[4];
#pragma unroll
        for (int mt = 0; mt < 4; ++mt) { vq[mt] = u_unpack(ucur[mt]); vp[mt] = (f32x4){0.f, 0.f, 0.f, 0.f};
#pragma unroll
            for (int s = 0; s < 4; ++s) { const bf16x8 f = dn::frag(Wl, mt * 4 + s, lane); vq[mt] = MFMA16(f, sbq[s], vq[mt]); vp[mt] = MFMA16(f, sbp[s], vp[mt]); } }
        bf16x8 vbq[2], vbp[2];
#pragma unroll
        for (int s = 0; s < 2; ++s) { vbq[s] = dn::packB(vq[2 * s], vq[2 * s + 1]); vbp[s] = dn::packB(vp[2 * s], vp[2 * s + 1]); }
#pragma unroll
        for (int mt = 0; mt < 8; ++mt) { SQ[mt] = SQ[mt] * eg; SP[mt] = SP[mt] * eg;
#pragma unroll
            for (int s = 0; s < 2; ++s) { const bf16x8 f = dn::frag(Kl, mt * 2 + s, lane); SQ[mt] = MFMA16(f, vbq[s], SQ[mt]); SP[mt] = MFMA16(f, vbp[s], SP[mt]); } }
        if (i + 1 < GRP) { asm volatile("s_waitcnt vmcnt(0)" ::: "memory"); stage_write2(st, lds + ((i + 1) & 1) * SBUF);
#pragma unroll
            for (int mt = 0; mt < 4; ++mt) ucur[mt] = unxt[mt]; }
        __syncthreads();
    }
    bf16_t* PG = (bf16_t*)(a.ws + WS_PG) + (size_t)chain * 16384;
#pragma unroll
    for (int mt = 0; mt < 8; ++mt)
#pragma unroll
        for (int r = 0; r < 4; ++r) PG[((mt * 4 + (vs >> 1)) * 64 + (lr >> 2) * 16 + 4 * lq + r) * 8 + 4 * (vs & 1) + (lr & 3)] = f2bf(SP[mt][r]);
    float* QG = (float*)(a.ws + WS_QG) + ((size_t)chain * 8 + vs) * 2048;
#pragma unroll
    for (int mt = 0; mt < 8; ++mt) *(f32x4*)(QG + ((size_t)mt * 64 + lane) * 4) = SQ[mt];
}
DI void scanPC_chain(const Args& a, char* lds, int chain) {
    const int tid = threadIdx.x, lane = tid & 63, vs = tid >> 6, lr = lane & 15, lq = lane >> 4;
    const int h = chain >> 4, g = chain & 15;
    f32x4 S[8];
#pragma unroll
    for (int mt = 0; mt < 8; ++mt) S[mt] = (f32x4){0.f, 0.f, 0.f, 0.f};
    __syncthreads();
    if (g > 0) {
        const bf16_t* PG = (const bf16_t*)(a.ws + WS_PG) + (size_t)(h * NGRP) * 16384; const float* QG = (const float*)(a.ws + WS_QG) + ((size_t)(h * NGRP) * 8 + vs) * 2048;
        Stage<4> st; f32x4 qc[8], qn[8];
        stage_load2(st, PG, PG + 8192);
#pragma unroll
        for (int mt = 0; mt < 8; ++mt) qc[mt] = *(const f32x4*)(QG + ((size_t)mt * 64 + lane) * 4);
        asm volatile("s_waitcnt vmcnt(0)" ::: "memory");
        stage_write2(st, lds);
        __syncthreads();
        for (int j = 0; j < g; ++j) {
            const bf16_t* Pl = (const bf16_t*)(lds + (j & 1) * SBUF);
            if (j + 1 < g) { stage_load2(st, PG + (size_t)(j + 1) * 16384, PG + (size_t)(j + 1) * 16384 + 8192);
#pragma unroll
                for (int mt = 0; mt < 8; ++mt) qn[mt] = *(const f32x4*)(QG + (size_t)(j + 1) * 16384 + ((size_t)mt * 64 + lane) * 4); }
            bf16x8 sb[4];
#pragma unroll
            for (int s = 0; s < 4; ++s) sb[s] = dn::packB(S[2 * s], S[2 * s + 1]);
#pragma unroll
            for (int mt = 0; mt < 8; ++mt) { f32x4 acc = qc[mt];
#pragma unroll
                for (int s = 0; s < 4; ++s) acc = MFMA16(dn::frag(Pl, mt * 4 + s, lane), sb[s], acc);
                S[mt] = acc; }
            if (j + 1 < g) { asm volatile("s_waitcnt vmcnt(0)" ::: "memory"); stage_write2(st, lds + ((j + 1) & 1) * SBUF);
#pragma unroll
                for (int mt = 0; mt < 8; ++mt) qc[mt] = qn[mt]; }
            __syncthreads();
        }
    }
    const size_t cb0 = (size_t)(h * NCH + g * GRP);
    const bf16_t* WF = (const bf16_t*)(a.ws + WS_DNW) + cb0 * 8192; const bf16_t* KF = (const bf16_t*)(a.ws + WS_DNKD) + cb0 * 8192;
    const bf16_t* QF = (const bf16_t*)(a.ws + WS_DNQD) + cb0 * 8192; const bf16_t* AF = (const bf16_t*)(a.ws + WS_DNATT) + cb0 * 4096;
    const bf16_t* UF = (const bf16_t*)(a.ws + WS_DNU) + cb0 * 8192 + (size_t)vs * 1024; const float* EG = (const float*)(a.ws + WS_EG) + cb0;
    float* ORAW = (float*)(a.ws + WS_ORAW);
    Stage<7> st; u32x2 ucur[4], unxt[4];
    stage_load4(st, WF, KF, QF, AF);
#pragma unroll
    for (int mt = 0; mt < 4; ++mt) ucur[mt] = *(const u32x2*)(UF + ((size_t)mt * 64 + lane) * 4);
    asm volatile("s_waitcnt vmcnt(0)" ::: "memory");
    stage_write4(st, lds);
    __syncthreads();
    for (int i = 0; i < GRP; ++i) {
        const char* buf = lds + (i & 1) * SBUF; const int n = g * GRP + i;
        if (i + 1 < GRP) { stage_load4(st, WF + (size_t)(i + 1) * 8192, KF + (size_t)(i + 1) * 8192, QF + (size_t)(i + 1) * 8192, AF + (size_t)(i + 1) * 4096);
#pragma unroll
            for (int mt = 0; mt < 4; ++mt) unxt[mt] = *(const u32x2*)(UF + (size_t)(i + 1) * 8192 + ((size_t)mt * 64 + lane) * 4); }
        const float eg = EG[i];
        const bf16_t* Wl = (const bf16_t*)buf; const bf16_t* Kl = (const bf16_t*)(buf + 16384); const bf16_t* Ql = (const bf16_t*)(buf + 32768); const bf16_t* Al = (const bf16_t*)(buf + 49152);
        bf16x8 sb[4];
#pragma unroll
        for (int s = 0; s < 4; ++s) sb[s] = dn::packB(S[2 * s], S[2 * s + 1]);
        f32x4 vn[4], o[4];
#pragma unroll
        for (int mt = 0; mt < 4; ++mt) { vn[mt] = u_unpack(ucur[mt]); o[mt] = (f32x4){0.f, 0.f, 0.f, 0.f};
#pragma unroll
            for (int s = 0; s < 4; ++s) { vn[mt] = MFMA16(dn::frag(Wl, mt * 4 + s, lane), sb[s], vn[mt]); o[mt] = MFMA16(dn::frag(Ql, mt * 4 + s, lane), sb[s], o[mt]); } }
        bf16x8 vb[2];
#pragma unroll
        for (int s = 0; s < 2; ++s) vb[s] = dn::packB(vn[2 * s], vn[2 * s + 1]);
#pragma unroll
        for (int mt = 0; mt < 4; ++mt)
#pragma unroll
            for (int s = 0; s < 2; ++s) o[mt] = MFMA16(dn::frag(Al, mt * 2 + s, lane), vb[s], o[mt]);
#pragma unroll
        for (int mt = 0; mt < 8; ++mt) { S[mt] = S[mt] * eg;
#pragma unroll
            for (int s = 0; s < 2; ++s) S[mt] = MFMA16(dn::frag(Kl, mt * 2 + s, lane), vb[s], S[mt]); }
#pragma unroll
        for (int mt = 0; mt < 4; ++mt)
#pragma unroll
            for (int r = 0; r < 4; ++r) ORAW[(size_t)(n * CH + 16 * mt + 4 * lq + r) * 512 + h * 128 + 16 * vs + lr] = o[mt][r];
        if (i + 1 < GRP) { asm volatile("s_waitcnt vmcnt(0)" ::: "memory"); stage_write4(st, lds + ((i + 1) & 1) * SBUF);
#pragma unroll
            for (int mt = 0; mt < 4; ++mt) ucur[mt] = unxt[mt]; }
        __syncthreads();
    }
}
DI int fox_jlo(const Args& a, int h, int qb, const float* qkbs, int lane) {
    const float* Fh = (const float*)(a.ws + WS_F) + (size_t)h * SEQ; const float* TB = (const float*)(a.ws + WS_NRMT); const int P0 = qb * 256;
    float mq = 0.f, md = 3.0e38f;
    if (lane < 32) { mq = TB[(qb * 32 + lane) * 12 + h]; md = TB[(qb * 32 + lane) * 12 + 8 + h]; }
    for (int o_ = 1; o_ < 64; o_ <<= 1) { mq = fmaxf(mq, __shfl_xor(mq, o_)); md = fminf(md, __shfl_xor(md, o_)); }
    const float qkb = sqrtf(mq * qkbs[h]) * fox::SCALE, lim = Fh[P0] + qkb - md * fox::SCALE + 32.f;
    const int jd = P0 / 64, stride = jd / 64 + 1;
    int j = lane * stride; bool ok = (j > jd) ? true : (Fh[64 * j + 63] <= lim);
    unsigned long long mk = __ballot(ok); const int first = mk ? __builtin_ctzll(mk) : 64;
    const int lo_ex = first == 0 ? -1 : (first - 1) * stride; const int hi_in = (first < 64 && first * stride <= jd) ? first * stride : jd;
    j = lo_ex + 1 + lane; ok = (j < hi_in) ? (Fh[64 * j + 63] <= lim) : false;
    mk = __ballot(ok); return mk ? lo_ex + 1 + __builtin_ctzll(mk) : hi_in;
}
DI void ph4_fox(const Args& a, char* lds, int nscan) {
    const int tid = threadIdx.x, lane = tid & 63, wave = tid >> 6;
    const float* F = (const float*)(a.ws + WS_F); unsigned* QH = (unsigned*)(a.ws + WS_QH);
    int* misc = (int*)(lds + fox::OFF_MISC);
    if (tid == 0) { int ord0 = 0, ord1 = 1, ord2 = 2, ord3 = 3;
      float r0 = -F[0 * SEQ + SEQ - 1], r1 = -F[1 * SEQ + SEQ - 1], r2 = -F[2 * SEQ + SEQ - 1], r3 = -F[3 * SEQ + SEQ - 1];
#define CSWAP(ra, rb, oa, ob) if (rb < ra) { const float tf = ra; ra = rb; rb = tf; const int ti = oa; oa = ob; ob = ti; }
      CSWAP(r0, r1, ord0, ord1) CSWAP(r2, r3, ord2, ord3) CSWAP(r0, r2, ord0, ord2) CSWAP(r1, r3, ord1, ord3) CSWAP(r1, r2, ord1, ord2)
#undef CSWAP
      misc[4] = ord0; misc[5] = ord1; misc[6] = ord2; misc[7] = ord3; }
    float* qkbs = (float*)(lds + fox::OFF_MISC) + 8;
    const float* TB = (const float*)(a.ws + WS_NRMT);
    __syncthreads();
    { float m = 0.f; const int h = tid & 3;
        for (int g_ = tid >> 2; g_ < SEQ / 8; g_ += NTHREADS / 4) m = fmaxf(m, TB[g_ * 12 + 4 + h]);
        for (int o_ = 4; o_ < 64; o_ <<= 1) m = fmaxf(m, __shfl_xor(m, o_));
        if (lane < 4) qkbs[16 + wave * 4 + lane] = m; }
    __syncthreads();
    if (tid < 4) { float m = 0.f; for (int w = 0; w < NWAVES; ++w) m = fmaxf(m, qkbs[16 + w * 4 + tid]); qkbs[tid] = m; }
    __syncthreads();
    for (int round = 0;; ++round) {
        __syncthreads();
        if (tid == 0) misc[0] = (round == 0 && (int)blockIdx.x >= nscan) ? (int)blockIdx.x - nscan : (int)((int)gridDim.x - nscan + (int)atomicAdd(QH, 1u));
        __syncthreads();
        const int it = misc[0];
        if (it >= 256) break;
        const int h = misc[4 + (it >> 6)], qb = 63 - (it & 63), P0 = qb * 256;
        if (wave == 0) { const int jlo = fox_jlo(a, h, qb, qkbs, lane); if (lane == 0) misc[1] = jlo; }
        __syncthreads();
        fox::fox_block(a, lds, h, P0, misc[1]);
    }
    { unsigned* QC = (unsigned*)(a.ws + WS_QH) + 64; int par = 0;
        for (;;) {
            __syncthreads();
            if (tid == 0) misc[0] = (int)atomicAdd(QC, 1u);
            __syncthreads();
            const int c4 = misc[0] * 4;
            if (c4 >= Q_WGU) break;
#pragma unroll 1
            for (int q = 0; q < 4; ++q) conv_quad_gu(a, lds, par, c4 + q);
        }
    }
}
DI void ph4(const Args& a, float* lds) {
    const int nscan = (int)gridDim.x >= 2 * NSCAN ? NSCAN : 0;
    for (int chain = blockIdx.x; chain < NSCAN; chain += gridDim.x) scanA_chain(a, (char*)lds, chain);
    ph4_fox(a, (char*)lds, nscan);
}
DI void ph5_scan(const Args& a, float* lds) {
    const int G = gridDim.x;
    for (int chain = blockIdx.x; chain < NSCAN; chain += G) scanPC_chain(a, (char*)lds, chain);
    unsigned* QC = (unsigned*)(a.ws + WS_QH) + 128; int* misc = (int*)((char*)lds + 2 * SBUF + 4096); int par = 0;
    for (;;) {
        __syncthreads();
        if (threadIdx.x == 0) misc[0] = (int)atomicAdd(QC, 1u);
        __syncthreads();
        const int c4 = misc[0] * 4;
        if (c4 >= Q_WD) break;
#pragma unroll 1
        for (int q = 0; q < 4; ++q) conv_quad_d(a, (char*)lds, par, c4 + q);
    }
}

DI void ph5(const Args& a) {
    const int lane = threadIdx.x & 63, wave = threadIdx.x >> 6, NW = gridDim.x * NWAVES;
    const float* ORAW = (const float*)(a.ws + WS_ORAW); const bf16_t* P = (const bf16_t*)(a.ws + WS_PROJ); bf16_t* OA = (bf16_t*)(a.ws + WS_OA);
    const float g0 = a.in[I_GON][lane], g1 = a.in[I_GON][lane + 64];
    for (int id = blockIdx.x * NWAVES + wave; id < SEQ * 4; id += NW) { const int t = id >> 2, h = id & 3;
        const float o0 = ORAW[(size_t)t * 512 + h * 128 + lane], o1 = ORAW[(size_t)t * 512 + h * 128 + 64 + lane];
        const float rstd = rsqrtf(wave_sum(o0 * o0 + o1 * o1) * (1.f / 128.f) + 1e-6f);
        const float z0 = bf2f(P[(size_t)t * NPJ + PJ_DZ + h * 128 + lane]), z1 = bf2f(P[(size_t)t * NPJ + PJ_DZ + h * 128 + 64 + lane]);
        OA[(size_t)t * 512 + h * 128 + lane] = f2bf(o0 * rstd * g0 * siluf(z0)); OA[(size_t)t * 512 + h * 128 + 64 + lane] = f2bf(o1 * rstd * g1 * siluf(z1)); }
}

DI void ph6(const Args& a, unsigned char* ldsb) {
    const bf16_t* P = (const bf16_t*)(a.ws + WS_PROJ);
    pg8::OrderDense S; S.init(SEQ / 256, DM / 256, (int)gridDim.x, (int)blockIdx.x);
    { pg8::Gemm g{(const bf16_t*)(a.ws + WS_OA), (const bf16_t*)(a.ws + WS_WOAT), SEQ, DM, 512};
      pg8::EpiMerge<0> E{P + PJ_GA, (float*)(a.ws + WS_X1), (bf16_t*)(a.ws + WS_MRG)};
      pg8::gemm_phase<pg8::EpiMerge<0>, pg8::OrderDense>((LAS unsigned char*)ldsb, g, S, E); }
    __syncthreads();
    { pg8::Gemm g{(const bf16_t*)(a.ws + WS_OB), (const bf16_t*)(a.ws + WS_WOBT), SEQ, DM, 512};
      pg8::EpiMerge<1> E{P + PJ_GB, (float*)(a.ws + WS_X1), (bf16_t*)(a.ws + WS_MRG)};
      pg8::gemm_phase<pg8::EpiMerge<1>, pg8::OrderDense>((LAS unsigned char*)ldsb, g, S, E); }
}

DI void ph7(const Args& a, unsigned char* ldsb) {
    pg8::Gemm g{(const bf16_t*)(a.ws + WS_MRG), (const bf16_t*)(a.ws + WS_WOUTT), SEQ, DM, DM};
    pg8::OrderDense S; S.init(SEQ / 256, DM / 256, (int)gridDim.x, (int)blockIdx.x);
    pg8::EpiResid E{a.in[I_X], (const float*)(a.ws + WS_MOD) + 2048, (float*)(a.ws + WS_X1)};
    pg8::gemm_phase<pg8::EpiResid, pg8::OrderDense>((LAS unsigned char*)ldsb, g, S, E);
}

DI void ph8(const Args& a, float* lds) {
    const int tid = threadIdx.x, lane = tid & 63, wave = tid >> 6, G = gridDim.x;
    constexpr int HP = 1028;
    float* A2 = lds; float* B2 = lds + 1024; float* hs = lds + 2048; float* lgs = hs + 16 * HP;
    const float* mod = (const float*)(a.ws + WS_MOD);
    for (int k = tid; k < DM; k += NTHREADS) { A2[k] = a.in[I_G2][k] * (1.f + mod[4096 + k]); B2[k] = mod[3072 + k]; }
    const float* X1 = (const float*)(a.ws + WS_X1); bf16_t* H2 = (bf16_t*)(a.ws + WS_H2);
    int* TOKE = (int*)(a.ws + WS_TOKE); int* TOKS = (int*)(a.ws + WS_TOKS); float* TOKG = (float*)(a.ws + WS_TOKG); unsigned* CNT = (unsigned*)(a.ws + WS_CNT);
    const float* wr = a.in[I_WR];
    float* part = lgs + 512; int* lcnt = (int*)(part + 8 * 16 * 32);
    float wb0[32], wb1[32];
#pragma unroll
    for (int s = 0; s < 32; ++s) { const size_t k = (size_t)(128 * wave + 4 * s + (lane >> 4)); wb0[s] = wr[k * NE + (lane & 15)]; wb1[s] = wr[k * NE + 16 + (lane & 15)]; }
    for (int tile = blockIdx.x; tile < SEQ / 16; tile += G) {
        __syncthreads();
#pragma unroll 1
        for (int q = 0; q < 2; ++q) { const int tt = wave * 2 + q, t = tile * 16 + tt; const float* xr = X1 + (size_t)t * DM;
            f32x4 v[4]; float ss = 0.f;
#pragma unroll
            for (int i = 0; i < 4; ++i) { v[i] = *(const f32x4*)(xr + lane * 4 + 256 * i); ss += v[i][0] * v[i][0] + v[i][1] * v[i][1] + v[i][2] * v[i][2] + v[i][3] * v[i][3]; }
            ss = wave_sum(ss);
            const float rstd = rsqrtf(ss * (1.f / DM) + 1e-6f);
#pragma unroll
            for (int i = 0; i < 4; ++i) { const int k = lane * 4 + 256 * i;
#pragma unroll
                for (int e = 0; e < 4; ++e) v[i][e] = v[i][e] * rstd * A2[k + e] + B2[k + e];
                *(f32x4*)(hs + tt * HP + k) = v[i];
                u32x2 w; w.x = cvt_pk(v[i][0], v[i][1]); w.y = cvt_pk(v[i][2], v[i][3]);
                *(u32x2*)(H2 + (size_t)t * DM + k) = w; } }
        __syncthreads();
        {
            if (tid < 32) lcnt[tid] = 0;
            f32x4 c0 = (f32x4){0.f, 0.f, 0.f, 0.f}, c1 = c0; const float* ha = hs + (lane & 15) * HP + 128 * wave + (lane >> 4);
#pragma unroll
            for (int s = 0; s < 32; ++s) { const float av = ha[4 * s];
                c0 = __builtin_amdgcn_mfma_f32_16x16x4f32(av, wb0[s], c0, 0, 0, 0); c1 = __builtin_amdgcn_mfma_f32_16x16x4f32(av, wb1[s], c1, 0, 0, 0); }
#pragma unroll
            for (int r = 0; r < 4; ++r) { part[(wave * 16 + 4 * (lane >> 4) + r) * 32 + (lane & 15)] = c0[r]; part[(wave * 16 + 4 * (lane >> 4) + r) * 32 + 16 + (lane & 15)] = c1[r]; }
            __syncthreads();
            const int tt = tid >> 5, e = tid & 31; float acc = a.in[I_BR][e];
#pragma unroll
            for (int w = 0; w < 8; ++w) acc += part[(w * 16 + tt) * 32 + e];
            lgs[tt * 32 + e] = acc; }
        __syncthreads();
        { const int e = lane & 31, tt = wave * 2 + (lane >> 5), t = tile * 16 + tt;
            float cur = lgs[tt * 32 + e];
#define TOP1(TV, TI) float TV = cur; int TI = e; for (int o_ = 1; o_ <= 16; o_ <<= 1) { const float ov = __shfl_xor(TV, o_); const int oi = __shfl_xor(TI, o_); if (ov > TV || (ov == TV && oi < TI)) { TV = ov; TI = oi; } } if (e == TI) cur = -__builtin_inff();
            TOP1(tv0, ti0) TOP1(tv1, ti1) TOP1(tv2, ti2) TOP1(tv3, ti3)
#undef TOP1
            const float ex0 = 1.f, ex1 = expf(tv1 - tv0), ex2 = expf(tv2 - tv0), ex3 = expf(tv3 - tv0), den = ex0 + ex1 + ex2 + ex3;
            if (e < 4) { int ee = ti0; float gg = ex0;
                if (e == 1) { ee = ti1; gg = ex1; } if (e == 2) { ee = ti2; gg = ex2; } if (e == 3) { ee = ti3; gg = ex3; }
                const int rank = atomicAdd(lcnt + ee, 1);
                TOKE[t * 4 + e] = ee; TOKS[t * 4 + e] = rank; TOKG[t * 4 + e] = gg / den; } }
        __syncthreads();
        if (tid < 32) ((int*)(a.ws + WS_TCNT))[tile * 32 + tid] = lcnt[tid];
    }
}

DI void pad_starts(const Args& a, int* ps) {
    if (threadIdx.x == 0) { const unsigned* CNT = (const unsigned*)(a.ws + WS_CNT); int s = 0; for (int e = 0; e < NE; ++e) { ps[e] = s; s += (int)((CNT[e] + 255u) / 256u) * 256; } ps[NE] = s; }
    __syncthreads();
}
DI void ph9(const Args& a, float* lds) {
    const int tid = threadIdx.x, lane = tid & 63, wave = tid >> 6, G = gridDim.x;
    int* tab = (int*)lds; int* segs = tab + 32768; int* segoff = segs + 512; int* ps = segoff + 512; int* basel = ps + 64;
    const int* TCNT = (const int*)(a.ws + WS_TCNT);
    for (int i = tid; i < 8192; i += NTHREADS) ((u32x4*)tab)[i] = ((const u32x4*)TCNT)[i];
    __syncthreads();
    { const int e = tid & 31, sg = tid >> 5; int s = 0;
#pragma unroll 8
        for (int q = 0; q < 64; ++q) s += tab[(sg * 64 + q) * 32 + e];
        segs[sg * 32 + e] = s; }
    __syncthreads();
    if (tid < 32) { int run = 0; for (int sg = 0; sg < 16; ++sg) { segoff[sg * 32 + tid] = run; run += segs[sg * 32 + tid]; }
        segs[tid] = run;
        if (blockIdx.x == 0) ((unsigned*)(a.ws + WS_CNT))[tid] = (unsigned)run; }
    __syncthreads();
    if (tid == 0) { int s = 0; for (int e = 0; e < NE; ++e) { ps[e] = s; s += ((segs[e] + 255) / 256) * 256; } ps[NE] = s; }
    __syncthreads();
    const int* TOKE = (const int*)(a.ws + WS_TOKE); int* TOKS = (int*)(a.ws + WS_TOKS);
    const bf16_t* H2 = (const bf16_t*)(a.ws + WS_H2); bf16_t* XG = (bf16_t*)(a.ws + WS_XG);
    for (int tile = blockIdx.x; tile < SEQ / 16; tile += G) {
        __syncthreads();
        if (tid < 32) { int b = segoff[(tile >> 6) * 32 + tid]; for (int q = (tile >> 6) * 64; q < tile; ++q) b += tab[q * 32 + tid]; basel[tid] = ps[tid] + b; }
        __syncthreads();
#pragma unroll 1
        for (int q = 0; q < 8; ++q) { const int id = tile * 64 + wave * 8 + q, t = id >> 2;
            const size_t row = (size_t)(basel[TOKE[id]] + TOKS[id]);
            const u32x4 v0 = *(const u32x4*)(H2 + (size_t)t * DM + lane * 8), v1 = *(const u32x4*)(H2 + (size_t)t * DM + 512 + lane * 8);
            *(u32x4*)(XG + row * DM + lane * 8) = v0; *(u32x4*)(XG + row * DM + 512 + lane * 8) = v1;
            if (lane == 0) TOKS[id] = (int)row; }
    }
}
DI int expert_of(const int* ps, int row0) { int e = 0; for (int i = 1; i < NE; ++i) if (row0 >= ps[i]) e = i; return e; }
DI void ph10(const Args& a, unsigned char* ldsb) {
    int* ps = (int*)(ldsb + 131072); pad_starts(a, ps);
    pg8::Gemm g{(const bf16_t*)(a.ws + WS_XG), (const bf16_t*)(a.ws + WS_WGUT), 0, 2048, DM};
    pg8::OrderGrouped S; S.init(ps[NE] / 256, 8, (int)gridDim.x, (int)blockIdx.x); S.ps = (const LAS int*)ps;
    pg8::EpiSwiglu E{(bf16_t*)(a.ws + WS_ACT), a.in[I_BGU]};
    pg8::gemm_phase<pg8::EpiSwiglu, pg8::OrderGrouped>((LAS unsigned char*)ldsb, g, S, E);
}
DI void ph11(const Args& a, unsigned char* ldsb) {
    int* ps = (int*)(ldsb + 131072); pad_starts(a, ps);
    pg8::Gemm g{(const bf16_t*)(a.ws + WS_ACT), (const bf16_t*)(a.ws + WS_WDT), 0, DM, DM};
    pg8::OrderGrouped S; S.init(ps[NE] / 256, 4, (int)gridDim.x, (int)blockIdx.x); S.ps = (const LAS int*)ps;
    pg8::EpiStoreBf16 E{(bf16_t*)(a.ws + WS_YB), DM, a.in[I_BD], DM};
    pg8::gemm_phase<pg8::EpiStoreBf16, pg8::OrderGrouped>((LAS unsigned char*)ldsb, g, S, E);
}
DI void ph12(const Args& a, float* lds) {
    const int lane = threadIdx.x & 63, wave = threadIdx.x >> 6, G = gridDim.x;
    const float* X1 = (const float*)(a.ws + WS_X1); const bf16_t* YB = (const bf16_t*)(a.ws + WS_YB); const float* mod = (const float*)(a.ws + WS_MOD);
    const int* TOKS = (const int*)(a.ws + WS_TOKS); const float* TOKG = (const float*)(a.ws + WS_TOKG);
    f32x4 gt[4], gf[4];
#pragma unroll
    for (int i = 0; i < 4; ++i) { gt[i] = *(const f32x4*)(mod + 5120 + lane * 4 + 256 * i); gf[i] = *(const f32x4*)(a.in[I_GF] + lane * 4 + 256 * i); }
    for (int t0 = (blockIdx.x * NWAVES + wave) * 2; t0 < SEQ; t0 += G * NWAVES * 2) {
        int rows[2][4]; float gk[2][4];
#pragma unroll
        for (int p = 0; p < 2; ++p)
#pragma unroll
            for (int q = 0; q < 4; ++q) { rows[p][q] = TOKS[(t0 + p) * 4 + q]; gk[p][q] = TOKG[(t0 + p) * 4 + q]; }
        f32x4 v[2][4]; u32x2 yv[2][4][4];
#pragma unroll
        for (int p = 0; p < 2; ++p)
#pragma unroll
            for (int i = 0; i < 4; ++i) { const int k = lane * 4 + 256 * i; v[p][i] = *(const f32x4*)(X1 + (size_t)(t0 + p) * DM + k);
#pragma unroll
                for (int q = 0; q < 4; ++q) yv[p][i][q] = *(const u32x2*)(YB + (size_t)rows[p][q] * DM + k); }
#pragma unroll
        for (int p = 0; p < 2; ++p) { float ss = 0.f;
#pragma unroll
            for (int i = 0; i < 4; ++i) { f32x4 y = (f32x4){0.f, 0.f, 0.f, 0.f};
#pragma unroll
                for (int q = 0; q < 4; ++q) { const u32x2 w = yv[p][i][q];
                    y[0] += gk[p][q] * __uint_as_float(w.x << 16); y[1] += gk[p][q] * __uint_as_float(w.x & 0xffff0000u); y[2] += gk[p][q] * __uint_as_float(w.y << 16); y[3] += gk[p][q] * __uint_as_float(w.y & 0xffff0000u); }
                v[p][i] += gt[i] * y; ss += v[p][i][0] * v[p][i][0] + v[p][i][1] * v[p][i][1] + v[p][i][2] * v[p][i][2] + v[p][i][3] * v[p][i][3]; }
            ss = wave_sum(ss);
            const float rstd = rsqrtf(ss * (1.f / DM) + 1e-6f);
#pragma unroll
            for (int i = 0; i < 4; ++i) *(f32x4*)(a.out + (size_t)(t0 + p) * DM + lane * 4 + 256 * i) = v[p][i] * rstd * gf[i]; }
    }
}

__global__ void __launch_bounds__(NTHREADS, 2) hybrid_fwd(Args a) {
    extern __shared__ __attribute__((aligned(16))) unsigned char lds_raw[];
    float* lds = (float*)(lds_raw + 16);
    LAS unsigned* xbw = (LAS unsigned*)lds_raw;
    if (threadIdx.x == 0) { xbw[0] = 0u; xbw[1] = 0u; xbw[2] = 0u; xbw[3] = 0u; }
    __syncthreads();
    XcdBarrier bar; bar.bar = (unsigned*)(a.ws + WS_BAR); bar.x = 0; bar.st = (volatile LAS unsigned*)xbw;
    const int lo = a.ph_lo, hi = a.ph_hi;
    if (hi - lo > 1) bar = xcd_barrier_post((unsigned*)(a.ws + WS_BAR), (volatile LAS unsigned*)xbw);
#define IN(k) (lo <= (k) && (k) < hi)
#define SEAM(k) do { if (IN(k) && IN((k) + 1)) xcd_barrier(bar); } while (0)
    if (IN(0)) ph0(a, lds);
    SEAM(0);
    if (IN(1)) ph1(a, lds);
    SEAM(1);
    if (IN(2)) ph2(a, lds_raw + 16);
    SEAM(2);
    if (IN(3)) ph3(a, lds);
    SEAM(3);
    if (IN(4)) ph4(a, lds);
    SEAM(4);
    if (IN(5)) ph5_scan(a, lds);
    SEAM(5);
    if (IN(6)) ph5(a);
    SEAM(6);
    if (IN(7)) ph6(a, lds_raw + 16);
    SEAM(7);
    if (IN(8)) ph7(a, lds_raw + 16);
    SEAM(8);
    if (IN(9)) ph8(a, lds);
    SEAM(9);
    if (IN(10)) ph9(a, lds);
    SEAM(10);
    if (IN(11)) ph10(a, lds_raw + 16);
    SEAM(11);
    if (IN(12)) ph11(a, lds_raw + 16);
    SEAM(12);
    if (IN(13)) ph12(a, lds);
#undef IN
#undef SEAM
}

extern "C" void kernel_launch(void* const* d_in, const int* in_sizes, int n_in, void* d_out, int out_size, void* d_ws, size_t ws_size, hipStream_t stream) {
    static int grid = 0;
    if (grid == 0) {
        if (n_in != 22 || out_size != SEQ * DM || ws_size < WS_END) { fprintf(stderr, "kernel_launch: unexpected shapes (n_in %d out %d ws %zu, need %zu)\n", n_in, out_size, ws_size, (size_t)WS_END); grid = -1; return; }
        int dev = 0, cus = 0, per_cu = 0;
        if (hipGetDevice(&dev) != hipSuccess || hipDeviceGetAttribute(&cus, hipDeviceAttributeMultiprocessorCount, dev) != hipSuccess) { grid = -1; return; }
        if (hipFuncSetAttribute((const void*)hybrid_fwd, hipFuncAttributeMaxDynamicSharedMemorySize, LDS_BYTES) != hipSuccess) { fprintf(stderr, "kernel_launch: hipFuncSetAttribute failed\n"); grid = -1; return; }
        if (hipOccupancyMaxActiveBlocksPerMultiprocessor(&per_cu, (const void*)hybrid_fwd, NTHREADS, LDS_BYTES) != hipSuccess || per_cu < 1) { fprintf(stderr, "kernel_launch: occupancy query says %d\n", per_cu); }
        (void)hipGetLastError();
        grid = cus;
    }
    if (grid < 0) return;
    (void)hipMemsetAsync(d_ws, 0, CTL_ZERO, stream);
    Args a{};
    for (int i = 0; i < 22; ++i) a.in[i] = (const float*)d_in[i];
    a.out = (float*)d_out; a.ws = (unsigned char*)d_ws;
#if N_LAUNCHES == 1
    a.ph_lo = 0; a.ph_hi = NPHASES;
    hipLaunchKernelGGL(hybrid_fwd, dim3(grid), dim3(NTHREADS), LDS_BYTES, stream, a);
#else
    for (int p = 0; p < NPHASES; ++p) { a.ph_lo = p; a.ph_hi = p + 1; hipLaunchKernelGGL(hybrid_fwd, dim3(grid), dim3(NTHREADS), LDS_BYTES, stream, a); }
#endif
}
```

```cpp
#include <hip/hip_runtime.h>
#include <stdint.h>
#include <stdio.h>

#ifndef N_LAUNCHES
#define N_LAUNCHES 1
#endif

#define DI __device__ __forceinline__
#define LAS __attribute__((address_space(3)))
typedef unsigned short bf16_t;
typedef short bf16x8 __attribute__((ext_vector_type(8)));
typedef float f32x4 __attribute__((ext_vector_type(4)));
typedef unsigned u32x4 __attribute__((ext_vector_type(4)));
typedef unsigned u32x2 __attribute__((ext_vector_type(2)));
typedef int v8i32 __attribute__((ext_vector_type(8)));

constexpr int SEQ = 16384, DM = 1024, NIN = 5644, NPJ = 5632, NE = 32, TOPK = 4;
constexpr int NH = 4, HD = 128, CH = 64, NCH = SEQ / CH;
constexpr int PJ_DQ = 0, PJ_DK = 512, PJ_DV = 1024, PJ_DZ = 1536, PJ_FQ = 2048, PJ_FK = 2560, PJ_FV = 3072, PJ_GA = 3584, PJ_GB = 4608;
constexpr int NTHREADS = 512, NWAVES = 8;
constexpr int LDS_BYTES = 152 * 1024;
constexpr int NPHASES = 14;

constexpr size_t MiB = 1u << 20;
constexpr size_t WS_BAR = 0;
constexpr size_t WS_CNT = 32768;
constexpr size_t WS_NRM = 32768 + 256;
constexpr size_t WS_QH = 32768 + 512;
constexpr size_t CTL_ZERO = 65536;
constexpr size_t WS_MOD = 65536;
constexpr size_t WS_F = WS_MOD + 32768;
constexpr size_t WS_EG = WS_F + 262144;
constexpr size_t WS_TOKE = WS_EG + 4096;
constexpr size_t WS_TOKS = WS_TOKE + 262144;
constexpr size_t WS_TOKG = WS_TOKS + 262144;
constexpr size_t WS_SP = WS_TOKG + 262144;
constexpr size_t WS_WINT = WS_SP + MiB;
constexpr size_t WS_WOAT = WS_WINT + (size_t)NPJ * DM * 2;
constexpr size_t WS_WOBT = WS_WOAT + MiB;
constexpr size_t WS_WOUTT = WS_WOBT + MiB;
constexpr size_t WS_WGUT = WS_WOUTT + 2 * MiB;
constexpr size_t WS_WDT = WS_WGUT + 128 * MiB;
constexpr size_t WS_X1 = WS_WDT + 64 * MiB;
constexpr size_t WS_H2 = WS_X1 + 64 * MiB;
constexpr size_t WS_MRG = WS_H2 + 32 * MiB;
constexpr size_t WS_RA = WS_MRG + 32 * MiB;
constexpr size_t WS_RB = WS_RA + 176 * MiB;
constexpr size_t WS_H = WS_RB;
constexpr size_t WS_DNW = WS_H + 32 * MiB;
constexpr size_t WS_DNU = WS_DNW + 16 * MiB;
constexpr size_t WS_DNQD = WS_DNU + 16 * MiB;
constexpr size_t WS_DNKD = WS_DNQD + 16 * MiB;
constexpr size_t WS_DNATT = WS_DNKD + 16 * MiB;
constexpr size_t WS_ORAW = WS_DNATT + 8 * MiB;
constexpr size_t WS_OA = WS_ORAW + 32 * MiB;
constexpr size_t WS_OB = WS_OA + 16 * MiB;
constexpr size_t WS_VT = WS_OB + 16 * MiB;
constexpr size_t WS_PG = WS_VT;
constexpr size_t WS_QG = WS_PG + 2 * MiB;
constexpr size_t WS_SG = WS_QG + 4 * MiB;
constexpr size_t WS_TCNT = WS_SG + 4 * MiB;
constexpr size_t WS_LF = WS_TCNT + 131072 + 131072;
constexpr size_t WS_NRMT = WS_TCNT + 131072;
constexpr size_t WS_END = WS_RB + 184 * MiB;
constexpr size_t WS_XG = WS_RA, WS_YB = WS_RA, WS_ACT = WS_RB, WS_PROJ = WS_RA;
static_assert(WS_VT + 16 * MiB <= WS_END, "region B");

struct Args { const float* in[22]; float* out; unsigned char* ws; int ph_lo, ph_hi; };
enum { I_X = 0, I_C, I_WADA, I_BADA, I_G1, I_WIN, I_CONVW, I_ALOG, I_DTB, I_GON, I_BFG, I_WOD, I_WOF, I_WOUT, I_G2, I_WR, I_BR, I_WGU, I_BGU, I_WD, I_BD, I_GF };

DI float bf2f(bf16_t v) { return __uint_as_float(((unsigned)v) << 16); }
DI bf16_t f2bf(float f) { unsigned u = __float_as_uint(f); u += 0x7fffu + ((u >> 16) & 1u); return (bf16_t)(u >> 16); }
typedef float f32x2_t __attribute__((ext_vector_type(2)));
typedef __bf16 bf16x2_t __attribute__((ext_vector_type(2)));
DI unsigned cvt_pk(float lo, float hi) { const f32x2_t v = {lo, hi}; const bf16x2_t b = __builtin_convertvector(v, bf16x2_t); return __builtin_bit_cast(unsigned, b); }
DI unsigned cvt_f8x4(float a, float b, float c, float d) { unsigned w = 0; w = __builtin_amdgcn_cvt_pk_fp8_f32(a, b, w, false); w = __builtin_amdgcn_cvt_pk_fp8_f32(c, d, w, true); return w; }
DI unsigned pk2(float lo, float hi) { return (unsigned)f2bf(lo) | ((unsigned)f2bf(hi) << 16); }
DI float sigm(float x) { return 1.f / (1.f + expf(-x)); }
DI float siluf(float x) { return x / (1.f + expf(-x)); }
DI float softplusf(float x) { return fmaxf(x, 0.f) + log1pf(expf(-fabsf(x))); }
DI float logsigf(float x) { return fminf(x, 0.f) - log1pf(expf(-fabsf(x))); }
DI float wave_sum(float v) { for (int o = 32; o >= 1; o >>= 1) v += __shfl_xor(v, o); return v; }
#define MFMA16(a, b, c) __builtin_amdgcn_mfma_f32_16x16x32_bf16((a), (b), (c), 0, 0, 0)

DI int gu_src(int n) { const int g = n >> 8, r = n & 255; return r < 128 ? 128 * g + r : 1024 + 128 * g + (r - 128); }

#define XB_TMO      128
#define XB_XCNT(j)  (256  + 64 * (j))
#define XB_XSUB(j)  (1280 + 64 * (j))
#define XB_XGEN(j)  (2304 + 64 * (j))
#define XB_TOP      3328
#define XB_TOPGEN   3392
#define XCD_BAR_WORDS 3456
#define XB_SPIN_CAP (1u << 22)
DI unsigned xb_ld(unsigned* p)              { return __hip_atomic_load(p, __ATOMIC_RELAXED, __HIP_MEMORY_SCOPE_AGENT); }
DI unsigned xb_add(unsigned* p, unsigned v) { return __hip_atomic_fetch_add(p, v, __ATOMIC_RELAXED, __HIP_MEMORY_SCOPE_AGENT); }
DI unsigned xb_xcc_id() { return (unsigned)__builtin_amdgcn_s_getreg((3 << 11) | 20) & 0xFu; }
#define XB_SPIN(cond, bar) do { unsigned _sp = 0; while (cond) { __builtin_amdgcn_s_sleep(1); \
    if ((++_sp & 255u) == 0u) { if (xb_ld(&(bar)[XB_TMO])) break; if (_sp > XB_SPIN_CAP) { atomicAdd(&(bar)[XB_TMO], 1u); break; } } } } while (0)
struct XcdBarrier { unsigned* bar; unsigned x; volatile LAS unsigned* st; };
DI XcdBarrier xcd_barrier_post(unsigned* bar, volatile LAS unsigned* st) {
    XcdBarrier b; b.bar = bar; b.x = xb_xcc_id(); b.st = st;
    if (threadIdx.x == 0) (void)xb_add(&bar[XB_XCNT(b.x)], 1u);
    return b;
}
DI void xcd_barrier_complete(unsigned* bar, unsigned x, unsigned& nloc, unsigned& nx) {
    const unsigned G = gridDim.x * gridDim.y * gridDim.z;
    unsigned sum, cnt, mine, sp = 0u;
    for (;;) {
        sum = 0u; cnt = 0u; mine = 0u;
#pragma unroll
        for (unsigned j = 0; j < 16; ++j) { const unsigned c = xb_ld(&bar[XB_XCNT(j)]); sum += c; cnt += (c > 0u) ? 1u : 0u; mine = (j == x) ? c : mine; }
        if (sum == G) break;
        __builtin_amdgcn_s_sleep(1);
        if ((++sp & 255u) == 0u) { if (xb_ld(&bar[XB_TMO])) break; if (sp > XB_SPIN_CAP) { atomicAdd(&bar[XB_TMO], 1u); break; } }
    }
    nloc = mine > 0u ? mine : 1u; nx = cnt > 0u ? cnt : 1u;
}
DI void xcd_barrier(const XcdBarrier& b) {
    asm volatile("s_waitcnt vmcnt(0)" ::: "memory");
    __syncthreads();
    if (threadIdx.x == 0) {
        unsigned* bar = b.bar;
        __builtin_amdgcn_s_waitcnt(0);
        unsigned nloc = b.st[0], nx = b.st[1];
        if (nloc == 0u) { xcd_barrier_complete(bar, b.x, nloc, nx); b.st[0] = nloc; b.st[1] = nx; }
        const unsigned old = xb_add(&bar[XB_XSUB(b.x)], 1u);
        const unsigned gen = old / nloc;
        if (old + 1u == (gen + 1u) * nloc) {
            __builtin_amdgcn_fence(__ATOMIC_RELEASE, "agent");
            asm volatile("s_waitcnt vmcnt(0)" ::: "memory");
            const unsigned og = xb_add(&bar[XB_TOP], 1u);
            const unsigned tg = og / nx;
            if (og + 1u == (tg + 1u) * nx) xb_add(&bar[XB_TOPGEN], 1u);
            else XB_SPIN(xb_ld(&bar[XB_TOPGEN]) == tg, bar);
            __builtin_amdgcn_fence(__ATOMIC_ACQUIRE, "agent");
            xb_add(&bar[XB_XGEN(b.x)], 1u);
            asm volatile("s_waitcnt vmcnt(0)" ::: "memory");
        } else {
            XB_SPIN(xb_ld(&bar[XB_XGEN(b.x)]) == gen, bar);
            __builtin_amdgcn_fence(__ATOMIC_ACQUIRE, "agent");
            asm volatile("s_waitcnt vmcnt(0)" ::: "memory");
        }
    }
    __syncthreads();
}

template <int NT>
DI void wave_gemm(const bf16_t* const (&ap)[4], const bf16_t* const (&bp)[NT], int K, f32x4 (&acc)[4][NT]) {
    for (int k0 = 0; k0 < K; k0 += 32) {
        bf16x8 a[4], b[NT];
#pragma unroll
        for (int i = 0; i < 4; ++i) a[i] = *(const bf16x8*)(ap[i] + k0);
#pragma unroll
        for (int j = 0; j < NT; ++j) b[j] = *(const bf16x8*)(bp[j] + k0);
#pragma unroll
        for (int i = 0; i < 4; ++i)
#pragma unroll
            for (int j = 0; j < NT; ++j) acc[i][j] = MFMA16(a[i], b[j], acc[i][j]);
    }
}
template <int NT> DI void zero_acc(f32x4 (&acc)[4][NT]) {
#pragma unroll
    for (int i = 0; i < 4; ++i)
#pragma unroll
        for (int j = 0; j < NT; ++j) acc[i][j] = (f32x4){0.f, 0.f, 0.f, 0.f};
}


constexpr float WSCALE = 64.f, ASCALE = 4.f;
namespace pg8 {
struct Unit { int pm, pn, pb, e; };
struct Gemm { const bf16_t* A; const bf16_t* Bt; int M, N, K; };
constexpr int BM = 256, BK = 64, HALF = 128, HTB = HALF * BK * 2  , STAGE_BYTES = 8 * HTB, NXCD = 8, WGM = 8;

__host__ __device__ __forceinline__ int lds_byte(int r, int c) { const int st = (r >> 4) * 2 + (c >> 5), rr = r & 15, cc = c & 31, ob = rr * 64 + cc * 2; return st * 1024 + (ob ^ (((ob >> 9) & 1) << 5)); }
__host__ __device__ __forceinline__ void stage_rc(int b, int& R, int& C) { const int st = b / 1024, sb = b % 1024, swz = sb ^ (((sb >> 9) & 1) << 5); R = (st >> 1) * 16 + swz / 64; C = (st & 1) * 32 + (swz % 64) / 2; }
__host__ __device__ __forceinline__ int perm32(int rho) { const int n = rho >> 4, i = rho & 15; return 8 * (i >> 2) + 4 * n + (i & 3); }
template <class Epi, class Sched, bool FP8 = false>
__device__ __forceinline__ void gemm_phase(LAS unsigned char* lds, const Gemm g, const Sched& S, const Epi& E) {
    const int tid = threadIdx.x, wid = __builtin_amdgcn_readfirstlane(tid >> 6), lane = tid & 63, wr = wid >> 2, wc = wid & 3, fr = lane & 15, fq = lane >> 4;
    const int K = FP8 ? g.K / 2 : g.K, nt = K / BK;
    unsigned voffA[2], voffB[2];
#pragma unroll
    for (int i = 0; i < 2; ++i) { int R, C;
        if (FP8) { const int b = tid * 16 + i * 8192; R = b >> 7; C = (((((b & 127) >> 5) ^ ((R >> 1) & 3)) << 5) + (b & 31)) >> 1; }
        else stage_rc(tid * 16 + i * 8192, R, C);
        const int Rb = Epi::PERM ? ((R & ~31) + perm32(R & 31)) : R;
        voffA[i] = (unsigned)(R * K + C) * 2u; voffB[i] = (unsigned)(Rb * K + C) * 2u; }
    const size_t kstep = (size_t)(BK * 2);
    const size_t hstep = (size_t)HALF * K * 2;
    const size_t tstep = 2 * hstep;
    const unsigned ldsw = (unsigned)wid * 1024u;
    const int aoff = FP8 ? (wr * 64 + fr) * 128 + ((fq ^ ((fr >> 1) & 3)) << 5) : lds_byte(wr * 64 + fr, fq * 8), boff = FP8 ? (wc * 32 + fr) * 128 + ((fq ^ ((fr >> 1) & 3)) << 5) : lds_byte(wc * 32 + fr, fq * 8);
#define PG8_SA(b, h) (((b) * 2 + (h)) * HTB)
#define PG8_SB(b, h) ((4 + (b) * 2 + (h)) * HTB)
#define PG8_STAGE(bufoff, gbase, voff) do { _Pragma("unroll") for (int _i = 0; _i < 2; ++_i) \
        __builtin_amdgcn_global_load_lds((const unsigned*)((const char*)(gbase) + (voff)[_i]), (LAS unsigned*)(lds + (bufoff) + ldsw + _i * 8192), 16, 0, 0); } while (0)
#define PG8_LDA(dst, b, h) do { _Pragma("unroll") for (int m = 0; m < 4; ++m) { if (FP8) dst##8[m] = *(const LAS v8i32*)(lds + PG8_SA(b, h) + aoff + m * 2048); \
        else { _Pragma("unroll") for (int k = 0; k < 2; ++k) dst[m][k] = *(const LAS bf16x8*)(lds + PG8_SA(b, h) + aoff + m * 2048 + k * 1024); } } } while (0)
#define PG8_LDB(dst, b, h) do { _Pragma("unroll") for (int n = 0; n < 2; ++n) { if (FP8) dst##8[n] = *(const LAS v8i32*)(lds + PG8_SB(b, h) + boff + n * 2048); \
        else { _Pragma("unroll") for (int k = 0; k < 2; ++k) dst[n][k] = *(const LAS bf16x8*)(lds + PG8_SB(b, h) + boff + n * 2048 + k * 1024); } } } while (0)
#define PG8_MMA(ai, bj, At, Bt) do { __builtin_amdgcn_s_setprio(1); _Pragma("unroll") for (int m = 0; m < 4; ++m) _Pragma("unroll") for (int n = 0; n < 2; ++n) { \
        if (FP8) asm volatile("v_mfma_f32_16x16x128_f8f6f4 %0, %1, %2, %0" : "+v"(acc[ai][bj][m][n]) : "v"(Bt##8[n]), "v"(At##8[m])); \
        else { _Pragma("unroll") for (int k = 0; k < 2; ++k) acc[ai][bj][m][n] = __builtin_amdgcn_mfma_f32_16x16x32_bf16(Bt[n][k], At[m][k], acc[ai][bj][m][n], 0, 0, 0); } } \
        __builtin_amdgcn_s_setprio(0); } while (0)
#define PG8_WAIT_V(n) asm volatile("s_waitcnt vmcnt(" #n ")" ::: "memory")
#define PG8_WAIT_L(n) asm volatile("s_waitcnt lgkmcnt(" #n ")" ::: "memory")
#define PG8_BAR __builtin_amdgcn_s_barrier()
#define PG8_SCHED __builtin_amdgcn_sched_barrier(0)
    Unit cur, nxt; int ui = 0;
    if (!S.next(0, cur)) return;
    f32x4 acc[2][2][4][2];
#pragma unroll
    for (int a = 0; a < 2; ++a)
#pragma unroll
        for (int b = 0; b < 2; ++b)
#pragma unroll
            for (int m = 0; m < 4; ++m)
#pragma unroll
                for (int n = 0; n < 2; ++n) acc[a][b][m][n] = (f32x4){0.f, 0.f, 0.f, 0.f};
    bf16x8 At[4][2], B0[2][2], B1[2][2]; v8i32 At8[4], B08[2], B18[2];
    const char* cA = (const char*)g.A + (size_t)cur.pm * tstep; const char* cB = (const char*)g.Bt + (size_t)cur.pb * tstep;
    S.a_ready(cur);
    PG8_STAGE(PG8_SB(0, 0), cB, voffB); PG8_STAGE(PG8_SA(0, 0), cA, voffA); PG8_STAGE(PG8_SB(0, 1), cB + hstep, voffB); PG8_STAGE(PG8_SA(0, 1), cA + hstep, voffA);
    if (wr == 1) PG8_BAR;
    PG8_WAIT_V(4); PG8_BAR;
    PG8_STAGE(PG8_SB(1, 0), cB + kstep, voffB); PG8_STAGE(PG8_SA(1, 0), cA + kstep, voffA); PG8_STAGE(PG8_SB(1, 1), cB + hstep + kstep, voffB);
    PG8_WAIT_V(6); PG8_BAR;
    for (;;) {
        const bool has_next = S.next(ui + 1, nxt);
        const char* nA = has_next ? (const char*)g.A + (size_t)nxt.pm * tstep : cA; const char* nB = has_next ? (const char*)g.Bt + (size_t)nxt.pb * tstep : cB;
#pragma unroll 1
        for (int t = 0; t < nt; t += 2) {
            const bool last = (t == nt - 2);
            const char* a1 = cA + (size_t)(t + 1) * kstep;
            const char* a2 = last ? nA : cA + (size_t)(t + 2) * kstep; const char* b2 = last ? nB : cB + (size_t)(t + 2) * kstep;
            const char* a3 = a2 + kstep; const char* b3 = b2 + kstep;
            if (last && has_next) S.a_ready(nxt);
            PG8_LDB(B0, 0, 0); PG8_SCHED; PG8_LDA(At, 0, 0); PG8_STAGE(PG8_SA(1, 1), a1 + hstep, voffA);
            PG8_WAIT_L(8); PG8_BAR; PG8_WAIT_L(0); PG8_MMA(0, 0, At, B0); PG8_BAR; PG8_SCHED;
            PG8_LDB(B1, 0, 1); PG8_STAGE(PG8_SB(0, 0), b2, voffB);
            PG8_BAR; PG8_WAIT_L(0); PG8_MMA(0, 1, At, B1); PG8_BAR;
            PG8_LDA(At, 0, 1); PG8_STAGE(PG8_SA(0, 0), a2, voffA);
            PG8_BAR; PG8_WAIT_L(0); PG8_MMA(1, 0, At, B0); PG8_BAR; PG8_SCHED;
            PG8_STAGE(PG8_SB(0, 1), b2 + hstep, voffB);
            PG8_WAIT_V(6); PG8_BAR; PG8_MMA(1, 1, At, B1); PG8_BAR;
            PG8_LDB(B0, 1, 0); PG8_SCHED; PG8_LDA(At, 1, 0); PG8_STAGE(PG8_SA(0, 1), a2 + hstep, voffA);
            PG8_WAIT_L(8); PG8_BAR; PG8_WAIT_L(0); PG8_MMA(0, 0, At, B0); PG8_BAR; PG8_SCHED;
            PG8_LDB(B1, 1, 1); PG8_STAGE(PG8_SB(1, 0), b3, voffB);
            PG8_BAR; PG8_WAIT_L(0); PG8_MMA(0, 1, At, B1); PG8_BAR;
            PG8_LDA(At, 1, 1); PG8_STAGE(PG8_SA(1, 0), a3, voffA);
            PG8_BAR; PG8_WAIT_L(0); PG8_MMA(1, 0, At, B0); PG8_BAR; PG8_SCHED;
            PG8_STAGE(PG8_SB(1, 1), b3 + hstep, voffB);
            PG8_WAIT_V(6); PG8_BAR; PG8_MMA(1, 1, At, B1); PG8_BAR;
        }
        if (FP8) asm volatile("s_nop 15\n\ts_nop 15" ::: "memory");
        if constexpr (!Epi::AFTER_DRAIN) { E(acc, cur, wr, wc, fr, fq); S.done(cur); }
        if (!has_next) break;
#pragma unroll
        for (int a = 0; a < 2; ++a)
#pragma unroll
            for (int b = 0; b < 2; ++b)
#pragma unroll
                for (int m = 0; m < 4; ++m)
#pragma unroll
                    for (int n = 0; n < 2; ++n) acc[a][b][m][n] = (f32x4){0.f, 0.f, 0.f, 0.f};
        cur = nxt; cA = nA; cB = nB; ++ui;
    }
    PG8_WAIT_V(0);
    if (wr == 0) PG8_BAR;
    PG8_BAR;
    if constexpr (Epi::AFTER_DRAIN) { E.fused(acc, cur, wr, wc, fr, fq, lds, wid, lane); S.done(cur); }
#undef PG8_SA
#undef PG8_SB
#undef PG8_STAGE
#undef PG8_LDA
#undef PG8_LDB
#undef PG8_MMA
#undef PG8_WAIT_V
#undef PG8_WAIT_L
#undef PG8_BAR
#undef PG8_SCHED
}

DI unsigned cvt_pk_bf16(float lo, float hi) { return cvt_pk(lo, hi); }
DI float fsig(float x) { return __builtin_amdgcn_rcpf(1.f + __builtin_amdgcn_exp2f(-1.4426950408889634f * x)); }
DI int expert_of_l(const LAS int* ps, int row0) { int e = 0;
#pragma unroll 1
    for (int i = 1; i < NE; ++i) if (row0 >= ps[i]) e = i; return e; }
struct OrderDense {
    int nM, nN, nwg, G, c;
    DI void init(int nM_, int nN_, int G_, int c_) { nM = nM_; nN = nN_; nwg = nM * nN; G = G_; c = c_; }
    DI bool tile(int i, Unit& u) const {
        const long L = (long)i * G + c; if (L >= nwg) return false;
        int wgid = (int)L; { const int q = nwg / NXCD, r = nwg % NXCD, xcd = wgid % NXCD, off = wgid / NXCD; wgid = (xcd < r ? xcd * (q + 1) : r * (q + 1) + (xcd - r) * q) + off; }
        const int nig = WGM * nN, gid = wgid / nig, fm = gid * WGM, gsz = (nM - fm) < WGM ? (nM - fm) : WGM;
        u.pm = fm + ((wgid % nig) % gsz); u.pn = (wgid % nig) / gsz; return true;
    }
    DI bool next(int i, Unit& u) const { if (!tile(i, u)) return false; u.pb = u.pn; u.e = 0; return true; }
    DI void a_ready(const Unit&) const {}
    DI void done(const Unit&) const {}
};
struct OrderGrouped : OrderDense {
    const LAS int* ps;
    DI bool next(int i, Unit& u) const { if (!tile(i, u)) return false; u.e = expert_of_l(ps, u.pm * BM); u.pb = u.e * nN + u.pn; return true; }
};
struct EpiStoreBf16 {
    static constexpr bool PERM = true, AFTER_DRAIN = false;
    bf16_t* O; int ldc; const float* bias; int bstride; float scale;
    DI void operator()(const f32x4 (&acc)[2][2][4][2], const Unit& u, int wr, int wc, int fr, int fq) const {
        const int row0 = u.pm * BM + wr * 64 + fr, col0 = u.pn * BM + wc * 32 + 8 * fq;
        f32x4 bv[2][2];
#pragma unroll
        for (int bj = 0; bj < 2; ++bj)
#pragma unroll
            for (int n = 0; n < 2; ++n) bv[bj][n] = bias ? *(const f32x4*)(bias + (size_t)u.e * bstride + col0 + bj * HALF + 4 * n) : (f32x4){0.f, 0.f, 0.f, 0.f};
#pragma unroll
        for (int ai = 0; ai < 2; ++ai)
#pragma unroll
            for (int m = 0; m < 4; ++m) { bf16_t* rowp = O + (size_t)(row0 + ai * HALF + m * 16) * ldc + col0;
#pragma unroll
                for (int bj = 0; bj < 2; ++bj) { const f32x4 v0 = acc[ai][bj][m][0] * scale + bv[bj][0], v1 = acc[ai][bj][m][1] * scale + bv[bj][1];
                    u32x4 w; w.x = cvt_pk_bf16(v0[0], v0[1]); w.y = cvt_pk_bf16(v0[2], v0[3]); w.z = cvt_pk_bf16(v1[0], v1[1]); w.w = cvt_pk_bf16(v1[2], v1[3]);
                    *(u32x4*)(rowp + bj * HALF) = w; } }
    }
};
template <int SECOND> struct EpiMerge {
    static constexpr bool PERM = true, AFTER_DRAIN = false;
    const bf16_t* gate; float* T; bf16_t* O;
    DI void operator()(const f32x4 (&acc)[2][2][4][2], const Unit& u, int wr, int wc, int fr, int fq) const {
        const int row0 = u.pm * BM + wr * 64 + fr, col0 = u.pn * BM + wc * 32 + 8 * fq;
#pragma unroll
        for (int ai = 0; ai < 2; ++ai)
#pragma unroll
            for (int mp = 0; mp < 2; ++mp) {
                u32x4 g[2][2]; f32x4 t0[2][2], t1[2][2];
#pragma unroll
                for (int mm = 0; mm < 2; ++mm)
#pragma unroll
                    for (int bj = 0; bj < 2; ++bj) { const size_t row = (size_t)(row0 + ai * HALF + (2 * mp + mm) * 16); const int col = col0 + bj * HALF;
                        g[mm][bj] = *(const u32x4*)(gate + row * NPJ + col);
                        if (SECOND) { t0[mm][bj] = *(const f32x4*)(T + row * DM + col); t1[mm][bj] = *(const f32x4*)(T + row * DM + col + 4); } }
#pragma unroll
                for (int mm = 0; mm < 2; ++mm)
#pragma unroll
                    for (int bj = 0; bj < 2; ++bj) { const int m = 2 * mp + mm; const size_t row = (size_t)(row0 + ai * HALF + m * 16); const int col = col0 + bj * HALF;
                        const u32x4 gg = g[mm][bj]; f32x4 v0 = acc[ai][bj][m][0], v1 = acc[ai][bj][m][1];
                        v0[0] *= fsig(__uint_as_float(gg.x << 16)); v0[1] *= fsig(__uint_as_float(gg.x & 0xffff0000u)); v0[2] *= fsig(__uint_as_float(gg.y << 16)); v0[3] *= fsig(__uint_as_float(gg.y & 0xffff0000u));
                        v1[0] *= fsig(__uint_as_float(gg.z << 16)); v1[1] *= fsig(__uint_as_float(gg.z & 0xffff0000u)); v1[2] *= fsig(__uint_as_float(gg.w << 16)); v1[3] *= fsig(__uint_as_float(gg.w & 0xffff0000u));
                        if (SECOND == 0) { float* tp = T + row * DM + col; *(f32x4*)tp = v0; *(f32x4*)(tp + 4) = v1; }
                        else { v0 += t0[mm][bj]; v1 += t1[mm][bj];
                            u32x4 w; w.x = cvt_pk_bf16(v0[0], v0[1]); w.y = cvt_pk_bf16(v0[2], v0[3]); w.z = cvt_pk_bf16(v1[0], v1[1]); w.w = cvt_pk_bf16(v1[2], v1[3]);
                            *(u32x4*)(O + row * DM + col) = w; } }
            }
    }
};
struct EpiResid {
    static constexpr bool PERM = false, AFTER_DRAIN = false;
    const float* x; const float* gt; float* X1;
    DI void operator()(const f32x4 (&acc)[2][2][4][2], const Unit& u, int wr, int wc, int fr, int fq) const {
        const int row0 = u.pm * BM + wr * 64 + fr, col0 = u.pn * BM + wc * 32 + 4 * fq;
        f32x4 gv[2][2];
#pragma unroll
        for (int bj = 0; bj < 2; ++bj)
#pragma unroll
            for (int n = 0; n < 2; ++n) gv[bj][n] = *(const f32x4*)(gt + col0 + bj * HALF + n * 16);
#pragma unroll
        for (int ai = 0; ai < 2; ++ai)
#pragma unroll
            for (int mp = 0; mp < 2; ++mp) {
                f32x4 xv[2][2][2];
#pragma unroll
                for (int mm = 0; mm < 2; ++mm)
#pragma unroll
                    for (int bj = 0; bj < 2; ++bj)
#pragma unroll
                        for (int n = 0; n < 2; ++n) xv[mm][bj][n] = *(const f32x4*)(x + (size_t)(row0 + ai * HALF + (2 * mp + mm) * 16) * DM + col0 + bj * HALF + n * 16);
#pragma unroll
                for (int mm = 0; mm < 2; ++mm)
#pragma unroll
                    for (int bj = 0; bj < 2; ++bj)
#pragma unroll
                        for (int n = 0; n < 2; ++n) *(f32x4*)(X1 + (size_t)(row0 + ai * HALF + (2 * mp + mm) * 16) * DM + col0 + bj * HALF + n * 16) = xv[mm][bj][n] + gv[bj][n] * acc[ai][bj][2 * mp + mm][n];
            }
    }
};
struct EpiSwiglu {
    static constexpr bool PERM = true, AFTER_DRAIN = false;
    unsigned char* ACT; const float* bgu;
    DI void operator()(const f32x4 (&acc)[2][2][4][2], const Unit& u, int wr, int wc, int fr, int fq) const {
        const int row0 = u.pm * BM + wr * 64 + fr, gcol = u.pn * HALF + wc * 32 + 8 * fq;
        const float* bb = bgu + (size_t)u.e * 2048 + gcol;
        f32x4 bg[2], bu[2];
#pragma unroll
        for (int n = 0; n < 2; ++n) { bg[n] = *(const f32x4*)(bb + 4 * n); bu[n] = *(const f32x4*)(bb + 1024 + 4 * n); }
#pragma unroll
        for (int ai = 0; ai < 2; ++ai)
#pragma unroll
            for (int m = 0; m < 4; ++m) { float r[8];
#pragma unroll
                for (int n = 0; n < 2; ++n)
#pragma unroll
                    for (int j = 0; j < 4; ++j) { float g = acc[ai][0][m][n][j] * (1.f / WSCALE) + bg[n][j], up = acc[ai][1][m][n][j] * (1.f / WSCALE) + bu[n][j];
                        g = fminf(g, 7.f); up = fminf(fmaxf(up, -7.f), 7.f);
                        r[4 * n + j] = ASCALE * (up + 1.f) * (g * fsig(1.702f * g)); }
                u32x2 w; w.x = cvt_f8x4(r[0], r[1], r[2], r[3]); w.y = cvt_f8x4(r[4], r[5], r[6], r[7]);
                *(u32x2*)(ACT + (size_t)(row0 + ai * HALF + m * 16) * DM + gcol) = w; }
    }
};
}


namespace fox {
typedef float f32x16 __attribute__((ext_vector_type(16)));
typedef short s16x4 __attribute__((ext_vector_type(4)));
constexpr float SCALE = 0.08838834764831845f;
constexpr int KVBLK = 64, SHM_K = 16384, SHM_V = 16384;
constexpr int OFF_V = 0, OFF_K = 2 * SHM_V, OFF_G = OFF_K + 2 * SHM_K, OFF_WS = OFF_G + 512, OFF_MISC = OFF_WS + 8 * 256;
constexpr float THR = 8.f;
#define KSWZ(row, colB) ((row) * 256 + ((colB) ^ (((row) & 7) << 4)))
#define SBAR() __builtin_amdgcn_sched_barrier(0)
DI int v_st(int k, int c) { const int kk = (k & ~0xC) | ((k & 4) << 1) | ((k & 8) >> 1); return ((kk >> 3) * 4 + (c >> 5)) * 512 + ((kk & 7) * 32 + (c & 31)) * 2; }
DI int v_rd_base(int lane) { return ((lane & 3) << 3) | (((lane >> 2) & 3) << 6) | (((lane >> 4) & 1) << 5) | (((lane >> 5) & 1) << 8); }
constexpr int v_rd_off(int d0, int ks, int half) { return d0 * 512 + ks * 4096 + half * 2048; }
DI int crow(int r, int hi) { return (r & 3) + 8 * (r >> 2) + 4 * hi; }
DI unsigned cvtpk(float lo, float hi) { return cvt_pk(lo, hi); }
DI void mask_tile(f32x16& p0, f32x16& p1, int dq) {
    const float NEG = -__builtin_inff();
#pragma unroll
    for (int r = 0; r < 16; ++r) { const int c = (r & 3) + 8 * (r >> 2); if (dq - c < 0) p0[r] = NEG; if (dq - c - 32 < 0) p1[r] = NEG; }
}
DI void partialSM(f32x16& p0, f32x16& p1, float& m_reg, float& mn, float& alpha) {
    float pmax = p0[0];
#pragma unroll
    for (int r = 1; r < 16; ++r) pmax = fmaxf(pmax, p0[r]);
#pragma unroll
    for (int r = 0; r < 16; ++r) pmax = fmaxf(pmax, p1[r]);
    { auto rr = __builtin_amdgcn_permlane32_swap(__float_as_uint(pmax), __float_as_uint(pmax), false, false); pmax = fmaxf(__uint_as_float(rr[0]), __uint_as_float(rr[1])); }
    constexpr float C2 = 1.4426950408889634f * SCALE;
    if (__builtin_expect(__all((pmax - m_reg) * SCALE <= THR), 1)) { mn = m_reg; alpha = 1.f; }
    else { mn = fmaxf(m_reg, pmax); alpha = __builtin_amdgcn_exp2f((m_reg - mn) * C2); m_reg = mn; }
    const float mnL = -mn * C2;
#pragma unroll
    for (int r = 0; r < 16; ++r) p0[r] = fmaf(p0[r], C2, mnL);
#pragma unroll
    for (int r = 0; r < 16; ++r) p1[r] = fmaf(p1[r], C2, mnL);
#pragma unroll
    for (int r = 0; r < 16; ++r) p0[r] = __builtin_amdgcn_exp2f(p0[r]);
}
DI void finishSM(f32x16& p0, f32x16& p1, float alpha, float& l_reg, bf16x8& pa0, bf16x8& pa1, bf16x8& pa2, bf16x8& pa3) {
#pragma unroll
    for (int r = 0; r < 16; ++r) p1[r] = __builtin_amdgcn_exp2f(p1[r]);
    float ps = 0;
#pragma unroll
    for (int r = 0; r < 16; ++r) ps += p0[r];
#pragma unroll
    for (int r = 0; r < 16; ++r) ps += p1[r];
    { auto rr = __builtin_amdgcn_permlane32_swap(__float_as_uint(ps), __float_as_uint(ps), false, false); ps = __uint_as_float(rr[0]) + __uint_as_float(rr[1]); }
    l_reg = l_reg * alpha + ps;
#define PK4(P, B_, OUT) do { unsigned a0 = cvtpk(P[B_+0], P[B_+1]), a1 = cvtpk(P[B_+2], P[B_+3]);                          \
        unsigned b0 = cvtpk(P[B_+4], P[B_+5]), b1 = cvtpk(P[B_+6], P[B_+7]);                                             \
        auto r0 = __builtin_amdgcn_permlane32_swap(a0, b0, false, false); auto r1 = __builtin_amdgcn_permlane32_swap(a1, b1, false, false); \
        u32x4 w = {r0[0], r1[0], r0[1], r1[1]}; OUT = *reinterpret_cast<bf16x8*>(&w); } while (0)
    PK4(p0, 0, pa0); PK4(p0, 8, pa1); PK4(p1, 0, pa2); PK4(p1, 8, pa3);
#undef PK4
}
DI void qkt(f32x16& p0, f32x16& p1, const char* Kb, int r32, int hi, const bf16x8* qr) {
    p0 = f32x16{}; p1 = f32x16{};
    const char* kb[4];
#pragma unroll
    for (int dd = 0; dd < 4; ++dd) kb[dd] = Kb + KSWZ(r32, (dd * 16 + hi * 8) * 2);
#pragma unroll
    for (int d0 = 0; d0 < 8; ++d0) { const char* a = kb[d0 & 3] + (d0 >> 2) * 128;
        bf16x8 b0 = *reinterpret_cast<const bf16x8*>(a);
        bf16x8 b1 = *reinterpret_cast<const bf16x8*>(a + 32 * 256);
        p0 = __builtin_amdgcn_mfma_f32_32x32x16_bf16(b0, qr[d0], p0, 0, 0, 0);
        p1 = __builtin_amdgcn_mfma_f32_32x32x16_bf16(b1, qr[d0], p1, 0, 0, 0); }
}
DI void pv_tile(f32x16* o, int vb0, bf16x8 pa0, bf16x8 pa1, bf16x8 pa2, bf16x8 pa3) {
#define TRRD(dst, off) asm volatile("ds_read_b64_tr_b16 %0, %1 offset:%2" : "=&v"(dst) : "v"(vb0), "i"(off) : "memory")
#define PV_D0(d0) do { s16x4 l0, l1, l2, l3, h0, h1, h2, h3; constexpr int b_ = v_rd_off(d0, 0, 0); \
        TRRD(l0, b_); TRRD(h0, b_ + 2048); TRRD(l1, b_ + 4096); TRRD(h1, b_ + 6144); TRRD(l2, b_ + 8192); TRRD(h2, b_ + 10240); TRRD(l3, b_ + 12288); TRRD(h3, b_ + 14336); \
        asm volatile("s_waitcnt lgkmcnt(0)" ::: "memory"); SBAR();   \
        o[d0] = __builtin_amdgcn_mfma_f32_32x32x16_bf16(pa0, (bf16x8){l0[0], l0[1], l0[2], l0[3], h0[0], h0[1], h0[2], h0[3]}, o[d0], 0, 0, 0);   \
        o[d0] = __builtin_amdgcn_mfma_f32_32x32x16_bf16(pa1, (bf16x8){l1[0], l1[1], l1[2], l1[3], h1[0], h1[1], h1[2], h1[3]}, o[d0], 0, 0, 0);   \
        o[d0] = __builtin_amdgcn_mfma_f32_32x32x16_bf16(pa2, (bf16x8){l2[0], l2[1], l2[2], l2[3], h2[0], h2[1], h2[2], h2[3]}, o[d0], 0, 0, 0);   \
        o[d0] = __builtin_amdgcn_mfma_f32_32x32x16_bf16(pa3, (bf16x8){l3[0], l3[1], l3[2], l3[3], h3[0], h3[1], h3[2], h3[3]}, o[d0], 0, 0, 0); } while (0)
    PV_D0(0); PV_D0(1); PV_D0(2); PV_D0(3);
#undef PV_D0
#undef TRRD
}
DI void fox_block(const Args& a, char* lds, int h, int P0, int j_lo) {
    const int tid = threadIdx.x, wid = __builtin_amdgcn_readfirstlane(tid >> 6), lane = tid & 63, r32 = lane & 31, hi = lane >> 5;
    const bf16_t* P = (const bf16_t*)(a.ws + WS_PROJ); const float* F = (const float*)(a.ws + WS_F) + (size_t)h * SEQ; bf16_t* OB = (bf16_t*)(a.ws + WS_OB);
    const bf16_t* Qp = P + PJ_FQ + h * 128; const bf16_t* Kp = P + PJ_FK + h * 128; const bf16_t* Vp = P + PJ_FV + h * 128;
    const int j_hi = (P0 + 255) / KVBLK + 1, NT = j_hi - j_lo;
    const int qlo = P0 + wid * 32, qm = qlo + r32 - 4 * hi;
    char* V_lds = lds + OFF_V; char* K_lds = lds + OFF_K; float* G_lds = (float*)(lds + OFF_G);
    float* wsp = (float*)(lds + OFF_WS) + wid * 64; float* li_l = wsp; float* al_l = wsp + 32;
    const int sr = tid >> 4;
    const int vb0 = (int)(unsigned)(uintptr_t)(LAS char*)V_lds + v_rd_base(lane);
    const float Fref = F[P0];
    bf16x8 qr[8];
#pragma unroll
    for (int d0 = 0; d0 < 8; ++d0) qr[d0] = *(const bf16x8*)(Qp + (size_t)(qlo + r32) * NPJ + d0 * 16 + hi * 8);
    float m_reg = -1e30f, l_reg = 0.f; f32x16 o[4] = {};
    float st_g = 0.f;
    const int ksrc = (((tid & 15) * 16) ^ ((sr & 7) << 4)) >> 1;
    const int vkk = (tid >> 7) * 8 + ((tid & 31) >> 2), vkey = (vkk & ~0xC) | ((vkk & 4) << 1) | ((vkk & 8) >> 1), vcol = ((tid >> 5) & 3) * 32 + (tid & 3) * 8;
    LAS unsigned char* ldsl = (LAS unsigned char*)lds;
#define FOX_LOAD(t, bf) do { const size_t k0_ = (size_t)(j_lo + (t)) * KVBLK; \
        __builtin_amdgcn_global_load_lds((const unsigned*)(Kp + (k0_ + sr) * NPJ + ksrc), (LAS unsigned*)(ldsl + OFF_K + (bf) * SHM_K + wid * 1024), 16, 0, 0); \
        __builtin_amdgcn_global_load_lds((const unsigned*)(Kp + (k0_ + 32 + sr) * NPJ + ksrc), (LAS unsigned*)(ldsl + OFF_K + (bf) * SHM_K + 8192 + wid * 1024), 16, 0, 0); \
        __builtin_amdgcn_global_load_lds((const unsigned*)(Vp + (k0_ + vkey) * NPJ + vcol), (LAS unsigned*)(ldsl + OFF_V + (bf) * SHM_V + wid * 1024), 16, 0, 0); \
        __builtin_amdgcn_global_load_lds((const unsigned*)(Vp + (k0_ + 32 + vkey) * NPJ + vcol), (LAS unsigned*)(ldsl + OFF_V + (bf) * SHM_V + 8192 + wid * 1024), 16, 0, 0); \
        if (tid < 64) st_g = F[k0_ + tid]; } while (0)
#define FOX_WRITE(bf) do { if (tid < 64) G_lds[(bf) * 64 + tid] = (st_g - Fref) * (1.f / SCALE); } while (0)
    FOX_LOAD(0, 0); asm volatile("s_waitcnt vmcnt(0)" ::: "memory"); FOX_WRITE(0);
    __syncthreads();
    for (int t = 0; t < NT; ++t) {
        const int bf = t & 1, kb_ = (j_lo + t) * KVBLK;
        if (t + 1 < NT) FOX_LOAD(t + 1, bf ^ 1);
        if (kb_ <= qlo + 31) {
            f32x16 p0, p1; float mn, al; bf16x8 pa0, pa1, pa2, pa3;
            qkt(p0, p1, K_lds + bf * SHM_K, r32, hi, qr);
            const float* gt = G_lds + bf * 64 + 4 * hi;
#pragma unroll
            for (int g4 = 0; g4 < 4; ++g4) { const f32x4 g0 = *(const f32x4*)(gt + 8 * g4), g1 = *(const f32x4*)(gt + 32 + 8 * g4);
#pragma unroll
                for (int i = 0; i < 4; ++i) { p0[4 * g4 + i] -= g0[i]; p1[4 * g4 + i] -= g1[i]; } }
            if (kb_ + KVBLK - 1 > qlo) mask_tile(p0, p1, qm - kb_);
            partialSM(p0, p1, m_reg, mn, al);
            finishSM(p0, p1, al, l_reg, pa0, pa1, pa2, pa3);
            if (__any(al < 1.f)) { if (hi == 0) al_l[r32] = al; asm volatile("s_waitcnt lgkmcnt(0)" ::: "memory");
#pragma unroll
                for (int d_ = 0; d_ < 4; ++d_)
#pragma unroll
                    for (int r = 0; r < 16; ++r) o[d_][r] *= al_l[crow(r, hi)]; }
            SBAR();
            pv_tile(o, vb0 + bf * SHM_V, pa0, pa1, pa2, pa3);
        }
        if (t + 1 < NT) { asm volatile("s_waitcnt vmcnt(0)" ::: "memory"); FOX_WRITE(bf ^ 1); }
        __syncthreads();
    }
#undef FOX_LOAD
#undef FOX_WRITE
    if (hi == 0) li_l[r32] = l_reg;
    asm volatile("s_waitcnt lgkmcnt(0)" ::: "memory");
    bf16_t* Ow = OB + (size_t)qlo * 512 + h * 128;
#pragma unroll
    for (int r = 0; r < 16; ++r) { const int orow = crow(r, hi); const float rl = __builtin_amdgcn_rcpf(li_l[orow]);
#pragma unroll
        for (int d0 = 0; d0 < 4; ++d0) { const float v = o[d0][r] * rl; const float vn = __shfl_xor(v, 1);
            if ((r32 & 1) == 0) *(unsigned*)(Ow + (size_t)orow * 512 + d0 * 32 + r32) = cvtpk(v, vn); } }
    __syncthreads();
}
#undef KSWZ
}

DI void transpose_tile(float* tile, const float* src, int ld, int k0, int c0, int c1, bf16_t* dst, int Kd) {
    const int tid = threadIdx.x, nn = tid & 63, k8 = tid >> 6; const int col = nn < 32 ? c0 + nn : c1 + nn - 32;
    const float* s = src + (size_t)(k0 + k8 * 8) * ld + col;
    float v[8];
#pragma unroll
    for (int i = 0; i < 8; ++i) v[i] = s[(size_t)i * ld];
    u32x4 w; w.x = cvt_pk(v[0], v[1]); w.y = cvt_pk(v[2], v[3]); w.z = cvt_pk(v[4], v[5]); w.w = cvt_pk(v[6], v[7]);
    *(u32x4*)(dst + (size_t)nn * Kd + k0 + k8 * 8) = w;
}
DI void transpose_quad(char* lds, int& par, const float* src, int ld, int k0, int c0, int c1, unsigned char* dst, int Kd) {
    const int tid = threadIdx.x, nn = tid & 63, k8 = tid >> 6; const int col = nn < 32 ? c0 + nn : c1 + nn - 32;
    const float* s = src + (size_t)(k0 + k8 * 8) * ld + col;
    float v[4][8];
#pragma unroll
    for (int kk = 0; kk < 4; ++kk)
#pragma unroll
        for (int i = 0; i < 8; ++i) v[kk][i] = s[(size_t)(kk * 64 + i) * ld];
    char* tile = lds + par * 17408; par ^= 1;
#pragma unroll
    for (int kk = 0; kk < 4; ++kk) { u32x2 w; w.x = cvt_f8x4(v[kk][0] * WSCALE, v[kk][1] * WSCALE, v[kk][2] * WSCALE, v[kk][3] * WSCALE); w.y = cvt_f8x4(v[kk][4] * WSCALE, v[kk][5] * WSCALE, v[kk][6] * WSCALE, v[kk][7] * WSCALE);
        *(u32x2*)(tile + nn * 272 + kk * 64 + k8 * 8) = w; }
    __syncthreads();
    const int rn = tid >> 3, ch = tid & 7;
#pragma unroll
    for (int q = 0; q < 2; ++q) *(u32x4*)(dst + (size_t)rn * Kd + k0 + (ch + 8 * q) * 16) = *(const u32x4*)(tile + rn * 272 + (ch + 8 * q) * 16);
}
constexpr int Q_WGU = 32 * 32 * 4, Q_WD = 32 * 16 * 4;
DI void conv_quad_gu(const Args& a, char* lds, int& par, int r) { const int e = r / 128, q = r % 128, nt = q / 4, kt = q % 4, n0 = nt * 64;
    transpose_quad(lds, par, a.in[I_WGU] + (size_t)e * DM * 2048, 2048, kt * 256, gu_src(n0), gu_src(n0 + 32), (unsigned char*)(a.ws + WS_WGUT) + ((size_t)e * 2048 + n0) * DM, DM); }
DI void conv_quad_d(const Args& a, char* lds, int& par, int r) { const int e = r / 64, q = r % 64, nt = q / 4, kt = q % 4, n0 = nt * 64;
    transpose_quad(lds, par, a.in[I_WD] + (size_t)e * DM * DM, DM, kt * 256, n0, n0 + 32, (unsigned char*)(a.ws + WS_WDT) + ((size_t)e * DM + n0) * DM, DM); }
constexpr int T_WIN = 88 * 16, T_WOA = 16 * 8, T_WOUT = 16 * 16, T_WGU = 32 * 32 * 16, T_WD = 32 * 16 * 16;
constexpr int T_SMALL = T_WIN + 2 * T_WOA + T_WOUT;
DI void conv_tile(const Args& a, float* lds, int t) {
    unsigned char* ws = a.ws; int r = t;
    if (r < T_WIN) { const int nt = r / 16, kt = r % 16, n0 = nt * 64; const int c0 = n0 + (n0 >= 3584 ? 12 : (n0 >= 2048 ? 8 : 0));
        transpose_tile(lds, a.in[I_WIN], NIN, kt * 64, c0, c0 + 32, (bf16_t*)(ws + WS_WINT) + (size_t)n0 * DM, DM); return; }
    r -= T_WIN;
    if (r < T_WOA) { const int nt = r / 8, kt = r % 8, n0 = nt * 64; transpose_tile(lds, a.in[I_WOD], DM, kt * 64, n0, n0 + 32, (bf16_t*)(ws + WS_WOAT) + (size_t)n0 * 512, 512); return; }
    r -= T_WOA;
    if (r < T_WOA) { const int nt = r / 8, kt = r % 8, n0 = nt * 64; transpose_tile(lds, a.in[I_WOF], DM, kt * 64, n0, n0 + 32, (bf16_t*)(ws + WS_WOBT) + (size_t)n0 * 512, 512); return; }
    r -= T_WOA;
    if (r < T_WOUT) { const int nt = r / 16, kt = r % 16, n0 = nt * 64; transpose_tile(lds, a.in[I_WOUT], DM, kt * 64, n0, n0 + 32, (bf16_t*)(ws + WS_WOUTT) + (size_t)n0 * DM, DM); return; }
    r -= T_WOUT;
    if (r < T_WGU) { const int e = r / 512, q = r % 512, nt = q / 16, kt = q % 16, n0 = nt * 64;
        transpose_tile(lds, a.in[I_WGU] + (size_t)e * DM * 2048, 2048, kt * 64, gu_src(n0), gu_src(n0 + 32), (bf16_t*)(ws + WS_WGUT) + ((size_t)e * 2048 + n0) * DM, DM); return; }
    r -= T_WGU;
    { const int e = r / 256, q = r % 256, nt = q / 16, kt = q % 16, n0 = nt * 64;
        transpose_tile(lds, a.in[I_WD] + (size_t)e * DM * DM, DM, kt * 64, n0, n0 + 32, (bf16_t*)(ws + WS_WDT) + ((size_t)e * DM + n0) * DM, DM); }
}
DI void ph0(const Args& a, float* lds) {
    const int tid = threadIdx.x, G = gridDim.x, bx = blockIdx.x;
    unsigned char* ws = a.ws;
    for (int grp = bx; grp < 256; grp += G) {
        const int col = tid % 24, ks = tid / 24, j = grp * 24 + col; const float* c = a.in[I_C]; const float* w = a.in[I_WADA];
        float acc = 0.f;
        if (ks < 21) { const int k1 = (ks * 49 + 49) < DM ? (ks * 49 + 49) : DM; for (int k = ks * 49; k < k1; ++k) acc += c[k] * w[(size_t)k * 6144 + j]; }
        __syncthreads();
        if (ks < 21) lds[ks * 24 + col] = acc;
        __syncthreads();
        if (tid < 24) { float s = a.in[I_BADA][grp * 24 + tid]; for (int q = 0; q < 21; ++q) s += lds[q * 24 + tid]; ((float*)(ws + WS_MOD))[grp * 24 + tid] = s; }
    }
    for (int t = bx; t < T_SMALL; t += G) conv_tile(a, lds, t);
}

DI void ph1(const Args& a, float* lds) {
    const int tid = threadIdx.x, lane = tid & 63, wave = tid >> 6, G = gridDim.x;
    float* A1 = lds; float* B1 = lds + 1024; float* wsm = lds + 2048;
    const float* mod = (const float*)(a.ws + WS_MOD);
    for (int k = tid; k < DM; k += NTHREADS) { A1[k] = a.in[I_G1][k] * (1.f + mod[1024 + k]); B1[k] = mod[k]; }
    for (int i = tid; i < 12 * DM; i += NTHREADS) { const int k = i / 12, j = i % 12; wsm[j * DM + k] = a.in[I_WIN][(size_t)k * NIN + (j < 8 ? 2048 + j : 3592 + (j - 8))]; }
    __syncthreads();
    bf16_t* H = (bf16_t*)(a.ws + WS_H); float* SP = (float*)(a.ws + WS_SP);
    for (int t0 = (blockIdx.x * NWAVES + wave) * 2; t0 < SEQ; t0 += G * NWAVES * 2) {
        f32x4 v[2][4]; float ss[2] = {0.f, 0.f};
#pragma unroll
        for (int q = 0; q < 2; ++q)
#pragma unroll
            for (int i = 0; i < 4; ++i) v[q][i] = *(const f32x4*)(a.in[I_X] + (size_t)(t0 + q) * DM + lane * 4 + 256 * i);
#pragma unroll
        for (int q = 0; q < 2; ++q)
#pragma unroll
            for (int i = 0; i < 4; ++i) ss[q] += v[q][i][0] * v[q][i][0] + v[q][i][1] * v[q][i][1] + v[q][i][2] * v[q][i][2] + v[q][i][3] * v[q][i][3];
        ss[0] = wave_sum(ss[0]); ss[1] = wave_sum(ss[1]);
#pragma unroll
        for (int q = 0; q < 2; ++q) { const float rstd = rsqrtf(ss[q] * (1.f / DM) + 1e-6f);
#pragma unroll
            for (int i = 0; i < 4; ++i) { const int k = lane * 4 + 256 * i;
#pragma unroll
                for (int e = 0; e < 4; ++e) v[q][i][e] = v[q][i][e] * rstd * A1[k + e] + B1[k + e];
                u32x2 w; w.x = cvt_pk(v[q][i][0], v[q][i][1]); w.y = cvt_pk(v[q][i][2], v[q][i][3]);
                *(u32x2*)(H + (size_t)(t0 + q) * DM + k) = w; } }
#pragma unroll 1
        for (int j = 0; j < 12; ++j) { float p0 = 0.f, p1 = 0.f;
#pragma unroll
            for (int i = 0; i < 4; ++i) { const f32x4 wv = *(const f32x4*)(wsm + j * DM + lane * 4 + 256 * i);
                p0 += v[0][i][0] * wv[0] + v[0][i][1] * wv[1] + v[0][i][2] * wv[2] + v[0][i][3] * wv[3];
                p1 += v[1][i][0] * wv[0] + v[1][i][1] * wv[1] + v[1][i][2] * wv[2] + v[1][i][3] * wv[3]; }
            p0 = wave_sum(p0); p1 = wave_sum(p1); if (lane == j) { SP[(size_t)t0 * 16 + j] = p0; SP[(size_t)(t0 + 1) * 16 + j] = p1;
                if (j >= 8) { float* LF = (float*)(a.ws + WS_LF) + (size_t)(j - 8) * SEQ; LF[t0] = p0; LF[t0 + 1] = p1; } } }
    }
}

DI void ph2(const Args& a, unsigned char* ldsb) {
    pg8::Gemm g{(const bf16_t*)(a.ws + WS_H), (const bf16_t*)(a.ws + WS_WINT), SEQ, NPJ, DM};
    pg8::OrderDense S; S.init(SEQ / 256, NPJ / 256, (int)gridDim.x, (int)blockIdx.x);
    pg8::EpiStoreBf16 E{(bf16_t*)(a.ws + WS_PROJ), NPJ, nullptr, 0, 1.f};
    pg8::gemm_phase<pg8::EpiStoreBf16, pg8::OrderDense>((LAS unsigned char*)ldsb, g, S, E);
}

DI void ph3_fcum(const Args& a, float* lds) {
    const int tid = threadIdx.x, lane = tid & 63, wave = tid >> 6, h = blockIdx.x;
    const float* LF = (const float*)(a.ws + WS_LF) + (size_t)h * SEQ + tid * 32; float* F = (float*)(a.ws + WS_F);
    const float bf = a.in[I_BFG][h];
    double* wtot = (double*)lds;
    float lf[32];
#pragma unroll
    for (int i = 0; i < 8; ++i) { const f32x4 x = *(const f32x4*)(LF + 4 * i); lf[4 * i] = x[0]; lf[4 * i + 1] = x[1]; lf[4 * i + 2] = x[2]; lf[4 * i + 3] = x[3]; }
    double s = 0.0;
#pragma unroll
    for (int i = 0; i < 32; ++i) { lf[i] = logsigf(lf[i] + bf); s += (double)lf[i]; }
    double inc = s;
#pragma unroll
    for (int o_ = 1; o_ < 64; o_ <<= 1) { const double y = __shfl_up(inc, o_); if (lane >= o_) inc += y; }
    __syncthreads();
    if (lane == 63) wtot[wave] = inc;
    __syncthreads();
    double off = inc - s;
    for (int w = 0; w < wave; ++w) off += wtot[w];
#pragma unroll
    for (int i = 0; i < 32; ++i) { off += (double)lf[i]; lf[i] = (float)off; }
#pragma unroll
    for (int i = 0; i < 8; ++i) *(f32x4*)(F + (size_t)h * SEQ + tid * 32 + 4 * i) = (f32x4){lf[4 * i], lf[4 * i + 1], lf[4 * i + 2], lf[4 * i + 3]};
    __syncthreads();
}
namespace prep {
constexpr int QS = 0, KS = 17408, KT = 34816, VT = 53248, UNIT = 71680, SM = 2 * UNIT;
DI bf16x8 ld8(const char* p) { return *(const bf16x8*)p; }
template <int C, int M4> struct TRow { static DI void run(const float (&T)[64], const float* Ls, float& a0, float& a1) {
    if constexpr (4 * M4 < C) { const f32x4 Lv = *(const f32x4*)(Ls + C * 68 + 4 * M4);
        a0 -= Lv[0] * T[4 * M4]; if constexpr (4 * M4 + 1 < C) a1 -= Lv[1] * T[4 * M4 + 1]; if constexpr (4 * M4 + 2 < C) a0 -= Lv[2] * T[4 * M4 + 2]; if constexpr (4 * M4 + 3 < C) a1 -= Lv[3] * T[4 * M4 + 3];
        TRow<C, M4 + 1>::run(T, Ls, a0, a1); } } };
template <int C> struct TRow<C, 16> { static DI void run(const float (&)[64], const float*, float&, float&) {} };
template <int C> DI void tsolve(float (&T)[64], const float* Ls, int lane) {
    if constexpr (C < 64) { float a0 = (lane == C) ? 1.f : 0.f, a1 = 0.f; TRow<C, 0>::run(T, Ls, a0, a1); T[C] = a0 + a1; asm volatile("" ::: "memory"); __builtin_amdgcn_sched_barrier(0); tsolve<C + 1>(T, Ls, lane); } }
}
DI void ph3_prep2(const Args& a, char* lds, int pair) {
    using namespace prep;
    const int tid = threadIdx.x, lane = tid & 63, wave = tid >> 6, grp = wave >> 2, wq = wave & 3, tg = tid & 255, lr = lane & 15, lq = lane >> 4;
    int unit = pair * 2 + grp; if (unit >= NH * NCH) unit = NH * NCH - 1;
    const int h = unit & 3, n = unit >> 2, t0 = n * CH;
    char* U = lds + grp * UNIT;
    float* gcs = (float*)(lds + SM) + grp * 192; float* bes = gcs + 64; float* egs = gcs + 128;
    const float* SP = (const float*)(a.ws + WS_SP); const bf16_t* P = (const bf16_t*)(a.ws + WS_PROJ);
    const size_t cb = (size_t)(h * NCH + n);
    bf16_t* WF = (bf16_t*)(a.ws + WS_DNW) + cb * 8192; bf16_t* UF = (bf16_t*)(a.ws + WS_DNU) + cb * 8192;
    bf16_t* QF = (bf16_t*)(a.ws + WS_DNQD) + cb * 8192; bf16_t* KF = (bf16_t*)(a.ws + WS_DNKD) + cb * 8192; bf16_t* AF = (bf16_t*)(a.ws + WS_DNATT) + cb * 4096;
    __syncthreads();
    if (wq == 0) { const int t = t0 + lane;
        const float be = sigm(SP[(size_t)t * 16 + h]);
        float g = -expf(a.in[I_ALOG][h]) * softplusf(SP[(size_t)t * 16 + 4 + h] + a.in[I_DTB][h]);
#pragma unroll
        for (int o_ = 1; o_ < 64; o_ <<= 1) { const float y = __shfl_up(g, o_); if (lane >= o_) g += y; }
        gcs[lane] = g; bes[lane] = be; egs[lane] = expf(g); }
    __syncthreads();
    { const int d8 = tg & 15, ci = tg >> 4; const float* cw = a.in[I_CONVW];
#pragma unroll 1
        for (int sec = 0; sec < 3; ++sec) {
            const int col = sec * 512 + h * 128 + d8 * 8;
            f32x4 w[4][2];
#pragma unroll
            for (int j = 0; j < 4; ++j) { w[j][0] = *(const f32x4*)(cw + j * 1536 + col); w[j][1] = *(const f32x4*)(cw + j * 1536 + col + 4); }
#pragma unroll 1
          for (int ih = 0; ih < 2; ++ih) {
            u32x4 xin[2][4];
#pragma unroll
            for (int i = 0; i < 2; ++i)
#pragma unroll
                for (int j = 0; j < 4; ++j) { int tt = t0 + ci + 16 * (2 * ih + i) - 3 + j; tt = tt < 0 ? 0 : tt; xin[i][j] = *(const u32x4*)(P + (size_t)tt * NPJ + col); }
#pragma unroll
            for (int i = 0; i < 2; ++i) { const int c = ci + 16 * (2 * ih + i), t = t0 + c;
                float v[8];
#pragma unroll
                for (int e = 0; e < 8; ++e) v[e] = 0.f;
#pragma unroll
                for (int j = 0; j < 4; ++j) { const float ok = (t - 3 + j >= 0) ? 1.f : 0.f; const u32x4 x = xin[i][j];
                    v[0] += ok * w[j][0][0] * __uint_as_float(x.x << 16); v[1] += ok * w[j][0][1] * __uint_as_float(x.x & 0xffff0000u); v[2] += ok * w[j][0][2] * __uint_as_float(x.y << 16); v[3] += ok * w[j][0][3] * __uint_as_float(x.y & 0xffff0000u);
                    v[4] += ok * w[j][1][0] * __uint_as_float(x.z << 16); v[5] += ok * w[j][1][1] * __uint_as_float(x.z & 0xffff0000u); v[6] += ok * w[j][1][2] * __uint_as_float(x.w << 16); v[7] += ok * w[j][1][3] * __uint_as_float(x.w & 0xffff0000u); }
                float ss = 0.f;
#pragma unroll
                for (int e = 0; e < 8; ++e) { v[e] = siluf(v[e]); ss += v[e] * v[e]; }
                if (sec < 2) { ss += __shfl_xor(ss, 1); ss += __shfl_xor(ss, 2); ss += __shfl_xor(ss, 4); ss += __shfl_xor(ss, 8);
                    const float sc = rsqrtf(ss + 1e-6f) * (sec == 0 ? 0.08838834764831845f : 1.f);
#pragma unroll
                    for (int e = 0; e < 8; ++e) v[e] *= sc; }
                u32x4 pk; pk.x = cvt_pk(v[0], v[1]); pk.y = cvt_pk(v[2], v[3]); pk.z = cvt_pk(v[4], v[5]); pk.w = cvt_pk(v[6], v[7]);
                if (sec == 0) { *(u32x4*)(U + QS + c * 272 + d8 * 16) = pk;
                    const float eg = egs[c];
                    const int base = (((c >> 4) * 4 + (d8 >> 2)) * 64 + (c & 15)) * 8 + 4 * ((d8 & 3) >> 1), l0 = (2 * (d8 & 3)) & 3;
                    u32x2 q0, q1; q0.x = cvt_pk(v[0] * eg, v[1] * eg); q0.y = cvt_pk(v[2] * eg, v[3] * eg); q1.x = cvt_pk(v[4] * eg, v[5] * eg); q1.y = cvt_pk(v[6] * eg, v[7] * eg);
                    *(u32x2*)(QF + base + l0 * 128) = q0; *(u32x2*)(QF + base + (l0 + 1) * 128) = q1; }
                else { if (sec == 1) *(u32x4*)(U + KS + c * 272 + d8 * 16) = pk;
                    bf16_t* T_ = (bf16_t*)(U + (sec == 1 ? KT : VT)) + (d8 * 8) * 72 + c;
                    T_[0 * 72] = (bf16_t)(pk.x & 0xffffu); T_[1 * 72] = (bf16_t)(pk.x >> 16); T_[2 * 72] = (bf16_t)(pk.y & 0xffffu); T_[3 * 72] = (bf16_t)(pk.y >> 16);
                    T_[4 * 72] = (bf16_t)(pk.z & 0xffffu); T_[5 * 72] = (bf16_t)(pk.z >> 16); T_[6 * 72] = (bf16_t)(pk.w & 0xffffu); T_[7 * 72] = (bf16_t)(pk.w >> 16); }
            }
          }
        }
    }
    __syncthreads();
    f32x4 Lr[4];
    { const int mt = wq;
#pragma unroll
        for (int nt = 0; nt < 4; ++nt) { Lr[nt] = (f32x4){0.f, 0.f, 0.f, 0.f};
            if (nt <= mt) {
#pragma unroll
                for (int s = 0; s < 4; ++s) Lr[nt] = MFMA16(ld8(U + KS + (16 * mt + lr) * 272 + (32 * s + 8 * lq) * 2), ld8(U + KS + (16 * nt + lr) * 272 + (32 * s + 8 * lq) * 2), Lr[nt]); } }
        const int ntq = 3 - wq; const float gcc = gcs[16 * ntq + lr];
#pragma unroll
        for (int mtk = 0; mtk < 4; ++mtk) { f32x4 acc = (f32x4){0.f, 0.f, 0.f, 0.f};
            if (mtk <= ntq) {
#pragma unroll
                for (int s = 0; s < 4; ++s) acc = MFMA16(ld8(U + KS + (16 * mtk + lr) * 272 + (32 * s + 8 * lq) * 2), ld8(U + QS + (16 * ntq + lr) * 272 + (32 * s + 8 * lq) * 2), acc);
#pragma unroll
                for (int r = 0; r < 4; ++r) { const int m = 16 * mtk + 4 * lq + r, c = 16 * ntq + lr; acc[r] = (m <= c) ? acc[r] * expf(gcc - gcs[m]) : 0.f; } }
            u32x2 o_; o_.x = cvt_pk(acc[0], acc[1]); o_.y = cvt_pk(acc[2], acc[3]);
            *(u32x2*)(AF + ((ntq * 2 + (mtk >> 1)) * 64 + lane) * 8 + 4 * (mtk & 1)) = o_; }
    }
    __syncthreads();
    { const int mt = wq; float* LT = (float*)(U + QS);
#pragma unroll
        for (int nt = 0; nt < 4; ++nt) if (nt <= mt) { const int m = 16 * nt + lr; f32x4 o_;
#pragma unroll
            for (int r = 0; r < 4; ++r) { const int c = 16 * mt + 4 * lq + r; o_[r] = (m < c) ? bes[c] * Lr[nt][r] * expf(gcs[c] - gcs[m]) : 0.f; }
            *(f32x4*)(LT + m * 68 + 16 * mt + 4 * lq) = o_; } }
    __syncthreads();
    if (wq == 0) { const float* LT = (const float*)(U + QS); float* Tl = (float*)(U + KS);
#pragma unroll
        for (int ib = 0; ib < 4; ++ib) { float acc[16];
#pragma unroll
            for (int r = 0; r < 16; ++r) acc[r] = (lane == 16 * ib + r) ? 1.f : 0.f;
#pragma unroll 2
            for (int m = 0; m < 16 * ib; ++m) { const float t = Tl[m * 68 + lane];
#pragma unroll
                for (int q = 0; q < 4; ++q) { const f32x4 Lv = *(const f32x4*)(LT + m * 68 + 16 * ib + 4 * q);
#pragma unroll
                    for (int e = 0; e < 4; ++e) acc[4 * q + e] -= Lv[e] * t; } }
#pragma unroll
            for (int p = 0; p < 16; ++p) { const float t = acc[p]; Tl[(16 * ib + p) * 68 + lane] = t;
                if (p < 15) {
#pragma unroll
                    for (int q = 0; q < 4; ++q) if (4 * q + 3 > p) { const f32x4 Lv = *(const f32x4*)(LT + (16 * ib + p) * 68 + 16 * ib + 4 * q);
#pragma unroll
                        for (int e = 0; e < 4; ++e) if (4 * q + e > p) acc[4 * q + e] -= Lv[e] * t; } } }
            asm volatile("s_waitcnt lgkmcnt(0)" ::: "memory"); }
        if (lane == 0) ((float*)(a.ws + WS_EG))[cb] = egs[63];
    } else { const float gl = gcs[63];
        for (int i = tg - 64; i < 2048; i += 192) { const int dk = i >> 4, cq = i & 15;
            const u32x2 x = *(const u32x2*)(U + KT + dk * 144 + cq * 8);
            const float e0 = expf(gl - gcs[4 * cq]), e1 = expf(gl - gcs[4 * cq + 1]), e2 = expf(gl - gcs[4 * cq + 2]), e3 = expf(gl - gcs[4 * cq + 3]);
            u32x2 o_; o_.x = cvt_pk(__uint_as_float(x.x << 16) * e0, __uint_as_float(x.x & 0xffff0000u) * e1); o_.y = cvt_pk(__uint_as_float(x.y << 16) * e2, __uint_as_float(x.y & 0xffff0000u) * e3);
            *(u32x2*)(KF + (((dk >> 4) * 2 + (cq >> 3)) * 64 + (cq & 3) * 16 + (dk & 15)) * 8 + 4 * ((cq >> 2) & 1)) = o_; } }
    __syncthreads();
    { const float* Tl = (const float*)(U + KS); const int c = tg >> 2, m0 = (tg & 3) * 16;
        f32x4 tv[4];
#pragma unroll
        for (int q = 0; q < 4; ++q) tv[q] = *(const f32x4*)(Tl + c * 68 + m0 + 4 * q);
        __syncthreads();
        bf16_t* Tb = (bf16_t*)(U + QS); bf16_t* Tg = (bf16_t*)(U + KS);
#pragma unroll
        for (int q = 0; q < 4; ++q) { u32x2 b_, g_; float be[4], bg[4];
#pragma unroll
            for (int e = 0; e < 4; ++e) { const int m = m0 + 4 * q + e; be[e] = tv[q][e] * bes[m]; bg[e] = be[e] * egs[m]; }
            b_.x = cvt_pk(be[0], be[1]); b_.y = cvt_pk(be[2], be[3]); g_.x = cvt_pk(bg[0], bg[1]); g_.y = cvt_pk(bg[2], bg[3]);
            *(u32x2*)(Tb + c * 72 + m0 + 4 * q) = b_; *(u32x2*)(Tg + c * 72 + m0 + 4 * q) = g_; } }
    __syncthreads();
    {
#pragma unroll
        for (int q = 0; q < 2; ++q) { const int nt = 2 * wq + q;
#pragma unroll
            for (int mt = 0; mt < 4; ++mt) { f32x4 acc = (f32x4){0.f, 0.f, 0.f, 0.f};
#pragma unroll
                for (int s = 0; s < 2; ++s) acc = MFMA16(ld8(U + QS + (16 * mt + lr) * 144 + (32 * s + 8 * lq) * 2), ld8(U + VT + (16 * nt + lr) * 144 + (32 * s + 8 * lq) * 2), acc);
                u32x2 o_; o_.x = cvt_pk(acc[0], acc[1]); o_.y = cvt_pk(acc[2], acc[3]);
                *(u32x2*)(UF + ((nt * 4 + mt) * 64 + lane) * 4) = o_; } }
#pragma unroll
        for (int q = 0; q < 2; ++q) { const int mtk = 2 * wq + q;
#pragma unroll
            for (int ntc = 0; ntc < 4; ++ntc) { f32x4 acc = (f32x4){0.f, 0.f, 0.f, 0.f};
#pragma unroll
                for (int s = 0; s < 2; ++s) acc = MFMA16(ld8(U + KT + (16 * mtk + lr) * 144 + (32 * s + 8 * lq) * 2), ld8(U + KS + (16 * ntc + lr) * 144 + (32 * s + 8 * lq) * 2), acc);
                u32x2 o_; o_.x = cvt_pk(-acc[0], -acc[1]); o_.y = cvt_pk(-acc[2], -acc[3]);
                *(u32x2*)(WF + ((ntc * 4 + (mtk >> 1)) * 64 + lane) * 8 + 4 * (mtk & 1)) = o_; } }
    }
}
DI void ph3_norms(const Args& a, float* lds) {
    const int lane = threadIdx.x & 63, wave = threadIdx.x >> 6, NW = gridDim.x * NWAVES, sub = lane >> 4, l16 = lane & 15;
    const bf16_t* P = (const bf16_t*)(a.ws + WS_PROJ); float* TB = (float*)(a.ws + WS_NRMT);
    for (int grp = blockIdx.x * NWAVES + wave; grp < SEQ / 8; grp += NW) {
        float mq[4] = {0.f, 0.f, 0.f, 0.f}, mk[4] = {0.f, 0.f, 0.f, 0.f}, md[4] = {3.0e38f, 3.0e38f, 3.0e38f, 3.0e38f};
#pragma unroll
        for (int it = 0; it < 2; ++it) { const bf16_t* row = P + (size_t)(grp * 8 + it * 4 + sub) * NPJ + l16 * 8;
            u32x4 xq[4], xk[4];
#pragma unroll
            for (int h = 0; h < 4; ++h) { xq[h] = *(const u32x4*)(row + PJ_FQ + h * 128); xk[h] = *(const u32x4*)(row + PJ_FK + h * 128); }
#pragma unroll
            for (int h = 0; h < 4; ++h) { float sq = 0.f, sk = 0.f, sd = 0.f;
#pragma unroll
                for (int e = 0; e < 4; ++e) { const float a0 = __uint_as_float(xq[h][e] << 16), a1 = __uint_as_float(xq[h][e] & 0xffff0000u), b0 = __uint_as_float(xk[h][e] << 16), b1 = __uint_as_float(xk[h][e] & 0xffff0000u);
                    sq += a0 * a0 + a1 * a1; sk += b0 * b0 + b1 * b1; sd += a0 * b0 + a1 * b1; }
#pragma unroll
                for (int o_ = 1; o_ <= 8; o_ <<= 1) { sq += __shfl_xor(sq, o_); sk += __shfl_xor(sk, o_); sd += __shfl_xor(sd, o_); }
                mq[h] = fmaxf(mq[h], sq); mk[h] = fmaxf(mk[h], sk); md[h] = fminf(md[h], sd); } }
#pragma unroll
        for (int h = 0; h < 4; ++h) { mq[h] = fmaxf(mq[h], __shfl_xor(mq[h], 16)); mq[h] = fmaxf(mq[h], __shfl_xor(mq[h], 32)); mk[h] = fmaxf(mk[h], __shfl_xor(mk[h], 16)); mk[h] = fmaxf(mk[h], __shfl_xor(mk[h], 32));
            md[h] = fminf(md[h], __shfl_xor(md[h], 16)); md[h] = fminf(md[h], __shfl_xor(md[h], 32));
            if (lane == 0) { TB[grp * 12 + h] = mq[h]; TB[grp * 12 + 4 + h] = mk[h]; TB[grp * 12 + 8 + h] = md[h]; } }
    }
}
DI void ph3(const Args& a, float* lds) {
    const int G = gridDim.x;
    if (blockIdx.x < 4) ph3_fcum(a, lds);
    for (int p = blockIdx.x; p < NH * NCH / 2; p += G) ph3_prep2(a, (char*)lds, p);
    ph3_norms(a, lds);
}

namespace dn {
DI unsigned cvtpk(float lo, float hi) { return cvt_pk(lo, hi); }
DI bf16x8 packB(const f32x4& t0, const f32x4& t1) { u32x4 w = {cvtpk(t0[0], t0[1]), cvtpk(t0[2], t0[3]), cvtpk(t1[0], t1[1]), cvtpk(t1[2], t1[3])}; return *reinterpret_cast<bf16x8*>(&w); }
DI bf16x8 frag(const bf16_t* base, int f, int lane) { return *(const bf16x8*)(base + ((size_t)f * 64 + lane) * 8); }
template <bool WITH_U, bool WITH_O>
DI void step(const bf16_t* WFn, const bf16_t* KFn, const bf16_t* QFn, const bf16_t* AFn, const bf16_t* UFs, float eg, f32x4 (&S)[8], f32x4 (&o)[4], int lane) {
    bf16x8 sb[4];
#pragma unroll
    for (int s = 0; s < 4; ++s) sb[s] = packB(S[2 * s], S[2 * s + 1]);
    f32x4 vn[4];
#pragma unroll
    for (int mt = 0; mt < 4; ++mt) {
        if (WITH_U) { const u32x2 w = *(const u32x2*)(UFs + ((size_t)mt * 64 + lane) * 4); vn[mt] = (f32x4){__uint_as_float(w.x << 16), __uint_as_float(w.x & 0xffff0000u), __uint_as_float(w.y << 16), __uint_as_float(w.y & 0xffff0000u)}; }
        else vn[mt] = (f32x4){0.f, 0.f, 0.f, 0.f};
#pragma unroll
        for (int s = 0; s < 4; ++s) vn[mt] = MFMA16(frag(WFn, mt * 4 + s, lane), sb[s], vn[mt]); }
    if (WITH_O) {
#pragma unroll
        for (int mt = 0; mt < 4; ++mt) { o[mt] = (f32x4){0.f, 0.f, 0.f, 0.f};
#pragma unroll
            for (int s = 0; s < 4; ++s) o[mt] = MFMA16(frag(QFn, mt * 4 + s, lane), sb[s], o[mt]); } }
    bf16x8 vb[2];
#pragma unroll
    for (int s = 0; s < 2; ++s) vb[s] = packB(vn[2 * s], vn[2 * s + 1]);
    if (WITH_O) {
#pragma unroll
        for (int mt = 0; mt < 4; ++mt)
#pragma unroll
            for (int s = 0; s < 2; ++s) o[mt] = MFMA16(frag(AFn, mt * 2 + s, lane), vb[s], o[mt]); }
#pragma unroll
    for (int mt = 0; mt < 8; ++mt) { S[mt] = S[mt] * eg;
#pragma unroll
        for (int s = 0; s < 2; ++s) S[mt] = MFMA16(frag(KFn, mt * 2 + s, lane), vb[s], S[mt]); }
}
}
constexpr int NGRP = 16, GRP = 16;
constexpr int NSCAN = NH * NGRP;
constexpr int SBUF = 57344;
template <int N> struct Stage { u32x4 r[N]; };
DI void stage_load2(Stage<4>& st, const bf16_t* s0, const bf16_t* s1) {
    const int tid = threadIdx.x;
    st.r[0] = *(const u32x4*)(s0 + (size_t)tid * 8); st.r[1] = *(const u32x4*)(s0 + (size_t)(tid + 512) * 8);
    st.r[2] = *(const u32x4*)(s1 + (size_t)tid * 8); st.r[3] = *(const u32x4*)(s1 + (size_t)(tid + 512) * 8);
}
DI void stage_write2(const Stage<4>& st, char* buf) {
    const int tid = threadIdx.x;
    *(u32x4*)(buf + tid * 16) = st.r[0]; *(u32x4*)(buf + (tid + 512) * 16) = st.r[1];
    *(u32x4*)(buf + 16384 + tid * 16) = st.r[2]; *(u32x4*)(buf + 16384 + (tid + 512) * 16) = st.r[3];
}
DI void stage_load4(Stage<7>& st, const bf16_t* s0, const bf16_t* s1, const bf16_t* s2, const bf16_t* s3) {
    const int tid = threadIdx.x;
    st.r[0] = *(const u32x4*)(s0 + (size_t)tid * 8); st.r[1] = *(const u32x4*)(s0 + (size_t)(tid + 512) * 8);
    st.r[2] = *(const u32x4*)(s1 + (size_t)tid * 8); st.r[3] = *(const u32x4*)(s1 + (size_t)(tid + 512) * 8);
    st.r[4] = *(const u32x4*)(s2 + (size_t)tid * 8); st.r[5] = *(const u32x4*)(s2 + (size_t)(tid + 512) * 8);
    st.r[6] = *(const u32x4*)(s3 + (size_t)tid * 8);
}
DI void stage_write4(const Stage<7>& st, char* buf) {
    const int tid = threadIdx.x;
    *(u32x4*)(buf + tid * 16) = st.r[0]; *(u32x4*)(buf + (tid + 512) * 16) = st.r[1];
    *(u32x4*)(buf + 16384 + tid * 16) = st.r[2]; *(u32x4*)(buf + 16384 + (tid + 512) * 16) = st.r[3];
    *(u32x4*)(buf + 32768 + tid * 16) = st.r[4]; *(u32x4*)(buf + 32768 + (tid + 512) * 16) = st.r[5];
    *(u32x4*)(buf + 49152 + tid * 16) = st.r[6];
}
DI f32x4 u_unpack(const u32x2 w) { return (f32x4){__uint_as_float(w.x << 16), __uint_as_float(w.x & 0xffff0000u), __uint_as_float(w.y << 16), __uint_as_float(w.y & 0xffff0000u)}; }
DI void scanA_chain(const Args& a, char* lds, int chain) {
    const int tid = threadIdx.x, lane = tid & 63, vs = tid >> 6, lr = lane & 15, lq = lane >> 4;
    const int h = chain >> 4, g = chain & 15;
    f32x4 SQ[8], SP[8];
#pragma unroll
    for (int mt = 0; mt < 8; ++mt) { SQ[mt] = (f32x4){0.f, 0.f, 0.f, 0.f};
#pragma unroll
        for (int r = 0; r < 4; ++r) SP[mt][r] = (16 * mt + 4 * lq + r == 16 * vs + lr) ? 1.f : 0.f; }
    const size_t cb0 = (size_t)(h * NCH + g * GRP);
    const bf16_t* WF = (const bf16_t*)(a.ws + WS_DNW) + cb0 * 8192; const bf16_t* KF = (const bf16_t*)(a.ws + WS_DNKD) + cb0 * 8192;
    const bf16_t* UF = (const bf16_t*)(a.ws + WS_DNU) + cb0 * 8192 + (size_t)vs * 1024; const float* EG = (const float*)(a.ws + WS_EG) + cb0;
    Stage<4> st; u32x2 ucur[4], unxt[4];
    __syncthreads();
    stage_load2(st, WF, KF);
#pragma unroll
    for (int mt = 0; mt < 4; ++mt) ucur[mt] = *(const u32x2*)(UF + ((size_t)mt * 64 + lane) * 4);
    asm volatile("s_waitcnt vmcnt(0)" ::: "memory");
    stage_write2(st, lds);
    __syncthreads();
    for (int i = 0; i < GRP; ++i) {
        const char* buf = lds + (i & 1) * SBUF;
        if (i + 1 < GRP) { stage_load2(st, WF + (size_t)(i + 1) * 8192, KF + (size_t)(i + 1) * 8192);
#pragma unroll
            for (int mt = 0; mt < 4; ++mt) unxt[mt] = *(const u32x2*)(UF + (size_t)(i + 1) * 8192 + ((size_t)mt * 64 + lane) * 4); }
        const float eg = EG[i];
        const bf16_t* Wl = (const bf16_t*)buf; const bf16_t* Kl = (const bf16_t*)(buf + 16384);
        bf16x8 sbq[4], sbp[4];
#pragma unroll
        for (int s = 0; s < 4; ++s) { sbq[s] = dn::packB(SQ[2 * s], SQ[2 * s + 1]); sbp[s] = dn::packB(SP[2 * s], SP[2 * s + 1]); }
        f32x4 vq[4], vp[4];
#pragma unroll
        for (int mt = 0; mt < 4; ++mt) { vq[mt] = u_unpack(ucur[mt]); vp[mt] = (f32x4){0.f, 0.f, 0.f, 0.f};
#pragma unroll
            for (int s = 0; s < 4; ++s) { const bf16x8 f = dn::frag(Wl, mt * 4 + s, lane); vq[mt] = MFMA16(f, sbq[s], vq[mt]); vp[mt] = MFMA16(f, sbp[s], vp[mt]); } }
        bf16x8 vbq[2], vbp[2];
#pragma unroll
        for (int s = 0; s < 2; ++s) { vbq[s] = dn::packB(vq[2 * s], vq[2 * s + 1]); vbp[s] = dn::packB(vp[2 * s], vp[2 * s + 1]); }
#pragma unroll
        for (int mt = 0; mt < 8; ++mt) { SQ[mt] = SQ[mt] * eg; SP[mt] = SP[mt] * eg;
#pragma unroll
            for (int s = 0; s < 2; ++s) { const bf16x8 f = dn::frag(Kl, mt * 2 + s, lane); SQ[mt] = MFMA16(f, vbq[s], SQ[mt]); SP[mt] = MFMA16(f, vbp[s], SP[mt]); } }
        if (i + 1 < GRP) { asm volatile("s_waitcnt vmcnt(0)" ::: "memory"); stage_write2(st, lds + ((i + 1) & 1) * SBUF);
#pragma unroll
            for (int mt = 0; mt < 4; ++mt) ucur[mt] = unxt[mt]; }
        __syncthreads();
    }
    bf16_t* PG = (bf16_t*)(a.ws + WS_PG) + (size_t)chain * 16384;
#pragma unroll
    for (int mt = 0; mt < 8; ++mt)
#pragma unroll
        for (int r = 0; r < 4; ++r) PG[((mt * 4 + (vs >> 1)) * 64 + (lr >> 2) * 16 + 4 * lq + r) * 8 + 4 * (vs & 1) + (lr & 3)] = f2bf(SP[mt][r]);
    float* QG = (float*)(a.ws + WS_QG) + ((size_t)chain * 8 + vs) * 2048;
#pragma unroll
    for (int mt = 0; mt < 8; ++mt) *(f32x4*)(QG + ((size_t)mt * 64 + lane) * 4) = SQ[mt];
}
DI void scanPC_chain(const Args& a, char* lds, int chain) {
    const int tid = threadIdx.x, lane = tid & 63, vs = tid >> 6, lr = lane & 15, lq = lane >> 4;
    const int h = chain >> 4, g = chain & 15;
    f32x4 S[8];
#pragma unroll
    for (int mt = 0; mt < 8; ++mt) S[mt] = (f32x4){0.f, 0.f, 0.f, 0.f};
    __syncthreads();
    if (g > 0) {
        const bf16_t* PG = (const bf16_t*)(a.ws + WS_PG) + (size_t)(h * NGRP) * 16384; const float* QG = (const float*)(a.ws + WS_QG) + ((size_t)(h * NGRP) * 8 + vs) * 2048;
        Stage<4> P0, P1; f32x4 Q0[8], Q1[8];
#define PF_LOAD(PR, QR, j_) do { stage_load2(PR, PG + (size_t)(j_) * 16384, PG + (size_t)(j_) * 16384 + 8192); \
            _Pragma("unroll") for (int mt = 0; mt < 8; ++mt) QR[mt] = *(const f32x4*)(QG + (size_t)(j_) * 16384 + ((size_t)mt * 64 + lane) * 4); } while (0)
#define PF_STEP(j_, BUF, QC, PC, PN) do { \
            f32x4 acc_[8]; _Pragma("unroll") for (int mt = 0; mt < 8; ++mt) acc_[mt] = QC[mt]; \
            if ((j_) + 2 < g) PF_LOAD(PC, QC, (j_) + 2); \
            const bf16_t* Pl = (const bf16_t*)(lds + (BUF) * SBUF); bf16x8 sb[4]; \
            _Pragma("unroll") for (int s = 0; s < 4; ++s) sb[s] = dn::packB(S[2 * s], S[2 * s + 1]); \
            _Pragma("unroll") for (int mt = 0; mt < 8; ++mt) { f32x4 ac = acc_[mt]; \
                _Pragma("unroll") for (int s = 0; s < 4; ++s) ac = MFMA16(dn::frag(Pl, mt * 4 + s, lane), sb[s], ac); \
                S[mt] = ac; } \
            if ((j_) + 1 < g) stage_write2(PN, lds + ((BUF) ^ 1) * SBUF); \
            __syncthreads(); } while (0)
        PF_LOAD(P0, Q0, 0);
        if (g > 1) PF_LOAD(P1, Q1, 1);
        stage_write2(P0, lds);
        __syncthreads();
        for (int j = 0; j < g; j += 2) { PF_STEP(j, 0, Q0, P0, P1); if (j + 1 < g) PF_STEP(j + 1, 1, Q1, P1, P0); }
#undef PF_LOAD
#undef PF_STEP
    }
    const size_t cb0 = (size_t)(h * NCH + g * GRP);
    const bf16_t* WF = (const bf16_t*)(a.ws + WS_DNW) + cb0 * 8192; const bf16_t* KF = (const bf16_t*)(a.ws + WS_DNKD) + cb0 * 8192;
    const bf16_t* QF = (const bf16_t*)(a.ws + WS_DNQD) + cb0 * 8192; const bf16_t* AF = (const bf16_t*)(a.ws + WS_DNATT) + cb0 * 4096;
    const bf16_t* UF = (const bf16_t*)(a.ws + WS_DNU) + cb0 * 8192 + (size_t)vs * 1024; const float* EG = (const float*)(a.ws + WS_EG) + cb0;
    float* ORAW = (float*)(a.ws + WS_ORAW);
    Stage<7> R0, R1; u32x2 U0[4], U1[4];
#define PC_LOAD(RR, UU, i_) do { stage_load4(RR, WF + (size_t)(i_) * 8192, KF + (size_t)(i_) * 8192, QF + (size_t)(i_) * 8192, AF + (size_t)(i_) * 4096); \
        _Pragma("unroll") for (int mt = 0; mt < 4; ++mt) UU[mt] = *(const u32x2*)(UF + (size_t)(i_) * 8192 + ((size_t)mt * 64 + lane) * 4); } while (0)
#define PC_STEP(i_, BUF, RC, UC, RN) do { \
        const char* buf = lds + (BUF) * SBUF; const int n = g * GRP + (i_); \
        f32x4 vn[4], o[4]; \
        _Pragma("unroll") for (int mt = 0; mt < 4; ++mt) { vn[mt] = u_unpack(UC[mt]); o[mt] = (f32x4){0.f, 0.f, 0.f, 0.f}; } \
        if ((i_) + 2 < GRP) PC_LOAD(RC, UC, (i_) + 2); \
        const float eg = EG[(i_)]; \
        const bf16_t* Wl = (const bf16_t*)buf; const bf16_t* Kl = (const bf16_t*)(buf + 16384); const bf16_t* Ql = (const bf16_t*)(buf + 32768); const bf16_t* Al = (const bf16_t*)(buf + 49152); \
        bf16x8 sb[4]; \
        _Pragma("unroll") for (int s = 0; s < 4; ++s) sb[s] = dn::packB(S[2 * s], S[2 * s + 1]); \
        _Pragma("unroll") for (int mt = 0; mt < 4; ++mt) { \
            _Pragma("unroll") for (int s = 0; s < 4; ++s) { vn[mt] = MFMA16(dn::frag(Wl, mt * 4 + s, lane), sb[s], vn[mt]); o[mt] = MFMA16(dn::frag(Ql, mt * 4 + s, lane), sb[s], o[mt]); } } \
        bf16x8 vb[2]; \
        _Pragma("unroll") for (int s = 0; s < 2; ++s) vb[s] = dn::packB(vn[2 * s], vn[2 * s + 1]); \
        _Pragma("unroll") for (int mt = 0; mt < 4; ++mt) \
            _Pragma("unroll") for (int s = 0; s < 2; ++s) o[mt] = MFMA16(dn::frag(Al, mt * 2 + s, lane), vb[s], o[mt]); \
        _Pragma("unroll") for (int mt = 0; mt < 8; ++mt) { S[mt] = S[mt] * eg; \
            _Pragma("unroll") for (int s = 0; s < 2; ++s) S[mt] = MFMA16(dn::frag(Kl, mt * 2 + s, lane), vb[s], S[mt]); } \
        _Pragma("unroll") for (int mt = 0; mt < 4; ++mt) \
            _Pragma("unroll") for (int r = 0; r < 4; ++r) ORAW[(size_t)(n * CH + 16 * mt + 4 * lq + r) * 512 + h * 128 + 16 * vs + lr] = o[mt][r]; \
        if ((i_) + 1 < GRP) stage_write4(RN, lds + ((BUF) ^ 1) * SBUF); \
        __syncthreads(); } while (0)
    PC_LOAD(R0, U0, 0);
    PC_LOAD(R1, U1, 1);
    stage_write4(R0, lds);
    __syncthreads();
#pragma unroll 1
    for (int i = 0; i < GRP; i += 2) { PC_STEP(i, 0, R0, U0, R1); PC_STEP(i + 1, 1, R1, U1, R0); }
#undef PC_LOAD
#undef PC_STEP
}
DI int fox_jlo(const Args& a, int h, int qb, const float* qkbs, int lane) {
    const float* Fh = (const float*)(a.ws + WS_F) + (size_t)h * SEQ; const float* TB = (const float*)(a.ws + WS_NRMT); const int P0 = qb * 256;
    float mq = 0.f, md = 3.0e38f;
    if (lane < 32) { mq = TB[(qb * 32 + lane) * 12 + h]; md = TB[(qb * 32 + lane) * 12 + 8 + h]; }
    for (int o_ = 1; o_ < 64; o_ <<= 1) { mq = fmaxf(mq, __shfl_xor(mq, o_)); md = fminf(md, __shfl_xor(md, o_)); }
    const float qkb = sqrtf(mq * qkbs[h]) * fox::SCALE, lim = Fh[P0] + qkb - md * fox::SCALE + 32.f;
    const int jd = P0 / 64, stride = jd / 64 + 1;
    int j = lane * stride; bool ok = (j > jd) ? true : (Fh[64 * j + 63] <= lim);
    unsigned long long mk = __ballot(ok); const int first = mk ? __builtin_ctzll(mk) : 64;
    const int lo_ex = first == 0 ? -1 : (first - 1) * stride; const int hi_in = (first < 64 && first * stride <= jd) ? first * stride : jd;
    j = lo_ex + 1 + lane; ok = (j < hi_in) ? (Fh[64 * j + 63] <= lim) : false;
    mk = __ballot(ok); return mk ? lo_ex + 1 + __builtin_ctzll(mk) : hi_in;
}
DI void ph4_fox(const Args& a, char* lds, int nscan) {
    const int tid = threadIdx.x, lane = tid & 63, wave = tid >> 6;
    const float* F = (const float*)(a.ws + WS_F); unsigned* QH = (unsigned*)(a.ws + WS_QH);
    int* misc = (int*)(lds + fox::OFF_MISC);
    if (tid == 0) { int ord0 = 0, ord1 = 1, ord2 = 2, ord3 = 3;
      float r0 = -F[0 * SEQ + SEQ - 1], r1 = -F[1 * SEQ + SEQ - 1], r2 = -F[2 * SEQ + SEQ - 1], r3 = -F[3 * SEQ + SEQ - 1];
#define CSWAP(ra, rb, oa, ob) if (rb < ra) { const float tf = ra; ra = rb; rb = tf; const int ti = oa; oa = ob; ob = ti; }
      CSWAP(r0, r1, ord0, ord1) CSWAP(r2, r3, ord2, ord3) CSWAP(r0, r2, ord0, ord2) CSWAP(r1, r3, ord1, ord3) CSWAP(r1, r2, ord1, ord2)
#undef CSWAP
      misc[4] = ord0; misc[5] = ord1; misc[6] = ord2; misc[7] = ord3; }
    float* qkbs = (float*)(lds + fox::OFF_MISC) + 8;
    const float* TB = (const float*)(a.ws + WS_NRMT);
    __syncthreads();
    { float m = 0.f; const int h = tid & 3;
        for (int g_ = tid >> 2; g_ < SEQ / 8; g_ += NTHREADS / 4) m = fmaxf(m, TB[g_ * 12 + 4 + h]);
        for (int o_ = 4; o_ < 64; o_ <<= 1) m = fmaxf(m, __shfl_xor(m, o_));
        if (lane < 4) qkbs[16 + wave * 4 + lane] = m; }
    __syncthreads();
    if (tid < 4) { float m = 0.f; for (int w = 0; w < NWAVES; ++w) m = fmaxf(m, qkbs[16 + w * 4 + tid]); qkbs[tid] = m; }
    __syncthreads();
    for (int round = 0;; ++round) {
        __syncthreads();
        if (tid == 0) misc[0] = (round == 0 && (int)blockIdx.x >= nscan) ? (int)blockIdx.x - nscan : (int)((int)gridDim.x - nscan + (int)atomicAdd(QH, 1u));
        __syncthreads();
        const int it = misc[0];
        if (it >= 256) break;
        const int h = misc[4 + (it >> 6)], qb = 63 - (it & 63), P0 = qb * 256;
        if (wave == 0) { const int jlo = fox_jlo(a, h, qb, qkbs, lane); if (lane == 0) misc[1] = jlo; }
        __syncthreads();
        fox::fox_block(a, lds, h, P0, misc[1]);
    }
    { unsigned* QC = (unsigned*)(a.ws + WS_QH) + 64; int par = 0;
        for (;;) {
            __syncthreads();
            if (tid == 0) misc[0] = (int)atomicAdd(QC, 1u);
            __syncthreads();
            const int c4 = misc[0] * 4;
            if (c4 >= Q_WGU) break;
#pragma unroll 1
            for (int q = 0; q < 4; ++q) conv_quad_gu(a, lds, par, c4 + q);
        }
    }
}
DI void ph4(const Args& a, float* lds) {
    const int nscan = (int)gridDim.x >= 2 * NSCAN ? NSCAN : 0;
    for (int chain = blockIdx.x; chain < NSCAN; chain += gridDim.x) scanA_chain(a, (char*)lds, chain);
    ph4_fox(a, (char*)lds, nscan);
}
DI void ph5_scan(const Args& a, float* lds) {
    const int G = gridDim.x;
    for (int chain = blockIdx.x; chain < NSCAN; chain += G) scanPC_chain(a, (char*)lds, chain);
    unsigned* QC = (unsigned*)(a.ws + WS_QH) + 128; int* misc = (int*)((char*)lds + 2 * SBUF + 4096); int par = 0;
    for (;;) {
        __syncthreads();
        if (threadIdx.x == 0) misc[0] = (int)atomicAdd(QC, 1u);
        __syncthreads();
        const int c4 = misc[0] * 4;
        if (c4 >= Q_WD) break;
#pragma unroll 1
        for (int q = 0; q < 4; ++q) conv_quad_d(a, (char*)lds, par, c4 + q);
    }
}

DI void ph5(const Args& a) {
    const int lane = threadIdx.x & 63, wave = threadIdx.x >> 6, NW = gridDim.x * NWAVES;
    const float* ORAW = (const float*)(a.ws + WS_ORAW); const bf16_t* P = (const bf16_t*)(a.ws + WS_PROJ); bf16_t* OA = (bf16_t*)(a.ws + WS_OA);
    const float g0 = a.in[I_GON][lane], g1 = a.in[I_GON][lane + 64];
    for (int id = blockIdx.x * NWAVES + wave; id < SEQ * 4; id += NW) { const int t = id >> 2, h = id & 3;
        const float o0 = ORAW[(size_t)t * 512 + h * 128 + lane], o1 = ORAW[(size_t)t * 512 + h * 128 + 64 + lane];
        const float rstd = rsqrtf(wave_sum(o0 * o0 + o1 * o1) * (1.f / 128.f) + 1e-6f);
        const float z0 = bf2f(P[(size_t)t * NPJ + PJ_DZ + h * 128 + lane]), z1 = bf2f(P[(size_t)t * NPJ + PJ_DZ + h * 128 + 64 + lane]);
        OA[(size_t)t * 512 + h * 128 + lane] = f2bf(o0 * rstd * g0 * siluf(z0)); OA[(size_t)t * 512 + h * 128 + 64 + lane] = f2bf(o1 * rstd * g1 * siluf(z1)); }
}

DI void ph6(const Args& a, unsigned char* ldsb) {
    const bf16_t* P = (const bf16_t*)(a.ws + WS_PROJ);
    pg8::OrderDense S; S.init(SEQ / 256, DM / 256, (int)gridDim.x, (int)blockIdx.x);
    { pg8::Gemm g{(const bf16_t*)(a.ws + WS_OA), (const bf16_t*)(a.ws + WS_WOAT), SEQ, DM, 512};
      pg8::EpiMerge<0> E{P + PJ_GA, (float*)(a.ws + WS_X1), (bf16_t*)(a.ws + WS_MRG)};
      pg8::gemm_phase<pg8::EpiMerge<0>, pg8::OrderDense>((LAS unsigned char*)ldsb, g, S, E); }
    __syncthreads();
    { pg8::Gemm g{(const bf16_t*)(a.ws + WS_OB), (const bf16_t*)(a.ws + WS_WOBT), SEQ, DM, 512};
      pg8::EpiMerge<1> E{P + PJ_GB, (float*)(a.ws + WS_X1), (bf16_t*)(a.ws + WS_MRG)};
      pg8::gemm_phase<pg8::EpiMerge<1>, pg8::OrderDense>((LAS unsigned char*)ldsb, g, S, E); }
}

DI void ph7(const Args& a, unsigned char* ldsb) {
    pg8::Gemm g{(const bf16_t*)(a.ws + WS_MRG), (const bf16_t*)(a.ws + WS_WOUTT), SEQ, DM, DM};
    pg8::OrderDense S; S.init(SEQ / 256, DM / 256, (int)gridDim.x, (int)blockIdx.x);
    pg8::EpiResid E{a.in[I_X], (const float*)(a.ws + WS_MOD) + 2048, (float*)(a.ws + WS_X1)};
    pg8::gemm_phase<pg8::EpiResid, pg8::OrderDense>((LAS unsigned char*)ldsb, g, S, E);
}

DI void ph8(const Args& a, float* lds) {
    const int tid = threadIdx.x, lane = tid & 63, wave = tid >> 6, G = gridDim.x;
    constexpr int HP = 1028;
    float* A2 = lds; float* B2 = lds + 1024; float* hs = lds + 2048; float* lgs = hs + 16 * HP;
    const float* mod = (const float*)(a.ws + WS_MOD);
    for (int k = tid; k < DM; k += NTHREADS) { A2[k] = a.in[I_G2][k] * (1.f + mod[4096 + k]); B2[k] = mod[3072 + k]; }
    const float* X1 = (const float*)(a.ws + WS_X1); bf16_t* H2 = (bf16_t*)(a.ws + WS_H2);
    int* TOKE = (int*)(a.ws + WS_TOKE); int* TOKS = (int*)(a.ws + WS_TOKS); float* TOKG = (float*)(a.ws + WS_TOKG); unsigned* CNT = (unsigned*)(a.ws + WS_CNT);
    const float* wr = a.in[I_WR];
    float* part = lgs + 512; int* lcnt = (int*)(part + 8 * 16 * 32);
    float wb0[32], wb1[32];
#pragma unroll
    for (int s = 0; s < 32; ++s) { const size_t k = (size_t)(128 * wave + 4 * s + (lane >> 4)); wb0[s] = wr[k * NE + (lane & 15)]; wb1[s] = wr[k * NE + 16 + (lane & 15)]; }
    for (int tile = blockIdx.x; tile < SEQ / 16; tile += G) {
        __syncthreads();
#pragma unroll 1
        for (int q = 0; q < 2; ++q) { const int tt = wave * 2 + q, t = tile * 16 + tt; const float* xr = X1 + (size_t)t * DM;
            f32x4 v[4]; float ss = 0.f;
#pragma unroll
            for (int i = 0; i < 4; ++i) { v[i] = *(const f32x4*)(xr + lane * 4 + 256 * i); ss += v[i][0] * v[i][0] + v[i][1] * v[i][1] + v[i][2] * v[i][2] + v[i][3] * v[i][3]; }
            ss = wave_sum(ss);
            const float rstd = rsqrtf(ss * (1.f / DM) + 1e-6f);
#pragma unroll
            for (int i = 0; i < 4; ++i) { const int k = lane * 4 + 256 * i;
#pragma unroll
                for (int e = 0; e < 4; ++e) v[i][e] = v[i][e] * rstd * A2[k + e] + B2[k + e];
                *(f32x4*)(hs + tt * HP + k) = v[i];
                *(unsigned*)((unsigned char*)H2 + (size_t)t * DM + k) = cvt_f8x4(v[i][0], v[i][1], v[i][2], v[i][3]); } }
        __syncthreads();
        {
            if (tid < 32) lcnt[tid] = 0;
            f32x4 c0 = (f32x4){0.f, 0.f, 0.f, 0.f}, c1 = c0; const float* ha = hs + (lane & 15) * HP + 128 * wave + (lane >> 4);
#pragma unroll
            for (int s = 0; s < 32; ++s) { const float av = ha[4 * s];
                c0 = __builtin_amdgcn_mfma_f32_16x16x4f32(av, wb0[s], c0, 0, 0, 0); c1 = __builtin_amdgcn_mfma_f32_16x16x4f32(av, wb1[s], c1, 0, 0, 0); }
#pragma unroll
            for (int r = 0; r < 4; ++r) { part[(wave * 16 + 4 * (lane >> 4) + r) * 32 + (lane & 15)] = c0[r]; part[(wave * 16 + 4 * (lane >> 4) + r) * 32 + 16 + (lane & 15)] = c1[r]; }
            __syncthreads();
            const int tt = tid >> 5, e = tid & 31; float acc = a.in[I_BR][e];
#pragma unroll
            for (int w = 0; w < 8; ++w) acc += part[(w * 16 + tt) * 32 + e];
            lgs[tt * 32 + e] = acc; }
        __syncthreads();
        { const int e = lane & 31, tt = wave * 2 + (lane >> 5), t = tile * 16 + tt;
            float cur = lgs[tt * 32 + e];
#define TOP1(TV, TI) float TV = cur; int TI = e; for (int o_ = 1; o_ <= 16; o_ <<= 1) { const float ov = __shfl_xor(TV, o_); const int oi = __shfl_xor(TI, o_); if (ov > TV || (ov == TV && oi < TI)) { TV = ov; TI = oi; } } if (e == TI) cur = -__builtin_inff();
            TOP1(tv0, ti0) TOP1(tv1, ti1) TOP1(tv2, ti2) TOP1(tv3, ti3)
#undef TOP1
            const float ex0 = 1.f, ex1 = expf(tv1 - tv0), ex2 = expf(tv2 - tv0), ex3 = expf(tv3 - tv0), den = ex0 + ex1 + ex2 + ex3;
            if (e < 4) { int ee = ti0; float gg = ex0;
                if (e == 1) { ee = ti1; gg = ex1; } if (e == 2) { ee = ti2; gg = ex2; } if (e == 3) { ee = ti3; gg = ex3; }
                const int rank = atomicAdd(lcnt + ee, 1);
                TOKE[t * 4 + e] = ee; TOKS[t * 4 + e] = rank; TOKG[t * 4 + e] = gg / den; } }
        __syncthreads();
        if (tid < 32) ((int*)(a.ws + WS_TCNT))[tile * 32 + tid] = lcnt[tid];
    }
}

DI void pad_starts(const Args& a, int* ps) {
    if (threadIdx.x == 0) { const unsigned* CNT = (const unsigned*)(a.ws + WS_CNT); int s = 0; for (int e = 0; e < NE; ++e) { ps[e] = s; s += (int)((CNT[e] + 255u) / 256u) * 256; } ps[NE] = s; }
    __syncthreads();
}
DI void ph9(const Args& a, float* lds) {
    const int tid = threadIdx.x, lane = tid & 63, wave = tid >> 6, G = gridDim.x;
    int* tab = (int*)lds; int* segs = tab + 32768; int* segoff = segs + 512; int* ps = segoff + 512; int* basel = ps + 64;
    const int* TCNT = (const int*)(a.ws + WS_TCNT);
    for (int i = tid; i < 8192; i += NTHREADS) ((u32x4*)tab)[i] = ((const u32x4*)TCNT)[i];
    __syncthreads();
    { const int e = tid & 31, sg = tid >> 5; int s = 0;
#pragma unroll 8
        for (int q = 0; q < 64; ++q) s += tab[(sg * 64 + q) * 32 + e];
        segs[sg * 32 + e] = s; }
    __syncthreads();
    if (tid < 32) { int run = 0; for (int sg = 0; sg < 16; ++sg) { segoff[sg * 32 + tid] = run; run += segs[sg * 32 + tid]; }
        segs[tid] = run;
        if (blockIdx.x == 0) ((unsigned*)(a.ws + WS_CNT))[tid] = (unsigned)run; }
    __syncthreads();
    if (tid == 0) { int s = 0; for (int e = 0; e < NE; ++e) { ps[e] = s; s += ((segs[e] + 255) / 256) * 256; } ps[NE] = s; }
    __syncthreads();
    const int* TOKE = (const int*)(a.ws + WS_TOKE); int* TOKS = (int*)(a.ws + WS_TOKS);
    const bf16_t* H2 = (const bf16_t*)(a.ws + WS_H2); bf16_t* XG = (bf16_t*)(a.ws + WS_XG);
    for (int tile = blockIdx.x; tile < SEQ / 16; tile += G) {
        __syncthreads();
        if (tid < 32) { int b = segoff[(tile >> 6) * 32 + tid]; for (int q = (tile >> 6) * 64; q < tile; ++q) b += tab[q * 32 + tid]; basel[tid] = ps[tid] + b; }
        __syncthreads();
#pragma unroll 1
        for (int q = 0; q < 8; ++q) { const int id = tile * 64 + wave * 8 + q, t = id >> 2;
            const size_t row = (size_t)(basel[TOKE[id]] + TOKS[id]);
            const u32x4 v0 = *(const u32x4*)((const unsigned char*)H2 + (size_t)t * DM + lane * 16);
            *(u32x4*)((unsigned char*)XG + row * DM + lane * 16) = v0;
            if (lane == 0) TOKS[id] = (int)row; }
    }
}
DI int expert_of(const int* ps, int row0) { int e = 0; for (int i = 1; i < NE; ++i) if (row0 >= ps[i]) e = i; return e; }
DI void ph10(const Args& a, unsigned char* ldsb) {
    int* ps = (int*)(ldsb + 131072); pad_starts(a, ps);
    pg8::Gemm g{(const bf16_t*)(a.ws + WS_XG), (const bf16_t*)(a.ws + WS_WGUT), 0, 2048, DM};
    pg8::OrderGrouped S; S.init(ps[NE] / 256, 8, (int)gridDim.x, (int)blockIdx.x); S.ps = (const LAS int*)ps;
    pg8::EpiSwiglu E{(unsigned char*)(a.ws + WS_ACT), a.in[I_BGU]};
    pg8::gemm_phase<pg8::EpiSwiglu, pg8::OrderGrouped, true>((LAS unsigned char*)ldsb, g, S, E);
}
DI void ph11(const Args& a, unsigned char* ldsb) {
    int* ps = (int*)(ldsb + 131072); pad_starts(a, ps);
    pg8::Gemm g{(const bf16_t*)(a.ws + WS_ACT), (const bf16_t*)(a.ws + WS_WDT), 0, DM, DM};
    pg8::OrderGrouped S; S.init(ps[NE] / 256, 4, (int)gridDim.x, (int)blockIdx.x); S.ps = (const LAS int*)ps;
    pg8::EpiStoreBf16 E{(bf16_t*)(a.ws + WS_YB), DM, a.in[I_BD], DM, 1.f / (WSCALE * ASCALE)};
    pg8::gemm_phase<pg8::EpiStoreBf16, pg8::OrderGrouped, true>((LAS unsigned char*)ldsb, g, S, E);
}
DI void ph12(const Args& a, float* lds) {
    const int lane = threadIdx.x & 63, wave = threadIdx.x >> 6, G = gridDim.x;
    const float* X1 = (const float*)(a.ws + WS_X1); const bf16_t* YB = (const bf16_t*)(a.ws + WS_YB); const float* mod = (const float*)(a.ws + WS_MOD);
    const int* TOKS = (const int*)(a.ws + WS_TOKS); const float* TOKG = (const float*)(a.ws + WS_TOKG);
    f32x4 gt[4], gf[4];
#pragma unroll
    for (int i = 0; i < 4; ++i) { gt[i] = *(const f32x4*)(mod + 5120 + lane * 4 + 256 * i); gf[i] = *(const f32x4*)(a.in[I_GF] + lane * 4 + 256 * i); }
    for (int t0 = (blockIdx.x * NWAVES + wave) * 2; t0 < SEQ; t0 += G * NWAVES * 2) {
        int rows[2][4]; float gk[2][4];
#pragma unroll
        for (int p = 0; p < 2; ++p)
#pragma unroll
            for (int q = 0; q < 4; ++q) { rows[p][q] = TOKS[(t0 + p) * 4 + q]; gk[p][q] = TOKG[(t0 + p) * 4 + q]; }
        f32x4 v[2][4]; u32x2 yv[2][4][4];
#pragma unroll
        for (int p = 0; p < 2; ++p)
#pragma unroll
            for (int i = 0; i < 4; ++i) { const int k = lane * 4 + 256 * i; v[p][i] = *(const f32x4*)(X1 + (size_t)(t0 + p) * DM + k);
#pragma unroll
                for (int q = 0; q < 4; ++q) yv[p][i][q] = *(const u32x2*)(YB + (size_t)rows[p][q] * DM + k); }
#pragma unroll
        for (int p = 0; p < 2; ++p) { float ss = 0.f;
#pragma unroll
            for (int i = 0; i < 4; ++i) { f32x4 y = (f32x4){0.f, 0.f, 0.f, 0.f};
#pragma unroll
                for (int q = 0; q < 4; ++q) { const u32x2 w = yv[p][i][q];
                    y[0] += gk[p][q] * __uint_as_float(w.x << 16); y[1] += gk[p][q] * __uint_as_float(w.x & 0xffff0000u); y[2] += gk[p][q] * __uint_as_float(w.y << 16); y[3] += gk[p][q] * __uint_as_float(w.y & 0xffff0000u); }
                v[p][i] += gt[i] * y; ss += v[p][i][0] * v[p][i][0] + v[p][i][1] * v[p][i][1] + v[p][i][2] * v[p][i][2] + v[p][i][3] * v[p][i][3]; }
            ss = wave_sum(ss);
            const float rstd = rsqrtf(ss * (1.f / DM) + 1e-6f);
#pragma unroll
            for (int i = 0; i < 4; ++i) *(f32x4*)(a.out + (size_t)(t0 + p) * DM + lane * 4 + 256 * i) = v[p][i] * rstd * gf[i]; }
    }
}

__global__ void __launch_bounds__(NTHREADS, 2) hybrid_fwd(Args a) {
    extern __shared__ __attribute__((aligned(16))) unsigned char lds_raw[];
    float* lds = (float*)(lds_raw + 16);
    LAS unsigned* xbw = (LAS unsigned*)lds_raw;
    if (threadIdx.x == 0) { xbw[0] = 0u; xbw[1] = 0u; xbw[2] = 0u; xbw[3] = 0u; }
    __syncthreads();
    XcdBarrier bar; bar.bar = (unsigned*)(a.ws + WS_BAR); bar.x = 0; bar.st = (volatile LAS unsigned*)xbw;
    const int lo = a.ph_lo, hi = a.ph_hi;
    if (hi - lo > 1) bar = xcd_barrier_post((unsigned*)(a.ws + WS_BAR), (volatile LAS unsigned*)xbw);
#define IN(k) (lo <= (k) && (k) < hi)
#define SEAM(k) do { if (IN(k) && IN((k) + 1)) xcd_barrier(bar); } while (0)
    if (IN(0)) ph0(a, lds);
    SEAM(0);
    if (IN(1)) ph1(a, lds);
    SEAM(1);
    if (IN(2)) ph2(a, lds_raw + 16);
    SEAM(2);
    if (IN(3)) ph3(a, lds);
    SEAM(3);
    if (IN(4)) ph4(a, lds);
    SEAM(4);
    if (IN(5)) ph5_scan(a, lds);
    SEAM(5);
    if (IN(6)) ph5(a);
    SEAM(6);
    if (IN(7)) ph6(a, lds_raw + 16);
    SEAM(7);
    if (IN(8)) ph7(a, lds_raw + 16);
    SEAM(8);
    if (IN(9)) ph8(a, lds);
    SEAM(9);
    if (IN(10)) ph9(a, lds);
    SEAM(10);
    if (IN(11)) ph10(a, lds_raw + 16);
    SEAM(11);
    if (IN(12)) ph11(a, lds_raw + 16);
    SEAM(12);
    if (IN(13)) ph12(a, lds);
#undef IN
#undef SEAM
}

extern "C" void kernel_launch(void* const* d_in, const int* in_sizes, int n_in, void* d_out, int out_size, void* d_ws, size_t ws_size, hipStream_t stream) {
    static int grid = 0;
    if (grid == 0) {
        if (n_in != 22 || out_size != SEQ * DM || ws_size < WS_END) { fprintf(stderr, "kernel_launch: unexpected shapes (n_in %d out %d ws %zu, need %zu)\n", n_in, out_size, ws_size, (size_t)WS_END); grid = -1; return; }
        int dev = 0, cus = 0, per_cu = 0;
        if (hipGetDevice(&dev) != hipSuccess || hipDeviceGetAttribute(&cus, hipDeviceAttributeMultiprocessorCount, dev) != hipSuccess) { grid = -1; return; }
        if (hipFuncSetAttribute((const void*)hybrid_fwd, hipFuncAttributeMaxDynamicSharedMemorySize, LDS_BYTES) != hipSuccess) { fprintf(stderr, "kernel_launch: hipFuncSetAttribute failed\n"); grid = -1; return; }
        if (hipOccupancyMaxActiveBlocksPerMultiprocessor(&per_cu, (const void*)hybrid_fwd, NTHREADS, LDS_BYTES) != hipSuccess || per_cu < 1) { fprintf(stderr, "kernel_launch: occupancy query says %d\n", per_cu); }
        (void)hipGetLastError();
        grid = cus;
    }
    if (grid < 0) return;
    (void)hipMemsetAsync(d_ws, 0, CTL_ZERO, stream);
    Args a{};
    for (int i = 0; i < 22; ++i) a.in[i] = (const float*)d_in[i];
    a.out = (float*)d_out; a.ws = (unsigned char*)d_ws;
#if N_LAUNCHES == 1
    a.ph_lo = 0; a.ph_hi = NPHASES;
    hipLaunchKernelGGL(hybrid_fwd, dim3(grid), dim3(NTHREADS), LDS_BYTES, stream, a);
#else
    for (int p = 0; p < NPHASES; ++p) { a.ph_lo = p; a.ph_hi = p + 1; hipLaunchKernelGGL(hybrid_fwd, dim3(grid), dim3(NTHREADS), LDS_BYTES, stream, a); }
#endif
}
```

```cpp
#include <hip/hip_runtime.h>
#include <stdint.h>
#include <stdio.h>

#ifndef N_LAUNCHES
#define N_LAUNCHES 1
#endif

#define DI __device__ __forceinline__
#define LAS __attribute__((address_space(3)))
typedef unsigned short bf16_t;
typedef short bf16x8 __attribute__((ext_vector_type(8)));
typedef float f32x4 __attribute__((ext_vector_type(4)));
typedef unsigned u32x4 __attribute__((ext_vector_type(4)));
typedef unsigned u32x2 __attribute__((ext_vector_type(2)));
typedef int v8i32 __attribute__((ext_vector_type(8)));

constexpr int SEQ = 16384, DM = 1024, NIN = 5644, NPJ = 5632, NE = 32, TOPK = 4;
constexpr int NH = 4, HD = 128, CH = 64, NCH = SEQ / CH;
constexpr int PJ_DQ = 0, PJ_DK = 512, PJ_DV = 1024, PJ_DZ = 1536, PJ_FQ = 2048, PJ_FK = 2560, PJ_FV = 3072, PJ_GA = 3584, PJ_GB = 4608;
constexpr int NTHREADS = 512, NWAVES = 8;
constexpr int LDS_BYTES = 152 * 1024;
constexpr int NPHASES = 14;

constexpr size_t MiB = 1u << 20;
constexpr size_t WS_BAR = 0;
constexpr size_t WS_CNT = 32768;
constexpr size_t WS_NRM = 32768 + 256;
constexpr size_t WS_QH = 32768 + 512;
constexpr size_t CTL_ZERO = 65536;
constexpr size_t WS_MOD = 65536;
constexpr size_t WS_F = WS_MOD + 32768;
constexpr size_t WS_EG = WS_F + 262144;
constexpr size_t WS_TOKE = WS_EG + 4096;
constexpr size_t WS_TOKS = WS_TOKE + 262144;
constexpr size_t WS_TOKG = WS_TOKS + 262144;
constexpr size_t WS_SP = WS_TOKG + 262144;
constexpr size_t WS_WINT = WS_SP + MiB;
constexpr size_t WS_WOAT = WS_WINT + (size_t)NPJ * DM * 2;
constexpr size_t WS_WOBT = WS_WOAT + MiB;
constexpr size_t WS_WOUTT = WS_WOBT + MiB;
constexpr size_t WS_WGUT = WS_WOUTT + 2 * MiB;
constexpr size_t WS_WDT = WS_WGUT + 128 * MiB;
constexpr size_t WS_X1 = WS_WDT + 64 * MiB;
constexpr size_t WS_H2 = WS_X1 + 64 * MiB;
constexpr size_t WS_MRG = WS_H2 + 32 * MiB;
constexpr size_t WS_RA = WS_MRG + 32 * MiB;
constexpr size_t WS_RB = WS_RA + 176 * MiB;
constexpr size_t WS_H = WS_RB;
constexpr size_t WS_DNW = WS_H + 32 * MiB;
constexpr size_t WS_DNU = WS_DNW + 16 * MiB;
constexpr size_t WS_DNQD = WS_DNU + 16 * MiB;
constexpr size_t WS_DNKD = WS_DNQD + 16 * MiB;
constexpr size_t WS_DNATT = WS_DNKD + 16 * MiB;
constexpr size_t WS_ORAW = WS_DNATT + 8 * MiB;
constexpr size_t WS_OA = WS_ORAW + 32 * MiB;
constexpr size_t WS_OB = WS_OA + 16 * MiB;
constexpr size_t WS_VT = WS_OB + 16 * MiB;
constexpr size_t WS_PG = WS_VT;
constexpr size_t WS_QG = WS_PG + 2 * MiB;
constexpr size_t WS_SG = WS_QG + 4 * MiB;
constexpr size_t WS_TCNT = WS_SG + 4 * MiB;
constexpr size_t WS_LF = WS_TCNT + 131072 + 131072;
constexpr size_t WS_NRMT = WS_TCNT + 131072;
constexpr size_t WS_END = WS_RB + 184 * MiB;
constexpr size_t WS_XG = WS_RA, WS_YB = WS_RA, WS_ACT = WS_RB, WS_PROJ = WS_RA;
static_assert(WS_VT + 16 * MiB <= WS_END, "region B");

struct Args { const float* in[22]; float* out; unsigned char* ws; int ph_lo, ph_hi; };
enum { I_X = 0, I_C, I_WADA, I_BADA, I_G1, I_WIN, I_CONVW, I_ALOG, I_DTB, I_GON, I_BFG, I_WOD, I_WOF, I_WOUT, I_G2, I_WR, I_BR, I_WGU, I_BGU, I_WD, I_BD, I_GF };

DI float bf2f(bf16_t v) { return __uint_as_float(((unsigned)v) << 16); }
DI bf16_t f2bf(float f) { unsigned u = __float_as_uint(f); u += 0x7fffu + ((u >> 16) & 1u); return (bf16_t)(u >> 16); }
typedef float f32x2_t __attribute__((ext_vector_type(2)));
typedef __bf16 bf16x2_t __attribute__((ext_vector_type(2)));
DI unsigned cvt_pk(float lo, float hi) { const f32x2_t v = {lo, hi}; const bf16x2_t b = __builtin_convertvector(v, bf16x2_t); return __builtin_bit_cast(unsigned, b); }
DI unsigned cvt_f8x4(float a, float b, float c, float d) { unsigned w = 0; w = __builtin_amdgcn_cvt_pk_fp8_f32(a, b, w, false); w = __builtin_amdgcn_cvt_pk_fp8_f32(c, d, w, true); return w; }
DI unsigned pk2(float lo, float hi) { return (unsigned)f2bf(lo) | ((unsigned)f2bf(hi) << 16); }
DI float sigm(float x) { return 1.f / (1.f + expf(-x)); }
DI float siluf(float x) { return x / (1.f + expf(-x)); }
DI float softplusf(float x) { return fmaxf(x, 0.f) + log1pf(expf(-fabsf(x))); }
DI float logsigf(float x) { return fminf(x, 0.f) - log1pf(expf(-fabsf(x))); }
DI float wave_sum(float v) { for (int o = 32; o >= 1; o >>= 1) v += __shfl_xor(v, o); return v; }
#define MFMA16(a, b, c) __builtin_amdgcn_mfma_f32_16x16x32_bf16((a), (b), (c), 0, 0, 0)

DI int gu_src(int n) { const int g = n >> 8, r = n & 255; return r < 128 ? 128 * g + r : 1024 + 128 * g + (r - 128); }

#define XB_TMO      128
#define XB_XCNT(j)  (256  + 64 * (j))
#define XB_XSUB(j)  (1280 + 64 * (j))
#define XB_XGEN(j)  (2304 + 64 * (j))
#define XB_TOP      3328
#define XB_TOPGEN   3392
#define XCD_BAR_WORDS 3456
#define XB_SPIN_CAP (1u << 22)
DI unsigned xb_ld(unsigned* p)              { return __hip_atomic_load(p, __ATOMIC_RELAXED, __HIP_MEMORY_SCOPE_AGENT); }
DI unsigned xb_add(unsigned* p, unsigned v) { return __hip_atomic_fetch_add(p, v, __ATOMIC_RELAXED, __HIP_MEMORY_SCOPE_AGENT); }
DI unsigned xb_xcc_id() { return (unsigned)__builtin_amdgcn_s_getreg((3 << 11) | 20) & 0xFu; }
#define XB_SPIN(cond, bar) do { unsigned _sp = 0; while (cond) { __builtin_amdgcn_s_sleep(1); \
    if ((++_sp & 255u) == 0u) { if (xb_ld(&(bar)[XB_TMO])) break; if (_sp > XB_SPIN_CAP) { atomicAdd(&(bar)[XB_TMO], 1u); break; } } } } while (0)
struct XcdBarrier { unsigned* bar; unsigned x; volatile LAS unsigned* st; };
DI XcdBarrier xcd_barrier_post(unsigned* bar, volatile LAS unsigned* st) {
    XcdBarrier b; b.bar = bar; b.x = xb_xcc_id(); b.st = st;
    if (threadIdx.x == 0) (void)xb_add(&bar[XB_XCNT(b.x)], 1u);
    return b;
}
DI void xcd_barrier_complete(unsigned* bar, unsigned x, unsigned& nloc, unsigned& nx) {
    const unsigned G = gridDim.x * gridDim.y * gridDim.z;
    unsigned sum, cnt, mine, sp = 0u;
    for (;;) {
        sum = 0u; cnt = 0u; mine = 0u;
#pragma unroll
        for (unsigned j = 0; j < 16; ++j) { const unsigned c = xb_ld(&bar[XB_XCNT(j)]); sum += c; cnt += (c > 0u) ? 1u : 0u; mine = (j == x) ? c : mine; }
        if (sum == G) break;
        __builtin_amdgcn_s_sleep(1);
        if ((++sp & 255u) == 0u) { if (xb_ld(&bar[XB_TMO])) break; if (sp > XB_SPIN_CAP) { atomicAdd(&bar[XB_TMO], 1u); break; } }
    }
    nloc = mine > 0u ? mine : 1u; nx = cnt > 0u ? cnt : 1u;
}
DI void xcd_barrier(const XcdBarrier& b) {
    asm volatile("s_waitcnt vmcnt(0)" ::: "memory");
    __syncthreads();
    if (threadIdx.x == 0) {
        unsigned* bar = b.bar;
        __builtin_amdgcn_s_waitcnt(0);
        unsigned nloc = b.st[0], nx = b.st[1];
        if (nloc == 0u) { xcd_barrier_complete(bar, b.x, nloc, nx); b.st[0] = nloc; b.st[1] = nx; }
        const unsigned old = xb_add(&bar[XB_XSUB(b.x)], 1u);
        const unsigned gen = old / nloc;
        if (old + 1u == (gen + 1u) * nloc) {
            __builtin_amdgcn_fence(__ATOMIC_RELEASE, "agent");
            asm volatile("s_waitcnt vmcnt(0)" ::: "memory");
            const unsigned og = xb_add(&bar[XB_TOP], 1u);
            const unsigned tg = og / nx;
            if (og + 1u == (tg + 1u) * nx) xb_add(&bar[XB_TOPGEN], 1u);
            else XB_SPIN(xb_ld(&bar[XB_TOPGEN]) == tg, bar);
            __builtin_amdgcn_fence(__ATOMIC_ACQUIRE, "agent");
            xb_add(&bar[XB_XGEN(b.x)], 1u);
            asm volatile("s_waitcnt vmcnt(0)" ::: "memory");
        } else {
            XB_SPIN(xb_ld(&bar[XB_XGEN(b.x)]) == gen, bar);
            __builtin_amdgcn_fence(__ATOMIC_ACQUIRE, "agent");
            asm volatile("s_waitcnt vmcnt(0)" ::: "memory");
        }
    }
    __syncthreads();
}

template <int NT>
DI void wave_gemm(const bf16_t* const (&ap)[4], const bf16_t* const (&bp)[NT], int K, f32x4 (&acc)[4][NT]) {
    for (int k0 = 0; k0 < K; k0 += 32) {
        bf16x8 a[4], b[NT];
#pragma unroll
        for (int i = 0; i < 4; ++i) a[i] = *(const bf16x8*)(ap[i] + k0);
#pragma unroll
        for (int j = 0; j < NT; ++j) b[j] = *(const bf16x8*)(bp[j] + k0);
#pragma unroll
        for (int i = 0; i < 4; ++i)
#pragma unroll
            for (int j = 0; j < NT; ++j) acc[i][j] = MFMA16(a[i], b[j], acc[i][j]);
    }
}
template <int NT> DI void zero_acc(f32x4 (&acc)[4][NT]) {
#pragma unroll
    for (int i = 0; i < 4; ++i)
#pragma unroll
        for (int j = 0; j < NT; ++j) acc[i][j] = (f32x4){0.f, 0.f, 0.f, 0.f};
}


constexpr float WSCALE = 64.f, ASCALE = 4.f;
namespace pg8 {
struct Unit { int pm, pn, pb, e; };
struct Gemm { const bf16_t* A; const bf16_t* Bt; int M, N, K; };
constexpr int BM = 256, BK = 64, HALF = 128, HTB = HALF * BK * 2  , STAGE_BYTES = 8 * HTB, NXCD = 8, WGM = 8;

__host__ __device__ __forceinline__ int lds_byte(int r, int c) { const int st = (r >> 4) * 2 + (c >> 5), rr = r & 15, cc = c & 31, ob = rr * 64 + cc * 2; return st * 1024 + (ob ^ (((ob >> 9) & 1) << 5)); }
__host__ __device__ __forceinline__ void stage_rc(int b, int& R, int& C) { const int st = b / 1024, sb = b % 1024, swz = sb ^ (((sb >> 9) & 1) << 5); R = (st >> 1) * 16 + swz / 64; C = (st & 1) * 32 + (swz % 64) / 2; }
__host__ __device__ __forceinline__ int perm32(int rho) { const int n = rho >> 4, i = rho & 15; return 8 * (i >> 2) + 4 * n + (i & 3); }
template <class Epi, class Sched, bool FP8 = false>
__device__ __forceinline__ void gemm_phase(LAS unsigned char* lds, const Gemm g, const Sched& S, const Epi& E) {
    const int tid = threadIdx.x, wid = __builtin_amdgcn_readfirstlane(tid >> 6), lane = tid & 63, wr = wid >> 2, wc = wid & 3, fr = lane & 15, fq = lane >> 4;
    const int K = FP8 ? g.K / 2 : g.K, nt = K / BK;
    unsigned voffA[2], voffB[2];
#pragma unroll
    for (int i = 0; i < 2; ++i) { int R, C;
        if (FP8) { const int b = tid * 16 + i * 8192; R = b >> 7; const int sw = ((R >> 1) & 1) | (((R >> 3) & 1) << 1); C = (((((b & 127) >> 5) ^ sw) << 5) + (b & 31)) >> 1; }
        else stage_rc(tid * 16 + i * 8192, R, C);
        const int Rb = Epi::PERM ? ((R & ~31) + perm32(R & 31)) : R;
        voffA[i] = (unsigned)(R * K + C) * 2u; voffB[i] = (unsigned)(Rb * K + C) * 2u; }
    const size_t kstep = (size_t)(BK * 2);
    const size_t hstep = (size_t)HALF * K * 2;
    const size_t tstep = 2 * hstep;
    const unsigned ldsw = (unsigned)wid * 1024u;
    const int fsw = ((fr >> 1) & 1) | (((fr >> 3) & 1) << 1);
    const int aoff = FP8 ? (wr * 64 + fr) * 128 + ((fq ^ fsw) << 5) + ((fq & 1) << 4) : lds_byte(wr * 64 + fr, fq * 8), boff = FP8 ? (wc * 32 + fr) * 128 + ((fq ^ fsw) << 5) + ((fq & 1) << 4) : lds_byte(wc * 32 + fr, fq * 8);
    const int aoff2 = aoff ^ 16, boff2 = boff ^ 16;
#define PG8_SA(b, h) (((b) * 2 + (h)) * HTB)
#define PG8_SB(b, h) ((4 + (b) * 2 + (h)) * HTB)
#define PG8_STAGE(bufoff, gbase, voff) do { _Pragma("unroll") for (int _i = 0; _i < 2; ++_i) \
        __builtin_amdgcn_global_load_lds((const unsigned*)((const char*)(gbase) + (voff)[_i]), (LAS unsigned*)(lds + (bufoff) + ldsw + _i * 8192), 16, 0, 0); } while (0)
#define PG8_LDA(dst, b, h) do { _Pragma("unroll") for (int m = 0; m < 4; ++m) { if (FP8) { const u32x4 l_ = *(const LAS u32x4*)(lds + PG8_SA(b, h) + aoff + m * 2048), h_ = *(const LAS u32x4*)(lds + PG8_SA(b, h) + aoff2 + m * 2048); dst##8[m] = (v8i32){(int)l_.x, (int)l_.y, (int)l_.z, (int)l_.w, (int)h_.x, (int)h_.y, (int)h_.z, (int)h_.w}; } \
        else { _Pragma("unroll") for (int k = 0; k < 2; ++k) dst[m][k] = *(const LAS bf16x8*)(lds + PG8_SA(b, h) + aoff + m * 2048 + k * 1024); } } } while (0)
#define PG8_LDB(dst, b, h) do { _Pragma("unroll") for (int n = 0; n < 2; ++n) { if (FP8) { const u32x4 l_ = *(const LAS u32x4*)(lds + PG8_SB(b, h) + boff + n * 2048), h_ = *(const LAS u32x4*)(lds + PG8_SB(b, h) + boff2 + n * 2048); dst##8[n] = (v8i32){(int)l_.x, (int)l_.y, (int)l_.z, (int)l_.w, (int)h_.x, (int)h_.y, (int)h_.z, (int)h_.w}; } \
        else { _Pragma("unroll") for (int k = 0; k < 2; ++k) dst[n][k] = *(const LAS bf16x8*)(lds + PG8_SB(b, h) + boff + n * 2048 + k * 1024); } } } while (0)
#define PG8_MMA(ai, bj, At, Bt) do { __builtin_amdgcn_s_setprio(1); _Pragma("unroll") for (int m = 0; m < 4; ++m) _Pragma("unroll") for (int n = 0; n < 2; ++n) { \
        if (FP8) asm volatile("v_mfma_f32_16x16x128_f8f6f4 %0, %1, %2, %0" : "+v"(acc[ai][bj][m][n]) : "v"(Bt##8[n]), "v"(At##8[m])); \
        else { _Pragma("unroll") for (int k = 0; k < 2; ++k) acc[ai][bj][m][n] = __builtin_amdgcn_mfma_f32_16x16x32_bf16(Bt[n][k], At[m][k], acc[ai][bj][m][n], 0, 0, 0); } } \
        __builtin_amdgcn_s_setprio(0); } while (0)
#define PG8_WAIT_V(n) asm volatile("s_waitcnt vmcnt(" #n ")" ::: "memory")
#define PG8_WAIT_L(n) asm volatile("s_waitcnt lgkmcnt(" #n ")" ::: "memory")
#define PG8_BAR __builtin_amdgcn_s_barrier()
#define PG8_SCHED __builtin_amdgcn_sched_barrier(0)
    Unit cur, nxt; int ui = 0;
    if (!S.next(0, cur)) return;
    f32x4 acc[2][2][4][2];
#pragma unroll
    for (int a = 0; a < 2; ++a)
#pragma unroll
        for (int b = 0; b < 2; ++b)
#pragma unroll
            for (int m = 0; m < 4; ++m)
#pragma unroll
                for (int n = 0; n < 2; ++n) acc[a][b][m][n] = (f32x4){0.f, 0.f, 0.f, 0.f};
    bf16x8 At[4][2], B0[2][2], B1[2][2]; v8i32 At8[4], B08[2], B18[2];
    const char* cA = (const char*)g.A + (size_t)cur.pm * tstep; const char* cB = (const char*)g.Bt + (size_t)cur.pb * tstep;
    S.a_ready(cur);
    PG8_STAGE(PG8_SB(0, 0), cB, voffB); PG8_STAGE(PG8_SA(0, 0), cA, voffA); PG8_STAGE(PG8_SB(0, 1), cB + hstep, voffB); PG8_STAGE(PG8_SA(0, 1), cA + hstep, voffA);
    if (wr == 1) PG8_BAR;
    PG8_WAIT_V(4); PG8_BAR;
    PG8_STAGE(PG8_SB(1, 0), cB + kstep, voffB); PG8_STAGE(PG8_SA(1, 0), cA + kstep, voffA); PG8_STAGE(PG8_SB(1, 1), cB + hstep + kstep, voffB);
    PG8_WAIT_V(6); PG8_BAR;
    for (;;) {
        const bool has_next = S.next(ui + 1, nxt);
        const char* nA = has_next ? (const char*)g.A + (size_t)nxt.pm * tstep : cA; const char* nB = has_next ? (const char*)g.Bt + (size_t)nxt.pb * tstep : cB;
#pragma unroll 1
        for (int t = 0; t < nt; t += 2) {
            const bool last = (t == nt - 2);
            const char* a1 = cA + (size_t)(t + 1) * kstep;
            const char* a2 = last ? nA : cA + (size_t)(t + 2) * kstep; const char* b2 = last ? nB : cB + (size_t)(t + 2) * kstep;
            const char* a3 = a2 + kstep; const char* b3 = b2 + kstep;
            if (last && has_next) S.a_ready(nxt);
            PG8_LDB(B0, 0, 0); PG8_SCHED; PG8_LDA(At, 0, 0); PG8_STAGE(PG8_SA(1, 1), a1 + hstep, voffA);
            PG8_WAIT_L(8); PG8_BAR; PG8_WAIT_L(0); PG8_MMA(0, 0, At, B0); PG8_BAR; PG8_SCHED;
            PG8_LDB(B1, 0, 1); PG8_STAGE(PG8_SB(0, 0), b2, voffB);
            PG8_BAR; PG8_WAIT_L(0); PG8_MMA(0, 1, At, B1); PG8_BAR;
            PG8_LDA(At, 0, 1); PG8_STAGE(PG8_SA(0, 0), a2, voffA);
            PG8_BAR; PG8_WAIT_L(0); PG8_MMA(1, 0, At, B0); PG8_BAR; PG8_SCHED;
            PG8_STAGE(PG8_SB(0, 1), b2 + hstep, voffB);
            PG8_WAIT_V(6); PG8_BAR; PG8_MMA(1, 1, At, B1); PG8_BAR;
            PG8_LDB(B0, 1, 0); PG8_SCHED; PG8_LDA(At, 1, 0); PG8_STAGE(PG8_SA(0, 1), a2 + hstep, voffA);
            PG8_WAIT_L(8); PG8_BAR; PG8_WAIT_L(0); PG8_MMA(0, 0, At, B0); PG8_BAR; PG8_SCHED;
            PG8_LDB(B1, 1, 1); PG8_STAGE(PG8_SB(1, 0), b3, voffB);
            PG8_BAR; PG8_WAIT_L(0); PG8_MMA(0, 1, At, B1); PG8_BAR;
            PG8_LDA(At, 1, 1); PG8_STAGE(PG8_SA(1, 0), a3, voffA);
            PG8_BAR; PG8_WAIT_L(0); PG8_MMA(1, 0, At, B0); PG8_BAR; PG8_SCHED;
            PG8_STAGE(PG8_SB(1, 1), b3 + hstep, voffB);
            PG8_WAIT_V(6); PG8_BAR; PG8_MMA(1, 1, At, B1); PG8_BAR;
        }
        if (FP8) asm volatile("s_nop 15\n\ts_nop 15" ::: "memory");
        if constexpr (!Epi::AFTER_DRAIN) { E(acc, cur, wr, wc, fr, fq); S.done(cur); }
        if (!has_next) break;
#pragma unroll
        for (int a = 0; a < 2; ++a)
#pragma unroll
            for (int b = 0; b < 2; ++b)
#pragma unroll
                for (int m = 0; m < 4; ++m)
#pragma unroll
                    for (int n = 0; n < 2; ++n) acc[a][b][m][n] = (f32x4){0.f, 0.f, 0.f, 0.f};
        cur = nxt; cA = nA; cB = nB; ++ui;
    }
    PG8_WAIT_V(0);
    if (wr == 0) PG8_BAR;
    PG8_BAR;
    if constexpr (Epi::AFTER_DRAIN) { E.fused(acc, cur, wr, wc, fr, fq, lds, wid, lane); S.done(cur); }
#undef PG8_SA
#undef PG8_SB
#undef PG8_STAGE
#undef PG8_LDA
#undef PG8_LDB
#undef PG8_MMA
#undef PG8_WAIT_V
#undef PG8_WAIT_L
#undef PG8_BAR
#undef PG8_SCHED
}

DI unsigned cvt_pk_bf16(float lo, float hi) { return cvt_pk(lo, hi); }
DI float fsig(float x) { return __builtin_amdgcn_rcpf(1.f + __builtin_amdgcn_exp2f(-1.4426950408889634f * x)); }
DI int expert_of_l(const LAS int* ps, int row0) { int e = 0;
#pragma unroll 1
    for (int i = 1; i < NE; ++i) if (row0 >= ps[i]) e = i; return e; }
struct OrderDense {
    int nM, nN, nwg, G, c;
    DI void init(int nM_, int nN_, int G_, int c_) { nM = nM_; nN = nN_; nwg = nM * nN; G = G_; c = c_; }
    DI bool tile(int i, Unit& u) const {
        const long L = (long)i * G + c; if (L >= nwg) return false;
        int wgid = (int)L; { const int q = nwg / NXCD, r = nwg % NXCD, xcd = wgid % NXCD, off = wgid / NXCD; wgid = (xcd < r ? xcd * (q + 1) : r * (q + 1) + (xcd - r) * q) + off; }
        const int nig = WGM * nN, gid = wgid / nig, fm = gid * WGM, gsz = (nM - fm) < WGM ? (nM - fm) : WGM;
        u.pm = fm + ((wgid % nig) % gsz); u.pn = (wgid % nig) / gsz; return true;
    }
    DI bool next(int i, Unit& u) const { if (!tile(i, u)) return false; u.pb = u.pn; u.e = 0; return true; }
    DI void a_ready(const Unit&) const {}
    DI void done(const Unit&) const {}
};
struct OrderGrouped : OrderDense {
    const LAS int* ps;
    DI bool next(int i, Unit& u) const { if (!tile(i, u)) return false; u.e = expert_of_l(ps, u.pm * BM); u.pb = u.e * nN + u.pn; return true; }
};
struct EpiStoreBf16 {
    static constexpr bool PERM = true, AFTER_DRAIN = false;
    bf16_t* O; int ldc; const float* bias; int bstride; float scale;
    DI void operator()(const f32x4 (&acc)[2][2][4][2], const Unit& u, int wr, int wc, int fr, int fq) const {
        const int row0 = u.pm * BM + wr * 64 + fr, col0 = u.pn * BM + wc * 32 + 8 * fq;
        f32x4 bv[2][2];
#pragma unroll
        for (int bj = 0; bj < 2; ++bj)
#pragma unroll
            for (int n = 0; n < 2; ++n) bv[bj][n] = bias ? *(const f32x4*)(bias + (size_t)u.e * bstride + col0 + bj * HALF + 4 * n) : (f32x4){0.f, 0.f, 0.f, 0.f};
#pragma unroll
        for (int ai = 0; ai < 2; ++ai)
#pragma unroll
            for (int m = 0; m < 4; ++m) { bf16_t* rowp = O + (size_t)(row0 + ai * HALF + m * 16) * ldc + col0;
#pragma unroll
                for (int bj = 0; bj < 2; ++bj) { const f32x4 v0 = acc[ai][bj][m][0] * scale + bv[bj][0], v1 = acc[ai][bj][m][1] * scale + bv[bj][1];
                    u32x4 w; w.x = cvt_pk_bf16(v0[0], v0[1]); w.y = cvt_pk_bf16(v0[2], v0[3]); w.z = cvt_pk_bf16(v1[0], v1[1]); w.w = cvt_pk_bf16(v1[2], v1[3]);
                    *(u32x4*)(rowp + bj * HALF) = w; } }
    }
};
template <int SECOND> struct EpiMerge {
    static constexpr bool PERM = true, AFTER_DRAIN = false;
    const bf16_t* gate; float* T; bf16_t* O;
    DI void operator()(const f32x4 (&acc)[2][2][4][2], const Unit& u, int wr, int wc, int fr, int fq) const {
        const int row0 = u.pm * BM + wr * 64 + fr, col0 = u.pn * BM + wc * 32 + 8 * fq;
#pragma unroll
        for (int ai = 0; ai < 2; ++ai)
#pragma unroll
            for (int mp = 0; mp < 2; ++mp) {
                u32x4 g[2][2]; f32x4 t0[2][2], t1[2][2];
#pragma unroll
                for (int mm = 0; mm < 2; ++mm)
#pragma unroll
                    for (int bj = 0; bj < 2; ++bj) { const size_t row = (size_t)(row0 + ai * HALF + (2 * mp + mm) * 16); const int col = col0 + bj * HALF;
                        g[mm][bj] = *(const u32x4*)(gate + row * NPJ + col);
                        if (SECOND) { t0[mm][bj] = *(const f32x4*)(T + row * DM + col); t1[mm][bj] = *(const f32x4*)(T + row * DM + col + 4); } }
#pragma unroll
                for (int mm = 0; mm < 2; ++mm)
#pragma unroll
                    for (int bj = 0; bj < 2; ++bj) { const int m = 2 * mp + mm; const size_t row = (size_t)(row0 + ai * HALF + m * 16); const int col = col0 + bj * HALF;
                        const u32x4 gg = g[mm][bj]; f32x4 v0 = acc[ai][bj][m][0], v1 = acc[ai][bj][m][1];
                        v0[0] *= fsig(__uint_as_float(gg.x << 16)); v0[1] *= fsig(__uint_as_float(gg.x & 0xffff0000u)); v0[2] *= fsig(__uint_as_float(gg.y << 16)); v0[3] *= fsig(__uint_as_float(gg.y & 0xffff0000u));
                        v1[0] *= fsig(__uint_as_float(gg.z << 16)); v1[1] *= fsig(__uint_as_float(gg.z & 0xffff0000u)); v1[2] *= fsig(__uint_as_float(gg.w << 16)); v1[3] *= fsig(__uint_as_float(gg.w & 0xffff0000u));
                        if (SECOND == 0) { float* tp = T + row * DM + col; *(f32x4*)tp = v0; *(f32x4*)(tp + 4) = v1; }
                        else { v0 += t0[mm][bj]; v1 += t1[mm][bj];
                            u32x4 w; w.x = cvt_pk_bf16(v0[0], v0[1]); w.y = cvt_pk_bf16(v0[2], v0[3]); w.z = cvt_pk_bf16(v1[0], v1[1]); w.w = cvt_pk_bf16(v1[2], v1[3]);
                            *(u32x4*)(O + row * DM + col) = w; } }
            }
    }
};
struct EpiResid {
    static constexpr bool PERM = false, AFTER_DRAIN = false;
    const float* x; const float* gt; float* X1;
    DI void operator()(const f32x4 (&acc)[2][2][4][2], const Unit& u, int wr, int wc, int fr, int fq) const {
        const int row0 = u.pm * BM + wr * 64 + fr, col0 = u.pn * BM + wc * 32 + 4 * fq;
        f32x4 gv[2][2];
#pragma unroll
        for (int bj = 0; bj < 2; ++bj)
#pragma unroll
            for (int n = 0; n < 2; ++n) gv[bj][n] = *(const f32x4*)(gt + col0 + bj * HALF + n * 16);
#pragma unroll
        for (int ai = 0; ai < 2; ++ai)
#pragma unroll
            for (int mp = 0; mp < 2; ++mp) {
                f32x4 xv[2][2][2];
#pragma unroll
                for (int mm = 0; mm < 2; ++mm)
#pragma unroll
                    for (int bj = 0; bj < 2; ++bj)
#pragma unroll
                        for (int n = 0; n < 2; ++n) xv[mm][bj][n] = *(const f32x4*)(x + (size_t)(row0 + ai * HALF + (2 * mp + mm) * 16) * DM + col0 + bj * HALF + n * 16);
#pragma unroll
                for (int mm = 0; mm < 2; ++mm)
#pragma unroll
                    for (int bj = 0; bj < 2; ++bj)
#pragma unroll
                        for (int n = 0; n < 2; ++n) *(f32x4*)(X1 + (size_t)(row0 + ai * HALF + (2 * mp + mm) * 16) * DM + col0 + bj * HALF + n * 16) = xv[mm][bj][n] + gv[bj][n] * acc[ai][bj][2 * mp + mm][n];
            }
    }
};
struct EpiSwiglu {
    static constexpr bool PERM = true, AFTER_DRAIN = false;
    unsigned char* ACT; const float* bgu;
    DI void operator()(const f32x4 (&acc)[2][2][4][2], const Unit& u, int wr, int wc, int fr, int fq) const {
        const int row0 = u.pm * BM + wr * 64 + fr, gcol = u.pn * HALF + wc * 32 + 8 * fq;
        const float* bb = bgu + (size_t)u.e * 2048 + gcol;
        f32x4 bg[2], bu[2];
#pragma unroll
        for (int n = 0; n < 2; ++n) { bg[n] = *(const f32x4*)(bb + 4 * n); bu[n] = *(const f32x4*)(bb + 1024 + 4 * n); }
#pragma unroll
        for (int ai = 0; ai < 2; ++ai)
#pragma unroll
            for (int m = 0; m < 4; ++m) { float r[8];
#pragma unroll
                for (int n = 0; n < 2; ++n)
#pragma unroll
                    for (int j = 0; j < 4; ++j) { float g = acc[ai][0][m][n][j] * (1.f / WSCALE) + bg[n][j], up = acc[ai][1][m][n][j] * (1.f / WSCALE) + bu[n][j];
                        g = fminf(g, 7.f); up = fminf(fmaxf(up, -7.f), 7.f);
                        r[4 * n + j] = ASCALE * (up + 1.f) * (g * fsig(1.702f * g)); }
                u32x2 w; w.x = cvt_f8x4(r[0], r[1], r[2], r[3]); w.y = cvt_f8x4(r[4], r[5], r[6], r[7]);
                *(u32x2*)(ACT + (size_t)(row0 + ai * HALF + m * 16) * DM + gcol) = w; }
    }
};
}


namespace fox {
typedef float f32x16 __attribute__((ext_vector_type(16)));
typedef short s16x4 __attribute__((ext_vector_type(4)));
constexpr float SCALE = 0.08838834764831845f;
constexpr int KVBLK = 64, SHM_K = 16384, SHM_V = 16384;
constexpr int OFF_V = 0, OFF_K = 2 * SHM_V, OFF_G = OFF_K + 2 * SHM_K, OFF_WS = OFF_G + 512, OFF_MISC = OFF_WS + 8 * 256;
constexpr float THR = 8.f;
#define KSWZ(row, colB) ((row) * 256 + ((colB) ^ (((row) & 7) << 4)))
#define SBAR() __builtin_amdgcn_sched_barrier(0)
DI int v_st(int k, int c) { const int kk = (k & ~0xC) | ((k & 4) << 1) | ((k & 8) >> 1); return ((kk >> 3) * 4 + (c >> 5)) * 512 + ((kk & 7) * 32 + (c & 31)) * 2; }
DI int v_rd_base(int lane) { return ((lane & 3) << 3) | (((lane >> 2) & 3) << 6) | (((lane >> 4) & 1) << 5) | (((lane >> 5) & 1) << 8); }
constexpr int v_rd_off(int d0, int ks, int half) { return d0 * 512 + ks * 4096 + half * 2048; }
DI int crow(int r, int hi) { return (r & 3) + 8 * (r >> 2) + 4 * hi; }
DI unsigned cvtpk(float lo, float hi) { return cvt_pk(lo, hi); }
DI void mask_tile(f32x16& p0, f32x16& p1, int dq) {
    const float NEG = -__builtin_inff();
#pragma unroll
    for (int r = 0; r < 16; ++r) { const int c = (r & 3) + 8 * (r >> 2); if (dq - c < 0) p0[r] = NEG; if (dq - c - 32 < 0) p1[r] = NEG; }
}
DI void partialSM(f32x16& p0, f32x16& p1, float& m_reg, float& mn, float& alpha) {
    float pmax = p0[0];
#pragma unroll
    for (int r = 1; r < 16; ++r) pmax = fmaxf(pmax, p0[r]);
#pragma unroll
    for (int r = 0; r < 16; ++r) pmax = fmaxf(pmax, p1[r]);
    { auto rr = __builtin_amdgcn_permlane32_swap(__float_as_uint(pmax), __float_as_uint(pmax), false, false); pmax = fmaxf(__uint_as_float(rr[0]), __uint_as_float(rr[1])); }
    constexpr float C2 = 1.4426950408889634f * SCALE;
    if (__builtin_expect(__all((pmax - m_reg) * SCALE <= THR), 1)) { mn = m_reg; alpha = 1.f; }
    else { mn = fmaxf(m_reg, pmax); alpha = __builtin_amdgcn_exp2f((m_reg - mn) * C2); m_reg = mn; }
    const float mnL = -mn * C2;
#pragma unroll
    for (int r = 0; r < 16; ++r) p0[r] = fmaf(p0[r], C2, mnL);
#pragma unroll
    for (int r = 0; r < 16; ++r) p1[r] = fmaf(p1[r], C2, mnL);
#pragma unroll
    for (int r = 0; r < 16; ++r) p0[r] = __builtin_amdgcn_exp2f(p0[r]);
}
DI void finishSM(f32x16& p0, f32x16& p1, float alpha, float& l_reg, bf16x8& pa0, bf16x8& pa1, bf16x8& pa2, bf16x8& pa3) {
#pragma unroll
    for (int r = 0; r < 16; ++r) p1[r] = __builtin_amdgcn_exp2f(p1[r]);
    float ps = 0;
#pragma unroll
    for (int r = 0; r < 16; ++r) ps += p0[r];
#pragma unroll
    for (int r = 0; r < 16; ++r) ps += p1[r];
    { auto rr = __builtin_amdgcn_permlane32_swap(__float_as_uint(ps), __float_as_uint(ps), false, false); ps = __uint_as_float(rr[0]) + __uint_as_float(rr[1]); }
    l_reg = l_reg * alpha + ps;
#define PK4(P, B_, OUT) do { unsigned a0 = cvtpk(P[B_+0], P[B_+1]), a1 = cvtpk(P[B_+2], P[B_+3]);                          \
        unsigned b0 = cvtpk(P[B_+4], P[B_+5]), b1 = cvtpk(P[B_+6], P[B_+7]);                                             \
        auto r0 = __builtin_amdgcn_permlane32_swap(a0, b0, false, false); auto r1 = __builtin_amdgcn_permlane32_swap(a1, b1, false, false); \
        u32x4 w = {r0[0], r1[0], r0[1], r1[1]}; OUT = *reinterpret_cast<bf16x8*>(&w); } while (0)
    PK4(p0, 0, pa0); PK4(p0, 8, pa1); PK4(p1, 0, pa2); PK4(p1, 8, pa3);
#undef PK4
}
DI void qkt(f32x16& p0, f32x16& p1, const char* Kb, int r32, int hi, const bf16x8* qr) {
    p0 = f32x16{}; p1 = f32x16{};
    const char* kb[4];
#pragma unroll
    for (int dd = 0; dd < 4; ++dd) kb[dd] = Kb + KSWZ(r32, (dd * 16 + hi * 8) * 2);
#pragma unroll
    for (int d0 = 0; d0 < 8; ++d0) { const char* a = kb[d0 & 3] + (d0 >> 2) * 128;
        bf16x8 b0 = *reinterpret_cast<const bf16x8*>(a);
        bf16x8 b1 = *reinterpret_cast<const bf16x8*>(a + 32 * 256);
        p0 = __builtin_amdgcn_mfma_f32_32x32x16_bf16(b0, qr[d0], p0, 0, 0, 0);
        p1 = __builtin_amdgcn_mfma_f32_32x32x16_bf16(b1, qr[d0], p1, 0, 0, 0); }
}
DI void pv_tile(f32x16* o, int vb0, bf16x8 pa0, bf16x8 pa1, bf16x8 pa2, bf16x8 pa3) {
#define TRRD(dst, off) asm volatile("ds_read_b64_tr_b16 %0, %1 offset:%2" : "=&v"(dst) : "v"(vb0), "i"(off) : "memory")
#define PV_D0(d0) do { s16x4 l0, l1, l2, l3, h0, h1, h2, h3; constexpr int b_ = v_rd_off(d0, 0, 0); \
        TRRD(l0, b_); TRRD(h0, b_ + 2048); TRRD(l1, b_ + 4096); TRRD(h1, b_ + 6144); TRRD(l2, b_ + 8192); TRRD(h2, b_ + 10240); TRRD(l3, b_ + 12288); TRRD(h3, b_ + 14336); \
        asm volatile("s_waitcnt lgkmcnt(0)" ::: "memory"); SBAR();   \
        o[d0] = __builtin_amdgcn_mfma_f32_32x32x16_bf16(pa0, (bf16x8){l0[0], l0[1], l0[2], l0[3], h0[0], h0[1], h0[2], h0[3]}, o[d0], 0, 0, 0);   \
        o[d0] = __builtin_amdgcn_mfma_f32_32x32x16_bf16(pa1, (bf16x8){l1[0], l1[1], l1[2], l1[3], h1[0], h1[1], h1[2], h1[3]}, o[d0], 0, 0, 0);   \
        o[d0] = __builtin_amdgcn_mfma_f32_32x32x16_bf16(pa2, (bf16x8){l2[0], l2[1], l2[2], l2[3], h2[0], h2[1], h2[2], h2[3]}, o[d0], 0, 0, 0);   \
        o[d0] = __builtin_amdgcn_mfma_f32_32x32x16_bf16(pa3, (bf16x8){l3[0], l3[1], l3[2], l3[3], h3[0], h3[1], h3[2], h3[3]}, o[d0], 0, 0, 0); } while (0)
    PV_D0(0); PV_D0(1); PV_D0(2); PV_D0(3);
#undef PV_D0
#undef TRRD
}
DI void fox_block(const Args& a, char* lds, int h, int P0, int j_lo) {
    const int tid = threadIdx.x, wid = __builtin_amdgcn_readfirstlane(tid >> 6), lane = tid & 63, r32 = lane & 31, hi = lane >> 5;
    const bf16_t* P = (const bf16_t*)(a.ws + WS_PROJ); const float* F = (const float*)(a.ws + WS_F) + (size_t)h * SEQ; bf16_t* OB = (bf16_t*)(a.ws + WS_OB);
    const bf16_t* Qp = P + PJ_FQ + h * 128; const bf16_t* Kp = P + PJ_FK + h * 128; const bf16_t* Vp = P + PJ_FV + h * 128;
    const int j_hi = (P0 + 255) / KVBLK + 1, NT = j_hi - j_lo;
    const int qlo = P0 + wid * 32, qm = qlo + r32 - 4 * hi;
    char* V_lds = lds + OFF_V; char* K_lds = lds + OFF_K; float* G_lds = (float*)(lds + OFF_G);
    float* wsp = (float*)(lds + OFF_WS) + wid * 64; float* li_l = wsp; float* al_l = wsp + 32;
    const int sr = tid >> 4;
    const int vb0 = (int)(unsigned)(uintptr_t)(LAS char*)V_lds + v_rd_base(lane);
    const float Fref = F[P0];
    bf16x8 qr[8];
#pragma unroll
    for (int d0 = 0; d0 < 8; ++d0) qr[d0] = *(const bf16x8*)(Qp + (size_t)(qlo + r32) * NPJ + d0 * 16 + hi * 8);
    float m_reg = -1e30f, l_reg = 0.f; f32x16 o[4] = {};
    float st_g = 0.f;
    const int ksrc = (((tid & 15) * 16) ^ ((sr & 7) << 4)) >> 1;
    const int vkk = (tid >> 7) * 8 + ((tid & 31) >> 2), vkey = (vkk & ~0xC) | ((vkk & 4) << 1) | ((vkk & 8) >> 1), vcol = ((tid >> 5) & 3) * 32 + (tid & 3) * 8;
    LAS unsigned char* ldsl = (LAS unsigned char*)lds;
#define FOX_LOAD(t, bf) do { const size_t k0_ = (size_t)(j_lo + (t)) * KVBLK; \
        __builtin_amdgcn_global_load_lds((const unsigned*)(Kp + (k0_ + sr) * NPJ + ksrc), (LAS unsigned*)(ldsl + OFF_K + (bf) * SHM_K + wid * 1024), 16, 0, 0); \
        __builtin_amdgcn_global_load_lds((const unsigned*)(Kp + (k0_ + 32 + sr) * NPJ + ksrc), (LAS unsigned*)(ldsl + OFF_K + (bf) * SHM_K + 8192 + wid * 1024), 16, 0, 0); \
        __builtin_amdgcn_global_load_lds((const unsigned*)(Vp + (k0_ + vkey) * NPJ + vcol), (LAS unsigned*)(ldsl + OFF_V + (bf) * SHM_V + wid * 1024), 16, 0, 0); \
        __builtin_amdgcn_global_load_lds((const unsigned*)(Vp + (k0_ + 32 + vkey) * NPJ + vcol), (LAS unsigned*)(ldsl + OFF_V + (bf) * SHM_V + 8192 + wid * 1024), 16, 0, 0); \
        if (tid < 64) st_g = F[k0_ + tid]; } while (0)
#define FOX_WRITE(bf) do { if (tid < 64) G_lds[(bf) * 64 + tid] = (st_g - Fref) * (1.f / SCALE); } while (0)
    FOX_LOAD(0, 0); asm volatile("s_waitcnt vmcnt(0)" ::: "memory"); FOX_WRITE(0);
    __syncthreads();
    for (int t = 0; t < NT; ++t) {
        const int bf = t & 1, kb_ = (j_lo + t) * KVBLK;
        if (t + 1 < NT) FOX_LOAD(t + 1, bf ^ 1);
        if (kb_ <= qlo + 31) {
            f32x16 p0, p1; float mn, al; bf16x8 pa0, pa1, pa2, pa3;
            qkt(p0, p1, K_lds + bf * SHM_K, r32, hi, qr);
            const float* gt = G_lds + bf * 64 + 4 * hi;
#pragma unroll
            for (int g4 = 0; g4 < 4; ++g4) { const f32x4 g0 = *(const f32x4*)(gt + 8 * g4), g1 = *(const f32x4*)(gt + 32 + 8 * g4);
#pragma unroll
                for (int i = 0; i < 4; ++i) { p0[4 * g4 + i] -= g0[i]; p1[4 * g4 + i] -= g1[i]; } }
            if (kb_ + KVBLK - 1 > qlo) mask_tile(p0, p1, qm - kb_);
            partialSM(p0, p1, m_reg, mn, al);
            finishSM(p0, p1, al, l_reg, pa0, pa1, pa2, pa3);
            if (__any(al < 1.f)) { if (hi == 0) al_l[r32] = al; asm volatile("s_waitcnt lgkmcnt(0)" ::: "memory");
#pragma unroll
                for (int d_ = 0; d_ < 4; ++d_)
#pragma unroll
                    for (int r = 0; r < 16; ++r) o[d_][r] *= al_l[crow(r, hi)]; }
            SBAR();
            pv_tile(o, vb0 + bf * SHM_V, pa0, pa1, pa2, pa3);
        }
        if (t + 1 < NT) { asm volatile("s_waitcnt vmcnt(0)" ::: "memory"); FOX_WRITE(bf ^ 1); }
        __syncthreads();
    }
#undef FOX_LOAD
#undef FOX_WRITE
    if (hi == 0) li_l[r32] = l_reg;
    asm volatile("s_waitcnt lgkmcnt(0)" ::: "memory");
    bf16_t* Ow = OB + (size_t)qlo * 512 + h * 128;
#pragma unroll
    for (int r = 0; r < 16; ++r) { const int orow = crow(r, hi); const float rl = __builtin_amdgcn_rcpf(li_l[orow]);
#pragma unroll
        for (int d0 = 0; d0 < 4; ++d0) { const float v = o[d0][r] * rl; const float vn = __shfl_xor(v, 1);
            if ((r32 & 1) == 0) *(unsigned*)(Ow + (size_t)orow * 512 + d0 * 32 + r32) = cvtpk(v, vn); } }
    __syncthreads();
}
#undef KSWZ
}

DI void transpose_tile(float* tile, const float* src, int ld, int k0, int c0, int c1, bf16_t* dst, int Kd) {
    const int tid = threadIdx.x, nn = tid & 63, k8 = tid >> 6; const int col = nn < 32 ? c0 + nn : c1 + nn - 32;
    const float* s = src + (size_t)(k0 + k8 * 8) * ld + col;
    float v[8];
#pragma unroll
    for (int i = 0; i < 8; ++i) v[i] = s[(size_t)i * ld];
    u32x4 w; w.x = cvt_pk(v[0], v[1]); w.y = cvt_pk(v[2], v[3]); w.z = cvt_pk(v[4], v[5]); w.w = cvt_pk(v[6], v[7]);
    *(u32x4*)(dst + (size_t)nn * Kd + k0 + k8 * 8) = w;
}
DI void transpose_quad(char* lds, int& par, const float* src, int ld, int k0, int c0, int c1, unsigned char* dst, int Kd) {
    const int tid = threadIdx.x, nn = tid & 63, k8 = tid >> 6; const int col = nn < 32 ? c0 + nn : c1 + nn - 32;
    const float* s = src + (size_t)(k0 + k8 * 8) * ld + col;
    float v[4][8];
#pragma unroll
    for (int kk = 0; kk < 4; ++kk)
#pragma unroll
        for (int i = 0; i < 8; ++i) v[kk][i] = s[(size_t)(kk * 64 + i) * ld];
    char* tile = lds + par * 17408; par ^= 1;
#pragma unroll
    for (int kk = 0; kk < 4; ++kk) { u32x2 w; w.x = cvt_f8x4(v[kk][0] * WSCALE, v[kk][1] * WSCALE, v[kk][2] * WSCALE, v[kk][3] * WSCALE); w.y = cvt_f8x4(v[kk][4] * WSCALE, v[kk][5] * WSCALE, v[kk][6] * WSCALE, v[kk][7] * WSCALE);
        *(u32x2*)(tile + nn * 272 + kk * 64 + k8 * 8) = w; }
    __syncthreads();
    const int rn = tid >> 3, ch = tid & 7;
#pragma unroll
    for (int q = 0; q < 2; ++q) *(u32x4*)(dst + (size_t)rn * Kd + k0 + (ch + 8 * q) * 16) = *(const u32x4*)(tile + rn * 272 + (ch + 8 * q) * 16);
}
constexpr int Q_WGU = 32 * 32 * 4, Q_WD = 32 * 16 * 4;
DI void conv_quad_gu(const Args& a, char* lds, int& par, int r) { const int e = r / 128, q = r % 128, nt = q / 4, kt = q % 4, n0 = nt * 64;
    transpose_quad(lds, par, a.in[I_WGU] + (size_t)e * DM * 2048, 2048, kt * 256, gu_src(n0), gu_src(n0 + 32), (unsigned char*)(a.ws + WS_WGUT) + ((size_t)e * 2048 + n0) * DM, DM); }
DI void conv_quad_d(const Args& a, char* lds, int& par, int r) { const int e = r / 64, q = r % 64, nt = q / 4, kt = q % 4, n0 = nt * 64;
    transpose_quad(lds, par, a.in[I_WD] + (size_t)e * DM * DM, DM, kt * 256, n0, n0 + 32, (unsigned char*)(a.ws + WS_WDT) + ((size_t)e * DM + n0) * DM, DM); }
constexpr int T_WIN = 88 * 16, T_WOA = 16 * 8, T_WOUT = 16 * 16, T_WGU = 32 * 32 * 16, T_WD = 32 * 16 * 16;
constexpr int T_SMALL = T_WIN + 2 * T_WOA + T_WOUT;
DI void conv_tile(const Args& a, float* lds, int t) {
    unsigned char* ws = a.ws; int r = t;
    if (r < T_WIN) { const int nt = r / 16, kt = r % 16, n0 = nt * 64; const int c0 = n0 + (n0 >= 3584 ? 12 : (n0 >= 2048 ? 8 : 0));
        transpose_tile(lds, a.in[I_WIN], NIN, kt * 64, c0, c0 + 32, (bf16_t*)(ws + WS_WINT) + (size_t)n0 * DM, DM); return; }
    r -= T_WIN;
    if (r < T_WOA) { const int nt = r / 8, kt = r % 8, n0 = nt * 64; transpose_tile(lds, a.in[I_WOD], DM, kt * 64, n0, n0 + 32, (bf16_t*)(ws + WS_WOAT) + (size_t)n0 * 512, 512); return; }
    r -= T_WOA;
    if (r < T_WOA) { const int nt = r / 8, kt = r % 8, n0 = nt * 64; transpose_tile(lds, a.in[I_WOF], DM, kt * 64, n0, n0 + 32, (bf16_t*)(ws + WS_WOBT) + (size_t)n0 * 512, 512); return; }
    r -= T_WOA;
    if (r < T_WOUT) { const int nt = r / 16, kt = r % 16, n0 = nt * 64; transpose_tile(lds, a.in[I_WOUT], DM, kt * 64, n0, n0 + 32, (bf16_t*)(ws + WS_WOUTT) + (size_t)n0 * DM, DM); return; }
    r -= T_WOUT;
    if (r < T_WGU) { const int e = r / 512, q = r % 512, nt = q / 16, kt = q % 16, n0 = nt * 64;
        transpose_tile(lds, a.in[I_WGU] + (size_t)e * DM * 2048, 2048, kt * 64, gu_src(n0), gu_src(n0 + 32), (bf16_t*)(ws + WS_WGUT) + ((size_t)e * 2048 + n0) * DM, DM); return; }
    r -= T_WGU;
    { const int e = r / 256, q = r % 256, nt = q / 16, kt = q % 16, n0 = nt * 64;
        transpose_tile(lds, a.in[I_WD] + (size_t)e * DM * DM, DM, kt * 64, n0, n0 + 32, (bf16_t*)(ws + WS_WDT) + ((size_t)e * DM + n0) * DM, DM); }
}
DI void ph0(const Args& a, float* lds) {
    const int tid = threadIdx.x, G = gridDim.x, bx = blockIdx.x;
    unsigned char* ws = a.ws;
    for (int grp = bx; grp < 256; grp += G) {
        const int col = tid % 24, ks = tid / 24, j = grp * 24 + col; const float* c = a.in[I_C]; const float* w = a.in[I_WADA];
        float acc = 0.f;
        if (ks < 21) { const int k1 = (ks * 49 + 49) < DM ? (ks * 49 + 49) : DM; for (int k = ks * 49; k < k1; ++k) acc += c[k] * w[(size_t)k * 6144 + j]; }
        __syncthreads();
        if (ks < 21) lds[ks * 24 + col] = acc;
        __syncthreads();
        if (tid < 24) { float s = a.in[I_BADA][grp * 24 + tid]; for (int q = 0; q < 21; ++q) s += lds[q * 24 + tid]; ((float*)(ws + WS_MOD))[grp * 24 + tid] = s; }
    }
    for (int t = bx; t < T_SMALL; t += G) conv_tile(a, lds, t);
}

DI void ph1(const Args& a, float* lds) {
    const int tid = threadIdx.x, lane = tid & 63, wave = tid >> 6, G = gridDim.x;
    float* A1 = lds; float* B1 = lds + 1024; float* wsm = lds + 2048;
    const float* mod = (const float*)(a.ws + WS_MOD);
    for (int k = tid; k < DM; k += NTHREADS) { A1[k] = a.in[I_G1][k] * (1.f + mod[1024 + k]); B1[k] = mod[k]; }
    for (int i = tid; i < 12 * DM; i += NTHREADS) { const int k = i / 12, j = i % 12; wsm[j * DM + k] = a.in[I_WIN][(size_t)k * NIN + (j < 8 ? 2048 + j : 3592 + (j - 8))]; }
    __syncthreads();
    bf16_t* H = (bf16_t*)(a.ws + WS_H); float* SP = (float*)(a.ws + WS_SP);
    for (int t0 = (blockIdx.x * NWAVES + wave) * 2; t0 < SEQ; t0 += G * NWAVES * 2) {
        f32x4 v[2][4]; float ss[2] = {0.f, 0.f};
#pragma unroll
        for (int q = 0; q < 2; ++q)
#pragma unroll
            for (int i = 0; i < 4; ++i) v[q][i] = *(const f32x4*)(a.in[I_X] + (size_t)(t0 + q) * DM + lane * 4 + 256 * i);
#pragma unroll
        for (int q = 0; q < 2; ++q)
#pragma unroll
            for (int i = 0; i < 4; ++i) ss[q] += v[q][i][0] * v[q][i][0] + v[q][i][1] * v[q][i][1] + v[q][i][2] * v[q][i][2] + v[q][i][3] * v[q][i][3];
        ss[0] = wave_sum(ss[0]); ss[1] = wave_sum(ss[1]);
#pragma unroll
        for (int q = 0; q < 2; ++q) { const float rstd = rsqrtf(ss[q] * (1.f / DM) + 1e-6f);
#pragma unroll
            for (int i = 0; i < 4; ++i) { const int k = lane * 4 + 256 * i;
#pragma unroll
                for (int e = 0; e < 4; ++e) v[q][i][e] = v[q][i][e] * rstd * A1[k + e] + B1[k + e];
                u32x2 w; w.x = cvt_pk(v[q][i][0], v[q][i][1]); w.y = cvt_pk(v[q][i][2], v[q][i][3]);
                *(u32x2*)(H + (size_t)(t0 + q) * DM + k) = w; } }
#pragma unroll 1
        for (int j = 0; j < 12; ++j) { float p0 = 0.f, p1 = 0.f;
#pragma unroll
            for (int i = 0; i < 4; ++i) { const f32x4 wv = *(const f32x4*)(wsm + j * DM + lane * 4 + 256 * i);
                p0 += v[0][i][0] * wv[0] + v[0][i][1] * wv[1] + v[0][i][2] * wv[2] + v[0][i][3] * wv[3];
                p1 += v[1][i][0] * wv[0] + v[1][i][1] * wv[1] + v[1][i][2] * wv[2] + v[1][i][3] * wv[3]; }
            p0 = wave_sum(p0); p1 = wave_sum(p1); if (lane == j) { SP[(size_t)t0 * 16 + j] = p0; SP[(size_t)(t0 + 1) * 16 + j] = p1;
                if (j >= 8) { float* LF = (float*)(a.ws + WS_LF) + (size_t)(j - 8) * SEQ; LF[t0] = p0; LF[t0 + 1] = p1; } } }
    }
}

DI void ph2(const Args& a, unsigned char* ldsb) {
    pg8::Gemm g{(const bf16_t*)(a.ws + WS_H), (const bf16_t*)(a.ws + WS_WINT), SEQ, NPJ, DM};
    pg8::OrderDense S; S.init(SEQ / 256, NPJ / 256, (int)gridDim.x, (int)blockIdx.x);
    pg8::EpiStoreBf16 E{(bf16_t*)(a.ws + WS_PROJ), NPJ, nullptr, 0, 1.f};
    pg8::gemm_phase<pg8::EpiStoreBf16, pg8::OrderDense>((LAS unsigned char*)ldsb, g, S, E);
}

DI void ph3_fcum(const Args& a, float* lds) {
    const int tid = threadIdx.x, lane = tid & 63, wave = tid >> 6, h = blockIdx.x;
    const float* LF = (const float*)(a.ws + WS_LF) + (size_t)h * SEQ + tid * 32; float* F = (float*)(a.ws + WS_F);
    const float bf = a.in[I_BFG][h];
    double* wtot = (double*)lds;
    float lf[32];
#pragma unroll
    for (int i = 0; i < 8; ++i) { const f32x4 x = *(const f32x4*)(LF + 4 * i); lf[4 * i] = x[0]; lf[4 * i + 1] = x[1]; lf[4 * i + 2] = x[2]; lf[4 * i + 3] = x[3]; }
    double s = 0.0;
#pragma unroll
    for (int i = 0; i < 32; ++i) { lf[i] = logsigf(lf[i] + bf); s += (double)lf[i]; }
    double inc = s;
#pragma unroll
    for (int o_ = 1; o_ < 64; o_ <<= 1) { const double y = __shfl_up(inc, o_); if (lane >= o_) inc += y; }
    __syncthreads();
    if (lane == 63) wtot[wave] = inc;
    __syncthreads();
    double off = inc - s;
    for (int w = 0; w < wave; ++w) off += wtot[w];
#pragma unroll
    for (int i = 0; i < 32; ++i) { off += (double)lf[i]; lf[i] = (float)off; }
#pragma unroll
    for (int i = 0; i < 8; ++i) *(f32x4*)(F + (size_t)h * SEQ + tid * 32 + 4 * i) = (f32x4){lf[4 * i], lf[4 * i + 1], lf[4 * i + 2], lf[4 * i + 3]};
    __syncthreads();
}
namespace prep {
constexpr int QS = 0, KS = 17408, KT = 34816, VT = 53248, UNIT = 71680, SM = 2 * UNIT;
DI bf16x8 ld8(const char* p) { return *(const bf16x8*)p; }
template <int C, int M4> struct TRow { static DI void run(const float (&T)[64], const float* Ls, float& a0, float& a1) {
    if constexpr (4 * M4 < C) { const f32x4 Lv = *(const f32x4*)(Ls + C * 68 + 4 * M4);
        a0 -= Lv[0] * T[4 * M4]; if constexpr (4 * M4 + 1 < C) a1 -= Lv[1] * T[4 * M4 + 1]; if constexpr (4 * M4 + 2 < C) a0 -= Lv[2] * T[4 * M4 + 2]; if constexpr (4 * M4 + 3 < C) a1 -= Lv[3] * T[4 * M4 + 3];
        TRow<C, M4 + 1>::run(T, Ls, a0, a1); } } };
template <int C> struct TRow<C, 16> { static DI void run(const float (&)[64], const float*, float&, float&) {} };
template <int C> DI void tsolve(float (&T)[64], const float* Ls, int lane) {
    if constexpr (C < 64) { float a0 = (lane == C) ? 1.f : 0.f, a1 = 0.f; TRow<C, 0>::run(T, Ls, a0, a1); T[C] = a0 + a1; asm volatile("" ::: "memory"); __builtin_amdgcn_sched_barrier(0); tsolve<C + 1>(T, Ls, lane); } }
}
DI void ph3_prep2(const Args& a, char* lds, int pair) {
    using namespace prep;
    const int tid = threadIdx.x, lane = tid & 63, wave = tid >> 6, grp = wave >> 2, wq = wave & 3, tg = tid & 255, lr = lane & 15, lq = lane >> 4;
    int unit = pair * 2 + grp; if (unit >= NH * NCH) unit = NH * NCH - 1;
    const int h = unit & 3, n = unit >> 2, t0 = n * CH;
    char* U = lds + grp * UNIT;
    float* gcs = (float*)(lds + SM) + grp * 192; float* bes = gcs + 64; float* egs = gcs + 128;
    const float* SP = (const float*)(a.ws + WS_SP); const bf16_t* P = (const bf16_t*)(a.ws + WS_PROJ);
    const size_t cb = (size_t)(h * NCH + n);
    bf16_t* WF = (bf16_t*)(a.ws + WS_DNW) + cb * 8192; bf16_t* UF = (bf16_t*)(a.ws + WS_DNU) + cb * 8192;
    bf16_t* QF = (bf16_t*)(a.ws + WS_DNQD) + cb * 8192; bf16_t* KF = (bf16_t*)(a.ws + WS_DNKD) + cb * 8192; bf16_t* AF = (bf16_t*)(a.ws + WS_DNATT) + cb * 4096;
    __syncthreads();
    if (wq == 0) { const int t = t0 + lane;
        const float be = sigm(SP[(size_t)t * 16 + h]);
        float g = -expf(a.in[I_ALOG][h]) * softplusf(SP[(size_t)t * 16 + 4 + h] + a.in[I_DTB][h]);
#pragma unroll
        for (int o_ = 1; o_ < 64; o_ <<= 1) { const float y = __shfl_up(g, o_); if (lane >= o_) g += y; }
        gcs[lane] = g; bes[lane] = be; egs[lane] = expf(g); }
    __syncthreads();
    { const int d8 = tg & 15, ci = tg >> 4; const float* cw = a.in[I_CONVW];
#pragma unroll 1
        for (int sec = 0; sec < 3; ++sec) {
            const int col = sec * 512 + h * 128 + d8 * 8;
            f32x4 w[4][2];
#pragma unroll
            for (int j = 0; j < 4; ++j) { w[j][0] = *(const f32x4*)(cw + j * 1536 + col); w[j][1] = *(const f32x4*)(cw + j * 1536 + col + 4); }
#pragma unroll 1
          for (int ih = 0; ih < 2; ++ih) {
            u32x4 xin[2][4];
#pragma unroll
            for (int i = 0; i < 2; ++i)
#pragma unroll
                for (int j = 0; j < 4; ++j) { int tt = t0 + ci + 16 * (2 * ih + i) - 3 + j; tt = tt < 0 ? 0 : tt; xin[i][j] = *(const u32x4*)(P + (size_t)tt * NPJ + col); }
#pragma unroll
            for (int i = 0; i < 2; ++i) { const int c = ci + 16 * (2 * ih + i), t = t0 + c;
                float v[8];
#pragma unroll
                for (int e = 0; e < 8; ++e) v[e] = 0.f;
#pragma unroll
                for (int j = 0; j < 4; ++j) { const float ok = (t - 3 + j >= 0) ? 1.f : 0.f; const u32x4 x = xin[i][j];
                    v[0] += ok * w[j][0][0] * __uint_as_float(x.x << 16); v[1] += ok * w[j][0][1] * __uint_as_float(x.x & 0xffff0000u); v[2] += ok * w[j][0][2] * __uint_as_float(x.y << 16); v[3] += ok * w[j][0][3] * __uint_as_float(x.y & 0xffff0000u);
                    v[4] += ok * w[j][1][0] * __uint_as_float(x.z << 16); v[5] += ok * w[j][1][1] * __uint_as_float(x.z & 0xffff0000u); v[6] += ok * w[j][1][2] * __uint_as_float(x.w << 16); v[7] += ok * w[j][1][3] * __uint_as_float(x.w & 0xffff0000u); }
                float ss = 0.f;
#pragma unroll
                for (int e = 0; e < 8; ++e) { v[e] = siluf(v[e]); ss += v[e] * v[e]; }
                if (sec < 2) { ss += __shfl_xor(ss, 1); ss += __shfl_xor(ss, 2); ss += __shfl_xor(ss, 4); ss += __shfl_xor(ss, 8);
                    const float sc = rsqrtf(ss + 1e-6f) * (sec == 0 ? 0.08838834764831845f : 1.f);
#pragma unroll
                    for (int e = 0; e < 8; ++e) v[e] *= sc; }
                u32x4 pk; pk.x = cvt_pk(v[0], v[1]); pk.y = cvt_pk(v[2], v[3]); pk.z = cvt_pk(v[4], v[5]); pk.w = cvt_pk(v[6], v[7]);
                if (sec == 0) { *(u32x4*)(U + QS + c * 272 + d8 * 16) = pk;
                    const float eg = egs[c];
                    const int base = (((c >> 4) * 4 + (d8 >> 2)) * 64 + (c & 15)) * 8 + 4 * ((d8 & 3) >> 1), l0 = (2 * (d8 & 3)) & 3;
                    u32x2 q0, q1; q0.x = cvt_pk(v[0] * eg, v[1] * eg); q0.y = cvt_pk(v[2] * eg, v[3] * eg); q1.x = cvt_pk(v[4] * eg, v[5] * eg); q1.y = cvt_pk(v[6] * eg, v[7] * eg);
                    *(u32x2*)(QF + base + l0 * 128) = q0; *(u32x2*)(QF + base + (l0 + 1) * 128) = q1; }
                else { if (sec == 1) *(u32x4*)(U + KS + c * 272 + d8 * 16) = pk;
                    bf16_t* T_ = (bf16_t*)(U + (sec == 1 ? KT : VT)) + (d8 * 8) * 72 + c;
                    T_[0 * 72] = (bf16_t)(pk.x & 0xffffu); T_[1 * 72] = (bf16_t)(pk.x >> 16); T_[2 * 72] = (bf16_t)(pk.y & 0xffffu); T_[3 * 72] = (bf16_t)(pk.y >> 16);
                    T_[4 * 72] = (bf16_t)(pk.z & 0xffffu); T_[5 * 72] = (bf16_t)(pk.z >> 16); T_[6 * 72] = (bf16_t)(pk.w & 0xffffu); T_[7 * 72] = (bf16_t)(pk.w >> 16); }
            }
          }
        }
    }
    __syncthreads();
    f32x4 Lr[4];
    { const int mt = wq;
#pragma unroll
        for (int nt = 0; nt < 4; ++nt) { Lr[nt] = (f32x4){0.f, 0.f, 0.f, 0.f};
            if (nt <= mt) {
#pragma unroll
                for (int s = 0; s < 4; ++s) Lr[nt] = MFMA16(ld8(U + KS + (16 * mt + lr) * 272 + (32 * s + 8 * lq) * 2), ld8(U + KS + (16 * nt + lr) * 272 + (32 * s + 8 * lq) * 2), Lr[nt]); } }
        const int ntq = 3 - wq; const float gcc = gcs[16 * ntq + lr];
#pragma unroll
        for (int mtk = 0; mtk < 4; ++mtk) { f32x4 acc = (f32x4){0.f, 0.f, 0.f, 0.f};
            if (mtk <= ntq) {
#pragma unroll
                for (int s = 0; s < 4; ++s) acc = MFMA16(ld8(U + KS + (16 * mtk + lr) * 272 + (32 * s + 8 * lq) * 2), ld8(U + QS + (16 * ntq + lr) * 272 + (32 * s + 8 * lq) * 2), acc);
#pragma unroll
                for (int r = 0; r < 4; ++r) { const int m = 16 * mtk + 4 * lq + r, c = 16 * ntq + lr; acc[r] = (m <= c) ? acc[r] * expf(gcc - gcs[m]) : 0.f; } }
            u32x2 o_; o_.x = cvt_pk(acc[0], acc[1]); o_.y = cvt_pk(acc[2], acc[3]);
            *(u32x2*)(AF + ((ntq * 2 + (mtk >> 1)) * 64 + lane) * 8 + 4 * (mtk & 1)) = o_; }
    }
    __syncthreads();
    { const int mt = wq; float* LT = (float*)(U + QS);
#pragma unroll
        for (int nt = 0; nt < 4; ++nt) if (nt <= mt) { const int m = 16 * nt + lr; f32x4 o_;
#pragma unroll
            for (int r = 0; r < 4; ++r) { const int c = 16 * mt + 4 * lq + r; o_[r] = (m < c) ? bes[c] * Lr[nt][r] * expf(gcs[c] - gcs[m]) : 0.f; }
            *(f32x4*)(LT + m * 68 + 16 * mt + 4 * lq) = o_; } }
    __syncthreads();
    if (wq == 0) { const float* LT = (const float*)(U + QS); float* Tl = (float*)(U + KS);
#pragma unroll
        for (int ib = 0; ib < 4; ++ib) { float acc[16];
#pragma unroll
            for (int r = 0; r < 16; ++r) acc[r] = (lane == 16 * ib + r) ? 1.f : 0.f;
#pragma unroll 2
            for (int m = 0; m < 16 * ib; ++m) { const float t = Tl[m * 68 + lane];
#pragma unroll
                for (int q = 0; q < 4; ++q) { const f32x4 Lv = *(const f32x4*)(LT + m * 68 + 16 * ib + 4 * q);
#pragma unroll
                    for (int e = 0; e < 4; ++e) acc[4 * q + e] -= Lv[e] * t; } }
#pragma unroll
            for (int p = 0; p < 16; ++p) { const float t = acc[p]; Tl[(16 * ib + p) * 68 + lane] = t;
                if (p < 15) {
#pragma unroll
                    for (int q = 0; q < 4; ++q) if (4 * q + 3 > p) { const f32x4 Lv = *(const f32x4*)(LT + (16 * ib + p) * 68 + 16 * ib + 4 * q);
#pragma unroll
                        for (int e = 0; e < 4; ++e) if (4 * q + e > p) acc[4 * q + e] -= Lv[e] * t; } } }
            asm volatile("s_waitcnt lgkmcnt(0)" ::: "memory"); }
        if (lane == 0) ((float*)(a.ws + WS_EG))[cb] = egs[63];
    } else { const float gl = gcs[63];
        for (int i = tg - 64; i < 2048; i += 192) { const int dk = i >> 4, cq = i & 15;
            const u32x2 x = *(const u32x2*)(U + KT + dk * 144 + cq * 8);
            const float e0 = expf(gl - gcs[4 * cq]), e1 = expf(gl - gcs[4 * cq + 1]), e2 = expf(gl - gcs[4 * cq + 2]), e3 = expf(gl - gcs[4 * cq + 3]);
            u32x2 o_; o_.x = cvt_pk(__uint_as_float(x.x << 16) * e0, __uint_as_float(x.x & 0xffff0000u) * e1); o_.y = cvt_pk(__uint_as_float(x.y << 16) * e2, __uint_as_float(x.y & 0xffff0000u) * e3);
            *(u32x2*)(KF + (((dk >> 4) * 2 + (cq >> 3)) * 64 + (cq & 3) * 16 + (dk & 15)) * 8 + 4 * ((cq >> 2) & 1)) = o_; } }
    __syncthreads();
    { const float* Tl = (const float*)(U + KS); const int c = tg >> 2, m0 = (tg & 3) * 16;
        f32x4 tv[4];
#pragma unroll
        for (int q = 0; q < 4; ++q) tv[q] = *(const f32x4*)(Tl + c * 68 + m0 + 4 * q);
        __syncthreads();
        bf16_t* Tb = (bf16_t*)(U + QS); bf16_t* Tg = (bf16_t*)(U + KS);
#pragma unroll
        for (int q = 0; q < 4; ++q) { u32x2 b_, g_; float be[4], bg[4];
#pragma unroll
            for (int e = 0; e < 4; ++e) { const int m = m0 + 4 * q + e; be[e] = tv[q][e] * bes[m]; bg[e] = be[e] * egs[m]; }
            b_.x = cvt_pk(be[0], be[1]); b_.y = cvt_pk(be[2], be[3]); g_.x = cvt_pk(bg[0], bg[1]); g_.y = cvt_pk(bg[2], bg[3]);
            *(u32x2*)(Tb + c * 72 + m0 + 4 * q) = b_; *(u32x2*)(Tg + c * 72 + m0 + 4 * q) = g_; } }
    __syncthreads();
    {
#pragma unroll
        for (int q = 0; q < 2; ++q) { const int nt = 2 * wq + q;
#pragma unroll
            for (int mt = 0; mt < 4; ++mt) { f32x4 acc = (f32x4){0.f, 0.f, 0.f, 0.f};
#pragma unroll
                for (int s = 0; s < 2; ++s) acc = MFMA16(ld8(U + QS + (16 * mt + lr) * 144 + (32 * s + 8 * lq) * 2), ld8(U + VT + (16 * nt + lr) * 144 + (32 * s + 8 * lq) * 2), acc);
                u32x2 o_; o_.x = cvt_pk(acc[0], acc[1]); o_.y = cvt_pk(acc[2], acc[3]);
                *(u32x2*)(UF + ((nt * 4 + mt) * 64 + lane) * 4) = o_; } }
#pragma unroll
        for (int q = 0; q < 2; ++q) { const int mtk = 2 * wq + q;
#pragma unroll
            for (int ntc = 0; ntc < 4; ++ntc) { f32x4 acc = (f32x4){0.f, 0.f, 0.f, 0.f};
#pragma unroll
                for (int s = 0; s < 2; ++s) acc = MFMA16(ld8(U + KT + (16 * mtk + lr) * 144 + (32 * s + 8 * lq) * 2), ld8(U + KS + (16 * ntc + lr) * 144 + (32 * s + 8 * lq) * 2), acc);
                u32x2 o_; o_.x = cvt_pk(-acc[0], -acc[1]); o_.y = cvt_pk(-acc[2], -acc[3]);
                *(u32x2*)(WF + ((ntc * 4 + (mtk >> 1)) * 64 + lane) * 8 + 4 * (mtk & 1)) = o_; } }
    }
}
DI void ph3_norms(const Args& a, float* lds) {
    const int lane = threadIdx.x & 63, wave = threadIdx.x >> 6, NW = gridDim.x * NWAVES, sub = lane >> 4, l16 = lane & 15;
    const bf16_t* P = (const bf16_t*)(a.ws + WS_PROJ); float* TB = (float*)(a.ws + WS_NRMT);
    for (int grp = blockIdx.x * NWAVES + wave; grp < SEQ / 8; grp += NW) {
        float mq[4] = {0.f, 0.f, 0.f, 0.f}, mk[4] = {0.f, 0.f, 0.f, 0.f}, md[4] = {3.0e38f, 3.0e38f, 3.0e38f, 3.0e38f};
#pragma unroll
        for (int it = 0; it < 2; ++it) { const bf16_t* row = P + (size_t)(grp * 8 + it * 4 + sub) * NPJ + l16 * 8;
            u32x4 xq[4], xk[4];
#pragma unroll
            for (int h = 0; h < 4; ++h) { xq[h] = *(const u32x4*)(row + PJ_FQ + h * 128); xk[h] = *(const u32x4*)(row + PJ_FK + h * 128); }
#pragma unroll
            for (int h = 0; h < 4; ++h) { float sq = 0.f, sk = 0.f, sd = 0.f;
#pragma unroll
                for (int e = 0; e < 4; ++e) { const float a0 = __uint_as_float(xq[h][e] << 16), a1 = __uint_as_float(xq[h][e] & 0xffff0000u), b0 = __uint_as_float(xk[h][e] << 16), b1 = __uint_as_float(xk[h][e] & 0xffff0000u);
                    sq += a0 * a0 + a1 * a1; sk += b0 * b0 + b1 * b1; sd += a0 * b0 + a1 * b1; }
#pragma unroll
                for (int o_ = 1; o_ <= 8; o_ <<= 1) { sq += __shfl_xor(sq, o_); sk += __shfl_xor(sk, o_); sd += __shfl_xor(sd, o_); }
                mq[h] = fmaxf(mq[h], sq); mk[h] = fmaxf(mk[h], sk); md[h] = fminf(md[h], sd); } }
#pragma unroll
        for (int h = 0; h < 4; ++h) { mq[h] = fmaxf(mq[h], __shfl_xor(mq[h], 16)); mq[h] = fmaxf(mq[h], __shfl_xor(mq[h], 32)); mk[h] = fmaxf(mk[h], __shfl_xor(mk[h], 16)); mk[h] = fmaxf(mk[h], __shfl_xor(mk[h], 32));
            md[h] = fminf(md[h], __shfl_xor(md[h], 16)); md[h] = fminf(md[h], __shfl_xor(md[h], 32));
            if (lane == 0) { TB[grp * 12 + h] = mq[h]; TB[grp * 12 + 4 + h] = mk[h]; TB[grp * 12 + 8 + h] = md[h]; } }
    }
}
DI void ph3(const Args& a, float* lds) {
    const int G = gridDim.x;
    if (blockIdx.x < 4) ph3_fcum(a, lds);
    for (int p = blockIdx.x; p < NH * NCH / 2; p += G) ph3_prep2(a, (char*)lds, p);
    ph3_norms(a, lds);
}

namespace dn {
DI unsigned cvtpk(float lo, float hi) { return cvt_pk(lo, hi); }
DI bf16x8 packB(const f32x4& t0, const f32x4& t1) { u32x4 w = {cvtpk(t0[0], t0[1]), cvtpk(t0[2], t0[3]), cvtpk(t1[0], t1[1]), cvtpk(t1[2], t1[3])}; return *reinterpret_cast<bf16x8*>(&w); }
DI bf16x8 frag(const bf16_t* base, int f, int lane) { return *(const bf16x8*)(base + ((size_t)f * 64 + lane) * 8); }
template <bool WITH_U, bool WITH_O>
DI void step(const bf16_t* WFn, const bf16_t* KFn, const bf16_t* QFn, const bf16_t* AFn, const bf16_t* UFs, float eg, f32x4 (&S)[8], f32x4 (&o)[4], int lane) {
    bf16x8 sb[4];
#pragma unroll
    for (int s = 0; s < 4; ++s) sb[s] = packB(S[2 * s], S[2 * s + 1]);
    f32x4 vn[4];
#pragma unroll
    for (int mt = 0; mt < 4; ++mt) {
        if (WITH_U) { const u32x2 w = *(const u32x2*)(UFs + ((size_t)mt * 64 + lane) * 4); vn[mt] = (f32x4){__uint_as_float(w.x << 16), __uint_as_float(w.x & 0xffff0000u), __uint_as_float(w.y << 16), __uint_as_float(w.y & 0xffff0000u)}; }
        else vn[mt] = (f32x4){0.f, 0.f, 0.f, 0.f};
#pragma unroll
        for (int s = 0; s < 4; ++s) vn[mt] = MFMA16(frag(WFn, mt * 4 + s, lane), sb[s], vn[mt]); }
    if (WITH_O) {
#pragma unroll
        for (int mt = 0; mt < 4; ++mt) { o[mt] = (f32x4){0.f, 0.f, 0.f, 0.f};
#pragma unroll
            for (int s = 0; s < 4; ++s) o[mt] = MFMA16(frag(QFn, mt * 4 + s, lane), sb[s], o[mt]); } }
    bf16x8 vb[2];
#pragma unroll
    for (int s = 0; s < 2; ++s) vb[s] = packB(vn[2 * s], vn[2 * s + 1]);
    if (WITH_O) {
#pragma unroll
        for (int mt = 0; mt < 4; ++mt)
#pragma unroll
            for (int s = 0; s < 2; ++s) o[mt] = MFMA16(frag(AFn, mt * 2 + s, lane), vb[s], o[mt]); }
#pragma unroll
    for (int mt = 0; mt < 8; ++mt) { S[mt] = S[mt] * eg;
#pragma unroll
        for (int s = 0; s < 2; ++s) S[mt] = MFMA16(frag(KFn, mt * 2 + s, lane), vb[s], S[mt]); }
}
}
constexpr int NGRP = 16, GRP = 16;
constexpr int NSCAN = NH * NGRP;
constexpr int SBUF = 57344;
template <int N> struct Stage { u32x4 r[N]; };
DI void stage_load2(Stage<4>& st, const bf16_t* s0, const bf16_t* s1) {
    const int tid = threadIdx.x;
    st.r[0] = *(const u32x4*)(s0 + (size_t)tid * 8); st.r[1] = *(const u32x4*)(s0 + (size_t)(tid + 512) * 8);
    st.r[2] = *(const u32x4*)(s1 + (size_t)tid * 8); st.r[3] = *(const u32x4*)(s1 + (size_t)(tid + 512) * 8);
}
DI void stage_write2(const Stage<4>& st, char* buf) {
    const int tid = threadIdx.x;
    *(u32x4*)(buf + tid * 16) = st.r[0]; *(u32x4*)(buf + (tid + 512) * 16) = st.r[1];
    *(u32x4*)(buf + 16384 + tid * 16) = st.r[2]; *(u32x4*)(buf + 16384 + (tid + 512) * 16) = st.r[3];
}
DI void stage_load4(Stage<7>& st, const bf16_t* s0, const bf16_t* s1, const bf16_t* s2, const bf16_t* s3) {
    const int tid = threadIdx.x;
    st.r[0] = *(const u32x4*)(s0 + (size_t)tid * 8); st.r[1] = *(const u32x4*)(s0 + (size_t)(tid + 512) * 8);
    st.r[2] = *(const u32x4*)(s1 + (size_t)tid * 8); st.r[3] = *(const u32x4*)(s1 + (size_t)(tid + 512) * 8);
    st.r[4] = *(const u32x4*)(s2 + (size_t)tid * 8); st.r[5] = *(const u32x4*)(s2 + (size_t)(tid + 512) * 8);
    st.r[6] = *(const u32x4*)(s3 + (size_t)tid * 8);
}
DI void stage_write4(const Stage<7>& st, char* buf) {
    const int tid = threadIdx.x;
    *(u32x4*)(buf + tid * 16) = st.r[0]; *(u32x4*)(buf + (tid + 512) * 16) = st.r[1];
    *(u32x4*)(buf + 16384 + tid * 16) = st.r[2]; *(u32x4*)(buf + 16384 + (tid + 512) * 16) = st.r[3];
    *(u32x4*)(buf + 32768 + tid * 16) = st.r[4]; *(u32x4*)(buf + 32768 + (tid + 512) * 16) = st.r[5];
    *(u32x4*)(buf + 49152 + tid * 16) = st.r[6];
}
DI f32x4 u_unpack(const u32x2 w) { return (f32x4){__uint_as_float(w.x << 16), __uint_as_float(w.x & 0xffff0000u), __uint_as_float(w.y << 16), __uint_as_float(w.y & 0xffff0000u)}; }
DI void scanA_chain(const Args& a, char* lds, int chain) {
    const int tid = threadIdx.x, lane = tid & 63, vs = tid >> 6, lr = lane & 15, lq = lane >> 4;
    const int h = chain >> 4, g = chain & 15;
    f32x4 SQ[8], SP[8];
#pragma unroll
    for (int mt = 0; mt < 8; ++mt) { SQ[mt] = (f32x4){0.f, 0.f, 0.f, 0.f};
#pragma unroll
        for (int r = 0; r < 4; ++r) SP[mt][r] = (16 * mt + 4 * lq + r == 16 * vs + lr) ? 1.f : 0.f; }
    const size_t cb0 = (size_t)(h * NCH + g * GRP);
    const bf16_t* WF = (const bf16_t*)(a.ws + WS_DNW) + cb0 * 8192; const bf16_t* KF = (const bf16_t*)(a.ws + WS_DNKD) + cb0 * 8192;
    const bf16_t* UF = (const bf16_t*)(a.ws + WS_DNU) + cb0 * 8192 + (size_t)vs * 1024; const float* EG = (const float*)(a.ws + WS_EG) + cb0;
    Stage<4> st; u32x2 ucur[4], unxt[4];
    __syncthreads();
    stage_load2(st, WF, KF);
#pragma unroll
    for (int mt = 0; mt < 4; ++mt) ucur[mt] = *(const u32x2*)(UF + ((size_t)mt * 64 + lane) * 4);
    asm volatile("s_waitcnt vmcnt(0)" ::: "memory");
    stage_write2(st, lds);
    __syncthreads();
    for (int i = 0; i < GRP; ++i) {
        const char* buf = lds + (i & 1) * SBUF;
        if (i + 1 < GRP) { stage_load2(st, WF + (size_t)(i + 1) * 8192, KF + (size_t)(i + 1) * 8192);
#pragma unroll
            for (int mt = 0; mt < 4; ++mt) unxt[mt] = *(const u32x2*)(UF + (size_t)(i + 1) * 8192 + ((size_t)mt * 64 + lane) * 4); }
        const float eg = EG[i];
        const bf16_t* Wl = (const bf16_t*)buf; const bf16_t* Kl = (const bf16_t*)(buf + 16384);
        bf16x8 sbq[4], sbp[4];
#pragma unroll
        for (int s = 0; s < 4; ++s) { sbq[s] = dn::packB(SQ[2 * s], SQ[2 * s + 1]); sbp[s] = dn::packB(SP[2 * s], SP[2 * s + 1]); }
        f32x4 vq[4], vp[4];
#pragma unroll
        for (int mt = 0; mt < 4; ++mt) { vq[mt] = u_unpack(ucur[mt]); vp[mt] = (f32x4){0.f, 0.f, 0.f, 0.f};
#pragma unroll
            for (int s = 0; s < 4; ++s) { const bf16x8 f = dn::frag(Wl, mt * 4 + s, lane); vq[mt] = MFMA16(f, sbq[s], vq[mt]); vp[mt] = MFMA16(f, sbp[s], vp[mt]); } }
        bf16x8 vbq[2], vbp[2];
#pragma unroll
        for (int s = 0; s < 2; ++s) { vbq[s] = dn::packB(vq[2 * s], vq[2 * s + 1]); vbp[s] = dn::packB(vp[2 * s], vp[2 * s + 1]); }
#pragma unroll
        for (int mt = 0; mt < 8; ++mt) { SQ[mt] = SQ[mt] * eg; SP[mt] = SP[mt] * eg;
#pragma unroll
            for (int s = 0; s < 2; ++s) { const bf16x8 f = dn::frag(Kl, mt * 2 + s, lane); SQ[mt] = MFMA16(f, vbq[s], SQ[mt]); SP[mt] = MFMA16(f, vbp[s], SP[mt]); } }
        if (i + 1 < GRP) { asm volatile("s_waitcnt vmcnt(0)" ::: "memory"); stage_write2(st, lds + ((i + 1) & 1) * SBUF);
#pragma unroll
            for (int mt = 0; mt < 4; ++mt) ucur[mt] = unxt[mt]; }
        __syncthreads();
    }
    bf16_t* PG = (bf16_t*)(a.ws + WS_PG) + (size_t)chain * 16384;
#pragma unroll
    for (int mt = 0; mt < 8; ++mt)
#pragma unroll
        for (int r = 0; r < 4; ++r) PG[((mt * 4 + (vs >> 1)) * 64 + (lr >> 2) * 16 + 4 * lq + r) * 8 + 4 * (vs & 1) + (lr & 3)] = f2bf(SP[mt][r]);
    float* QG = (float*)(a.ws + WS_QG) + ((size_t)chain * 8 + vs) * 2048;
#pragma unroll
    for (int mt = 0; mt < 8; ++mt) *(f32x4*)(QG + ((size_t)mt * 64 + lane) * 4) = SQ[mt];
}
DI void scanPC_chain(const Args& a, char* lds, int chain) {
    const int tid = threadIdx.x, lane = tid & 63, vs = tid >> 6, lr = lane & 15, lq = lane >> 4;
    const int h = chain >> 4, g = chain & 15;
    f32x4 S[8];
#pragma unroll
    for (int mt = 0; mt < 8; ++mt) S[mt] = (f32x4){0.f, 0.f, 0.f, 0.f};
    __syncthreads();
    if (g > 0) {
        const bf16_t* PG = (const bf16_t*)(a.ws + WS_PG) + (size_t)(h * NGRP) * 16384; const float* QG = (const float*)(a.ws + WS_QG) + ((size_t)(h * NGRP) * 8 + vs) * 2048;
        Stage<4> P0, P1; f32x4 Q0[8], Q1[8];
#define PF_LOAD(PR, QR, j_) do { stage_load2(PR, PG + (size_t)(j_) * 16384, PG + (size_t)(j_) * 16384 + 8192); \
            _Pragma("unroll") for (int mt = 0; mt < 8; ++mt) QR[mt] = *(const f32x4*)(QG + (size_t)(j_) * 16384 + ((size_t)mt * 64 + lane) * 4); } while (0)
#define PF_STEP(j_, BUF, QC, PC, PN) do { \
            f32x4 acc_[8]; _Pragma("unroll") for (int mt = 0; mt < 8; ++mt) acc_[mt] = QC[mt]; \
            if ((j_) + 2 < g) PF_LOAD(PC, QC, (j_) + 2); \
            const bf16_t* Pl = (const bf16_t*)(lds + (BUF) * SBUF); bf16x8 sb[4]; \
            _Pragma("unroll") for (int s = 0; s < 4; ++s) sb[s] = dn::packB(S[2 * s], S[2 * s + 1]); \
            _Pragma("unroll") for (int mt = 0; mt < 8; ++mt) { f32x4 ac = acc_[mt]; \
                _Pragma("unroll") for (int s = 0; s < 4; ++s) ac = MFMA16(dn::frag(Pl, mt * 4 + s, lane), sb[s], ac); \
                S[mt] = ac; } \
            if ((j_) + 1 < g) stage_write2(PN, lds + ((BUF) ^ 1) * SBUF); \
            __syncthreads(); } while (0)
        PF_LOAD(P0, Q0, 0);
        if (g > 1) PF_LOAD(P1, Q1, 1);
        stage_write2(P0, lds);
        __syncthreads();
        for (int j = 0; j < g; j += 2) { PF_STEP(j, 0, Q0, P0, P1); if (j + 1 < g) PF_STEP(j + 1, 1, Q1, P1, P0); }
#undef PF_LOAD
#undef PF_STEP
    }
    const size_t cb0 = (size_t)(h * NCH + g * GRP);
    const bf16_t* WF = (const bf16_t*)(a.ws + WS_DNW) + cb0 * 8192; const bf16_t* KF = (const bf16_t*)(a.ws + WS_DNKD) + cb0 * 8192;
    const bf16_t* QF = (const bf16_t*)(a.ws + WS_DNQD) + cb0 * 8192; const bf16_t* AF = (const bf16_t*)(a.ws + WS_DNATT) + cb0 * 4096;
    const bf16_t* UF = (const bf16_t*)(a.ws + WS_DNU) + cb0 * 8192 + (size_t)vs * 1024; const float* EG = (const float*)(a.ws + WS_EG) + cb0;
    float* ORAW = (float*)(a.ws + WS_ORAW);
    Stage<7> R0, R1; u32x2 U0[4], U1[4];
#define PC_LOAD(RR, UU, i_) do { stage_load4(RR, WF + (size_t)(i_) * 8192, KF + (size_t)(i_) * 8192, QF + (size_t)(i_) * 8192, AF + (size_t)(i_) * 4096); \
        _Pragma("unroll") for (int mt = 0; mt < 4; ++mt) UU[mt] = *(const u32x2*)(UF + (size_t)(i_) * 8192 + ((size_t)mt * 64 + lane) * 4); } while (0)
#define PC_STEP(i_, BUF, RC, UC, RN) do { \
        const char* buf = lds + (BUF) * SBUF; const int n = g * GRP + (i_); \
        f32x4 vn[4], o[4]; \
        _Pragma("unroll") for (int mt = 0; mt < 4; ++mt) { vn[mt] = u_unpack(UC[mt]); o[mt] = (f32x4){0.f, 0.f, 0.f, 0.f}; } \
        if ((i_) + 2 < GRP) PC_LOAD(RC, UC, (i_) + 2); \
        const float eg = EG[(i_)]; \
        const bf16_t* Wl = (const bf16_t*)buf; const bf16_t* Kl = (const bf16_t*)(buf + 16384); const bf16_t* Ql = (const bf16_t*)(buf + 32768); const bf16_t* Al = (const bf16_t*)(buf + 49152); \
        bf16x8 sb[4]; \
        _Pragma("unroll") for (int s = 0; s < 4; ++s) sb[s] = dn::packB(S[2 * s], S[2 * s + 1]); \
        _Pragma("unroll") for (int mt = 0; mt < 4; ++mt) { \
            _Pragma("unroll") for (int s = 0; s < 4; ++s) { vn[mt] = MFMA16(dn::frag(Wl, mt * 4 + s, lane), sb[s], vn[mt]); o[mt] = MFMA16(dn::frag(Ql, mt * 4 + s, lane), sb[s], o[mt]); } } \
        bf16x8 vb[2]; \
        _Pragma("unroll") for (int s = 0; s < 2; ++s) vb[s] = dn::packB(vn[2 * s], vn[2 * s + 1]); \
        _Pragma("unroll") for (int mt = 0; mt < 4; ++mt) \
            _Pragma("unroll") for (int s = 0; s < 2; ++s) o[mt] = MFMA16(dn::frag(Al, mt * 2 + s, lane), vb[s], o[mt]); \
        _Pragma("unroll") for (int mt = 0; mt < 8; ++mt) { S[mt] = S[mt] * eg; \
            _Pragma("unroll") for (int s = 0; s < 2; ++s) S[mt] = MFMA16(dn::frag(Kl, mt * 2 + s, lane), vb[s], S[mt]); } \
        _Pragma("unroll") for (int mt = 0; mt < 4; ++mt) \
            _Pragma("unroll") for (int r = 0; r < 4; ++r) ORAW[(size_t)(n * CH + 16 * mt + 4 * lq + r) * 512 + h * 128 + 16 * vs + lr] = o[mt][r]; \
        if ((i_) + 1 < GRP) stage_write4(RN, lds + ((BUF) ^ 1) * SBUF); \
        __syncthreads(); } while (0)
    PC_LOAD(R0, U0, 0);
    PC_LOAD(R1, U1, 1);
    stage_write4(R0, lds);
    __syncthreads();
#pragma unroll 1
    for (int i = 0; i < GRP; i += 2) { PC_STEP(i, 0, R0, U0, R1); PC_STEP(i + 1, 1, R1, U1, R0); }
#undef PC_LOAD
#undef PC_STEP
}
DI int fox_jlo(const Args& a, int h, int qb, const float* qkbs, int lane) {
    const float* Fh = (const float*)(a.ws + WS_F) + (size_t)h * SEQ; const float* TB = (const float*)(a.ws + WS_NRMT); const int P0 = qb * 256;
    float mq = 0.f, md = 3.0e38f;
    if (lane < 32) { mq = TB[(qb * 32 + lane) * 12 + h]; md = TB[(qb * 32 + lane) * 12 + 8 + h]; }
    for (int o_ = 1; o_ < 64; o_ <<= 1) { mq = fmaxf(mq, __shfl_xor(mq, o_)); md = fminf(md, __shfl_xor(md, o_)); }
    const float qkb = sqrtf(mq * qkbs[h]) * fox::SCALE, lim = Fh[P0] + qkb - md * fox::SCALE + 32.f;
    const int jd = P0 / 64, stride = jd / 64 + 1;
    int j = lane * stride; bool ok = (j > jd) ? true : (Fh[64 * j + 63] <= lim);
    unsigned long long mk = __ballot(ok); const int first = mk ? __builtin_ctzll(mk) : 64;
    const int lo_ex = first == 0 ? -1 : (first - 1) * stride; const int hi_in = (first < 64 && first * stride <= jd) ? first * stride : jd;
    j = lo_ex + 1 + lane; ok = (j < hi_in) ? (Fh[64 * j + 63] <= lim) : false;
    mk = __ballot(ok); return mk ? lo_ex + 1 + __builtin_ctzll(mk) : hi_in;
}
DI void ph4_fox(const Args& a, char* lds, int nscan) {
    const int tid = threadIdx.x, lane = tid & 63, wave = tid >> 6;
    const float* F = (const float*)(a.ws + WS_F); unsigned* QH = (unsigned*)(a.ws + WS_QH);
    int* misc = (int*)(lds + fox::OFF_MISC);
    if (tid == 0) { int ord0 = 0, ord1 = 1, ord2 = 2, ord3 = 3;
      float r0 = -F[0 * SEQ + SEQ - 1], r1 = -F[1 * SEQ + SEQ - 1], r2 = -F[2 * SEQ + SEQ - 1], r3 = -F[3 * SEQ + SEQ - 1];
#define CSWAP(ra, rb, oa, ob) if (rb < ra) { const float tf = ra; ra = rb; rb = tf; const int ti = oa; oa = ob; ob = ti; }
      CSWAP(r0, r1, ord0, ord1) CSWAP(r2, r3, ord2, ord3) CSWAP(r0, r2, ord0, ord2) CSWAP(r1, r3, ord1, ord3) CSWAP(r1, r2, ord1, ord2)
#undef CSWAP
      misc[4] = ord0; misc[5] = ord1; misc[6] = ord2; misc[7] = ord3; }
    float* qkbs = (float*)(lds + fox::OFF_MISC) + 8;
    const float* TB = (const float*)(a.ws + WS_NRMT);
    __syncthreads();
    { float m = 0.f; const int h = tid & 3;
        for (int g_ = tid >> 2; g_ < SEQ / 8; g_ += NTHREADS / 4) m = fmaxf(m, TB[g_ * 12 + 4 + h]);
        for (int o_ = 4; o_ < 64; o_ <<= 1) m = fmaxf(m, __shfl_xor(m, o_));
        if (lane < 4) qkbs[16 + wave * 4 + lane] = m; }
    __syncthreads();
    if (tid < 4) { float m = 0.f; for (int w = 0; w < NWAVES; ++w) m = fmaxf(m, qkbs[16 + w * 4 + tid]); qkbs[tid] = m; }
    __syncthreads();
    for (int round = 0;; ++round) {
        __syncthreads();
        if (tid == 0) misc[0] = (round == 0 && (int)blockIdx.x >= nscan) ? (int)blockIdx.x - nscan : (int)((int)gridDim.x - nscan + (int)atomicAdd(QH, 1u));
        __syncthreads();
        const int it = misc[0];
        if (it >= 256) break;
        const int h = misc[4 + (it >> 6)], qb = 63 - (it & 63), P0 = qb * 256;
        if (wave == 0) { const int jlo = fox_jlo(a, h, qb, qkbs, lane); if (lane == 0) misc[1] = jlo; }
        __syncthreads();
        fox::fox_block(a, lds, h, P0, misc[1]);
    }
    { unsigned* QC = (unsigned*)(a.ws + WS_QH) + 64; int par = 0;
        for (;;) {
            __syncthreads();
            if (tid == 0) misc[0] = (int)atomicAdd(QC, 1u);
            __syncthreads();
            const int c4 = misc[0] * 4;
            if (c4 >= Q_WGU) break;
#pragma unroll 1
            for (int q = 0; q < 4; ++q) conv_quad_gu(a, lds, par, c4 + q);
        }
    }
}
DI void ph4(const Args& a, float* lds) {
    const int nscan = (int)gridDim.x >= 2 * NSCAN ? NSCAN : 0;
    for (int chain = blockIdx.x; chain < NSCAN; chain += gridDim.x) scanA_chain(a, (char*)lds, chain);
    ph4_fox(a, (char*)lds, nscan);
}
DI void ph5_scan(const Args& a, float* lds) {
    const int G = gridDim.x;
    for (int chain = blockIdx.x; chain < NSCAN; chain += G) scanPC_chain(a, (char*)lds, chain);
    unsigned* QC = (unsigned*)(a.ws + WS_QH) + 128; int* misc = (int*)((char*)lds + 2 * SBUF + 4096); int par = 0;
    for (;;) {
        __syncthreads();
        if (threadIdx.x == 0) misc[0] = (int)atomicAdd(QC, 1u);
        __syncthreads();
        const int c4 = misc[0] * 4;
        if (c4 >= Q_WD) break;
#pragma unroll 1
        for (int q = 0; q < 4; ++q) conv_quad_d(a, (char*)lds, par, c4 + q);
    }
}

DI void ph5(const Args& a) {
    const int lane = threadIdx.x & 63, wave = threadIdx.x >> 6, NW = gridDim.x * NWAVES;
    const float* ORAW = (const float*)(a.ws + WS_ORAW); const bf16_t* P = (const bf16_t*)(a.ws + WS_PROJ); bf16_t* OA = (bf16_t*)(a.ws + WS_OA);
    const float g0 = a.in[I_GON][lane], g1 = a.in[I_GON][lane + 64];
    for (int id = blockIdx.x * NWAVES + wave; id < SEQ * 4; id += NW) { const int t = id >> 2, h = id & 3;
        const float o0 = ORAW[(size_t)t * 512 + h * 128 + lane], o1 = ORAW[(size_t)t * 512 + h * 128 + 64 + lane];
        const float rstd = rsqrtf(wave_sum(o0 * o0 + o1 * o1) * (1.f / 128.f) + 1e-6f);
        const float z0 = bf2f(P[(size_t)t * NPJ + PJ_DZ + h * 128 + lane]), z1 = bf2f(P[(size_t)t * NPJ + PJ_DZ + h * 128 + 64 + lane]);
        OA[(size_t)t * 512 + h * 128 + lane] = f2bf(o0 * rstd * g0 * siluf(z0)); OA[(size_t)t * 512 + h * 128 + 64 + lane] = f2bf(o1 * rstd * g1 * siluf(z1)); }
}

DI void ph6(const Args& a, unsigned char* ldsb) {
    const bf16_t* P = (const bf16_t*)(a.ws + WS_PROJ);
    pg8::OrderDense S; S.init(SEQ / 256, DM / 256, (int)gridDim.x, (int)blockIdx.x);
    { pg8::Gemm g{(const bf16_t*)(a.ws + WS_OA), (const bf16_t*)(a.ws + WS_WOAT), SEQ, DM, 512};
      pg8::EpiMerge<0> E{P + PJ_GA, (float*)(a.ws + WS_X1), (bf16_t*)(a.ws + WS_MRG)};
      pg8::gemm_phase<pg8::EpiMerge<0>, pg8::OrderDense>((LAS unsigned char*)ldsb, g, S, E); }
    __syncthreads();
    { pg8::Gemm g{(const bf16_t*)(a.ws + WS_OB), (const bf16_t*)(a.ws + WS_WOBT), SEQ, DM, 512};
      pg8::EpiMerge<1> E{P + PJ_GB, (float*)(a.ws + WS_X1), (bf16_t*)(a.ws + WS_MRG)};
      pg8::gemm_phase<pg8::EpiMerge<1>, pg8::OrderDense>((LAS unsigned char*)ldsb, g, S, E); }
}

DI void ph7(const Args& a, unsigned char* ldsb) {
    pg8::Gemm g{(const bf16_t*)(a.ws + WS_MRG), (const bf16_t*)(a.ws + WS_WOUTT), SEQ, DM, DM};
    pg8::OrderDense S; S.init(SEQ / 256, DM / 256, (int)gridDim.x, (int)blockIdx.x);
    pg8::EpiResid E{a.in[I_X], (const float*)(a.ws + WS_MOD) + 2048, (float*)(a.ws + WS_X1)};
    pg8::gemm_phase<pg8::EpiResid, pg8::OrderDense>((LAS unsigned char*)ldsb, g, S, E);
}

DI void ph8(const Args& a, float* lds) {
    const int tid = threadIdx.x, lane = tid & 63, wave = tid >> 6, G = gridDim.x;
    constexpr int HP = 1028;
    float* A2 = lds; float* B2 = lds + 1024; float* hs = lds + 2048; float* lgs = hs + 16 * HP;
    const float* mod = (const float*)(a.ws + WS_MOD);
    for (int k = tid; k < DM; k += NTHREADS) { A2[k] = a.in[I_G2][k] * (1.f + mod[4096 + k]); B2[k] = mod[3072 + k]; }
    const float* X1 = (const float*)(a.ws + WS_X1); bf16_t* H2 = (bf16_t*)(a.ws + WS_H2);
    int* TOKE = (int*)(a.ws + WS_TOKE); int* TOKS = (int*)(a.ws + WS_TOKS); float* TOKG = (float*)(a.ws + WS_TOKG); unsigned* CNT = (unsigned*)(a.ws + WS_CNT);
    const float* wr = a.in[I_WR];
    float* part = lgs + 512; int* lcnt = (int*)(part + 8 * 16 * 32);
    float wb0[32], wb1[32];
#pragma unroll
    for (int s = 0; s < 32; ++s) { const size_t k = (size_t)(128 * wave + 4 * s + (lane >> 4)); wb0[s] = wr[k * NE + (lane & 15)]; wb1[s] = wr[k * NE + 16 + (lane & 15)]; }
    for (int tile = blockIdx.x; tile < SEQ / 16; tile += G) {
        __syncthreads();
#pragma unroll 1
        for (int q = 0; q < 2; ++q) { const int tt = wave * 2 + q, t = tile * 16 + tt; const float* xr = X1 + (size_t)t * DM;
            f32x4 v[4]; float ss = 0.f;
#pragma unroll
            for (int i = 0; i < 4; ++i) { v[i] = *(const f32x4*)(xr + lane * 4 + 256 * i); ss += v[i][0] * v[i][0] + v[i][1] * v[i][1] + v[i][2] * v[i][2] + v[i][3] * v[i][3]; }
            ss = wave_sum(ss);
            const float rstd = rsqrtf(ss * (1.f / DM) + 1e-6f);
#pragma unroll
            for (int i = 0; i < 4; ++i) { const int k = lane * 4 + 256 * i;
#pragma unroll
                for (int e = 0; e < 4; ++e) v[i][e] = v[i][e] * rstd * A2[k + e] + B2[k + e];
                *(f32x4*)(hs + tt * HP + k) = v[i];
                *(unsigned*)((unsigned char*)H2 + (size_t)t * DM + k) = cvt_f8x4(v[i][0], v[i][1], v[i][2], v[i][3]); } }
        __syncthreads();
        {
            if (tid < 32) lcnt[tid] = 0;
            f32x4 c0 = (f32x4){0.f, 0.f, 0.f, 0.f}, c1 = c0; const float* ha = hs + (lane & 15) * HP + 128 * wave + (lane >> 4);
#pragma unroll
            for (int s = 0; s < 32; ++s) { const float av = ha[4 * s];
                c0 = __builtin_amdgcn_mfma_f32_16x16x4f32(av, wb0[s], c0, 0, 0, 0); c1 = __builtin_amdgcn_mfma_f32_16x16x4f32(av, wb1[s], c1, 0, 0, 0); }
#pragma unroll
            for (int r = 0; r < 4; ++r) { part[(wave * 16 + 4 * (lane >> 4) + r) * 32 + (lane & 15)] = c0[r]; part[(wave * 16 + 4 * (lane >> 4) + r) * 32 + 16 + (lane & 15)] = c1[r]; }
            __syncthreads();
            const int tt = tid >> 5, e = tid & 31; float acc = a.in[I_BR][e];
#pragma unroll
            for (int w = 0; w < 8; ++w) acc += part[(w * 16 + tt) * 32 + e];
            lgs[tt * 32 + e] = acc; }
        __syncthreads();
        { const int e = lane & 31, tt = wave * 2 + (lane >> 5), t = tile * 16 + tt;
            float cur = lgs[tt * 32 + e];
#define TOP1(TV, TI) float TV = cur; int TI = e; for (int o_ = 1; o_ <= 16; o_ <<= 1) { const float ov = __shfl_xor(TV, o_); const int oi = __shfl_xor(TI, o_); if (ov > TV || (ov == TV && oi < TI)) { TV = ov; TI = oi; } } if (e == TI) cur = -__builtin_inff();
            TOP1(tv0, ti0) TOP1(tv1, ti1) TOP1(tv2, ti2) TOP1(tv3, ti3)
#undef TOP1
            const float ex0 = 1.f, ex1 = expf(tv1 - tv0), ex2 = expf(tv2 - tv0), ex3 = expf(tv3 - tv0), den = ex0 + ex1 + ex2 + ex3;
            if (e < 4) { int ee = ti0; float gg = ex0;
                if (e == 1) { ee = ti1; gg = ex1; } if (e == 2) { ee = ti2; gg = ex2; } if (e == 3) { ee = ti3; gg = ex3; }
                const int rank = atomicAdd(lcnt + ee, 1);
                TOKE[t * 4 + e] = ee; TOKS[t * 4 + e] = rank; TOKG[t * 4 + e] = gg / den; } }
        __syncthreads();
        if (tid < 32) ((int*)(a.ws + WS_TCNT))[tile * 32 + tid] = lcnt[tid];
    }
}

DI void pad_starts(const Args& a, int* ps) {
    if (threadIdx.x == 0) { const unsigned* CNT = (const unsigned*)(a.ws + WS_CNT); int s = 0; for (int e = 0; e < NE; ++e) { ps[e] = s; s += (int)((CNT[e] + 255u) / 256u) * 256; } ps[NE] = s; }
    __syncthreads();
}
DI void ph9(const Args& a, float* lds) {
    const int tid = threadIdx.x, lane = tid & 63, wave = tid >> 6, G = gridDim.x;
    int* tab = (int*)lds; int* segs = tab + 32768; int* segoff = segs + 512; int* ps = segoff + 512; int* basel = ps + 64;
    const int* TCNT = (const int*)(a.ws + WS_TCNT);
    for (int i = tid; i < 8192; i += NTHREADS) ((u32x4*)tab)[i] = ((const u32x4*)TCNT)[i];
    __syncthreads();
    { const int e = tid & 31, sg = tid >> 5; int s = 0;
#pragma unroll 8
        for (int q = 0; q < 64; ++q) s += tab[(sg * 64 + q) * 32 + e];
        segs[sg * 32 + e] = s; }
    __syncthreads();
    if (tid < 32) { int run = 0; for (int sg = 0; sg < 16; ++sg) { segoff[sg * 32 + tid] = run; run += segs[sg * 32 + tid]; }
        segs[tid] = run;
        if (blockIdx.x == 0) ((unsigned*)(a.ws + WS_CNT))[tid] = (unsigned)run; }
    __syncthreads();
    if (tid == 0) { int s = 0; for (int e = 0; e < NE; ++e) { ps[e] = s; s += ((segs[e] + 255) / 256) * 256; } ps[NE] = s; }
    __syncthreads();
    const int* TOKE = (const int*)(a.ws + WS_TOKE); int* TOKS = (int*)(a.ws + WS_TOKS);
    const bf16_t* H2 = (const bf16_t*)(a.ws + WS_H2); bf16_t* XG = (bf16_t*)(a.ws + WS_XG);
    for (int tile = blockIdx.x; tile < SEQ / 16; tile += G) {
        __syncthreads();
        if (tid < 32) { int b = segoff[(tile >> 6) * 32 + tid]; for (int q = (tile >> 6) * 64; q < tile; ++q) b += tab[q * 32 + tid]; basel[tid] = ps[tid] + b; }
        __syncthreads();
#pragma unroll 1
        for (int q = 0; q < 8; ++q) { const int id = tile * 64 + wave * 8 + q, t = id >> 2;
            const size_t row = (size_t)(basel[TOKE[id]] + TOKS[id]);
            const u32x4 v0 = *(const u32x4*)((const unsigned char*)H2 + (size_t)t * DM + lane * 16);
            *(u32x4*)((unsigned char*)XG + row * DM + lane * 16) = v0;
            if (lane == 0) TOKS[id] = (int)row; }
    }
}
DI int expert_of(const int* ps, int row0) { int e = 0; for (int i = 1; i < NE; ++i) if (row0 >= ps[i]) e = i; return e; }
DI void ph10(const Args& a, unsigned char* ldsb) {
    int* ps = (int*)(ldsb + 131072); pad_starts(a, ps);
    pg8::Gemm g{(const bf16_t*)(a.ws + WS_XG), (const bf16_t*)(a.ws + WS_WGUT), 0, 2048, DM};
    pg8::OrderGrouped S; S.init(ps[NE] / 256, 8, (int)gridDim.x, (int)blockIdx.x); S.ps = (const LAS int*)ps;
    pg8::EpiSwiglu E{(unsigned char*)(a.ws + WS_ACT), a.in[I_BGU]};
    pg8::gemm_phase<pg8::EpiSwiglu, pg8::OrderGrouped, true>((LAS unsigned char*)ldsb, g, S, E);
}
DI void ph11(const Args& a, unsigned char* ldsb) {
    int* ps = (int*)(ldsb + 131072); pad_starts(a, ps);
    pg8::Gemm g{(const bf16_t*)(a.ws + WS_ACT), (const bf16_t*)(a.ws + WS_WDT), 0, DM, DM};
    pg8::OrderGrouped S; S.init(ps[NE] / 256, 4, (int)gridDim.x, (int)blockIdx.x); S.ps = (const LAS int*)ps;
    pg8::EpiStoreBf16 E{(bf16_t*)(a.ws + WS_YB), DM, a.in[I_BD], DM, 1.f / (WSCALE * ASCALE)};
    pg8::gemm_phase<pg8::EpiStoreBf16, pg8::OrderGrouped, true>((LAS unsigned char*)ldsb, g, S, E);
}
DI void ph12(const Args& a, float* lds) {
    const int lane = threadIdx.x & 63, wave = threadIdx.x >> 6, G = gridDim.x;
    const float* X1 = (const float*)(a.ws + WS_X1); const bf16_t* YB = (const bf16_t*)(a.ws + WS_YB); const float* mod = (const float*)(a.ws + WS_MOD);
    const int* TOKS = (const int*)(a.ws + WS_TOKS); const float* TOKG = (const float*)(a.ws + WS_TOKG);
    f32x4 gt[4], gf[4];
#pragma unroll
    for (int i = 0; i < 4; ++i) { gt[i] = *(const f32x4*)(mod + 5120 + lane * 4 + 256 * i); gf[i] = *(const f32x4*)(a.in[I_GF] + lane * 4 + 256 * i); }
    for (int t0 = (blockIdx.x * NWAVES + wave) * 2; t0 < SEQ; t0 += G * NWAVES * 2) {
        int rows[2][4]; float gk[2][4];
#pragma unroll
        for (int p = 0; p < 2; ++p)
#pragma unroll
            for (int q = 0; q < 4; ++q) { rows[p][q] = TOKS[(t0 + p) * 4 + q]; gk[p][q] = TOKG[(t0 + p) * 4 + q]; }
        f32x4 v[2][4]; u32x2 yv[2][4][4];
#pragma unroll
        for (int p = 0; p < 2; ++p)
#pragma unroll
            for (int i = 0; i < 4; ++i) { const int k = lane * 4 + 256 * i; v[p][i] = *(const f32x4*)(X1 + (size_t)(t0 + p) * DM + k);
#pragma unroll
                for (int q = 0; q < 4; ++q) yv[p][i][q] = *(const u32x2*)(YB + (size_t)rows[p][q] * DM + k); }
#pragma unroll
        for (int p = 0; p < 2; ++p) { float ss = 0.f;
#pragma unroll
            for (int i = 0; i < 4; ++i) { f32x4 y = (f32x4){0.f, 0.f, 0.f, 0.f};
#pragma unroll
                for (int q = 0; q < 4; ++q) { const u32x2 w = yv[p][i][q];
                    y[0] += gk[p][q] * __uint_as_float(w.x << 16); y[1] += gk[p][q] * __uint_as_float(w.x & 0xffff0000u); y[2] += gk[p][q] * __uint_as_float(w.y << 16); y[3] += gk[p][q] * __uint_as_float(w.y & 0xffff0000u); }
                v[p][i] += gt[i] * y; ss += v[p][i][0] * v[p][i][0] + v[p][i][1] * v[p][i][1] + v[p][i][2] * v[p][i][2] + v[p][i][3] * v[p][i][3]; }
            ss = wave_sum(ss);
            const float rstd = rsqrtf(ss * (1.f / DM) + 1e-6f);
#pragma unroll
            for (int i = 0; i < 4; ++i) *(f32x4*)(a.out + (size_t)(t0 + p) * DM + lane * 4 + 256 * i) = v[p][i] * rstd * gf[i]; }
    }
}

__global__ void __launch_bounds__(NTHREADS, 2) hybrid_fwd(Args a) {
    extern __shared__ __attribute__((aligned(16))) unsigned char lds_raw[];
    float* lds = (float*)(lds_raw + 16);
    LAS unsigned* xbw = (LAS unsigned*)lds_raw;
    if (threadIdx.x == 0) { xbw[0] = 0u; xbw[1] = 0u; xbw[2] = 0u; xbw[3] = 0u; }
    __syncthreads();
    XcdBarrier bar; bar.bar = (unsigned*)(a.ws + WS_BAR); bar.x = 0; bar.st = (volatile LAS unsigned*)xbw;
    const int lo = a.ph_lo, hi = a.ph_hi;
    if (hi - lo > 1) bar = xcd_barrier_post((unsigned*)(a.ws + WS_BAR), (volatile LAS unsigned*)xbw);
#define IN(k) (lo <= (k) && (k) < hi)
#define SEAM(k) do { if (IN(k) && IN((k) + 1)) xcd_barrier(bar); } while (0)
    if (IN(0)) ph0(a, lds);
    SEAM(0);
    if (IN(1)) ph1(a, lds);
    SEAM(1);
    if (IN(2)) ph2(a, lds_raw + 16);
    SEAM(2);
    if (IN(3)) ph3(a, lds);
    SEAM(3);
    if (IN(4)) ph4(a, lds);
    SEAM(4);
    if (IN(5)) ph5_scan(a, lds);
    SEAM(5);
    if (IN(6)) ph5(a);
    SEAM(6);
    if (IN(7)) ph6(a, lds_raw + 16);
    SEAM(7);
    if (IN(8)) ph7(a, lds_raw + 16);
    SEAM(8);
    if (IN(9)) ph8(a, lds);
    SEAM(9);
    if (IN(10)) ph9(a, lds);
    SEAM(10);
    if (IN(11)) ph10(a, lds_raw + 16);
    SEAM(11);
    if (IN(12)) ph11(a, lds_raw + 16);
    SEAM(12);
    if (IN(13)) ph12(a, lds);
#undef IN
#undef SEAM
}

extern "C" void kernel_launch(void* const* d_in, const int* in_sizes, int n_in, void* d_out, int out_size, void* d_ws, size_t ws_size, hipStream_t stream) {
    static int grid = 0;
    if (grid == 0) {
        if (n_in != 22 || out_size != SEQ * DM || ws_size < WS_END) { fprintf(stderr, "kernel_launch: unexpected shapes (n_in %d out %d ws %zu, need %zu)\n", n_in, out_size, ws_size, (size_t)WS_END); grid = -1; return; }
        int dev = 0, cus = 0, per_cu = 0;
        if (hipGetDevice(&dev) != hipSuccess || hipDeviceGetAttribute(&cus, hipDeviceAttributeMultiprocessorCount, dev) != hipSuccess) { grid = -1; return; }
        if (hipFuncSetAttribute((const void*)hybrid_fwd, hipFuncAttributeMaxDynamicSharedMemorySize, LDS_BYTES) != hipSuccess) { fprintf(stderr, "kernel_launch: hipFuncSetAttribute failed\n"); grid = -1; return; }
        if (hipOccupancyMaxActiveBlocksPerMultiprocessor(&per_cu, (const void*)hybrid_fwd, NTHREADS, LDS_BYTES) != hipSuccess || per_cu < 1) { fprintf(stderr, "kernel_launch: occupancy query says %d\n", per_cu); }
        (void)hipGetLastError();
        grid = cus;
    }
    if (grid < 0) return;
    (void)hipMemsetAsync(d_ws, 0, CTL_ZERO, stream);
    Args a{};
    for (int i = 0; i < 22; ++i) a.in[i] = (const float*)d_in[i];
    a.out = (float*)d_out; a.ws = (unsigned char*)d_ws;
#if N_LAUNCHES == 1
    a.ph_lo = 0; a.ph_hi = NPHASES;
    hipLaunchKernelGGL(hybrid_fwd, dim3(grid), dim3(NTHREADS), LDS_BYTES, stream, a);
#else
    for (int p = 0; p < NPHASES; ++p) { a.ph_lo = p; a.ph_hi = p + 1; hipLaunchKernelGGL(hybrid_fwd, dim3(grid), dim3(NTHREADS), LDS_BYTES, stream, a); }
#endif
}
```

```cpp
#include <hip/hip_runtime.h>
#include <stdint.h>
#include <stdio.h>

#ifndef N_LAUNCHES
#define N_LAUNCHES 1
#endif

#define DI __device__ __forceinline__
#define LAS __attribute__((address_space(3)))
typedef unsigned short bf16_t;
typedef short bf16x8 __attribute__((ext_vector_type(8)));
typedef float f32x4 __attribute__((ext_vector_type(4)));
typedef unsigned u32x4 __attribute__((ext_vector_type(4)));
typedef unsigned u32x2 __attribute__((ext_vector_type(2)));
typedef int v8i32 __attribute__((ext_vector_type(8)));

constexpr int SEQ = 16384, DM = 1024, NIN = 5644, NPJ = 5632, NE = 32, TOPK = 4;
constexpr int NH = 4, HD = 128, CH = 64, NCH = SEQ / CH;
constexpr int PJ_DQ = 0, PJ_DK = 512, PJ_DV = 1024, PJ_DZ = 1536, PJ_FQ = 2048, PJ_FK = 2560, PJ_FV = 3072, PJ_GA = 3584, PJ_GB = 4608;
constexpr int NTHREADS = 512, NWAVES = 8;
constexpr int LDS_BYTES = 152 * 1024;
constexpr int NPHASES = 14;

constexpr size_t MiB = 1u << 20;
constexpr size_t WS_BAR = 0;
constexpr size_t WS_CNT = 32768;
constexpr size_t WS_NRM = 32768 + 256;
constexpr size_t WS_QH = 32768 + 512;
constexpr size_t CTL_ZERO = 65536;
constexpr size_t WS_MOD = 65536;
constexpr size_t WS_F = WS_MOD + 32768;
constexpr size_t WS_EG = WS_F + 262144;
constexpr size_t WS_TOKE = WS_EG + 4096;
constexpr size_t WS_TOKS = WS_TOKE + 262144;
constexpr size_t WS_TOKG = WS_TOKS + 262144;
constexpr size_t WS_SP = WS_TOKG + 262144;
constexpr size_t WS_WINT = WS_SP + MiB;
constexpr size_t WS_WOAT = WS_WINT + (size_t)NPJ * DM * 2;
constexpr size_t WS_WOBT = WS_WOAT + MiB;
constexpr size_t WS_WOUTT = WS_WOBT + MiB;
constexpr size_t WS_WGUT = WS_WOUTT + 2 * MiB;
constexpr size_t WS_WDT = WS_WGUT + 128 * MiB;
constexpr size_t WS_X1 = WS_WDT + 64 * MiB;
constexpr size_t WS_H2 = WS_X1 + 64 * MiB;
constexpr size_t WS_MRG = WS_H2 + 32 * MiB;
constexpr size_t WS_RA = WS_MRG + 32 * MiB;
constexpr size_t WS_RB = WS_RA + 176 * MiB;
constexpr size_t WS_H = WS_RB;
constexpr size_t WS_DNW = WS_H + 32 * MiB;
constexpr size_t WS_DNU = WS_DNW + 16 * MiB;
constexpr size_t WS_DNQD = WS_DNU + 16 * MiB;
constexpr size_t WS_DNKD = WS_DNQD + 16 * MiB;
constexpr size_t WS_DNATT = WS_DNKD + 16 * MiB;
constexpr size_t WS_ORAW = WS_DNATT + 8 * MiB;
constexpr size_t WS_OA = WS_ORAW + 32 * MiB;
constexpr size_t WS_OB = WS_OA + 16 * MiB;
constexpr size_t WS_VT = WS_OB + 16 * MiB;
constexpr size_t WS_PG = WS_VT;
constexpr size_t WS_QG = WS_PG + 2 * MiB;
constexpr size_t WS_SG = WS_QG + 4 * MiB;
constexpr size_t WS_TCNT = WS_SG + 4 * MiB;
constexpr size_t WS_LF = WS_TCNT + 131072 + 131072;
constexpr size_t WS_NRMT = WS_TCNT + 131072;
constexpr size_t WS_END = WS_RB + 184 * MiB;
constexpr size_t WS_XG = WS_RA, WS_YB = WS_RA, WS_ACT = WS_RB, WS_PROJ = WS_RA;
static_assert(WS_VT + 16 * MiB <= WS_END, "region B");

struct Args { const float* in[22]; float* out; unsigned char* ws; int ph_lo, ph_hi; };
enum { I_X = 0, I_C, I_WADA, I_BADA, I_G1, I_WIN, I_CONVW, I_ALOG, I_DTB, I_GON, I_BFG, I_WOD, I_WOF, I_WOUT, I_G2, I_WR, I_BR, I_WGU, I_BGU, I_WD, I_BD, I_GF };

DI float bf2f(bf16_t v) { return __uint_as_float(((unsigned)v) << 16); }
DI bf16_t f2bf(float f) { unsigned u = __float_as_uint(f); u += 0x7fffu + ((u >> 16) & 1u); return (bf16_t)(u >> 16); }
typedef float f32x2_t __attribute__((ext_vector_type(2)));
typedef __bf16 bf16x2_t __attribute__((ext_vector_type(2)));
DI unsigned cvt_pk(float lo, float hi) { const f32x2_t v = {lo, hi}; const bf16x2_t b = __builtin_convertvector(v, bf16x2_t); return __builtin_bit_cast(unsigned, b); }
DI unsigned cvt_f8x4(float a, float b, float c, float d) { unsigned w = 0; w = __builtin_amdgcn_cvt_pk_fp8_f32(a, b, w, false); w = __builtin_amdgcn_cvt_pk_fp8_f32(c, d, w, true); return w; }
DI unsigned pk2(float lo, float hi) { return (unsigned)f2bf(lo) | ((unsigned)f2bf(hi) << 16); }
DI float sigm(float x) { return 1.f / (1.f + expf(-x)); }
DI float siluf(float x) { return x / (1.f + expf(-x)); }
DI float softplusf(float x) { return fmaxf(x, 0.f) + log1pf(expf(-fabsf(x))); }
DI float logsigf(float x) { return fminf(x, 0.f) - log1pf(expf(-fabsf(x))); }
DI float wave_sum(float v) { for (int o = 32; o >= 1; o >>= 1) v += __shfl_xor(v, o); return v; }
#define MFMA16(a, b, c) __builtin_amdgcn_mfma_f32_16x16x32_bf16((a), (b), (c), 0, 0, 0)

DI int gu_src(int n) { const int g = n >> 8, r = n & 255; return r < 128 ? 128 * g + r : 1024 + 128 * g + (r - 128); }

#define XB_TMO      128
#define XB_XCNT(j)  (256  + 64 * (j))
#define XB_XSUB(j)  (1280 + 64 * (j))
#define XB_XGEN(j)  (2304 + 64 * (j))
#define XB_TOP      3328
#define XB_TOPGEN   3392
#define XCD_BAR_WORDS 3456
#define XB_SPIN_CAP (1u << 22)
DI unsigned xb_ld(unsigned* p)              { return __hip_atomic_load(p, __ATOMIC_RELAXED, __HIP_MEMORY_SCOPE_AGENT); }
DI unsigned xb_add(unsigned* p, unsigned v) { return __hip_atomic_fetch_add(p, v, __ATOMIC_RELAXED, __HIP_MEMORY_SCOPE_AGENT); }
DI unsigned xb_xcc_id() { return (unsigned)__builtin_amdgcn_s_getreg((3 << 11) | 20) & 0xFu; }
#define XB_SPIN(cond, bar) do { unsigned _sp = 0; while (cond) { __builtin_amdgcn_s_sleep(1); \
    if ((++_sp & 255u) == 0u) { if (xb_ld(&(bar)[XB_TMO])) break; if (_sp > XB_SPIN_CAP) { atomicAdd(&(bar)[XB_TMO], 1u); break; } } } } while (0)
struct XcdBarrier { unsigned* bar; unsigned x; volatile LAS unsigned* st; };
DI XcdBarrier xcd_barrier_post(unsigned* bar, volatile LAS unsigned* st) {
    XcdBarrier b; b.bar = bar; b.x = xb_xcc_id(); b.st = st;
    if (threadIdx.x == 0) (void)xb_add(&bar[XB_XCNT(b.x)], 1u);
    return b;
}
DI void xcd_barrier_complete(unsigned* bar, unsigned x, unsigned& nloc, unsigned& nx) {
    const unsigned G = gridDim.x * gridDim.y * gridDim.z;
    unsigned sum, cnt, mine, sp = 0u;
    for (;;) {
        sum = 0u; cnt = 0u; mine = 0u;
#pragma unroll
        for (unsigned j = 0; j < 16; ++j) { const unsigned c = xb_ld(&bar[XB_XCNT(j)]); sum += c; cnt += (c > 0u) ? 1u : 0u; mine = (j == x) ? c : mine; }
        if (sum == G) break;
        __builtin_amdgcn_s_sleep(1);
        if ((++sp & 255u) == 0u) { if (xb_ld(&bar[XB_TMO])) break; if (sp > XB_SPIN_CAP) { atomicAdd(&bar[XB_TMO], 1u); break; } }
    }
    nloc = mine > 0u ? mine : 1u; nx = cnt > 0u ? cnt : 1u;
}
DI void xcd_barrier(const XcdBarrier& b) {
    asm volatile("s_waitcnt vmcnt(0)" ::: "memory");
    __syncthreads();
    if (threadIdx.x == 0) {
        unsigned* bar = b.bar;
        __builtin_amdgcn_s_waitcnt(0);
        unsigned nloc = b.st[0], nx = b.st[1];
        if (nloc == 0u) { xcd_barrier_complete(bar, b.x, nloc, nx); b.st[0] = nloc; b.st[1] = nx; }
        const unsigned old = xb_add(&bar[XB_XSUB(b.x)], 1u);
        const unsigned gen = old / nloc;
        if (old + 1u == (gen + 1u) * nloc) {
            __builtin_amdgcn_fence(__ATOMIC_RELEASE, "agent");
            asm volatile("s_waitcnt vmcnt(0)" ::: "memory");
            const unsigned og = xb_add(&bar[XB_TOP], 1u);
            const unsigned tg = og / nx;
            if (og + 1u == (tg + 1u) * nx) xb_add(&bar[XB_TOPGEN], 1u);
            else XB_SPIN(xb_ld(&bar[XB_TOPGEN]) == tg, bar);
            __builtin_amdgcn_fence(__ATOMIC_ACQUIRE, "agent");
            xb_add(&bar[XB_XGEN(b.x)], 1u);
            asm volatile("s_waitcnt vmcnt(0)" ::: "memory");
        } else {
            XB_SPIN(xb_ld(&bar[XB_XGEN(b.x)]) == gen, bar);
            __builtin_amdgcn_fence(__ATOMIC_ACQUIRE, "agent");
            asm volatile("s_waitcnt vmcnt(0)" ::: "memory");
        }
    }
    __syncthreads();
}

template <int NT>
DI void wave_gemm(const bf16_t* const (&ap)[4], const bf16_t* const (&bp)[NT], int K, f32x4 (&acc)[4][NT]) {
    for (int k0 = 0; k0 < K; k0 += 32) {
        bf16x8 a[4], b[NT];
#pragma unroll
        for (int i = 0; i < 4; ++i) a[i] = *(const bf16x8*)(ap[i] + k0);
#pragma unroll
        for (int j = 0; j < NT; ++j) b[j] = *(const bf16x8*)(bp[j] + k0);
#pragma unroll
        for (int i = 0; i < 4; ++i)
#pragma unroll
            for (int j = 0; j < NT; ++j) acc[i][j] = MFMA16(a[i], b[j], acc[i][j]);
    }
}
template <int NT> DI void zero_acc(f32x4 (&acc)[4][NT]) {
#pragma unroll
    for (int i = 0; i < 4; ++i)
#pragma unroll
        for (int j = 0; j < NT; ++j) acc[i][j] = (f32x4){0.f, 0.f, 0.f, 0.f};
}


constexpr float WSCALE = 64.f, ASCALE = 4.f;
namespace pg8 {
struct Unit { int pm, pn, pb, e; };
struct Gemm { const bf16_t* A; const bf16_t* Bt; int M, N, K; };
constexpr int BM = 256, BK = 64, HALF = 128, HTB = HALF * BK * 2  , STAGE_BYTES = 8 * HTB, NXCD = 8, WGM = 8;

__host__ __device__ __forceinline__ int lds_byte(int r, int c) { const int st = (r >> 4) * 2 + (c >> 5), rr = r & 15, cc = c & 31, ob = rr * 64 + cc * 2; return st * 1024 + (ob ^ (((ob >> 9) & 1) << 5)); }
__host__ __device__ __forceinline__ void stage_rc(int b, int& R, int& C) { const int st = b / 1024, sb = b % 1024, swz = sb ^ (((sb >> 9) & 1) << 5); R = (st >> 1) * 16 + swz / 64; C = (st & 1) * 32 + (swz % 64) / 2; }
__host__ __device__ __forceinline__ int perm32(int rho) { const int n = rho >> 4, i = rho & 15; return 8 * (i >> 2) + 4 * n + (i & 3); }
template <class Epi, class Sched, bool FP8 = false>
__device__ __forceinline__ void gemm_phase(LAS unsigned char* lds, const Gemm g, const Sched& S, const Epi& E) {
    const int tid = threadIdx.x, wid = __builtin_amdgcn_readfirstlane(tid >> 6), lane = tid & 63, wr = wid >> 2, wc = wid & 3, fr = lane & 15, fq = lane >> 4;
    const int K = FP8 ? g.K / 2 : g.K, nt = K / BK;
    unsigned voffA[2], voffB[2];
#pragma unroll
    for (int i = 0; i < 2; ++i) { int R, C;
        if (FP8) { const int b = tid * 16 + i * 8192; R = b >> 7; const int sw = ((R >> 1) & 1) | (((R >> 3) & 1) << 1); C = (((((b & 127) >> 5) ^ sw) << 5) + (b & 31)) >> 1; }
        else stage_rc(tid * 16 + i * 8192, R, C);
        const int Rb = Epi::PERM ? ((R & ~31) + perm32(R & 31)) : R;
        voffA[i] = (unsigned)(R * K + C) * 2u; voffB[i] = (unsigned)(Rb * K + C) * 2u; }
    const size_t kstep = (size_t)(BK * 2);
    const size_t hstep = (size_t)HALF * K * 2;
    const size_t tstep = 2 * hstep;
    const unsigned ldsw = (unsigned)wid * 1024u;
    const int fsw = ((fr >> 1) & 1) | (((fr >> 3) & 1) << 1);
    const int aoff = FP8 ? (wr * 64 + fr) * 128 + ((fq ^ fsw) << 5) + ((fq & 1) << 4) : lds_byte(wr * 64 + fr, fq * 8), boff = FP8 ? (wc * 32 + fr) * 128 + ((fq ^ fsw) << 5) + ((fq & 1) << 4) : lds_byte(wc * 32 + fr, fq * 8);
    const int aoff2 = aoff ^ 16, boff2 = boff ^ 16;
#define PG8_SA(b, h) (((b) * 2 + (h)) * HTB)
#define PG8_SB(b, h) ((4 + (b) * 2 + (h)) * HTB)
#define PG8_STAGE(bufoff, gbase, voff) do { _Pragma("unroll") for (int _i = 0; _i < 2; ++_i) \
        __builtin_amdgcn_global_load_lds((const unsigned*)((const char*)(gbase) + (voff)[_i]), (LAS unsigned*)(lds + (bufoff) + ldsw + _i * 8192), 16, 0, 0); } while (0)
#define PG8_LDA(dst, b, h) do { _Pragma("unroll") for (int m = 0; m < 4; ++m) { if (FP8) { const u32x4 l_ = *(const LAS u32x4*)(lds + PG8_SA(b, h) + aoff + m * 2048), h_ = *(const LAS u32x4*)(lds + PG8_SA(b, h) + aoff2 + m * 2048); dst##8[m] = (v8i32){(int)l_.x, (int)l_.y, (int)l_.z, (int)l_.w, (int)h_.x, (int)h_.y, (int)h_.z, (int)h_.w}; } \
        else { _Pragma("unroll") for (int k = 0; k < 2; ++k) dst[m][k] = *(const LAS bf16x8*)(lds + PG8_SA(b, h) + aoff + m * 2048 + k * 1024); } } } while (0)
#define PG8_LDB(dst, b, h) do { _Pragma("unroll") for (int n = 0; n < 2; ++n) { if (FP8) { const u32x4 l_ = *(const LAS u32x4*)(lds + PG8_SB(b, h) + boff + n * 2048), h_ = *(const LAS u32x4*)(lds + PG8_SB(b, h) + boff2 + n * 2048); dst##8[n] = (v8i32){(int)l_.x, (int)l_.y, (int)l_.z, (int)l_.w, (int)h_.x, (int)h_.y, (int)h_.z, (int)h_.w}; } \
        else { _Pragma("unroll") for (int k = 0; k < 2; ++k) dst[n][k] = *(const LAS bf16x8*)(lds + PG8_SB(b, h) + boff + n * 2048 + k * 1024); } } } while (0)
#define PG8_MMA(ai, bj, At, Bt) do { __builtin_amdgcn_s_setprio(1); _Pragma("unroll") for (int m = 0; m < 4; ++m) _Pragma("unroll") for (int n = 0; n < 2; ++n) { \
        if (FP8) asm volatile("v_mfma_f32_16x16x128_f8f6f4 %0, %1, %2, %0" : "+v"(acc[ai][bj][m][n]) : "v"(Bt##8[n]), "v"(At##8[m])); \
        else { _Pragma("unroll") for (int k = 0; k < 2; ++k) acc[ai][bj][m][n] = __builtin_amdgcn_mfma_f32_16x16x32_bf16(Bt[n][k], At[m][k], acc[ai][bj][m][n], 0, 0, 0); } } \
        __builtin_amdgcn_s_setprio(0); } while (0)
#define PG8_WAIT_V(n) asm volatile("s_waitcnt vmcnt(" #n ")" ::: "memory")
#define PG8_WAIT_L(n) asm volatile("s_waitcnt lgkmcnt(" #n ")" ::: "memory")
#define PG8_BAR __builtin_amdgcn_s_barrier()
#define PG8_SCHED __builtin_amdgcn_sched_barrier(0)
    Unit cur, nxt; int ui = 0; f32x4 pb[4];
    if (!S.next(0, cur)) return;
    f32x4 acc[2][2][4][2];
#pragma unroll
    for (int a = 0; a < 2; ++a)
#pragma unroll
        for (int b = 0; b < 2; ++b)
#pragma unroll
            for (int m = 0; m < 4; ++m)
#pragma unroll
                for (int n = 0; n < 2; ++n) acc[a][b][m][n] = (f32x4){0.f, 0.f, 0.f, 0.f};
    bf16x8 At[4][2], B0[2][2], B1[2][2]; v8i32 At8[4], B08[2], B18[2];
    const char* cA = (const char*)g.A + (size_t)cur.pm * tstep; const char* cB = (const char*)g.Bt + (size_t)cur.pb * tstep;
    S.a_ready(cur);
    PG8_STAGE(PG8_SB(0, 0), cB, voffB); PG8_STAGE(PG8_SA(0, 0), cA, voffA); PG8_STAGE(PG8_SB(0, 1), cB + hstep, voffB); PG8_STAGE(PG8_SA(0, 1), cA + hstep, voffA);
    if (wr == 1) PG8_BAR;
    PG8_WAIT_V(4); PG8_BAR;
    PG8_STAGE(PG8_SB(1, 0), cB + kstep, voffB); PG8_STAGE(PG8_SA(1, 0), cA + kstep, voffA); PG8_STAGE(PG8_SB(1, 1), cB + hstep + kstep, voffB);
    PG8_WAIT_V(6); PG8_BAR;
    for (;;) {
        const bool has_next = S.next(ui + 1, nxt);
        const char* nA = has_next ? (const char*)g.A + (size_t)nxt.pm * tstep : cA; const char* nB = has_next ? (const char*)g.Bt + (size_t)nxt.pb * tstep : cB;
#pragma unroll 1
        for (int t = 0; t < nt; t += 2) {
            const bool last = (t == nt - 2);
            const char* a1 = cA + (size_t)(t + 1) * kstep;
            const char* a2 = last ? nA : cA + (size_t)(t + 2) * kstep; const char* b2 = last ? nB : cB + (size_t)(t + 2) * kstep;
            const char* a3 = a2 + kstep; const char* b3 = b2 + kstep;
            if (last && has_next) S.a_ready(nxt);
            if (last) E.pre(cur, wc, fq, pb);
            PG8_LDB(B0, 0, 0); PG8_SCHED; PG8_LDA(At, 0, 0); PG8_STAGE(PG8_SA(1, 1), a1 + hstep, voffA);
            PG8_WAIT_L(8); PG8_BAR; PG8_WAIT_L(0); PG8_MMA(0, 0, At, B0); PG8_BAR; PG8_SCHED;
            PG8_LDB(B1, 0, 1); PG8_STAGE(PG8_SB(0, 0), b2, voffB);
            PG8_BAR; PG8_WAIT_L(0); PG8_MMA(0, 1, At, B1); PG8_BAR;
            PG8_LDA(At, 0, 1); PG8_STAGE(PG8_SA(0, 0), a2, voffA);
            PG8_BAR; PG8_WAIT_L(0); PG8_MMA(1, 0, At, B0); PG8_BAR; PG8_SCHED;
            PG8_STAGE(PG8_SB(0, 1), b2 + hstep, voffB);
            PG8_WAIT_V(6); PG8_BAR; PG8_MMA(1, 1, At, B1); PG8_BAR;
            PG8_LDB(B0, 1, 0); PG8_SCHED; PG8_LDA(At, 1, 0); PG8_STAGE(PG8_SA(0, 1), a2 + hstep, voffA);
            PG8_WAIT_L(8); PG8_BAR; PG8_WAIT_L(0); PG8_MMA(0, 0, At, B0); PG8_BAR; PG8_SCHED;
            PG8_LDB(B1, 1, 1); PG8_STAGE(PG8_SB(1, 0), b3, voffB);
            PG8_BAR; PG8_WAIT_L(0); PG8_MMA(0, 1, At, B1); PG8_BAR;
            PG8_LDA(At, 1, 1); PG8_STAGE(PG8_SA(1, 0), a3, voffA);
            PG8_BAR; PG8_WAIT_L(0); PG8_MMA(1, 0, At, B0); PG8_BAR; PG8_SCHED;
            PG8_STAGE(PG8_SB(1, 1), b3 + hstep, voffB);
            PG8_WAIT_V(6); PG8_BAR; PG8_MMA(1, 1, At, B1); PG8_BAR;
        }
        if (FP8) asm volatile("s_nop 15\n\ts_nop 15" ::: "memory");
        if constexpr (!Epi::AFTER_DRAIN) { E(acc, cur, wr, wc, fr, fq, pb); S.done(cur); }
        if (!has_next) break;
#pragma unroll
        for (int a = 0; a < 2; ++a)
#pragma unroll
            for (int b = 0; b < 2; ++b)
#pragma unroll
                for (int m = 0; m < 4; ++m)
#pragma unroll
                    for (int n = 0; n < 2; ++n) acc[a][b][m][n] = (f32x4){0.f, 0.f, 0.f, 0.f};
        cur = nxt; cA = nA; cB = nB; ++ui;
    }
    PG8_WAIT_V(0);
    if (wr == 0) PG8_BAR;
    PG8_BAR;
    if constexpr (Epi::AFTER_DRAIN) { E.fused(acc, cur, wr, wc, fr, fq, lds, wid, lane); S.done(cur); }
#undef PG8_SA
#undef PG8_SB
#undef PG8_STAGE
#undef PG8_LDA
#undef PG8_LDB
#undef PG8_MMA
#undef PG8_WAIT_V
#undef PG8_WAIT_L
#undef PG8_BAR
#undef PG8_SCHED
}

DI unsigned cvt_pk_bf16(float lo, float hi) { return cvt_pk(lo, hi); }
DI float fsig(float x) { return __builtin_amdgcn_rcpf(1.f + __builtin_amdgcn_exp2f(-1.4426950408889634f * x)); }
DI int expert_of_l(const LAS int* ps, int row0) { int e = 0;
#pragma unroll 1
    for (int i = 1; i < NE; ++i) if (row0 >= ps[i]) e = i; return e; }
struct OrderDense {
    int nM, nN, nwg, G, c;
    DI void init(int nM_, int nN_, int G_, int c_) { nM = nM_; nN = nN_; nwg = nM * nN; G = G_; c = c_; }
    DI bool tile(int i, Unit& u) const {
        const long L = (long)i * G + c; if (L >= nwg) return false;
        int wgid = (int)L; { const int q = nwg / NXCD, r = nwg % NXCD, xcd = wgid % NXCD, off = wgid / NXCD; wgid = (xcd < r ? xcd * (q + 1) : r * (q + 1) + (xcd - r) * q) + off; }
        const int nig = WGM * nN, gid = wgid / nig, fm = gid * WGM, gsz = (nM - fm) < WGM ? (nM - fm) : WGM;
        u.pm = fm + ((wgid % nig) % gsz); u.pn = (wgid % nig) / gsz; return true;
    }
    DI bool next(int i, Unit& u) const { if (!tile(i, u)) return false; u.pb = u.pn; u.e = 0; return true; }
    DI void a_ready(const Unit&) const {}
    DI void done(const Unit&) const {}
};
struct OrderGrouped : OrderDense {
    const LAS int* ps;
    DI bool next(int i, Unit& u) const { if (!tile(i, u)) return false; u.e = ps[40 + u.pm]; u.pb = u.e * nN + u.pn; return true; }
};
struct EpiStoreBf16 {
    static constexpr bool PERM = true, AFTER_DRAIN = false;
    bf16_t* O; int ldc; const float* bias; int bstride; float scale;
    DI void pre(const Unit& u, int wc, int fq, f32x4 (&pb)[4]) const { const int col0 = u.pn * BM + wc * 32 + 8 * fq;
#pragma unroll
        for (int bj = 0; bj < 2; ++bj)
#pragma unroll
            for (int n = 0; n < 2; ++n) pb[bj * 2 + n] = bias ? *(const f32x4*)(bias + (size_t)u.e * bstride + col0 + bj * HALF + 4 * n) : (f32x4){0.f, 0.f, 0.f, 0.f}; }
    DI void operator()(const f32x4 (&acc)[2][2][4][2], const Unit& u, int wr, int wc, int fr, int fq, const f32x4 (&pb)[4]) const {
        const int row0 = u.pm * BM + wr * 64 + fr, col0 = u.pn * BM + wc * 32 + 8 * fq;
        f32x4 bv[2][2];
#pragma unroll
        for (int bj = 0; bj < 2; ++bj)
#pragma unroll
            for (int n = 0; n < 2; ++n) bv[bj][n] = pb[bj * 2 + n];
#pragma unroll
        for (int ai = 0; ai < 2; ++ai)
#pragma unroll
            for (int m = 0; m < 4; ++m) { bf16_t* rowp = O + (size_t)(row0 + ai * HALF + m * 16) * ldc + col0;
#pragma unroll
                for (int bj = 0; bj < 2; ++bj) { const f32x4 v0 = acc[ai][bj][m][0] * scale + bv[bj][0], v1 = acc[ai][bj][m][1] * scale + bv[bj][1];
                    u32x4 w; w.x = cvt_pk_bf16(v0[0], v0[1]); w.y = cvt_pk_bf16(v0[2], v0[3]); w.z = cvt_pk_bf16(v1[0], v1[1]); w.w = cvt_pk_bf16(v1[2], v1[3]);
                    *(u32x4*)(rowp + bj * HALF) = w; } }
    }
};
template <int SECOND> struct EpiMerge {
    static constexpr bool PERM = true, AFTER_DRAIN = false;
    const bf16_t* gate; float* T; bf16_t* O;
    DI void pre(const Unit&, int, int, f32x4 (&)[4]) const {}
    DI void operator()(const f32x4 (&acc)[2][2][4][2], const Unit& u, int wr, int wc, int fr, int fq, const f32x4 (&)[4]) const {
        const int row0 = u.pm * BM + wr * 64 + fr, col0 = u.pn * BM + wc * 32 + 8 * fq;
#pragma unroll
        for (int ai = 0; ai < 2; ++ai)
#pragma unroll
            for (int mp = 0; mp < 2; ++mp) {
                u32x4 g[2][2]; f32x4 t0[2][2], t1[2][2];
#pragma unroll
                for (int mm = 0; mm < 2; ++mm)
#pragma unroll
                    for (int bj = 0; bj < 2; ++bj) { const size_t row = (size_t)(row0 + ai * HALF + (2 * mp + mm) * 16); const int col = col0 + bj * HALF;
                        g[mm][bj] = *(const u32x4*)(gate + row * NPJ + col);
                        if (SECOND) { t0[mm][bj] = *(const f32x4*)(T + row * DM + col); t1[mm][bj] = *(const f32x4*)(T + row * DM + col + 4); } }
#pragma unroll
                for (int mm = 0; mm < 2; ++mm)
#pragma unroll
                    for (int bj = 0; bj < 2; ++bj) { const int m = 2 * mp + mm; const size_t row = (size_t)(row0 + ai * HALF + m * 16); const int col = col0 + bj * HALF;
                        const u32x4 gg = g[mm][bj]; f32x4 v0 = acc[ai][bj][m][0], v1 = acc[ai][bj][m][1];
                        v0[0] *= fsig(__uint_as_float(gg.x << 16)); v0[1] *= fsig(__uint_as_float(gg.x & 0xffff0000u)); v0[2] *= fsig(__uint_as_float(gg.y << 16)); v0[3] *= fsig(__uint_as_float(gg.y & 0xffff0000u));
                        v1[0] *= fsig(__uint_as_float(gg.z << 16)); v1[1] *= fsig(__uint_as_float(gg.z & 0xffff0000u)); v1[2] *= fsig(__uint_as_float(gg.w << 16)); v1[3] *= fsig(__uint_as_float(gg.w & 0xffff0000u));
                        if (SECOND == 0) { float* tp = T + row * DM + col; *(f32x4*)tp = v0; *(f32x4*)(tp + 4) = v1; }
                        else { v0 += t0[mm][bj]; v1 += t1[mm][bj];
                            u32x4 w; w.x = cvt_pk_bf16(v0[0], v0[1]); w.y = cvt_pk_bf16(v0[2], v0[3]); w.z = cvt_pk_bf16(v1[0], v1[1]); w.w = cvt_pk_bf16(v1[2], v1[3]);
                            *(u32x4*)(O + row * DM + col) = w; } }
            }
    }
};
struct EpiResid {
    static constexpr bool PERM = false, AFTER_DRAIN = false;
    const float* x; const float* gt; float* X1;
    DI void pre(const Unit& u, int wc, int fq, f32x4 (&pb)[4]) const { const int col0 = u.pn * BM + wc * 32 + 4 * fq;
#pragma unroll
        for (int bj = 0; bj < 2; ++bj)
#pragma unroll
            for (int n = 0; n < 2; ++n) pb[bj * 2 + n] = *(const f32x4*)(gt + col0 + bj * HALF + n * 16); }
    DI void operator()(const f32x4 (&acc)[2][2][4][2], const Unit& u, int wr, int wc, int fr, int fq, const f32x4 (&pb)[4]) const {
        const int row0 = u.pm * BM + wr * 64 + fr, col0 = u.pn * BM + wc * 32 + 4 * fq;
        f32x4 gv[2][2];
#pragma unroll
        for (int bj = 0; bj < 2; ++bj)
#pragma unroll
            for (int n = 0; n < 2; ++n) gv[bj][n] = pb[bj * 2 + n];
#pragma unroll
        for (int ai = 0; ai < 2; ++ai)
#pragma unroll
            for (int mp = 0; mp < 2; ++mp) {
                f32x4 xv[2][2][2];
#pragma unroll
                for (int mm = 0; mm < 2; ++mm)
#pragma unroll
                    for (int bj = 0; bj < 2; ++bj)
#pragma unroll
                        for (int n = 0; n < 2; ++n) xv[mm][bj][n] = *(const f32x4*)(x + (size_t)(row0 + ai * HALF + (2 * mp + mm) * 16) * DM + col0 + bj * HALF + n * 16);
#pragma unroll
                for (int mm = 0; mm < 2; ++mm)
#pragma unroll
                    for (int bj = 0; bj < 2; ++bj)
#pragma unroll
                        for (int n = 0; n < 2; ++n) *(f32x4*)(X1 + (size_t)(row0 + ai * HALF + (2 * mp + mm) * 16) * DM + col0 + bj * HALF + n * 16) = xv[mm][bj][n] + gv[bj][n] * acc[ai][bj][2 * mp + mm][n];
            }
    }
};
struct EpiSwiglu {
    static constexpr bool PERM = true, AFTER_DRAIN = false;
    unsigned char* ACT; const float* bgu;
    DI void pre(const Unit& u, int wc, int fq, f32x4 (&pb)[4]) const { const float* bb = bgu + (size_t)u.e * 2048 + u.pn * HALF + wc * 32 + 8 * fq;
#pragma unroll
        for (int n = 0; n < 2; ++n) { pb[n] = *(const f32x4*)(bb + 4 * n); pb[2 + n] = *(const f32x4*)(bb + 1024 + 4 * n); } }
    DI void operator()(const f32x4 (&acc)[2][2][4][2], const Unit& u, int wr, int wc, int fr, int fq, const f32x4 (&pb)[4]) const {
        const int row0 = u.pm * BM + wr * 64 + fr, gcol = u.pn * HALF + wc * 32 + 8 * fq;
        f32x4 bg[2], bu[2];
#pragma unroll
        for (int n = 0; n < 2; ++n) { bg[n] = pb[n]; bu[n] = pb[2 + n]; }
#pragma unroll
        for (int ai = 0; ai < 2; ++ai)
#pragma unroll
            for (int m = 0; m < 4; ++m) { float r[8];
#pragma unroll
                for (int n = 0; n < 2; ++n)
#pragma unroll
                    for (int j = 0; j < 4; ++j) { float g = acc[ai][0][m][n][j] * (1.f / WSCALE) + bg[n][j], up = acc[ai][1][m][n][j] * (1.f / WSCALE) + bu[n][j];
                        g = fminf(g, 7.f); up = fminf(fmaxf(up, -7.f), 7.f);
                        r[4 * n + j] = ASCALE * (up + 1.f) * (g * fsig(1.702f * g)); }
                u32x2 w; w.x = cvt_f8x4(r[0], r[1], r[2], r[3]); w.y = cvt_f8x4(r[4], r[5], r[6], r[7]);
                *(u32x2*)(ACT + (size_t)(row0 + ai * HALF + m * 16) * DM + gcol) = w; }
    }
};
}


namespace fox {
typedef float f32x16 __attribute__((ext_vector_type(16)));
typedef short s16x4 __attribute__((ext_vector_type(4)));
constexpr float SCALE = 0.08838834764831845f;
constexpr int KVBLK = 64, SHM_K = 16384, SHM_V = 16384;
constexpr int OFF_V = 0, OFF_K = 2 * SHM_V, OFF_G = OFF_K + 2 * SHM_K, OFF_WS = OFF_G + 512, OFF_MISC = OFF_WS + 8 * 256;
constexpr float THR = 8.f;
#define KSWZ(row, colB) ((row) * 256 + ((colB) ^ (((row) & 7) << 4)))
#define SBAR() __builtin_amdgcn_sched_barrier(0)
DI int v_st(int k, int c) { const int kk = (k & ~0xC) | ((k & 4) << 1) | ((k & 8) >> 1); return ((kk >> 3) * 4 + (c >> 5)) * 512 + ((kk & 7) * 32 + (c & 31)) * 2; }
DI int v_rd_base(int lane) { return ((lane & 3) << 3) | (((lane >> 2) & 3) << 6) | (((lane >> 4) & 1) << 5) | (((lane >> 5) & 1) << 8); }
constexpr int v_rd_off(int d0, int ks, int half) { return d0 * 512 + ks * 4096 + half * 2048; }
DI int crow(int r, int hi) { return (r & 3) + 8 * (r >> 2) + 4 * hi; }
DI unsigned cvtpk(float lo, float hi) { return cvt_pk(lo, hi); }
DI void mask_tile(f32x16& p0, f32x16& p1, int dq) {
    const float NEG = -__builtin_inff();
#pragma unroll
    for (int r = 0; r < 16; ++r) { const int c = (r & 3) + 8 * (r >> 2); if (dq - c < 0) p0[r] = NEG; if (dq - c - 32 < 0) p1[r] = NEG; }
}
DI void partialSM(f32x16& p0, f32x16& p1, float& m_reg, float& mn, float& alpha) {
    float pmax = p0[0];
#pragma unroll
    for (int r = 1; r < 16; ++r) pmax = fmaxf(pmax, p0[r]);
#pragma unroll
    for (int r = 0; r < 16; ++r) pmax = fmaxf(pmax, p1[r]);
    { auto rr = __builtin_amdgcn_permlane32_swap(__float_as_uint(pmax), __float_as_uint(pmax), false, false); pmax = fmaxf(__uint_as_float(rr[0]), __uint_as_float(rr[1])); }
    constexpr float C2 = 1.4426950408889634f * SCALE;
    if (__builtin_expect(__all((pmax - m_reg) * SCALE <= THR), 1)) { mn = m_reg; alpha = 1.f; }
    else { mn = fmaxf(m_reg, pmax); alpha = __builtin_amdgcn_exp2f((m_reg - mn) * C2); m_reg = mn; }
    const float mnL = -mn * C2;
#pragma unroll
    for (int r = 0; r < 16; ++r) p0[r] = fmaf(p0[r], C2, mnL);
#pragma unroll
    for (int r = 0; r < 16; ++r) p1[r] = fmaf(p1[r], C2, mnL);
#pragma unroll
    for (int r = 0; r < 16; ++r) p0[r] = __builtin_amdgcn_exp2f(p0[r]);
}
DI void finishSM(f32x16& p0, f32x16& p1, float alpha, float& l_reg, bf16x8& pa0, bf16x8& pa1, bf16x8& pa2, bf16x8& pa3) {
#pragma unroll
    for (int r = 0; r < 16; ++r) p1[r] = __builtin_amdgcn_exp2f(p1[r]);
    float ps = 0;
#pragma unroll
    for (int r = 0; r < 16; ++r) ps += p0[r];
#pragma unroll
    for (int r = 0; r < 16; ++r) ps += p1[r];
    { auto rr = __builtin_amdgcn_permlane32_swap(__float_as_uint(ps), __float_as_uint(ps), false, false); ps = __uint_as_float(rr[0]) + __uint_as_float(rr[1]); }
    l_reg = l_reg * alpha + ps;
#define PK4(P, B_, OUT) do { unsigned a0 = cvtpk(P[B_+0], P[B_+1]), a1 = cvtpk(P[B_+2], P[B_+3]);                          \
        unsigned b0 = cvtpk(P[B_+4], P[B_+5]), b1 = cvtpk(P[B_+6], P[B_+7]);                                             \
        auto r0 = __builtin_amdgcn_permlane32_swap(a0, b0, false, false); auto r1 = __builtin_amdgcn_permlane32_swap(a1, b1, false, false); \
        u32x4 w = {r0[0], r1[0], r0[1], r1[1]}; OUT = *reinterpret_cast<bf16x8*>(&w); } while (0)
    PK4(p0, 0, pa0); PK4(p0, 8, pa1); PK4(p1, 0, pa2); PK4(p1, 8, pa3);
#undef PK4
}
DI void qkt(f32x16& p0, f32x16& p1, const char* Kb, int r32, int hi, const bf16x8* qr) {
    p0 = f32x16{}; p1 = f32x16{};
    const char* kb[4];
#pragma unroll
    for (int dd = 0; dd < 4; ++dd) kb[dd] = Kb + KSWZ(r32, (dd * 16 + hi * 8) * 2);
#pragma unroll
    for (int d0 = 0; d0 < 8; ++d0) { const char* a = kb[d0 & 3] + (d0 >> 2) * 128;
        bf16x8 b0 = *reinterpret_cast<const bf16x8*>(a);
        bf16x8 b1 = *reinterpret_cast<const bf16x8*>(a + 32 * 256);
        p0 = __builtin_amdgcn_mfma_f32_32x32x16_bf16(b0, qr[d0], p0, 0, 0, 0);
        p1 = __builtin_amdgcn_mfma_f32_32x32x16_bf16(b1, qr[d0], p1, 0, 0, 0); }
}
DI void pv_tile(f32x16* o, int vb0, bf16x8 pa0, bf16x8 pa1, bf16x8 pa2, bf16x8 pa3) {
#define TRRD(dst, off) asm volatile("ds_read_b64_tr_b16 %0, %1 offset:%2" : "=&v"(dst) : "v"(vb0), "i"(off) : "memory")
#define PV_D0(d0) do { s16x4 l0, l1, l2, l3, h0, h1, h2, h3; constexpr int b_ = v_rd_off(d0, 0, 0); \
        TRRD(l0, b_); TRRD(h0, b_ + 2048); TRRD(l1, b_ + 4096); TRRD(h1, b_ + 6144); TRRD(l2, b_ + 8192); TRRD(h2, b_ + 10240); TRRD(l3, b_ + 12288); TRRD(h3, b_ + 14336); \
        asm volatile("s_waitcnt lgkmcnt(0)" ::: "memory"); SBAR();   \
        o[d0] = __builtin_amdgcn_mfma_f32_32x32x16_bf16(pa0, (bf16x8){l0[0], l0[1], l0[2], l0[3], h0[0], h0[1], h0[2], h0[3]}, o[d0], 0, 0, 0);   \
        o[d0] = __builtin_amdgcn_mfma_f32_32x32x16_bf16(pa1, (bf16x8){l1[0], l1[1], l1[2], l1[3], h1[0], h1[1], h1[2], h1[3]}, o[d0], 0, 0, 0);   \
        o[d0] = __builtin_amdgcn_mfma_f32_32x32x16_bf16(pa2, (bf16x8){l2[0], l2[1], l2[2], l2[3], h2[0], h2[1], h2[2], h2[3]}, o[d0], 0, 0, 0);   \
        o[d0] = __builtin_amdgcn_mfma_f32_32x32x16_bf16(pa3, (bf16x8){l3[0], l3[1], l3[2], l3[3], h3[0], h3[1], h3[2], h3[3]}, o[d0], 0, 0, 0); } while (0)
    PV_D0(0); PV_D0(1); PV_D0(2); PV_D0(3);
#undef PV_D0
#undef TRRD
}
DI void fox_block(const Args& a, char* lds, int h, int P0, int j_lo) {
    const int tid = threadIdx.x, wid = __builtin_amdgcn_readfirstlane(tid >> 6), lane = tid & 63, r32 = lane & 31, hi = lane >> 5;
    const bf16_t* P = (const bf16_t*)(a.ws + WS_PROJ); const float* F = (const float*)(a.ws + WS_F) + (size_t)h * SEQ; bf16_t* OB = (bf16_t*)(a.ws + WS_OB);
    const bf16_t* Qp = P + PJ_FQ + h * 128; const bf16_t* Kp = P + PJ_FK + h * 128; const bf16_t* Vp = P + PJ_FV + h * 128;
    const int j_hi = (P0 + 255) / KVBLK + 1, NT = j_hi - j_lo;
    const int qlo = P0 + wid * 32, qm = qlo + r32 - 4 * hi;
    char* V_lds = lds + OFF_V; char* K_lds = lds + OFF_K; float* G_lds = (float*)(lds + OFF_G);
    float* wsp = (float*)(lds + OFF_WS) + wid * 64; float* li_l = wsp; float* al_l = wsp + 32;
    const int sr = tid >> 4;
    const int vb0 = (int)(unsigned)(uintptr_t)(LAS char*)V_lds + v_rd_base(lane);
    const float Fref = F[P0];
    bf16x8 qr[8];
#pragma unroll
    for (int d0 = 0; d0 < 8; ++d0) qr[d0] = *(const bf16x8*)(Qp + (size_t)(qlo + r32) * NPJ + d0 * 16 + hi * 8);
    float m_reg = -1e30f, l_reg = 0.f; f32x16 o[4] = {};
    float st_g = 0.f;
    const int ksrc = (((tid & 15) * 16) ^ ((sr & 7) << 4)) >> 1;
    const int vkk = (tid >> 7) * 8 + ((tid & 31) >> 2), vkey = (vkk & ~0xC) | ((vkk & 4) << 1) | ((vkk & 8) >> 1), vcol = ((tid >> 5) & 3) * 32 + (tid & 3) * 8;
    LAS unsigned char* ldsl = (LAS unsigned char*)lds;
#define FOX_LOAD(t, bf) do { const size_t k0_ = (size_t)(j_lo + (t)) * KVBLK; \
        __builtin_amdgcn_global_load_lds((const unsigned*)(Kp + (k0_ + sr) * NPJ + ksrc), (LAS unsigned*)(ldsl + OFF_K + (bf) * SHM_K + wid * 1024), 16, 0, 0); \
        __builtin_amdgcn_global_load_lds((const unsigned*)(Kp + (k0_ + 32 + sr) * NPJ + ksrc), (LAS unsigned*)(ldsl + OFF_K + (bf) * SHM_K + 8192 + wid * 1024), 16, 0, 0); \
        __builtin_amdgcn_global_load_lds((const unsigned*)(Vp + (k0_ + vkey) * NPJ + vcol), (LAS unsigned*)(ldsl + OFF_V + (bf) * SHM_V + wid * 1024), 16, 0, 0); \
        __builtin_amdgcn_global_load_lds((const unsigned*)(Vp + (k0_ + 32 + vkey) * NPJ + vcol), (LAS unsigned*)(ldsl + OFF_V + (bf) * SHM_V + 8192 + wid * 1024), 16, 0, 0); \
        if (tid < 64) st_g = F[k0_ + tid]; } while (0)
#define FOX_WRITE(bf) do { if (tid < 64) G_lds[(bf) * 64 + tid] = (st_g - Fref) * (1.f / SCALE); } while (0)
    FOX_LOAD(0, 0); asm volatile("s_waitcnt vmcnt(0)" ::: "memory"); FOX_WRITE(0);
    __syncthreads();
    for (int t = 0; t < NT; ++t) {
        const int bf = t & 1, kb_ = (j_lo + t) * KVBLK;
        if (t + 1 < NT) FOX_LOAD(t + 1, bf ^ 1);
        if (kb_ <= qlo + 31) {
            f32x16 p0, p1; float mn, al; bf16x8 pa0, pa1, pa2, pa3;
            qkt(p0, p1, K_lds + bf * SHM_K, r32, hi, qr);
            const float* gt = G_lds + bf * 64 + 4 * hi;
#pragma unroll
            for (int g4 = 0; g4 < 4; ++g4) { const f32x4 g0 = *(const f32x4*)(gt + 8 * g4), g1 = *(const f32x4*)(gt + 32 + 8 * g4);
#pragma unroll
                for (int i = 0; i < 4; ++i) { p0[4 * g4 + i] -= g0[i]; p1[4 * g4 + i] -= g1[i]; } }
            if (kb_ + KVBLK - 1 > qlo) mask_tile(p0, p1, qm - kb_);
            partialSM(p0, p1, m_reg, mn, al);
            finishSM(p0, p1, al, l_reg, pa0, pa1, pa2, pa3);
            if (__any(al < 1.f)) { if (hi == 0) al_l[r32] = al; asm volatile("s_waitcnt lgkmcnt(0)" ::: "memory");
#pragma unroll
                for (int d_ = 0; d_ < 4; ++d_)
#pragma unroll
                    for (int r = 0; r < 16; ++r) o[d_][r] *= al_l[crow(r, hi)]; }
            SBAR();
            pv_tile(o, vb0 + bf * SHM_V, pa0, pa1, pa2, pa3);
        }
        if (t + 1 < NT) { asm volatile("s_waitcnt vmcnt(0)" ::: "memory"); FOX_WRITE(bf ^ 1); }
        __syncthreads();
    }
#undef FOX_LOAD
#undef FOX_WRITE
    if (hi == 0) li_l[r32] = l_reg;
    asm volatile("s_waitcnt lgkmcnt(0)" ::: "memory");
    bf16_t* Ow = OB + (size_t)qlo * 512 + h * 128;
#pragma unroll
    for (int r = 0; r < 16; ++r) { const int orow = crow(r, hi); const float rl = __builtin_amdgcn_rcpf(li_l[orow]);
#pragma unroll
        for (int d0 = 0; d0 < 4; ++d0) { const float v = o[d0][r] * rl; const float vn = __shfl_xor(v, 1);
            if ((r32 & 1) == 0) *(unsigned*)(Ow + (size_t)orow * 512 + d0 * 32 + r32) = cvtpk(v, vn); } }
    __syncthreads();
}
#undef KSWZ
}

DI void transpose_tile(float* tile, const float* src, int ld, int k0, int c0, int c1, bf16_t* dst, int Kd) {
    const int tid = threadIdx.x, nn = tid & 63, k8 = tid >> 6; const int col = nn < 32 ? c0 + nn : c1 + nn - 32;
    const float* s = src + (size_t)(k0 + k8 * 8) * ld + col;
    float v[8];
#pragma unroll
    for (int i = 0; i < 8; ++i) v[i] = s[(size_t)i * ld];
    u32x4 w; w.x = cvt_pk(v[0], v[1]); w.y = cvt_pk(v[2], v[3]); w.z = cvt_pk(v[4], v[5]); w.w = cvt_pk(v[6], v[7]);
    *(u32x4*)(dst + (size_t)nn * Kd + k0 + k8 * 8) = w;
}
DI void transpose_quad(char* lds, int& par, const float* src, int ld, int k0, int c0, int c1, unsigned char* dst, int Kd) {
    const int tid = threadIdx.x, nn = tid & 63, k8 = tid >> 6; const int col = nn < 32 ? c0 + nn : c1 + nn - 32;
    const float* s = src + (size_t)(k0 + k8 * 8) * ld + col;
    float v[4][8];
#pragma unroll
    for (int kk = 0; kk < 4; ++kk)
#pragma unroll
        for (int i = 0; i < 8; ++i) v[kk][i] = s[(size_t)(kk * 64 + i) * ld];
    char* tile = lds + par * 17408; par ^= 1;
#pragma unroll
    for (int kk = 0; kk < 4; ++kk) { u32x2 w; w.x = cvt_f8x4(v[kk][0] * WSCALE, v[kk][1] * WSCALE, v[kk][2] * WSCALE, v[kk][3] * WSCALE); w.y = cvt_f8x4(v[kk][4] * WSCALE, v[kk][5] * WSCALE, v[kk][6] * WSCALE, v[kk][7] * WSCALE);
        *(u32x2*)(tile + nn * 272 + kk * 64 + k8 * 8) = w; }
    __syncthreads();
    const int rn = tid >> 3, ch = tid & 7;
#pragma unroll
    for (int q = 0; q < 2; ++q) *(u32x4*)(dst + (size_t)rn * Kd + k0 + (ch + 8 * q) * 16) = *(const u32x4*)(tile + rn * 272 + (ch + 8 * q) * 16);
}
constexpr int Q_WGU = 32 * 32 * 4, Q_WD = 32 * 16 * 4;
DI void conv_quad_gu(const Args& a, char* lds, int& par, int r) { const int e = r / 128, q = r % 128, nt = q / 4, kt = q % 4, n0 = nt * 64;
    transpose_quad(lds, par, a.in[I_WGU] + (size_t)e * DM * 2048, 2048, kt * 256, gu_src(n0), gu_src(n0 + 32), (unsigned char*)(a.ws + WS_WGUT) + ((size_t)e * 2048 + n0) * DM, DM); }
DI void conv_quad_d(const Args& a, char* lds, int& par, int r) { const int e = r / 64, q = r % 64, nt = q / 4, kt = q % 4, n0 = nt * 64;
    transpose_quad(lds, par, a.in[I_WD] + (size_t)e * DM * DM, DM, kt * 256, n0, n0 + 32, (unsigned char*)(a.ws + WS_WDT) + ((size_t)e * DM + n0) * DM, DM); }
constexpr int T_WIN = 88 * 16, T_WOA = 16 * 8, T_WOUT = 16 * 16, T_WGU = 32 * 32 * 16, T_WD = 32 * 16 * 16;
constexpr int T_SMALL = T_WIN + 2 * T_WOA + T_WOUT;
DI void conv_tile(const Args& a, float* lds, int t) {
    unsigned char* ws = a.ws; int r = t;
    if (r < T_WIN) { const int nt = r / 16, kt = r % 16, n0 = nt * 64; const int c0 = n0 + (n0 >= 3584 ? 12 : (n0 >= 2048 ? 8 : 0));
        transpose_tile(lds, a.in[I_WIN], NIN, kt * 64, c0, c0 + 32, (bf16_t*)(ws + WS_WINT) + (size_t)n0 * DM, DM); return; }
    r -= T_WIN;
    if (r < T_WOA) { const int nt = r / 8, kt = r % 8, n0 = nt * 64; transpose_tile(lds, a.in[I_WOD], DM, kt * 64, n0, n0 + 32, (bf16_t*)(ws + WS_WOAT) + (size_t)n0 * 512, 512); return; }
    r -= T_WOA;
    if (r < T_WOA) { const int nt = r / 8, kt = r % 8, n0 = nt * 64; transpose_tile(lds, a.in[I_WOF], DM, kt * 64, n0, n0 + 32, (bf16_t*)(ws + WS_WOBT) + (size_t)n0 * 512, 512); return; }
    r -= T_WOA;
    if (r < T_WOUT) { const int nt = r / 16, kt = r % 16, n0 = nt * 64; transpose_tile(lds, a.in[I_WOUT], DM, kt * 64, n0, n0 + 32, (bf16_t*)(ws + WS_WOUTT) + (size_t)n0 * DM, DM); return; }
    r -= T_WOUT;
    if (r < T_WGU) { const int e = r / 512, q = r % 512, nt = q / 16, kt = q % 16, n0 = nt * 64;
        transpose_tile(lds, a.in[I_WGU] + (size_t)e * DM * 2048, 2048, kt * 64, gu_src(n0), gu_src(n0 + 32), (bf16_t*)(ws + WS_WGUT) + ((size_t)e * 2048 + n0) * DM, DM); return; }
    r -= T_WGU;
    { const int e = r / 256, q = r % 256, nt = q / 16, kt = q % 16, n0 = nt * 64;
        transpose_tile(lds, a.in[I_WD] + (size_t)e * DM * DM, DM, kt * 64, n0, n0 + 32, (bf16_t*)(ws + WS_WDT) + ((size_t)e * DM + n0) * DM, DM); }
}
DI void ph0(const Args& a, float* lds) {
    const int tid = threadIdx.x, G = gridDim.x, bx = blockIdx.x;
    unsigned char* ws = a.ws;
    for (int grp = bx; grp < 256; grp += G) {
        const int col = tid % 24, ks = tid / 24, j = grp * 24 + col; const float* c = a.in[I_C]; const float* w = a.in[I_WADA];
        float acc = 0.f;
        if (ks < 21) { const int k1 = (ks * 49 + 49) < DM ? (ks * 49 + 49) : DM; for (int k = ks * 49; k < k1; ++k) acc += c[k] * w[(size_t)k * 6144 + j]; }
        __syncthreads();
        if (ks < 21) lds[ks * 24 + col] = acc;
        __syncthreads();
        if (tid < 24) { float s = a.in[I_BADA][grp * 24 + tid]; for (int q = 0; q < 21; ++q) s += lds[q * 24 + tid]; ((float*)(ws + WS_MOD))[grp * 24 + tid] = s; }
    }
    for (int t = bx; t < T_SMALL; t += G) conv_tile(a, lds, t);
}

DI void ph1(const Args& a, float* lds) {
    const int tid = threadIdx.x, lane = tid & 63, wave = tid >> 6, G = gridDim.x;
    float* A1 = lds; float* B1 = lds + 1024; float* wsm = lds + 2048;
    const float* mod = (const float*)(a.ws + WS_MOD);
    for (int k = tid; k < DM; k += NTHREADS) { A1[k] = a.in[I_G1][k] * (1.f + mod[1024 + k]); B1[k] = mod[k]; }
    for (int i = tid; i < 12 * DM; i += NTHREADS) { const int k = i / 12, j = i % 12; wsm[j * DM + k] = a.in[I_WIN][(size_t)k * NIN + (j < 8 ? 2048 + j : 3592 + (j - 8))]; }
    __syncthreads();
    bf16_t* H = (bf16_t*)(a.ws + WS_H); float* SP = (float*)(a.ws + WS_SP);
    for (int t0 = (blockIdx.x * NWAVES + wave) * 2; t0 < SEQ; t0 += G * NWAVES * 2) {
        f32x4 v[2][4]; float ss[2] = {0.f, 0.f};
#pragma unroll
        for (int q = 0; q < 2; ++q)
#pragma unroll
            for (int i = 0; i < 4; ++i) v[q][i] = *(const f32x4*)(a.in[I_X] + (size_t)(t0 + q) * DM + lane * 4 + 256 * i);
#pragma unroll
        for (int q = 0; q < 2; ++q)
#pragma unroll
            for (int i = 0; i < 4; ++i) ss[q] += v[q][i][0] * v[q][i][0] + v[q][i][1] * v[q][i][1] + v[q][i][2] * v[q][i][2] + v[q][i][3] * v[q][i][3];
        ss[0] = wave_sum(ss[0]); ss[1] = wave_sum(ss[1]);
#pragma unroll
        for (int q = 0; q < 2; ++q) { const float rstd = rsqrtf(ss[q] * (1.f / DM) + 1e-6f);
#pragma unroll
            for (int i = 0; i < 4; ++i) { const int k = lane * 4 + 256 * i;
#pragma unroll
                for (int e = 0; e < 4; ++e) v[q][i][e] = v[q][i][e] * rstd * A1[k + e] + B1[k + e];
                u32x2 w; w.x = cvt_pk(v[q][i][0], v[q][i][1]); w.y = cvt_pk(v[q][i][2], v[q][i][3]);
                *(u32x2*)(H + (size_t)(t0 + q) * DM + k) = w; } }
#pragma unroll 1
        for (int j = 0; j < 12; ++j) { float p0 = 0.f, p1 = 0.f;
#pragma unroll
            for (int i = 0; i < 4; ++i) { const f32x4 wv = *(const f32x4*)(wsm + j * DM + lane * 4 + 256 * i);
                p0 += v[0][i][0] * wv[0] + v[0][i][1] * wv[1] + v[0][i][2] * wv[2] + v[0][i][3] * wv[3];
                p1 += v[1][i][0] * wv[0] + v[1][i][1] * wv[1] + v[1][i][2] * wv[2] + v[1][i][3] * wv[3]; }
            p0 = wave_sum(p0); p1 = wave_sum(p1); if (lane == j) { SP[(size_t)t0 * 16 + j] = p0; SP[(size_t)(t0 + 1) * 16 + j] = p1;
                if (j >= 8) { float* LF = (float*)(a.ws + WS_LF) + (size_t)(j - 8) * SEQ; LF[t0] = p0; LF[t0 + 1] = p1; } } }
    }
}

DI void ph2(const Args& a, unsigned char* ldsb) {
    pg8::Gemm g{(const bf16_t*)(a.ws + WS_H), (const bf16_t*)(a.ws + WS_WINT), SEQ, NPJ, DM};
    pg8::OrderDense S; S.init(SEQ / 256, NPJ / 256, (int)gridDim.x, (int)blockIdx.x);
    pg8::EpiStoreBf16 E{(bf16_t*)(a.ws + WS_PROJ), NPJ, nullptr, 0, 1.f};
    pg8::gemm_phase<pg8::EpiStoreBf16, pg8::OrderDense>((LAS unsigned char*)ldsb, g, S, E);
}

DI void ph3_fcum(const Args& a, float* lds) {
    const int tid = threadIdx.x, lane = tid & 63, wave = tid >> 6, h = blockIdx.x;
    const float* LF = (const float*)(a.ws + WS_LF) + (size_t)h * SEQ + tid * 32; float* F = (float*)(a.ws + WS_F);
    const float bf = a.in[I_BFG][h];
    double* wtot = (double*)lds;
    float lf[32];
#pragma unroll
    for (int i = 0; i < 8; ++i) { const f32x4 x = *(const f32x4*)(LF + 4 * i); lf[4 * i] = x[0]; lf[4 * i + 1] = x[1]; lf[4 * i + 2] = x[2]; lf[4 * i + 3] = x[3]; }
    double s = 0.0;
#pragma unroll
    for (int i = 0; i < 32; ++i) { lf[i] = logsigf(lf[i] + bf); s += (double)lf[i]; }
    double inc = s;
#pragma unroll
    for (int o_ = 1; o_ < 64; o_ <<= 1) { const double y = __shfl_up(inc, o_); if (lane >= o_) inc += y; }
    __syncthreads();
    if (lane == 63) wtot[wave] = inc;
    __syncthreads();
    double off = inc - s;
    for (int w = 0; w < wave; ++w) off += wtot[w];
#pragma unroll
    for (int i = 0; i < 32; ++i) { off += (double)lf[i]; lf[i] = (float)off; }
#pragma unroll
    for (int i = 0; i < 8; ++i) *(f32x4*)(F + (size_t)h * SEQ + tid * 32 + 4 * i) = (f32x4){lf[4 * i], lf[4 * i + 1], lf[4 * i + 2], lf[4 * i + 3]};
    __syncthreads();
}
namespace prep {
constexpr int QS = 0, KS = 17408, KT = 34816, VT = 53248, UNIT = 71680, SM = 2 * UNIT;
DI bf16x8 ld8(const char* p) { return *(const bf16x8*)p; }
template <int C, int M4> struct TRow { static DI void run(const float (&T)[64], const float* Ls, float& a0, float& a1) {
    if constexpr (4 * M4 < C) { const f32x4 Lv = *(const f32x4*)(Ls + C * 68 + 4 * M4);
        a0 -= Lv[0] * T[4 * M4]; if constexpr (4 * M4 + 1 < C) a1 -= Lv[1] * T[4 * M4 + 1]; if constexpr (4 * M4 + 2 < C) a0 -= Lv[2] * T[4 * M4 + 2]; if constexpr (4 * M4 + 3 < C) a1 -= Lv[3] * T[4 * M4 + 3];
        TRow<C, M4 + 1>::run(T, Ls, a0, a1); } } };
template <int C> struct TRow<C, 16> { static DI void run(const float (&)[64], const float*, float&, float&) {} };
template <int C> DI void tsolve(float (&T)[64], const float* Ls, int lane) {
    if constexpr (C < 64) { float a0 = (lane == C) ? 1.f : 0.f, a1 = 0.f; TRow<C, 0>::run(T, Ls, a0, a1); T[C] = a0 + a1; asm volatile("" ::: "memory"); __builtin_amdgcn_sched_barrier(0); tsolve<C + 1>(T, Ls, lane); } }
}
DI void ph3_prep2(const Args& a, char* lds, int pair) {
    using namespace prep;
    const int tid = threadIdx.x, lane = tid & 63, wave = tid >> 6, grp = wave >> 2, wq = wave & 3, tg = tid & 255, lr = lane & 15, lq = lane >> 4;
    int unit = pair * 2 + grp; if (unit >= NH * NCH) unit = NH * NCH - 1;
    const int h = unit & 3, n = unit >> 2, t0 = n * CH;
    char* U = lds + grp * UNIT;
    float* gcs = (float*)(lds + SM) + grp * 192; float* bes = gcs + 64; float* egs = gcs + 128;
    const float* SP = (const float*)(a.ws + WS_SP); const bf16_t* P = (const bf16_t*)(a.ws + WS_PROJ);
    const size_t cb = (size_t)(h * NCH + n);
    bf16_t* WF = (bf16_t*)(a.ws + WS_DNW) + cb * 8192; bf16_t* UF = (bf16_t*)(a.ws + WS_DNU) + cb * 8192;
    bf16_t* QF = (bf16_t*)(a.ws + WS_DNQD) + cb * 8192; bf16_t* KF = (bf16_t*)(a.ws + WS_DNKD) + cb * 8192; bf16_t* AF = (bf16_t*)(a.ws + WS_DNATT) + cb * 4096;
    __syncthreads();
    if (wq == 0) { const int t = t0 + lane;
        const float be = sigm(SP[(size_t)t * 16 + h]);
        float g = -expf(a.in[I_ALOG][h]) * softplusf(SP[(size_t)t * 16 + 4 + h] + a.in[I_DTB][h]);
#pragma unroll
        for (int o_ = 1; o_ < 64; o_ <<= 1) { const float y = __shfl_up(g, o_); if (lane >= o_) g += y; }
        gcs[lane] = g; bes[lane] = be; egs[lane] = expf(g); }
    __syncthreads();
    { const int d8 = tg & 15, ci = tg >> 4; const float* cw = a.in[I_CONVW];
#pragma unroll 1
        for (int sec = 0; sec < 3; ++sec) {
            const int col = sec * 512 + h * 128 + d8 * 8;
            f32x4 w[4][2];
#pragma unroll
            for (int j = 0; j < 4; ++j) { w[j][0] = *(const f32x4*)(cw + j * 1536 + col); w[j][1] = *(const f32x4*)(cw + j * 1536 + col + 4); }
#pragma unroll 1
          for (int ih = 0; ih < 2; ++ih) {
            u32x4 xin[2][4];
#pragma unroll
            for (int i = 0; i < 2; ++i)
#pragma unroll
                for (int j = 0; j < 4; ++j) { int tt = t0 + ci + 16 * (2 * ih + i) - 3 + j; tt = tt < 0 ? 0 : tt; xin[i][j] = *(const u32x4*)(P + (size_t)tt * NPJ + col); }
#pragma unroll
            for (int i = 0; i < 2; ++i) { const int c = ci + 16 * (2 * ih + i), t = t0 + c;
                float v[8];
#pragma unroll
                for (int e = 0; e < 8; ++e) v[e] = 0.f;
#pragma unroll
                for (int j = 0; j < 4; ++j) { const float ok = (t - 3 + j >= 0) ? 1.f : 0.f; const u32x4 x = xin[i][j];
                    v[0] += ok * w[j][0][0] * __uint_as_float(x.x << 16); v[1] += ok * w[j][0][1] * __uint_as_float(x.x & 0xffff0000u); v[2] += ok * w[j][0][2] * __uint_as_float(x.y << 16); v[3] += ok * w[j][0][3] * __uint_as_float(x.y & 0xffff0000u);
                    v[4] += ok * w[j][1][0] * __uint_as_float(x.z << 16); v[5] += ok * w[j][1][1] * __uint_as_float(x.z & 0xffff0000u); v[6] += ok * w[j][1][2] * __uint_as_float(x.w << 16); v[7] += ok * w[j][1][3] * __uint_as_float(x.w & 0xffff0000u); }
                float ss = 0.f;
#pragma unroll
                for (int e = 0; e < 8; ++e) { v[e] = siluf(v[e]); ss += v[e] * v[e]; }
                if (sec < 2) { ss += __shfl_xor(ss, 1); ss += __shfl_xor(ss, 2); ss += __shfl_xor(ss, 4); ss += __shfl_xor(ss, 8);
                    const float sc = rsqrtf(ss + 1e-6f) * (sec == 0 ? 0.08838834764831845f : 1.f);
#pragma unroll
                    for (int e = 0; e < 8; ++e) v[e] *= sc; }
                u32x4 pk; pk.x = cvt_pk(v[0], v[1]); pk.y = cvt_pk(v[2], v[3]); pk.z = cvt_pk(v[4], v[5]); pk.w = cvt_pk(v[6], v[7]);
                if (sec == 0) { *(u32x4*)(U + QS + c * 272 + d8 * 16) = pk;
                    const float eg = egs[c];
                    const int base = (((c >> 4) * 4 + (d8 >> 2)) * 64 + (c & 15)) * 8 + 4 * ((d8 & 3) >> 1), l0 = (2 * (d8 & 3)) & 3;
                    u32x2 q0, q1; q0.x = cvt_pk(v[0] * eg, v[1] * eg); q0.y = cvt_pk(v[2] * eg, v[3] * eg); q1.x = cvt_pk(v[4] * eg, v[5] * eg); q1.y = cvt_pk(v[6] * eg, v[7] * eg);
                    *(u32x2*)(QF + base + l0 * 128) = q0; *(u32x2*)(QF + base + (l0 + 1) * 128) = q1; }
                else { if (sec == 1) *(u32x4*)(U + KS + c * 272 + d8 * 16) = pk;
                    bf16_t* T_ = (bf16_t*)(U + (sec == 1 ? KT : VT)) + (d8 * 8) * 72 + c;
                    T_[0 * 72] = (bf16_t)(pk.x & 0xffffu); T_[1 * 72] = (bf16_t)(pk.x >> 16); T_[2 * 72] = (bf16_t)(pk.y & 0xffffu); T_[3 * 72] = (bf16_t)(pk.y >> 16);
                    T_[4 * 72] = (bf16_t)(pk.z & 0xffffu); T_[5 * 72] = (bf16_t)(pk.z >> 16); T_[6 * 72] = (bf16_t)(pk.w & 0xffffu); T_[7 * 72] = (bf16_t)(pk.w >> 16); }
            }
          }
        }
    }
    __syncthreads();
    f32x4 Lr[4];
    { const int mt = wq;
#pragma unroll
        for (int nt = 0; nt < 4; ++nt) { Lr[nt] = (f32x4){0.f, 0.f, 0.f, 0.f};
            if (nt <= mt) {
#pragma unroll
                for (int s = 0; s < 4; ++s) Lr[nt] = MFMA16(ld8(U + KS + (16 * mt + lr) * 272 + (32 * s + 8 * lq) * 2), ld8(U + KS + (16 * nt + lr) * 272 + (32 * s + 8 * lq) * 2), Lr[nt]); } }
        const int ntq = 3 - wq; const float gcc = gcs[16 * ntq + lr];
#pragma unroll
        for (int mtk = 0; mtk < 4; ++mtk) { f32x4 acc = (f32x4){0.f, 0.f, 0.f, 0.f};
            if (mtk <= ntq) {
#pragma unroll
                for (int s = 0; s < 4; ++s) acc = MFMA16(ld8(U + KS + (16 * mtk + lr) * 272 + (32 * s + 8 * lq) * 2), ld8(U + QS + (16 * ntq + lr) * 272 + (32 * s + 8 * lq) * 2), acc);
#pragma unroll
                for (int r = 0; r < 4; ++r) { const int m = 16 * mtk + 4 * lq + r, c = 16 * ntq + lr; acc[r] = (m <= c) ? acc[r] * expf(gcc - gcs[m]) : 0.f; } }
            u32x2 o_; o_.x = cvt_pk(acc[0], acc[1]); o_.y = cvt_pk(acc[2], acc[3]);
            *(u32x2*)(AF + ((ntq * 2 + (mtk >> 1)) * 64 + lane) * 8 + 4 * (mtk & 1)) = o_; }
    }
    __syncthreads();
    { const int mt = wq; float* LT = (float*)(U + QS);
#pragma unroll
        for (int nt = 0; nt < 4; ++nt) if (nt <= mt) { const int m = 16 * nt + lr; f32x4 o_;
#pragma unroll
            for (int r = 0; r < 4; ++r) { const int c = 16 * mt + 4 * lq + r; o_[r] = (m < c) ? bes[c] * Lr[nt][r] * expf(gcs[c] - gcs[m]) : 0.f; }
            *(f32x4*)(LT + m * 68 + 16 * mt + 4 * lq) = o_; } }
    __syncthreads();
    if (wq == 0) { const float* LT = (const float*)(U + QS); float* Tl = (float*)(U + KS);
#pragma unroll
        for (int ib = 0; ib < 4; ++ib) { float acc[16];
#pragma unroll
            for (int r = 0; r < 16; ++r) acc[r] = (lane == 16 * ib + r) ? 1.f : 0.f;
#pragma unroll 2
            for (int m = 0; m < 16 * ib; ++m) { const float t = Tl[m * 68 + lane];
#pragma unroll
                for (int q = 0; q < 4; ++q) { const f32x4 Lv = *(const f32x4*)(LT + m * 68 + 16 * ib + 4 * q);
#pragma unroll
                    for (int e = 0; e < 4; ++e) acc[4 * q + e] -= Lv[e] * t; } }
#pragma unroll
            for (int p = 0; p < 16; ++p) { const float t = acc[p]; Tl[(16 * ib + p) * 68 + lane] = t;
                if (p < 15) {
#pragma unroll
                    for (int q = 0; q < 4; ++q) if (4 * q + 3 > p) { const f32x4 Lv = *(const f32x4*)(LT + (16 * ib + p) * 68 + 16 * ib + 4 * q);
#pragma unroll
                        for (int e = 0; e < 4; ++e) if (4 * q + e > p) acc[4 * q + e] -= Lv[e] * t; } } }
            asm volatile("s_waitcnt lgkmcnt(0)" ::: "memory"); }
        if (lane == 0) ((float*)(a.ws + WS_EG))[cb] = egs[63];
    } else { const float gl = gcs[63];
        for (int i = tg - 64; i < 2048; i += 192) { const int dk = i >> 4, cq = i & 15;
            const u32x2 x = *(const u32x2*)(U + KT + dk * 144 + cq * 8);
            const float e0 = expf(gl - gcs[4 * cq]), e1 = expf(gl - gcs[4 * cq + 1]), e2 = expf(gl - gcs[4 * cq + 2]), e3 = expf(gl - gcs[4 * cq + 3]);
            u32x2 o_; o_.x = cvt_pk(__uint_as_float(x.x << 16) * e0, __uint_as_float(x.x & 0xffff0000u) * e1); o_.y = cvt_pk(__uint_as_float(x.y << 16) * e2, __uint_as_float(x.y & 0xffff0000u) * e3);
            *(u32x2*)(KF + (((dk >> 4) * 2 + (cq >> 3)) * 64 + (cq & 3) * 16 + (dk & 15)) * 8 + 4 * ((cq >> 2) & 1)) = o_; } }
    __syncthreads();
    { const float* Tl = (const float*)(U + KS); const int c = tg >> 2, m0 = (tg & 3) * 16;
        f32x4 tv[4];
#pragma unroll
        for (int q = 0; q < 4; ++q) tv[q] = *(const f32x4*)(Tl + c * 68 + m0 + 4 * q);
        __syncthreads();
        bf16_t* Tb = (bf16_t*)(U + QS); bf16_t* Tg = (bf16_t*)(U + KS);
#pragma unroll
        for (int q = 0; q < 4; ++q) { u32x2 b_, g_; float be[4], bg[4];
#pragma unroll
            for (int e = 0; e < 4; ++e) { const int m = m0 + 4 * q + e; be[e] = tv[q][e] * bes[m]; bg[e] = be[e] * egs[m]; }
            b_.x = cvt_pk(be[0], be[1]); b_.y = cvt_pk(be[2], be[3]); g_.x = cvt_pk(bg[0], bg[1]); g_.y = cvt_pk(bg[2], bg[3]);
            *(u32x2*)(Tb + c * 72 + m0 + 4 * q) = b_; *(u32x2*)(Tg + c * 72 + m0 + 4 * q) = g_; } }
    __syncthreads();
    {
#pragma unroll
        for (int q = 0; q < 2; ++q) { const int nt = 2 * wq + q;
#pragma unroll
            for (int mt = 0; mt < 4; ++mt) { f32x4 acc = (f32x4){0.f, 0.f, 0.f, 0.f};
#pragma unroll
                for (int s = 0; s < 2; ++s) acc = MFMA16(ld8(U + QS + (16 * mt + lr) * 144 + (32 * s + 8 * lq) * 2), ld8(U + VT + (16 * nt + lr) * 144 + (32 * s + 8 * lq) * 2), acc);
                u32x2 o_; o_.x = cvt_pk(acc[0], acc[1]); o_.y = cvt_pk(acc[2], acc[3]);
                *(u32x2*)(UF + ((nt * 4 + mt) * 64 + lane) * 4) = o_; } }
#pragma unroll
        for (int q = 0; q < 2; ++q) { const int mtk = 2 * wq + q;
#pragma unroll
            for (int ntc = 0; ntc < 4; ++ntc) { f32x4 acc = (f32x4){0.f, 0.f, 0.f, 0.f};
#pragma unroll
                for (int s = 0; s < 2; ++s) acc = MFMA16(ld8(U + KT + (16 * mtk + lr) * 144 + (32 * s + 8 * lq) * 2), ld8(U + KS + (16 * ntc + lr) * 144 + (32 * s + 8 * lq) * 2), acc);
                u32x2 o_; o_.x = cvt_pk(-acc[0], -acc[1]); o_.y = cvt_pk(-acc[2], -acc[3]);
                *(u32x2*)(WF + ((ntc * 4 + (mtk >> 1)) * 64 + lane) * 8 + 4 * (mtk & 1)) = o_; } }
    }
}
DI void ph3_norms(const Args& a, float* lds) {
    const int lane = threadIdx.x & 63, wave = threadIdx.x >> 6, NW = gridDim.x * NWAVES, sub = lane >> 4, l16 = lane & 15;
    const bf16_t* P = (const bf16_t*)(a.ws + WS_PROJ); float* TB = (float*)(a.ws + WS_NRMT);
    for (int grp = blockIdx.x * NWAVES + wave; grp < SEQ / 8; grp += NW) {
        float mq[4] = {0.f, 0.f, 0.f, 0.f}, mk[4] = {0.f, 0.f, 0.f, 0.f}, md[4] = {3.0e38f, 3.0e38f, 3.0e38f, 3.0e38f};
#pragma unroll
        for (int it = 0; it < 2; ++it) { const bf16_t* row = P + (size_t)(grp * 8 + it * 4 + sub) * NPJ + l16 * 8;
            u32x4 xq[4], xk[4];
#pragma unroll
            for (int h = 0; h < 4; ++h) { xq[h] = *(const u32x4*)(row + PJ_FQ + h * 128); xk[h] = *(const u32x4*)(row + PJ_FK + h * 128); }
#pragma unroll
            for (int h = 0; h < 4; ++h) { float sq = 0.f, sk = 0.f, sd = 0.f;
#pragma unroll
                for (int e = 0; e < 4; ++e) { const float a0 = __uint_as_float(xq[h][e] << 16), a1 = __uint_as_float(xq[h][e] & 0xffff0000u), b0 = __uint_as_float(xk[h][e] << 16), b1 = __uint_as_float(xk[h][e] & 0xffff0000u);
                    sq += a0 * a0 + a1 * a1; sk += b0 * b0 + b1 * b1; sd += a0 * b0 + a1 * b1; }
#pragma unroll
                for (int o_ = 1; o_ <= 8; o_ <<= 1) { sq += __shfl_xor(sq, o_); sk += __shfl_xor(sk, o_); sd += __shfl_xor(sd, o_); }
                mq[h] = fmaxf(mq[h], sq); mk[h] = fmaxf(mk[h], sk); md[h] = fminf(md[h], sd); } }
#pragma unroll
        for (int h = 0; h < 4; ++h) { mq[h] = fmaxf(mq[h], __shfl_xor(mq[h], 16)); mq[h] = fmaxf(mq[h], __shfl_xor(mq[h], 32)); mk[h] = fmaxf(mk[h], __shfl_xor(mk[h], 16)); mk[h] = fmaxf(mk[h], __shfl_xor(mk[h], 32));
            md[h] = fminf(md[h], __shfl_xor(md[h], 16)); md[h] = fminf(md[h], __shfl_xor(md[h], 32));
            if (lane == 0) { TB[grp * 12 + h] = mq[h]; TB[grp * 12 + 4 + h] = mk[h]; TB[grp * 12 + 8 + h] = md[h]; } }
    }
}
DI void ph3(const Args& a, float* lds) {
    const int G = gridDim.x;
    if (blockIdx.x < 4) ph3_fcum(a, lds);
    for (int p = blockIdx.x; p < NH * NCH / 2; p += G) ph3_prep2(a, (char*)lds, p);
    ph3_norms(a, lds);
}

namespace dn {
DI unsigned cvtpk(float lo, float hi) { return cvt_pk(lo, hi); }
DI bf16x8 packB(const f32x4& t0, const f32x4& t1) { u32x4 w = {cvtpk(t0[0], t0[1]), cvtpk(t0[2], t0[3]), cvtpk(t1[0], t1[1]), cvtpk(t1[2], t1[3])}; return *reinterpret_cast<bf16x8*>(&w); }
DI bf16x8 frag(const bf16_t* base, int f, int lane) { return *(const bf16x8*)(base + ((size_t)f * 64 + lane) * 8); }
template <bool WITH_U, bool WITH_O>
DI void step(const bf16_t* WFn, const bf16_t* KFn, const bf16_t* QFn, const bf16_t* AFn, const bf16_t* UFs, float eg, f32x4 (&S)[8], f32x4 (&o)[4], int lane) {
    bf16x8 sb[4];
#pragma unroll
    for (int s = 0; s < 4; ++s) sb[s] = packB(S[2 * s], S[2 * s + 1]);
    f32x4 vn[4];
#pragma unroll
    for (int mt = 0; mt < 4; ++mt) {
        if (WITH_U) { const u32x2 w = *(const u32x2*)(UFs + ((size_t)mt * 64 + lane) * 4); vn[mt] = (f32x4){__uint_as_float(w.x << 16), __uint_as_float(w.x & 0xffff0000u), __uint_as_float(w.y << 16), __uint_as_float(w.y & 0xffff0000u)}; }
        else vn[mt] = (f32x4){0.f, 0.f, 0.f, 0.f};
#pragma unroll
        for (int s = 0; s < 4; ++s) vn[mt] = MFMA16(frag(WFn, mt * 4 + s, lane), sb[s], vn[mt]); }
    if (WITH_O) {
#pragma unroll
        for (int mt = 0; mt < 4; ++mt) { o[mt] = (f32x4){0.f, 0.f, 0.f, 0.f};
#pragma unroll
            for (int s = 0; s < 4; ++s) o[mt] = MFMA16(frag(QFn, mt * 4 + s, lane), sb[s], o[mt]); } }
    bf16x8 vb[2];
#pragma unroll
    for (int s = 0; s < 2; ++s) vb[s] = packB(vn[2 * s], vn[2 * s + 1]);
    if (WITH_O) {
#pragma unroll
        for (int mt = 0; mt < 4; ++mt)
#pragma unroll
            for (int s = 0; s < 2; ++s) o[mt] = MFMA16(frag(AFn, mt * 2 + s, lane), vb[s], o[mt]); }
#pragma unroll
    for (int mt = 0; mt < 8; ++mt) { S[mt] = S[mt] * eg;
#pragma unroll
        for (int s = 0; s < 2; ++s) S[mt] = MFMA16(frag(KFn, mt * 2 + s, lane), vb[s], S[mt]); }
}
}
constexpr int NGRP = 16, GRP = 16;
constexpr int NSCAN = NH * NGRP;
constexpr int SBUF = 57344;
template <int N> struct Stage { u32x4 r[N]; };
DI void stage_load2(Stage<4>& st, const bf16_t* s0, const bf16_t* s1) {
    const int tid = threadIdx.x;
    st.r[0] = *(const u32x4*)(s0 + (size_t)tid * 8); st.r[1] = *(const u32x4*)(s0 + (size_t)(tid + 512) * 8);
    st.r[2] = *(const u32x4*)(s1 + (size_t)tid * 8); st.r[3] = *(const u32x4*)(s1 + (size_t)(tid + 512) * 8);
}
DI void stage_write2(const Stage<4>& st, char* buf) {
    const int tid = threadIdx.x;
    *(u32x4*)(buf + tid * 16) = st.r[0]; *(u32x4*)(buf + (tid + 512) * 16) = st.r[1];
    *(u32x4*)(buf + 16384 + tid * 16) = st.r[2]; *(u32x4*)(buf + 16384 + (tid + 512) * 16) = st.r[3];
}
DI void stage_load4(Stage<7>& st, const bf16_t* s0, const bf16_t* s1, const bf16_t* s2, const bf16_t* s3) {
    const int tid = threadIdx.x;
    st.r[0] = *(const u32x4*)(s0 + (size_t)tid * 8); st.r[1] = *(const u32x4*)(s0 + (size_t)(tid + 512) * 8);
    st.r[2] = *(const u32x4*)(s1 + (size_t)tid * 8); st.r[3] = *(const u32x4*)(s1 + (size_t)(tid + 512) * 8);
    st.r[4] = *(const u32x4*)(s2 + (size_t)tid * 8); st.r[5] = *(const u32x4*)(s2 + (size_t)(tid + 512) * 8);
    st.r[6] = *(const u32x4*)(s3 + (size_t)tid * 8);
}
DI void stage_write4(const Stage<7>& st, char* buf) {
    const int tid = threadIdx.x;
    *(u32x4*)(buf + tid * 16) = st.r[0]; *(u32x4*)(buf + (tid + 512) * 16) = st.r[1];
    *(u32x4*)(buf + 16384 + tid * 16) = st.r[2]; *(u32x4*)(buf + 16384 + (tid + 512) * 16) = st.r[3];
    *(u32x4*)(buf + 32768 + tid * 16) = st.r[4]; *(u32x4*)(buf + 32768 + (tid + 512) * 16) = st.r[5];
    *(u32x4*)(buf + 49152 + tid * 16) = st.r[6];
}
DI f32x4 u_unpack(const u32x2 w) { return (f32x4){__uint_as_float(w.x << 16), __uint_as_float(w.x & 0xffff0000u), __uint_as_float(w.y << 16), __uint_as_float(w.y & 0xffff0000u)}; }
DI void scanA_chain(const Args& a, char* lds, int chain) {
    const int tid = threadIdx.x, lane = tid & 63, vs = tid >> 6, lr = lane & 15, lq = lane >> 4;
    const int h = chain >> 4, g = chain & 15;
    f32x4 SQ[8], SP[8];
#pragma unroll
    for (int mt = 0; mt < 8; ++mt) { SQ[mt] = (f32x4){0.f, 0.f, 0.f, 0.f};
#pragma unroll
        for (int r = 0; r < 4; ++r) SP[mt][r] = (16 * mt + 4 * lq + r == 16 * vs + lr) ? 1.f : 0.f; }
    const size_t cb0 = (size_t)(h * NCH + g * GRP);
    const bf16_t* WF = (const bf16_t*)(a.ws + WS_DNW) + cb0 * 8192; const bf16_t* KF = (const bf16_t*)(a.ws + WS_DNKD) + cb0 * 8192;
    const bf16_t* UF = (const bf16_t*)(a.ws + WS_DNU) + cb0 * 8192 + (size_t)vs * 1024; const float* EG = (const float*)(a.ws + WS_EG) + cb0;
    Stage<4> st; u32x2 ucur[4], unxt[4];
    __syncthreads();
    stage_load2(st, WF, KF);
#pragma unroll
    for (int mt = 0; mt < 4; ++mt) ucur[mt] = *(const u32x2*)(UF + ((size_t)mt * 64 + lane) * 4);
    asm volatile("s_waitcnt vmcnt(0)" ::: "memory");
    stage_write2(st, lds);
    __syncthreads();
    for (int i = 0; i < GRP; ++i) {
        const char* buf = lds + (i & 1) * SBUF;
        if (i + 1 < GRP) { stage_load2(st, WF + (size_t)(i + 1) * 8192, KF + (size_t)(i + 1) * 8192);
#pragma unroll
            for (int mt = 0; mt < 4; ++mt) unxt[mt] = *(const u32x2*)(UF + (size_t)(i + 1) * 8192 + ((size_t)mt * 64 + lane) * 4); }
        const float eg = EG[i];
        const bf16_t* Wl = (const bf16_t*)buf; const bf16_t* Kl = (const bf16_t*)(buf + 16384);
        bf16x8 sbq[4], sbp[4];
#pragma unroll
        for (int s = 0; s < 4; ++s) { sbq[s] = dn::packB(SQ[2 * s], SQ[2 * s + 1]); sbp[s] = dn::packB(SP[2 * s], SP[2 * s + 1]); }
        f32x4 vq[4], vp[4];
#pragma unroll
        for (int mt = 0; mt < 4; ++mt) { vq[mt] = u_unpack(ucur[mt]); vp[mt] = (f32x4){0.f, 0.f, 0.f, 0.f};
#pragma unroll
            for (int s = 0; s < 4; ++s) { const bf16x8 f = dn::frag(Wl, mt * 4 + s, lane); vq[mt] = MFMA16(f, sbq[s], vq[mt]); vp[mt] = MFMA16(f, sbp[s], vp[mt]); } }
        bf16x8 vbq[2], vbp[2];
#pragma unroll
        for (int s = 0; s < 2; ++s) { vbq[s] = dn::packB(vq[2 * s], vq[2 * s + 1]); vbp[s] = dn::packB(vp[2 * s], vp[2 * s + 1]); }
#pragma unroll
        for (int mt = 0; mt < 8; ++mt) { SQ[mt] = SQ[mt] * eg; SP[mt] = SP[mt] * eg;
#pragma unroll
            for (int s = 0; s < 2; ++s) { const bf16x8 f = dn::frag(Kl, mt * 2 + s, lane); SQ[mt] = MFMA16(f, vbq[s], SQ[mt]); SP[mt] = MFMA16(f, vbp[s], SP[mt]); } }
        if (i + 1 < GRP) { asm volatile("s_waitcnt vmcnt(0)" ::: "memory"); stage_write2(st, lds + ((i + 1) & 1) * SBUF);
#pragma unroll
            for (int mt = 0; mt < 4; ++mt) ucur[mt] = unxt[mt]; }
        __syncthreads();
    }
    bf16_t* PG = (bf16_t*)(a.ws + WS_PG) + (size_t)chain * 16384;
#pragma unroll
    for (int mt = 0; mt < 8; ++mt)
#pragma unroll
        for (int r = 0; r < 4; ++r) PG[((mt * 4 + (vs >> 1)) * 64 + (lr >> 2) * 16 + 4 * lq + r) * 8 + 4 * (vs & 1) + (lr & 3)] = f2bf(SP[mt][r]);
    float* QG = (float*)(a.ws + WS_QG) + ((size_t)chain * 8 + vs) * 2048;
#pragma unroll
    for (int mt = 0; mt < 8; ++mt) *(f32x4*)(QG + ((size_t)mt * 64 + lane) * 4) = SQ[mt];
}
DI void scanPC_chain(const Args& a, char* lds, int chain, int half) {
    const int tid = threadIdx.x, lane = tid & 63, wv = tid >> 6, vs = (wv & 3) + 4 * half, lr = lane & 15, lq = lane >> 4; const bool cw = wv < 4;
    const int h = chain >> 4, g = chain & 15;
    f32x4 S[8];
#pragma unroll
    for (int mt = 0; mt < 8; ++mt) S[mt] = (f32x4){0.f, 0.f, 0.f, 0.f};
    __syncthreads();
    if (g > 0) {
        const bf16_t* PG = (const bf16_t*)(a.ws + WS_PG) + (size_t)(h * NGRP) * 16384; const float* QG = (const float*)(a.ws + WS_QG) + ((size_t)(h * NGRP) * 8 + vs) * 2048;
        Stage<4> P0, P1; f32x4 Q0[8], Q1[8];
#define PF_LOAD(PR, QR, j_) do { stage_load2(PR, PG + (size_t)(j_) * 16384, PG + (size_t)(j_) * 16384 + 8192); \
            _Pragma("unroll") for (int mt = 0; mt < 8; ++mt) QR[mt] = *(const f32x4*)(QG + (size_t)(j_) * 16384 + ((size_t)mt * 64 + lane) * 4); } while (0)
#define PF_STEP(j_, BUF, QC, PC, PN) do { \
            f32x4 acc_[8]; _Pragma("unroll") for (int mt = 0; mt < 8; ++mt) acc_[mt] = QC[mt]; \
            if ((j_) + 2 < g) PF_LOAD(PC, QC, (j_) + 2); \
            if (cw) { const bf16_t* Pl = (const bf16_t*)(lds + (BUF) * SBUF); bf16x8 sb[4]; \
            _Pragma("unroll") for (int s = 0; s < 4; ++s) sb[s] = dn::packB(S[2 * s], S[2 * s + 1]); \
            _Pragma("unroll") for (int mt = 0; mt < 8; ++mt) { f32x4 ac = acc_[mt]; \
                _Pragma("unroll") for (int s = 0; s < 4; ++s) ac = MFMA16(dn::frag(Pl, mt * 4 + s, lane), sb[s], ac); \
                S[mt] = ac; } } \
            if ((j_) + 1 < g) stage_write2(PN, lds + ((BUF) ^ 1) * SBUF); \
            __syncthreads(); } while (0)
        PF_LOAD(P0, Q0, 0);
        if (g > 1) PF_LOAD(P1, Q1, 1);
        stage_write2(P0, lds);
        __syncthreads();
        for (int j = 0; j < g; j += 2) { PF_STEP(j, 0, Q0, P0, P1); if (j + 1 < g) PF_STEP(j + 1, 1, Q1, P1, P0); }
#undef PF_LOAD
#undef PF_STEP
    }
    const size_t cb0 = (size_t)(h * NCH + g * GRP);
    const bf16_t* WF = (const bf16_t*)(a.ws + WS_DNW) + cb0 * 8192; const bf16_t* KF = (const bf16_t*)(a.ws + WS_DNKD) + cb0 * 8192;
    const bf16_t* QF = (const bf16_t*)(a.ws + WS_DNQD) + cb0 * 8192; const bf16_t* AF = (const bf16_t*)(a.ws + WS_DNATT) + cb0 * 4096;
    const bf16_t* UF = (const bf16_t*)(a.ws + WS_DNU) + cb0 * 8192 + (size_t)vs * 1024; const float* EG = (const float*)(a.ws + WS_EG) + cb0;
    float* ORAW = (float*)(a.ws + WS_ORAW);
    Stage<7> R0, R1; u32x2 U0[4], U1[4];
#define PC_LOAD(RR, UU, i_) do { stage_load4(RR, WF + (size_t)(i_) * 8192, KF + (size_t)(i_) * 8192, QF + (size_t)(i_) * 8192, AF + (size_t)(i_) * 4096); \
        _Pragma("unroll") for (int mt = 0; mt < 4; ++mt) UU[mt] = *(const u32x2*)(UF + (size_t)(i_) * 8192 + ((size_t)mt * 64 + lane) * 4); } while (0)
#define PC_STEP(i_, BUF, RC, UC, RN) do { \
        const char* buf = lds + (BUF) * SBUF; const int n = g * GRP + (i_); \
        f32x4 vn[4], o[4]; \
        _Pragma("unroll") for (int mt = 0; mt < 4; ++mt) { vn[mt] = u_unpack(UC[mt]); o[mt] = (f32x4){0.f, 0.f, 0.f, 0.f}; } \
        if ((i_) + 2 < GRP) PC_LOAD(RC, UC, (i_) + 2); \
        const float eg = EG[(i_)]; \
        const bf16_t* Wl = (const bf16_t*)buf; const bf16_t* Kl = (const bf16_t*)(buf + 16384); const bf16_t* Ql = (const bf16_t*)(buf + 32768); const bf16_t* Al = (const bf16_t*)(buf + 49152); \
        if (cw) { bf16x8 sb[4]; \
        _Pragma("unroll") for (int s = 0; s < 4; ++s) sb[s] = dn::packB(S[2 * s], S[2 * s + 1]); \
        _Pragma("unroll") for (int mt = 0; mt < 4; ++mt) { \
            _Pragma("unroll") for (int s = 0; s < 4; ++s) { vn[mt] = MFMA16(dn::frag(Wl, mt * 4 + s, lane), sb[s], vn[mt]); o[mt] = MFMA16(dn::frag(Ql, mt * 4 + s, lane), sb[s], o[mt]); } } \
        bf16x8 vb[2]; \
        _Pragma("unroll") for (int s = 0; s < 2; ++s) vb[s] = dn::packB(vn[2 * s], vn[2 * s + 1]); \
        _Pragma("unroll") for (int mt = 0; mt < 4; ++mt) \
            _Pragma("unroll") for (int s = 0; s < 2; ++s) o[mt] = MFMA16(dn::frag(Al, mt * 2 + s, lane), vb[s], o[mt]); \
        _Pragma("unroll") for (int mt = 0; mt < 8; ++mt) { S[mt] = S[mt] * eg; \
            _Pragma("unroll") for (int s = 0; s < 2; ++s) S[mt] = MFMA16(dn::frag(Kl, mt * 2 + s, lane), vb[s], S[mt]); } \
        _Pragma("unroll") for (int mt = 0; mt < 4; ++mt) \
            _Pragma("unroll") for (int r = 0; r < 4; ++r) ORAW[(size_t)(n * CH + 16 * mt + 4 * lq + r) * 512 + h * 128 + 16 * vs + lr] = o[mt][r]; } \
        if ((i_) + 1 < GRP) stage_write4(RN, lds + ((BUF) ^ 1) * SBUF); \
        __syncthreads(); } while (0)
    PC_LOAD(R0, U0, 0);
    PC_LOAD(R1, U1, 1);
    stage_write4(R0, lds);
    __syncthreads();
#pragma unroll 1
    for (int i = 0; i < GRP; i += 2) { PC_STEP(i, 0, R0, U0, R1); PC_STEP(i + 1, 1, R1, U1, R0); }
#undef PC_LOAD
#undef PC_STEP
}
DI int fox_jlo(const Args& a, int h, int qb, const float* qkbs, int lane) {
    const float* Fh = (const float*)(a.ws + WS_F) + (size_t)h * SEQ; const float* TB = (const float*)(a.ws + WS_NRMT); const int P0 = qb * 256;
    float mq = 0.f, md = 3.0e38f;
    if (lane < 32) { mq = TB[(qb * 32 + lane) * 12 + h]; md = TB[(qb * 32 + lane) * 12 + 8 + h]; }
    for (int o_ = 1; o_ < 64; o_ <<= 1) { mq = fmaxf(mq, __shfl_xor(mq, o_)); md = fminf(md, __shfl_xor(md, o_)); }
    const float qkb = sqrtf(mq * qkbs[h]) * fox::SCALE, lim = Fh[P0] + qkb - md * fox::SCALE + 32.f;
    const int jd = P0 / 64, stride = jd / 64 + 1;
    int j = lane * stride; bool ok = (j > jd) ? true : (Fh[64 * j + 63] <= lim);
    unsigned long long mk = __ballot(ok); const int first = mk ? __builtin_ctzll(mk) : 64;
    const int lo_ex = first == 0 ? -1 : (first - 1) * stride; const int hi_in = (first < 64 && first * stride <= jd) ? first * stride : jd;
    j = lo_ex + 1 + lane; ok = (j < hi_in) ? (Fh[64 * j + 63] <= lim) : false;
    mk = __ballot(ok); return mk ? lo_ex + 1 + __builtin_ctzll(mk) : hi_in;
}
DI void ph4_fox(const Args& a, char* lds, int nscan) {
    const int tid = threadIdx.x, lane = tid & 63, wave = tid >> 6;
    const float* F = (const float*)(a.ws + WS_F); unsigned* QH = (unsigned*)(a.ws + WS_QH);
    int* misc = (int*)(lds + fox::OFF_MISC);
    if (tid == 0) { int ord0 = 0, ord1 = 1, ord2 = 2, ord3 = 3;
      float r0 = -F[0 * SEQ + SEQ - 1], r1 = -F[1 * SEQ + SEQ - 1], r2 = -F[2 * SEQ + SEQ - 1], r3 = -F[3 * SEQ + SEQ - 1];
#define CSWAP(ra, rb, oa, ob) if (rb < ra) { const float tf = ra; ra = rb; rb = tf; const int ti = oa; oa = ob; ob = ti; }
      CSWAP(r0, r1, ord0, ord1) CSWAP(r2, r3, ord2, ord3) CSWAP(r0, r2, ord0, ord2) CSWAP(r1, r3, ord1, ord3) CSWAP(r1, r2, ord1, ord2)
#undef CSWAP
      misc[4] = ord0; misc[5] = ord1; misc[6] = ord2; misc[7] = ord3; }
    float* qkbs = (float*)(lds + fox::OFF_MISC) + 8;
    const float* TB = (const float*)(a.ws + WS_NRMT);
    __syncthreads();
    { float m = 0.f; const int h = tid & 3;
        for (int g_ = tid >> 2; g_ < SEQ / 8; g_ += NTHREADS / 4) m = fmaxf(m, TB[g_ * 12 + 4 + h]);
        for (int o_ = 4; o_ < 64; o_ <<= 1) m = fmaxf(m, __shfl_xor(m, o_));
        if (lane < 4) qkbs[16 + wave * 4 + lane] = m; }
    __syncthreads();
    if (tid < 4) { float m = 0.f; for (int w = 0; w < NWAVES; ++w) m = fmaxf(m, qkbs[16 + w * 4 + tid]); qkbs[tid] = m; }
    __syncthreads();
    for (int round = 0;; ++round) {
        __syncthreads();
        if (tid == 0) misc[0] = (round == 0 && (int)blockIdx.x >= nscan) ? (int)blockIdx.x - nscan : (int)((int)gridDim.x - nscan + (int)atomicAdd(QH, 1u));
        __syncthreads();
        const int it = misc[0];
        if (it >= 256) break;
        const int h = misc[4 + (it >> 6)], qb = 63 - (it & 63), P0 = qb * 256;
        if (wave == 0) { const int jlo = fox_jlo(a, h, qb, qkbs, lane); if (lane == 0) misc[1] = jlo; }
        __syncthreads();
        fox::fox_block(a, lds, h, P0, misc[1]);
    }
    { unsigned* QC = (unsigned*)(a.ws + WS_QH) + 64; int par = 0;
        for (;;) {
            __syncthreads();
            if (tid == 0) misc[0] = (int)atomicAdd(QC, 1u);
            __syncthreads();
            const int c4 = misc[0] * 4;
            if (c4 >= Q_WGU) break;
#pragma unroll 1
            for (int q = 0; q < 4; ++q) conv_quad_gu(a, lds, par, c4 + q);
        }
    }
}
DI void ph4(const Args& a, float* lds) {
    const int nscan = (int)gridDim.x >= 2 * NSCAN ? NSCAN : 0;
    for (int chain = blockIdx.x; chain < NSCAN; chain += gridDim.x) scanA_chain(a, (char*)lds, chain);
    ph4_fox(a, (char*)lds, nscan);
}
DI void ph5_scan(const Args& a, float* lds) {
    const int G = gridDim.x;
    for (int u = blockIdx.x; u < 2 * NSCAN; u += G) scanPC_chain(a, (char*)lds, u >> 1, u & 1);
    unsigned* QC = (unsigned*)(a.ws + WS_QH) + 128; int* misc = (int*)((char*)lds + 2 * SBUF + 4096); int par = 0;
    for (;;) {
        __syncthreads();
        if (threadIdx.x == 0) misc[0] = (int)atomicAdd(QC, 1u);
        __syncthreads();
        const int c4 = misc[0] * 4;
        if (c4 >= Q_WD) break;
#pragma unroll 1
        for (int q = 0; q < 4; ++q) conv_quad_d(a, (char*)lds, par, c4 + q);
    }
}

DI void ph5(const Args& a) {
    const int lane = threadIdx.x & 63, wave = threadIdx.x >> 6, NW = gridDim.x * NWAVES;
    const float* ORAW = (const float*)(a.ws + WS_ORAW); const bf16_t* P = (const bf16_t*)(a.ws + WS_PROJ); bf16_t* OA = (bf16_t*)(a.ws + WS_OA);
    const float g0 = a.in[I_GON][lane], g1 = a.in[I_GON][lane + 64];
    for (int id = blockIdx.x * NWAVES + wave; id < SEQ * 4; id += NW) { const int t = id >> 2, h = id & 3;
        const float o0 = ORAW[(size_t)t * 512 + h * 128 + lane], o1 = ORAW[(size_t)t * 512 + h * 128 + 64 + lane];
        const float rstd = rsqrtf(wave_sum(o0 * o0 + o1 * o1) * (1.f / 128.f) + 1e-6f);
        const float z0 = bf2f(P[(size_t)t * NPJ + PJ_DZ + h * 128 + lane]), z1 = bf2f(P[(size_t)t * NPJ + PJ_DZ + h * 128 + 64 + lane]);
        OA[(size_t)t * 512 + h * 128 + lane] = f2bf(o0 * rstd * g0 * siluf(z0)); OA[(size_t)t * 512 + h * 128 + 64 + lane] = f2bf(o1 * rstd * g1 * siluf(z1)); }
}

DI void ph6(const Args& a, unsigned char* ldsb) {
    const bf16_t* P = (const bf16_t*)(a.ws + WS_PROJ);
    pg8::OrderDense S; S.init(SEQ / 256, DM / 256, (int)gridDim.x, (int)blockIdx.x);
    { pg8::Gemm g{(const bf16_t*)(a.ws + WS_OA), (const bf16_t*)(a.ws + WS_WOAT), SEQ, DM, 512};
      pg8::EpiMerge<0> E{P + PJ_GA, (float*)(a.ws + WS_X1), (bf16_t*)(a.ws + WS_MRG)};
      pg8::gemm_phase<pg8::EpiMerge<0>, pg8::OrderDense>((LAS unsigned char*)ldsb, g, S, E); }
    __syncthreads();
    { pg8::Gemm g{(const bf16_t*)(a.ws + WS_OB), (const bf16_t*)(a.ws + WS_WOBT), SEQ, DM, 512};
      pg8::EpiMerge<1> E{P + PJ_GB, (float*)(a.ws + WS_X1), (bf16_t*)(a.ws + WS_MRG)};
      pg8::gemm_phase<pg8::EpiMerge<1>, pg8::OrderDense>((LAS unsigned char*)ldsb, g, S, E); }
}

DI void ph7(const Args& a, unsigned char* ldsb) {
    pg8::Gemm g{(const bf16_t*)(a.ws + WS_MRG), (const bf16_t*)(a.ws + WS_WOUTT), SEQ, DM, DM};
    pg8::OrderDense S; S.init(SEQ / 256, DM / 256, (int)gridDim.x, (int)blockIdx.x);
    pg8::EpiResid E{a.in[I_X], (const float*)(a.ws + WS_MOD) + 2048, (float*)(a.ws + WS_X1)};
    pg8::gemm_phase<pg8::EpiResid, pg8::OrderDense>((LAS unsigned char*)ldsb, g, S, E);
}

DI void ph8(const Args& a, float* lds) {
    const int tid = threadIdx.x, lane = tid & 63, wave = tid >> 6, G = gridDim.x;
    constexpr int HP = 1028;
    float* A2 = lds; float* B2 = lds + 1024; float* hs = lds + 2048; float* lgs = hs + 16 * HP;
    const float* mod = (const float*)(a.ws + WS_MOD);
    for (int k = tid; k < DM; k += NTHREADS) { A2[k] = a.in[I_G2][k] * (1.f + mod[4096 + k]); B2[k] = mod[3072 + k]; }
    const float* X1 = (const float*)(a.ws + WS_X1); bf16_t* H2 = (bf16_t*)(a.ws + WS_H2);
    int* TOKE = (int*)(a.ws + WS_TOKE); int* TOKS = (int*)(a.ws + WS_TOKS); float* TOKG = (float*)(a.ws + WS_TOKG); unsigned* CNT = (unsigned*)(a.ws + WS_CNT);
    const float* wr = a.in[I_WR];
    float* part = lgs + 512; int* lcnt = (int*)(part + 8 * 16 * 32);
    float wb0[32], wb1[32];
#pragma unroll
    for (int s = 0; s < 32; ++s) { const size_t k = (size_t)(128 * wave + 4 * s + (lane >> 4)); wb0[s] = wr[k * NE + (lane & 15)]; wb1[s] = wr[k * NE + 16 + (lane & 15)]; }
    for (int tile = blockIdx.x; tile < SEQ / 16; tile += G) {
        __syncthreads();
#pragma unroll 1
        for (int q = 0; q < 2; ++q) { const int tt = wave * 2 + q, t = tile * 16 + tt; const float* xr = X1 + (size_t)t * DM;
            f32x4 v[4]; float ss = 0.f;
#pragma unroll
            for (int i = 0; i < 4; ++i) { v[i] = *(const f32x4*)(xr + lane * 4 + 256 * i); ss += v[i][0] * v[i][0] + v[i][1] * v[i][1] + v[i][2] * v[i][2] + v[i][3] * v[i][3]; }
            ss = wave_sum(ss);
            const float rstd = rsqrtf(ss * (1.f / DM) + 1e-6f);
#pragma unroll
            for (int i = 0; i < 4; ++i) { const int k = lane * 4 + 256 * i;
#pragma unroll
                for (int e = 0; e < 4; ++e) v[i][e] = v[i][e] * rstd * A2[k + e] + B2[k + e];
                *(f32x4*)(hs + tt * HP + k) = v[i];
                *(unsigned*)((unsigned char*)H2 + (size_t)t * DM + k) = cvt_f8x4(v[i][0], v[i][1], v[i][2], v[i][3]); } }
        __syncthreads();
        {
            if (tid < 32) lcnt[tid] = 0;
            f32x4 c0 = (f32x4){0.f, 0.f, 0.f, 0.f}, c1 = c0; const float* ha = hs + (lane & 15) * HP + 128 * wave + (lane >> 4);
#pragma unroll
            for (int s = 0; s < 32; ++s) { const float av = ha[4 * s];
                c0 = __builtin_amdgcn_mfma_f32_16x16x4f32(av, wb0[s], c0, 0, 0, 0); c1 = __builtin_amdgcn_mfma_f32_16x16x4f32(av, wb1[s], c1, 0, 0, 0); }
#pragma unroll
            for (int r = 0; r < 4; ++r) { part[(wave * 16 + 4 * (lane >> 4) + r) * 32 + (lane & 15)] = c0[r]; part[(wave * 16 + 4 * (lane >> 4) + r) * 32 + 16 + (lane & 15)] = c1[r]; }
            __syncthreads();
            const int tt = tid >> 5, e = tid & 31; float acc = a.in[I_BR][e];
#pragma unroll
            for (int w = 0; w < 8; ++w) acc += part[(w * 16 + tt) * 32 + e];
            lgs[tt * 32 + e] = acc; }
        __syncthreads();
        { const int e = lane & 31, tt = wave * 2 + (lane >> 5), t = tile * 16 + tt;
            float cur = lgs[tt * 32 + e];
#define TOP1(TV, TI) float TV = cur; int TI = e; for (int o_ = 1; o_ <= 16; o_ <<= 1) { const float ov = __shfl_xor(TV, o_); const int oi = __shfl_xor(TI, o_); if (ov > TV || (ov == TV && oi < TI)) { TV = ov; TI = oi; } } if (e == TI) cur = -__builtin_inff();
            TOP1(tv0, ti0) TOP1(tv1, ti1) TOP1(tv2, ti2) TOP1(tv3, ti3)
#undef TOP1
            const float ex0 = 1.f, ex1 = expf(tv1 - tv0), ex2 = expf(tv2 - tv0), ex3 = expf(tv3 - tv0), den = ex0 + ex1 + ex2 + ex3;
            if (e < 4) { int ee = ti0; float gg = ex0;
                if (e == 1) { ee = ti1; gg = ex1; } if (e == 2) { ee = ti2; gg = ex2; } if (e == 3) { ee = ti3; gg = ex3; }
                const int rank = atomicAdd(lcnt + ee, 1);
                TOKE[t * 4 + e] = ee; TOKS[t * 4 + e] = rank; TOKG[t * 4 + e] = gg / den; } }
        __syncthreads();
        if (tid < 32) ((int*)(a.ws + WS_TCNT))[tile * 32 + tid] = lcnt[tid];
    }
}

DI void pad_starts(const Args& a, int* ps) {
    if (threadIdx.x == 0) { const unsigned* CNT = (const unsigned*)(a.ws + WS_CNT); int s = 0; for (int e = 0; e < NE; ++e) { ps[e] = s; s += (int)((CNT[e] + 255u) / 256u) * 256; } ps[NE] = s; }
    __syncthreads();
}
DI void ph9(const Args& a, float* lds) {
    const int tid = threadIdx.x, lane = tid & 63, wave = tid >> 6, G = gridDim.x;
    int* tab = (int*)lds; int* segs = tab + 32768; int* segoff = segs + 512; int* ps = segoff + 512; int* basel = ps + 64;
    const int* TCNT = (const int*)(a.ws + WS_TCNT);
    for (int i = tid; i < 8192; i += NTHREADS) ((u32x4*)tab)[i] = ((const u32x4*)TCNT)[i];
    __syncthreads();
    { const int e = tid & 31, sg = tid >> 5; int s = 0;
#pragma unroll 8
        for (int q = 0; q < 64; ++q) s += tab[(sg * 64 + q) * 32 + e];
        segs[sg * 32 + e] = s; }
    __syncthreads();
    if (tid < 32) { int run = 0; for (int sg = 0; sg < 16; ++sg) { segoff[sg * 32 + tid] = run; run += segs[sg * 32 + tid]; }
        segs[tid] = run;
        if (blockIdx.x == 0) ((unsigned*)(a.ws + WS_CNT))[tid] = (unsigned)run; }
    __syncthreads();
    if (tid == 0) { int s = 0; for (int e = 0; e < NE; ++e) { ps[e] = s; s += ((segs[e] + 255) / 256) * 256; } ps[NE] = s; }
    __syncthreads();
    const int* TOKE = (const int*)(a.ws + WS_TOKE); int* TOKS = (int*)(a.ws + WS_TOKS);
    const bf16_t* H2 = (const bf16_t*)(a.ws + WS_H2); bf16_t* XG = (bf16_t*)(a.ws + WS_XG);
    for (int tile = blockIdx.x; tile < SEQ / 16; tile += G) {
        __syncthreads();
        if (tid < 32) { int b = segoff[(tile >> 6) * 32 + tid]; for (int q = (tile >> 6) * 64; q < tile; ++q) b += tab[q * 32 + tid]; basel[tid] = ps[tid] + b; }
        __syncthreads();
#pragma unroll 1
        for (int q = 0; q < 8; ++q) { const int id = tile * 64 + wave * 8 + q, t = id >> 2;
            const size_t row = (size_t)(basel[TOKE[id]] + TOKS[id]);
            const u32x4 v0 = *(const u32x4*)((const unsigned char*)H2 + (size_t)t * DM + lane * 16);
            *(u32x4*)((unsigned char*)XG + row * DM + lane * 16) = v0;
            if (lane == 0) TOKS[id] = (int)row; }
    }
}
DI void pad_starts_tab(const Args& a, int* ps) {
    pad_starts(a, ps);
    const int nM = ps[NE] / 256;
    for (int t = threadIdx.x; t < nM; t += NTHREADS) { int e = 0; for (int i = 1; i < NE; ++i) if (t * 256 >= ps[i]) e = i; ps[40 + t] = e; }
    __syncthreads();
}
DI int expert_of(const int* ps, int row0) { int e = 0; for (int i = 1; i < NE; ++i) if (row0 >= ps[i]) e = i; return e; }
DI void ph10(const Args& a, unsigned char* ldsb) {
    int* ps = (int*)(ldsb + 131072); pad_starts_tab(a, ps);
    pg8::Gemm g{(const bf16_t*)(a.ws + WS_XG), (const bf16_t*)(a.ws + WS_WGUT), 0, 2048, DM};
    pg8::OrderGrouped S; S.init(ps[NE] / 256, 8, (int)gridDim.x, (int)blockIdx.x); S.ps = (const LAS int*)ps;
    pg8::EpiSwiglu E{(unsigned char*)(a.ws + WS_ACT), a.in[I_BGU]};
    pg8::gemm_phase<pg8::EpiSwiglu, pg8::OrderGrouped, true>((LAS unsigned char*)ldsb, g, S, E);
}
DI void ph11(const Args& a, unsigned char* ldsb) {
    int* ps = (int*)(ldsb + 131072); pad_starts_tab(a, ps);
    pg8::Gemm g{(const bf16_t*)(a.ws + WS_ACT), (const bf16_t*)(a.ws + WS_WDT), 0, DM, DM};
    pg8::OrderGrouped S; S.init(ps[NE] / 256, 4, (int)gridDim.x, (int)blockIdx.x); S.ps = (const LAS int*)ps;
    pg8::EpiStoreBf16 E{(bf16_t*)(a.ws + WS_YB), DM, a.in[I_BD], DM, 1.f / (WSCALE * ASCALE)};
    pg8::gemm_phase<pg8::EpiStoreBf16, pg8::OrderGrouped, true>((LAS unsigned char*)ldsb, g, S, E);
}
DI void ph12(const Args& a, float* lds) {
    const int lane = threadIdx.x & 63, wave = threadIdx.x >> 6, G = gridDim.x;
    const float* X1 = (const float*)(a.ws + WS_X1); const bf16_t* YB = (const bf16_t*)(a.ws + WS_YB); const float* mod = (const float*)(a.ws + WS_MOD);
    const int* TOKS = (const int*)(a.ws + WS_TOKS); const float* TOKG = (const float*)(a.ws + WS_TOKG);
    f32x4 gt[4], gf[4];
#pragma unroll
    for (int i = 0; i < 4; ++i) { gt[i] = *(const f32x4*)(mod + 5120 + lane * 4 + 256 * i); gf[i] = *(const f32x4*)(a.in[I_GF] + lane * 4 + 256 * i); }
    for (int t0 = (blockIdx.x * NWAVES + wave) * 2; t0 < SEQ; t0 += G * NWAVES * 2) {
        int rows[2][4]; float gk[2][4];
#pragma unroll
        for (int p = 0; p < 2; ++p)
#pragma unroll
            for (int q = 0; q < 4; ++q) { rows[p][q] = TOKS[(t0 + p) * 4 + q]; gk[p][q] = TOKG[(t0 + p) * 4 + q]; }
        f32x4 v[2][4]; u32x2 yv[2][4][4];
#pragma unroll
        for (int p = 0; p < 2; ++p)
#pragma unroll
            for (int i = 0; i < 4; ++i) { const int k = lane * 4 + 256 * i; v[p][i] = *(const f32x4*)(X1 + (size_t)(t0 + p) * DM + k);
#pragma unroll
                for (int q = 0; q < 4; ++q) yv[p][i][q] = *(const u32x2*)(YB + (size_t)rows[p][q] * DM + k); }
#pragma unroll
        for (int p = 0; p < 2; ++p) { float ss = 0.f;
#pragma unroll
            for (int i = 0; i < 4; ++i) { f32x4 y = (f32x4){0.f, 0.f, 0.f, 0.f};
#pragma unroll
                for (int q = 0; q < 4; ++q) { const u32x2 w = yv[p][i][q];
                    y[0] += gk[p][q] * __uint_as_float(w.x << 16); y[1] += gk[p][q] * __uint_as_float(w.x & 0xffff0000u); y[2] += gk[p][q] * __uint_as_float(w.y << 16); y[3] += gk[p][q] * __uint_as_float(w.y & 0xffff0000u); }
                v[p][i] += gt[i] * y; ss += v[p][i][0] * v[p][i][0] + v[p][i][1] * v[p][i][1] + v[p][i][2] * v[p][i][2] + v[p][i][3] * v[p][i][3]; }
            ss = wave_sum(ss);
            const float rstd = rsqrtf(ss * (1.f / DM) + 1e-6f);
#pragma unroll
            for (int i = 0; i < 4; ++i) *(f32x4*)(a.out + (size_t)(t0 + p) * DM + lane * 4 + 256 * i) = v[p][i] * rstd * gf[i]; }
    }
}

__global__ void __launch_bounds__(NTHREADS, 2) hybrid_fwd(Args a) {
    extern __shared__ __attribute__((aligned(16))) unsigned char lds_raw[];
    float* lds = (float*)(lds_raw + 16);
    LAS unsigned* xbw = (LAS unsigned*)lds_raw;
    if (threadIdx.x == 0) { xbw[0] = 0u; xbw[1] = 0u; xbw[2] = 0u; xbw[3] = 0u; }
    __syncthreads();
    XcdBarrier bar; bar.bar = (unsigned*)(a.ws + WS_BAR); bar.x = 0; bar.st = (volatile LAS unsigned*)xbw;
    const int lo = a.ph_lo, hi = a.ph_hi;
    if (hi - lo > 1) bar = xcd_barrier_post((unsigned*)(a.ws + WS_BAR), (volatile LAS unsigned*)xbw);
#define IN(k) (lo <= (k) && (k) < hi)
#define SEAM(k) do { if (IN(k) && IN((k) + 1)) xcd_barrier(bar); } while (0)
    if (IN(0)) ph0(a, lds);
    SEAM(0);
    if (IN(1)) ph1(a, lds);
    SEAM(1);
    if (IN(2)) ph2(a, lds_raw + 16);
    SEAM(2);
    if (IN(3)) ph3(a, lds);
    SEAM(3);
    if (IN(4)) ph4(a, lds);
    SEAM(4);
    if (IN(5)) ph5_scan(a, lds);
    SEAM(5);
    if (IN(6)) ph5(a);
    SEAM(6);
    if (IN(7)) ph6(a, lds_raw + 16);
    SEAM(7);
    if (IN(8)) ph7(a, lds_raw + 16);
    SEAM(8);
    if (IN(9)) ph8(a, lds);
    SEAM(9);
    if (IN(10)) ph9(a, lds);
    SEAM(10);
    if (IN(11)) ph10(a, lds_raw + 16);
    SEAM(11);
    if (IN(12)) ph11(a, lds_raw + 16);
    SEAM(12);
    if (IN(13)) ph12(a, lds);
#undef IN
#undef SEAM
}

extern "C" void kernel_launch(void* const* d_in, const int* in_sizes, int n_in, void* d_out, int out_size, void* d_ws, size_t ws_size, hipStream_t stream) {
    static int grid = 0;
    if (grid == 0) {
        if (n_in != 22 || out_size != SEQ * DM || ws_size < WS_END) { fprintf(stderr, "kernel_launch: unexpected shapes (n_in %d out %d ws %zu, need %zu)\n", n_in, out_size, ws_size, (size_t)WS_END); grid = -1; return; }
        int dev = 0, cus = 0, per_cu = 0;
        if (hipGetDevice(&dev) != hipSuccess || hipDeviceGetAttribute(&cus, hipDeviceAttributeMultiprocessorCount, dev) != hipSuccess) { grid = -1; return; }
        if (hipFuncSetAttribute((const void*)hybrid_fwd, hipFuncAttributeMaxDynamicSharedMemorySize, LDS_BYTES) != hipSuccess) { fprintf(stderr, "kernel_launch: hipFuncSetAttribute failed\n"); grid = -1; return; }
        if (hipOccupancyMaxActiveBlocksPerMultiprocessor(&per_cu, (const void*)hybrid_fwd, NTHREADS, LDS_BYTES) != hipSuccess || per_cu < 1) { fprintf(stderr, "kernel_launch: occupancy query says %d\n", per_cu); }
        (void)hipGetLastError();
        grid = cus;
    }
    if (grid < 0) return;
    (void)hipMemsetAsync(d_ws, 0, CTL_ZERO, stream);
    Args a{};
    for (int i = 0; i < 22; ++i) a.in[i] = (const float*)d_in[i];
    a.out = (float*)d_out; a.ws = (unsigned char*)d_ws;
#if N_LAUNCHES == 1
    a.ph_lo = 0; a.ph_hi = NPHASES;
    hipLaunchKernelGGL(hybrid_fwd, dim3(grid), dim3(NTHREADS), LDS_BYTES, stream, a);
#else
    for (int p = 0; p < NPHASES; ++p) { a.ph_lo = p; a.ph_hi = p + 1; hipLaunchKernelGGL(hybrid_fwd, dim3(grid), dim3(NTHREADS), LDS_BYTES, stream, a); }
#endif
}
```

```cpp
#include <hip/hip_runtime.h>
#include <stdint.h>
#include <stdio.h>

#ifndef N_LAUNCHES
#define N_LAUNCHES 1
#endif

#define DI __device__ __forceinline__
#define LAS __attribute__((address_space(3)))
typedef unsigned short bf16_t;
typedef short bf16x8 __attribute__((ext_vector_type(8)));
typedef float f32x4 __attribute__((ext_vector_type(4)));
typedef unsigned u32x4 __attribute__((ext_vector_type(4)));
typedef unsigned u32x2 __attribute__((ext_vector_type(2)));
typedef int v8i32 __attribute__((ext_vector_type(8)));

constexpr int SEQ = 16384, DM = 1024, NIN = 5644, NPJ = 5632, NE = 32, TOPK = 4;
constexpr int NH = 4, HD = 128, CH = 64, NCH = SEQ / CH;
constexpr int PJ_DQ = 0, PJ_DK = 512, PJ_DV = 1024, PJ_DZ = 1536, PJ_FQ = 2048, PJ_FK = 2560, PJ_FV = 3072, PJ_GA = 3584, PJ_GB = 4608;
constexpr int NTHREADS = 512, NWAVES = 8;
constexpr int LDS_BYTES = 152 * 1024;
constexpr int NPHASES = 14;

constexpr size_t MiB = 1u << 20;
constexpr size_t WS_BAR = 0;
constexpr size_t WS_CNT = 32768;
constexpr size_t WS_NRM = 32768 + 256;
constexpr size_t WS_QH = 32768 + 512;
constexpr size_t WS_PST = 32768 + 4096;
constexpr size_t CTL_ZERO = 65536;
constexpr size_t WS_MOD = 65536;
constexpr size_t WS_F = WS_MOD + 32768;
constexpr size_t WS_EG = WS_F + 262144;
constexpr size_t WS_TOKE = WS_EG + 4096;
constexpr size_t WS_TOKS = WS_TOKE + 262144;
constexpr size_t WS_TOKG = WS_TOKS + 262144;
constexpr size_t WS_SP = WS_TOKG + 262144;
constexpr size_t WS_WINT = WS_SP + MiB;
constexpr size_t WS_WOAT = WS_WINT + (size_t)NPJ * DM * 2;
constexpr size_t WS_WOBT = WS_WOAT + MiB;
constexpr size_t WS_WOUTT = WS_WOBT + MiB;
constexpr size_t WS_WGUT = WS_WOUTT + 2 * MiB;
constexpr size_t WS_WDT = WS_WGUT + 128 * MiB;
constexpr size_t WS_X1 = WS_WDT + 64 * MiB;
constexpr size_t WS_H2 = WS_X1 + 64 * MiB;
constexpr size_t WS_MRG = WS_H2 + 32 * MiB;
constexpr size_t WS_RA = WS_MRG + 32 * MiB;
constexpr size_t WS_RB = WS_RA + 176 * MiB;
constexpr size_t WS_H = WS_RB;
constexpr size_t WS_DNW = WS_H + 32 * MiB;
constexpr size_t WS_DNU = WS_DNW + 16 * MiB;
constexpr size_t WS_DNQD = WS_DNU + 16 * MiB;
constexpr size_t WS_DNKD = WS_DNQD + 16 * MiB;
constexpr size_t WS_DNATT = WS_DNKD + 16 * MiB;
constexpr size_t WS_ORAW = WS_DNATT + 8 * MiB;
constexpr size_t WS_OA = WS_ORAW + 32 * MiB;
constexpr size_t WS_OB = WS_OA + 16 * MiB;
constexpr size_t WS_VT = WS_OB + 16 * MiB;
constexpr size_t WS_PG = WS_VT;
constexpr size_t WS_QG = WS_PG + 2 * MiB;
constexpr size_t WS_SG = WS_QG + 4 * MiB;
constexpr size_t WS_TCNT = WS_SG + 4 * MiB;
constexpr size_t WS_LF = WS_TCNT + 131072 + 131072;
constexpr size_t WS_NRMT = WS_TCNT + 131072;
constexpr size_t WS_END = WS_RB + 184 * MiB;
constexpr size_t WS_ROWTOK = WS_RA + 160 * MiB, WS_YB = WS_RA, WS_ACT = WS_RB, WS_PROJ = WS_RA;
static_assert(WS_VT + 16 * MiB <= WS_END, "region B");

struct Args { const float* in[22]; float* out; unsigned char* ws; int ph_lo, ph_hi; };
enum { I_X = 0, I_C, I_WADA, I_BADA, I_G1, I_WIN, I_CONVW, I_ALOG, I_DTB, I_GON, I_BFG, I_WOD, I_WOF, I_WOUT, I_G2, I_WR, I_BR, I_WGU, I_BGU, I_WD, I_BD, I_GF };

DI float bf2f(bf16_t v) { return __uint_as_float(((unsigned)v) << 16); }
DI bf16_t f2bf(float f) { unsigned u = __float_as_uint(f); u += 0x7fffu + ((u >> 16) & 1u); return (bf16_t)(u >> 16); }
typedef float f32x2_t __attribute__((ext_vector_type(2)));
typedef __bf16 bf16x2_t __attribute__((ext_vector_type(2)));
DI unsigned cvt_pk(float lo, float hi) { const f32x2_t v = {lo, hi}; const bf16x2_t b = __builtin_convertvector(v, bf16x2_t); return __builtin_bit_cast(unsigned, b); }
DI unsigned cvt_f8x4(float a, float b, float c, float d) { unsigned w = 0; w = __builtin_amdgcn_cvt_pk_fp8_f32(a, b, w, false); w = __builtin_amdgcn_cvt_pk_fp8_f32(c, d, w, true); return w; }
DI unsigned pk2(float lo, float hi) { return (unsigned)f2bf(lo) | ((unsigned)f2bf(hi) << 16); }
DI float sigm(float x) { return 1.f / (1.f + expf(-x)); }
DI float siluf(float x) { return x / (1.f + expf(-x)); }
DI float fexp(float x) { return __builtin_amdgcn_exp2f(x * 1.4426950408889634f); }
DI float fsilu(float x) { return x * __builtin_amdgcn_rcpf(1.f + fexp(-x)); }
DI float softplusf(float x) { return fmaxf(x, 0.f) + log1pf(expf(-fabsf(x))); }
DI float logsigf(float x) { return fminf(x, 0.f) - 0.6931471805599453f * __builtin_amdgcn_logf(1.f + fexp(-fabsf(x))); }
template <int CTRL> DI float dpp_f(float v) { return __builtin_bit_cast(float, __builtin_amdgcn_update_dpp(0, __builtin_bit_cast(int, v), CTRL, 0xF, 0xF, true)); }
DI float rdl(float v, int l) { return __builtin_bit_cast(float, __builtin_amdgcn_readlane(__builtin_bit_cast(int, v), l)); }
DI float wave_sum(float v) {
    v += dpp_f<0xB1>(v); v += dpp_f<0x4E>(v); v += dpp_f<0x141>(v); v += dpp_f<0x140>(v);
    return (rdl(v, 0) + rdl(v, 16)) + (rdl(v, 32) + rdl(v, 48)); }
#define MFMA16(a, b, c) __builtin_amdgcn_mfma_f32_16x16x32_bf16((a), (b), (c), 0, 0, 0)

DI int gu_src(int n) { const int g = n >> 8, r = n & 255; return r < 128 ? 128 * g + r : 1024 + 128 * g + (r - 128); }

#define XB_TMO      128
#define XB_XCNT(j)  (256  + 64 * (j))
#define XB_XSUB(j)  (1280 + 64 * (j))
#define XB_XGEN(j)  (2304 + 64 * (j))
#define XB_TOP      3328
#define XB_TOPGEN   3392
#define XCD_BAR_WORDS 3456
#define XB_SPIN_CAP (1u << 22)
DI unsigned xb_ld(unsigned* p)              { return __hip_atomic_load(p, __ATOMIC_RELAXED, __HIP_MEMORY_SCOPE_AGENT); }
DI unsigned xb_add(unsigned* p, unsigned v) { return __hip_atomic_fetch_add(p, v, __ATOMIC_RELAXED, __HIP_MEMORY_SCOPE_AGENT); }
DI unsigned xb_xcc_id() { return (unsigned)__builtin_amdgcn_s_getreg((3 << 11) | 20) & 0xFu; }
#define XB_SPIN(cond, bar) do { unsigned _sp = 0; while (cond) { __builtin_amdgcn_s_sleep(1); \
    if ((++_sp & 255u) == 0u) { if (xb_ld(&(bar)[XB_TMO])) break; if (_sp > XB_SPIN_CAP) { atomicAdd(&(bar)[XB_TMO], 1u); break; } } } } while (0)
struct XcdBarrier { unsigned* bar; unsigned x; volatile LAS unsigned* st; };
DI XcdBarrier xcd_barrier_post(unsigned* bar, volatile LAS unsigned* st) {
    XcdBarrier b; b.bar = bar; b.x = xb_xcc_id(); b.st = st;
    if (threadIdx.x == 0) (void)xb_add(&bar[XB_XCNT(b.x)], 1u);
    return b;
}
DI void xcd_barrier_complete(unsigned* bar, unsigned x, unsigned& nloc, unsigned& nx) {
    const unsigned G = gridDim.x * gridDim.y * gridDim.z;
    unsigned sum, cnt, mine, sp = 0u;
    for (;;) {
        sum = 0u; cnt = 0u; mine = 0u;
#pragma unroll
        for (unsigned j = 0; j < 16; ++j) { const unsigned c = xb_ld(&bar[XB_XCNT(j)]); sum += c; cnt += (c > 0u) ? 1u : 0u; mine = (j == x) ? c : mine; }
        if (sum == G) break;
        __builtin_amdgcn_s_sleep(1);
        if ((++sp & 255u) == 0u) { if (xb_ld(&bar[XB_TMO])) break; if (sp > XB_SPIN_CAP) { atomicAdd(&bar[XB_TMO], 1u); break; } }
    }
    nloc = mine > 0u ? mine : 1u; nx = cnt > 0u ? cnt : 1u;
}
DI void xcd_barrier(const XcdBarrier& b) {
    asm volatile("s_waitcnt vmcnt(0)" ::: "memory");
    __syncthreads();
    if (threadIdx.x == 0) {
        unsigned* bar = b.bar;
        __builtin_amdgcn_s_waitcnt(0);
        unsigned nloc = b.st[0], nx = b.st[1];
        if (nloc == 0u) { xcd_barrier_complete(bar, b.x, nloc, nx); b.st[0] = nloc; b.st[1] = nx; }
        const unsigned old = xb_add(&bar[XB_XSUB(b.x)], 1u);
        const unsigned gen = old / nloc;
        if (old + 1u == (gen + 1u) * nloc) {
            __builtin_amdgcn_fence(__ATOMIC_RELEASE, "agent");
            asm volatile("s_waitcnt vmcnt(0)" ::: "memory");
            const unsigned og = xb_add(&bar[XB_TOP], 1u);
            const unsigned tg = og / nx;
            if (og + 1u == (tg + 1u) * nx) xb_add(&bar[XB_TOPGEN], 1u);
            else XB_SPIN(xb_ld(&bar[XB_TOPGEN]) == tg, bar);
            __builtin_amdgcn_fence(__ATOMIC_ACQUIRE, "agent");
            xb_add(&bar[XB_XGEN(b.x)], 1u);
            asm volatile("s_waitcnt vmcnt(0)" ::: "memory");
        } else {
            XB_SPIN(xb_ld(&bar[XB_XGEN(b.x)]) == gen, bar);
            __builtin_amdgcn_fence(__ATOMIC_ACQUIRE, "agent");
            asm volatile("s_waitcnt vmcnt(0)" ::: "memory");
        }
    }
    __syncthreads();
}

template <int NT>
DI void wave_gemm(const bf16_t* const (&ap)[4], const bf16_t* const (&bp)[NT], int K, f32x4 (&acc)[4][NT]) {
    for (int k0 = 0; k0 < K; k0 += 32) {
        bf16x8 a[4], b[NT];
#pragma unroll
        for (int i = 0; i < 4; ++i) a[i] = *(const bf16x8*)(ap[i] + k0);
#pragma unroll
        for (int j = 0; j < NT; ++j) b[j] = *(const bf16x8*)(bp[j] + k0);
#pragma unroll
        for (int i = 0; i < 4; ++i)
#pragma unroll
            for (int j = 0; j < NT; ++j) acc[i][j] = MFMA16(a[i], b[j], acc[i][j]);
    }
}
template <int NT> DI void zero_acc(f32x4 (&acc)[4][NT]) {
#pragma unroll
    for (int i = 0; i < 4; ++i)
#pragma unroll
        for (int j = 0; j < NT; ++j) acc[i][j] = (f32x4){0.f, 0.f, 0.f, 0.f};
}


constexpr float WSCALE = 64.f, ASCALE = 4.f;
namespace pg8 {
struct Unit { int pm, pn, pb, e; };
struct Gemm { const bf16_t* A; const bf16_t* Bt; int M, N, K; };
constexpr int BM = 256, BK = 64, HALF = 128, HTB = HALF * BK * 2  , STAGE_BYTES = 8 * HTB, NXCD = 8, WGM = 8;

__host__ __device__ __forceinline__ int lds_byte(int r, int c) { const int st = (r >> 4) * 2 + (c >> 5), rr = r & 15, cc = c & 31, ob = rr * 64 + cc * 2; return st * 1024 + (ob ^ (((ob >> 9) & 1) << 5)); }
__host__ __device__ __forceinline__ void stage_rc(int b, int& R, int& C) { const int st = b / 1024, sb = b % 1024, swz = sb ^ (((sb >> 9) & 1) << 5); R = (st >> 1) * 16 + swz / 64; C = (st & 1) * 32 + (swz % 64) / 2; }
__host__ __device__ __forceinline__ int perm32(int rho) { const int n = rho >> 4, i = rho & 15; return 8 * (i >> 2) + 4 * n + (i & 3); }
template <class Epi, class Sched, bool FP8 = false, bool GATHER = false>
__device__ __forceinline__ void gemm_phase(LAS unsigned char* lds, const Gemm g, const Sched& S, const Epi& E, const LAS int* rtl = nullptr) {
    int tid_ = threadIdx.x; asm volatile("" : "+v"(tid_));
    const int tid = tid_, wid = __builtin_amdgcn_readfirstlane(tid >> 6), lane = tid & 63, wr = wid >> 2, wc = wid & 3, fr = lane & 15, fq = lane >> 4;
    const int K = FP8 ? g.K / 2 : g.K, nt = K / BK;
    unsigned voffA[2], voffB[2];
#pragma unroll
    for (int i = 0; i < 2; ++i) { int R, C;
        if (FP8) { const int b = tid * 16 + i * 8192; R = b >> 7; const int sw = ((R >> 1) & 1) | (((R >> 3) & 1) << 1); C = (((((b & 127) >> 5) ^ sw) << 5) + (b & 31)) >> 1; }
        else stage_rc(tid * 16 + i * 8192, R, C);
        const int Rb = Epi::PERM ? ((R & ~31) + perm32(R & 31)) : R;
        voffA[i] = GATHER ? (unsigned)C * 2u : (unsigned)(R * K + C) * 2u; voffB[i] = (unsigned)(Rb * K + C) * 2u; }
    const int gR = tid >> 3;
    unsigned oC[2][2];
#define PG8_ROWS(dst, ui_) do { _Pragma("unroll") for (int h_ = 0; h_ < 2; ++h_) _Pragma("unroll") for (int i_ = 0; i_ < 2; ++i_) dst[h_][i_] = (unsigned)rtl[(ui_) * 256 + h_ * 128 + i_ * 64 + gR] * (unsigned)(K * 2) + voffA[i_]; } while (0)
    const size_t kstep = (size_t)(BK * 2);
    const size_t hstep = (size_t)HALF * K * 2;
    const size_t tstep = 2 * hstep;
    const unsigned ldsw = (unsigned)wid * 1024u;
    const int fsw = ((fr >> 1) & 1) | (((fr >> 3) & 1) << 1);
    const int aoff = FP8 ? (wr * 64 + fr) * 128 + ((fq ^ fsw) << 5) + ((fq & 1) << 4) : lds_byte(wr * 64 + fr, fq * 8), boff = FP8 ? (wc * 32 + fr) * 128 + ((fq ^ fsw) << 5) + ((fq & 1) << 4) : lds_byte(wc * 32 + fr, fq * 8);
    const int aoff2 = aoff ^ 16, boff2 = boff ^ 16;
#define PG8_SA(b, h) (((b) * 2 + (h)) * HTB)
#define PG8_SB(b, h) ((4 + (b) * 2 + (h)) * HTB)
#define PG8_STAGE(bufoff, gbase, voff) do { _Pragma("unroll") for (int _i = 0; _i < 2; ++_i) \
        __builtin_amdgcn_global_load_lds((const unsigned*)((const char*)(gbase) + (voff)[_i]), (LAS unsigned*)(lds + (bufoff) + ldsw + _i * 8192), 16, 0, 0); } while (0)
#define PG8_STAGE_A(bufoff, gbase, h, nx) do { if constexpr (GATHER) { _Pragma("unroll") for (int _i = 0; _i < 2; ++_i) \
        __builtin_amdgcn_global_load_lds((const unsigned*)((const char*)(gbase) + oC[h][_i]), (LAS unsigned*)(lds + (bufoff) + ldsw + _i * 8192), 16, 0, 0); } \
        else PG8_STAGE(bufoff, (gbase) + (h) * hstep, voffA); } while (0)
#define PG8_LDA(dst, b, h) do { _Pragma("unroll") for (int m = 0; m < 4; ++m) { if (FP8) { const u32x4 l_ = *(const LAS u32x4*)(lds + PG8_SA(b, h) + aoff + m * 2048), h_ = *(const LAS u32x4*)(lds + PG8_SA(b, h) + aoff2 + m * 2048); dst##8[m] = (v8i32){(int)l_.x, (int)l_.y, (int)l_.z, (int)l_.w, (int)h_.x, (int)h_.y, (int)h_.z, (int)h_.w}; } \
        else { _Pragma("unroll") for (int k = 0; k < 2; ++k) dst[m][k] = *(const LAS bf16x8*)(lds + PG8_SA(b, h) + aoff + m * 2048 + k * 1024); } } } while (0)
#define PG8_LDB(dst, b, h) do { _Pragma("unroll") for (int n = 0; n < 2; ++n) { if (FP8) { const u32x4 l_ = *(const LAS u32x4*)(lds + PG8_SB(b, h) + boff + n * 2048), h_ = *(const LAS u32x4*)(lds + PG8_SB(b, h) + boff2 + n * 2048); dst##8[n] = (v8i32){(int)l_.x, (int)l_.y, (int)l_.z, (int)l_.w, (int)h_.x, (int)h_.y, (int)h_.z, (int)h_.w}; } \
        else { _Pragma("unroll") for (int k = 0; k < 2; ++k) dst[n][k] = *(const LAS bf16x8*)(lds + PG8_SB(b, h) + boff + n * 2048 + k * 1024); } } } while (0)
#define PG8_MMA(ai, bj, At, Bt) do { __builtin_amdgcn_s_setprio(1); _Pragma("unroll") for (int m = 0; m < 4; ++m) _Pragma("unroll") for (int n = 0; n < 2; ++n) { \
        if (FP8) asm volatile("v_mfma_f32_16x16x128_f8f6f4 %0, %1, %2, %0" : "+v"(acc[ai][bj][m][n]) : "v"(Bt##8[n]), "v"(At##8[m])); \
        else { _Pragma("unroll") for (int k = 0; k < 2; ++k) acc[ai][bj][m][n] = __builtin_amdgcn_mfma_f32_16x16x32_bf16(Bt[n][k], At[m][k], acc[ai][bj][m][n], 0, 0, 0); } } \
        __builtin_amdgcn_s_setprio(0); } while (0)
#define PG8_WAIT_V(n) asm volatile("s_waitcnt vmcnt(" #n ")" ::: "memory")
#define PG8_WAIT_L(n) asm volatile("s_waitcnt lgkmcnt(" #n ")" ::: "memory")
#define PG8_BAR __builtin_amdgcn_s_barrier()
#define PG8_SCHED __builtin_amdgcn_sched_barrier(0)
    Unit cur, nxt; int ui = 0; f32x4 pb[4];
    if (!S.next(0, cur)) return;
    f32x4 acc[2][2][4][2];
#pragma unroll
    for (int a = 0; a < 2; ++a)
#pragma unroll
        for (int b = 0; b < 2; ++b)
#pragma unroll
            for (int m = 0; m < 4; ++m)
#pragma unroll
                for (int n = 0; n < 2; ++n) acc[a][b][m][n] = (f32x4){0.f, 0.f, 0.f, 0.f};
    bf16x8 At[4][2], B0[2][2], B1[2][2]; v8i32 At8[4], B08[2], B18[2];
    const char* cA = (const char*)g.A + (GATHER ? (size_t)0 : (size_t)cur.pm * tstep); const char* cB = (const char*)g.Bt + (size_t)cur.pb * tstep;
    if constexpr (GATHER) { PG8_ROWS(oC, 0); }
    S.a_ready(cur);
    PG8_STAGE(PG8_SB(0, 0), cB, voffB); PG8_STAGE_A(PG8_SA(0, 0), cA, 0, false); PG8_STAGE(PG8_SB(0, 1), cB + hstep, voffB); PG8_STAGE_A(PG8_SA(0, 1), cA, 1, false);
    if (wr == 1) PG8_BAR;
    PG8_WAIT_V(4); PG8_BAR;
    PG8_STAGE(PG8_SB(1, 0), cB + kstep, voffB); PG8_STAGE_A(PG8_SA(1, 0), cA + kstep, 0, false); PG8_STAGE(PG8_SB(1, 1), cB + hstep + kstep, voffB);
    PG8_WAIT_V(6); PG8_BAR;
    for (;;) {
        const bool has_next = S.next(ui + 1, nxt);
        const char* nA = (has_next && !GATHER) ? (const char*)g.A + (size_t)nxt.pm * tstep : cA; const char* nB = has_next ? (const char*)g.Bt + (size_t)nxt.pb * tstep : cB;
#pragma unroll 1
        for (int t = 0; t < nt; t += 2) {
            const bool last = (t == nt - 2);
            const char* a1 = cA + (size_t)(t + 1) * kstep;
            const char* a2 = last ? nA : cA + (size_t)(t + 2) * kstep; const char* b2 = last ? nB : cB + (size_t)(t + 2) * kstep;
            const char* a3 = a2 + kstep; const char* b3 = b2 + kstep;
            if (last && has_next) S.a_ready(nxt);
            if (last) E.pre(cur, wc, fq, pb);
            PG8_LDB(B0, 0, 0); PG8_SCHED; PG8_LDA(At, 0, 0); PG8_STAGE_A(PG8_SA(1, 1), a1, 1, false);
            if constexpr (GATHER) { if (last && has_next) { PG8_ROWS(oC, ui + 1); } }

            PG8_WAIT_L(8); PG8_BAR; PG8_WAIT_L(0); PG8_MMA(0, 0, At, B0); PG8_BAR; PG8_SCHED;
            PG8_LDB(B1, 0, 1); PG8_STAGE(PG8_SB(0, 0), b2, voffB);
            PG8_BAR; PG8_WAIT_L(0); PG8_MMA(0, 1, At, B1); PG8_BAR;
            PG8_LDA(At, 0, 1); PG8_STAGE_A(PG8_SA(0, 0), a2, 0, last);
            PG8_BAR; PG8_WAIT_L(0); PG8_MMA(1, 0, At, B0); PG8_BAR; PG8_SCHED;
            PG8_STAGE(PG8_SB(0, 1), b2 + hstep, voffB);
            PG8_WAIT_V(6); PG8_BAR; PG8_MMA(1, 1, At, B1); PG8_BAR;
            PG8_LDB(B0, 1, 0); PG8_SCHED; PG8_LDA(At, 1, 0); PG8_STAGE_A(PG8_SA(0, 1), a2, 1, last);
            PG8_WAIT_L(8); PG8_BAR; PG8_WAIT_L(0); PG8_MMA(0, 0, At, B0); PG8_BAR; PG8_SCHED;
            PG8_LDB(B1, 1, 1); PG8_STAGE(PG8_SB(1, 0), b3, voffB);
            PG8_BAR; PG8_WAIT_L(0); PG8_MMA(0, 1, At, B1); PG8_BAR;
            PG8_LDA(At, 1, 1); PG8_STAGE_A(PG8_SA(1, 0), a3, 0, last);
            PG8_BAR; PG8_WAIT_L(0); PG8_MMA(1, 0, At, B0); PG8_BAR; PG8_SCHED;
            PG8_STAGE(PG8_SB(1, 1), b3 + hstep, voffB);
            PG8_WAIT_V(6); PG8_BAR; PG8_MMA(1, 1, At, B1); PG8_BAR;
        }
        if (FP8) asm volatile("s_nop 15\n\ts_nop 15" ::: "memory");
        if constexpr (!Epi::AFTER_DRAIN) { E(acc, cur, wr, wc, fr, fq, pb); S.done(cur); }
        if (!has_next) break;
#pragma unroll
        for (int a = 0; a < 2; ++a)
#pragma unroll
            for (int b = 0; b < 2; ++b)
#pragma unroll
                for (int m = 0; m < 4; ++m)
#pragma unroll
                    for (int n = 0; n < 2; ++n) acc[a][b][m][n] = (f32x4){0.f, 0.f, 0.f, 0.f};
        cur = nxt; cA = nA; cB = nB; ++ui;
    }
    PG8_WAIT_V(0);
    if (wr == 0) PG8_BAR;
    PG8_BAR;
    if constexpr (Epi::AFTER_DRAIN) { E.fused(acc, cur, wr, wc, fr, fq, lds, wid, lane); S.done(cur); }
#undef PG8_SA
#undef PG8_SB
#undef PG8_STAGE
#undef PG8_STAGE_A
#undef PG8_ROWS
#undef PG8_LDA
#undef PG8_LDB
#undef PG8_MMA
#undef PG8_WAIT_V
#undef PG8_WAIT_L
#undef PG8_BAR
#undef PG8_SCHED
}

DI unsigned cvt_pk_bf16(float lo, float hi) { return cvt_pk(lo, hi); }
DI float fsig(float x) { return __builtin_amdgcn_rcpf(1.f + __builtin_amdgcn_exp2f(-1.4426950408889634f * x)); }
DI int expert_of_l(const LAS int* ps, int row0) { int e = 0;
#pragma unroll 1
    for (int i = 1; i < NE; ++i) if (row0 >= ps[i]) e = i; return e; }
struct OrderDense {
    int nM, nN, nwg, G, c, pn0;
    DI void init(int nM_, int nN_, int G_, int c_, int pn0_ = 0) { nM = nM_; nN = nN_; nwg = nM * nN; G = G_; c = c_; pn0 = pn0_; }
    DI bool tile(int i, Unit& u) const {
        const long L = (long)i * G + c; if (L >= nwg) return false;
        int wgid = (int)L; { const int q = nwg / NXCD, r = nwg % NXCD, xcd = wgid % NXCD, off = wgid / NXCD; wgid = (xcd < r ? xcd * (q + 1) : r * (q + 1) + (xcd - r) * q) + off; }
        const int nig = WGM * nN, gid = wgid / nig, fm = gid * WGM, gsz = (nM - fm) < WGM ? (nM - fm) : WGM;
        u.pm = fm + ((wgid % nig) % gsz); u.pn = (wgid % nig) / gsz; return true;
    }
    DI bool next(int i, Unit& u) const { if (!tile(i, u)) return false; u.pn += pn0; u.pb = u.pn; u.e = 0; return true; }
    DI void a_ready(const Unit&) const {}
    DI void done(const Unit&) const {}
};
struct OrderTwo {
    int pm, pn0, pn1;
    DI bool next(int i, Unit& u) const { if (i >= 2) return false; u.pm = pm; u.pn = i ? pn1 : pn0; u.pb = u.pn; u.e = 0; return true; }
    DI void a_ready(const Unit&) const {}
    DI void done(const Unit&) const {}
};
struct OrderGrouped : OrderDense {
    const LAS int* ps;
    DI bool next(int i, Unit& u) const { if (!tile(i, u)) return false; u.e = ps[40 + u.pm]; u.pb = u.e * nN + u.pn; return true; }
};
struct EpiStoreBf16 {
    static constexpr bool PERM = true, AFTER_DRAIN = false;
    bf16_t* O; int ldc; const float* bias; int bstride; float scale;
    DI void pre(const Unit& u, int wc, int fq, f32x4 (&pb)[4]) const { const int col0 = u.pn * BM + wc * 32 + 8 * fq;
#pragma unroll
        for (int bj = 0; bj < 2; ++bj)
#pragma unroll
            for (int n = 0; n < 2; ++n) pb[bj * 2 + n] = bias ? *(const f32x4*)(bias + (size_t)u.e * bstride + col0 + bj * HALF + 4 * n) : (f32x4){0.f, 0.f, 0.f, 0.f}; }
    DI void operator()(const f32x4 (&acc)[2][2][4][2], const Unit& u, int wr, int wc, int fr, int fq, const f32x4 (&pb)[4]) const {
        const int row0 = u.pm * BM + wr * 64 + fr, col0 = u.pn * BM + wc * 32 + 8 * fq;
        f32x4 bv[2][2];
#pragma unroll
        for (int bj = 0; bj < 2; ++bj)
#pragma unroll
            for (int n = 0; n < 2; ++n) bv[bj][n] = pb[bj * 2 + n];
#pragma unroll
        for (int ai = 0; ai < 2; ++ai)
#pragma unroll
            for (int m = 0; m < 4; ++m) { bf16_t* rowp = O + (size_t)(row0 + ai * HALF + m * 16) * ldc + col0;
#pragma unroll
                for (int bj = 0; bj < 2; ++bj) { const f32x4 v0 = acc[ai][bj][m][0] * scale + bv[bj][0], v1 = acc[ai][bj][m][1] * scale + bv[bj][1];
                    u32x4 w; w.x = cvt_pk_bf16(v0[0], v0[1]); w.y = cvt_pk_bf16(v0[2], v0[3]); w.z = cvt_pk_bf16(v1[0], v1[1]); w.w = cvt_pk_bf16(v1[2], v1[3]);
                    *(u32x4*)(rowp + bj * HALF) = w; } }
    }
};
constexpr float YSCALE = 32.f;
struct EpiStoreF8 {
    static constexpr bool PERM = true, AFTER_DRAIN = false;
    unsigned char* O; int ldc; const float* bias; int bstride; float scale;
    DI void pre(const Unit& u, int wc, int fq, f32x4 (&pb)[4]) const { const int col0 = u.pn * BM + wc * 32 + 8 * fq;
#pragma unroll
        for (int bj = 0; bj < 2; ++bj)
#pragma unroll
            for (int n = 0; n < 2; ++n) pb[bj * 2 + n] = *(const f32x4*)(bias + (size_t)u.e * bstride + col0 + bj * HALF + 4 * n); }
    DI void operator()(const f32x4 (&acc)[2][2][4][2], const Unit& u, int wr, int wc, int fr, int fq, const f32x4 (&pb)[4]) const {
        const int row0 = u.pm * BM + wr * 64 + fr, col0 = u.pn * BM + wc * 32 + 8 * fq; const float sc = scale * YSCALE;
        f32x4 bv[2][2];
#pragma unroll
        for (int bj = 0; bj < 2; ++bj)
#pragma unroll
            for (int n = 0; n < 2; ++n) bv[bj][n] = pb[bj * 2 + n] * YSCALE;
#pragma unroll
        for (int ai = 0; ai < 2; ++ai)
#pragma unroll
            for (int m = 0; m < 4; ++m) { unsigned char* rowp = O + (size_t)(row0 + ai * HALF + m * 16) * ldc + col0;
#pragma unroll
                for (int bj = 0; bj < 2; ++bj) { f32x4 v0 = acc[ai][bj][m][0] * sc + bv[bj][0], v1 = acc[ai][bj][m][1] * sc + bv[bj][1];
#pragma unroll
                    for (int j = 0; j < 4; ++j) { v0[j] = __builtin_amdgcn_fmed3f(v0[j], -440.f, 440.f); v1[j] = __builtin_amdgcn_fmed3f(v1[j], -440.f, 440.f); }
                    u32x2 w; w.x = cvt_f8x4(v0[0], v0[1], v0[2], v0[3]); w.y = cvt_f8x4(v1[0], v1[1], v1[2], v1[3]);
                    *(u32x2*)(rowp + bj * HALF) = w; } }
    }
};
struct EpiStorePlain {
    static constexpr bool PERM = true, AFTER_DRAIN = false;
    bf16_t* O; int ldc;
    DI void pre(const Unit&, int, int, f32x4 (&)[4]) const {}
    DI void operator()(const f32x4 (&acc)[2][2][4][2], const Unit& u, int wr, int wc, int fr, int fq, const f32x4 (&)[4]) const {
        const int row0 = u.pm * BM + wr * 64 + fr, col0 = u.pn * BM + wc * 32 + 8 * fq;
#pragma unroll
        for (int ai = 0; ai < 2; ++ai)
#pragma unroll
            for (int m = 0; m < 4; ++m) { bf16_t* rowp = O + (size_t)(row0 + ai * HALF + m * 16) * ldc + col0;
#pragma unroll
                for (int bj = 0; bj < 2; ++bj) { const f32x4 v0 = acc[ai][bj][m][0], v1 = acc[ai][bj][m][1];
                    u32x4 w; w.x = cvt_pk_bf16(v0[0], v0[1]); w.y = cvt_pk_bf16(v0[2], v0[3]); w.z = cvt_pk_bf16(v1[0], v1[1]); w.w = cvt_pk_bf16(v1[2], v1[3]);
                    *(u32x4*)(rowp + bj * HALF) = w; } }
    }
};
template <int SECOND> struct EpiMerge {
    static constexpr bool PERM = true, AFTER_DRAIN = false;
    const bf16_t* gate; bf16_t* T; bf16_t* O;
    DI void pre(const Unit&, int, int, f32x4 (&)[4]) const {}
    DI void operator()(const f32x4 (&acc)[2][2][4][2], const Unit& u, int wr, int wc, int fr, int fq, const f32x4 (&)[4]) const {
        const int row0 = u.pm * BM + wr * 64 + fr, col0 = u.pn * BM + wc * 32 + 8 * fq;
#pragma unroll
        for (int ai = 0; ai < 2; ++ai) {
            u32x4 g[4][2], t[4][2];
#pragma unroll
            for (int m = 0; m < 4; ++m)
#pragma unroll
                for (int bj = 0; bj < 2; ++bj) { const size_t row = (size_t)(row0 + ai * HALF + m * 16); const int col = col0 + bj * HALF;
                    g[m][bj] = *(const u32x4*)(gate + row * NPJ + col);
                    if (SECOND) t[m][bj] = *(const u32x4*)(T + row * DM + col); }
#pragma unroll
            for (int m = 0; m < 4; ++m)
#pragma unroll
                for (int bj = 0; bj < 2; ++bj) { const size_t row = (size_t)(row0 + ai * HALF + m * 16); const int col = col0 + bj * HALF;
                    const u32x4 gg = g[m][bj]; f32x4 v0 = acc[ai][bj][m][0], v1 = acc[ai][bj][m][1];
                    v0[0] *= fsig(__uint_as_float(gg.x << 16)); v0[1] *= fsig(__uint_as_float(gg.x & 0xffff0000u)); v0[2] *= fsig(__uint_as_float(gg.y << 16)); v0[3] *= fsig(__uint_as_float(gg.y & 0xffff0000u));
                    v1[0] *= fsig(__uint_as_float(gg.z << 16)); v1[1] *= fsig(__uint_as_float(gg.z & 0xffff0000u)); v1[2] *= fsig(__uint_as_float(gg.w << 16)); v1[3] *= fsig(__uint_as_float(gg.w & 0xffff0000u));
                    if (SECOND) { const u32x4 tt = t[m][bj];
                        v0[0] += __uint_as_float(tt.x << 16); v0[1] += __uint_as_float(tt.x & 0xffff0000u); v0[2] += __uint_as_float(tt.y << 16); v0[3] += __uint_as_float(tt.y & 0xffff0000u);
                        v1[0] += __uint_as_float(tt.z << 16); v1[1] += __uint_as_float(tt.z & 0xffff0000u); v1[2] += __uint_as_float(tt.w << 16); v1[3] += __uint_as_float(tt.w & 0xffff0000u); }
                    u32x4 w; w.x = cvt_pk_bf16(v0[0], v0[1]); w.y = cvt_pk_bf16(v0[2], v0[3]); w.z = cvt_pk_bf16(v1[0], v1[1]); w.w = cvt_pk_bf16(v1[2], v1[3]);
                    *(u32x4*)((SECOND ? O : T) + row * DM + col) = w; }
        }
    }
};
struct EpiColScale {
    static constexpr bool PERM = true, AFTER_DRAIN = false;
    const float* gt; bf16_t* D;
    DI void pre(const Unit& u, int wc, int fq, f32x4 (&pb)[4]) const { const int col0 = u.pn * BM + wc * 32 + 8 * fq;
#pragma unroll
        for (int bj = 0; bj < 2; ++bj)
#pragma unroll
            for (int n = 0; n < 2; ++n) pb[bj * 2 + n] = *(const f32x4*)(gt + col0 + bj * HALF + 4 * n); }
    DI void operator()(const f32x4 (&acc)[2][2][4][2], const Unit& u, int wr, int wc, int fr, int fq, const f32x4 (&pb)[4]) const {
        const int row0 = u.pm * BM + wr * 64 + fr, col0 = u.pn * BM + wc * 32 + 8 * fq;
        f32x4 gv[2][2];
#pragma unroll
        for (int bj = 0; bj < 2; ++bj)
#pragma unroll
            for (int n = 0; n < 2; ++n) gv[bj][n] = pb[bj * 2 + n];
#pragma unroll
        for (int ai = 0; ai < 2; ++ai)
#pragma unroll
            for (int m = 0; m < 4; ++m) { bf16_t* rowp = D + (size_t)(row0 + ai * HALF + m * 16) * DM + col0;
#pragma unroll
                for (int bj = 0; bj < 2; ++bj) { const f32x4 v0 = acc[ai][bj][m][0] * gv[bj][0], v1 = acc[ai][bj][m][1] * gv[bj][1];
                    u32x4 w; w.x = cvt_pk_bf16(v0[0], v0[1]); w.y = cvt_pk_bf16(v0[2], v0[3]); w.z = cvt_pk_bf16(v1[0], v1[1]); w.w = cvt_pk_bf16(v1[2], v1[3]);
                    *(u32x4*)(rowp + bj * HALF) = w; } }
    }
};
struct EpiSwiglu {
    static constexpr bool PERM = true, AFTER_DRAIN = false;
    unsigned char* ACT; const float* bgu;
    DI void pre(const Unit& u, int wc, int fq, f32x4 (&pb)[4]) const { const float* bb = bgu + (size_t)u.e * 2048 + u.pn * HALF + wc * 32 + 8 * fq;
#pragma unroll
        for (int n = 0; n < 2; ++n) { pb[n] = *(const f32x4*)(bb + 4 * n); pb[2 + n] = *(const f32x4*)(bb + 1024 + 4 * n); } }
    DI void operator()(const f32x4 (&acc)[2][2][4][2], const Unit& u, int wr, int wc, int fr, int fq, const f32x4 (&pb)[4]) const {
        const int row0 = u.pm * BM + wr * 64 + fr, gcol = u.pn * HALF + wc * 32 + 8 * fq;
        f32x4 bg[2], bu[2];
#pragma unroll
        for (int n = 0; n < 2; ++n) { bg[n] = pb[n]; bu[n] = pb[2 + n]; }
#pragma unroll
        for (int ai = 0; ai < 2; ++ai)
#pragma unroll
            for (int m = 0; m < 4; ++m) { float r[8];
#pragma unroll
                for (int n = 0; n < 2; ++n)
#pragma unroll
                    for (int j = 0; j < 4; j += 2) {
                        const f32x2_t ag = {acc[ai][0][m][n][j], acc[ai][0][m][n][j + 1]}, au = {acc[ai][1][m][n][j], acc[ai][1][m][n][j + 1]};
                        const f32x2_t bgv = {bg[n][j], bg[n][j + 1]}, buv = {bu[n][j], bu[n][j + 1]};
                        f32x2_t g = ag * (1.f / WSCALE) + bgv, up = au * (1.f / WSCALE) + buv;
                        g[0] = fminf(g[0], 7.f); g[1] = fminf(g[1], 7.f); up[0] = fminf(fmaxf(up[0], -7.f), 7.f); up[1] = fminf(fmaxf(up[1], -7.f), 7.f);
                        const f32x2_t t = g * (-1.702f * 1.4426950408889634f);
                        f32x2_t d = {__builtin_amdgcn_exp2f(t[0]), __builtin_amdgcn_exp2f(t[1])}; d = d + 1.f;
                        const f32x2_t sg = {__builtin_amdgcn_rcpf(d[0]), __builtin_amdgcn_rcpf(d[1])};
                        const f32x2_t rr = (g * sg) * (up * ASCALE + ASCALE);
                        r[4 * n + j] = rr[0]; r[4 * n + j + 1] = rr[1]; }
                u32x2 w; w.x = cvt_f8x4(r[0], r[1], r[2], r[3]); w.y = cvt_f8x4(r[4], r[5], r[6], r[7]);
                *(u32x2*)(ACT + (size_t)(row0 + ai * HALF + m * 16) * DM + gcol) = w; }
    }
};
}


namespace fox {
typedef float f32x16 __attribute__((ext_vector_type(16)));
typedef short s16x4 __attribute__((ext_vector_type(4)));
constexpr float SCALE = 0.08838834764831845f;
constexpr int KVBLK = 64, SHM_K = 16384, SHM_V = 16384;
constexpr int OFF_V = 0, OFF_K = 2 * SHM_V, OFF_G = OFF_K + 2 * SHM_K, OFF_WS = OFF_G + 512, OFF_MISC = OFF_WS + 8 * 256;
constexpr float THR = 8.f;
#define KSWZ(row, colB) ((row) * 256 + ((colB) ^ (((row) & 7) << 4)))
#define SBAR() __builtin_amdgcn_sched_barrier(0)
DI int v_st(int k, int c) { const int kk = (k & ~0xC) | ((k & 4) << 1) | ((k & 8) >> 1); return ((kk >> 3) * 4 + (c >> 5)) * 512 + ((kk & 7) * 32 + (c & 31)) * 2; }
DI int v_rd_base(int lane) { return ((lane & 3) << 3) | (((lane >> 2) & 3) << 6) | (((lane >> 4) & 1) << 5) | (((lane >> 5) & 1) << 8); }
constexpr int v_rd_off(int d0, int ks, int half) { return d0 * 512 + ks * 4096 + half * 2048; }
DI int crow(int r, int hi) { return (r & 3) + 8 * (r >> 2) + 4 * hi; }
DI unsigned cvtpk(float lo, float hi) { return cvt_pk(lo, hi); }
DI void mask_tile(f32x16& p0, f32x16& p1, int dq) {
    const float NEG = -__builtin_inff();
#pragma unroll
    for (int r = 0; r < 16; ++r) { const int c = (r & 3) + 8 * (r >> 2); if (dq - c < 0) p0[r] = NEG; if (dq - c - 32 < 0) p1[r] = NEG; }
}
DI void partialSM(f32x16& p0, f32x16& p1, float& m_reg, float& mn, float& alpha) {
    float pmax = p0[0];
#pragma unroll
    for (int r = 1; r < 16; ++r) pmax = fmaxf(pmax, p0[r]);
#pragma unroll
    for (int r = 0; r < 16; ++r) pmax = fmaxf(pmax, p1[r]);
    { auto rr = __builtin_amdgcn_permlane32_swap(__float_as_uint(pmax), __float_as_uint(pmax), false, false); pmax = fmaxf(__uint_as_float(rr[0]), __uint_as_float(rr[1])); }
    constexpr float C2 = 1.4426950408889634f * SCALE;
    if (__builtin_expect(__all((pmax - m_reg) * SCALE <= THR), 1)) { mn = m_reg; alpha = 1.f; }
    else { mn = fmaxf(m_reg, pmax); alpha = __builtin_amdgcn_exp2f((m_reg - mn) * C2); m_reg = mn; }
    const float mnL = -mn * C2;
#pragma unroll
    for (int r = 0; r < 16; ++r) p0[r] = fmaf(p0[r], C2, mnL);
#pragma unroll
    for (int r = 0; r < 16; ++r) p1[r] = fmaf(p1[r], C2, mnL);
#pragma unroll
    for (int r = 0; r < 16; ++r) p0[r] = __builtin_amdgcn_exp2f(p0[r]);
}
DI void finishSM(f32x16& p0, f32x16& p1, float alpha, float& l_reg, bf16x8& pa0, bf16x8& pa1, bf16x8& pa2, bf16x8& pa3) {
#pragma unroll
    for (int r = 0; r < 16; ++r) p1[r] = __builtin_amdgcn_exp2f(p1[r]);
    float ps = 0;
#pragma unroll
    for (int r = 0; r < 16; ++r) ps += p0[r];
#pragma unroll
    for (int r = 0; r < 16; ++r) ps += p1[r];
    { auto rr = __builtin_amdgcn_permlane32_swap(__float_as_uint(ps), __float_as_uint(ps), false, false); ps = __uint_as_float(rr[0]) + __uint_as_float(rr[1]); }
    l_reg = l_reg * alpha + ps;
#define PK4(P, B_, OUT) do { unsigned a0 = cvtpk(P[B_+0], P[B_+1]), a1 = cvtpk(P[B_+2], P[B_+3]);                          \
        unsigned b0 = cvtpk(P[B_+4], P[B_+5]), b1 = cvtpk(P[B_+6], P[B_+7]);                                             \
        auto r0 = __builtin_amdgcn_permlane32_swap(a0, b0, false, false); auto r1 = __builtin_amdgcn_permlane32_swap(a1, b1, false, false); \
        u32x4 w = {r0[0], r1[0], r0[1], r1[1]}; OUT = *reinterpret_cast<bf16x8*>(&w); } while (0)
    PK4(p0, 0, pa0); PK4(p0, 8, pa1); PK4(p1, 0, pa2); PK4(p1, 8, pa3);
#undef PK4
}
DI void qkt(f32x16& p0, f32x16& p1, const char* Kb, int r32, int hi, const bf16x8* qr) {
    p0 = f32x16{}; p1 = f32x16{};
    const char* kb[4];
#pragma unroll
    for (int dd = 0; dd < 4; ++dd) kb[dd] = Kb + KSWZ(r32, (dd * 16 + hi * 8) * 2);
#pragma unroll
    for (int d0 = 0; d0 < 8; ++d0) { const char* a = kb[d0 & 3] + (d0 >> 2) * 128;
        bf16x8 b0 = *reinterpret_cast<const bf16x8*>(a);
        bf16x8 b1 = *reinterpret_cast<const bf16x8*>(a + 32 * 256);
        p0 = __builtin_amdgcn_mfma_f32_32x32x16_bf16(b0, qr[d0], p0, 0, 0, 0);
        p1 = __builtin_amdgcn_mfma_f32_32x32x16_bf16(b1, qr[d0], p1, 0, 0, 0); }
}
DI void pv_tile(f32x16* o, int vb0, bf16x8 pa0, bf16x8 pa1, bf16x8 pa2, bf16x8 pa3) {
#define TRRD(dst, off) asm volatile("ds_read_b64_tr_b16 %0, %1 offset:%2" : "=&v"(dst) : "v"(vb0), "i"(off) : "memory")
#define PV_D0(d0) do { s16x4 l0, l1, l2, l3, h0, h1, h2, h3; constexpr int b_ = v_rd_off(d0, 0, 0); \
        TRRD(l0, b_); TRRD(h0, b_ + 2048); TRRD(l1, b_ + 4096); TRRD(h1, b_ + 6144); TRRD(l2, b_ + 8192); TRRD(h2, b_ + 10240); TRRD(l3, b_ + 12288); TRRD(h3, b_ + 14336); \
        asm volatile("s_waitcnt lgkmcnt(0)" ::: "memory"); SBAR();   \
        o[d0] = __builtin_amdgcn_mfma_f32_32x32x16_bf16(pa0, (bf16x8){l0[0], l0[1], l0[2], l0[3], h0[0], h0[1], h0[2], h0[3]}, o[d0], 0, 0, 0);   \
        o[d0] = __builtin_amdgcn_mfma_f32_32x32x16_bf16(pa1, (bf16x8){l1[0], l1[1], l1[2], l1[3], h1[0], h1[1], h1[2], h1[3]}, o[d0], 0, 0, 0);   \
        o[d0] = __builtin_amdgcn_mfma_f32_32x32x16_bf16(pa2, (bf16x8){l2[0], l2[1], l2[2], l2[3], h2[0], h2[1], h2[2], h2[3]}, o[d0], 0, 0, 0);   \
        o[d0] = __builtin_amdgcn_mfma_f32_32x32x16_bf16(pa3, (bf16x8){l3[0], l3[1], l3[2], l3[3], h3[0], h3[1], h3[2], h3[3]}, o[d0], 0, 0, 0); } while (0)
    PV_D0(0); PV_D0(1); PV_D0(2); PV_D0(3);
#undef PV_D0
#undef TRRD
}
DI void fox_block(const Args& a, char* lds, int h, int P0, int j_lo) {
    const int tid = threadIdx.x, wid = __builtin_amdgcn_readfirstlane(tid >> 6), lane = tid & 63, r32 = lane & 31, hi = lane >> 5;
    const bf16_t* P = (const bf16_t*)(a.ws + WS_PROJ); const float* F = (const float*)(a.ws + WS_F) + (size_t)h * SEQ; bf16_t* OB = (bf16_t*)(a.ws + WS_OB);
    const bf16_t* Qp = P + PJ_FQ + h * 128; const bf16_t* Kp = P + PJ_FK + h * 128; const bf16_t* Vp = P + PJ_FV + h * 128;
    const int j_hi = (P0 + 255) / KVBLK + 1, NT = j_hi - j_lo;
    const int qlo = P0 + wid * 32, qm = qlo + r32 - 4 * hi;
    char* V_lds = lds + OFF_V; char* K_lds = lds + OFF_K; float* G_lds = (float*)(lds + OFF_G);
    float* wsp = (float*)(lds + OFF_WS) + wid * 64; float* li_l = wsp; float* al_l = wsp + 32;
    const int sr = tid >> 4;
    const int vb0 = (int)(unsigned)(uintptr_t)(LAS char*)V_lds + v_rd_base(lane);
    const float Fref = F[P0];
    bf16x8 qr[8];
#pragma unroll
    for (int d0 = 0; d0 < 8; ++d0) qr[d0] = *(const bf16x8*)(Qp + (size_t)(qlo + r32) * NPJ + d0 * 16 + hi * 8);
    float m_reg = -1e30f, l_reg = 0.f; f32x16 o[4] = {};
    float st_g = 0.f;
    const int ksrc = (((tid & 15) * 16) ^ ((sr & 7) << 4)) >> 1;
    const int vkk = (tid >> 7) * 8 + ((tid & 31) >> 2), vkey = (vkk & ~0xC) | ((vkk & 4) << 1) | ((vkk & 8) >> 1), vcol = ((tid >> 5) & 3) * 32 + (tid & 3) * 8;
    LAS unsigned char* ldsl = (LAS unsigned char*)lds;
#define FOX_LOAD(t, bf) do { const size_t k0_ = (size_t)(j_lo + (t)) * KVBLK; \
        __builtin_amdgcn_global_load_lds((const unsigned*)(Kp + (k0_ + sr) * NPJ + ksrc), (LAS unsigned*)(ldsl + OFF_K + (bf) * SHM_K + wid * 1024), 16, 0, 0); \
        __builtin_amdgcn_global_load_lds((const unsigned*)(Kp + (k0_ + 32 + sr) * NPJ + ksrc), (LAS unsigned*)(ldsl + OFF_K + (bf) * SHM_K + 8192 + wid * 1024), 16, 0, 0); \
        __builtin_amdgcn_global_load_lds((const unsigned*)(Vp + (k0_ + vkey) * NPJ + vcol), (LAS unsigned*)(ldsl + OFF_V + (bf) * SHM_V + wid * 1024), 16, 0, 0); \
        __builtin_amdgcn_global_load_lds((const unsigned*)(Vp + (k0_ + 32 + vkey) * NPJ + vcol), (LAS unsigned*)(ldsl + OFF_V + (bf) * SHM_V + 8192 + wid * 1024), 16, 0, 0); \
        if (tid < 64) st_g = F[k0_ + tid]; } while (0)
#define FOX_WRITE(bf) do { if (tid < 64) G_lds[(bf) * 64 + tid] = (st_g - Fref) * (1.f / SCALE); } while (0)
    FOX_LOAD(0, 0); asm volatile("s_waitcnt vmcnt(0)" ::: "memory"); FOX_WRITE(0);
    __syncthreads();
    for (int t = 0; t < NT; ++t) {
        const int bf = t & 1, kb_ = (j_lo + t) * KVBLK;
        if (t + 1 < NT) FOX_LOAD(t + 1, bf ^ 1);
        if (kb_ <= qlo + 31) {
            f32x16 p0, p1; float mn, al; bf16x8 pa0, pa1, pa2, pa3;
            qkt(p0, p1, K_lds + bf * SHM_K, r32, hi, qr);
            const float* gt = G_lds + bf * 64 + 4 * hi;
#pragma unroll
            for (int g4 = 0; g4 < 4; ++g4) { const f32x4 g0 = *(const f32x4*)(gt + 8 * g4), g1 = *(const f32x4*)(gt + 32 + 8 * g4);
#pragma unroll
                for (int i = 0; i < 4; ++i) { p0[4 * g4 + i] -= g0[i]; p1[4 * g4 + i] -= g1[i]; } }
            if (kb_ + KVBLK - 1 > qlo) mask_tile(p0, p1, qm - kb_);
            partialSM(p0, p1, m_reg, mn, al);
            finishSM(p0, p1, al, l_reg, pa0, pa1, pa2, pa3);
            if (__any(al < 1.f)) { if (hi == 0) al_l[r32] = al; asm volatile("s_waitcnt lgkmcnt(0)" ::: "memory");
#pragma unroll
                for (int d_ = 0; d_ < 4; ++d_)
#pragma unroll
                    for (int r = 0; r < 16; ++r) o[d_][r] *= al_l[crow(r, hi)]; }
            SBAR();
            pv_tile(o, vb0 + bf * SHM_V, pa0, pa1, pa2, pa3);
        }
        if (t + 1 < NT) { asm volatile("s_waitcnt vmcnt(0)" ::: "memory"); FOX_WRITE(bf ^ 1); }
        __syncthreads();
    }
#undef FOX_LOAD
#undef FOX_WRITE
    if (hi == 0) li_l[r32] = l_reg;
    asm volatile("s_waitcnt lgkmcnt(0)" ::: "memory");
    bf16_t* Ow = OB + (size_t)qlo * 512 + h * 128;
#pragma unroll
    for (int r = 0; r < 16; ++r) { const int orow = crow(r, hi); const float rl = __builtin_amdgcn_rcpf(li_l[orow]);
#pragma unroll
        for (int d0 = 0; d0 < 4; ++d0) { const float v = o[d0][r] * rl; const float vn = __shfl_xor(v, 1);
            if ((r32 & 1) == 0) *(unsigned*)(Ow + (size_t)orow * 512 + d0 * 32 + r32) = cvtpk(v, vn); } }
    __syncthreads();
}
#undef KSWZ
}

DI void transpose_tile(float* tile, const float* src, int ld, int k0, int c0, int c1, bf16_t* dst, int Kd) {
    const int tid = threadIdx.x, nn = tid & 63, k8 = tid >> 6; const int col = nn < 32 ? c0 + nn : c1 + nn - 32;
    const float* s = src + (size_t)(k0 + k8 * 8) * ld + col;
    float v[8];
#pragma unroll
    for (int i = 0; i < 8; ++i) v[i] = s[(size_t)i * ld];
    u32x4 w; w.x = cvt_pk(v[0], v[1]); w.y = cvt_pk(v[2], v[3]); w.z = cvt_pk(v[4], v[5]); w.w = cvt_pk(v[6], v[7]);
    *(u32x4*)(dst + (size_t)nn * Kd + k0 + k8 * 8) = w;
}
DI void transpose_quad(char* lds, int& par, const float* src, int ld, int k0, int c0, int c1, unsigned char* dst, int Kd) {
    const int tid = threadIdx.x, nn = tid & 63, k8 = tid >> 6; const int col = nn < 32 ? c0 + nn : c1 + nn - 32;
    const float* s = src + (size_t)(k0 + k8 * 8) * ld + col;
    float v[4][8];
#pragma unroll
    for (int kk = 0; kk < 4; ++kk)
#pragma unroll
        for (int i = 0; i < 8; ++i) v[kk][i] = s[(size_t)(kk * 64 + i) * ld];
    char* tile = lds + par * 17408; par ^= 1;
#pragma unroll
    for (int kk = 0; kk < 4; ++kk) { u32x2 w; w.x = cvt_f8x4(v[kk][0] * WSCALE, v[kk][1] * WSCALE, v[kk][2] * WSCALE, v[kk][3] * WSCALE); w.y = cvt_f8x4(v[kk][4] * WSCALE, v[kk][5] * WSCALE, v[kk][6] * WSCALE, v[kk][7] * WSCALE);
        *(u32x2*)(tile + nn * 272 + kk * 64 + k8 * 8) = w; }
    asm volatile("s_waitcnt lgkmcnt(0)" ::: "memory"); __builtin_amdgcn_s_barrier(); asm volatile("" ::: "memory");
    const int rn = tid >> 3, ch = tid & 7;
#pragma unroll
    for (int q = 0; q < 2; ++q) *(u32x4*)(dst + (size_t)rn * Kd + k0 + (ch + 8 * q) * 16) = *(const u32x4*)(tile + rn * 272 + (ch + 8 * q) * 16);
}
constexpr int Q_WGU = 32 * 32 * 4, Q_WD = 32 * 16 * 4;
DI void conv_quad_gu(const Args& a, char* lds, int& par, int r) { const int e = r / 128, q = r % 128, nt = q / 4, kt = q % 4, n0 = nt * 64;
    transpose_quad(lds, par, a.in[I_WGU] + (size_t)e * DM * 2048, 2048, kt * 256, gu_src(n0), gu_src(n0 + 32), (unsigned char*)(a.ws + WS_WGUT) + ((size_t)e * 2048 + n0) * DM, DM); }
DI void conv_quad_d(const Args& a, char* lds, int& par, int r) { const int e = r / 64, q = r % 64, nt = q / 4, kt = q % 4, n0 = nt * 64;
    transpose_quad(lds, par, a.in[I_WD] + (size_t)e * DM * DM, DM, kt * 256, n0, n0 + 32, (unsigned char*)(a.ws + WS_WDT) + ((size_t)e * DM + n0) * DM, DM); }
constexpr int T_WIN = 88 * 16, T_WOA = 16 * 8, T_WOUT = 16 * 16, T_WGU = 32 * 32 * 16, T_WD = 32 * 16 * 16;
constexpr int T_SMALL = T_WIN + 2 * T_WOA + T_WOUT;
DI void conv_tile(const Args& a, float* lds, int t) {
    unsigned char* ws = a.ws; int r = t;
    if (r < T_WIN) { const int nt = r / 16, kt = r % 16, n0 = nt * 64; const int c0 = n0 + (n0 >= 3584 ? 12 : (n0 >= 2048 ? 8 : 0));
        transpose_tile(lds, a.in[I_WIN], NIN, kt * 64, c0, c0 + 32, (bf16_t*)(ws + WS_WINT) + (size_t)n0 * DM, DM); return; }
    r -= T_WIN;
    if (r < T_WOA) { const int nt = r / 8, kt = r % 8, n0 = nt * 64; transpose_tile(lds, a.in[I_WOD], DM, kt * 64, n0, n0 + 32, (bf16_t*)(ws + WS_WOAT) + (size_t)n0 * 512, 512); return; }
    r -= T_WOA;
    if (r < T_WOA) { const int nt = r / 8, kt = r % 8, n0 = nt * 64; transpose_tile(lds, a.in[I_WOF], DM, kt * 64, n0, n0 + 32, (bf16_t*)(ws + WS_WOBT) + (size_t)n0 * 512, 512); return; }
    r -= T_WOA;
    if (r < T_WOUT) { const int nt = r / 16, kt = r % 16, n0 = nt * 64; transpose_tile(lds, a.in[I_WOUT], DM, kt * 64, n0, n0 + 32, (bf16_t*)(ws + WS_WOUTT) + (size_t)n0 * DM, DM); return; }
    r -= T_WOUT;
    if (r < T_WGU) { const int e = r / 512, q = r % 512, nt = q / 16, kt = q % 16, n0 = nt * 64;
        transpose_tile(lds, a.in[I_WGU] + (size_t)e * DM * 2048, 2048, kt * 64, gu_src(n0), gu_src(n0 + 32), (bf16_t*)(ws + WS_WGUT) + ((size_t)e * 2048 + n0) * DM, DM); return; }
    r -= T_WGU;
    { const int e = r / 256, q = r % 256, nt = q / 16, kt = q % 16, n0 = nt * 64;
        transpose_tile(lds, a.in[I_WD] + (size_t)e * DM * DM, DM, kt * 64, n0, n0 + 32, (bf16_t*)(ws + WS_WDT) + ((size_t)e * DM + n0) * DM, DM); }
}
constexpr int J_WIN = 88 * 4, J_WOA = 16 * 2, J_WOUT = 16 * 4, J_SMALL = J_WIN + 2 * J_WOA + J_WOUT;
DI void sjob_addr(const Args& a, int j, int tid, const float*& s, int& ld, bf16_t*& d) {
    const int nn = tid & 63, k8 = tid >> 6, rn = tid >> 3, ch = tid & 7; unsigned char* ws = a.ws;
    if (j < J_WIN) { const int nt = j / 4, kt = j % 4, n0 = nt * 64, c0 = n0 + (n0 >= 3584 ? 12 : (n0 >= 2048 ? 8 : 0));
        ld = NIN; s = a.in[I_WIN] + (size_t)(kt * 256 + k8 * 8) * NIN + c0 + nn; d = (bf16_t*)(ws + WS_WINT) + (size_t)(n0 + rn) * DM + kt * 256 + ch * 8; return; }
    j -= J_WIN;
    if (j < 2 * J_WOA) { const int fox = j >= J_WOA, jj = fox ? j - J_WOA : j, nt = jj / 2, kt = jj % 2, n0 = nt * 64;
        ld = DM; s = a.in[fox ? I_WOF : I_WOD] + (size_t)(kt * 256 + k8 * 8) * DM + n0 + nn; d = (bf16_t*)(ws + (fox ? WS_WOBT : WS_WOAT)) + (size_t)(n0 + rn) * 512 + kt * 256 + ch * 8; return; }
    j -= 2 * J_WOA;
    { const int nt = j / 4, kt = j % 4, n0 = nt * 64;
        ld = DM; s = a.in[I_WOUT] + (size_t)(kt * 256 + k8 * 8) * DM + n0 + nn; d = (bf16_t*)(ws + WS_WOUTT) + (size_t)(n0 + rn) * DM + kt * 256 + ch * 8; } }
DI void sjob_load(float (&v)[32], const float* s, int ld) {
#pragma unroll
    for (int kk = 0; kk < 4; ++kk)
#pragma unroll
        for (int i = 0; i < 8; ++i) v[kk * 8 + i] = s[(size_t)(kk * 64 + i) * ld]; }
DI void sjob_emit(const float (&v)[32], char* tile, bf16_t* d, int tid) {
    const int nn = tid & 63, k8 = tid >> 6, rn = tid >> 3, ch = tid & 7;
#pragma unroll
    for (int kk = 0; kk < 4; ++kk) { u32x4 w; w.x = cvt_pk(v[kk * 8 + 0], v[kk * 8 + 1]); w.y = cvt_pk(v[kk * 8 + 2], v[kk * 8 + 3]); w.z = cvt_pk(v[kk * 8 + 4], v[kk * 8 + 5]); w.w = cvt_pk(v[kk * 8 + 6], v[kk * 8 + 7]);
        *(u32x4*)(tile + nn * 528 + (kk * 64 + k8 * 8) * 2) = w; }
    asm volatile("s_waitcnt lgkmcnt(0)" ::: "memory"); __builtin_amdgcn_s_barrier(); asm volatile("" ::: "memory");
#pragma unroll
    for (int q = 0; q < 4; ++q) *(u32x4*)(d + q * 64) = *(const u32x4*)(tile + rn * 528 + (ch + 8 * q) * 16); }
DI void ph0(const Args& a, float* lds) {
    const int tid = threadIdx.x, G = gridDim.x, bx = blockIdx.x;
    unsigned char* ws = a.ws;
    float* cs = lds; float* part = lds + 1024; char* tiles = (char*)(lds + 2048);
    { const float* c = a.in[I_C]; cs[tid] = c[tid]; cs[tid + 512] = c[tid + 512]; }
    float v0[32], v1[32]; const float* s0; int ld0; bf16_t* d0; const bool job0 = bx < J_SMALL;
    if (job0) { sjob_addr(a, bx, tid, s0, ld0, d0); sjob_load(v0, s0, ld0); }
    const bool pre1 = job0 && bx + G < J_SMALL; bf16_t* d1p = nullptr;
    if (pre1) { const float* s1; int ld1; sjob_addr(a, bx + G, tid, s1, ld1, d1p); sjob_load(v1, s1, ld1); }
    for (int grp = bx; grp < 256; grp += G) {
        const int col = tid % 24, ks = tid / 24, j = grp * 24 + col; const float* w = a.in[I_WADA];
        float wv[49]; const int kb = ks * 49; const float bsv = tid < 24 ? a.in[I_BADA][grp * 24 + tid] : 0.f;
        if (ks < 21) {
#pragma unroll
            for (int u = 0; u < 49; ++u) { const int k = kb + u; wv[u] = k < DM ? w[(size_t)k * 6144 + j] : 0.f; } }
        asm volatile("s_waitcnt lgkmcnt(0)" ::: "memory"); __builtin_amdgcn_s_barrier(); asm volatile("" ::: "memory");
        float acc = 0.f;
        if (ks < 21) {
#pragma unroll
            for (int u = 0; u < 49; ++u) { const int k = kb + u; acc += (k < DM ? cs[k] : 0.f) * wv[u]; } }
        if (ks < 21) part[ks * 24 + col] = acc;
        asm volatile("s_waitcnt lgkmcnt(0)" ::: "memory"); __builtin_amdgcn_s_barrier(); asm volatile("" ::: "memory");
        if (tid < 24) { float s = bsv; for (int q = 0; q < 21; ++q) s += part[q * 24 + tid]; ((float*)(ws + WS_MOD))[grp * 24 + tid] = s; }
    }
    if (job0) { int par = 0;
        for (int j = bx;; ) { const int jn = j + G; const bool more = jn < J_SMALL; const float* s1; int ld1; bf16_t* d1;
            if (more) { if (pre1 && j == bx) d1 = d1p; else { sjob_addr(a, jn, tid, s1, ld1, d1); sjob_load(v1, s1, ld1); } }
            sjob_emit(v0, tiles + par * 33792, d0, tid); par ^= 1;
            if (!more) break;
#pragma unroll
            for (int i = 0; i < 32; ++i) v0[i] = v1[i];
            d0 = d1; j = jn; } }
}

DI void ph1(const Args& a, float* lds) {
    const int tid = threadIdx.x, lane = tid & 63, wave = tid >> 6, G = gridDim.x;
    float* A1 = lds; float* B1 = lds + 1024; float* wsm = lds + 2048;
    const float* mod = (const float*)(a.ws + WS_MOD);
    for (int k = tid; k < DM; k += NTHREADS) { A1[k] = a.in[I_G1][k] * (1.f + mod[1024 + k]); B1[k] = mod[k]; }
    { float wl[24];
#pragma unroll
        for (int q = 0; q < 24; ++q) { const int i = tid + q * NTHREADS, k = i / 12, j = i % 12; wl[q] = a.in[I_WIN][(size_t)k * NIN + (j < 8 ? 2048 + j : 3592 + (j - 8))]; }
#pragma unroll
        for (int q = 0; q < 24; ++q) { const int i = tid + q * NTHREADS, k = i / 12, j = i % 12; wsm[j * DM + k] = wl[q]; } }
    __syncthreads();
    bf16_t* H = (bf16_t*)(a.ws + WS_H); float* SP = (float*)(a.ws + WS_SP);
    for (int t0 = (blockIdx.x * NWAVES + wave) * 2; t0 < SEQ; t0 += G * NWAVES * 2) {
        f32x4 v[2][4]; float ss[2] = {0.f, 0.f};
#pragma unroll
        for (int q = 0; q < 2; ++q)
#pragma unroll
            for (int i = 0; i < 4; ++i) v[q][i] = *(const f32x4*)(a.in[I_X] + (size_t)(t0 + q) * DM + lane * 4 + 256 * i);
#pragma unroll
        for (int q = 0; q < 2; ++q)
#pragma unroll
            for (int i = 0; i < 4; ++i) ss[q] += v[q][i][0] * v[q][i][0] + v[q][i][1] * v[q][i][1] + v[q][i][2] * v[q][i][2] + v[q][i][3] * v[q][i][3];
        ss[0] = wave_sum(ss[0]); ss[1] = wave_sum(ss[1]);
#pragma unroll
        for (int q = 0; q < 2; ++q) { const float rstd = rsqrtf(ss[q] * (1.f / DM) + 1e-6f);
#pragma unroll
            for (int i = 0; i < 4; ++i) { const int k = lane * 4 + 256 * i;
#pragma unroll
                for (int e = 0; e < 4; ++e) v[q][i][e] = v[q][i][e] * rstd * A1[k + e] + B1[k + e];
                u32x2 w; w.x = cvt_pk(v[q][i][0], v[q][i][1]); w.y = cvt_pk(v[q][i][2], v[q][i][3]);
                *(u32x2*)(H + (size_t)(t0 + q) * DM + k) = w; } }
        float pv[32];
#pragma unroll
        for (int j = 0; j < 16; ++j) { float p0 = 0.f, p1 = 0.f;
            if (j < 12) {
#pragma unroll
                for (int i = 0; i < 4; ++i) { const f32x4 wv = *(const f32x4*)(wsm + j * DM + lane * 4 + 256 * i);
                    p0 += v[0][i][0] * wv[0] + v[0][i][1] * wv[1] + v[0][i][2] * wv[2] + v[0][i][3] * wv[3];
                    p1 += v[1][i][0] * wv[0] + v[1][i][1] * wv[1] + v[1][i][2] * wv[2] + v[1][i][3] * wv[3]; } }
            pv[j] = p0; pv[16 + j] = p1;
            if ((j & 1) == 1) __builtin_amdgcn_sched_barrier(0); }
#define RED_STEP(N, MASK) _Pragma("unroll") for (int i_ = 0; i_ < (N); ++i_) { const bool up_ = (lane & (MASK)) != 0; const float snd_ = up_ ? pv[i_] : pv[i_ + (N)], kp_ = up_ ? pv[i_ + (N)] : pv[i_]; pv[i_] = kp_ + __shfl_xor(snd_, (MASK)); }
        RED_STEP(16, 32) RED_STEP(8, 16) RED_STEP(4, 8) RED_STEP(2, 4) RED_STEP(1, 2)
#undef RED_STEP
        pv[0] += __shfl_xor(pv[0], 1);
        { const int idx = ((lane >> 5) & 1) * 16 + ((lane >> 4) & 1) * 8 + ((lane >> 3) & 1) * 4 + ((lane >> 2) & 1) * 2 + ((lane >> 1) & 1), tk = idx >> 4, j = idx & 15;
            if ((lane & 1) == 0 && j < 12) { SP[(size_t)(t0 + tk) * 16 + j] = pv[0];
                if (j >= 8) ((float*)(a.ws + WS_LF))[(size_t)(j - 8) * SEQ + t0 + tk] = pv[0]; } }
    }
}

constexpr int P2_NT = 20;
DI void ph2(const Args& a, unsigned char* ldsb) {
    pg8::Gemm g{(const bf16_t*)(a.ws + WS_H), (const bf16_t*)(a.ws + WS_WINT), SEQ, NPJ, DM};
    pg8::OrderDense S; S.init(SEQ / 256, P2_NT, (int)gridDim.x, (int)blockIdx.x);
    pg8::EpiStorePlain E{(bf16_t*)(a.ws + WS_PROJ), NPJ};
    pg8::gemm_phase<pg8::EpiStorePlain, pg8::OrderDense>((LAS unsigned char*)ldsb, g, S, E);
}
DI void ph2_rest(const Args& a, unsigned char* ldsb, int c, int G) {
    pg8::Gemm g{(const bf16_t*)(a.ws + WS_H), (const bf16_t*)(a.ws + WS_WINT), SEQ, NPJ, DM};
    pg8::OrderDense S; S.init(SEQ / 256, NPJ / 256 - P2_NT, G, c, P2_NT);
    pg8::EpiStorePlain E{(bf16_t*)(a.ws + WS_PROJ), NPJ};
    pg8::gemm_phase<pg8::EpiStorePlain, pg8::OrderDense>((LAS unsigned char*)ldsb, g, S, E);
}

DI void ph3_fcum(const Args& a, float* lds, int fb) {
    const int tid = threadIdx.x, lane = tid & 63, wave = tid >> 6, h = fb >> 2, seg = fb & 3;
    const float* LFh = (const float*)(a.ws + WS_LF) + (size_t)h * SEQ; float* F = (float*)(a.ws + WS_F);
    const float bf = a.in[I_BFG][h];
    double* wtot = (double*)lds;
    float lf[8]; double pre = 0.0;
    for (int s_ = 0; s_ <= seg; ++s_) { const float* p = LFh + (size_t)s_ * 4096 + tid * 8;
        const f32x4 x0 = *(const f32x4*)p, x1 = *(const f32x4*)(p + 4);
        lf[0] = logsigf(x0[0] + bf); lf[1] = logsigf(x0[1] + bf); lf[2] = logsigf(x0[2] + bf); lf[3] = logsigf(x0[3] + bf); lf[4] = logsigf(x1[0] + bf); lf[5] = logsigf(x1[1] + bf); lf[6] = logsigf(x1[2] + bf); lf[7] = logsigf(x1[3] + bf);
        if (s_ < seg) { double s = 0.0;
#pragma unroll
            for (int i = 0; i < 8; ++i) s += (double)lf[i];
            pre += s; } }
    double s = 0.0;
#pragma unroll
    for (int i = 0; i < 8; ++i) s += (double)lf[i];
    double inc = s, ptot = pre;
#pragma unroll
    for (int o_ = 1; o_ < 64; o_ <<= 1) { const double y = __shfl_up(inc, o_); if (lane >= o_) inc += y; ptot += __shfl_xor(ptot, o_); }
    __syncthreads();
    if (lane == 63) { wtot[wave] = inc; wtot[8 + wave] = ptot; }
    __syncthreads();
    double off = inc - s;
    for (int w = 0; w < NWAVES; ++w) { off += wtot[8 + w]; if (w < wave) off += wtot[w]; }
#pragma unroll
    for (int i = 0; i < 8; ++i) { off += (double)lf[i]; lf[i] = (float)off; }
    float* o = F + (size_t)h * SEQ + (size_t)seg * 4096 + tid * 8;
    *(f32x4*)o = (f32x4){lf[0], lf[1], lf[2], lf[3]}; *(f32x4*)(o + 4) = (f32x4){lf[4], lf[5], lf[6], lf[7]};
    __syncthreads();
}
namespace prep {
constexpr int QS = 0, KS = 17408, KT = 34816, VT = 53248, UNIT = 71680, SM = 2 * UNIT;
DI bf16x8 ld8(const char* p) { return *(const bf16x8*)p; }
template <int C, int M4> struct TRow { static DI void run(const float (&T)[64], const float* Ls, float& a0, float& a1) {
    if constexpr (4 * M4 < C) { const f32x4 Lv = *(const f32x4*)(Ls + C * 68 + 4 * M4);
        a0 -= Lv[0] * T[4 * M4]; if constexpr (4 * M4 + 1 < C) a1 -= Lv[1] * T[4 * M4 + 1]; if constexpr (4 * M4 + 2 < C) a0 -= Lv[2] * T[4 * M4 + 2]; if constexpr (4 * M4 + 3 < C) a1 -= Lv[3] * T[4 * M4 + 3];
        TRow<C, M4 + 1>::run(T, Ls, a0, a1); } } };
template <int C> struct TRow<C, 16> { static DI void run(const float (&)[64], const float*, float&, float&) {} };
template <int C> DI void tsolve(float (&T)[64], const float* Ls, int lane) {
    if constexpr (C < 64) { float a0 = (lane == C) ? 1.f : 0.f, a1 = 0.f; TRow<C, 0>::run(T, Ls, a0, a1); T[C] = a0 + a1; asm volatile("" ::: "memory"); __builtin_amdgcn_sched_barrier(0); tsolve<C + 1>(T, Ls, lane); } }
}
DI void ph3_prep2(const Args& a, char* lds, int pair) {
    using namespace prep;
    int tid_ = threadIdx.x; asm volatile("" : "+v"(tid_));
    const int tid = tid_, lane = tid & 63, wave = tid >> 6, grp = wave >> 2, wq = wave & 3, tg = tid & 255, lr = lane & 15, lq = lane >> 4;
    int unit = pair * 2 + grp; if (unit >= NH * NCH) unit = NH * NCH - 1;
    const int h = unit & 3, n = unit >> 2, t0 = n * CH;
    char* U = lds + grp * UNIT;
    float* gcs = (float*)(lds + SM) + grp * 192; float* bes = gcs + 64; float* egs = gcs + 128;
    const float* SP = (const float*)(a.ws + WS_SP); const bf16_t* P = (const bf16_t*)(a.ws + WS_PROJ);
    const size_t cb = (size_t)(h * NCH + n);
    bf16_t* WF = (bf16_t*)(a.ws + WS_DNW) + cb * 8192; bf16_t* UF = (bf16_t*)(a.ws + WS_DNU) + cb * 8192;
    bf16_t* QF = (bf16_t*)(a.ws + WS_DNQD) + cb * 8192; bf16_t* KF = (bf16_t*)(a.ws + WS_DNKD) + cb * 8192; bf16_t* AF = (bf16_t*)(a.ws + WS_DNATT) + cb * 4096;
    __syncthreads();
    const int d8 = tg & 15, ci = tg >> 4; const float* cw = a.in[I_CONVW];
    float sp0 = 0.f, sp1 = 0.f, al_ = 0.f, dt_ = 0.f;
    if (wq == 0) { const int t = t0 + lane; sp0 = SP[(size_t)t * 16 + h]; sp1 = SP[(size_t)t * 16 + 4 + h]; al_ = a.in[I_ALOG][h]; dt_ = a.in[I_DTB][h]; }
    {
#define CV_LOADW(W, sec) do { const int col_ = (sec) * 512 + h * 128 + d8 * 8; \
            _Pragma("unroll") for (int j_ = 0; j_ < 4; ++j_) { W[j_][0] = *(const f32x4*)(cw + j_ * 1536 + col_); W[j_][1] = *(const f32x4*)(cw + j_ * 1536 + col_ + 4); } } while (0)
#define CV_LOADX(X, sec, ih) do { const int col_ = (sec) * 512 + h * 128 + d8 * 8; \
            _Pragma("unroll") for (int j_ = 0; j_ < 5; ++j_) { int tt_ = t0 + 2 * ci + 32 * (ih) - 3 + j_; tt_ = tt_ < 0 ? 0 : tt_; X[j_] = *(const u32x4*)(P + (size_t)tt_ * NPJ + col_); } } while (0)
          \
#define CV_COMP(sec, ih, W, X) do { const int c0 = 2 * ci + 32 * (ih); float v[2][8]; \
            _Pragma("unroll") for (int i_ = 0; i_ < 2; ++i_) { const int c = c0 + i_, t = t0 + c; \
                _Pragma("unroll") for (int e = 0; e < 8; ++e) v[i_][e] = 0.f; \
                _Pragma("unroll") for (int j_ = 0; j_ < 4; ++j_) { const float ok = (t - 3 + j_ >= 0) ? 1.f : 0.f; const u32x4 x = X[i_ + j_]; \
                    v[i_][0] += ok * W[j_][0][0] * __uint_as_float(x.x << 16); v[i_][1] += ok * W[j_][0][1] * __uint_as_float(x.x & 0xffff0000u); v[i_][2] += ok * W[j_][0][2] * __uint_as_float(x.y << 16); v[i_][3] += ok * W[j_][0][3] * __uint_as_float(x.y & 0xffff0000u); \
                    v[i_][4] += ok * W[j_][1][0] * __uint_as_float(x.z << 16); v[i_][5] += ok * W[j_][1][1] * __uint_as_float(x.z & 0xffff0000u); v[i_][6] += ok * W[j_][1][2] * __uint_as_float(x.w << 16); v[i_][7] += ok * W[j_][1][3] * __uint_as_float(x.w & 0xffff0000u); } \
                float ss = 0.f; \
                _Pragma("unroll") for (int e = 0; e < 8; ++e) { v[i_][e] = fsilu(v[i_][e]); ss += v[i_][e] * v[i_][e]; } \
                if ((sec) < 2) { ss += dpp_f<0xB1>(ss); ss += dpp_f<0x4E>(ss); ss += dpp_f<0x141>(ss); ss += dpp_f<0x140>(ss); \
                    const float sc = rsqrtf(ss + 1e-6f) * ((sec) == 0 ? 0.08838834764831845f : 1.f); \
                    _Pragma("unroll") for (int e = 0; e < 8; ++e) v[i_][e] *= sc; } \
                u32x4 pk; pk.x = cvt_pk(v[i_][0], v[i_][1]); pk.y = cvt_pk(v[i_][2], v[i_][3]); pk.z = cvt_pk(v[i_][4], v[i_][5]); pk.w = cvt_pk(v[i_][6], v[i_][7]); \
                if ((sec) == 0) { *(u32x4*)(U + QS + c * 272 + d8 * 16) = pk; \
                    const float eg = egs[c]; \
                    const int base = (((c >> 4) * 4 + (d8 >> 2)) * 64 + (c & 15)) * 8 + 4 * ((d8 & 3) >> 1), l0 = (2 * (d8 & 3)) & 3; \
                    u32x2 q0, q1; q0.x = cvt_pk(v[i_][0] * eg, v[i_][1] * eg); q0.y = cvt_pk(v[i_][2] * eg, v[i_][3] * eg); q1.x = cvt_pk(v[i_][4] * eg, v[i_][5] * eg); q1.y = cvt_pk(v[i_][6] * eg, v[i_][7] * eg); \
                    *(u32x2*)(QF + base + l0 * 128) = q0; *(u32x2*)(QF + base + (l0 + 1) * 128) = q1; } \
                else if ((sec) == 1) *(u32x4*)(U + KS + c * 272 + d8 * 16) = pk; } \
            if ((sec) >= 1) { bf16_t* T_ = (bf16_t*)(U + ((sec) == 1 ? KT : VT)) + (d8 * 8) * 72 + ((((c0 >> 3) ^ (d8 & 7)) << 3) | (c0 & 7)); \
                _Pragma("unroll") for (int e = 0; e < 8; ++e) *(unsigned*)(T_ + e * 72) = cvt_pk(v[0][e], v[1][e]); } } while (0)
        f32x4 W0[4][2]; u32x4 X0[5], X1[5];
        CV_LOADW(W0, 0); CV_LOADX(X0, 0, 0);
        if (wq == 0) { const float be = sigm(sp0);
            float g = -expf(al_) * softplusf(sp1 + dt_);
#pragma unroll
            for (int o_ = 1; o_ < 64; o_ <<= 1) { const float y = __shfl_up(g, o_); if (lane >= o_) g += y; }
            gcs[lane] = g; bes[lane] = be; egs[lane] = expf(g); }
        asm volatile("s_waitcnt lgkmcnt(0)" ::: "memory"); __builtin_amdgcn_s_barrier(); asm volatile("" ::: "memory");
        CV_LOADX(X1, 0, 1);                  CV_COMP(0, 0, W0, X0);
        CV_LOADX(X0, 1, 0);                  CV_COMP(0, 1, W0, X1);
        CV_LOADW(W0, 1); CV_LOADX(X1, 1, 1); CV_COMP(1, 0, W0, X0);
        CV_LOADX(X0, 2, 0);                  CV_COMP(1, 1, W0, X1);
        CV_LOADW(W0, 2); CV_LOADX(X1, 2, 1); CV_COMP(2, 0, W0, X0);
                                             CV_COMP(2, 1, W0, X1);
#undef CV_LOADW
#undef CV_LOADX
#undef CV_COMP
    }
    __syncthreads();
    f32x4 Lr[4];
    { const int mt = wq;
#pragma unroll
        for (int nt = 0; nt < 4; ++nt) { Lr[nt] = (f32x4){0.f, 0.f, 0.f, 0.f};
            if (nt <= mt) {
#pragma unroll
                for (int s = 0; s < 4; ++s) Lr[nt] = MFMA16(ld8(U + KS + (16 * mt + lr) * 272 + (32 * s + 8 * lq) * 2), ld8(U + KS + (16 * nt + lr) * 272 + (32 * s + 8 * lq) * 2), Lr[nt]); } }
        const int ntq = 3 - wq; const float gcc = gcs[16 * ntq + lr];
#pragma unroll
        for (int mtk = 0; mtk < 4; ++mtk) { f32x4 acc = (f32x4){0.f, 0.f, 0.f, 0.f};
            if (mtk <= ntq) {
#pragma unroll
                for (int s = 0; s < 4; ++s) acc = MFMA16(ld8(U + KS + (16 * mtk + lr) * 272 + (32 * s + 8 * lq) * 2), ld8(U + QS + (16 * ntq + lr) * 272 + (32 * s + 8 * lq) * 2), acc);
#pragma unroll
                for (int r = 0; r < 4; ++r) { const int m = 16 * mtk + 4 * lq + r, c = 16 * ntq + lr; acc[r] = (m <= c) ? acc[r] * fexp(gcc - gcs[m]) : 0.f; } }
            u32x2 o_; o_.x = cvt_pk(acc[0], acc[1]); o_.y = cvt_pk(acc[2], acc[3]);
            *(u32x2*)(AF + ((ntq * 2 + (mtk >> 1)) * 64 + lane) * 8 + 4 * (mtk & 1)) = o_; }
    }
    __syncthreads();
    { const int mt = wq; float* LT = (float*)(U + QS);
#pragma unroll
        for (int nt = 0; nt < 4; ++nt) if (nt <= mt) { const int m = 16 * nt + lr; f32x4 o_;
#pragma unroll
            for (int r = 0; r < 4; ++r) { const int c = 16 * mt + 4 * lq + r; o_[r] = (m < c) ? bes[c] * Lr[nt][r] * fexp(gcs[c] - gcs[m]) : 0.f; }
            *(f32x4*)(LT + m * 68 + 16 * mt + 4 * lq) = o_; } }
    __syncthreads();
    { const float gl = gcs[63];
        for (int i = tg; i < 2048; i += 256) { const int dk = i >> 4, cq = i & 15;
            const u32x2 x = *(const u32x2*)(U + KT + dk * 144 + (((cq >> 1) ^ ((dk >> 3) & 7)) << 4) + (cq & 1) * 8);
            const float e0 = fexp(gl - gcs[4 * cq]), e1 = fexp(gl - gcs[4 * cq + 1]), e2 = fexp(gl - gcs[4 * cq + 2]), e3 = fexp(gl - gcs[4 * cq + 3]);
            u32x2 o_; o_.x = cvt_pk(__uint_as_float(x.x << 16) * e0, __uint_as_float(x.x & 0xffff0000u) * e1); o_.y = cvt_pk(__uint_as_float(x.y << 16) * e2, __uint_as_float(x.y & 0xffff0000u) * e3);
            *(u32x2*)(KF + (((dk >> 4) * 2 + (cq >> 3)) * 64 + (cq & 3) * 16 + (dk & 15)) * 8 + 4 * ((cq >> 2) & 1)) = o_; }
        if (tg == 0) ((float*)(a.ws + WS_EG))[cb] = egs[63]; }
    { const float* LT = (const float*)(U + QS); float* Tl = (float*)(U + KS); const int jl = lane & 15, rg = lane >> 4, jc = 16 * wq + jl;
#pragma unroll
        for (int ib = 0; ib < 4; ++ib) { float acc[4];
#pragma unroll
            for (int e = 0; e < 4; ++e) acc[e] = (16 * ib + 4 * rg + e == jc) ? 1.f : 0.f;
#pragma unroll 4
            for (int m = 0; m < 16 * ib; ++m) { const float t = Tl[m * 68 + jc]; const f32x4 Lv = *(const f32x4*)(LT + m * 68 + 16 * ib + 4 * rg);
#pragma unroll
                for (int e = 0; e < 4; ++e) acc[e] -= Lv[e] * t; }
#pragma unroll
            for (int p = 0; p < 16; ++p) { const float t = __shfl(acc[p & 3], (p >> 2) * 16 + jl);
                if (rg == (p >> 2)) Tl[(16 * ib + p) * 68 + jc] = t;
                if (p < 15) { const f32x4 Lv = *(const f32x4*)(LT + (16 * ib + p) * 68 + 16 * ib + 4 * rg);
#pragma unroll
                    for (int e = 0; e < 4; ++e) acc[e] -= Lv[e] * t; } }
            asm volatile("s_waitcnt lgkmcnt(0)" ::: "memory"); }
    }
    __syncthreads();
    { const float* Tl = (const float*)(U + KS); const int c = tg >> 2, m0 = (tg & 3) * 16;
        f32x4 tv[4];
#pragma unroll
        for (int q = 0; q < 4; ++q) tv[q] = *(const f32x4*)(Tl + c * 68 + m0 + 4 * q);
        __syncthreads();
        bf16_t* Tb = (bf16_t*)(U + QS); bf16_t* Tg = (bf16_t*)(U + KS);
#pragma unroll
        for (int q = 0; q < 4; ++q) { u32x2 b_, g_; float be[4], bg[4];
#pragma unroll
            for (int e = 0; e < 4; ++e) { const int m = m0 + 4 * q + e; be[e] = tv[q][e] * bes[m]; bg[e] = be[e] * egs[m]; }
            b_.x = cvt_pk(be[0], be[1]); b_.y = cvt_pk(be[2], be[3]); g_.x = cvt_pk(bg[0], bg[1]); g_.y = cvt_pk(bg[2], bg[3]);
            *(u32x2*)(Tb + c * 72 + m0 + 4 * q) = b_; *(u32x2*)(Tg + c * 72 + m0 + 4 * q) = g_; } }
    __syncthreads();
    {
#pragma unroll
        for (int q = 0; q < 2; ++q) { const int nt = 2 * wq + q;
#pragma unroll
            for (int mt = 0; mt < 4; ++mt) { f32x4 acc = (f32x4){0.f, 0.f, 0.f, 0.f};
#pragma unroll
                for (int s = 0; s < 2; ++s) acc = MFMA16(ld8(U + QS + (16 * mt + lr) * 144 + (32 * s + 8 * lq) * 2), ld8(U + VT + (16 * nt + lr) * 144 + (((4 * s + lq) ^ ((2 * nt + (lr >> 3)) & 7)) << 4)), acc);
                u32x2 o_; o_.x = cvt_pk(acc[0], acc[1]); o_.y = cvt_pk(acc[2], acc[3]);
                *(u32x2*)(UF + ((nt * 4 + mt) * 64 + lane) * 4) = o_; } }
#pragma unroll
        for (int q = 0; q < 2; ++q) { const int mtk = 2 * wq + q;
#pragma unroll
            for (int ntc = 0; ntc < 4; ++ntc) { f32x4 acc = (f32x4){0.f, 0.f, 0.f, 0.f};
#pragma unroll
                for (int s = 0; s < 2; ++s) acc = MFMA16(ld8(U + KT + (16 * mtk + lr) * 144 + (((4 * s + lq) ^ ((2 * mtk + (lr >> 3)) & 7)) << 4)), ld8(U + KS + (16 * ntc + lr) * 144 + (32 * s + 8 * lq) * 2), acc);
                u32x2 o_; o_.x = cvt_pk(-acc[0], -acc[1]); o_.y = cvt_pk(-acc[2], -acc[3]);
                *(u32x2*)(WF + ((ntc * 4 + (mtk >> 1)) * 64 + lane) * 8 + 4 * (mtk & 1)) = o_; } }
    }
}
DI void ph3_norms(const Args& a, float* lds) {
    const int lane = threadIdx.x & 63, wave = threadIdx.x >> 6, NW = gridDim.x * NWAVES, sub = lane >> 4, l16 = lane & 15;
    const bf16_t* P = (const bf16_t*)(a.ws + WS_PROJ); float* TB = (float*)(a.ws + WS_NRMT);
    for (int grp = blockIdx.x * NWAVES + wave; grp < SEQ / 8; grp += NW) {
        float mq[4] = {0.f, 0.f, 0.f, 0.f}, mk[4] = {0.f, 0.f, 0.f, 0.f}, md[4] = {3.0e38f, 3.0e38f, 3.0e38f, 3.0e38f};
#pragma unroll
        for (int it = 0; it < 2; ++it) { const bf16_t* row = P + (size_t)(grp * 8 + it * 4 + sub) * NPJ + l16 * 8;
            u32x4 xq[4], xk[4];
#pragma unroll
            for (int h = 0; h < 4; ++h) { xq[h] = *(const u32x4*)(row + PJ_FQ + h * 128); xk[h] = *(const u32x4*)(row + PJ_FK + h * 128); }
#pragma unroll
            for (int h = 0; h < 4; ++h) { float sq = 0.f, sk = 0.f, sd = 0.f;
#pragma unroll
                for (int e = 0; e < 4; ++e) { const float a0 = __uint_as_float(xq[h][e] << 16), a1 = __uint_as_float(xq[h][e] & 0xffff0000u), b0 = __uint_as_float(xk[h][e] << 16), b1 = __uint_as_float(xk[h][e] & 0xffff0000u);
                    sq += a0 * a0 + a1 * a1; sk += b0 * b0 + b1 * b1; sd += a0 * b0 + a1 * b1; }
#pragma unroll
                for (int o_ = 1; o_ <= 8; o_ <<= 1) { sq += __shfl_xor(sq, o_); sk += __shfl_xor(sk, o_); sd += __shfl_xor(sd, o_); }
                mq[h] = fmaxf(mq[h], sq); mk[h] = fmaxf(mk[h], sk); md[h] = fminf(md[h], sd); } }
#pragma unroll
        for (int h = 0; h < 4; ++h) { mq[h] = fmaxf(mq[h], __shfl_xor(mq[h], 16)); mq[h] = fmaxf(mq[h], __shfl_xor(mq[h], 32)); mk[h] = fmaxf(mk[h], __shfl_xor(mk[h], 16)); mk[h] = fmaxf(mk[h], __shfl_xor(mk[h], 32));
            md[h] = fminf(md[h], __shfl_xor(md[h], 16)); md[h] = fminf(md[h], __shfl_xor(md[h], 32));
            if (lane == 0) { TB[grp * 12 + h] = mq[h]; TB[grp * 12 + 4 + h] = mk[h]; TB[grp * 12 + 8 + h] = md[h]; } }
    }
}
DI void ph3(const Args& a, float* lds) {
    const int G = gridDim.x;
    for (int fb = blockIdx.x; fb < 16; fb += G) ph3_fcum(a, lds, fb);
    for (int p = blockIdx.x; p < NH * NCH / 2; p += G) ph3_prep2(a, (char*)lds, p);
    ph3_norms(a, lds);
}

namespace dn {
DI unsigned cvtpk(float lo, float hi) { return cvt_pk(lo, hi); }
DI bf16x8 packB(const f32x4& t0, const f32x4& t1) { u32x4 w = {cvtpk(t0[0], t0[1]), cvtpk(t0[2], t0[3]), cvtpk(t1[0], t1[1]), cvtpk(t1[2], t1[3])}; return *reinterpret_cast<bf16x8*>(&w); }
DI bf16x8 frag(const bf16_t* base, int f, int lane) { return *(const bf16x8*)(base + ((size_t)f * 64 + lane) * 8); }
template <bool WITH_U, bool WITH_O>
DI void step(const bf16_t* WFn, const bf16_t* KFn, const bf16_t* QFn, const bf16_t* AFn, const bf16_t* UFs, float eg, f32x4 (&S)[8], f32x4 (&o)[4], int lane) {
    bf16x8 sb[4];
#pragma unroll
    for (int s = 0; s < 4; ++s) sb[s] = packB(S[2 * s], S[2 * s + 1]);
    f32x4 vn[4];
#pragma unroll
    for (int mt = 0; mt < 4; ++mt) {
        if (WITH_U) { const u32x2 w = *(const u32x2*)(UFs + ((size_t)mt * 64 + lane) * 4); vn[mt] = (f32x4){__uint_as_float(w.x << 16), __uint_as_float(w.x & 0xffff0000u), __uint_as_float(w.y << 16), __uint_as_float(w.y & 0xffff0000u)}; }
        else vn[mt] = (f32x4){0.f, 0.f, 0.f, 0.f};
#pragma unroll
        for (int s = 0; s < 4; ++s) vn[mt] = MFMA16(frag(WFn, mt * 4 + s, lane), sb[s], vn[mt]); }
    if (WITH_O) {
#pragma unroll
        for (int mt = 0; mt < 4; ++mt) { o[mt] = (f32x4){0.f, 0.f, 0.f, 0.f};
#pragma unroll
            for (int s = 0; s < 4; ++s) o[mt] = MFMA16(frag(QFn, mt * 4 + s, lane), sb[s], o[mt]); } }
    bf16x8 vb[2];
#pragma unroll
    for (int s = 0; s < 2; ++s) vb[s] = packB(vn[2 * s], vn[2 * s + 1]);
    if (WITH_O) {
#pragma unroll
        for (int mt = 0; mt < 4; ++mt)
#pragma unroll
            for (int s = 0; s < 2; ++s) o[mt] = MFMA16(frag(AFn, mt * 2 + s, lane), vb[s], o[mt]); }
#pragma unroll
    for (int mt = 0; mt < 8; ++mt) { S[mt] = S[mt] * eg;
#pragma unroll
        for (int s = 0; s < 2; ++s) S[mt] = MFMA16(frag(KFn, mt * 2 + s, lane), vb[s], S[mt]); }
}
}
constexpr int NGRP = 16, GRP = 16;
constexpr int NSCAN = NH * NGRP;
constexpr int SBUF = 57344;
template <int N> struct Stage { u32x4 r[N]; };
DI void stage_load2(Stage<4>& st, const bf16_t* s0, const bf16_t* s1) {
    const int tid = threadIdx.x;
    st.r[0] = *(const u32x4*)(s0 + (size_t)tid * 8); st.r[1] = *(const u32x4*)(s0 + (size_t)(tid + 512) * 8);
    st.r[2] = *(const u32x4*)(s1 + (size_t)tid * 8); st.r[3] = *(const u32x4*)(s1 + (size_t)(tid + 512) * 8);
}
DI void stage_write2(const Stage<4>& st, char* buf) {
    const int tid = threadIdx.x;
    *(u32x4*)(buf + tid * 16) = st.r[0]; *(u32x4*)(buf + (tid + 512) * 16) = st.r[1];
    *(u32x4*)(buf + 16384 + tid * 16) = st.r[2]; *(u32x4*)(buf + 16384 + (tid + 512) * 16) = st.r[3];
}
DI void stage_load4(Stage<7>& st, const bf16_t* s0, const bf16_t* s1, const bf16_t* s2, const bf16_t* s3) {
    const int tid = threadIdx.x;
    st.r[0] = *(const u32x4*)(s0 + (size_t)tid * 8); st.r[1] = *(const u32x4*)(s0 + (size_t)(tid + 512) * 8);
    st.r[2] = *(const u32x4*)(s1 + (size_t)tid * 8); st.r[3] = *(const u32x4*)(s1 + (size_t)(tid + 512) * 8);
    st.r[4] = *(const u32x4*)(s2 + (size_t)tid * 8); st.r[5] = *(const u32x4*)(s2 + (size_t)(tid + 512) * 8);
    st.r[6] = *(const u32x4*)(s3 + (size_t)tid * 8);
}
DI void stage_write4(const Stage<7>& st, char* buf) {
    const int tid = threadIdx.x;
    *(u32x4*)(buf + tid * 16) = st.r[0]; *(u32x4*)(buf + (tid + 512) * 16) = st.r[1];
    *(u32x4*)(buf + 16384 + tid * 16) = st.r[2]; *(u32x4*)(buf + 16384 + (tid + 512) * 16) = st.r[3];
    *(u32x4*)(buf + 32768 + tid * 16) = st.r[4]; *(u32x4*)(buf + 32768 + (tid + 512) * 16) = st.r[5];
    *(u32x4*)(buf + 49152 + tid * 16) = st.r[6];
}
DI f32x4 u_unpack(const u32x2 w) { return (f32x4){__uint_as_float(w.x << 16), __uint_as_float(w.x & 0xffff0000u), __uint_as_float(w.y << 16), __uint_as_float(w.y & 0xffff0000u)}; }
DI void scanA_chain(const Args& a, char* lds, int chain) {
    const int tid = threadIdx.x, lane = tid & 63, vs = tid >> 6, lr = lane & 15, lq = lane >> 4;
    const int h = chain >> 4, g = chain & 15;
    f32x4 SQ[8], SP[8];
#pragma unroll
    for (int mt = 0; mt < 8; ++mt) { SQ[mt] = (f32x4){0.f, 0.f, 0.f, 0.f};
#pragma unroll
        for (int r = 0; r < 4; ++r) SP[mt][r] = (16 * mt + 4 * lq + r == 16 * vs + lr) ? 1.f : 0.f; }
    const size_t cb0 = (size_t)(h * NCH + g * GRP);
    const bf16_t* WF = (const bf16_t*)(a.ws + WS_DNW) + cb0 * 8192; const bf16_t* KF = (const bf16_t*)(a.ws + WS_DNKD) + cb0 * 8192;
    const bf16_t* UF = (const bf16_t*)(a.ws + WS_DNU) + cb0 * 8192 + (size_t)vs * 1024; const float* EG = (const float*)(a.ws + WS_EG) + cb0;
    Stage<4> st; u32x2 ucur[4], unxt[4];
    __syncthreads();
    stage_load2(st, WF, KF);
#pragma unroll
    for (int mt = 0; mt < 4; ++mt) ucur[mt] = *(const u32x2*)(UF + ((size_t)mt * 64 + lane) * 4);
    float egc = EG[0], egn = 0.f;
    asm volatile("s_waitcnt vmcnt(0)" ::: "memory");
    stage_write2(st, lds);
    __syncthreads();
    for (int i = 0; i < GRP; ++i) {
        const char* buf = lds + (i & 1) * SBUF;
        if (i + 1 < GRP) { stage_load2(st, WF + (size_t)(i + 1) * 8192, KF + (size_t)(i + 1) * 8192);
#pragma unroll
            for (int mt = 0; mt < 4; ++mt) unxt[mt] = *(const u32x2*)(UF + (size_t)(i + 1) * 8192 + ((size_t)mt * 64 + lane) * 4);
            egn = EG[i + 1]; }
        const float eg = egc;
        const bf16_t* Wl = (const bf16_t*)buf; const bf16_t* Kl = (const bf16_t*)(buf + 16384);
        bf16x8 sbq[4], sbp[4];
#pragma unroll
        for (int s = 0; s < 4; ++s) { sbq[s] = dn::packB(SQ[2 * s], SQ[2 * s + 1]); sbp[s] = dn::packB(SP[2 * s], SP[2 * s + 1]); }
        f32x4 vq[4], vp[4];
#pragma unroll
        for (int mt = 0; mt < 4; ++mt) { vq[mt] = u_unpack(ucur[mt]); vp[mt] = (f32x4){0.f, 0.f, 0.f, 0.f};
#pragma unroll
            for (int s = 0; s < 4; ++s) { const bf16x8 f = dn::frag(Wl, mt * 4 + s, lane); vq[mt] = MFMA16(f, sbq[s], vq[mt]); vp[mt] = MFMA16(f, sbp[s], vp[mt]); } }
        bf16x8 vbq[2], vbp[2];
#pragma unroll
        for (int s = 0; s < 2; ++s) { vbq[s] = dn::packB(vq[2 * s], vq[2 * s + 1]); vbp[s] = dn::packB(vp[2 * s], vp[2 * s + 1]); }
#pragma unroll
        for (int mt = 0; mt < 8; ++mt) { SQ[mt] = SQ[mt] * eg; SP[mt] = SP[mt] * eg;
#pragma unroll
            for (int s = 0; s < 2; ++s) { const bf16x8 f = dn::frag(Kl, mt * 2 + s, lane); SQ[mt] = MFMA16(f, vbq[s], SQ[mt]); SP[mt] = MFMA16(f, vbp[s], SP[mt]); } }
        if (i + 1 < GRP) { stage_write2(st, lds + ((i + 1) & 1) * SBUF);
#pragma unroll
            for (int mt = 0; mt < 4; ++mt) ucur[mt] = unxt[mt];
            egc = egn; }
        asm volatile("s_waitcnt lgkmcnt(0)" ::: "memory"); __builtin_amdgcn_s_barrier();
    }
    bf16_t* PG = (bf16_t*)(a.ws + WS_PG) + (size_t)chain * 16384;
#pragma unroll
    for (int mt = 0; mt < 8; ++mt)
#pragma unroll
        for (int r = 0; r < 4; ++r) PG[((mt * 4 + (vs >> 1)) * 64 + (lr >> 2) * 16 + 4 * lq + r) * 8 + 4 * (vs & 1) + (lr & 3)] = f2bf(SP[mt][r]);
    float* QG = (float*)(a.ws + WS_QG) + ((size_t)chain * 8 + vs) * 2048;
#pragma unroll
    for (int mt = 0; mt < 8; ++mt) *(f32x4*)(QG + ((size_t)mt * 64 + lane) * 4) = SQ[mt];
}
DI void scanPC_chain(const Args& a, char* lds, int chain, int half) {
    const int tid = threadIdx.x, lane = tid & 63, wv = tid >> 6, vs = (wv & 3) + 4 * half, lr = lane & 15, lq = lane >> 4; const bool cw = wv < 4;
    const int h = chain >> 4, g = chain & 15;
    f32x4 S[8];
#pragma unroll
    for (int mt = 0; mt < 8; ++mt) S[mt] = (f32x4){0.f, 0.f, 0.f, 0.f};
    __syncthreads();
    if (g > 0) {
        const bf16_t* PG = (const bf16_t*)(a.ws + WS_PG) + (size_t)(h * NGRP) * 16384; const float* QG = (const float*)(a.ws + WS_QG) + ((size_t)(h * NGRP) * 8 + vs) * 2048;
        Stage<4> P0, P1; f32x4 Q0[8], Q1[8];
#define PF_LOAD(PR, QR, j_) do { stage_load2(PR, PG + (size_t)(j_) * 16384, PG + (size_t)(j_) * 16384 + 8192); \
            _Pragma("unroll") for (int mt = 0; mt < 8; ++mt) QR[mt] = *(const f32x4*)(QG + (size_t)(j_) * 16384 + ((size_t)mt * 64 + lane) * 4); } while (0)
#define PF_STEP(j_, BUF, QC, PC, PN) do { \
            f32x4 acc_[8]; _Pragma("unroll") for (int mt = 0; mt < 8; ++mt) acc_[mt] = QC[mt]; \
            if ((j_) + 2 < g) PF_LOAD(PC, QC, (j_) + 2); \
            if (cw) { const bf16_t* Pl = (const bf16_t*)(lds + (BUF) * SBUF); bf16x8 sb[4]; \
            _Pragma("unroll") for (int s = 0; s < 4; ++s) sb[s] = dn::packB(S[2 * s], S[2 * s + 1]); \
            _Pragma("unroll") for (int mp = 0; mp < 4; ++mp) { bf16x8 fp[8];                                     \
                _Pragma("unroll") for (int q_ = 0; q_ < 8; ++q_) fp[q_] = dn::frag(Pl, mp * 8 + q_, lane); \
                __builtin_amdgcn_sched_barrier(0); \
                f32x4 a0_ = acc_[2 * mp], a1_ = acc_[2 * mp + 1]; \
                _Pragma("unroll") for (int s = 0; s < 4; ++s) { a0_ = MFMA16(fp[s], sb[s], a0_); a1_ = MFMA16(fp[4 + s], sb[s], a1_); } \
                S[2 * mp] = a0_; S[2 * mp + 1] = a1_; \
                __builtin_amdgcn_sched_barrier(0); } } \
            if ((j_) + 1 < g) stage_write2(PN, lds + ((BUF) ^ 1) * SBUF); \
            asm volatile("s_waitcnt lgkmcnt(0)" ::: "memory"); __builtin_amdgcn_s_barrier(); } while (0)
        PF_LOAD(P0, Q0, 0);
        if (g > 1) PF_LOAD(P1, Q1, 1);
        stage_write2(P0, lds);
        __syncthreads();
        for (int j = 0; j < g; j += 2) { PF_STEP(j, 0, Q0, P0, P1); if (j + 1 < g) PF_STEP(j + 1, 1, Q1, P1, P0); }
#undef PF_LOAD
#undef PF_STEP
    }
    const size_t cb0 = (size_t)(h * NCH + g * GRP);
    const bf16_t* WF = (const bf16_t*)(a.ws + WS_DNW) + cb0 * 8192; const bf16_t* KF = (const bf16_t*)(a.ws + WS_DNKD) + cb0 * 8192;
    const bf16_t* QF = (const bf16_t*)(a.ws + WS_DNQD) + cb0 * 8192; const bf16_t* AF = (const bf16_t*)(a.ws + WS_DNATT) + cb0 * 4096;
    const bf16_t* UF = (const bf16_t*)(a.ws + WS_DNU) + cb0 * 8192 + (size_t)vs * 1024; const float* EG = (const float*)(a.ws + WS_EG) + cb0;
    float* ORAW = (float*)(a.ws + WS_ORAW);
    Stage<7> R0, R1; u32x2 U0[4], U1[4]; float E0, E1;
#define PC_LOAD(RR, UU, EE, i_) do { stage_load4(RR, WF + (size_t)(i_) * 8192, KF + (size_t)(i_) * 8192, QF + (size_t)(i_) * 8192, AF + (size_t)(i_) * 4096); \
        _Pragma("unroll") for (int mt = 0; mt < 4; ++mt) UU[mt] = *(const u32x2*)(UF + (size_t)(i_) * 8192 + ((size_t)mt * 64 + lane) * 4); EE = EG[(i_)]; } while (0)
#define PC_STEP(i_, BUF, RC, UC, EC, RN) do { \
        const char* buf = lds + (BUF) * SBUF; const int n = g * GRP + (i_); \
        f32x4 vn[4], o[4]; const float eg = EC; \
        _Pragma("unroll") for (int mt = 0; mt < 4; ++mt) { vn[mt] = u_unpack(UC[mt]); o[mt] = (f32x4){0.f, 0.f, 0.f, 0.f}; } \
        if ((i_) + 2 < GRP) PC_LOAD(RC, UC, EC, (i_) + 2); \
        const bf16_t* Wl = (const bf16_t*)buf; const bf16_t* Kl = (const bf16_t*)(buf + 16384); const bf16_t* Ql = (const bf16_t*)(buf + 32768); const bf16_t* Al = (const bf16_t*)(buf + 49152); \
        if (cw) { bf16x8 sb[4]; \
        _Pragma("unroll") for (int s = 0; s < 4; ++s) sb[s] = dn::packB(S[2 * s], S[2 * s + 1]); \
        _Pragma("unroll") for (int mt = 0; mt < 4; ++mt) { bf16x8 fw[4], fq[4];                                    \
            _Pragma("unroll") for (int s = 0; s < 4; ++s) { fw[s] = dn::frag(Wl, mt * 4 + s, lane); fq[s] = dn::frag(Ql, mt * 4 + s, lane); } \
            __builtin_amdgcn_sched_barrier(0); \
            _Pragma("unroll") for (int s = 0; s < 4; ++s) { vn[mt] = MFMA16(fw[s], sb[s], vn[mt]); o[mt] = MFMA16(fq[s], sb[s], o[mt]); } \
            __builtin_amdgcn_sched_barrier(0); } \
        bf16x8 vb[2]; \
        _Pragma("unroll") for (int s = 0; s < 2; ++s) vb[s] = dn::packB(vn[2 * s], vn[2 * s + 1]); \
        { bf16x8 fa[8]; \
            _Pragma("unroll") for (int q_ = 0; q_ < 8; ++q_) fa[q_] = dn::frag(Al, q_, lane); \
            __builtin_amdgcn_sched_barrier(0); \
            _Pragma("unroll") for (int mt = 0; mt < 4; ++mt) _Pragma("unroll") for (int s = 0; s < 2; ++s) o[mt] = MFMA16(fa[mt * 2 + s], vb[s], o[mt]); \
            __builtin_amdgcn_sched_barrier(0); } \
        _Pragma("unroll") for (int mh = 0; mh < 2; ++mh) { bf16x8 fk[8]; \
            _Pragma("unroll") for (int q_ = 0; q_ < 8; ++q_) fk[q_] = dn::frag(Kl, mh * 8 + q_, lane); \
            _Pragma("unroll") for (int m_ = 0; m_ < 4; ++m_) S[mh * 4 + m_] = S[mh * 4 + m_] * eg; \
            __builtin_amdgcn_sched_barrier(0); \
            _Pragma("unroll") for (int m_ = 0; m_ < 4; ++m_) _Pragma("unroll") for (int s = 0; s < 2; ++s) S[mh * 4 + m_] = MFMA16(fk[m_ * 2 + s], vb[s], S[mh * 4 + m_]); \
            __builtin_amdgcn_sched_barrier(0); } \
        _Pragma("unroll") for (int mt = 0; mt < 4; ++mt) \
            _Pragma("unroll") for (int r = 0; r < 4; ++r) ORAW[(size_t)(n * CH + 16 * mt + 4 * lq + r) * 512 + h * 128 + 16 * vs + lr] = o[mt][r]; } \
        if ((i_) + 1 < GRP) stage_write4(RN, lds + ((BUF) ^ 1) * SBUF); \
        asm volatile("s_waitcnt lgkmcnt(0)" ::: "memory"); __builtin_amdgcn_s_barrier(); } while (0)
    PC_LOAD(R0, U0, E0, 0);
    PC_LOAD(R1, U1, E1, 1);
    stage_write4(R0, lds);
    __syncthreads();
#pragma unroll 1
    for (int i = 0; i < GRP; i += 2) { PC_STEP(i, 0, R0, U0, E0, R1); PC_STEP(i + 1, 1, R1, U1, E1, R0); }
#undef PC_LOAD
#undef PC_STEP
}
DI int fox_jlo(const Args& a, int h, int qb, const float* qkbs, int lane) {
    const float* Fh = (const float*)(a.ws + WS_F) + (size_t)h * SEQ; const float* TB = (const float*)(a.ws + WS_NRMT); const int P0 = qb * 256;
    float mq = 0.f, md = 3.0e38f;
    if (lane < 32) { mq = TB[(qb * 32 + lane) * 12 + h]; md = TB[(qb * 32 + lane) * 12 + 8 + h]; }
    for (int o_ = 1; o_ < 64; o_ <<= 1) { mq = fmaxf(mq, __shfl_xor(mq, o_)); md = fminf(md, __shfl_xor(md, o_)); }
    const float qkb = sqrtf(mq * qkbs[h]) * fox::SCALE, lim = Fh[P0] + qkb - md * fox::SCALE + 32.f;
    const int jd = P0 / 64, stride = jd / 64 + 1;
    int j = lane * stride; bool ok = (j > jd) ? true : (Fh[64 * j + 63] <= lim);
    unsigned long long mk = __ballot(ok); const int first = mk ? __builtin_ctzll(mk) : 64;
    const int lo_ex = first == 0 ? -1 : (first - 1) * stride; const int hi_in = (first < 64 && first * stride <= jd) ? first * stride : jd;
    j = lo_ex + 1 + lane; ok = (j < hi_in) ? (Fh[64 * j + 63] <= lim) : false;
    mk = __ballot(ok); return mk ? lo_ex + 1 + __builtin_ctzll(mk) : hi_in;
}
DI void ph4_fox(const Args& a, char* lds, int nscan) {
    const int tid = threadIdx.x, lane = tid & 63, wave = tid >> 6;
    const float* F = (const float*)(a.ws + WS_F); unsigned* QH = (unsigned*)(a.ws + WS_QH);
    int* misc = (int*)(lds + fox::OFF_MISC);
    float* qkbs = (float*)(lds + fox::OFF_MISC) + 8;
    const float* TB = (const float*)(a.ws + WS_NRMT);
    float mv[16];
#pragma unroll
    for (int k = 0; k < 16; ++k) mv[k] = TB[((tid >> 2) + k * (NTHREADS / 4)) * 12 + 4 + (tid & 3)];
    if (tid == 0) { int ord0 = 0, ord1 = 1, ord2 = 2, ord3 = 3;
      float r0 = -F[0 * SEQ + SEQ - 1], r1 = -F[1 * SEQ + SEQ - 1], r2 = -F[2 * SEQ + SEQ - 1], r3 = -F[3 * SEQ + SEQ - 1];
#define CSWAP(ra, rb, oa, ob) if (rb < ra) { const float tf = ra; ra = rb; rb = tf; const int ti = oa; oa = ob; ob = ti; }
      CSWAP(r0, r1, ord0, ord1) CSWAP(r2, r3, ord2, ord3) CSWAP(r0, r2, ord0, ord2) CSWAP(r1, r3, ord1, ord3) CSWAP(r1, r2, ord1, ord2)
#undef CSWAP
      misc[4] = ord0; misc[5] = ord1; misc[6] = ord2; misc[7] = ord3; }
    { float m = 0.f;
#pragma unroll
        for (int k = 0; k < 16; ++k) m = fmaxf(m, mv[k]);
        for (int o_ = 4; o_ < 64; o_ <<= 1) m = fmaxf(m, __shfl_xor(m, o_));
        if (lane < 4) qkbs[16 + wave * 4 + lane] = m; }
    __syncthreads();
    if (tid < 4) { float m = 0.f; for (int w = 0; w < NWAVES; ++w) m = fmaxf(m, qkbs[16 + w * 4 + tid]); qkbs[tid] = m; }
    for (int round = 0;; ++round) {
        __syncthreads();
        if (tid == 0) misc[0] = (round == 0 && (int)blockIdx.x >= nscan) ? (int)blockIdx.x - nscan : (int)((int)gridDim.x - nscan + (int)atomicAdd(QH, 1u));
        __syncthreads();
        const int it = misc[0];
        if (it >= 256) break;
        const int h = misc[4 + (it >> 6)], qb = 63 - (it & 63), P0 = qb * 256;
        if (wave == 0) { const int jlo = fox_jlo(a, h, qb, qkbs, lane); if (lane == 0) misc[1] = jlo; }
        __syncthreads();
        fox::fox_block(a, lds, h, P0, misc[1]);
    }
    { unsigned* QC = (unsigned*)(a.ws + WS_QH) + 64; int par = 0;
        for (;;) {
            __syncthreads();
            if (tid == 0) misc[0] = (int)atomicAdd(QC, 1u);
            __syncthreads();
            const int c4 = misc[0] * 4;
            if (c4 >= Q_WGU + Q_WD) break;
#pragma unroll 1
            for (int q = 0; q < 4; ++q) { if (c4 < Q_WGU) conv_quad_gu(a, lds, par, c4 + q); else conv_quad_d(a, lds, par, c4 - Q_WGU + q); }
        }
    }
}
DI void ph4(const Args& a, float* lds) {
    const int nscan = (int)gridDim.x >= 2 * NSCAN ? NSCAN : 0;
    for (int chain = blockIdx.x; chain < NSCAN; chain += gridDim.x) scanA_chain(a, (char*)lds, chain);
    ph4_fox(a, (char*)lds, nscan);
}
DI bool merge_early(int G) { return G > 2 * NSCAN && G - 2 * NSCAN == SEQ / 256 * 2; }
DI void ph5_scan(const Args& a, float* lds) {
    const int G = gridDim.x;
    if (G > 2 * NSCAN) { if ((int)blockIdx.x < 2 * NSCAN) scanPC_chain(a, (char*)lds, blockIdx.x >> 1, blockIdx.x & 1);
        else { const int c = blockIdx.x - 2 * NSCAN, Gi = G - 2 * NSCAN;
            ph2_rest(a, (unsigned char*)lds, c, Gi); __syncthreads();
            if (merge_early(G)) {
                pg8::OrderDense S0; S0.init(SEQ / 256, NPJ / 256 - P2_NT, Gi, c, P2_NT); pg8::Unit u; S0.next(0, u);
                asm volatile("s_waitcnt vmcnt(0)" ::: "memory"); __syncthreads();
                const bf16_t* P = (const bf16_t*)(a.ws + WS_PROJ);
                pg8::Gemm g{(const bf16_t*)(a.ws + WS_OB), (const bf16_t*)(a.ws + WS_WOBT), SEQ, DM, 512};
                pg8::OrderTwo S{u.pm, u.pn - 20, u.pn - 18};
                pg8::EpiMerge<0> E{P + PJ_GB, (bf16_t*)(a.ws + WS_X1), (bf16_t*)(a.ws + WS_MRG)};
                pg8::gemm_phase<pg8::EpiMerge<0>, pg8::OrderTwo>((LAS unsigned char*)lds, g, S, E); __syncthreads(); } } }
    else { for (int u = blockIdx.x; u < 2 * NSCAN; u += G) scanPC_chain(a, (char*)lds, u >> 1, u & 1); ph2_rest(a, (unsigned char*)lds, blockIdx.x, G); __syncthreads(); }
}

DI void ph5(const Args& a) {
    const int lane = threadIdx.x & 63, wave = threadIdx.x >> 6, NW = gridDim.x * NWAVES;
    const float* ORAW = (const float*)(a.ws + WS_ORAW); const bf16_t* P = (const bf16_t*)(a.ws + WS_PROJ); bf16_t* OA = (bf16_t*)(a.ws + WS_OA);
    const float g0 = a.in[I_GON][lane], g1 = a.in[I_GON][lane + 64];
    for (int t = blockIdx.x * NWAVES + wave; t < SEQ; t += NW) {
        float o0[4], o1[4], z0[4], z1[4];
#pragma unroll
        for (int h = 0; h < 4; ++h) { o0[h] = ORAW[(size_t)t * 512 + h * 128 + lane]; o1[h] = ORAW[(size_t)t * 512 + h * 128 + 64 + lane];
            z0[h] = bf2f(P[(size_t)t * NPJ + PJ_DZ + h * 128 + lane]); z1[h] = bf2f(P[(size_t)t * NPJ + PJ_DZ + h * 128 + 64 + lane]); }
#pragma unroll
        for (int h = 0; h < 4; ++h) { const float rstd = rsqrtf(wave_sum(o0[h] * o0[h] + o1[h] * o1[h]) * (1.f / 128.f) + 1e-6f);
            OA[(size_t)t * 512 + h * 128 + lane] = f2bf(o0[h] * rstd * g0 * fsilu(z0[h])); OA[(size_t)t * 512 + h * 128 + 64 + lane] = f2bf(o1[h] * rstd * g1 * fsilu(z1[h])); }
    }
}

DI void ph6(const Args& a, unsigned char* ldsb) {
    const bf16_t* P = (const bf16_t*)(a.ws + WS_PROJ);
    pg8::OrderDense S; S.init(SEQ / 256, DM / 256, (int)gridDim.x, (int)blockIdx.x);
    if (!merge_early((int)gridDim.x)) {
      pg8::Gemm g{(const bf16_t*)(a.ws + WS_OB), (const bf16_t*)(a.ws + WS_WOBT), SEQ, DM, 512};
      pg8::EpiMerge<0> E{P + PJ_GB, (bf16_t*)(a.ws + WS_X1), (bf16_t*)(a.ws + WS_MRG)};
      pg8::gemm_phase<pg8::EpiMerge<0>, pg8::OrderDense>((LAS unsigned char*)ldsb, g, S, E);
      __syncthreads(); }
    { pg8::Gemm g{(const bf16_t*)(a.ws + WS_OA), (const bf16_t*)(a.ws + WS_WOAT), SEQ, DM, 512};
      pg8::EpiMerge<1> E{P + PJ_GA, (bf16_t*)(a.ws + WS_X1), (bf16_t*)(a.ws + WS_MRG)};
      pg8::gemm_phase<pg8::EpiMerge<1>, pg8::OrderDense>((LAS unsigned char*)ldsb, g, S, E); }
}

DI void ph7(const Args& a, unsigned char* ldsb) {
    pg8::Gemm g{(const bf16_t*)(a.ws + WS_MRG), (const bf16_t*)(a.ws + WS_WOUTT), SEQ, DM, DM};
    pg8::OrderDense S; S.init(SEQ / 256, DM / 256, (int)gridDim.x, (int)blockIdx.x);
    pg8::EpiColScale E{(const float*)(a.ws + WS_MOD) + 2048, (bf16_t*)(a.ws + WS_ORAW)};
    pg8::gemm_phase<pg8::EpiColScale, pg8::OrderDense>((LAS unsigned char*)ldsb, g, S, E);
}

DI void ph8(const Args& a, float* lds, const XcdBarrier& bar, bool seam) {
    const int tid = threadIdx.x, lane = tid & 63, wave = tid >> 6, G = gridDim.x;
    constexpr int HPB = 2064;
    float* A2 = lds; float* B2 = lds + 1024; char* hsh = (char*)(lds + 2048); char* hsl = hsh + 16 * HPB; float* lgs = (float*)(hsl + 16 * HPB);
    const float* mod = (const float*)(a.ws + WS_MOD);
    for (int k = tid; k < DM; k += NTHREADS) { A2[k] = a.in[I_G2][k] * (1.f + mod[4096 + k]); B2[k] = mod[3072 + k]; }
    const float* Xin = a.in[I_X]; const bf16_t* D1 = (const bf16_t*)(a.ws + WS_ORAW); bf16_t* X1b = (bf16_t*)(a.ws + WS_X1); bf16_t* H2 = (bf16_t*)(a.ws + WS_H2);
    int* TOKE = (int*)(a.ws + WS_TOKE); int* TOKS = (int*)(a.ws + WS_TOKS); float* TOKG = (float*)(a.ws + WS_TOKG); unsigned* CNT = (unsigned*)(a.ws + WS_CNT);
    const float* wr = a.in[I_WR];
    float* part = lgs + 512; int* lcnt = (int*)(part + 8 * 16 * 32);
    bf16x8 wbh[4][2], wbl[4][2];
#pragma unroll
    for (int s = 0; s < 4; ++s)
#pragma unroll
        for (int c = 0; c < 2; ++c) { float f[8];
#pragma unroll
            for (int j = 0; j < 8; ++j) f[j] = wr[(size_t)(128 * wave + 32 * s + 8 * (lane >> 4) + j) * NE + 16 * c + (lane & 15)];
            u32x4 hi, lo;
#define P8_SPLIT(a_, b_, H, L) do { H = cvt_pk(a_, b_); L = cvt_pk((a_) - __uint_as_float(H << 16), (b_) - __uint_as_float(H & 0xffff0000u)); } while (0)
            P8_SPLIT(f[0], f[1], hi.x, lo.x); P8_SPLIT(f[2], f[3], hi.y, lo.y); P8_SPLIT(f[4], f[5], hi.z, lo.z); P8_SPLIT(f[6], f[7], hi.w, lo.w);
            wbh[s][c] = *reinterpret_cast<bf16x8*>(&hi); wbl[s][c] = *reinterpret_cast<bf16x8*>(&lo); }
#define P8_LOAD(V, tl) _Pragma("unroll") for (int q = 0; q < 2; ++q) _Pragma("unroll") for (int i = 0; i < 4; ++i) { V[q][i] = *(const f32x4*)(Xin + (size_t)((tl) * 16 + wave * 2 + q) * DM + lane * 4 + 256 * i); V##d[q][i] = *(const u32x2*)(D1 + (size_t)((tl) * 16 + wave * 2 + q) * DM + lane * 4 + 256 * i); }
#define P8_BAR() do { asm volatile("s_waitcnt lgkmcnt(0)" ::: "memory"); __builtin_amdgcn_s_barrier(); asm volatile("" ::: "memory"); } while (0)
    const float brv = a.in[I_BR][tid & 31];
    f32x4 vA[2][4]; u32x2 vAd[2][4];
    if ((int)blockIdx.x < SEQ / 16) {
#pragma unroll
        for (int q = 0; q < 2; ++q)
#pragma unroll
            for (int i = 0; i < 4; ++i) vA[q][i] = *(const f32x4*)(Xin + (size_t)(blockIdx.x * 16 + wave * 2 + q) * DM + lane * 4 + 256 * i); }
    if (seam) xcd_barrier(bar); else __syncthreads();
    if ((int)blockIdx.x < SEQ / 16) {
#pragma unroll
        for (int q = 0; q < 2; ++q)
#pragma unroll
            for (int i = 0; i < 4; ++i) vAd[q][i] = *(const u32x2*)(D1 + (size_t)(blockIdx.x * 16 + wave * 2 + q) * DM + lane * 4 + 256 * i); }
    auto body = [&](const int tile, f32x4 (&vin)[2][4], u32x2 (&vind)[2][4]) __attribute__((always_inline)) {
        P8_BAR();
#pragma unroll
        for (int q = 0; q < 2; ++q) { const int tt = wave * 2 + q, t = tile * 16 + tt;
            f32x4 v[4]; float ss = 0.f;
#pragma unroll
            for (int i = 0; i < 4; ++i) { const u32x2 d_ = vind[q][i]; v[i] = vin[q][i] + (f32x4){__uint_as_float(d_.x << 16), __uint_as_float(d_.x & 0xffff0000u), __uint_as_float(d_.y << 16), __uint_as_float(d_.y & 0xffff0000u)};
                { u32x2 xb; xb.x = cvt_pk(v[i][0], v[i][1]); xb.y = cvt_pk(v[i][2], v[i][3]); *(u32x2*)(X1b + (size_t)t * DM + lane * 4 + 256 * i) = xb; }
                ss += v[i][0] * v[i][0] + v[i][1] * v[i][1] + v[i][2] * v[i][2] + v[i][3] * v[i][3]; }
            ss = wave_sum(ss);
            const float rstd = rsqrtf(ss * (1.f / DM) + 1e-6f);
#pragma unroll
            for (int i = 0; i < 4; ++i) { const int k = lane * 4 + 256 * i;
#pragma unroll
                for (int e = 0; e < 4; ++e) v[i][e] = v[i][e] * rstd * A2[k + e] + B2[k + e];
                { u32x2 hi, lo; P8_SPLIT(v[i][0], v[i][1], hi.x, lo.x); P8_SPLIT(v[i][2], v[i][3], hi.y, lo.y);
                    *(u32x2*)(hsh + tt * HPB + k * 2) = hi; *(u32x2*)(hsl + tt * HPB + k * 2) = lo; }
                *(unsigned*)((unsigned char*)H2 + (size_t)t * DM + k) = cvt_f8x4(__builtin_amdgcn_fmed3f(v[i][0], -440.f, 440.f), __builtin_amdgcn_fmed3f(v[i][1], -440.f, 440.f), __builtin_amdgcn_fmed3f(v[i][2], -440.f, 440.f), __builtin_amdgcn_fmed3f(v[i][3], -440.f, 440.f));   } }
        if (tile + G < SEQ / 16) P8_LOAD(vin, tile + G);
        P8_BAR();
        {
            if (tid < 32) lcnt[tid] = 0;
            f32x4 c0 = (f32x4){0.f, 0.f, 0.f, 0.f}, c1 = c0; const int aoff = (lane & 15) * HPB + (128 * wave + 8 * (lane >> 4)) * 2;
            bf16x8 ah[4], al[4];
#pragma unroll
            for (int s = 0; s < 4; ++s) { ah[s] = *(const bf16x8*)(hsh + aoff + 64 * s); al[s] = *(const bf16x8*)(hsl + aoff + 64 * s); }
#pragma unroll
            for (int s = 0; s < 4; ++s) { c0 = MFMA16(ah[s], wbh[s][0], c0); c1 = MFMA16(ah[s], wbh[s][1], c1); c0 = MFMA16(ah[s], wbl[s][0], c0); c1 = MFMA16(ah[s], wbl[s][1], c1); c0 = MFMA16(al[s], wbh[s][0], c0); c1 = MFMA16(al[s], wbh[s][1], c1); }
#pragma unroll
            for (int r = 0; r < 4; ++r) { part[(wave * 16 + 4 * (lane >> 4) + r) * 32 + (lane & 15)] = c0[r]; part[(wave * 16 + 4 * (lane >> 4) + r) * 32 + 16 + (lane & 15)] = c1[r]; }
            P8_BAR();
            const int tt = tid >> 5, e = tid & 31; float acc = brv;
#pragma unroll
            for (int w = 0; w < 8; ++w) acc += part[(w * 16 + tt) * 32 + e];
            lgs[tt * 32 + e] = acc; }
        P8_BAR();
        { const int e = lane & 31, tt = wave * 2 + (lane >> 5), t = tile * 16 + tt;
            const float cur = lgs[tt * 32 + e]; int rk = 0; float mx = cur;
#pragma unroll
            for (int j4 = 0; j4 < 8; ++j4) { const f32x4 x = *(const f32x4*)(lgs + tt * 32 + 4 * j4);
#pragma unroll
                for (int i = 0; i < 4; ++i) { const int j = 4 * j4 + i; rk += (x[i] > cur || (x[i] == cur && j < e)) ? 1 : 0; mx = fmaxf(mx, x[i]); } }
            const bool sel = rk < 4; const float ex = sel ? expf(cur - mx) : 0.f; float den = ex;
#pragma unroll
            for (int o_ = 1; o_ <= 16; o_ <<= 1) den += __shfl_xor(den, o_);
            if (sel) { const int rank = atomicAdd(lcnt + e, 1);
                TOKE[t * 4 + rk] = e; TOKS[t * 4 + rk] = rank; TOKG[t * 4 + rk] = ex / den; } }
        P8_BAR();
        if (tid < 32) ((int*)(a.ws + WS_TCNT))[tile * 32 + tid] = lcnt[tid];
    };
    for (int tile = blockIdx.x; tile < SEQ / 16; tile += G) body(tile, vA, vAd);
#undef P8_LOAD
#undef P8_BAR
#undef P8_SPLIT
}

DI void pad_starts(const Args& a, int* ps) {
    if (threadIdx.x < 64) { const int lane = threadIdx.x; const unsigned* CNT = (const unsigned*)(a.ws + WS_CNT);
        const int c = lane < NE ? (int)((CNT[lane & 31] + 255u) / 256u) * 256 : 0; int inc = c;
#pragma unroll
        for (int o_ = 1; o_ < 32; o_ <<= 1) { const int y = __shfl_up(inc, o_); if ((lane & 31) >= o_) inc += y; }
        if (lane < NE) ps[lane] = inc - c;
        if (lane == NE - 1) ps[NE] = inc; }
    __syncthreads();
}
DI void ph9(const Args& a, float* lds) {
    const int tid = threadIdx.x, lane = tid & 63, wave = tid >> 6, G = gridDim.x;
    int* tab = (int*)lds; int* segs = tab + 32768; int* segoff = segs + 512; int* ps = segoff + 512; int* basel = ps + 64;
    const int* TCNT = (const int*)(a.ws + WS_TCNT);
    const int* TOKE = (const int*)(a.ws + WS_TOKE); int* TOKS = (int*)(a.ws + WS_TOKS); int* RT = (int*)(a.ws + WS_ROWTOK);
    int te0 = 0, ts0 = 0;
    { const int tile = blockIdx.x + (tid >> 6) * G; if (tid < 256 && tile < SEQ / 16) { te0 = TOKE[tile * 64 + (tid & 63)]; ts0 = TOKS[tile * 64 + (tid & 63)]; } }
    for (int i = tid; i < 8192; i += NTHREADS) ((u32x4*)tab)[i] = ((const u32x4*)TCNT)[i];
    __syncthreads();
    { const int e = tid & 31, sg = tid >> 5; int s = 0;
#pragma unroll 8
        for (int q = 0; q < 64; ++q) s += tab[(sg * 64 + q) * 32 + e];
        segs[sg * 32 + e] = s; }
    __syncthreads();
    if (tid < 64) { int run = 0;
        if (tid < 32) { for (int sg = 0; sg < 16; ++sg) { segoff[sg * 32 + tid] = run; run += segs[sg * 32 + tid]; }
            segs[tid] = run;
            if (blockIdx.x == 0) ((unsigned*)(a.ws + WS_CNT))[tid] = (unsigned)run; }
        const int c = tid < 32 ? ((run + 255) / 256) * 256 : 0; int inc = c;
#pragma unroll
        for (int o_ = 1; o_ < 32; o_ <<= 1) { const int y = __shfl_up(inc, o_); if ((tid & 31) >= o_) inc += y; }
        if (tid < 32) ps[tid] = inc - c;
        if (tid == 31) ps[NE] = inc; }
    __syncthreads();
    if (blockIdx.x == 0) { int* PST = (int*)(a.ws + WS_PST); const int nM = ps[NE] / 256;
        if (tid <= NE) PST[tid] = ps[tid];
        for (int t = tid; t < nM; t += NTHREADS) { int e = 0; for (int i = 1; i < NE; ++i) if (t * 256 >= ps[i]) e = i; PST[40 + t] = e; } }
    for (int e = blockIdx.x; e < NE; e += G)
        for (int r = ps[e] + segs[e] + tid; r < ps[e + 1]; r += NTHREADS) RT[r] = 0;
    for (int t0 = blockIdx.x; t0 < SEQ / 16; t0 += 4 * G) {
        __syncthreads();
        if (tid < 128) { const int j = tid >> 5, e = tid & 31, tile = t0 + j * G;
            if (tile < SEQ / 16) { int b = segoff[(tile >> 6) * 32 + e]; const int q0 = (tile >> 6) * 64; int b1 = 0, b2 = 0, b3 = 0;
#pragma unroll 4
                for (int q = 0; q < 64; q += 4) { b += (q0 + q < tile) ? tab[(q0 + q) * 32 + e] : 0; b1 += (q0 + q + 1 < tile) ? tab[(q0 + q + 1) * 32 + e] : 0; b2 += (q0 + q + 2 < tile) ? tab[(q0 + q + 2) * 32 + e] : 0; b3 += (q0 + q + 3 < tile) ? tab[(q0 + q + 3) * 32 + e] : 0; }
                basel[j * 32 + e] = ps[e] + b + b1 + b2 + b3; } }
        __syncthreads();
        if (tid < 256) { const int j = tid >> 6, tile = t0 + j * G;
            if (tile < SEQ / 16) { const int id = tile * 64 + (tid & 63); const bool first = t0 == (int)blockIdx.x; const int te = first ? te0 : TOKE[id], ts = first ? ts0 : TOKS[id], row = basel[j * 32 + te] + ts;
                RT[row] = id >> 2; TOKS[id] = row; } }
    }
}
DI void pad_starts_tab(const Args& a, int* ps) {
    pad_starts(a, ps);
    const int nM = ps[NE] / 256;
    for (int t = threadIdx.x; t < nM; t += NTHREADS) { int e = 0; for (int i = 1; i < NE; ++i) if (t * 256 >= ps[i]) e = i; ps[40 + t] = e; }
    __syncthreads();
}
DI int expert_of(const int* ps, int row0) { int e = 0; for (int i = 1; i < NE; ++i) if (row0 >= ps[i]) e = i; return e; }
DI void ph10(const Args& a, unsigned char* ldsb) {
    int* ps = (int*)(ldsb + 131072); const int* PST = (const int*)(a.ws + WS_PST);
    const int pv_ = (threadIdx.x < 40 + 288) ? PST[threadIdx.x] : 0; const int nM = PST[NE] / 256;
    pg8::Gemm g{(const bf16_t*)(a.ws + WS_H2), (const bf16_t*)(a.ws + WS_WGUT), 0, 2048, DM};
    pg8::OrderGrouped S; S.init(nM, 8, (int)gridDim.x, (int)blockIdx.x); S.ps = (const LAS int*)ps;
    int* rtl = (int*)(ldsb + 131072 + 2048);
    { const int* RT = (const int*)(a.ws + WS_ROWTOK); pg8::Unit u;
        int rv[10];
#pragma unroll
        for (int i = 0; i < 10; ++i) rv[i] = (threadIdx.x < 256 && S.tile(i, u)) ? RT[u.pm * 256 + threadIdx.x] : 0;
#pragma unroll
        for (int i = 0; i < 10; ++i) if (threadIdx.x < 256) rtl[i * 256 + threadIdx.x] = rv[i]; }
    if (threadIdx.x < 40 + 288) ps[threadIdx.x] = pv_;
    __syncthreads();
    pg8::EpiSwiglu E{(unsigned char*)(a.ws + WS_ACT), a.in[I_BGU]};
    pg8::gemm_phase<pg8::EpiSwiglu, pg8::OrderGrouped, true, true>((LAS unsigned char*)ldsb, g, S, E, (const LAS int*)rtl);
}
DI void ph11(const Args& a, unsigned char* ldsb, const XcdBarrier& bar, bool seam) {
    int* ps = (int*)(ldsb + 131072); pad_starts_tab(a, ps);
    if (seam) xcd_barrier(bar);
    pg8::Gemm g{(const bf16_t*)(a.ws + WS_ACT), (const bf16_t*)(a.ws + WS_WDT), 0, DM, DM};
    pg8::OrderGrouped S; S.init(ps[NE] / 256, 4, (int)gridDim.x, (int)blockIdx.x); S.ps = (const LAS int*)ps;
    pg8::EpiStoreF8 E{(unsigned char*)(a.ws + WS_YB), DM, a.in[I_BD], DM, 1.f / (WSCALE * ASCALE)};
    pg8::gemm_phase<pg8::EpiStoreF8, pg8::OrderGrouped, true>((LAS unsigned char*)ldsb, g, S, E);
}
DI void ph12(const Args& a, float* lds) {
    const int lane = threadIdx.x & 63, wave = threadIdx.x >> 6, G = gridDim.x;
    const bf16_t* X1b = (const bf16_t*)(a.ws + WS_X1); const unsigned char* YB = (const unsigned char*)(a.ws + WS_YB); const float* mod = (const float*)(a.ws + WS_MOD);
    const int* TOKS = (const int*)(a.ws + WS_TOKS); const float* TOKG = (const float*)(a.ws + WS_TOKG);
    f32x4 gt[4], gf[4];
#pragma unroll
    for (int i = 0; i < 4; ++i) { gt[i] = *(const f32x4*)(mod + 5120 + lane * 4 + 256 * i); gf[i] = *(const f32x4*)(a.in[I_GF] + lane * 4 + 256 * i); }
    for (int t0 = (blockIdx.x * NWAVES + wave) * 2; t0 < SEQ; t0 += G * NWAVES * 2) {
        int rows[2][4]; float gk[2][4];
#pragma unroll
        for (int p = 0; p < 2; ++p)
#pragma unroll
            for (int q = 0; q < 4; ++q) { rows[p][q] = TOKS[(t0 + p) * 4 + q]; gk[p][q] = TOKG[(t0 + p) * 4 + q] * (1.f / pg8::YSCALE); }
        f32x4 v[2][4]; unsigned yv[2][4][4]; u32x2 xv[2][4];
#pragma unroll
        for (int p = 0; p < 2; ++p)
#pragma unroll
            for (int i = 0; i < 4; ++i) { const int k = lane * 4 + 256 * i; xv[p][i] = *(const u32x2*)(X1b + (size_t)(t0 + p) * DM + k);
#pragma unroll
                for (int q = 0; q < 4; ++q) yv[p][i][q] = *(const unsigned*)(YB + (size_t)rows[p][q] * DM + k); }
#pragma unroll
        for (int p = 0; p < 2; ++p) { float ss = 0.f;
#pragma unroll
            for (int i = 0; i < 4; ++i) { f32x4 y = (f32x4){0.f, 0.f, 0.f, 0.f}; { const u32x2 x_ = xv[p][i]; v[p][i] = (f32x4){__uint_as_float(x_.x << 16), __uint_as_float(x_.x & 0xffff0000u), __uint_as_float(x_.y << 16), __uint_as_float(x_.y & 0xffff0000u)}; }
#pragma unroll
                for (int q = 0; q < 4; ++q) { const unsigned w = yv[p][i][q];
                    y[0] += gk[p][q] * __builtin_amdgcn_cvt_f32_fp8(w, 0); y[1] += gk[p][q] * __builtin_amdgcn_cvt_f32_fp8(w, 1); y[2] += gk[p][q] * __builtin_amdgcn_cvt_f32_fp8(w, 2); y[3] += gk[p][q] * __builtin_amdgcn_cvt_f32_fp8(w, 3); }
                v[p][i] += gt[i] * y; ss += v[p][i][0] * v[p][i][0] + v[p][i][1] * v[p][i][1] + v[p][i][2] * v[p][i][2] + v[p][i][3] * v[p][i][3]; }
            ss = wave_sum(ss);
            const float rstd = rsqrtf(ss * (1.f / DM) + 1e-6f);
#pragma unroll
            for (int i = 0; i < 4; ++i) *(f32x4*)(a.out + (size_t)(t0 + p) * DM + lane * 4 + 256 * i) = v[p][i] * rstd * gf[i]; }
    }
}

__global__ void __launch_bounds__(NTHREADS, 2) hybrid_fwd(Args a) {
    extern __shared__ __attribute__((aligned(16))) unsigned char lds_raw[];
    float* lds = (float*)(lds_raw + 16);
    LAS unsigned* xbw = (LAS unsigned*)lds_raw;
    if (threadIdx.x == 0) { xbw[0] = 0u; xbw[1] = 0u; xbw[2] = 0u; xbw[3] = 0u; }
    __syncthreads();
    XcdBarrier bar; bar.bar = (unsigned*)(a.ws + WS_BAR); bar.x = 0; bar.st = (volatile LAS unsigned*)xbw;
    const int lo = a.ph_lo, hi = a.ph_hi;
    if (hi - lo > 1) bar = xcd_barrier_post((unsigned*)(a.ws + WS_BAR), (volatile LAS unsigned*)xbw);
#define IN(k) (lo <= (k) && (k) < hi)
#define SEAM(k) do { if (IN(k) && IN((k) + 1)) xcd_barrier(bar); } while (0)
    if (IN(0)) ph0(a, lds);
    SEAM(0);
    if (IN(1)) ph1(a, lds);
    SEAM(1);
    if (IN(2)) ph2(a, lds_raw + 16);
    SEAM(2);
    if (IN(3)) ph3(a, lds);
    SEAM(3);
    if (IN(4)) ph4(a, lds);
    SEAM(4);
    if (IN(5)) ph5_scan(a, lds);
    SEAM(5);
    if (IN(6)) ph5(a);
    SEAM(6);
    if (IN(7)) ph6(a, lds_raw + 16);
    SEAM(7);
    if (IN(8)) ph7(a, lds_raw + 16);
    if (IN(9)) ph8(a, lds, bar, IN(8));
    SEAM(9);
    if (IN(10)) ph9(a, lds);
    SEAM(10);
    if (IN(11)) ph10(a, lds_raw + 16);
    if (IN(12)) ph11(a, lds_raw + 16, bar, IN(11));
    SEAM(12);
    if (IN(13)) ph12(a, lds);
#undef IN
#undef SEAM
}

extern "C" void kernel_launch(void* const* d_in, const int* in_sizes, int n_in, void* d_out, int out_size, void* d_ws, size_t ws_size, hipStream_t stream) {
    static int grid = 0;
    if (grid == 0) {
        if (n_in != 22 || out_size != SEQ * DM || ws_size < WS_END) { fprintf(stderr, "kernel_launch: unexpected shapes (n_in %d out %d ws %zu, need %zu)\n", n_in, out_size, ws_size, (size_t)WS_END); grid = -1; return; }
        int dev = 0, cus = 0, per_cu = 0;
        if (hipGetDevice(&dev) != hipSuccess || hipDeviceGetAttribute(&cus, hipDeviceAttributeMultiprocessorCount, dev) != hipSuccess) { grid = -1; return; }
        if (hipFuncSetAttribute((const void*)hybrid_fwd, hipFuncAttributeMaxDynamicSharedMemorySize, LDS_BYTES) != hipSuccess) { fprintf(stderr, "kernel_launch: hipFuncSetAttribute failed\n"); grid = -1; return; }
        if (hipOccupancyMaxActiveBlocksPerMultiprocessor(&per_cu, (const void*)hybrid_fwd, NTHREADS, LDS_BYTES) != hipSuccess || per_cu < 1) { fprintf(stderr, "kernel_launch: occupancy query says %d\n", per_cu); }
        (void)hipGetLastError();
        grid = cus;
    }
    if (grid < 0) return;
    (void)hipMemsetAsync(d_ws, 0, CTL_ZERO, stream);
    Args a{};
    for (int i = 0; i < 22; ++i) a.in[i] = (const float*)d_in[i];
    a.out = (float*)d_out; a.ws = (unsigned char*)d_ws;
#if N_LAUNCHES == 1
    a.ph_lo = 0; a.ph_hi = NPHASES;
    hipLaunchKernelGGL(hybrid_fwd, dim3(grid), dim3(NTHREADS), LDS_BYTES, stream, a);
#else
    for (int p = 0; p < NPHASES; ++p) { a.ph_lo = p; a.ph_hi = p + 1; hipLaunchKernelGGL(hybrid_fwd, dim3(grid), dim3(NTHREADS), LDS_BYTES, stream, a); }
#endif
}
```
